# Optimizing an MI355X kernel written in HIP

```python
import math
import jax, jax.numpy as jnp
from jax import lax
import numpy as np

D_MODEL = 1024
BATCH = 8
SEQ = 4096
DEPTH = 1

DN_HEADS = 4
DN_HEAD_DIM = 128
DN_WIDTH = DN_HEADS * DN_HEAD_DIM
CONV_WIDTH = 4
DN_CHUNK = 64
SWA_Q_HEADS = 8
SWA_KV_HEADS = 2
SWA_HEAD_DIM = 64
SWA_WIDTH = SWA_Q_HEADS * SWA_HEAD_DIM
SWA_KV_WIDTH = SWA_KV_HEADS * SWA_HEAD_DIM
SWA_WINDOW = 128
SWA_BLOCK = 128
MIX_WIDTH = DN_WIDTH + SWA_WIDTH
IN_SIZES = (DN_WIDTH, DN_WIDTH, DN_WIDTH, SWA_WIDTH, SWA_KV_WIDTH, SWA_KV_WIDTH, DN_WIDTH, DN_HEADS, DN_HEADS)
IN_COLS = sum(IN_SIZES)
N_EXPERTS = 256
N_GROUPS = 8
TOPK_GROUPS = 4
TOP_K = 8
EXPERT_FF = 256
SHARED_FF = 256
ROUTED_SCALE = 2.5
MOE_BLOCK = 256
DEEPNORM_ALPHA = (2.0 * DEPTH) ** 0.25
DEEPNORM_BETA = (8.0 * DEPTH) ** -0.25
LN_EPS = 1e-5
RMS_EPS = 1e-6
L2_EPS = 1e-6

kernel_name = "hymba_deltanet_swa_moe_deepnorm"


def layer_norm(x, g, b):
    xf = x.astype(jnp.float32)
    mu = jnp.mean(xf, axis=-1, keepdims=True)
    var = jnp.mean(jnp.square(xf - mu), axis=-1, keepdims=True)
    return ((xf - mu) * lax.rsqrt(var + LN_EPS) * g.astype(jnp.float32) + b.astype(jnp.float32)).astype(x.dtype)


def l2_normalize(x):
    return x * lax.rsqrt(jnp.sum(jnp.square(x), axis=-1, keepdims=True) + L2_EPS)


def causal_depthwise_conv(x, w):
    width = w.shape[0]
    return lax.conv_general_dilated(
        x, w[:, None, :].astype(x.dtype), window_strides=(1,), padding=[(width - 1, 0)],
        dimension_numbers=("NWC", "WIO", "NWC"), feature_group_count=x.shape[-1])


def gated_delta_rule(q, k, v, g, beta):
    B, T, H, DK = q.shape
    DV = v.shape[-1]
    C = DN_CHUNK
    NC = T // C

    def chunks(t):
        return t.reshape(B, NC, C, H, t.shape[-1]).transpose(0, 3, 1, 2, 4)

    q = chunks(q) * (DK ** -0.5)
    k = chunks(k)
    v = chunks(v)
    g = g.reshape(B, NC, C, H).transpose(0, 3, 1, 2)
    beta = beta.reshape(B, NC, C, H).transpose(0, 3, 1, 2)
    gc = jnp.cumsum(g, axis=-1)

    tri_incl = jnp.tril(jnp.ones((C, C), dtype=bool))
    tri_strict = jnp.tril(jnp.ones((C, C), dtype=bool), k=-1)
    decay = jnp.exp(jnp.where(tri_incl, gc[..., :, None] - gc[..., None, :], -jnp.inf))

    kb = k * beta[..., None]
    vb = v * beta[..., None]
    a_strict = jnp.where(tri_strict, jnp.einsum("bhnik,bhnjk->bhnij", kb, k) * decay, 0.0)
    rhs = jnp.concatenate([vb, kb * jnp.exp(gc)[..., None]], axis=-1)
    eye = jnp.eye(C, dtype=q.dtype)
    sol = lax.linalg.triangular_solve(eye + a_strict, rhs, left_side=True, lower=True, unit_diagonal=True)
    u, w = sol[..., :DV], sol[..., DV:]

    attn_in = jnp.einsum("bhnik,bhnjk->bhnij", q, k) * decay
    q_dec = q * jnp.exp(gc)[..., None]
    k_tail = k * jnp.exp(gc[..., -1:] - gc)[..., None]
    g_last = jnp.exp(gc[..., -1])

    def to_front(t):
        return jnp.moveaxis(t, 2, 0)

    xs = (to_front(w), to_front(u), to_front(q_dec), to_front(attn_in), to_front(k_tail), to_front(g_last))

    def step(S, inp):
        w_c, u_c, qd_c, a_c, kt_c, gl_c = inp
        v_new = u_c - jnp.einsum("bhck,bhkv->bhcv", w_c, S)
        o_c = jnp.einsum("bhck,bhkv->bhcv", qd_c, S) + jnp.einsum("bhij,bhjv->bhiv", a_c, v_new)
        S = S * gl_c[..., None, None] + jnp.einsum("bhck,bhcv->bhkv", kt_c, v_new)
        return S, o_c

    S0 = jnp.zeros((B, H, DK, DV), dtype=q.dtype)
    _, o = lax.scan(step, S0, xs)
    return o.transpose(1, 0, 3, 2, 4).reshape(B, T, H, DV)


def sliding_window_attention(q, k, v, sinks):
    B, T, Hq, D = q.shape
    Hkv = k.shape[2]
    G = Hq // Hkv
    BLK = SWA_BLOCK
    NB = T // BLK
    qb = q.reshape(B, NB, BLK, Hkv, G, D)

    def band(t):
        cur = t.reshape(B, NB, BLK, Hkv, D)
        prev = jnp.pad(t, ((0, 0), (BLK, 0), (0, 0), (0, 0)))[:, :T].reshape(B, NB, BLK, Hkv, D)
        return jnp.concatenate([prev, cur], axis=2)

    kb, vb = band(k), band(v)
    s = jnp.einsum("bnqhgd,bnkhd->bnhgqk", qb, kb).astype(jnp.float32) * (D ** -0.5)
    dist = (jnp.arange(BLK)[:, None] + BLK) - jnp.arange(2 * BLK)[None, :]
    key_global = (jnp.arange(NB) * BLK - BLK)[:, None] + jnp.arange(2 * BLK)[None, :]
    valid = ((dist >= 0) & (dist < SWA_WINDOW))[None] & (key_global >= 0)[:, None, :]
    slopes = (2.0 ** (-8.0 * (jnp.arange(Hq, dtype=jnp.float32) + 1.0) / Hq)).reshape(Hkv, G)
    s = s - slopes[:, :, None, None] * dist.astype(jnp.float32)
    s = jnp.where(valid[None, :, None, None], s, -jnp.inf)
    sink = sinks.astype(jnp.float32).reshape(Hkv, G)[:, :, None, None]
    m = jnp.maximum(jnp.max(s, axis=-1, keepdims=True), sink)
    p = jnp.exp(s - m)
    denom = jnp.sum(p, axis=-1, keepdims=True) + jnp.exp(sink - m)
    p = (p / denom).astype(v.dtype)
    o = jnp.einsum("bnhgqk,bnkhd->bnqhgd", p, vb)
    return o.reshape(B, T, Hq * D)


def hybrid_token_mixer(x, w_in, conv_w, a_log, dt_bias, dn_norm_g, sinks, w_out):
    B, T, _ = x.shape
    proj = x @ w_in
    split_idx = list(np.cumsum(np.array(IN_SIZES))[:-1])
    dn_q, dn_k, dn_v, sq, sk, sv, z, b_logit, a_logit = jnp.split(proj, split_idx, axis=-1)

    qkv = jax.nn.silu(causal_depthwise_conv(jnp.concatenate([dn_q, dn_k, dn_v], axis=-1), conv_w))
    qkv = qkv.astype(jnp.float32)
    q, k, v = jnp.split(qkv, 3, axis=-1)
    q = l2_normalize(q.reshape(B, T, DN_HEADS, DN_HEAD_DIM))
    k = l2_normalize(k.reshape(B, T, DN_HEADS, DN_HEAD_DIM))
    v = v.reshape(B, T, DN_HEADS, DN_HEAD_DIM)
    beta = jax.nn.sigmoid(b_logit.astype(jnp.float32))
    g = -jnp.exp(a_log.astype(jnp.float32)) * jax.nn.softplus(a_logit.astype(jnp.float32) + dt_bias.astype(jnp.float32))
    o = gated_delta_rule(q, k, v, g, beta)
    o = o * lax.rsqrt(jnp.mean(jnp.square(o), axis=-1, keepdims=True) + RMS_EPS) * dn_norm_g.astype(jnp.float32)
    o = o * jax.nn.silu(z.astype(jnp.float32).reshape(B, T, DN_HEADS, DN_HEAD_DIM))
    dn_out = o.reshape(B, T, DN_WIDTH).astype(x.dtype)

    swa_out = sliding_window_attention(
        sq.reshape(B, T, SWA_Q_HEADS, SWA_HEAD_DIM),
        sk.reshape(B, T, SWA_KV_HEADS, SWA_HEAD_DIM),
        sv.reshape(B, T, SWA_KV_HEADS, SWA_HEAD_DIM), sinks)

    mixed = jnp.concatenate([dn_out, swa_out.astype(x.dtype)], axis=-1)
    return mixed @ w_out


def moe_ffn(x, router_w, router_bias, w_gate, w_up, w_down, shared_w_gate, shared_w_up, shared_w_down):
    B, T, D = x.shape
    N = B * T
    xf = x.reshape(N, D)
    scores = jax.nn.sigmoid((xf @ router_w).astype(jnp.float32))
    sel = scores + router_bias.astype(jnp.float32)
    grp_score = lax.top_k(sel.reshape(N, N_GROUPS, N_EXPERTS // N_GROUPS), 2)[0].sum(-1)
    _, gidx = lax.top_k(grp_score, TOPK_GROUPS)
    gmask = jnp.any(gidx[..., None] == jnp.arange(N_GROUPS)[None, None, :], axis=1)
    emask = jnp.repeat(gmask, N_EXPERTS // N_GROUPS, axis=-1)
    _, eidx = lax.top_k(jnp.where(emask, sel, -jnp.inf), TOP_K)
    gate = jnp.take_along_axis(scores, eidx, axis=-1)
    gate = gate / jnp.sum(gate, axis=-1, keepdims=True) * ROUTED_SCALE

    NA = N * TOP_K
    flat_e = eidx.reshape(-1)
    order = jnp.argsort(flat_e)
    sorted_e = flat_e[order]
    tok = (order // TOP_K).astype(jnp.int32)
    sizes = jnp.bincount(flat_e, length=N_EXPERTS).astype(jnp.int32)
    start = jnp.cumsum(sizes) - sizes
    padded = (sizes + MOE_BLOCK - 1) // MOE_BLOCK * MOE_BLOCK
    pend = jnp.cumsum(padded)
    pstart = pend - padded
    dest = pstart[sorted_e] + (jnp.arange(NA, dtype=jnp.int32) - start[sorted_e])
    n_blocks = -(-NA // MOE_BLOCK) + N_EXPERTS
    rows = n_blocks * MOE_BLOCK
    row_tok = jnp.full((rows,), N, jnp.int32).at[dest].set(tok)
    row_gate = jnp.zeros((rows,), jnp.float32).at[dest].set(gate.reshape(-1)[order])
    blk_e = jnp.clip(jnp.searchsorted(pend, jnp.arange(n_blocks, dtype=jnp.int32) * MOE_BLOCK, side="right"),
                     0, N_EXPERTS - 1)
    xpad = jnp.concatenate([xf, jnp.zeros((1, D), xf.dtype)], axis=0)
    xb = xpad[row_tok].reshape(n_blocks, MOE_BLOCK, D)

    def expert_block(args):
        xblk, e = args
        h = jax.nn.silu(xblk @ w_gate[e]) * (xblk @ w_up[e])
        return h @ w_down[e]

    y = lax.map(expert_block, (xb, blk_e)).reshape(rows, D) * row_gate[:, None].astype(xf.dtype)
    routed = jax.ops.segment_sum(y, row_tok, num_segments=N + 1)[:N]
    shared = (jax.nn.silu(xf @ shared_w_gate) * (xf @ shared_w_up)) @ shared_w_down
    return (routed + shared).reshape(B, T, D)


def setup_inputs(seed: int = 0) -> dict:
    key = jax.random.key(seed)
    ks = jax.random.split(key, 24)

    def nrm(k, shape, scale):
        return jax.random.normal(k, shape, jnp.float32) * scale

    x = nrm(ks[0], (BATCH, SEQ, D_MODEL), 1.0)
    col_scale = np.ones((IN_COLS,), np.float32)
    offs = np.concatenate([[0], np.cumsum(np.array(IN_SIZES))])
    for idx in (2, 5):
        col_scale[offs[idx]:offs[idx + 1]] = DEEPNORM_BETA
    w_in = nrm(ks[1], (DEPTH, D_MODEL, IN_COLS), D_MODEL ** -0.5) * jnp.asarray(col_scale)
    conv_w = nrm(ks[2], (DEPTH, CONV_WIDTH, 3 * DN_WIDTH), CONV_WIDTH ** -0.5)
    a_log = jnp.log(jax.random.uniform(ks[3], (DEPTH, DN_HEADS), jnp.float32, 1.0, 16.0))
    dt = jnp.exp(jax.random.uniform(ks[4], (DEPTH, DN_HEADS), jnp.float32, math.log(1e-3), math.log(1e-1)))
    dt_bias = dt + jnp.log(-jnp.expm1(-dt))
    dn_norm_g = 1.0 + nrm(ks[5], (DEPTH, DN_HEAD_DIM), 0.02)
    sinks = nrm(ks[6], (DEPTH, SWA_Q_HEADS), 0.5)
    w_out = nrm(ks[7], (DEPTH, MIX_WIDTH, D_MODEL), MIX_WIDTH ** -0.5 * DEEPNORM_BETA)
    ln1_g = 1.0 + nrm(ks[8], (DEPTH, D_MODEL), 0.02)
    ln1_b = nrm(ks[9], (DEPTH, D_MODEL), 0.02)
    router_w = nrm(ks[10], (DEPTH, D_MODEL, N_EXPERTS), D_MODEL ** -0.5)
    router_bias = nrm(ks[11], (DEPTH, N_EXPERTS), 0.01)
    w_gate = nrm(ks[12], (DEPTH, N_EXPERTS, D_MODEL, EXPERT_FF), D_MODEL ** -0.5)
    w_up = nrm(ks[13], (DEPTH, N_EXPERTS, D_MODEL, EXPERT_FF), D_MODEL ** -0.5 * DEEPNORM_BETA)
    w_down = nrm(ks[14], (DEPTH, N_EXPERTS, EXPERT_FF, D_MODEL), EXPERT_FF ** -0.5 * DEEPNORM_BETA)
    shared_w_gate = nrm(ks[15], (DEPTH, D_MODEL, SHARED_FF), D_MODEL ** -0.5)
    shared_w_up = nrm(ks[16], (DEPTH, D_MODEL, SHARED_FF), D_MODEL ** -0.5 * DEEPNORM_BETA)
    shared_w_down = nrm(ks[17], (DEPTH, SHARED_FF, D_MODEL), SHARED_FF ** -0.5 * DEEPNORM_BETA)
    ln2_g = 1.0 + nrm(ks[18], (DEPTH, D_MODEL), 0.02)
    ln2_b = nrm(ks[19], (DEPTH, D_MODEL), 0.02)
    return {"x": x, "w_in": w_in, "conv_w": conv_w, "a_log": a_log, "dt_bias": dt_bias,
            "dn_norm_g": dn_norm_g, "sinks": sinks, "w_out": w_out, "ln1_g": ln1_g, "ln1_b": ln1_b,
            "router_w": router_w, "router_bias": router_bias, "w_gate": w_gate, "w_up": w_up,
            "w_down": w_down, "shared_w_gate": shared_w_gate, "shared_w_up": shared_w_up,
            "shared_w_down": shared_w_down, "ln2_g": ln2_g, "ln2_b": ln2_b}


def reference(x, w_in, conv_w, a_log, dt_bias, dn_norm_g, sinks, w_out, ln1_g, ln1_b,
              router_w, router_bias, w_gate, w_up, w_down, shared_w_gate, shared_w_up,
              shared_w_down, ln2_g, ln2_b):
    for l in range(DEPTH):
        mix = hybrid_token_mixer(x, w_in[l], conv_w[l], a_log[l], dt_bias[l], dn_norm_g[l], sinks[l], w_out[l])
        x = layer_norm(DEEPNORM_ALPHA * x + mix, ln1_g[l], ln1_b[l])
        ffn = moe_ffn(x, router_w[l], router_bias[l], w_gate[l], w_up[l], w_down[l],
                      shared_w_gate[l], shared_w_up[l], shared_w_down[l])
        x = layer_norm(DEEPNORM_ALPHA * x + ffn, ln2_g[l], ln2_b[l])
    return x
```

```cpp
#include <hip/hip_runtime.h>
#include <stdint.h>

typedef __attribute__((ext_vector_type(8))) short bf16x8;
typedef __attribute__((ext_vector_type(4))) float f32x4;
typedef unsigned short bf16_t;

constexpr int NTOK = 32768, SEQ = 4096, DM = 1024;
constexpr int INC = 2824, PROJW = 2816;
constexpr int OFF_DQ = 0, OFF_DK = 512, OFF_DV = 1024, OFF_SQ = 1536, OFF_SK = 2048, OFF_SV = 2176, OFF_Z = 2304;
constexpr int NEXP = 256, TOPK = 8, EFF = 256;
constexpr int NA = NTOK * TOPK;
constexpr int CAP = NTOK;
constexpr float ALPHA = 1.189207115002721f;
constexpr float LN_EPS = 1e-5f, RMS_EPS = 1e-6f, L2_EPS = 1e-6f;

constexpr size_t MiB = 1024ull * 1024ull;
constexpr size_t WS_X1BF = 0;
constexpr size_t WS_LOGIT = 64 * MiB;
constexpr size_t WS_LIST = 96 * MiB;
constexpr size_t WS_GATES = 128 * MiB;
constexpr size_t WS_CTRL = 129 * MiB;
constexpr size_t WS_MIXED = 130 * MiB;
constexpr size_t WS_PROJ = 200 * MiB;
constexpr size_t WS_BA = 376 * MiB;
constexpr size_t WS_QN = 377 * MiB;
constexpr size_t WS_KN = 409 * MiB;
constexpr size_t WS_VV = 441 * MiB;
constexpr size_t WS_BETA = 473 * MiB;
constexpr size_t WS_G = WS_BETA + 512 * 1024;
constexpr size_t WS_O = 474 * MiB;
constexpr size_t WS_HBUF = 200 * MiB;
constexpr size_t WS_YBUF = 344 * MiB;

__device__ __forceinline__ unsigned f2bf(float f) {
  unsigned u = __float_as_uint(f);
  u += 0x7fffu + ((u >> 16) & 1u);
  return u >> 16;
}
__device__ __forceinline__ unsigned pack2(float lo, float hi) { return f2bf(lo) | (f2bf(hi) << 16); }
__device__ __forceinline__ float bf2f(unsigned h) { return __uint_as_float(h << 16); }
__device__ __forceinline__ float bflo(unsigned w) { return __uint_as_float(w << 16); }
__device__ __forceinline__ float bfhi(unsigned w) { return __uint_as_float(w & 0xffff0000u); }
__device__ __forceinline__ float siluf(float x) { return x / (1.f + __expf(-x)); }
__device__ __forceinline__ float sigmoidf(float x) { return 1.f / (1.f + __expf(-x)); }
__device__ __forceinline__ float wave_sum(float v) {
#pragma unroll
  for (int o = 32; o > 0; o >>= 1) v += __shfl_xor(v, o);
  return v;
}

struct LdRowF32 {
  const char* p[8]; float4 r[8]; int row0, ch4;
  template <class F> __device__ __forceinline__ void init(F rowptr) {
    const int tid = threadIdx.x; ch4 = tid & 15; row0 = tid >> 4;
#pragma unroll
    for (int i = 0; i < 8; ++i) p[i] = (const char*)rowptr(row0 + i * 16) + ch4 * 16;
  }
  __device__ __forceinline__ void load(int kt) {
#pragma unroll
    for (int i = 0; i < 8; ++i) r[i] = *(const float4*)(p[i] + (size_t)kt * 256);
  }
  __device__ __forceinline__ void store(unsigned char* s) {
#pragma unroll
    for (int i = 0; i < 8; ++i) {
      const int row = row0 + i * 16;
      uint2 w; w.x = pack2(r[i].x, r[i].y); w.y = pack2(r[i].z, r[i].w);
      *(uint2*)(s + row * 128 + ((((ch4 >> 1) ^ (row & 7))) << 4) + (ch4 & 1) * 8) = w;
    }
  }
};
struct LdRowBF16 {
  const char* p[4]; uint4 r[4]; int row0, ch;
  template <class F> __device__ __forceinline__ void init(F rowptr) {
    const int tid = threadIdx.x; ch = tid & 7; row0 = tid >> 3;
#pragma unroll
    for (int i = 0; i < 4; ++i) p[i] = (const char*)rowptr(row0 + i * 32) + ch * 16;
  }
  __device__ __forceinline__ void load(int kt) {
#pragma unroll
    for (int i = 0; i < 4; ++i) r[i] = *(const uint4*)(p[i] + (size_t)kt * 128);
  }
  __device__ __forceinline__ void store(unsigned char* s) {
#pragma unroll
    for (int i = 0; i < 4; ++i) {
      const int row = row0 + i * 32;
      *(uint4*)(s + row * 128 + ((ch ^ (row & 7)) << 4)) = r[i];
    }
  }
};
struct LdColF32 {
  const char* p; size_t ldb; float4 r[8]; int n4, kg; bool valid;
  __device__ __forceinline__ void init(const float* colptr, size_t ld, bool v) {
    const int tid = threadIdx.x; n4 = tid & 31; kg = tid >> 5; ldb = ld * 4; valid = v;
    p = (const char*)colptr + (size_t)(kg * 8) * ldb;
  }
  __device__ __forceinline__ void load(int kt) {
#pragma unroll
    for (int j = 0; j < 8; ++j) {
      if (valid) r[j] = *(const float4*)(p + (size_t)(kt * 64 + j) * ldb);
      else r[j] = make_float4(0.f, 0.f, 0.f, 0.f);
    }
  }
  __device__ __forceinline__ void store(unsigned char* s) {
    {
      const int row = n4 * 4 + 0; uint4 w;
      w.x = pack2(r[0].x, r[1].x); w.y = pack2(r[2].x, r[3].x); w.z = pack2(r[4].x, r[5].x); w.w = pack2(r[6].x, r[7].x);
      *(uint4*)(s + row * 128 + ((kg ^ (row & 7)) << 4)) = w;
    }
    {
      const int row = n4 * 4 + 1; uint4 w;
      w.x = pack2(r[0].y, r[1].y); w.y = pack2(r[2].y, r[3].y); w.z = pack2(r[4].y, r[5].y); w.w = pack2(r[6].y, r[7].y);
      *(uint4*)(s + row * 128 + ((kg ^ (row & 7)) << 4)) = w;
    }
    {
      const int row = n4 * 4 + 2; uint4 w;
      w.x = pack2(r[0].z, r[1].z); w.y = pack2(r[2].z, r[3].z); w.z = pack2(r[4].z, r[5].z); w.w = pack2(r[6].z, r[7].z);
      *(uint4*)(s + row * 128 + ((kg ^ (row & 7)) << 4)) = w;
    }
    {
      const int row = n4 * 4 + 3; uint4 w;
      w.x = pack2(r[0].w, r[1].w); w.y = pack2(r[2].w, r[3].w); w.z = pack2(r[4].w, r[5].w); w.w = pack2(r[6].w, r[7].w);
      *(uint4*)(s + row * 128 + ((kg ^ (row & 7)) << 4)) = w;
    }
  }
};

template <class AL, class BL>
__device__ __forceinline__ void gemm128(unsigned char* smem, AL& al, BL& bl, int nk, f32x4 (&acc)[4][4]) {
  const int tid = threadIdx.x, lane = tid & 63, wid = tid >> 6, wr = wid >> 1, wc = wid & 1, fr = lane & 15, fq = lane >> 4;
  unsigned char* sA = smem; unsigned char* sB = smem + 16384;
#pragma unroll
  for (int m = 0; m < 4; ++m)
#pragma unroll
    for (int n = 0; n < 4; ++n) acc[m][n] = (f32x4){0.f, 0.f, 0.f, 0.f};
  al.load(0); bl.load(0);
  for (int kt = 0; kt < nk; ++kt) {
    __syncthreads();
    al.store(sA); bl.store(sB);
    __syncthreads();
    if (kt + 1 < nk) { al.load(kt + 1); bl.load(kt + 1); }
#pragma unroll
    for (int ks = 0; ks < 2; ++ks) {
      bf16x8 a[4], b[4];
#pragma unroll
      for (int m = 0; m < 4; ++m) {
        const int row = wr * 64 + m * 16 + fr;
        a[m] = *(const bf16x8*)(sA + row * 128 + (((ks * 4 + fq) ^ (row & 7)) << 4));
      }
#pragma unroll
      for (int n = 0; n < 4; ++n) {
        const int row = wc * 64 + n * 16 + fr;
        b[n] = *(const bf16x8*)(sB + row * 128 + (((ks * 4 + fq) ^ (row & 7)) << 4));
      }
#pragma unroll
      for (int m = 0; m < 4; ++m)
#pragma unroll
        for (int n = 0; n < 4; ++n) acc[m][n] = __builtin_amdgcn_mfma_f32_16x16x32_bf16(a[m], b[n], acc[m][n], 0, 0, 0);
    }
  }
  __syncthreads();
}

#define GEMM_IDS const int tid = threadIdx.x, lane = tid & 63, wid = tid >> 6, wr = wid >> 1, wc = wid & 1, fr = lane & 15, fq = lane >> 4; (void)tid; (void)lane;

__global__ void __launch_bounds__(256) k_proj(const float* __restrict__ x, const float* __restrict__ w_in, bf16_t* __restrict__ proj, float* __restrict__ ba) {
  __shared__ __attribute__((aligned(16))) unsigned char smem[32768];
  GEMM_IDS
  const int n0 = blockIdx.x * 128, m0 = blockIdx.y * 128;
  LdRowF32 al; al.init([&](int r) { return x + (size_t)(m0 + r) * DM; });
  LdColF32 bl; { const int col = n0 + 4 * (tid & 31); const bool v = col < INC; bl.init(w_in + (v ? col : 0), INC, v); }
  f32x4 acc[4][4];
  gemm128(smem, al, bl, DM / 64, acc);
#pragma unroll
  for (int m = 0; m < 4; ++m)
#pragma unroll
    for (int n = 0; n < 4; ++n)
#pragma unroll
      for (int j = 0; j < 4; ++j) {
        const int row = m0 + wr * 64 + m * 16 + fq * 4 + j, col = n0 + wc * 64 + n * 16 + fr;
        if (col < PROJW) proj[(size_t)row * PROJW + col] = (bf16_t)f2bf(acc[m][n][j]);
        else if (col < INC) ba[(size_t)row * 8 + (col - PROJW)] = acc[m][n][j];
      }
}

__global__ void __launch_bounds__(256) k_dnprep(const bf16_t* __restrict__ proj, const float* __restrict__ ba, const float* __restrict__ conv_w,
                                                const float* __restrict__ a_log, const float* __restrict__ dt_bias,
                                                bf16_t* __restrict__ qn, bf16_t* __restrict__ kn, bf16_t* __restrict__ vv, float* __restrict__ beta, float* __restrict__ g) {
  __shared__ float red[6][4];
  const int n = blockIdx.x, t = n % SEQ, tid = threadIdx.x, lane = tid & 63, wid = tid >> 6;
  float y[6];
#pragma unroll
  for (int i = 0; i < 6; ++i) {
    const int c = tid + i * 256;
    float s = 0.f;
#pragma unroll
    for (int j = 0; j < 4; ++j) {
      const int tt = t - 3 + j;
      if (tt >= 0) s += conv_w[j * 1536 + c] * bf2f(proj[(size_t)(n - 3 + j) * PROJW + c]);
    }
    y[i] = siluf(s);
    const float ss = wave_sum(y[i] * y[i]);
    if (lane == 0) red[i][wid] = ss;
  }
  __syncthreads();
#pragma unroll
  for (int i = 0; i < 6; ++i) {
    const int c = tid + i * 256;
    const float ss = red[i][wid & 2] + red[i][(wid & 2) + 1];
    const float rn = rsqrtf(ss + L2_EPS);
    if (i < 2) qn[(size_t)n * 512 + c] = (bf16_t)f2bf(y[i] * rn);
    else if (i < 4) kn[(size_t)n * 512 + (c - 512)] = (bf16_t)f2bf(y[i] * rn);
    else vv[(size_t)n * 512 + (c - 1024)] = (bf16_t)f2bf(y[i]);
  }
  if (tid < 4) {
    beta[(size_t)n * 4 + tid] = sigmoidf(ba[(size_t)n * 8 + tid]);
    const float xx = ba[(size_t)n * 8 + 4 + tid] + dt_bias[tid];
    const float sp = fmaxf(xx, 0.f) + log1pf(__expf(-fabsf(xx)));
    g[(size_t)n * 4 + tid] = -__expf(a_log[tid]) * sp;
  }
}

__global__ void __launch_bounds__(128) k_dn_naive(const bf16_t* __restrict__ qn, const bf16_t* __restrict__ kn, const bf16_t* __restrict__ vv,
                                                  const float* __restrict__ beta, const float* __restrict__ g, float* __restrict__ o) {
  __shared__ float sq[16][128];
  __shared__ float sk[16][128];
  const int b = blockIdx.x >> 2, h = blockIdx.x & 3, v = threadIdx.x;
  float S[128];
#pragma unroll
  for (int i = 0; i < 128; ++i) S[i] = 0.f;
  const float scale = 0.08838834764831845f;
  for (int t0 = 0; t0 < SEQ; t0 += 16) {
    __syncthreads();
    for (int e = threadIdx.x; e < 16 * 128; e += 128) {
      const int tt = e >> 7, d = e & 127;
      const size_t n = (size_t)b * SEQ + t0 + tt;
      sq[tt][d] = bf2f(qn[n * 512 + h * 128 + d]);
      sk[tt][d] = bf2f(kn[n * 512 + h * 128 + d]);
    }
    __syncthreads();
    for (int tt = 0; tt < 16; ++tt) {
      const size_t n = (size_t)b * SEQ + t0 + tt;
      const float vt = bf2f(vv[n * 512 + h * 128 + v]);
      const float bt = beta[n * 4 + h];
      const float a = __expf(g[n * 4 + h]);
      float dot = 0.f;
#pragma unroll
      for (int i = 0; i < 128; ++i) dot += sk[tt][i] * S[i];
      const float c = bt * (vt - a * dot);
      float oo = 0.f;
#pragma unroll
      for (int i = 0; i < 128; ++i) { S[i] = a * S[i] + sk[tt][i] * c; oo += sq[tt][i] * S[i]; }
      o[n * 512 + h * 128 + v] = oo * scale;
    }
  }
}

__global__ void __launch_bounds__(256) k_dn_post(const float* __restrict__ o, const bf16_t* __restrict__ proj, const float* __restrict__ dn_norm_g, bf16_t* __restrict__ mixed) {
  const int n = blockIdx.x, tid = threadIdx.x, h = tid >> 6, lane = tid & 63;
  const float o0 = o[(size_t)n * 512 + h * 128 + lane], o1 = o[(size_t)n * 512 + h * 128 + 64 + lane];
  const float ss = wave_sum(o0 * o0 + o1 * o1);
  const float rn = rsqrtf(ss * (1.f / 128.f) + RMS_EPS);
  const float z0 = bf2f(proj[(size_t)n * PROJW + OFF_Z + h * 128 + lane]), z1 = bf2f(proj[(size_t)n * PROJW + OFF_Z + h * 128 + 64 + lane]);
  mixed[(size_t)n * DM + h * 128 + lane] = (bf16_t)f2bf(o0 * rn * dn_norm_g[lane] * siluf(z0));
  mixed[(size_t)n * DM + h * 128 + 64 + lane] = (bf16_t)f2bf(o1 * rn * dn_norm_g[64 + lane] * siluf(z1));
}

__global__ void __launch_bounds__(256) k_swa_naive(const bf16_t* __restrict__ proj, const float* __restrict__ sinks, bf16_t* __restrict__ mixed) {
  const int gid = blockIdx.x * 256 + threadIdx.x;
  const int h = gid / NTOK, n = gid % NTOK, t = n % SEQ, kvh = h >> 2;
  float q[64], acc[64];
  {
    const uint4* qp = (const uint4*)(proj + (size_t)n * PROJW + OFF_SQ + h * 64);
#pragma unroll
    for (int c = 0; c < 8; ++c) {
      const uint4 w = qp[c];
      q[c * 8 + 0] = bflo(w.x); q[c * 8 + 1] = bfhi(w.x); q[c * 8 + 2] = bflo(w.y); q[c * 8 + 3] = bfhi(w.y);
      q[c * 8 + 4] = bflo(w.z); q[c * 8 + 5] = bfhi(w.z); q[c * 8 + 6] = bflo(w.w); q[c * 8 + 7] = bfhi(w.w);
    }
  }
#pragma unroll
  for (int d = 0; d < 64; ++d) acc[d] = 0.f;
  const float slope = exp2f(-(float)(h + 1));
  float mrun = sinks[h], l = 1.f;
  const int s0 = (t - 127 > 0) ? (t - 127) : 0;
  for (int s = s0; s <= t; ++s) {
    const size_t nk = (size_t)(n - (t - s));
    const uint4* kp = (const uint4*)(proj + nk * PROJW + OFF_SK + kvh * 64);
    float dot = 0.f;
#pragma unroll
    for (int c = 0; c < 8; ++c) {
      const uint4 w = kp[c];
      dot += q[c * 8 + 0] * bflo(w.x) + q[c * 8 + 1] * bfhi(w.x) + q[c * 8 + 2] * bflo(w.y) + q[c * 8 + 3] * bfhi(w.y)
           + q[c * 8 + 4] * bflo(w.z) + q[c * 8 + 5] * bfhi(w.z) + q[c * 8 + 6] * bflo(w.w) + q[c * 8 + 7] * bfhi(w.w);
    }
    const float sc = dot * 0.125f - slope * (float)(t - s);
    const float mn = fmaxf(mrun, sc);
    const float corr = __expf(mrun - mn), p = __expf(sc - mn);
    l = l * corr + p;
    const uint4* vp = (const uint4*)(proj + nk * PROJW + OFF_SV + kvh * 64);
#pragma unroll
    for (int c = 0; c < 8; ++c) {
      const uint4 w = vp[c];
      acc[c * 8 + 0] = acc[c * 8 + 0] * corr + p * bflo(w.x); acc[c * 8 + 1] = acc[c * 8 + 1] * corr + p * bfhi(w.x);
      acc[c * 8 + 2] = acc[c * 8 + 2] * corr + p * bflo(w.y); acc[c * 8 + 3] = acc[c * 8 + 3] * corr + p * bfhi(w.y);
      acc[c * 8 + 4] = acc[c * 8 + 4] * corr + p * bflo(w.z); acc[c * 8 + 5] = acc[c * 8 + 5] * corr + p * bfhi(w.z);
      acc[c * 8 + 6] = acc[c * 8 + 6] * corr + p * bflo(w.w); acc[c * 8 + 7] = acc[c * 8 + 7] * corr + p * bfhi(w.w);
    }
    mrun = mn;
  }
  const float inv = 1.f / l;
  uint4* op = (uint4*)(mixed + (size_t)n * DM + 512 + h * 64);
#pragma unroll
  for (int c = 0; c < 8; ++c) {
    uint4 w;
    w.x = pack2(acc[c * 8 + 0] * inv, acc[c * 8 + 1] * inv); w.y = pack2(acc[c * 8 + 2] * inv, acc[c * 8 + 3] * inv);
    w.z = pack2(acc[c * 8 + 4] * inv, acc[c * 8 + 5] * inv); w.w = pack2(acc[c * 8 + 6] * inv, acc[c * 8 + 7] * inv);
    op[c] = w;
  }
}

__global__ void __launch_bounds__(256) k_wout(const bf16_t* __restrict__ mixed, const float* __restrict__ w_out, const float* __restrict__ x, float* __restrict__ y1) {
  __shared__ __attribute__((aligned(16))) unsigned char smem[32768];
  GEMM_IDS
  const int n0 = blockIdx.x * 128, m0 = blockIdx.y * 128;
  LdRowBF16 al; al.init([&](int r) { return mixed + (size_t)(m0 + r) * DM; });
  LdColF32 bl; bl.init(w_out + n0 + 4 * (tid & 31), DM, true);
  f32x4 acc[4][4];
  gemm128(smem, al, bl, DM / 64, acc);
#pragma unroll
  for (int m = 0; m < 4; ++m)
#pragma unroll
    for (int n = 0; n < 4; ++n)
#pragma unroll
      for (int j = 0; j < 4; ++j) {
        const size_t idx = (size_t)(m0 + wr * 64 + m * 16 + fq * 4 + j) * DM + n0 + wc * 64 + n * 16 + fr;
        y1[idx] = ALPHA * x[idx] + acc[m][n][j];
      }
}

__global__ void __launch_bounds__(256) k_ln1(float* __restrict__ y, const float* __restrict__ gam, const float* __restrict__ bet, bf16_t* __restrict__ xbf) {
  const int row = blockIdx.x * 4 + (threadIdx.x >> 6), lane = threadIdx.x & 63;
  float4* p = (float4*)(y + (size_t)row * DM);
  float4 v[4]; float s = 0.f;
#pragma unroll
  for (int i = 0; i < 4; ++i) { v[i] = p[lane + i * 64]; s += v[i].x + v[i].y + v[i].z + v[i].w; }
  const float mu = wave_sum(s) * (1.f / DM);
  float q = 0.f;
#pragma unroll
  for (int i = 0; i < 4; ++i) { const float a = v[i].x - mu, b = v[i].y - mu, c = v[i].z - mu, d = v[i].w - mu; q += a * a + b * b + c * c + d * d; }
  const float rs = rsqrtf(wave_sum(q) * (1.f / DM) + LN_EPS);
#pragma unroll
  for (int i = 0; i < 4; ++i) {
    const float4 gg = ((const float4*)gam)[lane + i * 64], bb = ((const float4*)bet)[lane + i * 64];
    float4 r;
    r.x = (v[i].x - mu) * rs * gg.x + bb.x; r.y = (v[i].y - mu) * rs * gg.y + bb.y;
    r.z = (v[i].z - mu) * rs * gg.z + bb.z; r.w = (v[i].w - mu) * rs * gg.w + bb.w;
    p[lane + i * 64] = r;
    uint2 w; w.x = pack2(r.x, r.y); w.y = pack2(r.z, r.w);
    ((uint2*)(xbf + (size_t)row * DM))[lane + i * 64] = w;
  }
}

__global__ void __launch_bounds__(256) k_router(const bf16_t* __restrict__ xbf, const float* __restrict__ router_w, float* __restrict__ logits) {
  __shared__ __attribute__((aligned(16))) unsigned char smem[32768];
  GEMM_IDS
  const int n0 = blockIdx.x * 128, m0 = blockIdx.y * 128;
  LdRowBF16 al; al.init([&](int r) { return xbf + (size_t)(m0 + r) * DM; });
  LdColF32 bl; bl.init(router_w + n0 + 4 * (tid & 31), NEXP, true);
  f32x4 acc[4][4];
  gemm128(smem, al, bl, DM / 64, acc);
#pragma unroll
  for (int m = 0; m < 4; ++m)
#pragma unroll
    for (int n = 0; n < 4; ++n)
#pragma unroll
      for (int j = 0; j < 4; ++j)
        logits[(size_t)(m0 + wr * 64 + m * 16 + fq * 4 + j) * NEXP + n0 + wc * 64 + n * 16 + fr] = acc[m][n][j];
}

__global__ void __launch_bounds__(256) k_route(const float* __restrict__ logits, const float* __restrict__ router_bias, int* __restrict__ cnt, int* __restrict__ list, float* __restrict__ gates) {
  const int n = blockIdx.x * 4 + (threadIdx.x >> 6), lane = threadIdx.x & 63;
  const float4 lg = ((const float4*)(logits + (size_t)n * NEXP))[lane];
  const float4 rb = ((const float4*)router_bias)[lane];
  float sc[4] = {sigmoidf(lg.x), sigmoidf(lg.y), sigmoidf(lg.z), sigmoidf(lg.w)};
  float sel[4] = {sc[0] + rb.x, sc[1] + rb.y, sc[2] + rb.z, sc[3] + rb.w};
  float t1 = fmaxf(sel[0], sel[1]), t2 = fminf(sel[0], sel[1]);
  { const float a = sel[2]; if (a > t1) { t2 = t1; t1 = a; } else if (a > t2) t2 = a; }
  { const float a = sel[3]; if (a > t1) { t2 = t1; t1 = a; } else if (a > t2) t2 = a; }
#pragma unroll
  for (int o = 1; o < 8; o <<= 1) {
    const float b1 = __shfl_xor(t1, o), b2 = __shfl_xor(t2, o);
    const float n1 = fmaxf(t1, b1), n2 = fmaxf(fminf(t1, b1), fmaxf(t2, b2));
    t1 = n1; t2 = n2;
  }
  const float gs = t1 + t2;
  const int mygrp = lane >> 3;
  int rank = 0;
#pragma unroll
  for (int j = 0; j < 8; ++j) {
    const float o = __shfl(gs, j * 8);
    rank += (o > gs || (o == gs && j < mygrp)) ? 1 : 0;
  }
  const bool gsel = rank < 4;
  float cand[4];
#pragma unroll
  for (int i = 0; i < 4; ++i) cand[i] = gsel ? sel[i] : -INFINITY;
  float gsum = 0.f; float myg = 0.f; int mye = 0;
#pragma unroll 1
  for (int r = 0; r < TOPK; ++r) {
    float bv = cand[0]; int bi = 0;
#pragma unroll
    for (int i = 1; i < 4; ++i) if (cand[i] > bv) { bv = cand[i]; bi = i; }
    int be = lane * 4 + bi;
    float bs = (bi == 0) ? sc[0] : (bi == 1) ? sc[1] : (bi == 2) ? sc[2] : sc[3];
#pragma unroll
    for (int o = 1; o < 64; o <<= 1) {
      const float ov = __shfl_xor(bv, o); const int oe = __shfl_xor(be, o); const float os = __shfl_xor(bs, o);
      if (ov > bv || (ov == bv && oe < be)) { bv = ov; be = oe; bs = os; }
    }
    if ((be >> 2) == lane) {
      const int bi2 = be & 3;
      if (bi2 == 0) cand[0] = -INFINITY; else if (bi2 == 1) cand[1] = -INFINITY; else if (bi2 == 2) cand[2] = -INFINITY; else cand[3] = -INFINITY;
    }
    gsum += bs;
    if (lane == r) { myg = bs; mye = be; }
  }
  if (lane < TOPK) {
    const int slot = atomicAdd(&cnt[mye], 1);
    list[(size_t)mye * CAP + slot] = n * TOPK + lane;
    gates[(size_t)n * TOPK + lane] = myg / gsum * 2.5f;
  }
}

__device__ __forceinline__ bool moe_find_tile(const int* __restrict__ cnt, int bx, int* sscan, int& e_out, int& rt_out, int& rows_out) {
  const int tid = threadIdx.x;
  const int c = cnt[tid];
  const int tiles = (c + 127) >> 7;
  sscan[tid] = tiles;
  __syncthreads();
  for (int o = 1; o < 256; o <<= 1) {
    const int v = (tid >= o) ? sscan[tid - o] : 0;
    __syncthreads();
    sscan[tid] += v;
    __syncthreads();
  }
  const int incl = sscan[tid], excl = incl - tiles;
  if (bx >= excl && bx < incl) { sscan[256] = tid; sscan[257] = bx - excl; sscan[258] = c; }
  const int total = sscan[255];
  if (tid == 0 && bx >= total) {
    const int s = bx - total;
    if (s < NTOK / 128) { sscan[256] = 256; sscan[257] = s; sscan[258] = NTOK; } else { sscan[256] = -1; }
  }
  __syncthreads();
  e_out = sscan[256]; rt_out = sscan[257]; rows_out = sscan[258];
  return e_out >= 0;
}

__global__ void __launch_bounds__(256) k_moe1(const bf16_t* __restrict__ xbf, const int* __restrict__ cnt, const int* __restrict__ list,
                                              const float* __restrict__ w_gate, const float* __restrict__ w_up,
                                              const float* __restrict__ sw_gate, const float* __restrict__ sw_up, bf16_t* __restrict__ hbuf) {
  __shared__ __attribute__((aligned(16))) unsigned char smem[32768];
  __shared__ int sscan[260];
  __shared__ int sasg[128];
  GEMM_IDS
  int e, rt, rows;
  if (!moe_find_tile(cnt, blockIdx.x, sscan, e, rt, rows)) return;
  const int ct = blockIdx.y;
  if (tid < 128) {
    const int r = rt * 128 + tid;
    int a = -1;
    if (r < rows) a = (e < 256) ? list[(size_t)e * CAP + r] : (NA + r);
    sasg[tid] = a;
  }
  __syncthreads();
  LdRowBF16 al; al.init([&](int r) { const int a = sasg[r]; const int tok = (a < 0) ? 0 : (a < NA ? (a >> 3) : (a - NA)); return xbf + (size_t)tok * DM; });
  LdColF32 bl;
  {
    const int jj = 4 * (tid & 31);
    const int bwc = jj >> 6, bn = (jj >> 4) & 3;
    const int ff = ct * 64 + bwc * 32 + (bn >> 1) * 16 + (jj & 15);
    const float* W = (e < 256) ? ((bn & 1) ? w_up : w_gate) + (size_t)e * DM * EFF : ((bn & 1) ? sw_up : sw_gate);
    bl.init(W + ff, EFF, true);
  }
  f32x4 acc[4][4];
  gemm128(smem, al, bl, DM / 64, acc);
#pragma unroll
  for (int m = 0; m < 4; ++m)
#pragma unroll
    for (int pp = 0; pp < 2; ++pp)
#pragma unroll
      for (int j = 0; j < 4; ++j) {
        const int r = wr * 64 + m * 16 + fq * 4 + j;
        const int a = sasg[r];
        if (a >= 0) {
          const float gv = acc[m][2 * pp][j], uv = acc[m][2 * pp + 1][j];
          hbuf[(size_t)a * EFF + ct * 64 + wc * 32 + pp * 16 + fr] = (bf16_t)f2bf(siluf(gv) * uv);
        }
      }
}

__global__ void __launch_bounds__(256) k_moe2(const bf16_t* __restrict__ hbuf, const int* __restrict__ cnt, const int* __restrict__ list, const float* __restrict__ gates,
                                              const float* __restrict__ w_down, const float* __restrict__ sw_down, bf16_t* __restrict__ ybuf) {
  __shared__ __attribute__((aligned(16))) unsigned char smem[32768];
  __shared__ int sscan[260];
  __shared__ int sasg[128];
  __shared__ float sgate[128];
  GEMM_IDS
  int e, rt, rows;
  if (!moe_find_tile(cnt, blockIdx.x, sscan, e, rt, rows)) return;
  const int n0 = blockIdx.y * 128;
  if (tid < 128) {
    const int r = rt * 128 + tid;
    int a = -1;
    if (r < rows) a = (e < 256) ? list[(size_t)e * CAP + r] : (NA + r);
    sasg[tid] = a;
    sgate[tid] = (a >= 0 && a < NA) ? gates[a] : 1.f;
  }
  __syncthreads();
  LdRowBF16 al; al.init([&](int r) { const int a = sasg[r]; return hbuf + (size_t)(a < 0 ? 0 : a) * EFF; });
  LdColF32 bl; bl.init(((e < 256) ? w_down + (size_t)e * EFF * DM : sw_down) + n0 + 4 * (tid & 31), DM, true);
  f32x4 acc[4][4];
  gemm128(smem, al, bl, EFF / 64, acc);
#pragma unroll
  for (int m = 0; m < 4; ++m)
#pragma unroll
    for (int n = 0; n < 4; ++n)
#pragma unroll
      for (int j = 0; j < 4; ++j) {
        const int r = wr * 64 + m * 16 + fq * 4 + j;
        const int a = sasg[r];
        if (a >= 0) ybuf[(size_t)a * DM + n0 + wc * 64 + n * 16 + fr] = (bf16_t)f2bf(acc[m][n][j] * sgate[r]);
      }
}

__global__ void __launch_bounds__(256) k_final(float* __restrict__ out  , const bf16_t* __restrict__ ybuf, const float* __restrict__ gam, const float* __restrict__ bet) {
  const int row = blockIdx.x * 4 + (threadIdx.x >> 6), lane = threadIdx.x & 63;
  float4* p = (float4*)(out + (size_t)row * DM);
  float4 v[4]; float s = 0.f;
#pragma unroll
  for (int i = 0; i < 4; ++i) {
    float4 a = p[lane + i * 64];
    a.x *= ALPHA; a.y *= ALPHA; a.z *= ALPHA; a.w *= ALPHA;
#pragma unroll
    for (int k = 0; k < 9; ++k) {
      const size_t yr = (k < 8) ? ((size_t)row * 8 + k) : ((size_t)NA + row);
      const uint2 w = ((const uint2*)(ybuf + yr * DM))[lane + i * 64];
      a.x += bflo(w.x); a.y += bfhi(w.x); a.z += bflo(w.y); a.w += bfhi(w.y);
    }
    v[i] = a; s += a.x + a.y + a.z + a.w;
  }
  const float mu = wave_sum(s) * (1.f / DM);
  float q = 0.f;
#pragma unroll
  for (int i = 0; i < 4; ++i) { const float a = v[i].x - mu, b = v[i].y - mu, c = v[i].z - mu, d = v[i].w - mu; q += a * a + b * b + c * c + d * d; }
  const float rs = rsqrtf(wave_sum(q) * (1.f / DM) + LN_EPS);
#pragma unroll
  for (int i = 0; i < 4; ++i) {
    const float4 gg = ((const float4*)gam)[lane + i * 64], bb = ((const float4*)bet)[lane + i * 64];
    float4 r;
    r.x = (v[i].x - mu) * rs * gg.x + bb.x; r.y = (v[i].y - mu) * rs * gg.y + bb.y;
    r.z = (v[i].z - mu) * rs * gg.z + bb.z; r.w = (v[i].w - mu) * rs * gg.w + bb.w;
    p[lane + i * 64] = r;
  }
}

extern "C" void kernel_launch(void* const* d_in, const int* in_sizes, int n_in, void* d_out, int out_size, void* d_ws, size_t ws_size, hipStream_t stream) {
  const float* x = (const float*)d_in[0];
  const float* w_in = (const float*)d_in[1];
  const float* conv_w = (const float*)d_in[2];
  const float* a_log = (const float*)d_in[3];
  const float* dt_bias = (const float*)d_in[4];
  const float* dn_norm_g = (const float*)d_in[5];
  const float* sinks = (const float*)d_in[6];
  const float* w_out = (const float*)d_in[7];
  const float* ln1_g = (const float*)d_in[8];
  const float* ln1_b = (const float*)d_in[9];
  const float* router_w = (const float*)d_in[10];
  const float* router_bias = (const float*)d_in[11];
  const float* w_gate = (const float*)d_in[12];
  const float* w_up = (const float*)d_in[13];
  const float* w_down = (const float*)d_in[14];
  const float* sw_gate = (const float*)d_in[15];
  const float* sw_up = (const float*)d_in[16];
  const float* sw_down = (const float*)d_in[17];
  const float* ln2_g = (const float*)d_in[18];
  const float* ln2_b = (const float*)d_in[19];
  float* out = (float*)d_out;
  char* ws = (char*)d_ws;
  bf16_t* x1bf = (bf16_t*)(ws + WS_X1BF);
  float* logits = (float*)(ws + WS_LOGIT);
  int* list = (int*)(ws + WS_LIST);
  float* gates = (float*)(ws + WS_GATES);
  int* cnt = (int*)(ws + WS_CTRL);
  bf16_t* mixed = (bf16_t*)(ws + WS_MIXED);
  bf16_t* proj = (bf16_t*)(ws + WS_PROJ);
  float* ba = (float*)(ws + WS_BA);
  bf16_t* qn = (bf16_t*)(ws + WS_QN);
  bf16_t* kn = (bf16_t*)(ws + WS_KN);
  bf16_t* vv = (bf16_t*)(ws + WS_VV);
  float* beta = (float*)(ws + WS_BETA);
  float* g = (float*)(ws + WS_G);
  float* o = (float*)(ws + WS_O);
  bf16_t* hbuf = (bf16_t*)(ws + WS_HBUF);
  bf16_t* ybuf = (bf16_t*)(ws + WS_YBUF);

  hipMemsetAsync(cnt, 0, 1024, stream);
  k_proj<<<dim3(23, NTOK / 128), 256, 0, stream>>>(x, w_in, proj, ba);
  k_dnprep<<<NTOK, 256, 0, stream>>>(proj, ba, conv_w, a_log, dt_bias, qn, kn, vv, beta, g);
  k_dn_naive<<<32, 128, 0, stream>>>(qn, kn, vv, beta, g, o);
  k_dn_post<<<NTOK, 256, 0, stream>>>(o, proj, dn_norm_g, mixed);
  k_swa_naive<<<NTOK * 8 / 256, 256, 0, stream>>>(proj, sinks, mixed);
  k_wout<<<dim3(8, NTOK / 128), 256, 0, stream>>>(mixed, w_out, x, out);
  k_ln1<<<NTOK / 4, 256, 0, stream>>>(out, ln1_g, ln1_b, x1bf);
  k_router<<<dim3(2, NTOK / 128), 256, 0, stream>>>(x1bf, router_w, logits);
  k_route<<<NTOK / 4, 256, 0, stream>>>(logits, router_bias, cnt, list, gates);
  const int max_tiles = NA / 128 + NEXP + NTOK / 128;
  k_moe1<<<dim3(max_tiles, 4), 256, 0, stream>>>(x1bf, cnt, list, w_gate, w_up, sw_gate, sw_up, hbuf);
  k_moe2<<<dim3(max_tiles, 8), 256, 0, stream>>>(hbuf, cnt, list, gates, w_down, sw_down, ybuf);
  k_final<<<NTOK / 4, 256, 0, stream>>>(out, ybuf, ln2_g, ln2_b);
}
```

```cpp
#include <hip/hip_runtime.h>
#include <hip/hip_cooperative_groups.h>
#include <stdint.h>
#include <stdio.h>
namespace cg = cooperative_groups;

typedef __attribute__((ext_vector_type(8))) short bf16x8;
typedef __attribute__((ext_vector_type(4))) float f32x4;
typedef unsigned short bf16_t;

constexpr int NTOK = 32768, SEQ = 4096, DM = 1024;
constexpr int INC = 2824, PROJW = 2816;
constexpr int OFF_DQ = 0, OFF_DK = 512, OFF_DV = 1024, OFF_SQ = 1536, OFF_SK = 2048, OFF_SV = 2176, OFF_Z = 2304;
constexpr int NEXP = 256, TOPK = 8, EFF = 256;
constexpr int NA = NTOK * TOPK;
constexpr int CAP = NTOK;
constexpr float ALPHA = 1.189207115002721f;
constexpr float LN_EPS = 1e-5f, RMS_EPS = 1e-6f, L2_EPS = 1e-6f;

constexpr size_t MiB = 1024ull * 1024ull;
constexpr size_t WS_X1BF = 0;
constexpr size_t WS_LOGIT = 64 * MiB;
constexpr size_t WS_LIST = 96 * MiB;
constexpr size_t WS_GATES = 128 * MiB;
constexpr size_t WS_CTRL = 129 * MiB;
constexpr size_t WS_MIXED = 130 * MiB;
constexpr size_t WS_PROJ = 200 * MiB;
constexpr size_t WS_BA = 376 * MiB;
constexpr size_t WS_QN = 377 * MiB;
constexpr size_t WS_KN = 409 * MiB;
constexpr size_t WS_VV = 441 * MiB;
constexpr size_t WS_BETA = 473 * MiB;
constexpr size_t WS_G = WS_BETA + 512 * 1024;
constexpr size_t WS_O = 474 * MiB;
constexpr size_t WS_HBUF = 200 * MiB;
constexpr size_t WS_YBUF = 344 * MiB;

__device__ __forceinline__ unsigned f2bf(float f) {
  unsigned u = __float_as_uint(f);
  u += 0x7fffu + ((u >> 16) & 1u);
  return u >> 16;
}
__device__ __forceinline__ unsigned pack2(float lo, float hi) { return f2bf(lo) | (f2bf(hi) << 16); }
__device__ __forceinline__ float bf2f(unsigned h) { return __uint_as_float(h << 16); }
__device__ __forceinline__ float bflo(unsigned w) { return __uint_as_float(w << 16); }
__device__ __forceinline__ float bfhi(unsigned w) { return __uint_as_float(w & 0xffff0000u); }
__device__ __forceinline__ float siluf(float x) { return x / (1.f + __expf(-x)); }
__device__ __forceinline__ float sigmoidf(float x) { return 1.f / (1.f + __expf(-x)); }
__device__ __forceinline__ float wave_sum(float v) {
#pragma unroll
  for (int o = 32; o > 0; o >>= 1) v += __shfl_xor(v, o);
  return v;
}

struct LdRowF32 {
  const char* p[8]; float4 r[8]; int row0, ch4;
  template <class F> __device__ __forceinline__ void init(F rowptr) {
    const int tid = threadIdx.x; ch4 = tid & 15; row0 = tid >> 4;
#pragma unroll
    for (int i = 0; i < 8; ++i) p[i] = (const char*)rowptr(row0 + i * 16) + ch4 * 16;
  }
  __device__ __forceinline__ void load(int kt) {
#pragma unroll
    for (int i = 0; i < 8; ++i) r[i] = *(const float4*)(p[i] + (size_t)kt * 256);
  }
  __device__ __forceinline__ void store(unsigned char* s) {
#pragma unroll
    for (int i = 0; i < 8; ++i) {
      const int row = row0 + i * 16;
      uint2 w; w.x = pack2(r[i].x, r[i].y); w.y = pack2(r[i].z, r[i].w);
      *(uint2*)(s + row * 128 + ((((ch4 >> 1) ^ (row & 7))) << 4) + (ch4 & 1) * 8) = w;
    }
  }
};
struct LdRowBF16 {
  const char* p[4]; uint4 r[4]; int row0, ch;
  template <class F> __device__ __forceinline__ void init(F rowptr) {
    const int tid = threadIdx.x; ch = tid & 7; row0 = tid >> 3;
#pragma unroll
    for (int i = 0; i < 4; ++i) p[i] = (const char*)rowptr(row0 + i * 32) + ch * 16;
  }
  __device__ __forceinline__ void load(int kt) {
#pragma unroll
    for (int i = 0; i < 4; ++i) r[i] = *(const uint4*)(p[i] + (size_t)kt * 128);
  }
  __device__ __forceinline__ void store(unsigned char* s) {
#pragma unroll
    for (int i = 0; i < 4; ++i) {
      const int row = row0 + i * 32;
      *(uint4*)(s + row * 128 + ((ch ^ (row & 7)) << 4)) = r[i];
    }
  }
};
struct LdColF32 {
  const char* p; size_t ldb; float4 r[8]; int n4, kg; bool valid;
  __device__ __forceinline__ void init(const float* colptr, size_t ld, bool v) {
    const int tid = threadIdx.x; n4 = tid & 31; kg = tid >> 5; ldb = ld * 4; valid = v;
    p = (const char*)colptr + (size_t)(kg * 8) * ldb;
  }
  __device__ __forceinline__ void load(int kt) {
#pragma unroll
    for (int j = 0; j < 8; ++j) {
      if (valid) r[j] = *(const float4*)(p + (size_t)(kt * 64 + j) * ldb);
      else r[j] = make_float4(0.f, 0.f, 0.f, 0.f);
    }
  }
  __device__ __forceinline__ void store(unsigned char* s) {
    {
      const int row = n4 * 4 + 0; uint4 w;
      w.x = pack2(r[0].x, r[1].x); w.y = pack2(r[2].x, r[3].x); w.z = pack2(r[4].x, r[5].x); w.w = pack2(r[6].x, r[7].x);
      *(uint4*)(s + row * 128 + ((kg ^ (row & 7)) << 4)) = w;
    }
    {
      const int row = n4 * 4 + 1; uint4 w;
      w.x = pack2(r[0].y, r[1].y); w.y = pack2(r[2].y, r[3].y); w.z = pack2(r[4].y, r[5].y); w.w = pack2(r[6].y, r[7].y);
      *(uint4*)(s + row * 128 + ((kg ^ (row & 7)) << 4)) = w;
    }
    {
      const int row = n4 * 4 + 2; uint4 w;
      w.x = pack2(r[0].z, r[1].z); w.y = pack2(r[2].z, r[3].z); w.z = pack2(r[4].z, r[5].z); w.w = pack2(r[6].z, r[7].z);
      *(uint4*)(s + row * 128 + ((kg ^ (row & 7)) << 4)) = w;
    }
    {
      const int row = n4 * 4 + 3; uint4 w;
      w.x = pack2(r[0].w, r[1].w); w.y = pack2(r[2].w, r[3].w); w.z = pack2(r[4].w, r[5].w); w.w = pack2(r[6].w, r[7].w);
      *(uint4*)(s + row * 128 + ((kg ^ (row & 7)) << 4)) = w;
    }
  }
};

template <class AL, class BL>
__device__ __forceinline__ void gemm128(unsigned char* smem, AL& al, BL& bl, int nk, f32x4 (&acc)[4][4]) {
  const int tid = threadIdx.x, lane = tid & 63, wid = tid >> 6, wr = wid >> 1, wc = wid & 1, fr = lane & 15, fq = lane >> 4;
  unsigned char* sA = smem; unsigned char* sB = smem + 16384;
#pragma unroll
  for (int m = 0; m < 4; ++m)
#pragma unroll
    for (int n = 0; n < 4; ++n) acc[m][n] = (f32x4){0.f, 0.f, 0.f, 0.f};
  al.load(0); bl.load(0);
  for (int kt = 0; kt < nk; ++kt) {
    __syncthreads();
    al.store(sA); bl.store(sB);
    __syncthreads();
    if (kt + 1 < nk) { al.load(kt + 1); bl.load(kt + 1); }
#pragma unroll
    for (int ks = 0; ks < 2; ++ks) {
      bf16x8 a[4], b[4];
#pragma unroll
      for (int m = 0; m < 4; ++m) {
        const int row = wr * 64 + m * 16 + fr;
        a[m] = *(const bf16x8*)(sA + row * 128 + (((ks * 4 + fq) ^ (row & 7)) << 4));
      }
#pragma unroll
      for (int n = 0; n < 4; ++n) {
        const int row = wc * 64 + n * 16 + fr;
        b[n] = *(const bf16x8*)(sB + row * 128 + (((ks * 4 + fq) ^ (row & 7)) << 4));
      }
#pragma unroll
      for (int m = 0; m < 4; ++m)
#pragma unroll
        for (int n = 0; n < 4; ++n) acc[m][n] = __builtin_amdgcn_mfma_f32_16x16x32_bf16(a[m], b[n], acc[m][n], 0, 0, 0);
    }
  }
  __syncthreads();
}

#define GEMM_IDS const int tid = threadIdx.x, lane = tid & 63, wid = tid >> 6, wr = wid >> 1, wc = wid & 1, fr = lane & 15, fq = lane >> 4; (void)tid; (void)lane;

struct Params {
  const float* in[20];
  float* out;
  char* ws;
};

constexpr int SMEM_BYTES = 36864;
constexpr int SM_MISC = 32768;

__device__ __forceinline__ void ph_proj(unsigned char* smem, int tile, const float* __restrict__ x, const float* __restrict__ w_in, bf16_t* __restrict__ proj, float* __restrict__ ba) {
  GEMM_IDS
  const int n0 = (tile % 23) * 128, m0 = (tile / 23) * 128;
  LdRowF32 al; al.init([&](int r) { return x + (size_t)(m0 + r) * DM; });
  LdColF32 bl; { const int col = n0 + 4 * (tid & 31); const bool v = col < INC; bl.init(w_in + (v ? col : 0), INC, v); }
  f32x4 acc[4][4];
  gemm128(smem, al, bl, DM / 64, acc);
#pragma unroll
  for (int m = 0; m < 4; ++m)
#pragma unroll
    for (int n = 0; n < 4; ++n)
#pragma unroll
      for (int j = 0; j < 4; ++j) {
        const int row = m0 + wr * 64 + m * 16 + fq * 4 + j, col = n0 + wc * 64 + n * 16 + fr;
        if (col < PROJW) proj[(size_t)row * PROJW + col] = (bf16_t)f2bf(acc[m][n][j]);
        else if (col < INC) ba[(size_t)row * 8 + (col - PROJW)] = acc[m][n][j];
      }
}

__device__ __forceinline__ void ph_dnprep(unsigned char* smem, int n, const bf16_t* __restrict__ proj, const float* __restrict__ ba, const float* __restrict__ conv_w,
                                          const float* __restrict__ a_log, const float* __restrict__ dt_bias,
                                          bf16_t* __restrict__ qn, bf16_t* __restrict__ kn, bf16_t* __restrict__ vv, float* __restrict__ beta, float* __restrict__ g) {
  float (*red)[4] = (float (*)[4])(smem + SM_MISC);
  const int t = n % SEQ, tid = threadIdx.x, lane = tid & 63, wid = tid >> 6;
  float y[6];
#pragma unroll
  for (int i = 0; i < 6; ++i) {
    const int c = tid + i * 256;
    float s = 0.f;
#pragma unroll
    for (int j = 0; j < 4; ++j) {
      const int tt = t - 3 + j;
      if (tt >= 0) s += conv_w[j * 1536 + c] * bf2f(proj[(size_t)(n - 3 + j) * PROJW + c]);
    }
    y[i] = siluf(s);
    const float ss = wave_sum(y[i] * y[i]);
    if (lane == 0) red[i][wid] = ss;
  }
  __syncthreads();
#pragma unroll
  for (int i = 0; i < 6; ++i) {
    const int c = tid + i * 256;
    const float ss = red[i][wid & 2] + red[i][(wid & 2) + 1];
    const float rn = rsqrtf(ss + L2_EPS);
    if (i < 2) qn[(size_t)n * 512 + c] = (bf16_t)f2bf(y[i] * rn);
    else if (i < 4) kn[(size_t)n * 512 + (c - 512)] = (bf16_t)f2bf(y[i] * rn);
    else vv[(size_t)n * 512 + (c - 1024)] = (bf16_t)f2bf(y[i]);
  }
  if (tid < 4) {
    beta[(size_t)n * 4 + tid] = sigmoidf(ba[(size_t)n * 8 + tid]);
    const float xx = ba[(size_t)n * 8 + 4 + tid] + dt_bias[tid];
    const float sp = fmaxf(xx, 0.f) + log1pf(__expf(-fabsf(xx)));
    g[(size_t)n * 4 + tid] = -__expf(a_log[tid]) * sp;
  }
  __syncthreads();
}

__device__ __forceinline__ void ph_dn_naive(unsigned char* smem, int bh, const bf16_t* __restrict__ qn, const bf16_t* __restrict__ kn, const bf16_t* __restrict__ vv,
                                            const float* __restrict__ beta, const float* __restrict__ g, float* __restrict__ o) {
  const int v = threadIdx.x >> 1, p = threadIdx.x & 1;
  float (*sq)[128] = (float (*)[128])(smem);
  float (*sk)[128] = (float (*)[128])(smem + 8192);
  const int b = bh >> 2, h = bh & 3;
  float S[64];
#pragma unroll
  for (int i = 0; i < 64; ++i) S[i] = 0.f;
  const float scale = 0.08838834764831845f;
  for (int t0 = 0; t0 < SEQ; t0 += 16) {
    __syncthreads();
    for (int e = threadIdx.x; e < 16 * 128; e += 256) {
      const int tt = e >> 7, d = e & 127;
      const size_t n = (size_t)b * SEQ + t0 + tt;
      sq[tt][d] = bf2f(qn[n * 512 + h * 128 + d]);
      sk[tt][d] = bf2f(kn[n * 512 + h * 128 + d]);
    }
    __syncthreads();
    for (int tt = 0; tt < 16; ++tt) {
      const size_t n = (size_t)b * SEQ + t0 + tt;
      const float vt = bf2f(vv[n * 512 + h * 128 + v]);
      const float bt = beta[n * 4 + h];
      const float a = __expf(g[n * 4 + h]);
      float dot = 0.f;
#pragma unroll
      for (int i = 0; i < 64; ++i) dot += sk[tt][p * 64 + i] * S[i];
      dot += __shfl_xor(dot, 1);
      const float c = bt * (vt - a * dot);
      float oo = 0.f;
#pragma unroll
      for (int i = 0; i < 64; ++i) { S[i] = a * S[i] + sk[tt][p * 64 + i] * c; oo += sq[tt][p * 64 + i] * S[i]; }
      oo += __shfl_xor(oo, 1);
      if (p == 0) o[n * 512 + h * 128 + v] = oo * scale;
    }
  }
  __syncthreads();
}

__device__ __forceinline__ void ph_dn_post(int n, const float* __restrict__ o, const bf16_t* __restrict__ proj, const float* __restrict__ dn_norm_g, bf16_t* __restrict__ mixed) {
  const int tid = threadIdx.x, h = tid >> 6, lane = tid & 63;
  const float o0 = o[(size_t)n * 512 + h * 128 + lane], o1 = o[(size_t)n * 512 + h * 128 + 64 + lane];
  const float ss = wave_sum(o0 * o0 + o1 * o1);
  const float rn = rsqrtf(ss * (1.f / 128.f) + RMS_EPS);
  const float z0 = bf2f(proj[(size_t)n * PROJW + OFF_Z + h * 128 + lane]), z1 = bf2f(proj[(size_t)n * PROJW + OFF_Z + h * 128 + 64 + lane]);
  mixed[(size_t)n * DM + h * 128 + lane] = (bf16_t)f2bf(o0 * rn * dn_norm_g[lane] * siluf(z0));
  mixed[(size_t)n * DM + h * 128 + 64 + lane] = (bf16_t)f2bf(o1 * rn * dn_norm_g[64 + lane] * siluf(z1));
}

__device__ __forceinline__ void ph_swa_naive(int item, const bf16_t* __restrict__ proj, const float* __restrict__ sinks, bf16_t* __restrict__ mixed) {
  const int gid = item * 256 + threadIdx.x;
  const int h = gid / NTOK, n = gid % NTOK, t = n % SEQ, kvh = h >> 2;
  float q[64], acc[64];
  {
    const uint4* qp = (const uint4*)(proj + (size_t)n * PROJW + OFF_SQ + h * 64);
#pragma unroll
    for (int c = 0; c < 8; ++c) {
      const uint4 w = qp[c];
      q[c * 8 + 0] = bflo(w.x); q[c * 8 + 1] = bfhi(w.x); q[c * 8 + 2] = bflo(w.y); q[c * 8 + 3] = bfhi(w.y);
      q[c * 8 + 4] = bflo(w.z); q[c * 8 + 5] = bfhi(w.z); q[c * 8 + 6] = bflo(w.w); q[c * 8 + 7] = bfhi(w.w);
    }
  }
#pragma unroll
  for (int d = 0; d < 64; ++d) acc[d] = 0.f;
  const float slope = exp2f(-(float)(h + 1));
  float mrun = sinks[h], l = 1.f;
  const int s0 = (t - 127 > 0) ? (t - 127) : 0;
  for (int s = s0; s <= t; ++s) {
    const size_t nk = (size_t)(n - (t - s));
    const uint4* kp = (const uint4*)(proj + nk * PROJW + OFF_SK + kvh * 64);
    float dot = 0.f;
#pragma unroll
    for (int c = 0; c < 8; ++c) {
      const uint4 w = kp[c];
      dot += q[c * 8 + 0] * bflo(w.x) + q[c * 8 + 1] * bfhi(w.x) + q[c * 8 + 2] * bflo(w.y) + q[c * 8 + 3] * bfhi(w.y)
           + q[c * 8 + 4] * bflo(w.z) + q[c * 8 + 5] * bfhi(w.z) + q[c * 8 + 6] * bflo(w.w) + q[c * 8 + 7] * bfhi(w.w);
    }
    const float sc = dot * 0.125f - slope * (float)(t - s);
    const float mn = fmaxf(mrun, sc);
    const float corr = __expf(mrun - mn), p = __expf(sc - mn);
    l = l * corr + p;
    const uint4* vp = (const uint4*)(proj + nk * PROJW + OFF_SV + kvh * 64);
#pragma unroll
    for (int c = 0; c < 8; ++c) {
      const uint4 w = vp[c];
      acc[c * 8 + 0] = acc[c * 8 + 0] * corr + p * bflo(w.x); acc[c * 8 + 1] = acc[c * 8 + 1] * corr + p * bfhi(w.x);
      acc[c * 8 + 2] = acc[c * 8 + 2] * corr + p * bflo(w.y); acc[c * 8 + 3] = acc[c * 8 + 3] * corr + p * bfhi(w.y);
      acc[c * 8 + 4] = acc[c * 8 + 4] * corr + p * bflo(w.z); acc[c * 8 + 5] = acc[c * 8 + 5] * corr + p * bfhi(w.z);
      acc[c * 8 + 6] = acc[c * 8 + 6] * corr + p * bflo(w.w); acc[c * 8 + 7] = acc[c * 8 + 7] * corr + p * bfhi(w.w);
    }
    mrun = mn;
  }
  const float inv = 1.f / l;
  uint4* op = (uint4*)(mixed + (size_t)n * DM + 512 + h * 64);
#pragma unroll
  for (int c = 0; c < 8; ++c) {
    uint4 w;
    w.x = pack2(acc[c * 8 + 0] * inv, acc[c * 8 + 1] * inv); w.y = pack2(acc[c * 8 + 2] * inv, acc[c * 8 + 3] * inv);
    w.z = pack2(acc[c * 8 + 4] * inv, acc[c * 8 + 5] * inv); w.w = pack2(acc[c * 8 + 6] * inv, acc[c * 8 + 7] * inv);
    op[c] = w;
  }
}

__device__ __forceinline__ void ph_wout(unsigned char* smem, int tile, const bf16_t* __restrict__ mixed, const float* __restrict__ w_out, const float* __restrict__ x, float* __restrict__ y1) {
  GEMM_IDS
  const int n0 = (tile & 7) * 128, m0 = (tile >> 3) * 128;
  LdRowBF16 al; al.init([&](int r) { return mixed + (size_t)(m0 + r) * DM; });
  LdColF32 bl; bl.init(w_out + n0 + 4 * (tid & 31), DM, true);
  f32x4 acc[4][4];
  gemm128(smem, al, bl, DM / 64, acc);
#pragma unroll
  for (int m = 0; m < 4; ++m)
#pragma unroll
    for (int n = 0; n < 4; ++n)
#pragma unroll
      for (int j = 0; j < 4; ++j) {
        const size_t idx = (size_t)(m0 + wr * 64 + m * 16 + fq * 4 + j) * DM + n0 + wc * 64 + n * 16 + fr;
        y1[idx] = ALPHA * x[idx] + acc[m][n][j];
      }
}

__device__ __forceinline__ void ph_ln1(int item, float* __restrict__ y, const float* __restrict__ gam, const float* __restrict__ bet, bf16_t* __restrict__ xbf) {
  const int row = item * 4 + (threadIdx.x >> 6), lane = threadIdx.x & 63;
  float4* p = (float4*)(y + (size_t)row * DM);
  float4 v[4]; float s = 0.f;
#pragma unroll
  for (int i = 0; i < 4; ++i) { v[i] = p[lane + i * 64]; s += v[i].x + v[i].y + v[i].z + v[i].w; }
  const float mu = wave_sum(s) * (1.f / DM);
  float q = 0.f;
#pragma unroll
  for (int i = 0; i < 4; ++i) { const float a = v[i].x - mu, b = v[i].y - mu, c = v[i].z - mu, d = v[i].w - mu; q += a * a + b * b + c * c + d * d; }
  const float rs = rsqrtf(wave_sum(q) * (1.f / DM) + LN_EPS);
#pragma unroll
  for (int i = 0; i < 4; ++i) {
    const float4 gg = ((const float4*)gam)[lane + i * 64], bb = ((const float4*)bet)[lane + i * 64];
    float4 r;
    r.x = (v[i].x - mu) * rs * gg.x + bb.x; r.y = (v[i].y - mu) * rs * gg.y + bb.y;
    r.z = (v[i].z - mu) * rs * gg.z + bb.z; r.w = (v[i].w - mu) * rs * gg.w + bb.w;
    p[lane + i * 64] = r;
    uint2 w; w.x = pack2(r.x, r.y); w.y = pack2(r.z, r.w);
    ((uint2*)(xbf + (size_t)row * DM))[lane + i * 64] = w;
  }
}

__device__ __forceinline__ void ph_router(unsigned char* smem, int tile, const bf16_t* __restrict__ xbf, const float* __restrict__ router_w, float* __restrict__ logits) {
  GEMM_IDS
  const int n0 = (tile & 1) * 128, m0 = (tile >> 1) * 128;
  LdRowBF16 al; al.init([&](int r) { return xbf + (size_t)(m0 + r) * DM; });
  LdColF32 bl; bl.init(router_w + n0 + 4 * (tid & 31), NEXP, true);
  f32x4 acc[4][4];
  gemm128(smem, al, bl, DM / 64, acc);
#pragma unroll
  for (int m = 0; m < 4; ++m)
#pragma unroll
    for (int n = 0; n < 4; ++n)
#pragma unroll
      for (int j = 0; j < 4; ++j)
        logits[(size_t)(m0 + wr * 64 + m * 16 + fq * 4 + j) * NEXP + n0 + wc * 64 + n * 16 + fr] = acc[m][n][j];
}

__device__ __forceinline__ void ph_route(int item, const float* __restrict__ logits, const float* __restrict__ router_bias, int* __restrict__ cnt, int* __restrict__ list, float* __restrict__ gates) {
  const int n = item * 4 + (threadIdx.x >> 6), lane = threadIdx.x & 63;
  const float4 lg = ((const float4*)(logits + (size_t)n * NEXP))[lane];
  const float4 rb = ((const float4*)router_bias)[lane];
  float sc[4] = {sigmoidf(lg.x), sigmoidf(lg.y), sigmoidf(lg.z), sigmoidf(lg.w)};
  float sel[4] = {sc[0] + rb.x, sc[1] + rb.y, sc[2] + rb.z, sc[3] + rb.w};
  float t1 = fmaxf(sel[0], sel[1]), t2 = fminf(sel[0], sel[1]);
  { const float a = sel[2]; if (a > t1) { t2 = t1; t1 = a; } else if (a > t2) t2 = a; }
  { const float a = sel[3]; if (a > t1) { t2 = t1; t1 = a; } else if (a > t2) t2 = a; }
#pragma unroll
  for (int o = 1; o < 8; o <<= 1) {
    const float b1 = __shfl_xor(t1, o), b2 = __shfl_xor(t2, o);
    const float n1 = fmaxf(t1, b1), n2 = fmaxf(fminf(t1, b1), fmaxf(t2, b2));
    t1 = n1; t2 = n2;
  }
  const float gs = t1 + t2;
  const int mygrp = lane >> 3;
  int rank = 0;
#pragma unroll
  for (int j = 0; j < 8; ++j) {
    const float o = __shfl(gs, j * 8);
    rank += (o > gs || (o == gs && j < mygrp)) ? 1 : 0;
  }
  const bool gsel = rank < 4;
  float cand[4];
#pragma unroll
  for (int i = 0; i < 4; ++i) cand[i] = gsel ? sel[i] : -INFINITY;
  float gsum = 0.f; float myg = 0.f; int mye = 0;
#pragma unroll 1
  for (int r = 0; r < TOPK; ++r) {
    float bv = cand[0]; int bi = 0;
#pragma unroll
    for (int i = 1; i < 4; ++i) if (cand[i] > bv) { bv = cand[i]; bi = i; }
    int be = lane * 4 + bi;
    float bs = (bi == 0) ? sc[0] : (bi == 1) ? sc[1] : (bi == 2) ? sc[2] : sc[3];
#pragma unroll
    for (int o = 1; o < 64; o <<= 1) {
      const float ov = __shfl_xor(bv, o); const int oe = __shfl_xor(be, o); const float os = __shfl_xor(bs, o);
      if (ov > bv || (ov == bv && oe < be)) { bv = ov; be = oe; bs = os; }
    }
    if ((be >> 2) == lane) {
      const int bi2 = be & 3;
      if (bi2 == 0) cand[0] = -INFINITY; else if (bi2 == 1) cand[1] = -INFINITY; else if (bi2 == 2) cand[2] = -INFINITY; else cand[3] = -INFINITY;
    }
    gsum += bs;
    if (lane == r) { myg = bs; mye = be; }
  }
  if (lane < TOPK) {
    const int slot = atomicAdd(&cnt[mye], 1);
    list[(size_t)mye * CAP + slot] = n * TOPK + lane;
    gates[(size_t)n * TOPK + lane] = myg / gsum * 2.5f;
  }
}

__device__ __forceinline__ int moe_build_prefix(const int* __restrict__ cnt, int* sscan) {
  const int tid = threadIdx.x;
  const int c = cnt[tid];
  __syncthreads();
  sscan[tid] = (c + 127) >> 7;
  __syncthreads();
  for (int o = 1; o < 256; o <<= 1) {
    const int v = (tid >= o) ? sscan[tid - o] : 0;
    __syncthreads();
    sscan[tid] += v;
    __syncthreads();
  }
  return sscan[255];
}
__device__ __forceinline__ void moe_locate(const int* sscan, int total, int rtile, int& e, int& rt) {
  if (rtile >= total) { e = 256; rt = rtile - total; return; }
  int lo = 0, hi = 255;
  while (lo < hi) { const int mid = (lo + hi) >> 1; if (sscan[mid] > rtile) hi = mid; else lo = mid + 1; }
  e = lo; rt = rtile - (lo ? sscan[lo - 1] : 0);
}

__device__ __forceinline__ void ph_moe1(unsigned char* smem, int e, int rt, int ct, const bf16_t* __restrict__ xbf, const int* __restrict__ cnt, const int* __restrict__ list,
                                        const float* __restrict__ w_gate, const float* __restrict__ w_up,
                                        const float* __restrict__ sw_gate, const float* __restrict__ sw_up, bf16_t* __restrict__ hbuf) {
  int* sasg = (int*)(smem + SM_MISC + 2048);
  GEMM_IDS
  const int rows = (e < 256) ? cnt[e] : NTOK;
  if (tid < 128) {
    const int r = rt * 128 + tid;
    int a = -1;
    if (r < rows) a = (e < 256) ? list[(size_t)e * CAP + r] : (NA + r);
    sasg[tid] = a;
  }
  __syncthreads();
  LdRowBF16 al; al.init([&](int r) { const int a = sasg[r]; const int tok = (a < 0) ? 0 : (a < NA ? (a >> 3) : (a - NA)); return xbf + (size_t)tok * DM; });
  LdColF32 bl;
  {
    const int jj = 4 * (tid & 31);
    const int bwc = jj >> 6, bn = (jj >> 4) & 3;
    const int ff = ct * 64 + bwc * 32 + (bn >> 1) * 16 + (jj & 15);
    const float* W = (e < 256) ? ((bn & 1) ? w_up : w_gate) + (size_t)e * DM * EFF : ((bn & 1) ? sw_up : sw_gate);
    bl.init(W + ff, EFF, true);
  }
  f32x4 acc[4][4];
  gemm128(smem, al, bl, DM / 64, acc);
#pragma unroll
  for (int m = 0; m < 4; ++m)
#pragma unroll
    for (int pp = 0; pp < 2; ++pp)
#pragma unroll
      for (int j = 0; j < 4; ++j) {
        const int r = wr * 64 + m * 16 + fq * 4 + j;
        const int a = sasg[r];
        if (a >= 0) {
          const float gv = acc[m][2 * pp][j], uv = acc[m][2 * pp + 1][j];
          hbuf[(size_t)a * EFF + ct * 64 + wc * 32 + pp * 16 + fr] = (bf16_t)f2bf(siluf(gv) * uv);
        }
      }
  __syncthreads();
}

__device__ __forceinline__ void ph_moe2(unsigned char* smem, int e, int rt, int ct, const bf16_t* __restrict__ hbuf, const int* __restrict__ cnt, const int* __restrict__ list, const float* __restrict__ gates,
                                        const float* __restrict__ w_down, const float* __restrict__ sw_down, bf16_t* __restrict__ ybuf) {
  int* sasg = (int*)(smem + SM_MISC + 2048);
  float* sgate = (float*)(smem + SM_MISC + 2048 + 512);
  GEMM_IDS
  const int rows = (e < 256) ? cnt[e] : NTOK;
  const int n0 = ct * 128;
  if (tid < 128) {
    const int r = rt * 128 + tid;
    int a = -1;
    if (r < rows) a = (e < 256) ? list[(size_t)e * CAP + r] : (NA + r);
    sasg[tid] = a;
    sgate[tid] = (a >= 0 && a < NA) ? gates[a] : 1.f;
  }
  __syncthreads();
  LdRowBF16 al; al.init([&](int r) { const int a = sasg[r]; return hbuf + (size_t)(a < 0 ? 0 : a) * EFF; });
  LdColF32 bl; bl.init(((e < 256) ? w_down + (size_t)e * EFF * DM : sw_down) + n0 + 4 * (tid & 31), DM, true);
  f32x4 acc[4][4];
  gemm128(smem, al, bl, EFF / 64, acc);
#pragma unroll
  for (int m = 0; m < 4; ++m)
#pragma unroll
    for (int n = 0; n < 4; ++n)
#pragma unroll
      for (int j = 0; j < 4; ++j) {
        const int r = wr * 64 + m * 16 + fq * 4 + j;
        const int a = sasg[r];
        if (a >= 0) ybuf[(size_t)a * DM + n0 + wc * 64 + n * 16 + fr] = (bf16_t)f2bf(acc[m][n][j] * sgate[r]);
      }
  __syncthreads();
}

__device__ __forceinline__ void ph_final(int item, float* __restrict__ out, const bf16_t* __restrict__ ybuf, const float* __restrict__ gam, const float* __restrict__ bet) {
  const int row = item * 4 + (threadIdx.x >> 6), lane = threadIdx.x & 63;
  float4* p = (float4*)(out + (size_t)row * DM);
  float4 v[4]; float s = 0.f;
#pragma unroll
  for (int i = 0; i < 4; ++i) {
    float4 a = p[lane + i * 64];
    a.x *= ALPHA; a.y *= ALPHA; a.z *= ALPHA; a.w *= ALPHA;
#pragma unroll
    for (int k = 0; k < 9; ++k) {
      const size_t yr = (k < 8) ? ((size_t)row * 8 + k) : ((size_t)NA + row);
      const uint2 w = ((const uint2*)(ybuf + yr * DM))[lane + i * 64];
      a.x += bflo(w.x); a.y += bfhi(w.x); a.z += bflo(w.y); a.w += bfhi(w.y);
    }
    v[i] = a; s += a.x + a.y + a.z + a.w;
  }
  const float mu = wave_sum(s) * (1.f / DM);
  float q = 0.f;
#pragma unroll
  for (int i = 0; i < 4; ++i) { const float a = v[i].x - mu, b = v[i].y - mu, c = v[i].z - mu, d = v[i].w - mu; q += a * a + b * b + c * c + d * d; }
  const float rs = rsqrtf(wave_sum(q) * (1.f / DM) + LN_EPS);
#pragma unroll
  for (int i = 0; i < 4; ++i) {
    const float4 gg = ((const float4*)gam)[lane + i * 64], bb = ((const float4*)bet)[lane + i * 64];
    float4 r;
    r.x = (v[i].x - mu) * rs * gg.x + bb.x; r.y = (v[i].y - mu) * rs * gg.y + bb.y;
    r.z = (v[i].z - mu) * rs * gg.z + bb.z; r.w = (v[i].w - mu) * rs * gg.w + bb.w;
    p[lane + i * 64] = r;
  }
}

__global__ void __launch_bounds__(256, 2) mega(Params P) {
  __shared__ __attribute__((aligned(16))) unsigned char smem[SMEM_BYTES];
  cg::grid_group grid = cg::this_grid();
  const int bid = blockIdx.x, nblk = gridDim.x;
  const float* x = P.in[0]; const float* w_in = P.in[1]; const float* conv_w = P.in[2]; const float* a_log = P.in[3];
  const float* dt_bias = P.in[4]; const float* dn_norm_g = P.in[5]; const float* sinks = P.in[6]; const float* w_out = P.in[7];
  const float* ln1_g = P.in[8]; const float* ln1_b = P.in[9]; const float* router_w = P.in[10]; const float* router_bias = P.in[11];
  const float* w_gate = P.in[12]; const float* w_up = P.in[13]; const float* w_down = P.in[14];
  const float* sw_gate = P.in[15]; const float* sw_up = P.in[16]; const float* sw_down = P.in[17];
  const float* ln2_g = P.in[18]; const float* ln2_b = P.in[19];
  float* out = P.out; char* ws = P.ws;
  bf16_t* x1bf = (bf16_t*)(ws + WS_X1BF);
  float* logits = (float*)(ws + WS_LOGIT);
  int* list = (int*)(ws + WS_LIST);
  float* gates = (float*)(ws + WS_GATES);
  int* cnt = (int*)(ws + WS_CTRL);
  bf16_t* mixed = (bf16_t*)(ws + WS_MIXED);
  bf16_t* proj = (bf16_t*)(ws + WS_PROJ);
  float* ba = (float*)(ws + WS_BA);
  bf16_t* qn = (bf16_t*)(ws + WS_QN);
  bf16_t* kn = (bf16_t*)(ws + WS_KN);
  bf16_t* vv = (bf16_t*)(ws + WS_VV);
  float* beta = (float*)(ws + WS_BETA);
  float* g = (float*)(ws + WS_G);
  float* o = (float*)(ws + WS_O);
  bf16_t* hbuf = (bf16_t*)(ws + WS_HBUF);
  bf16_t* ybuf = (bf16_t*)(ws + WS_YBUF);

  for (int t = bid; t < 23 * (NTOK / 128); t += nblk) ph_proj(smem, t, x, w_in, proj, ba);
  grid.sync();
  for (int n = bid; n < NTOK; n += nblk) ph_dnprep(smem, n, proj, ba, conv_w, a_log, dt_bias, qn, kn, vv, beta, g);
  for (int it = bid; it < NTOK * 8 / 256; it += nblk) ph_swa_naive(it, proj, sinks, mixed);
  grid.sync();
  for (int it = bid; it < 32; it += nblk) ph_dn_naive(smem, it, qn, kn, vv, beta, g, o);
  grid.sync();
  for (int n = bid; n < NTOK; n += nblk) ph_dn_post(n, o, proj, dn_norm_g, mixed);
  grid.sync();
  for (int t = bid; t < 8 * (NTOK / 128); t += nblk) ph_wout(smem, t, mixed, w_out, x, out);
  grid.sync();
  for (int it = bid; it < NTOK / 4; it += nblk) ph_ln1(it, out, ln1_g, ln1_b, x1bf);
  grid.sync();
  for (int t = bid; t < 2 * (NTOK / 128); t += nblk) ph_router(smem, t, x1bf, router_w, logits);
  grid.sync();
  for (int it = bid; it < NTOK / 4; it += nblk) ph_route(it, logits, router_bias, cnt, list, gates);
  grid.sync();
  int* sscan = (int*)(smem + SM_MISC);
  const int total = moe_build_prefix(cnt, sscan);
  const int ntile = total + NTOK / 128;
  for (int it = bid; it < ntile * 4; it += nblk) {
    int e, rt; moe_locate(sscan, total, it >> 2, e, rt);
    ph_moe1(smem, e, rt, it & 3, x1bf, cnt, list, w_gate, w_up, sw_gate, sw_up, hbuf);
  }
  grid.sync();
  for (int it = bid; it < ntile * 8; it += nblk) {
    int e, rt; moe_locate(sscan, total, it >> 3, e, rt);
    ph_moe2(smem, e, rt, it & 7, hbuf, cnt, list, gates, w_down, sw_down, ybuf);
  }
  grid.sync();
  for (int it = bid; it < NTOK / 4; it += nblk) ph_final(it, out, ybuf, ln2_g, ln2_b);
}

extern "C" void kernel_launch(void* const* d_in, const int* in_sizes, int n_in, void* d_out, int out_size, void* d_ws, size_t ws_size, hipStream_t stream) {
  static int grid_blocks = 0;
  if (!grid_blocks) {
    int dev = 0, cus = 0, per_cu = 0;
    (void)hipGetDevice(&dev);
    (void)hipDeviceGetAttribute(&cus, hipDeviceAttributeMultiprocessorCount, dev);
    (void)hipOccupancyMaxActiveBlocksPerMultiprocessor(&per_cu, mega, 256, 0);
    if (per_cu > 2) per_cu = 2;
    if (per_cu < 1) per_cu = 1;
    grid_blocks = cus * per_cu;
  }
  Params p{};
  for (int i = 0; i < 20; ++i) p.in[i] = (const float*)d_in[i];
  p.out = (float*)d_out; p.ws = (char*)d_ws;
  (void)hipMemsetAsync((char*)d_ws + WS_CTRL, 0, 1024, stream);
  void* args[] = {&p};
  hipError_t e = hipLaunchCooperativeKernel((void*)mega, dim3(grid_blocks), dim3(256), args, 0, stream);
  if (e != hipSuccess) fprintf(stderr, "cooperative launch failed: %s (grid %d)\n", hipGetErrorString(e), grid_blocks);
}
```

```cpp
#include <hip/hip_runtime.h>
#include <hip/hip_cooperative_groups.h>
#include <stdint.h>
#include <stdio.h>
namespace cg = cooperative_groups;

typedef __attribute__((ext_vector_type(8))) short bf16x8;
typedef __attribute__((ext_vector_type(4))) float f32x4;
typedef unsigned short bf16_t;

constexpr int NTOK = 32768, SEQ = 4096, DM = 1024;
constexpr int INC = 2824, PROJW = 2816;
constexpr int OFF_DQ = 0, OFF_DK = 512, OFF_DV = 1024, OFF_SQ = 1536, OFF_SK = 2048, OFF_SV = 2176, OFF_Z = 2304;
constexpr int NEXP = 256, TOPK = 8, EFF = 256;
constexpr int NA = NTOK * TOPK;
constexpr int CAP = NTOK;
constexpr float ALPHA = 1.189207115002721f;
constexpr float LN_EPS = 1e-5f, RMS_EPS = 1e-6f, L2_EPS = 1e-6f;

constexpr size_t MiB = 1024ull * 1024ull;
constexpr size_t WS_X1BF = 0;
constexpr size_t WS_LOGIT = 64 * MiB;
constexpr size_t WS_LIST = 96 * MiB;
constexpr size_t WS_GATES = 128 * MiB;
constexpr size_t WS_CTRL = 129 * MiB;
constexpr size_t WS_MIXED = 130 * MiB;
constexpr size_t WS_PROJ = 200 * MiB;
constexpr size_t WS_BA = 376 * MiB;
constexpr size_t WS_QD = 377 * MiB;
constexpr size_t WS_W0N = 409 * MiB;
constexpr size_t WS_KTT = 441 * MiB;
constexpr size_t WS_RV = 473 * MiB;
constexpr size_t WS_TM = 505 * MiB;
constexpr size_t WS_ATT = 521 * MiB;
constexpr size_t WS_GL = 537 * MiB;
constexpr size_t WS_O = 538 * MiB;
constexpr size_t WS_HBUF = 200 * MiB;
constexpr size_t WS_YBUF = 344 * MiB;

__device__ __forceinline__ int opaque_tid() { int t = threadIdx.x; asm volatile("" : "+v"(t)); return t; }
#define TIDX opaque_tid()
__device__ __forceinline__ unsigned f2bf(float f) {
  unsigned u = __float_as_uint(f);
  u += 0x7fffu + ((u >> 16) & 1u);
  return u >> 16;
}
__device__ __forceinline__ unsigned pack2(float lo, float hi) { return f2bf(lo) | (f2bf(hi) << 16); }
__device__ __forceinline__ float bf2f(unsigned h) { return __uint_as_float(h << 16); }
__device__ __forceinline__ float bflo(unsigned w) { return __uint_as_float(w << 16); }
__device__ __forceinline__ float bfhi(unsigned w) { return __uint_as_float(w & 0xffff0000u); }
__device__ __forceinline__ float siluf(float x) { return x / (1.f + __expf(-x)); }
__device__ __forceinline__ float sigmoidf(float x) { return 1.f / (1.f + __expf(-x)); }
__device__ __forceinline__ float wave_sum(float v) {
#pragma unroll
  for (int o = 32; o > 0; o >>= 1) v += __shfl_xor(v, o);
  return v;
}

struct LdRowF32 {
  const char* p[8]; float4 r[8]; int row0, ch4;
  template <class F> __device__ __forceinline__ void init(F rowptr) {
    const int tid = TIDX; ch4 = tid & 15; row0 = tid >> 4;
#pragma unroll
    for (int i = 0; i < 8; ++i) p[i] = (const char*)rowptr(row0 + i * 16) + ch4 * 16;
  }
  __device__ __forceinline__ void load(int kt) {
#pragma unroll
    for (int i = 0; i < 8; ++i) r[i] = *(const float4*)(p[i] + (size_t)kt * 256);
  }
  __device__ __forceinline__ void store(unsigned char* s) {
#pragma unroll
    for (int i = 0; i < 8; ++i) {
      const int row = row0 + i * 16;
      uint2 w; w.x = pack2(r[i].x, r[i].y); w.y = pack2(r[i].z, r[i].w);
      *(uint2*)(s + row * 128 + ((((ch4 >> 1) ^ (row & 7))) << 4) + (ch4 & 1) * 8) = w;
    }
  }
};
struct LdRowBF16 {
  const char* p[4]; uint4 r[4]; int row0, ch;
  template <class F> __device__ __forceinline__ void init(F rowptr) {
    const int tid = TIDX; ch = tid & 7; row0 = tid >> 3;
#pragma unroll
    for (int i = 0; i < 4; ++i) p[i] = (const char*)rowptr(row0 + i * 32) + ch * 16;
  }
  __device__ __forceinline__ void load(int kt) {
#pragma unroll
    for (int i = 0; i < 4; ++i) r[i] = *(const uint4*)(p[i] + (size_t)kt * 128);
  }
  __device__ __forceinline__ void store(unsigned char* s) {
#pragma unroll
    for (int i = 0; i < 4; ++i) {
      const int row = row0 + i * 32;
      *(uint4*)(s + row * 128 + ((ch ^ (row & 7)) << 4)) = r[i];
    }
  }
};
struct LdColF32 {
  const char* p; size_t ldb; float4 r[8]; int n4, kg; bool valid;
  __device__ __forceinline__ void init(const float* colptr, size_t ld, bool v) {
    const int tid = TIDX; n4 = tid & 31; kg = tid >> 5; ldb = ld * 4; valid = v;
    p = (const char*)colptr + (size_t)(kg * 8) * ldb;
  }
  __device__ __forceinline__ void load(int kt) {
#pragma unroll
    for (int j = 0; j < 8; ++j) {
      if (valid) r[j] = *(const float4*)(p + (size_t)(kt * 64 + j) * ldb);
      else r[j] = make_float4(0.f, 0.f, 0.f, 0.f);
    }
  }
  __device__ __forceinline__ void store(unsigned char* s) {
    {
      const int row = n4 * 4 + 0; uint4 w;
      w.x = pack2(r[0].x, r[1].x); w.y = pack2(r[2].x, r[3].x); w.z = pack2(r[4].x, r[5].x); w.w = pack2(r[6].x, r[7].x);
      *(uint4*)(s + row * 128 + ((kg ^ (row & 7)) << 4)) = w;
    }
    {
      const int row = n4 * 4 + 1; uint4 w;
      w.x = pack2(r[0].y, r[1].y); w.y = pack2(r[2].y, r[3].y); w.z = pack2(r[4].y, r[5].y); w.w = pack2(r[6].y, r[7].y);
      *(uint4*)(s + row * 128 + ((kg ^ (row & 7)) << 4)) = w;
    }
    {
      const int row = n4 * 4 + 2; uint4 w;
      w.x = pack2(r[0].z, r[1].z); w.y = pack2(r[2].z, r[3].z); w.z = pack2(r[4].z, r[5].z); w.w = pack2(r[6].z, r[7].z);
      *(uint4*)(s + row * 128 + ((kg ^ (row & 7)) << 4)) = w;
    }
    {
      const int row = n4 * 4 + 3; uint4 w;
      w.x = pack2(r[0].w, r[1].w); w.y = pack2(r[2].w, r[3].w); w.z = pack2(r[4].w, r[5].w); w.w = pack2(r[6].w, r[7].w);
      *(uint4*)(s + row * 128 + ((kg ^ (row & 7)) << 4)) = w;
    }
  }
};

template <class AL, class BL>
__device__ __forceinline__ void gemm128(unsigned char* smem, AL& al, BL& bl, int nk, f32x4 (&acc)[4][4]) {
  const int tid = TIDX, lane = tid & 63, wid = tid >> 6, wr = wid >> 1, wc = wid & 1, fr = lane & 15, fq = lane >> 4;
  unsigned char* sA = smem; unsigned char* sB = smem + 16384;
#pragma unroll
  for (int m = 0; m < 4; ++m)
#pragma unroll
    for (int n = 0; n < 4; ++n) acc[m][n] = (f32x4){0.f, 0.f, 0.f, 0.f};
  al.load(0); bl.load(0);
  for (int kt = 0; kt < nk; ++kt) {
    __syncthreads();
    al.store(sA); bl.store(sB);
    __syncthreads();
    if (kt + 1 < nk) { al.load(kt + 1); bl.load(kt + 1); }
#pragma unroll
    for (int ks = 0; ks < 2; ++ks) {
      bf16x8 a[4], b[4];
#pragma unroll
      for (int m = 0; m < 4; ++m) {
        const int row = wr * 64 + m * 16 + fr;
        a[m] = *(const bf16x8*)(sA + row * 128 + (((ks * 4 + fq) ^ (row & 7)) << 4));
      }
#pragma unroll
      for (int n = 0; n < 4; ++n) {
        const int row = wc * 64 + n * 16 + fr;
        b[n] = *(const bf16x8*)(sB + row * 128 + (((ks * 4 + fq) ^ (row & 7)) << 4));
      }
#pragma unroll
      for (int m = 0; m < 4; ++m)
#pragma unroll
        for (int n = 0; n < 4; ++n) acc[m][n] = __builtin_amdgcn_mfma_f32_16x16x32_bf16(a[m], b[n], acc[m][n], 0, 0, 0);
    }
  }
  __syncthreads();
}

#define GEMM_IDS const int tid = TIDX, lane = tid & 63, wid = tid >> 6, wr = wid >> 1, wc = wid & 1, fr = lane & 15, fq = lane >> 4; (void)tid; (void)lane;

struct Params {
  const float* in[20];
  float* out;
  char* ws;
};

constexpr int SMEM_BYTES = 69632;
constexpr int SM_MISC = 65536;

__device__ __forceinline__ void ph_proj(unsigned char* smem, int tile, const float* __restrict__ x, const float* __restrict__ w_in, bf16_t* __restrict__ proj, float* __restrict__ ba) {
  GEMM_IDS
  const int n0 = (tile % 23) * 128, m0 = (tile / 23) * 128;
  LdRowF32 al; al.init([&](int r) { return x + (size_t)(m0 + r) * DM; });
  LdColF32 bl; { const int col = n0 + 4 * (tid & 31); const bool v = col < INC; bl.init(w_in + (v ? col : 0), INC, v); }
  f32x4 acc[4][4];
  gemm128(smem, al, bl, DM / 64, acc);
#pragma unroll
  for (int m = 0; m < 4; ++m)
#pragma unroll
    for (int n = 0; n < 4; ++n)
#pragma unroll
      for (int j = 0; j < 4; ++j) {
        const int row = m0 + wr * 64 + m * 16 + fq * 4 + j, col = n0 + wc * 64 + n * 16 + fr;
        if (col < PROJW) proj[(size_t)row * PROJW + col] = (bf16_t)f2bf(acc[m][n][j]);
        else if (col < INC) ba[(size_t)row * 8 + (col - PROJW)] = acc[m][n][j];
      }
}

typedef __attribute__((ext_vector_type(4))) unsigned u32x4;
__device__ __forceinline__ bf16x8 pack8(f32x4 a, f32x4 b) {
  union { bf16x8 v; unsigned u[4]; } x;
  x.u[0] = pack2(a[0], a[1]); x.u[1] = pack2(a[2], a[3]); x.u[2] = pack2(b[0], b[1]); x.u[3] = pack2(b[2], b[3]);
  return x.v;
}
__device__ __forceinline__ void ph_dnchunk(unsigned char* smem, int item, const bf16_t* __restrict__ proj, const float* __restrict__ ba, const float* __restrict__ conv_w,
                                           const float* __restrict__ a_log, const float* __restrict__ dt_bias,
                                           bf16_t* __restrict__ QD, bf16_t* __restrict__ W0N, bf16_t* __restrict__ KTT, bf16_t* __restrict__ RV,
                                           bf16_t* __restrict__ TM, bf16_t* __restrict__ ATT, float* __restrict__ GL) {
  const int tid = TIDX, lane = tid & 63, w = tid >> 6, fr = lane & 15, fq = lane >> 4;
  const int n = item & 63, h = (item >> 6) & 3, b = item >> 8;
  const int t0 = n * 64; const size_t row0 = (size_t)b * SEQ + t0;
  unsigned char* qs = smem; unsigned char* ks = smem + 16384; float* AT = (float*)(smem + 32768);
  const float scale = 0.08838834764831845f;
  float bL, gcL;
  {
    const float* bap = ba + (row0 + lane) * 8;
    bL = sigmoidf(bap[h]);
    const float xx = bap[4 + h] + dt_bias[h];
    const float sp = fmaxf(xx, 0.f) + log1pf(__expf(-fabsf(xx)));
    float gg = -__expf(a_log[h]) * sp;
#pragma unroll
    for (int o = 1; o < 64; o <<= 1) { const float v = __shfl_up(gg, o); if (lane >= o) gg += v; }
    gcL = gg;
  }
  {
    const int d = 2 * lane;
    float cw[3][4][2], xw[3][4][2];
#pragma unroll
    for (int mx = 0; mx < 3; ++mx)
#pragma unroll
      for (int j = 0; j < 4; ++j) {
        const float2 c2 = *(const float2*)(conv_w + j * 1536 + mx * 512 + h * 128 + d);
        cw[mx][j][0] = c2.x; cw[mx][j][1] = c2.y;
      }
    const bf16_t* pbase = proj + (row0 + 16 * w) * PROJW + h * 128 + d;
#pragma unroll
    for (int j = 0; j < 3; ++j) {
      const bool ok = (t0 + 16 * w - 3 + j) >= 0;
#pragma unroll
      for (int mx = 0; mx < 3; ++mx) {
        unsigned u = 0;
        if (ok) u = *(const unsigned*)(pbase + (ptrdiff_t)(j - 3) * PROJW + mx * 512);
        xw[mx][j + 1][0] = bflo(u); xw[mx][j + 1][1] = bfhi(u);
      }
    }
#pragma unroll
    for (int i = 0; i < 16; ++i) {
      float s[3][2];
#pragma unroll
      for (int mx = 0; mx < 3; ++mx) {
        const unsigned u = *(const unsigned*)(pbase + (size_t)i * PROJW + mx * 512);
#pragma unroll
        for (int j = 0; j < 3; ++j) { xw[mx][j][0] = xw[mx][j + 1][0]; xw[mx][j][1] = xw[mx][j + 1][1]; }
        xw[mx][3][0] = bflo(u); xw[mx][3][1] = bfhi(u);
        float y0 = 0.f, y1 = 0.f;
#pragma unroll
        for (int j = 0; j < 4; ++j) { y0 += cw[mx][j][0] * xw[mx][j][0]; y1 += cw[mx][j][1] * xw[mx][j][1]; }
        s[mx][0] = siluf(y0); s[mx][1] = siluf(y1);
      }
      const int row = 16 * w + i;
      const float rq = rsqrtf(wave_sum(s[0][0] * s[0][0] + s[0][1] * s[0][1]) + L2_EPS);
      const float rk = rsqrtf(wave_sum(s[1][0] * s[1][0] + s[1][1] * s[1][1]) + L2_EPS);
      const int off = row * 256 + ((((lane >> 2) ^ (row & 15))) << 4) + (lane & 3) * 4;
      *(unsigned*)(qs + off) = pack2(s[0][0] * rq, s[0][1] * rq);
      *(unsigned*)(ks + off) = pack2(s[1][0] * rk, s[1][1] * rk);
      const float bi = __shfl(bL, row);
      *(unsigned*)(RV + ((size_t)item * 64 + row) * 128 + d) = pack2(bi * s[2][0], bi * s[2][1]);
    }
  }
  __syncthreads();
  {
    f32x4 aKK[4], aQK[4];
#pragma unroll
    for (int nt = 0; nt < 4; ++nt) { aKK[nt] = (f32x4){0.f, 0.f, 0.f, 0.f}; aQK[nt] = (f32x4){0.f, 0.f, 0.f, 0.f}; }
#pragma unroll
    for (int k4 = 0; k4 < 4; ++k4) {
      const int arow = 16 * w + fr;
      const bf16x8 aq = *(const bf16x8*)(qs + arow * 256 + ((((k4 * 4 + fq) ^ (arow & 15))) << 4));
      const bf16x8 ak = *(const bf16x8*)(ks + arow * 256 + ((((k4 * 4 + fq) ^ (arow & 15))) << 4));
#pragma unroll
      for (int nt = 0; nt < 4; ++nt) {
        const int brow = 16 * nt + fr;
        const bf16x8 bk = *(const bf16x8*)(ks + brow * 256 + ((((k4 * 4 + fq) ^ (brow & 15))) << 4));
        aKK[nt] = __builtin_amdgcn_mfma_f32_16x16x32_bf16(ak, bk, aKK[nt], 0, 0, 0);
        aQK[nt] = __builtin_amdgcn_mfma_f32_16x16x32_bf16(aq, bk, aQK[nt], 0, 0, 0);
      }
    }
    float gci[4], bi[4];
#pragma unroll
    for (int r = 0; r < 4; ++r) { gci[r] = __shfl(gcL, 16 * w + 4 * fq + r); bi[r] = __shfl(bL, 16 * w + 4 * fq + r); }
#pragma unroll
    for (int nt = 0; nt < 4; ++nt) {
      const int j = 16 * nt + fr;
      const float gcj = __shfl(gcL, j);
      const int p = 32 * (nt >> 1) + 8 * (fr >> 2) + 4 * (nt & 1) + (fr & 3);
      float av[4];
#pragma unroll
      for (int r = 0; r < 4; ++r) {
        const int i = 16 * w + 4 * fq + r;
        const float dec = (j <= i) ? __expf(gci[r] - gcj) : 0.f;
        av[r] = (j < i) ? bi[r] * aKK[nt][r] * dec : 0.f;
        ATT[((size_t)item * 64 + i) * 64 + p] = (bf16_t)f2bf(aQK[nt][r] * scale * dec);
      }
      *(float4*)(AT + j * 68 + 16 * w + 4 * fq) = make_float4(av[0], av[1], av[2], av[3]);
    }
  }
  __syncthreads();
  if (w == 0) {
    float Tr[64];
    int ln = lane; asm volatile("" : "+v"(ln));
#pragma unroll
    for (int j = 0; j < 64; ++j) Tr[j] = 0.f;
#pragma unroll
    for (int c = 63; c >= 0; --c) {
      float a0 = 0.f, a1 = 0.f, a2 = 0.f, a3 = 0.f;
#pragma unroll
      for (int j4 = 15; j4 >= (c + 1) / 4; --j4) {
        const float4 a = *(const float4*)(AT + c * 68 + j4 * 4);
        asm volatile("v_fmac_f32 %0, %1, %2" : "+v"(a0) : "v"(Tr[4 * j4 + 0]), "v"(a.x));
        asm volatile("v_fmac_f32 %0, %1, %2" : "+v"(a1) : "v"(Tr[4 * j4 + 1]), "v"(a.y));
        asm volatile("v_fmac_f32 %0, %1, %2" : "+v"(a2) : "v"(Tr[4 * j4 + 2]), "v"(a.z));
        asm volatile("v_fmac_f32 %0, %1, %2" : "+v"(a3) : "v"(Tr[4 * j4 + 3]), "v"(a.w));
      }
      Tr[c] = ((ln == c) ? 1.f : 0.f) - ((a0 + a1) + (a2 + a3));
    }
    uint4* tp = (uint4*)(TM + ((size_t)item * 64 + lane) * 64);
#pragma unroll
    for (int oc = 0; oc < 8; ++oc) {
      const int k0 = 32 * (oc >> 2) + 4 * (oc & 3);
      uint4 v;
      v.x = pack2(Tr[k0 + 0], Tr[k0 + 1]); v.y = pack2(Tr[k0 + 2], Tr[k0 + 3]);
      v.z = pack2(Tr[k0 + 16], Tr[k0 + 17]); v.w = pack2(Tr[k0 + 18], Tr[k0 + 19]);
      tp[oc] = v;
    }
  } else {
    const float gclast = __shfl(gcL, 63);
    if (tid == 64) GL[item] = __expf(gclast);
#pragma unroll 1
    for (int it = 0; it < 16; ++it) {
      const int idx = (tid - 64) + it * 192;
      const int mtx = idx >> 10, rem = idx & 1023;
      if (mtx < 2) {
        const int i = rem >> 4, oc = rem & 15;
        const float gi = __shfl(gcL, i), bi = __shfl(bL, i);
        const float f = (mtx == 0) ? scale * __expf(gi) : -bi * __expf(gi);
        const unsigned char* st = (mtx == 0) ? qs : ks;
        const int d0 = 32 * (oc >> 2) + 4 * (oc & 3);
        const uint2 lo = *(const uint2*)(st + i * 256 + ((((d0 >> 3) ^ (i & 15))) << 4) + (d0 & 7) * 2);
        const uint2 hi = *(const uint2*)(st + i * 256 + (((((d0 + 16) >> 3) ^ (i & 15))) << 4) + (d0 & 7) * 2);
        uint4 v;
        v.x = pack2(bflo(lo.x) * f, bfhi(lo.x) * f); v.y = pack2(bflo(lo.y) * f, bfhi(lo.y) * f);
        v.z = pack2(bflo(hi.x) * f, bfhi(hi.x) * f); v.w = pack2(bflo(hi.y) * f, bfhi(hi.y) * f);
        bf16_t* dst = ((mtx == 0) ? QD : W0N) + ((size_t)item * 64 + i) * 128 + 8 * oc;
        *(uint4*)dst = v;
      } else {
        const int d = rem & 127, oc = rem >> 7;
        const int j0 = 32 * (oc >> 2) + 4 * (oc & 3);
        float val[8];
#pragma unroll
        for (int e = 0; e < 8; ++e) {
          const int j = j0 + (e & 3) + ((e >> 2) << 4);
          const float f = __expf(gclast - __shfl(gcL, j));
          const unsigned short raw = *(const unsigned short*)(ks + j * 256 + ((((d >> 3) ^ (j & 15))) << 4) + (d & 7) * 2);
          val[e] = bf2f(raw) * f;
        }
        uint4 v;
        v.x = pack2(val[0], val[1]); v.y = pack2(val[2], val[3]); v.z = pack2(val[4], val[5]); v.w = pack2(val[6], val[7]);
        *(uint4*)(KTT + ((size_t)item * 128 + d) * 64 + 8 * oc) = v;
      }
    }
  }
  __syncthreads();
}

__device__ __forceinline__ void ph_dnscan(unsigned char* smem, int item, const bf16_t* __restrict__ QDp, const bf16_t* __restrict__ W0Np, const bf16_t* __restrict__ KTTp,
                                          const bf16_t* __restrict__ RVp, const bf16_t* __restrict__ TMp, const bf16_t* __restrict__ ATTp, const float* __restrict__ GLp,
                                          float* __restrict__ op) {
  const int tid = TIDX, lane = tid & 63, w = tid >> 6, fr = lane & 15, fq = lane >> 4;
  const int bh = item >> 1, half = item & 1, b = bh >> 2, h = bh & 3;
  const int vcol0 = (half * 4 + w) * 16;
  unsigned char* sW0 = smem; unsigned char* sQD = smem + 16384; unsigned char* sKT = smem + 32768; unsigned char* sT = smem + 49152; unsigned char* sAT = smem + 57344;
  f32x4 S[8];
#pragma unroll
  for (int t = 0; t < 8; ++t) S[t] = (f32x4){0.f, 0.f, 0.f, 0.f};
  u32x4 pf[8]; unsigned short rvp[16];
#define DN_LOAD_A(nn_) do { \
    const size_t ci = (size_t)bh * 64 + (nn_); \
    _Pragma("unroll") for (int i = 0; i < 4; ++i) pf[i] = *(const u32x4*)((const char*)W0Np + ci * 16384 + (size_t)(tid + 256 * i) * 16); \
    _Pragma("unroll") for (int i = 0; i < 4; ++i) pf[4 + i] = *(const u32x4*)((const char*)QDp + ci * 16384 + (size_t)(tid + 256 * i) * 16); \
    _Pragma("unroll") for (int mt = 0; mt < 4; ++mt) \
      _Pragma("unroll") for (int r = 0; r < 4; ++r) rvp[mt * 4 + r] = RVp[(ci * 64 + 16 * mt + 4 * fq + r) * 128 + vcol0 + fr]; \
  } while (0)
#define DN_STORE_A() do { \
    _Pragma("unroll") for (int i = 0; i < 4; ++i) { const int q = tid + 256 * i, row = q >> 4, ch = q & 15; *(u32x4*)(sW0 + row * 256 + ((ch ^ (row & 15)) << 4)) = pf[i]; } \
    _Pragma("unroll") for (int i = 0; i < 4; ++i) { const int q = tid + 256 * i, row = q >> 4, ch = q & 15; *(u32x4*)(sQD + row * 256 + ((ch ^ (row & 15)) << 4)) = pf[4 + i]; } \
  } while (0)
#define DN_LOAD_B(nn_) do { \
    const size_t ci = (size_t)bh * 64 + (nn_); \
    _Pragma("unroll") for (int i = 0; i < 4; ++i) pf[i] = *(const u32x4*)((const char*)KTTp + ci * 16384 + (size_t)(tid + 256 * i) * 16); \
    _Pragma("unroll") for (int i = 0; i < 2; ++i) pf[4 + i] = *(const u32x4*)((const char*)TMp + ci * 8192 + (size_t)(tid + 256 * i) * 16); \
    _Pragma("unroll") for (int i = 0; i < 2; ++i) pf[6 + i] = *(const u32x4*)((const char*)ATTp + ci * 8192 + (size_t)(tid + 256 * i) * 16); \
  } while (0)
#define DN_STORE_B() do { \
    _Pragma("unroll") for (int i = 0; i < 4; ++i) { const int q = tid + 256 * i, row = q >> 3, ch = q & 7; *(u32x4*)(sKT + row * 128 + ((ch ^ (row & 7)) << 4)) = pf[i]; } \
    _Pragma("unroll") for (int i = 0; i < 2; ++i) { const int q = tid + 256 * i, row = q >> 3, ch = q & 7; *(u32x4*)(sT + row * 128 + ((ch ^ (row & 7)) << 4)) = pf[4 + i]; } \
    _Pragma("unroll") for (int i = 0; i < 2; ++i) { const int q = tid + 256 * i, row = q >> 3, ch = q & 7; *(u32x4*)(sAT + row * 128 + ((ch ^ (row & 7)) << 4)) = pf[6 + i]; } \
  } while (0)
  __syncthreads();
  DN_LOAD_A(0);
  DN_STORE_A();
  for (int nn = 0; nn < 64; ++nn) {
    f32x4 Z[4];
#pragma unroll
    for (int mt = 0; mt < 4; ++mt) Z[mt] = (f32x4){bf2f(rvp[mt * 4 + 0]), bf2f(rvp[mt * 4 + 1]), bf2f(rvp[mt * 4 + 2]), bf2f(rvp[mt * 4 + 3])};
    const float gl = GLp[(size_t)bh * 64 + nn];
    DN_LOAD_B(nn);
    __syncthreads();
    bf16x8 Sb[4];
#pragma unroll
    for (int k4 = 0; k4 < 4; ++k4) Sb[k4] = pack8(S[2 * k4], S[2 * k4 + 1]);
    f32x4 O[4];
#pragma unroll
    for (int mt = 0; mt < 4; ++mt) {
      O[mt] = (f32x4){0.f, 0.f, 0.f, 0.f};
      const int row = 16 * mt + fr;
#pragma unroll
      for (int k4 = 0; k4 < 4; ++k4) {
        const int off = row * 256 + ((((k4 * 4 + fq) ^ fr)) << 4);
        const bf16x8 aw = *(const bf16x8*)(sW0 + off);
        const bf16x8 aq = *(const bf16x8*)(sQD + off);
        Z[mt] = __builtin_amdgcn_mfma_f32_16x16x32_bf16(aw, Sb[k4], Z[mt], 0, 0, 0);
        O[mt] = __builtin_amdgcn_mfma_f32_16x16x32_bf16(aq, Sb[k4], O[mt], 0, 0, 0);
      }
    }
    bf16x8 Zb[2];
    Zb[0] = pack8(Z[0], Z[1]); Zb[1] = pack8(Z[2], Z[3]);
    DN_STORE_B();
    if (nn + 1 < 64) DN_LOAD_A(nn + 1);
    __syncthreads();
    f32x4 Vn[4];
#pragma unroll
    for (int mt = 0; mt < 4; ++mt) {
      Vn[mt] = (f32x4){0.f, 0.f, 0.f, 0.f};
      const int row = 16 * mt + fr;
#pragma unroll
      for (int s = 0; s < 2; ++s) {
        if (s <= (mt >> 1)) {
          const bf16x8 at = *(const bf16x8*)(sT + row * 128 + ((((s * 4 + fq) ^ (row & 7))) << 4));
          Vn[mt] = __builtin_amdgcn_mfma_f32_16x16x32_bf16(at, Zb[s], Vn[mt], 0, 0, 0);
        }
      }
    }
    bf16x8 Vb[2];
    Vb[0] = pack8(Vn[0], Vn[1]); Vb[1] = pack8(Vn[2], Vn[3]);
#pragma unroll
    for (int mt = 0; mt < 4; ++mt) {
      const int row = 16 * mt + fr;
#pragma unroll
      for (int s = 0; s < 2; ++s) {
        if (s <= (mt >> 1)) {
          const bf16x8 aa = *(const bf16x8*)(sAT + row * 128 + ((((s * 4 + fq) ^ (row & 7))) << 4));
          O[mt] = __builtin_amdgcn_mfma_f32_16x16x32_bf16(aa, Vb[s], O[mt], 0, 0, 0);
        }
      }
      const size_t tok = (size_t)b * SEQ + nn * 64 + 16 * mt + 4 * fq;
#pragma unroll
      for (int r = 0; r < 4; ++r) op[(tok + r) * 512 + h * 128 + vcol0 + fr] = O[mt][r];
    }
#pragma unroll
    for (int t = 0; t < 8; ++t) {
      S[t] = S[t] * gl;
      const int row = 16 * t + fr;
#pragma unroll
      for (int s = 0; s < 2; ++s) {
        const bf16x8 ak = *(const bf16x8*)(sKT + row * 128 + ((((s * 4 + fq) ^ (row & 7))) << 4));
        S[t] = __builtin_amdgcn_mfma_f32_16x16x32_bf16(ak, Vb[s], S[t], 0, 0, 0);
      }
    }
    if (nn + 1 < 64) DN_STORE_A();
  }
  __syncthreads();
#undef DN_LOAD_A
#undef DN_STORE_A
#undef DN_LOAD_B
#undef DN_STORE_B
}

__device__ __forceinline__ void ph_dn_post(int n, const float* __restrict__ o, const bf16_t* __restrict__ proj, const float* __restrict__ dn_norm_g, bf16_t* __restrict__ mixed) {
  const int tid = TIDX, h = tid >> 6, lane = tid & 63;
  const float o0 = o[(size_t)n * 512 + h * 128 + lane], o1 = o[(size_t)n * 512 + h * 128 + 64 + lane];
  const float ss = wave_sum(o0 * o0 + o1 * o1);
  const float rn = rsqrtf(ss * (1.f / 128.f) + RMS_EPS);
  const float z0 = bf2f(proj[(size_t)n * PROJW + OFF_Z + h * 128 + lane]), z1 = bf2f(proj[(size_t)n * PROJW + OFF_Z + h * 128 + 64 + lane]);
  mixed[(size_t)n * DM + h * 128 + lane] = (bf16_t)f2bf(o0 * rn * dn_norm_g[lane] * siluf(z0));
  mixed[(size_t)n * DM + h * 128 + 64 + lane] = (bf16_t)f2bf(o1 * rn * dn_norm_g[64 + lane] * siluf(z1));
}

__device__ __forceinline__ void ph_swa_naive(int item, const bf16_t* __restrict__ proj, const float* __restrict__ sinks, bf16_t* __restrict__ mixed) {
  const int gid = item * 256 + TIDX;
  const int h = gid / NTOK, n = gid % NTOK, t = n % SEQ, kvh = h >> 2;
  float q[64], acc[64];
  {
    const uint4* qp = (const uint4*)(proj + (size_t)n * PROJW + OFF_SQ + h * 64);
#pragma unroll
    for (int c = 0; c < 8; ++c) {
      const uint4 w = qp[c];
      q[c * 8 + 0] = bflo(w.x); q[c * 8 + 1] = bfhi(w.x); q[c * 8 + 2] = bflo(w.y); q[c * 8 + 3] = bfhi(w.y);
      q[c * 8 + 4] = bflo(w.z); q[c * 8 + 5] = bfhi(w.z); q[c * 8 + 6] = bflo(w.w); q[c * 8 + 7] = bfhi(w.w);
    }
  }
#pragma unroll
  for (int d = 0; d < 64; ++d) acc[d] = 0.f;
  const float slope = exp2f(-(float)(h + 1));
  float mrun = sinks[h], l = 1.f;
  const int s0 = (t - 127 > 0) ? (t - 127) : 0;
  for (int s = s0; s <= t; ++s) {
    const size_t nk = (size_t)(n - (t - s));
    const uint4* kp = (const uint4*)(proj + nk * PROJW + OFF_SK + kvh * 64);
    float dot = 0.f;
#pragma unroll
    for (int c = 0; c < 8; ++c) {
      const uint4 w = kp[c];
      dot += q[c * 8 + 0] * bflo(w.x) + q[c * 8 + 1] * bfhi(w.x) + q[c * 8 + 2] * bflo(w.y) + q[c * 8 + 3] * bfhi(w.y)
           + q[c * 8 + 4] * bflo(w.z) + q[c * 8 + 5] * bfhi(w.z) + q[c * 8 + 6] * bflo(w.w) + q[c * 8 + 7] * bfhi(w.w);
    }
    const float sc = dot * 0.125f - slope * (float)(t - s);
    const float mn = fmaxf(mrun, sc);
    const float corr = __expf(mrun - mn), p = __expf(sc - mn);
    l = l * corr + p;
    const uint4* vp = (const uint4*)(proj + nk * PROJW + OFF_SV + kvh * 64);
#pragma unroll
    for (int c = 0; c < 8; ++c) {
      const uint4 w = vp[c];
      acc[c * 8 + 0] = acc[c * 8 + 0] * corr + p * bflo(w.x); acc[c * 8 + 1] = acc[c * 8 + 1] * corr + p * bfhi(w.x);
      acc[c * 8 + 2] = acc[c * 8 + 2] * corr + p * bflo(w.y); acc[c * 8 + 3] = acc[c * 8 + 3] * corr + p * bfhi(w.y);
      acc[c * 8 + 4] = acc[c * 8 + 4] * corr + p * bflo(w.z); acc[c * 8 + 5] = acc[c * 8 + 5] * corr + p * bfhi(w.z);
      acc[c * 8 + 6] = acc[c * 8 + 6] * corr + p * bflo(w.w); acc[c * 8 + 7] = acc[c * 8 + 7] * corr + p * bfhi(w.w);
    }
    mrun = mn;
  }
  const float inv = 1.f / l;
  uint4* op = (uint4*)(mixed + (size_t)n * DM + 512 + h * 64);
#pragma unroll
  for (int c = 0; c < 8; ++c) {
    uint4 w;
    w.x = pack2(acc[c * 8 + 0] * inv, acc[c * 8 + 1] * inv); w.y = pack2(acc[c * 8 + 2] * inv, acc[c * 8 + 3] * inv);
    w.z = pack2(acc[c * 8 + 4] * inv, acc[c * 8 + 5] * inv); w.w = pack2(acc[c * 8 + 6] * inv, acc[c * 8 + 7] * inv);
    op[c] = w;
  }
}

__device__ __forceinline__ void ph_wout(unsigned char* smem, int tile, const bf16_t* __restrict__ mixed, const float* __restrict__ w_out, const float* __restrict__ x, float* __restrict__ y1) {
  GEMM_IDS
  const int n0 = (tile & 7) * 128, m0 = (tile >> 3) * 128;
  LdRowBF16 al; al.init([&](int r) { return mixed + (size_t)(m0 + r) * DM; });
  LdColF32 bl; bl.init(w_out + n0 + 4 * (tid & 31), DM, true);
  f32x4 acc[4][4];
  gemm128(smem, al, bl, DM / 64, acc);
#pragma unroll
  for (int m = 0; m < 4; ++m)
#pragma unroll
    for (int n = 0; n < 4; ++n)
#pragma unroll
      for (int j = 0; j < 4; ++j) {
        const size_t idx = (size_t)(m0 + wr * 64 + m * 16 + fq * 4 + j) * DM + n0 + wc * 64 + n * 16 + fr;
        y1[idx] = ALPHA * x[idx] + acc[m][n][j];
      }
}

__device__ __forceinline__ void ph_ln1(int item, float* __restrict__ y, const float* __restrict__ gam, const float* __restrict__ bet, bf16_t* __restrict__ xbf) {
  const int row = item * 4 + (TIDX >> 6), lane = TIDX & 63;
  float4* p = (float4*)(y + (size_t)row * DM);
  float4 v[4]; float s = 0.f;
#pragma unroll
  for (int i = 0; i < 4; ++i) { v[i] = p[lane + i * 64]; s += v[i].x + v[i].y + v[i].z + v[i].w; }
  const float mu = wave_sum(s) * (1.f / DM);
  float q = 0.f;
#pragma unroll
  for (int i = 0; i < 4; ++i) { const float a = v[i].x - mu, b = v[i].y - mu, c = v[i].z - mu, d = v[i].w - mu; q += a * a + b * b + c * c + d * d; }
  const float rs = rsqrtf(wave_sum(q) * (1.f / DM) + LN_EPS);
#pragma unroll
  for (int i = 0; i < 4; ++i) {
    const float4 gg = ((const float4*)gam)[lane + i * 64], bb = ((const float4*)bet)[lane + i * 64];
    float4 r;
    r.x = (v[i].x - mu) * rs * gg.x + bb.x; r.y = (v[i].y - mu) * rs * gg.y + bb.y;
    r.z = (v[i].z - mu) * rs * gg.z + bb.z; r.w = (v[i].w - mu) * rs * gg.w + bb.w;
    p[lane + i * 64] = r;
    uint2 w; w.x = pack2(r.x, r.y); w.y = pack2(r.z, r.w);
    ((uint2*)(xbf + (size_t)row * DM))[lane + i * 64] = w;
  }
}

__device__ __forceinline__ void ph_router(unsigned char* smem, int tile, const bf16_t* __restrict__ xbf, const float* __restrict__ router_w, float* __restrict__ logits) {
  GEMM_IDS
  const int n0 = (tile & 1) * 128, m0 = (tile >> 1) * 128;
  LdRowBF16 al; al.init([&](int r) { return xbf + (size_t)(m0 + r) * DM; });
  LdColF32 bl; bl.init(router_w + n0 + 4 * (tid & 31), NEXP, true);
  f32x4 acc[4][4];
  gemm128(smem, al, bl, DM / 64, acc);
#pragma unroll
  for (int m = 0; m < 4; ++m)
#pragma unroll
    for (int n = 0; n < 4; ++n)
#pragma unroll
      for (int j = 0; j < 4; ++j)
        logits[(size_t)(m0 + wr * 64 + m * 16 + fq * 4 + j) * NEXP + n0 + wc * 64 + n * 16 + fr] = acc[m][n][j];
}

__device__ __forceinline__ void ph_route(int item, const float* __restrict__ logits, const float* __restrict__ router_bias, int* __restrict__ cnt, int* __restrict__ list, float* __restrict__ gates) {
  const int n = item * 4 + (TIDX >> 6), lane = TIDX & 63;
  const float4 lg = ((const float4*)(logits + (size_t)n * NEXP))[lane];
  const float4 rb = ((const float4*)router_bias)[lane];
  float sc[4] = {sigmoidf(lg.x), sigmoidf(lg.y), sigmoidf(lg.z), sigmoidf(lg.w)};
  float sel[4] = {sc[0] + rb.x, sc[1] + rb.y, sc[2] + rb.z, sc[3] + rb.w};
  float t1 = fmaxf(sel[0], sel[1]), t2 = fminf(sel[0], sel[1]);
  { const float a = sel[2]; if (a > t1) { t2 = t1; t1 = a; } else if (a > t2) t2 = a; }
  { const float a = sel[3]; if (a > t1) { t2 = t1; t1 = a; } else if (a > t2) t2 = a; }
#pragma unroll
  for (int o = 1; o < 8; o <<= 1) {
    const float b1 = __shfl_xor(t1, o), b2 = __shfl_xor(t2, o);
    const float n1 = fmaxf(t1, b1), n2 = fmaxf(fminf(t1, b1), fmaxf(t2, b2));
    t1 = n1; t2 = n2;
  }
  const float gs = t1 + t2;
  const int mygrp = lane >> 3;
  int rank = 0;
#pragma unroll
  for (int j = 0; j < 8; ++j) {
    const float o = __shfl(gs, j * 8);
    rank += (o > gs || (o == gs && j < mygrp)) ? 1 : 0;
  }
  const bool gsel = rank < 4;
  float cand[4];
#pragma unroll
  for (int i = 0; i < 4; ++i) cand[i] = gsel ? sel[i] : -INFINITY;
  float gsum = 0.f; float myg = 0.f; int mye = 0;
#pragma unroll 1
  for (int r = 0; r < TOPK; ++r) {
    float bv = cand[0]; int bi = 0;
#pragma unroll
    for (int i = 1; i < 4; ++i) if (cand[i] > bv) { bv = cand[i]; bi = i; }
    int be = lane * 4 + bi;
    float bs = (bi == 0) ? sc[0] : (bi == 1) ? sc[1] : (bi == 2) ? sc[2] : sc[3];
#pragma unroll
    for (int o = 1; o < 64; o <<= 1) {
      const float ov = __shfl_xor(bv, o); const int oe = __shfl_xor(be, o); const float os = __shfl_xor(bs, o);
      if (ov > bv || (ov == bv && oe < be)) { bv = ov; be = oe; bs = os; }
    }
    if ((be >> 2) == lane) {
      const int bi2 = be & 3;
      if (bi2 == 0) cand[0] = -INFINITY; else if (bi2 == 1) cand[1] = -INFINITY; else if (bi2 == 2) cand[2] = -INFINITY; else cand[3] = -INFINITY;
    }
    gsum += bs;
    if (lane == r) { myg = bs; mye = be; }
  }
  if (lane < TOPK) {
    const int slot = atomicAdd(&cnt[mye], 1);
    list[(size_t)mye * CAP + slot] = n * TOPK + lane;
    gates[(size_t)n * TOPK + lane] = myg / gsum * 2.5f;
  }
}

__device__ __forceinline__ int moe_build_prefix(const int* __restrict__ cnt, int* sscan) {
  const int tid = TIDX;
  const int c = cnt[tid];
  __syncthreads();
  sscan[tid] = (c + 127) >> 7;
  __syncthreads();
  for (int o = 1; o < 256; o <<= 1) {
    const int v = (tid >= o) ? sscan[tid - o] : 0;
    __syncthreads();
    sscan[tid] += v;
    __syncthreads();
  }
  return sscan[255];
}
__device__ __forceinline__ void moe_locate(const int* sscan, int total, int rtile, int& e, int& rt) {
  if (rtile >= total) { e = 256; rt = rtile - total; return; }
  int lo = 0, hi = 255;
  while (lo < hi) { const int mid = (lo + hi) >> 1; if (sscan[mid] > rtile) hi = mid; else lo = mid + 1; }
  e = lo; rt = rtile - (lo ? sscan[lo - 1] : 0);
}

__device__ __forceinline__ void ph_moe1(unsigned char* smem, int e, int rt, int ct, const bf16_t* __restrict__ xbf, const int* __restrict__ cnt, const int* __restrict__ list,
                                        const float* __restrict__ w_gate, const float* __restrict__ w_up,
                                        const float* __restrict__ sw_gate, const float* __restrict__ sw_up, bf16_t* __restrict__ hbuf) {
  int* sasg = (int*)(smem + SM_MISC + 2048);
  GEMM_IDS
  const int rows = (e < 256) ? cnt[e] : NTOK;
  if (tid < 128) {
    const int r = rt * 128 + tid;
    int a = -1;
    if (r < rows) a = (e < 256) ? list[(size_t)e * CAP + r] : (NA + r);
    sasg[tid] = a;
  }
  __syncthreads();
  LdRowBF16 al; al.init([&](int r) { const int a = sasg[r]; const int tok = (a < 0) ? 0 : (a < NA ? (a >> 3) : (a - NA)); return xbf + (size_t)tok * DM; });
  LdColF32 bl;
  {
    const int jj = 4 * (tid & 31);
    const int bwc = jj >> 6, bn = (jj >> 4) & 3;
    const int ff = ct * 64 + bwc * 32 + (bn >> 1) * 16 + (jj & 15);
    const float* W = (e < 256) ? ((bn & 1) ? w_up : w_gate) + (size_t)e * DM * EFF : ((bn & 1) ? sw_up : sw_gate);
    bl.init(W + ff, EFF, true);
  }
  f32x4 acc[4][4];
  gemm128(smem, al, bl, DM / 64, acc);
#pragma unroll
  for (int m = 0; m < 4; ++m)
#pragma unroll
    for (int pp = 0; pp < 2; ++pp)
#pragma unroll
      for (int j = 0; j < 4; ++j) {
        const int r = wr * 64 + m * 16 + fq * 4 + j;
        const int a = sasg[r];
        if (a >= 0) {
          const float gv = acc[m][2 * pp][j], uv = acc[m][2 * pp + 1][j];
          hbuf[(size_t)a * EFF + ct * 64 + wc * 32 + pp * 16 + fr] = (bf16_t)f2bf(siluf(gv) * uv);
        }
      }
  __syncthreads();
}

__device__ __forceinline__ void ph_moe2(unsigned char* smem, int e, int rt, int ct, const bf16_t* __restrict__ hbuf, const int* __restrict__ cnt, const int* __restrict__ list, const float* __restrict__ gates,
                                        const float* __restrict__ w_down, const float* __restrict__ sw_down, bf16_t* __restrict__ ybuf) {
  int* sasg = (int*)(smem + SM_MISC + 2048);
  float* sgate = (float*)(smem + SM_MISC + 2048 + 512);
  GEMM_IDS
  const int rows = (e < 256) ? cnt[e] : NTOK;
  const int n0 = ct * 128;
  if (tid < 128) {
    const int r = rt * 128 + tid;
    int a = -1;
    if (r < rows) a = (e < 256) ? list[(size_t)e * CAP + r] : (NA + r);
    sasg[tid] = a;
    sgate[tid] = (a >= 0 && a < NA) ? gates[a] : 1.f;
  }
  __syncthreads();
  LdRowBF16 al; al.init([&](int r) { const int a = sasg[r]; return hbuf + (size_t)(a < 0 ? 0 : a) * EFF; });
  LdColF32 bl; bl.init(((e < 256) ? w_down + (size_t)e * EFF * DM : sw_down) + n0 + 4 * (tid & 31), DM, true);
  f32x4 acc[4][4];
  gemm128(smem, al, bl, EFF / 64, acc);
#pragma unroll
  for (int m = 0; m < 4; ++m)
#pragma unroll
    for (int n = 0; n < 4; ++n)
#pragma unroll
      for (int j = 0; j < 4; ++j) {
        const int r = wr * 64 + m * 16 + fq * 4 + j;
        const int a = sasg[r];
        if (a >= 0) ybuf[(size_t)a * DM + n0 + wc * 64 + n * 16 + fr] = (bf16_t)f2bf(acc[m][n][j] * sgate[r]);
      }
  __syncthreads();
}

__device__ __forceinline__ void ph_final(int item, float* __restrict__ out, const bf16_t* __restrict__ ybuf, const float* __restrict__ gam, const float* __restrict__ bet) {
  const int row = item * 4 + (TIDX >> 6), lane = TIDX & 63;
  float4* p = (float4*)(out + (size_t)row * DM);
  float4 v[4]; float s = 0.f;
#pragma unroll
  for (int i = 0; i < 4; ++i) {
    float4 a = p[lane + i * 64];
    a.x *= ALPHA; a.y *= ALPHA; a.z *= ALPHA; a.w *= ALPHA;
#pragma unroll
    for (int k = 0; k < 9; ++k) {
      const size_t yr = (k < 8) ? ((size_t)row * 8 + k) : ((size_t)NA + row);
      const uint2 w = ((const uint2*)(ybuf + yr * DM))[lane + i * 64];
      a.x += bflo(w.x); a.y += bfhi(w.x); a.z += bflo(w.y); a.w += bfhi(w.y);
    }
    v[i] = a; s += a.x + a.y + a.z + a.w;
  }
  const float mu = wave_sum(s) * (1.f / DM);
  float q = 0.f;
#pragma unroll
  for (int i = 0; i < 4; ++i) { const float a = v[i].x - mu, b = v[i].y - mu, c = v[i].z - mu, d = v[i].w - mu; q += a * a + b * b + c * c + d * d; }
  const float rs = rsqrtf(wave_sum(q) * (1.f / DM) + LN_EPS);
#pragma unroll
  for (int i = 0; i < 4; ++i) {
    const float4 gg = ((const float4*)gam)[lane + i * 64], bb = ((const float4*)bet)[lane + i * 64];
    float4 r;
    r.x = (v[i].x - mu) * rs * gg.x + bb.x; r.y = (v[i].y - mu) * rs * gg.y + bb.y;
    r.z = (v[i].z - mu) * rs * gg.z + bb.z; r.w = (v[i].w - mu) * rs * gg.w + bb.w;
    p[lane + i * 64] = r;
  }
}

__global__ void __launch_bounds__(256, 2) mega(Params P) {
  __shared__ __attribute__((aligned(16))) unsigned char smem[SMEM_BYTES];
  cg::grid_group grid = cg::this_grid();
  const int bid = blockIdx.x, nblk = gridDim.x;
#define x (P.in[0])
#define w_in (P.in[1])
#define conv_w (P.in[2])
#define a_log (P.in[3])
#define dt_bias (P.in[4])
#define dn_norm_g (P.in[5])
#define sinks (P.in[6])
#define w_out (P.in[7])
#define ln1_g (P.in[8])
#define ln1_b (P.in[9])
#define router_w (P.in[10])
#define router_bias (P.in[11])
#define w_gate (P.in[12])
#define w_up (P.in[13])
#define w_down (P.in[14])
#define sw_gate (P.in[15])
#define sw_up (P.in[16])
#define sw_down (P.in[17])
#define ln2_g (P.in[18])
#define ln2_b (P.in[19])
#define out (P.out)
#define x1bf ((bf16_t*)(P.ws + WS_X1BF))
#define logits ((float*)(P.ws + WS_LOGIT))
#define list ((int*)(P.ws + WS_LIST))
#define gates ((float*)(P.ws + WS_GATES))
#define cnt ((int*)(P.ws + WS_CTRL))
#define mixed ((bf16_t*)(P.ws + WS_MIXED))
#define proj ((bf16_t*)(P.ws + WS_PROJ))
#define ba ((float*)(P.ws + WS_BA))
#define QD ((bf16_t*)(P.ws + WS_QD))
#define W0N ((bf16_t*)(P.ws + WS_W0N))
#define KTT ((bf16_t*)(P.ws + WS_KTT))
#define RV ((bf16_t*)(P.ws + WS_RV))
#define TM ((bf16_t*)(P.ws + WS_TM))
#define ATT ((bf16_t*)(P.ws + WS_ATT))
#define GL ((float*)(P.ws + WS_GL))
#define o ((float*)(P.ws + WS_O))
#define hbuf ((bf16_t*)(P.ws + WS_HBUF))
#define ybuf ((bf16_t*)(P.ws + WS_YBUF))
  for (int t = bid; t < 23 * (NTOK / 128); t += nblk) ph_proj(smem, t, x, w_in, proj, ba);
  grid.sync();
  for (int it = bid; it < 2048; it += nblk) ph_dnchunk(smem, it, proj, ba, conv_w, a_log, dt_bias, QD, W0N, KTT, RV, TM, ATT, GL);
  for (int it = bid; it < NTOK * 8 / 256; it += nblk) ph_swa_naive(it, proj, sinks, mixed);
  grid.sync();
  for (int it = bid; it < 64; it += nblk) ph_dnscan(smem, it, QD, W0N, KTT, RV, TM, ATT, GL, o);
  grid.sync();
  for (int n = bid; n < NTOK; n += nblk) ph_dn_post(n, o, proj, dn_norm_g, mixed);
  grid.sync();
  for (int t = bid; t < 8 * (NTOK / 128); t += nblk) ph_wout(smem, t, mixed, w_out, x, out);
  grid.sync();
  for (int it = bid; it < NTOK / 4; it += nblk) ph_ln1(it, out, ln1_g, ln1_b, x1bf);
  grid.sync();
  for (int t = bid; t < 2 * (NTOK / 128); t += nblk) ph_router(smem, t, x1bf, router_w, logits);
  grid.sync();
  for (int it = bid; it < NTOK / 4; it += nblk) ph_route(it, logits, router_bias, cnt, list, gates);
  grid.sync();
  int* sscan = (int*)(smem + SM_MISC);
  const int total = moe_build_prefix(cnt, sscan);
  const int ntile = total + NTOK / 128;
  for (int it = bid; it < ntile * 4; it += nblk) {
    int e, rt; moe_locate(sscan, total, it >> 2, e, rt);
    ph_moe1(smem, e, rt, it & 3, x1bf, cnt, list, w_gate, w_up, sw_gate, sw_up, hbuf);
  }
  grid.sync();
  for (int it = bid; it < ntile * 8; it += nblk) {
    int e, rt; moe_locate(sscan, total, it >> 3, e, rt);
    ph_moe2(smem, e, rt, it & 7, hbuf, cnt, list, gates, w_down, sw_down, ybuf);
  }
  grid.sync();
  for (int it = bid; it < NTOK / 4; it += nblk) ph_final(it, out, ybuf, ln2_g, ln2_b);
}

#undef x
#undef w_in
#undef conv_w
#undef a_log
#undef dt_bias
#undef dn_norm_g
#undef sinks
#undef w_out
#undef ln1_g
#undef ln1_b
#undef router_w
#undef router_bias
#undef w_gate
#undef w_up
#undef w_down
#undef sw_gate
#undef sw_up
#undef sw_down
#undef ln2_g
#undef ln2_b
#undef out
#undef x1bf
#undef logits
#undef list
#undef gates
#undef cnt
#undef mixed
#undef proj
#undef ba
#undef QD
#undef W0N
#undef KTT
#undef RV
#undef TM
#undef ATT
#undef GL
#undef o
#undef hbuf
#undef ybuf

extern "C" void kernel_launch(void* const* d_in, const int* in_sizes, int n_in, void* d_out, int out_size, void* d_ws, size_t ws_size, hipStream_t stream) {
  static int grid_blocks = 0;
  if (!grid_blocks) {
    int dev = 0, cus = 0, per_cu = 0;
    (void)hipGetDevice(&dev);
    (void)hipDeviceGetAttribute(&cus, hipDeviceAttributeMultiprocessorCount, dev);
    (void)hipOccupancyMaxActiveBlocksPerMultiprocessor(&per_cu, mega, 256, 0);
    if (per_cu > 2) per_cu = 2;
    if (per_cu < 1) per_cu = 1;
    grid_blocks = cus * per_cu;
  }
  Params p{};
  for (int i = 0; i < 20; ++i) p.in[i] = (const float*)d_in[i];
  p.out = (float*)d_out; p.ws = (char*)d_ws;
  (void)hipMemsetAsync((char*)d_ws + WS_CTRL, 0, 1024, stream);
  void* args[] = {&p};
  hipError_t e = hipLaunchCooperativeKernel((void*)mega, dim3(grid_blocks), dim3(256), args, 0, stream);
  if (e != hipSuccess) fprintf(stderr, "cooperative launch failed: %s (grid %d)\n", hipGetErrorString(e), grid_blocks);
}
```

```cpp
#include <hip/hip_runtime.h>
#include <hip/hip_cooperative_groups.h>
#include <stdint.h>
#include <stdio.h>
namespace cg = cooperative_groups;

typedef __attribute__((ext_vector_type(8))) short bf16x8;
typedef __attribute__((ext_vector_type(4))) float f32x4;
typedef unsigned short bf16_t;
typedef __attribute__((ext_vector_type(4))) unsigned u32x4;
typedef __attribute__((ext_vector_type(2))) unsigned u32x2;

constexpr int NTOK = 32768, SEQ = 4096, DM = 1024;
constexpr int INC = 2824, PROJW = 2816;
constexpr int OFF_DQ = 0, OFF_DK = 512, OFF_DV = 1024, OFF_SQ = 1536, OFF_SK = 2048, OFF_SV = 2176, OFF_Z = 2304;
constexpr int NEXP = 256, TOPK = 8, EFF = 256;
constexpr int NA = NTOK * TOPK;
constexpr int CAP = NTOK;
constexpr float ALPHA = 1.189207115002721f;
constexpr float LN_EPS = 1e-5f, RMS_EPS = 1e-6f, L2_EPS = 1e-6f;

constexpr size_t MiB = 1024ull * 1024ull;
constexpr size_t WS_X1BF = 0;
constexpr size_t WS_LOGIT = 64 * MiB;
constexpr size_t WS_LIST = 96 * MiB;
constexpr size_t WS_GATES = 128 * MiB;
constexpr size_t WS_CTRL = 129 * MiB;
constexpr size_t WS_MIXED = 130 * MiB;
constexpr size_t WS_PROJ = 200 * MiB;
constexpr size_t WS_BA = 376 * MiB;
constexpr size_t WS_QD = 377 * MiB;
constexpr size_t WS_W0N = 409 * MiB;
constexpr size_t WS_KTT = 441 * MiB;
constexpr size_t WS_RV = 473 * MiB;
constexpr size_t WS_TM = 505 * MiB;
constexpr size_t WS_ATT = 521 * MiB;
constexpr size_t WS_GL = 537 * MiB;
constexpr size_t WS_O = 538 * MiB;
constexpr size_t WS_HBUF = 200 * MiB;
constexpr size_t WS_YBUF = 344 * MiB;

__device__ __forceinline__ int opaque_tid() { int t = threadIdx.x; asm volatile("" : "+v"(t)); return t; }
#define TIDX opaque_tid()
typedef __attribute__((ext_vector_type(2))) __bf16 hwbf16x2;
typedef __attribute__((ext_vector_type(2))) float hwf32x2;
__device__ __forceinline__ unsigned pack2(float lo, float hi) {
  hwf32x2 f = {lo, hi};
  return __builtin_bit_cast(unsigned, __builtin_convertvector(f, hwbf16x2));
}
__device__ __forceinline__ unsigned f2bf(float f) { return pack2(f, 0.f) & 0xffffu; }
__device__ __forceinline__ float bf2f(unsigned h) { return __uint_as_float(h << 16); }
__device__ __forceinline__ float bflo(unsigned w) { return __uint_as_float(w << 16); }
__device__ __forceinline__ float bfhi(unsigned w) { return __uint_as_float(w & 0xffff0000u); }
__device__ __forceinline__ float siluf(float x) { return x / (1.f + __expf(-x)); }
__device__ __forceinline__ float sigmoidf(float x) { return 1.f / (1.f + __expf(-x)); }
__device__ __forceinline__ float wave_sum(float v) {
#pragma unroll
  for (int o = 32; o > 0; o >>= 1) v += __shfl_xor(v, o);
  return v;
}

struct LdRowF32 {
  const char* p[8]; f32x4 r[8]; int row0, ch4;
  template <class F> __device__ __forceinline__ void init(F rowptr) {
    const int tid = TIDX; ch4 = tid & 15; row0 = tid >> 4;
#pragma unroll
    for (int i = 0; i < 8; ++i) p[i] = (const char*)rowptr(row0 + i * 16) + ch4 * 16;
  }
  __device__ __forceinline__ void load(int kt) {
#pragma unroll
    for (int i = 0; i < 8; ++i) r[i] = *(const f32x4*)(p[i] + (size_t)kt * 256);
  }
  __device__ __forceinline__ void store(unsigned char* s) {
#pragma unroll
    for (int i = 0; i < 8; ++i) {
      const int row = row0 + i * 16;
      u32x2 w; w[0] = pack2(r[i][0], r[i][1]); w[1] = pack2(r[i][2], r[i][3]);
      *(u32x2*)(s + row * 128 + ((((ch4 >> 1) ^ (row & 7))) << 4) + (ch4 & 1) * 8) = w;
    }
  }
};
struct LdRowBF16 {
  const char* p[4]; u32x4 r[4]; int row0, ch;
  template <class F> __device__ __forceinline__ void init(F rowptr) {
    const int tid = TIDX; ch = tid & 7; row0 = tid >> 3;
#pragma unroll
    for (int i = 0; i < 4; ++i) p[i] = (const char*)rowptr(row0 + i * 32) + ch * 16;
  }
  __device__ __forceinline__ void load(int kt) {
#pragma unroll
    for (int i = 0; i < 4; ++i) r[i] = *(const u32x4*)(p[i] + (size_t)kt * 128);
  }
  __device__ __forceinline__ void store(unsigned char* s) {
#pragma unroll
    for (int i = 0; i < 4; ++i) {
      const int row = row0 + i * 32;
      *(u32x4*)(s + row * 128 + ((ch ^ (row & 7)) << 4)) = r[i];
    }
  }
};
struct LdColF32 {
  const char* p; size_t ldb; f32x4 r[8]; int n4, kg; bool valid;
  __device__ __forceinline__ void init(const float* colptr, size_t ld, bool v) {
    const int tid = TIDX; n4 = tid & 31; kg = tid >> 5; ldb = ld * 4; valid = v;
    p = (const char*)colptr + (size_t)(kg * 8) * ldb;
  }
  __device__ __forceinline__ void load(int kt) {
#pragma unroll
    for (int j = 0; j < 8; ++j) {
      if (valid) r[j] = *(const f32x4*)(p + (size_t)(kt * 64 + j) * ldb);
      else r[j] = (f32x4){0.f, 0.f, 0.f, 0.f};
    }
  }
  __device__ __forceinline__ void store(unsigned char* s) {
    {
      const int row = n4 * 4 + 0; u32x4 w;
      w[0] = pack2(r[0][0], r[1][0]); w[1] = pack2(r[2][0], r[3][0]); w[2] = pack2(r[4][0], r[5][0]); w[3] = pack2(r[6][0], r[7][0]);
      *(u32x4*)(s + row * 128 + ((kg ^ (row & 7)) << 4)) = w;
    }
    {
      const int row = n4 * 4 + 1; u32x4 w;
      w[0] = pack2(r[0][1], r[1][1]); w[1] = pack2(r[2][1], r[3][1]); w[2] = pack2(r[4][1], r[5][1]); w[3] = pack2(r[6][1], r[7][1]);
      *(u32x4*)(s + row * 128 + ((kg ^ (row & 7)) << 4)) = w;
    }
    {
      const int row = n4 * 4 + 2; u32x4 w;
      w[0] = pack2(r[0][2], r[1][2]); w[1] = pack2(r[2][2], r[3][2]); w[2] = pack2(r[4][2], r[5][2]); w[3] = pack2(r[6][2], r[7][2]);
      *(u32x4*)(s + row * 128 + ((kg ^ (row & 7)) << 4)) = w;
    }
    {
      const int row = n4 * 4 + 3; u32x4 w;
      w[0] = pack2(r[0][3], r[1][3]); w[1] = pack2(r[2][3], r[3][3]); w[2] = pack2(r[4][3], r[5][3]); w[3] = pack2(r[6][3], r[7][3]);
      *(u32x4*)(s + row * 128 + ((kg ^ (row & 7)) << 4)) = w;
    }
  }
};

template <class AL, class BL>
__device__ __forceinline__ void gemm128(unsigned char* smem, AL& al, BL& bl, int nk, f32x4 (&acc)[4][4]) {
  const int tid = TIDX, lane = tid & 63, wid = tid >> 6, wr = wid >> 1, wc = wid & 1, fr = lane & 15, fq = lane >> 4;
  unsigned char* sA = smem; unsigned char* sB = smem + 16384;
#pragma unroll
  for (int m = 0; m < 4; ++m)
#pragma unroll
    for (int n = 0; n < 4; ++n) acc[m][n] = (f32x4){0.f, 0.f, 0.f, 0.f};
  al.load(0); bl.load(0);
  for (int kt = 0; kt < nk; ++kt) {
    __syncthreads();
    al.store(sA); bl.store(sB);
    __syncthreads();
    if (kt + 1 < nk) { al.load(kt + 1); bl.load(kt + 1); }
#pragma unroll
    for (int ks = 0; ks < 2; ++ks) {
      bf16x8 a[4], b[4];
#pragma unroll
      for (int m = 0; m < 4; ++m) {
        const int row = wr * 64 + m * 16 + fr;
        a[m] = *(const bf16x8*)(sA + row * 128 + (((ks * 4 + fq) ^ (row & 7)) << 4));
      }
#pragma unroll
      for (int n = 0; n < 4; ++n) {
        const int row = wc * 64 + n * 16 + fr;
        b[n] = *(const bf16x8*)(sB + row * 128 + (((ks * 4 + fq) ^ (row & 7)) << 4));
      }
#pragma unroll
      for (int m = 0; m < 4; ++m)
#pragma unroll
        for (int n = 0; n < 4; ++n) acc[m][n] = __builtin_amdgcn_mfma_f32_16x16x32_bf16(a[m], b[n], acc[m][n], 0, 0, 0);
    }
  }
  __syncthreads();
}

#define GEMM_IDS const int tid = TIDX, lane = tid & 63, wid = tid >> 6, wr = wid >> 1, wc = wid & 1, fr = lane & 15, fq = lane >> 4; (void)tid; (void)lane;

struct Params {
  const float* in[20];
  float* out;
  char* ws;
};

constexpr int SMEM_BYTES = 69632;
constexpr int SM_MISC = 65536;

__device__ __forceinline__ void ph_proj(unsigned char* smem, int tile, const float* __restrict__ x, const float* __restrict__ w_in, bf16_t* __restrict__ proj, float* __restrict__ ba) {
  GEMM_IDS
  const int n0 = (tile % 23) * 128, m0 = (tile / 23) * 128;
  LdRowF32 al; al.init([&](int r) { return x + (size_t)(m0 + r) * DM; });
  LdColF32 bl; { const int col = n0 + 4 * (tid & 31); const bool v = col < INC; bl.init(w_in + (v ? col : 0), INC, v); }
  f32x4 acc[4][4];
  gemm128(smem, al, bl, DM / 64, acc);
#pragma unroll
  for (int m = 0; m < 4; ++m)
#pragma unroll
    for (int n = 0; n < 4; ++n)
#pragma unroll
      for (int j = 0; j < 4; ++j) {
        const int row = m0 + wr * 64 + m * 16 + fq * 4 + j, col = n0 + wc * 64 + n * 16 + fr;
        if (col < PROJW) proj[(size_t)row * PROJW + col] = (bf16_t)f2bf(acc[m][n][j]);
        else if (col < INC) ba[(size_t)row * 8 + (col - PROJW)] = acc[m][n][j];
      }
}

__device__ __forceinline__ bf16x8 pack8(f32x4 a, f32x4 b) {
  union { bf16x8 v; unsigned u[4]; } x;
  x.u[0] = pack2(a[0], a[1]); x.u[1] = pack2(a[2], a[3]); x.u[2] = pack2(b[0], b[1]); x.u[3] = pack2(b[2], b[3]);
  return x.v;
}
__device__ __forceinline__ void ph_dnchunk(unsigned char* smem, int item, const bf16_t* __restrict__ proj, const float* __restrict__ ba, const float* __restrict__ conv_w,
                                           const float* __restrict__ a_log, const float* __restrict__ dt_bias,
                                           bf16_t* __restrict__ QD, bf16_t* __restrict__ W0N, bf16_t* __restrict__ KTT, bf16_t* __restrict__ RV,
                                           bf16_t* __restrict__ TM, bf16_t* __restrict__ ATT, float* __restrict__ GL) {
  const int tid = TIDX, lane = tid & 63, w = tid >> 6, fr = lane & 15, fq = lane >> 4;
  const int n = item & 63, h = (item >> 6) & 3, b = item >> 8;
  const int t0 = n * 64; const size_t row0 = (size_t)b * SEQ + t0;
  unsigned char* qs = smem; unsigned char* ks = smem + 16384; float* AT = (float*)(smem + 32768);
  const float scale = 0.08838834764831845f;
  float bL, gcL;
  {
    const float* bap = ba + (row0 + lane) * 8;
    bL = sigmoidf(bap[h]);
    const float xx = bap[4 + h] + dt_bias[h];
    const float sp = fmaxf(xx, 0.f) + log1pf(__expf(-fabsf(xx)));
    float gg = -__expf(a_log[h]) * sp;
#pragma unroll
    for (int o = 1; o < 64; o <<= 1) { const float v = __shfl_up(gg, o); if (lane >= o) gg += v; }
    gcL = gg;
  }
  {
    const int d = 2 * lane;
    float cw[3][4][2], xw[3][4][2];
#pragma unroll
    for (int mx = 0; mx < 3; ++mx)
#pragma unroll
      for (int j = 0; j < 4; ++j) {
        const float2 c2 = *(const float2*)(conv_w + j * 1536 + mx * 512 + h * 128 + d);
        cw[mx][j][0] = c2.x; cw[mx][j][1] = c2.y;
      }
    const bf16_t* pbase = proj + (row0 + 16 * w) * PROJW + h * 128 + d;
#pragma unroll
    for (int j = 0; j < 3; ++j) {
      const bool ok = (t0 + 16 * w - 3 + j) >= 0;
#pragma unroll
      for (int mx = 0; mx < 3; ++mx) {
        unsigned u = 0;
        if (ok) u = *(const unsigned*)(pbase + (ptrdiff_t)(j - 3) * PROJW + mx * 512);
        xw[mx][j + 1][0] = bflo(u); xw[mx][j + 1][1] = bfhi(u);
      }
    }
#pragma unroll
    for (int i = 0; i < 16; ++i) {
      float s[3][2];
#pragma unroll
      for (int mx = 0; mx < 3; ++mx) {
        const unsigned u = *(const unsigned*)(pbase + (size_t)i * PROJW + mx * 512);
#pragma unroll
        for (int j = 0; j < 3; ++j) { xw[mx][j][0] = xw[mx][j + 1][0]; xw[mx][j][1] = xw[mx][j + 1][1]; }
        xw[mx][3][0] = bflo(u); xw[mx][3][1] = bfhi(u);
        float y0 = 0.f, y1 = 0.f;
#pragma unroll
        for (int j = 0; j < 4; ++j) { y0 += cw[mx][j][0] * xw[mx][j][0]; y1 += cw[mx][j][1] * xw[mx][j][1]; }
        s[mx][0] = siluf(y0); s[mx][1] = siluf(y1);
      }
      const int row = 16 * w + i;
      const float rq = rsqrtf(wave_sum(s[0][0] * s[0][0] + s[0][1] * s[0][1]) + L2_EPS);
      const float rk = rsqrtf(wave_sum(s[1][0] * s[1][0] + s[1][1] * s[1][1]) + L2_EPS);
      const int off = row * 256 + ((((lane >> 2) ^ (row & 15))) << 4) + (lane & 3) * 4;
      *(unsigned*)(qs + off) = pack2(s[0][0] * rq, s[0][1] * rq);
      *(unsigned*)(ks + off) = pack2(s[1][0] * rk, s[1][1] * rk);
      const float bi = __shfl(bL, row);
      *(unsigned*)(RV + ((size_t)item * 64 + row) * 128 + d) = pack2(bi * s[2][0], bi * s[2][1]);
    }
  }
  __syncthreads();
  {
    f32x4 aKK[4], aQK[4];
#pragma unroll
    for (int nt = 0; nt < 4; ++nt) { aKK[nt] = (f32x4){0.f, 0.f, 0.f, 0.f}; aQK[nt] = (f32x4){0.f, 0.f, 0.f, 0.f}; }
#pragma unroll
    for (int k4 = 0; k4 < 4; ++k4) {
      const int arow = 16 * w + fr;
      const bf16x8 aq = *(const bf16x8*)(qs + arow * 256 + ((((k4 * 4 + fq) ^ (arow & 15))) << 4));
      const bf16x8 ak = *(const bf16x8*)(ks + arow * 256 + ((((k4 * 4 + fq) ^ (arow & 15))) << 4));
#pragma unroll
      for (int nt = 0; nt < 4; ++nt) {
        const int brow = 16 * nt + fr;
        const bf16x8 bk = *(const bf16x8*)(ks + brow * 256 + ((((k4 * 4 + fq) ^ (brow & 15))) << 4));
        aKK[nt] = __builtin_amdgcn_mfma_f32_16x16x32_bf16(ak, bk, aKK[nt], 0, 0, 0);
        aQK[nt] = __builtin_amdgcn_mfma_f32_16x16x32_bf16(aq, bk, aQK[nt], 0, 0, 0);
      }
    }
    float gci[4], bi[4];
#pragma unroll
    for (int r = 0; r < 4; ++r) { gci[r] = __shfl(gcL, 16 * w + 4 * fq + r); bi[r] = __shfl(bL, 16 * w + 4 * fq + r); }
#pragma unroll
    for (int nt = 0; nt < 4; ++nt) {
      const int j = 16 * nt + fr;
      const float gcj = __shfl(gcL, j);
      const int p = 32 * (nt >> 1) + 8 * (fr >> 2) + 4 * (nt & 1) + (fr & 3);
      float av[4];
#pragma unroll
      for (int r = 0; r < 4; ++r) {
        const int i = 16 * w + 4 * fq + r;
        const float dec = (j <= i) ? __expf(gci[r] - gcj) : 0.f;
        av[r] = (j < i) ? bi[r] * aKK[nt][r] * dec : 0.f;
        ATT[((size_t)item * 64 + i) * 64 + p] = (bf16_t)f2bf(aQK[nt][r] * scale * dec);
      }
      *(float4*)(AT + j * 68 + 16 * w + 4 * fq) = make_float4(av[0], av[1], av[2], av[3]);
    }
  }
  __syncthreads();
  if (w == 0) {
    float Tr[64];
    int ln = lane; asm volatile("" : "+v"(ln));
#pragma unroll
    for (int j = 0; j < 64; ++j) Tr[j] = 0.f;
#pragma unroll
    for (int c = 63; c >= 0; --c) {
      float a0 = 0.f, a1 = 0.f, a2 = 0.f, a3 = 0.f;
#pragma unroll
      for (int j4 = 15; j4 >= (c + 1) / 4; --j4) {
        const float4 a = *(const float4*)(AT + c * 68 + j4 * 4);
        asm volatile("v_fmac_f32 %0, %1, %2" : "+v"(a0) : "v"(Tr[4 * j4 + 0]), "v"(a.x));
        asm volatile("v_fmac_f32 %0, %1, %2" : "+v"(a1) : "v"(Tr[4 * j4 + 1]), "v"(a.y));
        asm volatile("v_fmac_f32 %0, %1, %2" : "+v"(a2) : "v"(Tr[4 * j4 + 2]), "v"(a.z));
        asm volatile("v_fmac_f32 %0, %1, %2" : "+v"(a3) : "v"(Tr[4 * j4 + 3]), "v"(a.w));
      }
      Tr[c] = ((ln == c) ? 1.f : 0.f) - ((a0 + a1) + (a2 + a3));
    }
    u32x4* tp = (u32x4*)(TM + ((size_t)item * 64 + lane) * 64);
#pragma unroll
    for (int oc = 0; oc < 8; ++oc) {
      const int k0 = 32 * (oc >> 2) + 4 * (oc & 3);
      u32x4 v;
      v[0] = pack2(Tr[k0 + 0], Tr[k0 + 1]); v[1] = pack2(Tr[k0 + 2], Tr[k0 + 3]);
      v[2] = pack2(Tr[k0 + 16], Tr[k0 + 17]); v[3] = pack2(Tr[k0 + 18], Tr[k0 + 19]);
      tp[oc] = v;
    }
  } else {
    const float gclast = __shfl(gcL, 63);
    if (tid == 64) GL[item] = __expf(gclast);
#pragma unroll 1
    for (int it = 0; it < 16; ++it) {
      const int idx = (tid - 64) + it * 192;
      const int mtx = idx >> 10, rem = idx & 1023;
      if (mtx < 2) {
        const int i = rem >> 4, oc = rem & 15;
        const float gi = __shfl(gcL, i), bi = __shfl(bL, i);
        const float f = (mtx == 0) ? scale * __expf(gi) : -bi * __expf(gi);
        const unsigned char* st = (mtx == 0) ? qs : ks;
        const int d0 = 32 * (oc >> 2) + 4 * (oc & 3);
        const uint2 lo = *(const uint2*)(st + i * 256 + ((((d0 >> 3) ^ (i & 15))) << 4) + (d0 & 7) * 2);
        const uint2 hi = *(const uint2*)(st + i * 256 + (((((d0 + 16) >> 3) ^ (i & 15))) << 4) + (d0 & 7) * 2);
        u32x4 v;
        v[0] = pack2(bflo(lo.x) * f, bfhi(lo.x) * f); v[1] = pack2(bflo(lo.y) * f, bfhi(lo.y) * f);
        v[2] = pack2(bflo(hi.x) * f, bfhi(hi.x) * f); v[3] = pack2(bflo(hi.y) * f, bfhi(hi.y) * f);
        bf16_t* dst = ((mtx == 0) ? QD : W0N) + ((size_t)item * 64 + i) * 128 + 8 * oc;
        *(u32x4*)dst = v;
      } else {
        const int d = rem & 127, oc = rem >> 7;
        const int j0 = 32 * (oc >> 2) + 4 * (oc & 3);
        float val[8];
#pragma unroll
        for (int e = 0; e < 8; ++e) {
          const int j = j0 + (e & 3) + ((e >> 2) << 4);
          const float f = __expf(gclast - __shfl(gcL, j));
          const unsigned short raw = *(const unsigned short*)(ks + j * 256 + ((((d >> 3) ^ (j & 15))) << 4) + (d & 7) * 2);
          val[e] = bf2f(raw) * f;
        }
        u32x4 v;
        v[0] = pack2(val[0], val[1]); v[1] = pack2(val[2], val[3]); v[2] = pack2(val[4], val[5]); v[3] = pack2(val[6], val[7]);
        *(u32x4*)(KTT + ((size_t)item * 128 + d) * 64 + 8 * oc) = v;
      }
    }
  }
  __syncthreads();
}

__device__ __forceinline__ void ph_dnscan(unsigned char* smem, int item, const bf16_t* __restrict__ QDp, const bf16_t* __restrict__ W0Np, const bf16_t* __restrict__ KTTp,
                                          const bf16_t* __restrict__ RVp, const bf16_t* __restrict__ TMp, const bf16_t* __restrict__ ATTp, const float* __restrict__ GLp,
                                          float* __restrict__ op) {
  const int tid = TIDX, lane = tid & 63, w = tid >> 6, fr = lane & 15, fq = lane >> 4;
  const int bh = item >> 1, half = item & 1, b = bh >> 2, h = bh & 3;
  const int vcol0 = (half * 4 + w) * 16;
  unsigned char* sW0 = smem; unsigned char* sQD = smem + 16384; unsigned char* sKT = smem + 32768; unsigned char* sT = smem + 49152; unsigned char* sAT = smem + 57344;
  f32x4 S[8];
#pragma unroll
  for (int t = 0; t < 8; ++t) S[t] = (f32x4){0.f, 0.f, 0.f, 0.f};
  u32x4 pf[8]; unsigned short rvp[16];
#define DN_LOAD_A(nn_) do { \
    const size_t ci = (size_t)bh * 64 + (nn_); \
    _Pragma("unroll") for (int i = 0; i < 4; ++i) pf[i] = *(const u32x4*)((const char*)W0Np + ci * 16384 + (size_t)(tid + 256 * i) * 16); \
    _Pragma("unroll") for (int i = 0; i < 4; ++i) pf[4 + i] = *(const u32x4*)((const char*)QDp + ci * 16384 + (size_t)(tid + 256 * i) * 16); \
    _Pragma("unroll") for (int mt = 0; mt < 4; ++mt) \
      _Pragma("unroll") for (int r = 0; r < 4; ++r) rvp[mt * 4 + r] = RVp[(ci * 64 + 16 * mt + 4 * fq + r) * 128 + vcol0 + fr]; \
  } while (0)
#define DN_STORE_A() do { \
    _Pragma("unroll") for (int i = 0; i < 4; ++i) { const int q = tid + 256 * i, row = q >> 4, ch = q & 15; *(u32x4*)(sW0 + row * 256 + ((ch ^ (row & 15)) << 4)) = pf[i]; } \
    _Pragma("unroll") for (int i = 0; i < 4; ++i) { const int q = tid + 256 * i, row = q >> 4, ch = q & 15; *(u32x4*)(sQD + row * 256 + ((ch ^ (row & 15)) << 4)) = pf[4 + i]; } \
  } while (0)
#define DN_LOAD_B(nn_) do { \
    const size_t ci = (size_t)bh * 64 + (nn_); \
    _Pragma("unroll") for (int i = 0; i < 4; ++i) pf[i] = *(const u32x4*)((const char*)KTTp + ci * 16384 + (size_t)(tid + 256 * i) * 16); \
    _Pragma("unroll") for (int i = 0; i < 2; ++i) pf[4 + i] = *(const u32x4*)((const char*)TMp + ci * 8192 + (size_t)(tid + 256 * i) * 16); \
    _Pragma("unroll") for (int i = 0; i < 2; ++i) pf[6 + i] = *(const u32x4*)((const char*)ATTp + ci * 8192 + (size_t)(tid + 256 * i) * 16); \
  } while (0)
#define DN_STORE_B() do { \
    _Pragma("unroll") for (int i = 0; i < 4; ++i) { const int q = tid + 256 * i, row = q >> 3, ch = q & 7; *(u32x4*)(sKT + row * 128 + ((ch ^ (row & 7)) << 4)) = pf[i]; } \
    _Pragma("unroll") for (int i = 0; i < 2; ++i) { const int q = tid + 256 * i, row = q >> 3, ch = q & 7; *(u32x4*)(sT + row * 128 + ((ch ^ (row & 7)) << 4)) = pf[4 + i]; } \
    _Pragma("unroll") for (int i = 0; i < 2; ++i) { const int q = tid + 256 * i, row = q >> 3, ch = q & 7; *(u32x4*)(sAT + row * 128 + ((ch ^ (row & 7)) << 4)) = pf[6 + i]; } \
  } while (0)
  __syncthreads();
  DN_LOAD_A(0);
  DN_STORE_A();
  for (int nn = 0; nn < 64; ++nn) {
    f32x4 Z[4];
#pragma unroll
    for (int mt = 0; mt < 4; ++mt) Z[mt] = (f32x4){bf2f(rvp[mt * 4 + 0]), bf2f(rvp[mt * 4 + 1]), bf2f(rvp[mt * 4 + 2]), bf2f(rvp[mt * 4 + 3])};
    const float gl = GLp[(size_t)bh * 64 + nn];
    DN_LOAD_B(nn);
    __syncthreads();
    bf16x8 Sb[4];
#pragma unroll
    for (int k4 = 0; k4 < 4; ++k4) Sb[k4] = pack8(S[2 * k4], S[2 * k4 + 1]);
    f32x4 O[4];
#pragma unroll
    for (int mt = 0; mt < 4; ++mt) {
      O[mt] = (f32x4){0.f, 0.f, 0.f, 0.f};
      const int row = 16 * mt + fr;
#pragma unroll
      for (int k4 = 0; k4 < 4; ++k4) {
        const int off = row * 256 + ((((k4 * 4 + fq) ^ fr)) << 4);
        const bf16x8 aw = *(const bf16x8*)(sW0 + off);
        const bf16x8 aq = *(const bf16x8*)(sQD + off);
        Z[mt] = __builtin_amdgcn_mfma_f32_16x16x32_bf16(aw, Sb[k4], Z[mt], 0, 0, 0);
        O[mt] = __builtin_amdgcn_mfma_f32_16x16x32_bf16(aq, Sb[k4], O[mt], 0, 0, 0);
      }
    }
    bf16x8 Zb[2];
    Zb[0] = pack8(Z[0], Z[1]); Zb[1] = pack8(Z[2], Z[3]);
    DN_STORE_B();
    if (nn + 1 < 64) DN_LOAD_A(nn + 1);
    __syncthreads();
    f32x4 Vn[4];
#pragma unroll
    for (int mt = 0; mt < 4; ++mt) {
      Vn[mt] = (f32x4){0.f, 0.f, 0.f, 0.f};
      const int row = 16 * mt + fr;
#pragma unroll
      for (int s = 0; s < 2; ++s) {
        if (s <= (mt >> 1)) {
          const bf16x8 at = *(const bf16x8*)(sT + row * 128 + ((((s * 4 + fq) ^ (row & 7))) << 4));
          Vn[mt] = __builtin_amdgcn_mfma_f32_16x16x32_bf16(at, Zb[s], Vn[mt], 0, 0, 0);
        }
      }
    }
    bf16x8 Vb[2];
    Vb[0] = pack8(Vn[0], Vn[1]); Vb[1] = pack8(Vn[2], Vn[3]);
#pragma unroll
    for (int mt = 0; mt < 4; ++mt) {
      const int row = 16 * mt + fr;
#pragma unroll
      for (int s = 0; s < 2; ++s) {
        if (s <= (mt >> 1)) {
          const bf16x8 aa = *(const bf16x8*)(sAT + row * 128 + ((((s * 4 + fq) ^ (row & 7))) << 4));
          O[mt] = __builtin_amdgcn_mfma_f32_16x16x32_bf16(aa, Vb[s], O[mt], 0, 0, 0);
        }
      }
      const size_t tok = (size_t)b * SEQ + nn * 64 + 16 * mt + 4 * fq;
#pragma unroll
      for (int r = 0; r < 4; ++r) op[(tok + r) * 512 + h * 128 + vcol0 + fr] = O[mt][r];
    }
#pragma unroll
    for (int t = 0; t < 8; ++t) {
      S[t] = S[t] * gl;
      const int row = 16 * t + fr;
#pragma unroll
      for (int s = 0; s < 2; ++s) {
        const bf16x8 ak = *(const bf16x8*)(sKT + row * 128 + ((((s * 4 + fq) ^ (row & 7))) << 4));
        S[t] = __builtin_amdgcn_mfma_f32_16x16x32_bf16(ak, Vb[s], S[t], 0, 0, 0);
      }
    }
    if (nn + 1 < 64) DN_STORE_A();
  }
  __syncthreads();
#undef DN_LOAD_A
#undef DN_STORE_A
#undef DN_LOAD_B
#undef DN_STORE_B
}

__device__ __forceinline__ void ph_dn_post(int n, const float* __restrict__ o, const bf16_t* __restrict__ proj, const float* __restrict__ dn_norm_g, bf16_t* __restrict__ mixed) {
  const int tid = TIDX, h = tid >> 6, lane = tid & 63;
  const float o0 = o[(size_t)n * 512 + h * 128 + lane], o1 = o[(size_t)n * 512 + h * 128 + 64 + lane];
  const float ss = wave_sum(o0 * o0 + o1 * o1);
  const float rn = rsqrtf(ss * (1.f / 128.f) + RMS_EPS);
  const float z0 = bf2f(proj[(size_t)n * PROJW + OFF_Z + h * 128 + lane]), z1 = bf2f(proj[(size_t)n * PROJW + OFF_Z + h * 128 + 64 + lane]);
  mixed[(size_t)n * DM + h * 128 + lane] = (bf16_t)f2bf(o0 * rn * dn_norm_g[lane] * siluf(z0));
  mixed[(size_t)n * DM + h * 128 + 64 + lane] = (bf16_t)f2bf(o1 * rn * dn_norm_g[64 + lane] * siluf(z1));
}

__device__ __forceinline__ void ph_swa_naive(int item, const bf16_t* __restrict__ proj, const float* __restrict__ sinks, bf16_t* __restrict__ mixed) {
  const int gid = item * 256 + TIDX;
  const int h = gid / NTOK, n = gid % NTOK, t = n % SEQ, kvh = h >> 2;
  float q[64], acc[64];
  {
    const uint4* qp = (const uint4*)(proj + (size_t)n * PROJW + OFF_SQ + h * 64);
#pragma unroll
    for (int c = 0; c < 8; ++c) {
      const uint4 w = qp[c];
      q[c * 8 + 0] = bflo(w.x); q[c * 8 + 1] = bfhi(w.x); q[c * 8 + 2] = bflo(w.y); q[c * 8 + 3] = bfhi(w.y);
      q[c * 8 + 4] = bflo(w.z); q[c * 8 + 5] = bfhi(w.z); q[c * 8 + 6] = bflo(w.w); q[c * 8 + 7] = bfhi(w.w);
    }
  }
#pragma unroll
  for (int d = 0; d < 64; ++d) acc[d] = 0.f;
  const float slope = exp2f(-(float)(h + 1));
  float mrun = sinks[h], l = 1.f;
  const int s0 = (t - 127 > 0) ? (t - 127) : 0;
  for (int s = s0; s <= t; ++s) {
    const size_t nk = (size_t)(n - (t - s));
    const uint4* kp = (const uint4*)(proj + nk * PROJW + OFF_SK + kvh * 64);
    float dot = 0.f;
#pragma unroll
    for (int c = 0; c < 8; ++c) {
      const uint4 w = kp[c];
      dot += q[c * 8 + 0] * bflo(w.x) + q[c * 8 + 1] * bfhi(w.x) + q[c * 8 + 2] * bflo(w.y) + q[c * 8 + 3] * bfhi(w.y)
           + q[c * 8 + 4] * bflo(w.z) + q[c * 8 + 5] * bfhi(w.z) + q[c * 8 + 6] * bflo(w.w) + q[c * 8 + 7] * bfhi(w.w);
    }
    const float sc = dot * 0.125f - slope * (float)(t - s);
    const float mn = fmaxf(mrun, sc);
    const float corr = __expf(mrun - mn), p = __expf(sc - mn);
    l = l * corr + p;
    const uint4* vp = (const uint4*)(proj + nk * PROJW + OFF_SV + kvh * 64);
#pragma unroll
    for (int c = 0; c < 8; ++c) {
      const uint4 w = vp[c];
      acc[c * 8 + 0] = acc[c * 8 + 0] * corr + p * bflo(w.x); acc[c * 8 + 1] = acc[c * 8 + 1] * corr + p * bfhi(w.x);
      acc[c * 8 + 2] = acc[c * 8 + 2] * corr + p * bflo(w.y); acc[c * 8 + 3] = acc[c * 8 + 3] * corr + p * bfhi(w.y);
      acc[c * 8 + 4] = acc[c * 8 + 4] * corr + p * bflo(w.z); acc[c * 8 + 5] = acc[c * 8 + 5] * corr + p * bfhi(w.z);
      acc[c * 8 + 6] = acc[c * 8 + 6] * corr + p * bflo(w.w); acc[c * 8 + 7] = acc[c * 8 + 7] * corr + p * bfhi(w.w);
    }
    mrun = mn;
  }
  const float inv = 1.f / l;
  u32x4* op = (u32x4*)(mixed + (size_t)n * DM + 512 + h * 64);
#pragma unroll
  for (int c = 0; c < 8; ++c) {
    u32x4 w;
    w[0] = pack2(acc[c * 8 + 0] * inv, acc[c * 8 + 1] * inv); w[1] = pack2(acc[c * 8 + 2] * inv, acc[c * 8 + 3] * inv);
    w[2] = pack2(acc[c * 8 + 4] * inv, acc[c * 8 + 5] * inv); w[3] = pack2(acc[c * 8 + 6] * inv, acc[c * 8 + 7] * inv);
    op[c] = w;
  }
}

__device__ __forceinline__ void ph_wout(unsigned char* smem, int tile, const bf16_t* __restrict__ mixed, const float* __restrict__ w_out, const float* __restrict__ x, float* __restrict__ y1) {
  GEMM_IDS
  const int n0 = (tile & 7) * 128, m0 = (tile >> 3) * 128;
  LdRowBF16 al; al.init([&](int r) { return mixed + (size_t)(m0 + r) * DM; });
  LdColF32 bl; bl.init(w_out + n0 + 4 * (tid & 31), DM, true);
  f32x4 acc[4][4];
  gemm128(smem, al, bl, DM / 64, acc);
#pragma unroll
  for (int m = 0; m < 4; ++m)
#pragma unroll
    for (int n = 0; n < 4; ++n)
#pragma unroll
      for (int j = 0; j < 4; ++j) {
        const size_t idx = (size_t)(m0 + wr * 64 + m * 16 + fq * 4 + j) * DM + n0 + wc * 64 + n * 16 + fr;
        y1[idx] = ALPHA * x[idx] + acc[m][n][j];
      }
}

__device__ __forceinline__ void ph_ln1(int item, float* __restrict__ y, const float* __restrict__ gam, const float* __restrict__ bet, bf16_t* __restrict__ xbf) {
  const int row = item * 4 + (TIDX >> 6), lane = TIDX & 63;
  float4* p = (float4*)(y + (size_t)row * DM);
  float4 v[4]; float s = 0.f;
#pragma unroll
  for (int i = 0; i < 4; ++i) { v[i] = p[lane + i * 64]; s += v[i].x + v[i].y + v[i].z + v[i].w; }
  const float mu = wave_sum(s) * (1.f / DM);
  float q = 0.f;
#pragma unroll
  for (int i = 0; i < 4; ++i) { const float a = v[i].x - mu, b = v[i].y - mu, c = v[i].z - mu, d = v[i].w - mu; q += a * a + b * b + c * c + d * d; }
  const float rs = rsqrtf(wave_sum(q) * (1.f / DM) + LN_EPS);
#pragma unroll
  for (int i = 0; i < 4; ++i) {
    const float4 gg = ((const float4*)gam)[lane + i * 64], bb = ((const float4*)bet)[lane + i * 64];
    float4 r;
    r.x = (v[i].x - mu) * rs * gg.x + bb.x; r.y = (v[i].y - mu) * rs * gg.y + bb.y;
    r.z = (v[i].z - mu) * rs * gg.z + bb.z; r.w = (v[i].w - mu) * rs * gg.w + bb.w;
    p[lane + i * 64] = r;
    u32x2 w; w[0] = pack2(r.x, r.y); w[1] = pack2(r.z, r.w);
    ((u32x2*)(xbf + (size_t)row * DM))[lane + i * 64] = w;
  }
}

__device__ __forceinline__ void ph_router(unsigned char* smem, int tile, const bf16_t* __restrict__ xbf, const float* __restrict__ router_w, float* __restrict__ logits) {
  GEMM_IDS
  const int n0 = (tile & 1) * 128, m0 = (tile >> 1) * 128;
  LdRowBF16 al; al.init([&](int r) { return xbf + (size_t)(m0 + r) * DM; });
  LdColF32 bl; bl.init(router_w + n0 + 4 * (tid & 31), NEXP, true);
  f32x4 acc[4][4];
  gemm128(smem, al, bl, DM / 64, acc);
#pragma unroll
  for (int m = 0; m < 4; ++m)
#pragma unroll
    for (int n = 0; n < 4; ++n)
#pragma unroll
      for (int j = 0; j < 4; ++j)
        logits[(size_t)(m0 + wr * 64 + m * 16 + fq * 4 + j) * NEXP + n0 + wc * 64 + n * 16 + fr] = acc[m][n][j];
}

__device__ __forceinline__ void ph_route(int item, const float* __restrict__ logits, const float* __restrict__ router_bias, int* __restrict__ cnt, int* __restrict__ list, float* __restrict__ gates) {
  const int n = item * 4 + (TIDX >> 6), lane = TIDX & 63;
  const float4 lg = ((const float4*)(logits + (size_t)n * NEXP))[lane];
  const float4 rb = ((const float4*)router_bias)[lane];
  float sc[4] = {sigmoidf(lg.x), sigmoidf(lg.y), sigmoidf(lg.z), sigmoidf(lg.w)};
  float sel[4] = {sc[0] + rb.x, sc[1] + rb.y, sc[2] + rb.z, sc[3] + rb.w};
  float t1 = fmaxf(sel[0], sel[1]), t2 = fminf(sel[0], sel[1]);
  { const float a = sel[2]; if (a > t1) { t2 = t1; t1 = a; } else if (a > t2) t2 = a; }
  { const float a = sel[3]; if (a > t1) { t2 = t1; t1 = a; } else if (a > t2) t2 = a; }
#pragma unroll
  for (int o = 1; o < 8; o <<= 1) {
    const float b1 = __shfl_xor(t1, o), b2 = __shfl_xor(t2, o);
    const float n1 = fmaxf(t1, b1), n2 = fmaxf(fminf(t1, b1), fmaxf(t2, b2));
    t1 = n1; t2 = n2;
  }
  const float gs = t1 + t2;
  const int mygrp = lane >> 3;
  int rank = 0;
#pragma unroll
  for (int j = 0; j < 8; ++j) {
    const float o = __shfl(gs, j * 8);
    rank += (o > gs || (o == gs && j < mygrp)) ? 1 : 0;
  }
  const bool gsel = rank < 4;
  float cand[4];
#pragma unroll
  for (int i = 0; i < 4; ++i) cand[i] = gsel ? sel[i] : -INFINITY;
  float gsum = 0.f; float myg = 0.f; int mye = 0;
#pragma unroll 1
  for (int r = 0; r < TOPK; ++r) {
    float bv = cand[0]; int bi = 0;
#pragma unroll
    for (int i = 1; i < 4; ++i) if (cand[i] > bv) { bv = cand[i]; bi = i; }
    int be = lane * 4 + bi;
    float bs = (bi == 0) ? sc[0] : (bi == 1) ? sc[1] : (bi == 2) ? sc[2] : sc[3];
#pragma unroll
    for (int o = 1; o < 64; o <<= 1) {
      const float ov = __shfl_xor(bv, o); const int oe = __shfl_xor(be, o); const float os = __shfl_xor(bs, o);
      if (ov > bv || (ov == bv && oe < be)) { bv = ov; be = oe; bs = os; }
    }
    if ((be >> 2) == lane) {
      const int bi2 = be & 3;
      if (bi2 == 0) cand[0] = -INFINITY; else if (bi2 == 1) cand[1] = -INFINITY; else if (bi2 == 2) cand[2] = -INFINITY; else cand[3] = -INFINITY;
    }
    gsum += bs;
    if (lane == r) { myg = bs; mye = be; }
  }
  if (lane < TOPK) {
    const int slot = atomicAdd(&cnt[mye], 1);
    list[(size_t)mye * CAP + slot] = n * TOPK + lane;
    gates[(size_t)n * TOPK + lane] = myg / gsum * 2.5f;
  }
}

__device__ __forceinline__ int moe_build_prefix(const int* __restrict__ cnt, int* sscan) {
  const int tid = TIDX;
  const int c = cnt[tid];
  __syncthreads();
  sscan[tid] = (c + 127) >> 7;
  __syncthreads();
  for (int o = 1; o < 256; o <<= 1) {
    const int v = (tid >= o) ? sscan[tid - o] : 0;
    __syncthreads();
    sscan[tid] += v;
    __syncthreads();
  }
  return sscan[255];
}
__device__ __forceinline__ void moe_locate(const int* sscan, int total, int rtile, int& e, int& rt) {
  if (rtile >= total) { e = 256; rt = rtile - total; return; }
  int lo = 0, hi = 255;
  while (lo < hi) { const int mid = (lo + hi) >> 1; if (sscan[mid] > rtile) hi = mid; else lo = mid + 1; }
  e = lo; rt = rtile - (lo ? sscan[lo - 1] : 0);
}

__device__ __forceinline__ void ph_moe1(unsigned char* smem, int e, int rt, int ct, const bf16_t* __restrict__ xbf, const int* __restrict__ cnt, const int* __restrict__ list,
                                        const float* __restrict__ w_gate, const float* __restrict__ w_up,
                                        const float* __restrict__ sw_gate, const float* __restrict__ sw_up, bf16_t* __restrict__ hbuf) {
  int* sasg = (int*)(smem + SM_MISC + 2048);
  GEMM_IDS
  const int rows = (e < 256) ? cnt[e] : NTOK;
  if (tid < 128) {
    const int r = rt * 128 + tid;
    int a = -1;
    if (r < rows) a = (e < 256) ? list[(size_t)e * CAP + r] : (NA + r);
    sasg[tid] = a;
  }
  __syncthreads();
  LdRowBF16 al; al.init([&](int r) { const int a = sasg[r]; const int tok = (a < 0) ? 0 : (a < NA ? (a >> 3) : (a - NA)); return xbf + (size_t)tok * DM; });
  LdColF32 bl;
  {
    const int jj = 4 * (tid & 31);
    const int bwc = jj >> 6, bn = (jj >> 4) & 3;
    const int ff = ct * 64 + bwc * 32 + (bn >> 1) * 16 + (jj & 15);
    const float* W = (e < 256) ? ((bn & 1) ? w_up : w_gate) + (size_t)e * DM * EFF : ((bn & 1) ? sw_up : sw_gate);
    bl.init(W + ff, EFF, true);
  }
  f32x4 acc[4][4];
  gemm128(smem, al, bl, DM / 64, acc);
#pragma unroll
  for (int m = 0; m < 4; ++m)
#pragma unroll
    for (int pp = 0; pp < 2; ++pp)
#pragma unroll
      for (int j = 0; j < 4; ++j) {
        const int r = wr * 64 + m * 16 + fq * 4 + j;
        const int a = sasg[r];
        if (a >= 0) {
          const float gv = acc[m][2 * pp][j], uv = acc[m][2 * pp + 1][j];
          hbuf[(size_t)a * EFF + ct * 64 + wc * 32 + pp * 16 + fr] = (bf16_t)f2bf(siluf(gv) * uv);
        }
      }
  __syncthreads();
}

__device__ __forceinline__ void ph_moe2(unsigned char* smem, int e, int rt, int ct, const bf16_t* __restrict__ hbuf, const int* __restrict__ cnt, const int* __restrict__ list, const float* __restrict__ gates,
                                        const float* __restrict__ w_down, const float* __restrict__ sw_down, bf16_t* __restrict__ ybuf) {
  int* sasg = (int*)(smem + SM_MISC + 2048);
  float* sgate = (float*)(smem + SM_MISC + 2048 + 512);
  GEMM_IDS
  const int rows = (e < 256) ? cnt[e] : NTOK;
  const int n0 = ct * 128;
  if (tid < 128) {
    const int r = rt * 128 + tid;
    int a = -1;
    if (r < rows) a = (e < 256) ? list[(size_t)e * CAP + r] : (NA + r);
    sasg[tid] = a;
    sgate[tid] = (a >= 0 && a < NA) ? gates[a] : 1.f;
  }
  __syncthreads();
  LdRowBF16 al; al.init([&](int r) { const int a = sasg[r]; return hbuf + (size_t)(a < 0 ? 0 : a) * EFF; });
  LdColF32 bl; bl.init(((e < 256) ? w_down + (size_t)e * EFF * DM : sw_down) + n0 + 4 * (tid & 31), DM, true);
  f32x4 acc[4][4];
  gemm128(smem, al, bl, EFF / 64, acc);
#pragma unroll
  for (int m = 0; m < 4; ++m)
#pragma unroll
    for (int n = 0; n < 4; ++n)
#pragma unroll
      for (int j = 0; j < 4; ++j) {
        const int r = wr * 64 + m * 16 + fq * 4 + j;
        const int a = sasg[r];
        if (a >= 0) ybuf[(size_t)a * DM + n0 + wc * 64 + n * 16 + fr] = (bf16_t)f2bf(acc[m][n][j] * sgate[r]);
      }
  __syncthreads();
}

__device__ __forceinline__ void ph_final(int item, float* __restrict__ out, const bf16_t* __restrict__ ybuf, const float* __restrict__ gam, const float* __restrict__ bet) {
  const int row = item * 4 + (TIDX >> 6), lane = TIDX & 63;
  float4* p = (float4*)(out + (size_t)row * DM);
  float4 v[4]; float s = 0.f;
#pragma unroll
  for (int i = 0; i < 4; ++i) {
    float4 a = p[lane + i * 64];
    a.x *= ALPHA; a.y *= ALPHA; a.z *= ALPHA; a.w *= ALPHA;
#pragma unroll
    for (int k = 0; k < 9; ++k) {
      const size_t yr = (k < 8) ? ((size_t)row * 8 + k) : ((size_t)NA + row);
      const uint2 w = ((const uint2*)(ybuf + yr * DM))[lane + i * 64];
      a.x += bflo(w.x); a.y += bfhi(w.x); a.z += bflo(w.y); a.w += bfhi(w.y);
    }
    v[i] = a; s += a.x + a.y + a.z + a.w;
  }
  const float mu = wave_sum(s) * (1.f / DM);
  float q = 0.f;
#pragma unroll
  for (int i = 0; i < 4; ++i) { const float a = v[i].x - mu, b = v[i].y - mu, c = v[i].z - mu, d = v[i].w - mu; q += a * a + b * b + c * c + d * d; }
  const float rs = rsqrtf(wave_sum(q) * (1.f / DM) + LN_EPS);
#pragma unroll
  for (int i = 0; i < 4; ++i) {
    const float4 gg = ((const float4*)gam)[lane + i * 64], bb = ((const float4*)bet)[lane + i * 64];
    float4 r;
    r.x = (v[i].x - mu) * rs * gg.x + bb.x; r.y = (v[i].y - mu) * rs * gg.y + bb.y;
    r.z = (v[i].z - mu) * rs * gg.z + bb.z; r.w = (v[i].w - mu) * rs * gg.w + bb.w;
    p[lane + i * 64] = r;
  }
}

#define XB_TMO      128
#define XB_XCNT(j)  (256  + 64 * (j))
#define XB_XSUB(j)  (1280 + 64 * (j))
#define XB_XGEN(j)  (2304 + 64 * (j))
#define XB_TOP      3328
#define XB_TOPGEN   3392
#define XCD_BAR_WORDS 3456
#define XB_SPIN_CAP (1u << 22)
#define LAS __attribute__((address_space(3)))
__device__ __forceinline__ unsigned xb_ld(unsigned* p)              { return __hip_atomic_load(p, __ATOMIC_RELAXED, __HIP_MEMORY_SCOPE_AGENT); }
__device__ __forceinline__ unsigned xb_add(unsigned* p, unsigned v) { return __hip_atomic_fetch_add(p, v, __ATOMIC_RELAXED, __HIP_MEMORY_SCOPE_AGENT); }
__device__ __forceinline__ unsigned xb_xcc_id() { return (unsigned)__builtin_amdgcn_s_getreg((3 << 11) | 20) & 0xFu; }
#define XB_SPIN(cond, bar) do { unsigned _sp = 0; while (cond) { __builtin_amdgcn_s_sleep(1); \
    if ((++_sp & 255u) == 0u) { if (xb_ld(&(bar)[XB_TMO])) break; if (_sp > XB_SPIN_CAP) { atomicAdd(&(bar)[XB_TMO], 1u); break; } } } } while (0)
struct XcdBarrier { unsigned* bar; unsigned x; volatile LAS unsigned* st; };
__device__ __forceinline__ XcdBarrier xcd_barrier_post(unsigned* bar, volatile LAS unsigned* st) {
  XcdBarrier b; b.bar = bar; b.x = xb_xcc_id(); b.st = st;
  if (threadIdx.x == 0) (void)xb_add(&bar[XB_XCNT(b.x)], 1u);
  return b;
}
__device__ __forceinline__ void xcd_barrier_complete(unsigned* bar, unsigned x, unsigned& nloc, unsigned& nx) {
  const unsigned G = gridDim.x * gridDim.y * gridDim.z;
  unsigned sum, cnt, mine, sp = 0u;
  for (;;) {
    sum = 0u; cnt = 0u; mine = 0u;
#pragma unroll
    for (unsigned j = 0; j < 16; ++j) { const unsigned c = xb_ld(&bar[XB_XCNT(j)]); sum += c; cnt += (c > 0u) ? 1u : 0u; mine = (j == x) ? c : mine; }
    if (sum == G) break;
    __builtin_amdgcn_s_sleep(1);
    if ((++sp & 255u) == 0u) { if (xb_ld(&bar[XB_TMO])) break; if (sp > XB_SPIN_CAP) { atomicAdd(&bar[XB_TMO], 1u); break; } }
  }
  nloc = mine > 0u ? mine : 1u; nx = cnt > 0u ? cnt : 1u;
}
__device__ __forceinline__ void xcd_barrier(const XcdBarrier& b) {
  asm volatile("s_waitcnt vmcnt(0)" ::: "memory");
  __syncthreads();
  if (threadIdx.x == 0) {
    unsigned* bar = b.bar;
    __builtin_amdgcn_s_waitcnt(0);
    unsigned nloc = b.st[0], nx = b.st[1];
    if (nloc == 0u) { xcd_barrier_complete(bar, b.x, nloc, nx); b.st[0] = nloc; b.st[1] = nx; }
    const unsigned old = xb_add(&bar[XB_XSUB(b.x)], 1u);
    const unsigned gen = old / nloc;
    if (old + 1u == (gen + 1u) * nloc) {
      __builtin_amdgcn_fence(__ATOMIC_RELEASE, "agent");
      asm volatile("s_waitcnt vmcnt(0)" ::: "memory");
      const unsigned og = xb_add(&bar[XB_TOP], 1u);
      const unsigned tg = og / nx;
      if (og + 1u == (tg + 1u) * nx) xb_add(&bar[XB_TOPGEN], 1u);
      else XB_SPIN(xb_ld(&bar[XB_TOPGEN]) == tg, bar);
      __builtin_amdgcn_fence(__ATOMIC_ACQUIRE, "agent");
      xb_add(&bar[XB_XGEN(b.x)], 1u);
      asm volatile("s_waitcnt vmcnt(0)" ::: "memory");
    } else {
      XB_SPIN(xb_ld(&bar[XB_XGEN(b.x)]) == gen, bar);
      __builtin_amdgcn_fence(__ATOMIC_ACQUIRE, "agent");
      asm volatile("s_waitcnt vmcnt(0)" ::: "memory");
    }
  }
  __syncthreads();
}

__global__ void __launch_bounds__(256, 2) mega(Params P) {
  __shared__ __attribute__((aligned(16))) unsigned char smem[SMEM_BYTES];
  cg::grid_group grid = cg::this_grid();
  const int bid = blockIdx.x, nblk = gridDim.x;
#define xin (P.in[0])
#define w_in (P.in[1])
#define conv_w (P.in[2])
#define a_log (P.in[3])
#define dt_bias (P.in[4])
#define dn_norm_g (P.in[5])
#define sinks (P.in[6])
#define w_out (P.in[7])
#define ln1_g (P.in[8])
#define ln1_b (P.in[9])
#define router_w (P.in[10])
#define router_bias (P.in[11])
#define w_gate (P.in[12])
#define w_up (P.in[13])
#define w_down (P.in[14])
#define sw_gate (P.in[15])
#define sw_up (P.in[16])
#define sw_down (P.in[17])
#define ln2_g (P.in[18])
#define ln2_b (P.in[19])
#define outp (P.out)
#define x1bf ((bf16_t*)(P.ws + WS_X1BF))
#define logits ((float*)(P.ws + WS_LOGIT))
#define list ((int*)(P.ws + WS_LIST))
#define gates ((float*)(P.ws + WS_GATES))
#define cnt ((int*)(P.ws + WS_CTRL))
#define barw ((unsigned*)(P.ws + WS_CTRL + 4096))
#define mixed ((bf16_t*)(P.ws + WS_MIXED))
#define proj ((bf16_t*)(P.ws + WS_PROJ))
#define ba ((float*)(P.ws + WS_BA))
#define QD ((bf16_t*)(P.ws + WS_QD))
#define W0N ((bf16_t*)(P.ws + WS_W0N))
#define KTT ((bf16_t*)(P.ws + WS_KTT))
#define RV ((bf16_t*)(P.ws + WS_RV))
#define TM ((bf16_t*)(P.ws + WS_TM))
#define ATT ((bf16_t*)(P.ws + WS_ATT))
#define GL ((float*)(P.ws + WS_GL))
#define obuf ((float*)(P.ws + WS_O))
#define hbuf ((bf16_t*)(P.ws + WS_HBUF))
#define ybuf ((bf16_t*)(P.ws + WS_YBUF))
  {
    volatile LAS unsigned* st0 = (volatile LAS unsigned*)(smem + SM_MISC + 4080);
    if (threadIdx.x == 0) { st0[0] = 0u; st0[1] = 0u; }
    __syncthreads();
  }
  XcdBarrier xb = xcd_barrier_post(barw, (volatile LAS unsigned*)(smem + SM_MISC + 4080));
  for (int t = bid; t < 23 * (NTOK / 128); t += nblk) ph_proj(smem, t, xin, w_in, proj, ba);
  grid.sync();
  for (int it = bid; it < 2048; it += nblk) ph_dnchunk(smem, it, proj, ba, conv_w, a_log, dt_bias, QD, W0N, KTT, RV, TM, ATT, GL);
  for (int it = bid; it < NTOK * 8 / 256; it += nblk) ph_swa_naive(it, proj, sinks, mixed);
  xcd_barrier(xb);
  for (int it = bid; it < 64; it += nblk) ph_dnscan(smem, it, QD, W0N, KTT, RV, TM, ATT, GL, obuf);
  xcd_barrier(xb);
  for (int n = bid; n < NTOK; n += nblk) ph_dn_post(n, obuf, proj, dn_norm_g, mixed);
  xcd_barrier(xb);
  for (int t = bid; t < 8 * (NTOK / 128); t += nblk) ph_wout(smem, t, mixed, w_out, xin, outp);
  xcd_barrier(xb);
  for (int it = bid; it < NTOK / 4; it += nblk) ph_ln1(it, outp, ln1_g, ln1_b, x1bf);
  xcd_barrier(xb);
  for (int t = bid; t < 2 * (NTOK / 128); t += nblk) ph_router(smem, t, x1bf, router_w, logits);
  xcd_barrier(xb);
  for (int it = bid; it < NTOK / 4; it += nblk) ph_route(it, logits, router_bias, cnt, list, gates);
  xcd_barrier(xb);
  int* sscan = (int*)(smem + SM_MISC);
  const int total = moe_build_prefix(cnt, sscan);
  const int ntile = total + NTOK / 128;
  for (int it = bid; it < ntile * 4; it += nblk) {
    int e, rt; moe_locate(sscan, total, it >> 2, e, rt);
    ph_moe1(smem, e, rt, it & 3, x1bf, cnt, list, w_gate, w_up, sw_gate, sw_up, hbuf);
  }
  xcd_barrier(xb);
  for (int it = bid; it < ntile * 8; it += nblk) {
    int e, rt; moe_locate(sscan, total, it >> 3, e, rt);
    ph_moe2(smem, e, rt, it & 7, hbuf, cnt, list, gates, w_down, sw_down, ybuf);
  }
  xcd_barrier(xb);
  for (int it = bid; it < NTOK / 4; it += nblk) ph_final(it, outp, ybuf, ln2_g, ln2_b);
}

#undef xin
#undef w_in
#undef conv_w
#undef a_log
#undef dt_bias
#undef dn_norm_g
#undef sinks
#undef w_out
#undef ln1_g
#undef ln1_b
#undef router_w
#undef router_bias
#undef w_gate
#undef w_up
#undef w_down
#undef sw_gate
#undef sw_up
#undef sw_down
#undef ln2_g
#undef ln2_b
#undef outp
#undef x1bf
#undef logits
#undef list
#undef gates
#undef cnt
#undef mixed
#undef proj
#undef ba
#undef QD
#undef W0N
#undef KTT
#undef RV
#undef TM
#undef ATT
#undef GL
#undef obuf
#undef hbuf
#undef ybuf
#undef barw

extern "C" void kernel_launch(void* const* d_in, const int* in_sizes, int n_in, void* d_out, int out_size, void* d_ws, size_t ws_size, hipStream_t stream) {
  static int grid_blocks = 0;
  if (!grid_blocks) {
    int dev = 0, cus = 0, per_cu = 0;
    (void)hipGetDevice(&dev);
    (void)hipDeviceGetAttribute(&cus, hipDeviceAttributeMultiprocessorCount, dev);
    (void)hipOccupancyMaxActiveBlocksPerMultiprocessor(&per_cu, mega, 256, 0);
    if (per_cu > 2) per_cu = 2;
    if (per_cu < 1) per_cu = 1;
    grid_blocks = cus * per_cu;
  }
  Params p{};
  for (int i = 0; i < 20; ++i) p.in[i] = (const float*)d_in[i];
  p.out = (float*)d_out; p.ws = (char*)d_ws;
  (void)hipMemsetAsync((char*)d_ws + WS_CTRL, 0, 4096 + XCD_BAR_WORDS * 4, stream);
  void* args[] = {&p};
  hipError_t e = hipLaunchCooperativeKernel((void*)mega, dim3(grid_blocks), dim3(256), args, 0, stream);
  if (e != hipSuccess) fprintf(stderr, "cooperative launch failed: %s (grid %d)\n", hipGetErrorString(e), grid_blocks);
}
```

```cpp
#include <hip/hip_runtime.h>
#include <hip/hip_cooperative_groups.h>
#include <stdint.h>
#include <stdio.h>
namespace cg = cooperative_groups;

typedef __attribute__((ext_vector_type(8))) short bf16x8;
typedef __attribute__((ext_vector_type(4))) float f32x4;
typedef unsigned short bf16_t;
typedef __attribute__((ext_vector_type(4))) unsigned u32x4;
typedef __attribute__((ext_vector_type(2))) unsigned u32x2;

constexpr int NTOK = 32768, SEQ = 4096, DM = 1024;
constexpr int INC = 2824, PROJW = 2816;
constexpr int OFF_DQ = 0, OFF_DK = 512, OFF_DV = 1024, OFF_SQ = 1536, OFF_SK = 2048, OFF_SV = 2176, OFF_Z = 2304;
constexpr int NEXP = 256, TOPK = 8, EFF = 256;
constexpr int NA = NTOK * TOPK;
constexpr int CAP = NTOK;
constexpr float ALPHA = 1.189207115002721f;
constexpr float LN_EPS = 1e-5f, RMS_EPS = 1e-6f, L2_EPS = 1e-6f;

constexpr size_t MiB = 1024ull * 1024ull;
constexpr size_t WS_X1BF = 0;
constexpr size_t WS_LOGIT = 64 * MiB;
constexpr size_t WS_LIST = 96 * MiB;
constexpr size_t WS_GATES = 128 * MiB;
constexpr size_t WS_CTRL = 129 * MiB;
constexpr size_t WS_MIXED = 130 * MiB;
constexpr size_t WS_PROJ = 200 * MiB;
constexpr size_t WS_BA = 376 * MiB;
constexpr size_t WS_QD = 377 * MiB;
constexpr size_t WS_W0N = 409 * MiB;
constexpr size_t WS_KTT = 441 * MiB;
constexpr size_t WS_RV = 473 * MiB;
constexpr size_t WS_TM = 505 * MiB;
constexpr size_t WS_ATT = 521 * MiB;
constexpr size_t WS_GL = 537 * MiB;
constexpr size_t WS_O = 538 * MiB;
constexpr size_t WS_VT = 602 * MiB;
constexpr size_t WS_HBUF = 200 * MiB;
constexpr size_t WS_YBUF = 344 * MiB;

__device__ __forceinline__ int opaque_tid() { int t = threadIdx.x; asm volatile("" : "+v"(t)); return t; }
#define TIDX opaque_tid()
typedef __attribute__((ext_vector_type(2))) __bf16 hwbf16x2;
typedef __attribute__((ext_vector_type(2))) float hwf32x2;
__device__ __forceinline__ unsigned pack2(float lo, float hi) {
  hwf32x2 f = {lo, hi};
  return __builtin_bit_cast(unsigned, __builtin_convertvector(f, hwbf16x2));
}
__device__ __forceinline__ unsigned f2bf(float f) { return pack2(f, 0.f) & 0xffffu; }
__device__ __forceinline__ float bf2f(unsigned h) { return __uint_as_float(h << 16); }
__device__ __forceinline__ float bflo(unsigned w) { return __uint_as_float(w << 16); }
__device__ __forceinline__ float bfhi(unsigned w) { return __uint_as_float(w & 0xffff0000u); }
__device__ __forceinline__ float siluf(float x) { return x / (1.f + __expf(-x)); }
__device__ __forceinline__ float sigmoidf(float x) { return 1.f / (1.f + __expf(-x)); }
__device__ __forceinline__ float wave_sum(float v) {
#pragma unroll
  for (int o = 32; o > 0; o >>= 1) v += __shfl_xor(v, o);
  return v;
}

struct LdRowF32 {
  const char* p[8]; f32x4 r[8]; int row0, ch4;
  template <class F> __device__ __forceinline__ void init(F rowptr) {
    const int tid = TIDX; ch4 = tid & 15; row0 = tid >> 4;
#pragma unroll
    for (int i = 0; i < 8; ++i) p[i] = (const char*)rowptr(row0 + i * 16) + ch4 * 16;
  }
  __device__ __forceinline__ void load(int kt) {
#pragma unroll
    for (int i = 0; i < 8; ++i) r[i] = *(const f32x4*)(p[i] + (size_t)kt * 256);
  }
  __device__ __forceinline__ void store(unsigned char* s) {
#pragma unroll
    for (int i = 0; i < 8; ++i) {
      const int row = row0 + i * 16;
      u32x2 w; w[0] = pack2(r[i][0], r[i][1]); w[1] = pack2(r[i][2], r[i][3]);
      *(u32x2*)(s + row * 128 + ((((ch4 >> 1) ^ (row & 7))) << 4) + (ch4 & 1) * 8) = w;
    }
  }
};
struct LdRowBF16 {
  const char* p[4]; u32x4 r[4]; int row0, ch;
  template <class F> __device__ __forceinline__ void init(F rowptr) {
    const int tid = TIDX; ch = tid & 7; row0 = tid >> 3;
#pragma unroll
    for (int i = 0; i < 4; ++i) p[i] = (const char*)rowptr(row0 + i * 32) + ch * 16;
  }
  __device__ __forceinline__ void load(int kt) {
#pragma unroll
    for (int i = 0; i < 4; ++i) r[i] = *(const u32x4*)(p[i] + (size_t)kt * 128);
  }
  __device__ __forceinline__ void store(unsigned char* s) {
#pragma unroll
    for (int i = 0; i < 4; ++i) {
      const int row = row0 + i * 32;
      *(u32x4*)(s + row * 128 + ((ch ^ (row & 7)) << 4)) = r[i];
    }
  }
};
struct LdColF32 {
  const char* p; size_t ldb; f32x4 r[8]; int n4, kg; bool valid;
  __device__ __forceinline__ void init(const float* colptr, size_t ld, bool v) {
    const int tid = TIDX; n4 = tid & 31; kg = tid >> 5; ldb = ld * 4; valid = v;
    p = (const char*)colptr + (size_t)(kg * 8) * ldb;
  }
  __device__ __forceinline__ void load(int kt) {
#pragma unroll
    for (int j = 0; j < 8; ++j) {
      if (valid) r[j] = *(const f32x4*)(p + (size_t)(kt * 64 + j) * ldb);
      else r[j] = (f32x4){0.f, 0.f, 0.f, 0.f};
    }
  }
  __device__ __forceinline__ void store(unsigned char* s) {
    {
      const int row = n4 * 4 + 0; u32x4 w;
      w[0] = pack2(r[0][0], r[1][0]); w[1] = pack2(r[2][0], r[3][0]); w[2] = pack2(r[4][0], r[5][0]); w[3] = pack2(r[6][0], r[7][0]);
      *(u32x4*)(s + row * 128 + ((kg ^ (row & 7)) << 4)) = w;
    }
    {
      const int row = n4 * 4 + 1; u32x4 w;
      w[0] = pack2(r[0][1], r[1][1]); w[1] = pack2(r[2][1], r[3][1]); w[2] = pack2(r[4][1], r[5][1]); w[3] = pack2(r[6][1], r[7][1]);
      *(u32x4*)(s + row * 128 + ((kg ^ (row & 7)) << 4)) = w;
    }
    {
      const int row = n4 * 4 + 2; u32x4 w;
      w[0] = pack2(r[0][2], r[1][2]); w[1] = pack2(r[2][2], r[3][2]); w[2] = pack2(r[4][2], r[5][2]); w[3] = pack2(r[6][2], r[7][2]);
      *(u32x4*)(s + row * 128 + ((kg ^ (row & 7)) << 4)) = w;
    }
    {
      const int row = n4 * 4 + 3; u32x4 w;
      w[0] = pack2(r[0][3], r[1][3]); w[1] = pack2(r[2][3], r[3][3]); w[2] = pack2(r[4][3], r[5][3]); w[3] = pack2(r[6][3], r[7][3]);
      *(u32x4*)(s + row * 128 + ((kg ^ (row & 7)) << 4)) = w;
    }
  }
};

template <class AL, class BL>
__device__ __forceinline__ void gemm128(unsigned char* smem, AL& al, BL& bl, int nk, f32x4 (&acc)[4][4]) {
  const int tid = TIDX, lane = tid & 63, wid = tid >> 6, wr = wid >> 1, wc = wid & 1, fr = lane & 15, fq = lane >> 4;
  unsigned char* sA = smem; unsigned char* sB = smem + 16384;
#pragma unroll
  for (int m = 0; m < 4; ++m)
#pragma unroll
    for (int n = 0; n < 4; ++n) acc[m][n] = (f32x4){0.f, 0.f, 0.f, 0.f};
  al.load(0); bl.load(0);
  for (int kt = 0; kt < nk; ++kt) {
    __syncthreads();
    al.store(sA); bl.store(sB);
    __syncthreads();
    if (kt + 1 < nk) { al.load(kt + 1); bl.load(kt + 1); }
#pragma unroll
    for (int ks = 0; ks < 2; ++ks) {
      bf16x8 a[4], b[4];
#pragma unroll
      for (int m = 0; m < 4; ++m) {
        const int row = wr * 64 + m * 16 + fr;
        a[m] = *(const bf16x8*)(sA + row * 128 + (((ks * 4 + fq) ^ (row & 7)) << 4));
      }
#pragma unroll
      for (int n = 0; n < 4; ++n) {
        const int row = wc * 64 + n * 16 + fr;
        b[n] = *(const bf16x8*)(sB + row * 128 + (((ks * 4 + fq) ^ (row & 7)) << 4));
      }
#pragma unroll
      for (int m = 0; m < 4; ++m)
#pragma unroll
        for (int n = 0; n < 4; ++n) acc[m][n] = __builtin_amdgcn_mfma_f32_16x16x32_bf16(a[m], b[n], acc[m][n], 0, 0, 0);
    }
  }
  __syncthreads();
}

#define GEMM_IDS const int tid = TIDX, lane = tid & 63, wid = tid >> 6, wr = wid >> 1, wc = wid & 1, fr = lane & 15, fq = lane >> 4; (void)tid; (void)lane;

struct Params {
  const float* in[20];
  float* out;
  char* ws;
};

constexpr int SMEM_BYTES = 69632;
constexpr int SM_MISC = 65536;

__device__ __forceinline__ void ph_proj(unsigned char* smem, int tile, const float* __restrict__ x, const float* __restrict__ w_in, bf16_t* __restrict__ proj, float* __restrict__ ba, bf16_t* __restrict__ vt) {
  GEMM_IDS
  const int n0 = (tile % 23) * 128, m0 = (tile / 23) * 128;
  LdRowF32 al; al.init([&](int r) { return x + (size_t)(m0 + r) * DM; });
  LdColF32 bl; { const int col = n0 + 4 * (tid & 31); const bool v = col < INC; bl.init(w_in + (v ? col : 0), INC, v); }
  f32x4 acc[4][4];
  gemm128(smem, al, bl, DM / 64, acc);
#pragma unroll
  for (int m = 0; m < 4; ++m)
#pragma unroll
    for (int n = 0; n < 4; ++n)
#pragma unroll
      for (int j = 0; j < 4; ++j) {
        const int row = m0 + wr * 64 + m * 16 + fq * 4 + j, col = n0 + wc * 64 + n * 16 + fr;
        if (col < PROJW) proj[(size_t)row * PROJW + col] = (bf16_t)f2bf(acc[m][n][j]);
        else if (col < INC) ba[(size_t)row * 8 + (col - PROJW)] = acc[m][n][j];
      }
  if (n0 == OFF_SV) {
#pragma unroll
    for (int m = 0; m < 4; ++m)
#pragma unroll
      for (int n = 0; n < 4; ++n) {
        const int row = m0 + wr * 64 + m * 16 + fq * 4, c = wc * 64 + n * 16 + fr;
        const int bb = row / SEQ, t = row % SEQ;
        u32x2 w; w[0] = pack2(acc[m][n][0], acc[m][n][1]); w[1] = pack2(acc[m][n][2], acc[m][n][3]);
        *(u32x2*)(vt + ((size_t)(bb * 128 + c)) * SEQ + t) = w;
      }
  }
}

__device__ __forceinline__ bf16x8 pack8(f32x4 a, f32x4 b) {
  union { bf16x8 v; unsigned u[4]; } x;
  x.u[0] = pack2(a[0], a[1]); x.u[1] = pack2(a[2], a[3]); x.u[2] = pack2(b[0], b[1]); x.u[3] = pack2(b[2], b[3]);
  return x.v;
}
__device__ __forceinline__ void ph_dnchunk(unsigned char* smem, int item, const bf16_t* __restrict__ proj, const float* __restrict__ ba, const float* __restrict__ conv_w,
                                           const float* __restrict__ a_log, const float* __restrict__ dt_bias,
                                           bf16_t* __restrict__ QD, bf16_t* __restrict__ W0N, bf16_t* __restrict__ KTT, bf16_t* __restrict__ RV,
                                           bf16_t* __restrict__ TM, bf16_t* __restrict__ ATT, float* __restrict__ GL) {
  const int tid = TIDX, lane = tid & 63, w = tid >> 6, fr = lane & 15, fq = lane >> 4;
  const int n = item & 63, h = (item >> 6) & 3, b = item >> 8;
  const int t0 = n * 64; const size_t row0 = (size_t)b * SEQ + t0;
  unsigned char* qs = smem; unsigned char* ks = smem + 16384; float* AT = (float*)(smem + 32768);
  const float scale = 0.08838834764831845f;
  float bL, gcL;
  {
    const float* bap = ba + (row0 + lane) * 8;
    bL = sigmoidf(bap[h]);
    const float xx = bap[4 + h] + dt_bias[h];
    const float sp = fmaxf(xx, 0.f) + log1pf(__expf(-fabsf(xx)));
    float gg = -__expf(a_log[h]) * sp;
#pragma unroll
    for (int o = 1; o < 64; o <<= 1) { const float v = __shfl_up(gg, o); if (lane >= o) gg += v; }
    gcL = gg;
  }
  {
    const int d = 2 * lane;
    float cw[3][4][2], xw[3][4][2];
#pragma unroll
    for (int mx = 0; mx < 3; ++mx)
#pragma unroll
      for (int j = 0; j < 4; ++j) {
        const float2 c2 = *(const float2*)(conv_w + j * 1536 + mx * 512 + h * 128 + d);
        cw[mx][j][0] = c2.x; cw[mx][j][1] = c2.y;
      }
    const bf16_t* pbase = proj + (row0 + 16 * w) * PROJW + h * 128 + d;
#pragma unroll
    for (int j = 0; j < 3; ++j) {
      const bool ok = (t0 + 16 * w - 3 + j) >= 0;
#pragma unroll
      for (int mx = 0; mx < 3; ++mx) {
        unsigned u = 0;
        if (ok) u = *(const unsigned*)(pbase + (ptrdiff_t)(j - 3) * PROJW + mx * 512);
        xw[mx][j + 1][0] = bflo(u); xw[mx][j + 1][1] = bfhi(u);
      }
    }
#pragma unroll
    for (int i = 0; i < 16; ++i) {
      float s[3][2];
#pragma unroll
      for (int mx = 0; mx < 3; ++mx) {
        const unsigned u = *(const unsigned*)(pbase + (size_t)i * PROJW + mx * 512);
#pragma unroll
        for (int j = 0; j < 3; ++j) { xw[mx][j][0] = xw[mx][j + 1][0]; xw[mx][j][1] = xw[mx][j + 1][1]; }
        xw[mx][3][0] = bflo(u); xw[mx][3][1] = bfhi(u);
        float y0 = 0.f, y1 = 0.f;
#pragma unroll
        for (int j = 0; j < 4; ++j) { y0 += cw[mx][j][0] * xw[mx][j][0]; y1 += cw[mx][j][1] * xw[mx][j][1]; }
        s[mx][0] = siluf(y0); s[mx][1] = siluf(y1);
      }
      const int row = 16 * w + i;
      const float rq = rsqrtf(wave_sum(s[0][0] * s[0][0] + s[0][1] * s[0][1]) + L2_EPS);
      const float rk = rsqrtf(wave_sum(s[1][0] * s[1][0] + s[1][1] * s[1][1]) + L2_EPS);
      const int off = row * 256 + ((((lane >> 2) ^ (row & 15))) << 4) + (lane & 3) * 4;
      *(unsigned*)(qs + off) = pack2(s[0][0] * rq, s[0][1] * rq);
      *(unsigned*)(ks + off) = pack2(s[1][0] * rk, s[1][1] * rk);
      const float bi = __shfl(bL, row);
      *(unsigned*)(RV + ((size_t)item * 64 + row) * 128 + d) = pack2(bi * s[2][0], bi * s[2][1]);
    }
  }
  __syncthreads();
  {
    f32x4 aKK[4], aQK[4];
#pragma unroll
    for (int nt = 0; nt < 4; ++nt) { aKK[nt] = (f32x4){0.f, 0.f, 0.f, 0.f}; aQK[nt] = (f32x4){0.f, 0.f, 0.f, 0.f}; }
#pragma unroll
    for (int k4 = 0; k4 < 4; ++k4) {
      const int arow = 16 * w + fr;
      const bf16x8 aq = *(const bf16x8*)(qs + arow * 256 + ((((k4 * 4 + fq) ^ (arow & 15))) << 4));
      const bf16x8 ak = *(const bf16x8*)(ks + arow * 256 + ((((k4 * 4 + fq) ^ (arow & 15))) << 4));
#pragma unroll
      for (int nt = 0; nt < 4; ++nt) {
        const int brow = 16 * nt + fr;
        const bf16x8 bk = *(const bf16x8*)(ks + brow * 256 + ((((k4 * 4 + fq) ^ (brow & 15))) << 4));
        aKK[nt] = __builtin_amdgcn_mfma_f32_16x16x32_bf16(ak, bk, aKK[nt], 0, 0, 0);
        aQK[nt] = __builtin_amdgcn_mfma_f32_16x16x32_bf16(aq, bk, aQK[nt], 0, 0, 0);
      }
    }
    float gci[4], bi[4];
#pragma unroll
    for (int r = 0; r < 4; ++r) { gci[r] = __shfl(gcL, 16 * w + 4 * fq + r); bi[r] = __shfl(bL, 16 * w + 4 * fq + r); }
#pragma unroll
    for (int nt = 0; nt < 4; ++nt) {
      const int j = 16 * nt + fr;
      const float gcj = __shfl(gcL, j);
      const int p = 32 * (nt >> 1) + 8 * (fr >> 2) + 4 * (nt & 1) + (fr & 3);
      float av[4];
#pragma unroll
      for (int r = 0; r < 4; ++r) {
        const int i = 16 * w + 4 * fq + r;
        const float dec = (j <= i) ? __expf(gci[r] - gcj) : 0.f;
        av[r] = (j < i) ? bi[r] * aKK[nt][r] * dec : 0.f;
        ATT[((size_t)item * 64 + i) * 64 + p] = (bf16_t)f2bf(aQK[nt][r] * scale * dec);
      }
      *(float4*)(AT + j * 68 + 16 * w + 4 * fq) = make_float4(av[0], av[1], av[2], av[3]);
    }
  }
  __syncthreads();
  if (w == 0) {
    float Tr[64];
    int ln = lane; asm volatile("" : "+v"(ln));
#pragma unroll
    for (int j = 0; j < 64; ++j) Tr[j] = 0.f;
#pragma unroll
    for (int c = 63; c >= 0; --c) {
      float a0 = 0.f, a1 = 0.f, a2 = 0.f, a3 = 0.f;
#pragma unroll
      for (int j4 = 15; j4 >= (c + 1) / 4; --j4) {
        const float4 a = *(const float4*)(AT + c * 68 + j4 * 4);
        asm volatile("v_fmac_f32 %0, %1, %2" : "+v"(a0) : "v"(Tr[4 * j4 + 0]), "v"(a.x));
        asm volatile("v_fmac_f32 %0, %1, %2" : "+v"(a1) : "v"(Tr[4 * j4 + 1]), "v"(a.y));
        asm volatile("v_fmac_f32 %0, %1, %2" : "+v"(a2) : "v"(Tr[4 * j4 + 2]), "v"(a.z));
        asm volatile("v_fmac_f32 %0, %1, %2" : "+v"(a3) : "v"(Tr[4 * j4 + 3]), "v"(a.w));
      }
      Tr[c] = ((ln == c) ? 1.f : 0.f) - ((a0 + a1) + (a2 + a3));
    }
    u32x4* tp = (u32x4*)(TM + ((size_t)item * 64 + lane) * 64);
#pragma unroll
    for (int oc = 0; oc < 8; ++oc) {
      const int k0 = 32 * (oc >> 2) + 4 * (oc & 3);
      u32x4 v;
      v[0] = pack2(Tr[k0 + 0], Tr[k0 + 1]); v[1] = pack2(Tr[k0 + 2], Tr[k0 + 3]);
      v[2] = pack2(Tr[k0 + 16], Tr[k0 + 17]); v[3] = pack2(Tr[k0 + 18], Tr[k0 + 19]);
      tp[oc] = v;
    }
  } else {
    const float gclast = __shfl(gcL, 63);
    if (tid == 64) GL[item] = __expf(gclast);
#pragma unroll 1
    for (int it = 0; it < 16; ++it) {
      const int idx = (tid - 64) + it * 192;
      const int mtx = idx >> 10, rem = idx & 1023;
      if (mtx < 2) {
        const int i = rem >> 4, oc = rem & 15;
        const float gi = __shfl(gcL, i), bi = __shfl(bL, i);
        const float f = (mtx == 0) ? scale * __expf(gi) : -bi * __expf(gi);
        const unsigned char* st = (mtx == 0) ? qs : ks;
        const int d0 = 32 * (oc >> 2) + 4 * (oc & 3);
        const uint2 lo = *(const uint2*)(st + i * 256 + ((((d0 >> 3) ^ (i & 15))) << 4) + (d0 & 7) * 2);
        const uint2 hi = *(const uint2*)(st + i * 256 + (((((d0 + 16) >> 3) ^ (i & 15))) << 4) + (d0 & 7) * 2);
        u32x4 v;
        v[0] = pack2(bflo(lo.x) * f, bfhi(lo.x) * f); v[1] = pack2(bflo(lo.y) * f, bfhi(lo.y) * f);
        v[2] = pack2(bflo(hi.x) * f, bfhi(hi.x) * f); v[3] = pack2(bflo(hi.y) * f, bfhi(hi.y) * f);
        bf16_t* dst = ((mtx == 0) ? QD : W0N) + ((size_t)item * 64 + i) * 128 + 8 * oc;
        *(u32x4*)dst = v;
      } else {
        const int d = rem & 127, oc = rem >> 7;
        const int j0 = 32 * (oc >> 2) + 4 * (oc & 3);
        float val[8];
#pragma unroll
        for (int e = 0; e < 8; ++e) {
          const int j = j0 + (e & 3) + ((e >> 2) << 4);
          const float f = __expf(gclast - __shfl(gcL, j));
          const unsigned short raw = *(const unsigned short*)(ks + j * 256 + ((((d >> 3) ^ (j & 15))) << 4) + (d & 7) * 2);
          val[e] = bf2f(raw) * f;
        }
        u32x4 v;
        v[0] = pack2(val[0], val[1]); v[1] = pack2(val[2], val[3]); v[2] = pack2(val[4], val[5]); v[3] = pack2(val[6], val[7]);
        *(u32x4*)(KTT + ((size_t)item * 128 + d) * 64 + 8 * oc) = v;
      }
    }
  }
  __syncthreads();
}

__device__ __forceinline__ void ph_dnscan(unsigned char* smem, int item, const bf16_t* __restrict__ QDp, const bf16_t* __restrict__ W0Np, const bf16_t* __restrict__ KTTp,
                                          const bf16_t* __restrict__ RVp, const bf16_t* __restrict__ TMp, const bf16_t* __restrict__ ATTp, const float* __restrict__ GLp,
                                          float* __restrict__ op) {
  const int tid = TIDX, lane = tid & 63, w = tid >> 6, fr = lane & 15, fq = lane >> 4;
  const int bh = item >> 1, half = item & 1, b = bh >> 2, h = bh & 3;
  const int vcol0 = (half * 4 + w) * 16;
  unsigned char* sW0 = smem; unsigned char* sQD = smem + 16384; unsigned char* sKT = smem + 32768; unsigned char* sT = smem + 49152; unsigned char* sAT = smem + 57344;
  f32x4 S[8];
#pragma unroll
  for (int t = 0; t < 8; ++t) S[t] = (f32x4){0.f, 0.f, 0.f, 0.f};
  u32x4 pf[8]; unsigned short rvp[16];
#define DN_LOAD_A(nn_) do { \
    const size_t ci = (size_t)bh * 64 + (nn_); \
    _Pragma("unroll") for (int i = 0; i < 4; ++i) pf[i] = *(const u32x4*)((const char*)W0Np + ci * 16384 + (size_t)(tid + 256 * i) * 16); \
    _Pragma("unroll") for (int i = 0; i < 4; ++i) pf[4 + i] = *(const u32x4*)((const char*)QDp + ci * 16384 + (size_t)(tid + 256 * i) * 16); \
    _Pragma("unroll") for (int mt = 0; mt < 4; ++mt) \
      _Pragma("unroll") for (int r = 0; r < 4; ++r) rvp[mt * 4 + r] = RVp[(ci * 64 + 16 * mt + 4 * fq + r) * 128 + vcol0 + fr]; \
  } while (0)
#define DN_STORE_A() do { \
    _Pragma("unroll") for (int i = 0; i < 4; ++i) { const int q = tid + 256 * i, row = q >> 4, ch = q & 15; *(u32x4*)(sW0 + row * 256 + ((ch ^ (row & 15)) << 4)) = pf[i]; } \
    _Pragma("unroll") for (int i = 0; i < 4; ++i) { const int q = tid + 256 * i, row = q >> 4, ch = q & 15; *(u32x4*)(sQD + row * 256 + ((ch ^ (row & 15)) << 4)) = pf[4 + i]; } \
  } while (0)
#define DN_LOAD_B(nn_) do { \
    const size_t ci = (size_t)bh * 64 + (nn_); \
    _Pragma("unroll") for (int i = 0; i < 4; ++i) pf[i] = *(const u32x4*)((const char*)KTTp + ci * 16384 + (size_t)(tid + 256 * i) * 16); \
    _Pragma("unroll") for (int i = 0; i < 2; ++i) pf[4 + i] = *(const u32x4*)((const char*)TMp + ci * 8192 + (size_t)(tid + 256 * i) * 16); \
    _Pragma("unroll") for (int i = 0; i < 2; ++i) pf[6 + i] = *(const u32x4*)((const char*)ATTp + ci * 8192 + (size_t)(tid + 256 * i) * 16); \
  } while (0)
#define DN_STORE_B() do { \
    _Pragma("unroll") for (int i = 0; i < 4; ++i) { const int q = tid + 256 * i, row = q >> 3, ch = q & 7; *(u32x4*)(sKT + row * 128 + ((ch ^ (row & 7)) << 4)) = pf[i]; } \
    _Pragma("unroll") for (int i = 0; i < 2; ++i) { const int q = tid + 256 * i, row = q >> 3, ch = q & 7; *(u32x4*)(sT + row * 128 + ((ch ^ (row & 7)) << 4)) = pf[4 + i]; } \
    _Pragma("unroll") for (int i = 0; i < 2; ++i) { const int q = tid + 256 * i, row = q >> 3, ch = q & 7; *(u32x4*)(sAT + row * 128 + ((ch ^ (row & 7)) << 4)) = pf[6 + i]; } \
  } while (0)
  __syncthreads();
  DN_LOAD_A(0);
  DN_STORE_A();
  for (int nn = 0; nn < 64; ++nn) {
    f32x4 Z[4];
#pragma unroll
    for (int mt = 0; mt < 4; ++mt) Z[mt] = (f32x4){bf2f(rvp[mt * 4 + 0]), bf2f(rvp[mt * 4 + 1]), bf2f(rvp[mt * 4 + 2]), bf2f(rvp[mt * 4 + 3])};
    const float gl = GLp[(size_t)bh * 64 + nn];
    DN_LOAD_B(nn);
    __syncthreads();
    bf16x8 Sb[4];
#pragma unroll
    for (int k4 = 0; k4 < 4; ++k4) Sb[k4] = pack8(S[2 * k4], S[2 * k4 + 1]);
    f32x4 O[4];
#pragma unroll
    for (int mt = 0; mt < 4; ++mt) {
      O[mt] = (f32x4){0.f, 0.f, 0.f, 0.f};
      const int row = 16 * mt + fr;
#pragma unroll
      for (int k4 = 0; k4 < 4; ++k4) {
        const int off = row * 256 + ((((k4 * 4 + fq) ^ fr)) << 4);
        const bf16x8 aw = *(const bf16x8*)(sW0 + off);
        const bf16x8 aq = *(const bf16x8*)(sQD + off);
        Z[mt] = __builtin_amdgcn_mfma_f32_16x16x32_bf16(aw, Sb[k4], Z[mt], 0, 0, 0);
        O[mt] = __builtin_amdgcn_mfma_f32_16x16x32_bf16(aq, Sb[k4], O[mt], 0, 0, 0);
      }
    }
    bf16x8 Zb[2];
    Zb[0] = pack8(Z[0], Z[1]); Zb[1] = pack8(Z[2], Z[3]);
    DN_STORE_B();
    if (nn + 1 < 64) DN_LOAD_A(nn + 1);
    __syncthreads();
    f32x4 Vn[4];
#pragma unroll
    for (int mt = 0; mt < 4; ++mt) {
      Vn[mt] = (f32x4){0.f, 0.f, 0.f, 0.f};
      const int row = 16 * mt + fr;
#pragma unroll
      for (int s = 0; s < 2; ++s) {
        if (s <= (mt >> 1)) {
          const bf16x8 at = *(const bf16x8*)(sT + row * 128 + ((((s * 4 + fq) ^ (row & 7))) << 4));
          Vn[mt] = __builtin_amdgcn_mfma_f32_16x16x32_bf16(at, Zb[s], Vn[mt], 0, 0, 0);
        }
      }
    }
    bf16x8 Vb[2];
    Vb[0] = pack8(Vn[0], Vn[1]); Vb[1] = pack8(Vn[2], Vn[3]);
#pragma unroll
    for (int mt = 0; mt < 4; ++mt) {
      const int row = 16 * mt + fr;
#pragma unroll
      for (int s = 0; s < 2; ++s) {
        if (s <= (mt >> 1)) {
          const bf16x8 aa = *(const bf16x8*)(sAT + row * 128 + ((((s * 4 + fq) ^ (row & 7))) << 4));
          O[mt] = __builtin_amdgcn_mfma_f32_16x16x32_bf16(aa, Vb[s], O[mt], 0, 0, 0);
        }
      }
      const size_t tok = (size_t)b * SEQ + nn * 64 + 16 * mt + 4 * fq;
#pragma unroll
      for (int r = 0; r < 4; ++r) op[(tok + r) * 512 + h * 128 + vcol0 + fr] = O[mt][r];
    }
#pragma unroll
    for (int t = 0; t < 8; ++t) {
      S[t] = S[t] * gl;
      const int row = 16 * t + fr;
#pragma unroll
      for (int s = 0; s < 2; ++s) {
        const bf16x8 ak = *(const bf16x8*)(sKT + row * 128 + ((((s * 4 + fq) ^ (row & 7))) << 4));
        S[t] = __builtin_amdgcn_mfma_f32_16x16x32_bf16(ak, Vb[s], S[t], 0, 0, 0);
      }
    }
    if (nn + 1 < 64) DN_STORE_A();
  }
  __syncthreads();
#undef DN_LOAD_A
#undef DN_STORE_A
#undef DN_LOAD_B
#undef DN_STORE_B
}

__device__ __forceinline__ void ph_dn_post(int n, const float* __restrict__ o, const bf16_t* __restrict__ proj, const float* __restrict__ dn_norm_g, bf16_t* __restrict__ mixed) {
  const int tid = TIDX, h = tid >> 6, lane = tid & 63;
  const float o0 = o[(size_t)n * 512 + h * 128 + lane], o1 = o[(size_t)n * 512 + h * 128 + 64 + lane];
  const float ss = wave_sum(o0 * o0 + o1 * o1);
  const float rn = rsqrtf(ss * (1.f / 128.f) + RMS_EPS);
  const float z0 = bf2f(proj[(size_t)n * PROJW + OFF_Z + h * 128 + lane]), z1 = bf2f(proj[(size_t)n * PROJW + OFF_Z + h * 128 + 64 + lane]);
  mixed[(size_t)n * DM + h * 128 + lane] = (bf16_t)f2bf(o0 * rn * dn_norm_g[lane] * siluf(z0));
  mixed[(size_t)n * DM + h * 128 + 64 + lane] = (bf16_t)f2bf(o1 * rn * dn_norm_g[64 + lane] * siluf(z1));
}

__device__ __forceinline__ void ph_swa(unsigned char* smem, int item, const bf16_t* __restrict__ proj, const bf16_t* __restrict__ vt, const float* __restrict__ sinks, bf16_t* __restrict__ mixed) {
  const int tid = TIDX, lane = tid & 63, w = tid >> 6, fr = lane & 15, fq = lane >> 4;
  const int qb = item & 31, kvh = (item >> 5) & 1, b = item >> 6;
  const int t0 = qb * 128;
  const size_t rowb = (size_t)b * SEQ;
  unsigned char* sK = smem;
  unsigned char* sV = smem + 32768;
  __syncthreads();
#pragma unroll
  for (int i = 0; i < 8; ++i) {
    const int q = tid + 256 * i, row = q >> 3, ch = q & 7;
    const int pos = t0 - 128 + row;
    u32x4 v = (u32x4){0u, 0u, 0u, 0u};
    if (pos >= 0) v = *(const u32x4*)(proj + (rowb + pos) * PROJW + OFF_SK + kvh * 64 + ch * 8);
    *(u32x4*)(sK + row * 128 + ((ch ^ (row & 7)) << 4)) = v;
  }
#pragma unroll
  for (int i = 0; i < 8; ++i) {
    const int q = tid + 256 * i, row = q >> 5, ch = q & 31;
    const int pos = t0 - 128 + ch * 8;
    u32x4 v = (u32x4){0u, 0u, 0u, 0u};
    if (pos >= 0) v = *(const u32x4*)(vt + ((size_t)(b * 128 + kvh * 64 + row)) * SEQ + pos);
    *(u32x4*)(sV + row * 512 + ((ch ^ (row & 15)) << 4)) = v;
  }
  __syncthreads();
  const int head = kvh * 4 + w;
  const float slope = exp2f(-(float)(head + 1));
  const float sink = sinks[head];
#pragma unroll 1
  for (int qt = 0; qt < 8; ++qt) {
    const bf16_t* qp = proj + (rowb + t0 + qt * 16 + fr) * PROJW + OFF_SQ + head * 64 + fq * 8;
    const bf16x8 qf0 = *(const bf16x8*)(qp), qf1 = *(const bf16x8*)(qp + 32);
    const int kp0 = qt >> 1;
    f32x4 st[10];
#pragma unroll
    for (int kt = 0; kt < 10; ++kt) {
      const int krow = (2 * kp0 + kt) * 16 + fr;
      st[kt] = (f32x4){0.f, 0.f, 0.f, 0.f};
      const bf16x8 k0 = *(const bf16x8*)(sK + krow * 128 + (((0 + fq) ^ (krow & 7)) << 4));
      const bf16x8 k1 = *(const bf16x8*)(sK + krow * 128 + (((4 + fq) ^ (krow & 7)) << 4));
      st[kt] = __builtin_amdgcn_mfma_f32_16x16x32_bf16(k0, qf0, st[kt], 0, 0, 0);
      st[kt] = __builtin_amdgcn_mfma_f32_16x16x32_bf16(k1, qf1, st[kt], 0, 0, 0);
    }
    const int i = qt * 16 + fr;
    float mx = sink;
#pragma unroll
    for (int kt = 0; kt < 10; ++kt)
#pragma unroll
      for (int r = 0; r < 4; ++r) {
        const int jb = (2 * kp0 + kt) * 16 + 4 * fq + r;
        const int dist = 128 + i - jb;
        const bool ok = (dist >= 0) && (dist < 128) && (t0 - 128 + jb >= 0);
        const float s = ok ? (st[kt][r] * 0.125f - slope * (float)dist) : -INFINITY;
        st[kt][r] = s;
        mx = fmaxf(mx, s);
      }
    mx = fmaxf(mx, __shfl_xor(mx, 16));
    mx = fmaxf(mx, __shfl_xor(mx, 32));
    float sum = 0.f;
#pragma unroll
    for (int kt = 0; kt < 10; ++kt)
#pragma unroll
      for (int r = 0; r < 4; ++r) { const float p = __expf(st[kt][r] - mx); st[kt][r] = p; sum += p; }
    sum += __shfl_xor(sum, 16);
    sum += __shfl_xor(sum, 32);
    const float inv = 1.f / (sum + __expf(sink - mx));
    f32x4 O[4];
#pragma unroll
    for (int nt = 0; nt < 4; ++nt) O[nt] = (f32x4){0.f, 0.f, 0.f, 0.f};
#pragma unroll
    for (int s5 = 0; s5 < 5; ++s5) {
      const bf16x8 pa = pack8(st[2 * s5] * inv, st[2 * s5 + 1] * inv);
      const int key0 = (2 * kp0 + 2 * s5) * 16 + 4 * fq;
#pragma unroll
      for (int nt = 0; nt < 4; ++nt) {
        const int drow = nt * 16 + fr;
        const int c0 = key0 >> 3, c1 = (key0 + 16) >> 3;
        const u32x2 lo = *(const u32x2*)(sV + drow * 512 + ((c0 ^ (drow & 15)) << 4) + ((key0 >> 2) & 1) * 8);
        const u32x2 hi = *(const u32x2*)(sV + drow * 512 + ((c1 ^ (drow & 15)) << 4) + ((key0 >> 2) & 1) * 8);
        const u32x4 vb = (u32x4){lo[0], lo[1], hi[0], hi[1]};
        O[nt] = __builtin_amdgcn_mfma_f32_16x16x32_bf16(pa, __builtin_bit_cast(bf16x8, vb), O[nt], 0, 0, 0);
      }
    }
#pragma unroll
    for (int nt = 0; nt < 4; ++nt)
#pragma unroll
      for (int r = 0; r < 4; ++r)
        mixed[(rowb + t0 + qt * 16 + 4 * fq + r) * DM + 512 + head * 64 + nt * 16 + fr] = (bf16_t)f2bf(O[nt][r]);
  }
}

__device__ __forceinline__ void ph_wout(unsigned char* smem, int tile, const bf16_t* __restrict__ mixed, const float* __restrict__ w_out, const float* __restrict__ x, float* __restrict__ y1) {
  GEMM_IDS
  const int n0 = (tile & 7) * 128, m0 = (tile >> 3) * 128;
  LdRowBF16 al; al.init([&](int r) { return mixed + (size_t)(m0 + r) * DM; });
  LdColF32 bl; bl.init(w_out + n0 + 4 * (tid & 31), DM, true);
  f32x4 acc[4][4];
  gemm128(smem, al, bl, DM / 64, acc);
#pragma unroll
  for (int m = 0; m < 4; ++m)
#pragma unroll
    for (int n = 0; n < 4; ++n)
#pragma unroll
      for (int j = 0; j < 4; ++j) {
        const size_t idx = (size_t)(m0 + wr * 64 + m * 16 + fq * 4 + j) * DM + n0 + wc * 64 + n * 16 + fr;
        y1[idx] = ALPHA * x[idx] + acc[m][n][j];
      }
}

__device__ __forceinline__ void ph_ln1(int item, float* __restrict__ y, const float* __restrict__ gam, const float* __restrict__ bet, bf16_t* __restrict__ xbf) {
  const int row = item * 4 + (TIDX >> 6), lane = TIDX & 63;
  float4* p = (float4*)(y + (size_t)row * DM);
  float4 v[4]; float s = 0.f;
#pragma unroll
  for (int i = 0; i < 4; ++i) { v[i] = p[lane + i * 64]; s += v[i].x + v[i].y + v[i].z + v[i].w; }
  const float mu = wave_sum(s) * (1.f / DM);
  float q = 0.f;
#pragma unroll
  for (int i = 0; i < 4; ++i) { const float a = v[i].x - mu, b = v[i].y - mu, c = v[i].z - mu, d = v[i].w - mu; q += a * a + b * b + c * c + d * d; }
  const float rs = rsqrtf(wave_sum(q) * (1.f / DM) + LN_EPS);
#pragma unroll
  for (int i = 0; i < 4; ++i) {
    const float4 gg = ((const float4*)gam)[lane + i * 64], bb = ((const float4*)bet)[lane + i * 64];
    float4 r;
    r.x = (v[i].x - mu) * rs * gg.x + bb.x; r.y = (v[i].y - mu) * rs * gg.y + bb.y;
    r.z = (v[i].z - mu) * rs * gg.z + bb.z; r.w = (v[i].w - mu) * rs * gg.w + bb.w;
    p[lane + i * 64] = r;
    u32x2 w; w[0] = pack2(r.x, r.y); w[1] = pack2(r.z, r.w);
    ((u32x2*)(xbf + (size_t)row * DM))[lane + i * 64] = w;
  }
}

__device__ __forceinline__ void ph_router(unsigned char* smem, int tile, const bf16_t* __restrict__ xbf, const float* __restrict__ router_w, float* __restrict__ logits) {
  GEMM_IDS
  const int n0 = (tile & 1) * 128, m0 = (tile >> 1) * 128;
  LdRowBF16 al; al.init([&](int r) { return xbf + (size_t)(m0 + r) * DM; });
  LdColF32 bl; bl.init(router_w + n0 + 4 * (tid & 31), NEXP, true);
  f32x4 acc[4][4];
  gemm128(smem, al, bl, DM / 64, acc);
#pragma unroll
  for (int m = 0; m < 4; ++m)
#pragma unroll
    for (int n = 0; n < 4; ++n)
#pragma unroll
      for (int j = 0; j < 4; ++j)
        logits[(size_t)(m0 + wr * 64 + m * 16 + fq * 4 + j) * NEXP + n0 + wc * 64 + n * 16 + fr] = acc[m][n][j];
}

__device__ __forceinline__ void ph_route(int item, const float* __restrict__ logits, const float* __restrict__ router_bias, int* __restrict__ cnt, int* __restrict__ list, float* __restrict__ gates) {
  const int n = item * 4 + (TIDX >> 6), lane = TIDX & 63;
  const float4 lg = ((const float4*)(logits + (size_t)n * NEXP))[lane];
  const float4 rb = ((const float4*)router_bias)[lane];
  float sc[4] = {sigmoidf(lg.x), sigmoidf(lg.y), sigmoidf(lg.z), sigmoidf(lg.w)};
  float sel[4] = {sc[0] + rb.x, sc[1] + rb.y, sc[2] + rb.z, sc[3] + rb.w};
  float t1 = fmaxf(sel[0], sel[1]), t2 = fminf(sel[0], sel[1]);
  { const float a = sel[2]; if (a > t1) { t2 = t1; t1 = a; } else if (a > t2) t2 = a; }
  { const float a = sel[3]; if (a > t1) { t2 = t1; t1 = a; } else if (a > t2) t2 = a; }
#pragma unroll
  for (int o = 1; o < 8; o <<= 1) {
    const float b1 = __shfl_xor(t1, o), b2 = __shfl_xor(t2, o);
    const float n1 = fmaxf(t1, b1), n2 = fmaxf(fminf(t1, b1), fmaxf(t2, b2));
    t1 = n1; t2 = n2;
  }
  const float gs = t1 + t2;
  const int mygrp = lane >> 3;
  int rank = 0;
#pragma unroll
  for (int j = 0; j < 8; ++j) {
    const float o = __shfl(gs, j * 8);
    rank += (o > gs || (o == gs && j < mygrp)) ? 1 : 0;
  }
  const bool gsel = rank < 4;
  float cand[4];
#pragma unroll
  for (int i = 0; i < 4; ++i) cand[i] = gsel ? sel[i] : -INFINITY;
  float gsum = 0.f; float myg = 0.f; int mye = 0;
#pragma unroll 1
  for (int r = 0; r < TOPK; ++r) {
    float bv = cand[0]; int bi = 0;
#pragma unroll
    for (int i = 1; i < 4; ++i) if (cand[i] > bv) { bv = cand[i]; bi = i; }
    int be = lane * 4 + bi;
    float bs = (bi == 0) ? sc[0] : (bi == 1) ? sc[1] : (bi == 2) ? sc[2] : sc[3];
#pragma unroll
    for (int o = 1; o < 64; o <<= 1) {
      const float ov = __shfl_xor(bv, o); const int oe = __shfl_xor(be, o); const float os = __shfl_xor(bs, o);
      if (ov > bv || (ov == bv && oe < be)) { bv = ov; be = oe; bs = os; }
    }
    if ((be >> 2) == lane) {
      const int bi2 = be & 3;
      if (bi2 == 0) cand[0] = -INFINITY; else if (bi2 == 1) cand[1] = -INFINITY; else if (bi2 == 2) cand[2] = -INFINITY; else cand[3] = -INFINITY;
    }
    gsum += bs;
    if (lane == r) { myg = bs; mye = be; }
  }
  if (lane < TOPK) {
    const int slot = atomicAdd(&cnt[mye], 1);
    list[(size_t)mye * CAP + slot] = n * TOPK + lane;
    gates[(size_t)n * TOPK + lane] = myg / gsum * 2.5f;
  }
}

__device__ __forceinline__ int moe_build_prefix(const int* __restrict__ cnt, int* sscan) {
  const int tid = TIDX;
  const int c = cnt[tid];
  __syncthreads();
  sscan[tid] = (c + 127) >> 7;
  __syncthreads();
  for (int o = 1; o < 256; o <<= 1) {
    const int v = (tid >= o) ? sscan[tid - o] : 0;
    __syncthreads();
    sscan[tid] += v;
    __syncthreads();
  }
  return sscan[255];
}
__device__ __forceinline__ void moe_locate(const int* sscan, int total, int rtile, int& e, int& rt) {
  if (rtile >= total) { e = 256; rt = rtile - total; return; }
  int lo = 0, hi = 255;
  while (lo < hi) { const int mid = (lo + hi) >> 1; if (sscan[mid] > rtile) hi = mid; else lo = mid + 1; }
  e = lo; rt = rtile - (lo ? sscan[lo - 1] : 0);
}

__device__ __forceinline__ void ph_moe1(unsigned char* smem, int e, int rt, int ct, const bf16_t* __restrict__ xbf, const int* __restrict__ cnt, const int* __restrict__ list,
                                        const float* __restrict__ w_gate, const float* __restrict__ w_up,
                                        const float* __restrict__ sw_gate, const float* __restrict__ sw_up, bf16_t* __restrict__ hbuf) {
  int* sasg = (int*)(smem + SM_MISC + 2048);
  GEMM_IDS
  const int rows = (e < 256) ? cnt[e] : NTOK;
  if (tid < 128) {
    const int r = rt * 128 + tid;
    int a = -1;
    if (r < rows) a = (e < 256) ? list[(size_t)e * CAP + r] : (NA + r);
    sasg[tid] = a;
  }
  __syncthreads();
  LdRowBF16 al; al.init([&](int r) { const int a = sasg[r]; const int tok = (a < 0) ? 0 : (a < NA ? (a >> 3) : (a - NA)); return xbf + (size_t)tok * DM; });
  LdColF32 bl;
  {
    const int jj = 4 * (tid & 31);
    const int bwc = jj >> 6, bn = (jj >> 4) & 3;
    const int ff = ct * 64 + bwc * 32 + (bn >> 1) * 16 + (jj & 15);
    const float* W = (e < 256) ? ((bn & 1) ? w_up : w_gate) + (size_t)e * DM * EFF : ((bn & 1) ? sw_up : sw_gate);
    bl.init(W + ff, EFF, true);
  }
  f32x4 acc[4][4];
  gemm128(smem, al, bl, DM / 64, acc);
#pragma unroll
  for (int m = 0; m < 4; ++m)
#pragma unroll
    for (int pp = 0; pp < 2; ++pp)
#pragma unroll
      for (int j = 0; j < 4; ++j) {
        const int r = wr * 64 + m * 16 + fq * 4 + j;
        const int a = sasg[r];
        if (a >= 0) {
          const float gv = acc[m][2 * pp][j], uv = acc[m][2 * pp + 1][j];
          hbuf[(size_t)a * EFF + ct * 64 + wc * 32 + pp * 16 + fr] = (bf16_t)f2bf(siluf(gv) * uv);
        }
      }
  __syncthreads();
}

__device__ __forceinline__ void ph_moe2(unsigned char* smem, int e, int rt, int ct, const bf16_t* __restrict__ hbuf, const int* __restrict__ cnt, const int* __restrict__ list, const float* __restrict__ gates,
                                        const float* __restrict__ w_down, const float* __restrict__ sw_down, bf16_t* __restrict__ ybuf) {
  int* sasg = (int*)(smem + SM_MISC + 2048);
  float* sgate = (float*)(smem + SM_MISC + 2048 + 512);
  GEMM_IDS
  const int rows = (e < 256) ? cnt[e] : NTOK;
  const int n0 = ct * 128;
  if (tid < 128) {
    const int r = rt * 128 + tid;
    int a = -1;
    if (r < rows) a = (e < 256) ? list[(size_t)e * CAP + r] : (NA + r);
    sasg[tid] = a;
    sgate[tid] = (a >= 0 && a < NA) ? gates[a] : 1.f;
  }
  __syncthreads();
  LdRowBF16 al; al.init([&](int r) { const int a = sasg[r]; return hbuf + (size_t)(a < 0 ? 0 : a) * EFF; });
  LdColF32 bl; bl.init(((e < 256) ? w_down + (size_t)e * EFF * DM : sw_down) + n0 + 4 * (tid & 31), DM, true);
  f32x4 acc[4][4];
  gemm128(smem, al, bl, EFF / 64, acc);
#pragma unroll
  for (int m = 0; m < 4; ++m)
#pragma unroll
    for (int n = 0; n < 4; ++n)
#pragma unroll
      for (int j = 0; j < 4; ++j) {
        const int r = wr * 64 + m * 16 + fq * 4 + j;
        const int a = sasg[r];
        if (a >= 0) ybuf[(size_t)a * DM + n0 + wc * 64 + n * 16 + fr] = (bf16_t)f2bf(acc[m][n][j] * sgate[r]);
      }
  __syncthreads();
}

__device__ __forceinline__ void ph_final(int item, float* __restrict__ out, const bf16_t* __restrict__ ybuf, const float* __restrict__ gam, const float* __restrict__ bet) {
  const int row = item * 4 + (TIDX >> 6), lane = TIDX & 63;
  float4* p = (float4*)(out + (size_t)row * DM);
  float4 v[4]; float s = 0.f;
#pragma unroll
  for (int i = 0; i < 4; ++i) {
    float4 a = p[lane + i * 64];
    a.x *= ALPHA; a.y *= ALPHA; a.z *= ALPHA; a.w *= ALPHA;
#pragma unroll
    for (int k = 0; k < 9; ++k) {
      const size_t yr = (k < 8) ? ((size_t)row * 8 + k) : ((size_t)NA + row);
      const uint2 w = ((const uint2*)(ybuf + yr * DM))[lane + i * 64];
      a.x += bflo(w.x); a.y += bfhi(w.x); a.z += bflo(w.y); a.w += bfhi(w.y);
    }
    v[i] = a; s += a.x + a.y + a.z + a.w;
  }
  const float mu = wave_sum(s) * (1.f / DM);
  float q = 0.f;
#pragma unroll
  for (int i = 0; i < 4; ++i) { const float a = v[i].x - mu, b = v[i].y - mu, c = v[i].z - mu, d = v[i].w - mu; q += a * a + b * b + c * c + d * d; }
  const float rs = rsqrtf(wave_sum(q) * (1.f / DM) + LN_EPS);
#pragma unroll
  for (int i = 0; i < 4; ++i) {
    const float4 gg = ((const float4*)gam)[lane + i * 64], bb = ((const float4*)bet)[lane + i * 64];
    float4 r;
    r.x = (v[i].x - mu) * rs * gg.x + bb.x; r.y = (v[i].y - mu) * rs * gg.y + bb.y;
    r.z = (v[i].z - mu) * rs * gg.z + bb.z; r.w = (v[i].w - mu) * rs * gg.w + bb.w;
    p[lane + i * 64] = r;
  }
}

#define XB_TMO      128
#define XB_XCNT(j)  (256  + 64 * (j))
#define XB_XSUB(j)  (1280 + 64 * (j))
#define XB_XGEN(j)  (2304 + 64 * (j))
#define XB_TOP      3328
#define XB_TOPGEN   3392
#define XCD_BAR_WORDS 3456
#define XB_SPIN_CAP (1u << 22)
#define LAS __attribute__((address_space(3)))
__device__ __forceinline__ unsigned xb_ld(unsigned* p)              { return __hip_atomic_load(p, __ATOMIC_RELAXED, __HIP_MEMORY_SCOPE_AGENT); }
__device__ __forceinline__ unsigned xb_add(unsigned* p, unsigned v) { return __hip_atomic_fetch_add(p, v, __ATOMIC_RELAXED, __HIP_MEMORY_SCOPE_AGENT); }
__device__ __forceinline__ unsigned xb_xcc_id() { return (unsigned)__builtin_amdgcn_s_getreg((3 << 11) | 20) & 0xFu; }
#define XB_SPIN(cond, bar) do { unsigned _sp = 0; while (cond) { __builtin_amdgcn_s_sleep(1); \
    if ((++_sp & 255u) == 0u) { if (xb_ld(&(bar)[XB_TMO])) break; if (_sp > XB_SPIN_CAP) { atomicAdd(&(bar)[XB_TMO], 1u); break; } } } } while (0)
struct XcdBarrier { unsigned* bar; unsigned x; volatile LAS unsigned* st; };
__device__ __forceinline__ XcdBarrier xcd_barrier_post(unsigned* bar, volatile LAS unsigned* st) {
  XcdBarrier b; b.bar = bar; b.x = xb_xcc_id(); b.st = st;
  if (threadIdx.x == 0) (void)xb_add(&bar[XB_XCNT(b.x)], 1u);
  return b;
}
__device__ __forceinline__ void xcd_barrier_complete(unsigned* bar, unsigned x, unsigned& nloc, unsigned& nx) {
  const unsigned G = gridDim.x * gridDim.y * gridDim.z;
  unsigned sum, cnt, mine, sp = 0u;
  for (;;) {
    sum = 0u; cnt = 0u; mine = 0u;
#pragma unroll
    for (unsigned j = 0; j < 16; ++j) { const unsigned c = xb_ld(&bar[XB_XCNT(j)]); sum += c; cnt += (c > 0u) ? 1u : 0u; mine = (j == x) ? c : mine; }
    if (sum == G) break;
    __builtin_amdgcn_s_sleep(1);
    if ((++sp & 255u) == 0u) { if (xb_ld(&bar[XB_TMO])) break; if (sp > XB_SPIN_CAP) { atomicAdd(&bar[XB_TMO], 1u); break; } }
  }
  nloc = mine > 0u ? mine : 1u; nx = cnt > 0u ? cnt : 1u;
}
__device__ __forceinline__ void xcd_barrier(const XcdBarrier& b) {
  asm volatile("s_waitcnt vmcnt(0)" ::: "memory");
  __syncthreads();
  if (threadIdx.x == 0) {
    unsigned* bar = b.bar;
    __builtin_amdgcn_s_waitcnt(0);
    unsigned nloc = b.st[0], nx = b.st[1];
    if (nloc == 0u) { xcd_barrier_complete(bar, b.x, nloc, nx); b.st[0] = nloc; b.st[1] = nx; }
    const unsigned old = xb_add(&bar[XB_XSUB(b.x)], 1u);
    const unsigned gen = old / nloc;
    if (old + 1u == (gen + 1u) * nloc) {
      __builtin_amdgcn_fence(__ATOMIC_RELEASE, "agent");
      asm volatile("s_waitcnt vmcnt(0)" ::: "memory");
      const unsigned og = xb_add(&bar[XB_TOP], 1u);
      const unsigned tg = og / nx;
      if (og + 1u == (tg + 1u) * nx) xb_add(&bar[XB_TOPGEN], 1u);
      else XB_SPIN(xb_ld(&bar[XB_TOPGEN]) == tg, bar);
      __builtin_amdgcn_fence(__ATOMIC_ACQUIRE, "agent");
      xb_add(&bar[XB_XGEN(b.x)], 1u);
      asm volatile("s_waitcnt vmcnt(0)" ::: "memory");
    } else {
      XB_SPIN(xb_ld(&bar[XB_XGEN(b.x)]) == gen, bar);
      __builtin_amdgcn_fence(__ATOMIC_ACQUIRE, "agent");
      asm volatile("s_waitcnt vmcnt(0)" ::: "memory");
    }
  }
  __syncthreads();
}

__global__ void __launch_bounds__(256, 2) mega(Params P) {
  __shared__ __attribute__((aligned(16))) unsigned char smem[SMEM_BYTES];
  cg::grid_group grid = cg::this_grid();
  const int bid = blockIdx.x, nblk = gridDim.x;
#define xin (P.in[0])
#define w_in (P.in[1])
#define conv_w (P.in[2])
#define a_log (P.in[3])
#define dt_bias (P.in[4])
#define dn_norm_g (P.in[5])
#define sinks (P.in[6])
#define w_out (P.in[7])
#define ln1_g (P.in[8])
#define ln1_b (P.in[9])
#define router_w (P.in[10])
#define router_bias (P.in[11])
#define w_gate (P.in[12])
#define w_up (P.in[13])
#define w_down (P.in[14])
#define sw_gate (P.in[15])
#define sw_up (P.in[16])
#define sw_down (P.in[17])
#define ln2_g (P.in[18])
#define ln2_b (P.in[19])
#define outp (P.out)
#define x1bf ((bf16_t*)(P.ws + WS_X1BF))
#define logits ((float*)(P.ws + WS_LOGIT))
#define list ((int*)(P.ws + WS_LIST))
#define gates ((float*)(P.ws + WS_GATES))
#define cnt ((int*)(P.ws + WS_CTRL))
#define barw ((unsigned*)(P.ws + WS_CTRL + 4096))
#define mixed ((bf16_t*)(P.ws + WS_MIXED))
#define proj ((bf16_t*)(P.ws + WS_PROJ))
#define ba ((float*)(P.ws + WS_BA))
#define QD ((bf16_t*)(P.ws + WS_QD))
#define W0N ((bf16_t*)(P.ws + WS_W0N))
#define KTT ((bf16_t*)(P.ws + WS_KTT))
#define RV ((bf16_t*)(P.ws + WS_RV))
#define TM ((bf16_t*)(P.ws + WS_TM))
#define ATT ((bf16_t*)(P.ws + WS_ATT))
#define GL ((float*)(P.ws + WS_GL))
#define obuf ((float*)(P.ws + WS_O))
#define VTb ((bf16_t*)(P.ws + WS_VT))
#define hbuf ((bf16_t*)(P.ws + WS_HBUF))
#define ybuf ((bf16_t*)(P.ws + WS_YBUF))
  {
    volatile LAS unsigned* st0 = (volatile LAS unsigned*)(smem + SM_MISC + 4080);
    if (threadIdx.x == 0) { st0[0] = 0u; st0[1] = 0u; }
    __syncthreads();
  }
  XcdBarrier xb = xcd_barrier_post(barw, (volatile LAS unsigned*)(smem + SM_MISC + 4080));
  for (int t = bid; t < 23 * (NTOK / 128); t += nblk) ph_proj(smem, t, xin, w_in, proj, ba, VTb);
  grid.sync();
  for (int it = bid; it < 2048; it += nblk) ph_dnchunk(smem, it, proj, ba, conv_w, a_log, dt_bias, QD, W0N, KTT, RV, TM, ATT, GL);
  for (int it = bid; it < 512; it += nblk) ph_swa(smem, it, proj, VTb, sinks, mixed);
  xcd_barrier(xb);
  for (int it = bid; it < 64; it += nblk) ph_dnscan(smem, it, QD, W0N, KTT, RV, TM, ATT, GL, obuf);
  xcd_barrier(xb);
  for (int n = bid; n < NTOK; n += nblk) ph_dn_post(n, obuf, proj, dn_norm_g, mixed);
  xcd_barrier(xb);
  for (int t = bid; t < 8 * (NTOK / 128); t += nblk) ph_wout(smem, t, mixed, w_out, xin, outp);
  xcd_barrier(xb);
  for (int it = bid; it < NTOK / 4; it += nblk) ph_ln1(it, outp, ln1_g, ln1_b, x1bf);
  xcd_barrier(xb);
  for (int t = bid; t < 2 * (NTOK / 128); t += nblk) ph_router(smem, t, x1bf, router_w, logits);
  xcd_barrier(xb);
  for (int it = bid; it < NTOK / 4; it += nblk) ph_route(it, logits, router_bias, cnt, list, gates);
  xcd_barrier(xb);
  int* sscan = (int*)(smem + SM_MISC);
  const int total = moe_build_prefix(cnt, sscan);
  const int ntile = total + NTOK / 128;
  for (int it = bid; it < ntile * 4; it += nblk) {
    int e, rt; moe_locate(sscan, total, it >> 2, e, rt);
    ph_moe1(smem, e, rt, it & 3, x1bf, cnt, list, w_gate, w_up, sw_gate, sw_up, hbuf);
  }
  xcd_barrier(xb);
  for (int it = bid; it < ntile * 8; it += nblk) {
    int e, rt; moe_locate(sscan, total, it >> 3, e, rt);
    ph_moe2(smem, e, rt, it & 7, hbuf, cnt, list, gates, w_down, sw_down, ybuf);
  }
  xcd_barrier(xb);
  for (int it = bid; it < NTOK / 4; it += nblk) ph_final(it, outp, ybuf, ln2_g, ln2_b);
}

#undef xin
#undef w_in
#undef conv_w
#undef a_log
#undef dt_bias
#undef dn_norm_g
#undef sinks
#undef w_out
#undef ln1_g
#undef ln1_b
#undef router_w
#undef router_bias
#undef w_gate
#undef w_up
#undef w_down
#undef sw_gate
#undef sw_up
#undef sw_down
#undef ln2_g
#undef ln2_b
#undef outp
#undef x1bf
#undef logits
#undef list
#undef gates
#undef cnt
#undef mixed
#undef proj
#undef ba
#undef QD
#undef W0N
#undef KTT
#undef RV
#undef TM
#undef ATT
#undef GL
#undef obuf
#undef hbuf
#undef ybuf
#undef VTb
#undef barw

extern "C" void kernel_launch(void* const* d_in, const int* in_sizes, int n_in, void* d_out, int out_size, void* d_ws, size_t ws_size, hipStream_t stream) {
  static int grid_blocks = 0;
  if (!grid_blocks) {
    int dev = 0, cus = 0, per_cu = 0;
    (void)hipGetDevice(&dev);
    (void)hipDeviceGetAttribute(&cus, hipDeviceAttributeMultiprocessorCount, dev);
    (void)hipOccupancyMaxActiveBlocksPerMultiprocessor(&per_cu, mega, 256, 0);
    if (per_cu > 2) per_cu = 2;
    if (per_cu < 1) per_cu = 1;
    grid_blocks = cus * per_cu;
  }
  Params p{};
  for (int i = 0; i < 20; ++i) p.in[i] = (const float*)d_in[i];
  p.out = (float*)d_out; p.ws = (char*)d_ws;
  (void)hipMemsetAsync((char*)d_ws + WS_CTRL, 0, 4096 + XCD_BAR_WORDS * 4, stream);
  void* args[] = {&p};
  hipError_t e = hipLaunchCooperativeKernel((void*)mega, dim3(grid_blocks), dim3(256), args, 0, stream);
  if (e != hipSuccess) fprintf(stderr, "cooperative launch failed: %s (grid %d)\n", hipGetErrorString(e), grid_blocks);
}
```

```cpp
#include <hip/hip_runtime.h>
#include <hip/hip_cooperative_groups.h>
#include <stdint.h>
#include <stdio.h>
namespace cg = cooperative_groups;

typedef __attribute__((ext_vector_type(8))) short bf16x8;
typedef __attribute__((ext_vector_type(4))) float f32x4;
typedef unsigned short bf16_t;
typedef __attribute__((ext_vector_type(4))) unsigned u32x4;
typedef __attribute__((ext_vector_type(2))) unsigned u32x2;

constexpr int NTOK = 32768, SEQ = 4096, DM = 1024;
constexpr int INC = 2824, PROJW = 2816;
constexpr int OFF_DQ = 0, OFF_DK = 512, OFF_DV = 1024, OFF_SQ = 1536, OFF_SK = 2048, OFF_SV = 2176, OFF_Z = 2304;
constexpr int NEXP = 256, TOPK = 8, EFF = 256;
constexpr int NA = NTOK * TOPK;
constexpr int CAP = NTOK;
constexpr float ALPHA = 1.189207115002721f;
constexpr float LN_EPS = 1e-5f, RMS_EPS = 1e-6f, L2_EPS = 1e-6f;

constexpr size_t MiB = 1024ull * 1024ull;
constexpr size_t WS_X1BF = 0;
constexpr size_t WS_LOGIT = 64 * MiB;
constexpr size_t WS_LIST = 96 * MiB;
constexpr size_t WS_GATES = 128 * MiB;
constexpr size_t WS_CTRL = 129 * MiB;
constexpr size_t WS_MIXED = 130 * MiB;
constexpr size_t WS_PROJ = 200 * MiB;
constexpr size_t WS_BA = 376 * MiB;
constexpr size_t WS_QD = 377 * MiB;
constexpr size_t WS_W0N = 409 * MiB;
constexpr size_t WS_KTT = 441 * MiB;
constexpr size_t WS_RV = 473 * MiB;
constexpr size_t WS_TM = 505 * MiB;
constexpr size_t WS_ATT = 521 * MiB;
constexpr size_t WS_GL = 537 * MiB;
constexpr size_t WS_O = 538 * MiB;
constexpr size_t WS_VT = 602 * MiB;
constexpr size_t WS_HBUF = 200 * MiB;
constexpr size_t WS_YBUF = 344 * MiB;

__device__ __forceinline__ int opaque_tid() { int t = threadIdx.x; asm volatile("" : "+v"(t)); return t; }
#define TIDX opaque_tid()
typedef __attribute__((ext_vector_type(2))) __bf16 hwbf16x2;
typedef __attribute__((ext_vector_type(2))) float hwf32x2;
__device__ __forceinline__ unsigned pack2(float lo, float hi) {
  hwf32x2 f = {lo, hi};
  return __builtin_bit_cast(unsigned, __builtin_convertvector(f, hwbf16x2));
}
__device__ __forceinline__ unsigned f2bf(float f) { return pack2(f, 0.f) & 0xffffu; }
__device__ __forceinline__ float bf2f(unsigned h) { return __uint_as_float(h << 16); }
__device__ __forceinline__ float bflo(unsigned w) { return __uint_as_float(w << 16); }
__device__ __forceinline__ float bfhi(unsigned w) { return __uint_as_float(w & 0xffff0000u); }
__device__ __forceinline__ float siluf(float x) { return x / (1.f + __expf(-x)); }
__device__ __forceinline__ float sigmoidf(float x) { return 1.f / (1.f + __expf(-x)); }
__device__ __forceinline__ float wave_sum(float v) {
#pragma unroll
  for (int o = 32; o > 0; o >>= 1) v += __shfl_xor(v, o);
  return v;
}

struct LdRowF32 {
  const char* p[8]; f32x4 r[8]; int row0, ch4;
  template <class F> __device__ __forceinline__ void init(F rowptr) {
    const int tid = TIDX; ch4 = tid & 15; row0 = tid >> 4;
#pragma unroll
    for (int i = 0; i < 8; ++i) p[i] = (const char*)rowptr(row0 + i * 16) + ch4 * 16;
  }
  __device__ __forceinline__ void load(int kt) {
#pragma unroll
    for (int i = 0; i < 8; ++i) r[i] = *(const f32x4*)(p[i] + (size_t)kt * 256);
  }
  __device__ __forceinline__ void store(unsigned char* s) {
#pragma unroll
    for (int i = 0; i < 8; ++i) {
      const int row = row0 + i * 16;
      u32x2 w; w[0] = pack2(r[i][0], r[i][1]); w[1] = pack2(r[i][2], r[i][3]);
      *(u32x2*)(s + row * 128 + ((((ch4 >> 1) ^ (row & 7))) << 4) + (ch4 & 1) * 8) = w;
    }
  }
};
struct LdRowBF16 {
  const char* p[4]; u32x4 r[4]; int row0, ch;
  template <class F> __device__ __forceinline__ void init(F rowptr) {
    const int tid = TIDX; ch = tid & 7; row0 = tid >> 3;
#pragma unroll
    for (int i = 0; i < 4; ++i) p[i] = (const char*)rowptr(row0 + i * 32) + ch * 16;
  }
  __device__ __forceinline__ void load(int kt) {
#pragma unroll
    for (int i = 0; i < 4; ++i) r[i] = *(const u32x4*)(p[i] + (size_t)kt * 128);
  }
  __device__ __forceinline__ void store(unsigned char* s) {
#pragma unroll
    for (int i = 0; i < 4; ++i) {
      const int row = row0 + i * 32;
      *(u32x4*)(s + row * 128 + ((ch ^ (row & 7)) << 4)) = r[i];
    }
  }
};
struct LdColF32 {
  const char* p; size_t ldb; f32x4 r[8]; int n4, kg; bool valid;
  __device__ __forceinline__ void init(const float* colptr, size_t ld, bool v) {
    const int tid = TIDX; n4 = tid & 31; kg = tid >> 5; ldb = ld * 4; valid = v;
    p = (const char*)colptr + (size_t)(kg * 8) * ldb;
  }
  __device__ __forceinline__ void load(int kt) {
#pragma unroll
    for (int j = 0; j < 8; ++j) {
      if (valid) r[j] = *(const f32x4*)(p + (size_t)(kt * 64 + j) * ldb);
      else r[j] = (f32x4){0.f, 0.f, 0.f, 0.f};
    }
  }
  __device__ __forceinline__ void store(unsigned char* s) {
    {
      const int row = n4 * 4 + 0; u32x4 w;
      w[0] = pack2(r[0][0], r[1][0]); w[1] = pack2(r[2][0], r[3][0]); w[2] = pack2(r[4][0], r[5][0]); w[3] = pack2(r[6][0], r[7][0]);
      *(u32x4*)(s + row * 128 + ((kg ^ (row & 7)) << 4)) = w;
    }
    {
      const int row = n4 * 4 + 1; u32x4 w;
      w[0] = pack2(r[0][1], r[1][1]); w[1] = pack2(r[2][1], r[3][1]); w[2] = pack2(r[4][1], r[5][1]); w[3] = pack2(r[6][1], r[7][1]);
      *(u32x4*)(s + row * 128 + ((kg ^ (row & 7)) << 4)) = w;
    }
    {
      const int row = n4 * 4 + 2; u32x4 w;
      w[0] = pack2(r[0][2], r[1][2]); w[1] = pack2(r[2][2], r[3][2]); w[2] = pack2(r[4][2], r[5][2]); w[3] = pack2(r[6][2], r[7][2]);
      *(u32x4*)(s + row * 128 + ((kg ^ (row & 7)) << 4)) = w;
    }
    {
      const int row = n4 * 4 + 3; u32x4 w;
      w[0] = pack2(r[0][3], r[1][3]); w[1] = pack2(r[2][3], r[3][3]); w[2] = pack2(r[4][3], r[5][3]); w[3] = pack2(r[6][3], r[7][3]);
      *(u32x4*)(s + row * 128 + ((kg ^ (row & 7)) << 4)) = w;
    }
  }
};

template <class AL, class BL>
__device__ __forceinline__ void gemm128(unsigned char* smem, AL& al, BL& bl, int nk, f32x4 (&acc)[4][4]) {
  const int tid = TIDX, lane = tid & 63, wid = tid >> 6, wr = wid >> 1, wc = wid & 1, fr = lane & 15, fq = lane >> 4;
#pragma unroll
  for (int m = 0; m < 4; ++m)
#pragma unroll
    for (int n = 0; n < 4; ++n) acc[m][n] = (f32x4){0.f, 0.f, 0.f, 0.f};
  al.load(0); bl.load(0);
  al.store(smem); bl.store(smem + 16384);
  if (nk > 1) { al.load(1); bl.load(1); }
  __syncthreads();
  for (int kt = 0; kt < nk; ++kt) {
    unsigned char* sA = smem + (kt & 1) * 32768; unsigned char* sB = sA + 16384;
    unsigned char* sAn = smem + ((kt & 1) ^ 1) * 32768;
    if (kt + 1 < nk) { al.store(sAn); bl.store(sAn + 16384); }
    if (kt + 2 < nk) { al.load(kt + 2); bl.load(kt + 2); }
#pragma unroll
    for (int ks = 0; ks < 2; ++ks) {
      bf16x8 a[4], b[4];
#pragma unroll
      for (int m = 0; m < 4; ++m) {
        const int row = wr * 64 + m * 16 + fr;
        a[m] = *(const bf16x8*)(sA + row * 128 + (((ks * 4 + fq) ^ (row & 7)) << 4));
      }
#pragma unroll
      for (int n = 0; n < 4; ++n) {
        const int row = wc * 64 + n * 16 + fr;
        b[n] = *(const bf16x8*)(sB + row * 128 + (((ks * 4 + fq) ^ (row & 7)) << 4));
      }
#pragma unroll
      for (int m = 0; m < 4; ++m)
#pragma unroll
        for (int n = 0; n < 4; ++n) acc[m][n] = __builtin_amdgcn_mfma_f32_16x16x32_bf16(b[n], a[m], acc[m][n], 0, 0, 0);
    }
    __syncthreads();
  }
}

#define GEMM_IDS const int tid = TIDX, lane = tid & 63, wid = tid >> 6, wr = wid >> 1, wc = wid & 1, fr = lane & 15, fq = lane >> 4; (void)tid; (void)lane;

struct Params {
  const float* in[20];
  float* out;
  char* ws;
};

constexpr int SMEM_BYTES = 69632;
constexpr int SM_MISC = 65536;

__device__ __forceinline__ void ph_proj(unsigned char* smem, int tile, const float* __restrict__ x, const float* __restrict__ w_in, bf16_t* __restrict__ proj, float* __restrict__ ba, bf16_t* __restrict__ vt) {
  GEMM_IDS
  const int n0 = (tile % 23) * 128, m0 = (tile / 23) * 128;
  LdRowF32 al; al.init([&](int r) { return x + (size_t)(m0 + r) * DM; });
  LdColF32 bl; { const int col = n0 + 4 * (tid & 31); const bool v = col < INC; bl.init(w_in + (v ? col : 0), INC, v); }
  f32x4 acc[4][4];
  gemm128(smem, al, bl, DM / 64, acc);
#pragma unroll
  for (int m = 0; m < 4; ++m)
#pragma unroll
    for (int n = 0; n < 4; ++n) {
      const int row = m0 + wr * 64 + m * 16 + fr, col = n0 + wc * 64 + n * 16 + fq * 4;
      if (col < PROJW) {
        u32x2 w; w[0] = pack2(acc[m][n][0], acc[m][n][1]); w[1] = pack2(acc[m][n][2], acc[m][n][3]);
        *(u32x2*)(proj + (size_t)row * PROJW + col) = w;
      } else if (col < INC) {
        *(f32x4*)(ba + (size_t)row * 8 + (col - PROJW)) = acc[m][n];
      }
    }
  if (n0 == OFF_SV) {
#pragma unroll
    for (int m = 0; m < 4; ++m)
#pragma unroll
      for (int n = 0; n < 4; ++n) {
        const int row = m0 + wr * 64 + m * 16 + fr, c = wc * 64 + n * 16 + fq * 4;
        const int bb = row / SEQ, t = row % SEQ;
#pragma unroll
        for (int r = 0; r < 4; ++r) vt[((size_t)(bb * 128 + c + r)) * SEQ + t] = (bf16_t)f2bf(acc[m][n][r]);
      }
  }
}

__device__ __forceinline__ bf16x8 pack8(f32x4 a, f32x4 b) {
  union { bf16x8 v; unsigned u[4]; } x;
  x.u[0] = pack2(a[0], a[1]); x.u[1] = pack2(a[2], a[3]); x.u[2] = pack2(b[0], b[1]); x.u[3] = pack2(b[2], b[3]);
  return x.v;
}
__device__ __forceinline__ void ph_dnchunk(unsigned char* smem, int item, const bf16_t* __restrict__ proj, const float* __restrict__ ba, const float* __restrict__ conv_w,
                                           const float* __restrict__ a_log, const float* __restrict__ dt_bias,
                                           bf16_t* __restrict__ QD, bf16_t* __restrict__ W0N, bf16_t* __restrict__ KTT, bf16_t* __restrict__ RV,
                                           bf16_t* __restrict__ TM, bf16_t* __restrict__ ATT, float* __restrict__ GL) {
  const int tid = TIDX, lane = tid & 63, w = tid >> 6, fr = lane & 15, fq = lane >> 4;
  const int n = item & 63, h = (item >> 6) & 3, b = item >> 8;
  const int t0 = n * 64; const size_t row0 = (size_t)b * SEQ + t0;
  unsigned char* qs = smem; unsigned char* ks = smem + 16384; float* AT = (float*)(smem + 32768);
  const float scale = 0.08838834764831845f;
  float bL, gcL;
  {
    const float* bap = ba + (row0 + lane) * 8;
    bL = sigmoidf(bap[h]);
    const float xx = bap[4 + h] + dt_bias[h];
    const float sp = fmaxf(xx, 0.f) + log1pf(__expf(-fabsf(xx)));
    float gg = -__expf(a_log[h]) * sp;
#pragma unroll
    for (int o = 1; o < 64; o <<= 1) { const float v = __shfl_up(gg, o); if (lane >= o) gg += v; }
    gcL = gg;
  }
  {
    const int d = 2 * lane;
    float cw[3][4][2], xw[3][4][2];
#pragma unroll
    for (int mx = 0; mx < 3; ++mx)
#pragma unroll
      for (int j = 0; j < 4; ++j) {
        const float2 c2 = *(const float2*)(conv_w + j * 1536 + mx * 512 + h * 128 + d);
        cw[mx][j][0] = c2.x; cw[mx][j][1] = c2.y;
      }
    const bf16_t* pbase = proj + (row0 + 16 * w) * PROJW + h * 128 + d;
#pragma unroll
    for (int j = 0; j < 3; ++j) {
      const bool ok = (t0 + 16 * w - 3 + j) >= 0;
#pragma unroll
      for (int mx = 0; mx < 3; ++mx) {
        unsigned u = 0;
        if (ok) u = *(const unsigned*)(pbase + (ptrdiff_t)(j - 3) * PROJW + mx * 512);
        xw[mx][j + 1][0] = bflo(u); xw[mx][j + 1][1] = bfhi(u);
      }
    }
#pragma unroll
    for (int i = 0; i < 16; ++i) {
      float s[3][2];
#pragma unroll
      for (int mx = 0; mx < 3; ++mx) {
        const unsigned u = *(const unsigned*)(pbase + (size_t)i * PROJW + mx * 512);
#pragma unroll
        for (int j = 0; j < 3; ++j) { xw[mx][j][0] = xw[mx][j + 1][0]; xw[mx][j][1] = xw[mx][j + 1][1]; }
        xw[mx][3][0] = bflo(u); xw[mx][3][1] = bfhi(u);
        float y0 = 0.f, y1 = 0.f;
#pragma unroll
        for (int j = 0; j < 4; ++j) { y0 += cw[mx][j][0] * xw[mx][j][0]; y1 += cw[mx][j][1] * xw[mx][j][1]; }
        s[mx][0] = siluf(y0); s[mx][1] = siluf(y1);
      }
      const int row = 16 * w + i;
      const float rq = rsqrtf(wave_sum(s[0][0] * s[0][0] + s[0][1] * s[0][1]) + L2_EPS);
      const float rk = rsqrtf(wave_sum(s[1][0] * s[1][0] + s[1][1] * s[1][1]) + L2_EPS);
      const int off = row * 256 + ((((lane >> 2) ^ (row & 15))) << 4) + (lane & 3) * 4;
      *(unsigned*)(qs + off) = pack2(s[0][0] * rq, s[0][1] * rq);
      *(unsigned*)(ks + off) = pack2(s[1][0] * rk, s[1][1] * rk);
      const float bi = __shfl(bL, row);
      *(unsigned*)(RV + ((size_t)item * 64 + row) * 128 + d) = pack2(bi * s[2][0], bi * s[2][1]);
    }
  }
  __syncthreads();
  {
    f32x4 aKK[4], aQK[4];
#pragma unroll
    for (int nt = 0; nt < 4; ++nt) { aKK[nt] = (f32x4){0.f, 0.f, 0.f, 0.f}; aQK[nt] = (f32x4){0.f, 0.f, 0.f, 0.f}; }
#pragma unroll
    for (int k4 = 0; k4 < 4; ++k4) {
      const int arow = 16 * w + fr;
      const bf16x8 aq = *(const bf16x8*)(qs + arow * 256 + ((((k4 * 4 + fq) ^ (arow & 15))) << 4));
      const bf16x8 ak = *(const bf16x8*)(ks + arow * 256 + ((((k4 * 4 + fq) ^ (arow & 15))) << 4));
#pragma unroll
      for (int nt = 0; nt < 4; ++nt) {
        const int brow = 16 * nt + fr;
        const bf16x8 bk = *(const bf16x8*)(ks + brow * 256 + ((((k4 * 4 + fq) ^ (brow & 15))) << 4));
        aKK[nt] = __builtin_amdgcn_mfma_f32_16x16x32_bf16(ak, bk, aKK[nt], 0, 0, 0);
        aQK[nt] = __builtin_amdgcn_mfma_f32_16x16x32_bf16(aq, bk, aQK[nt], 0, 0, 0);
      }
    }
    float gci[4], bi[4];
#pragma unroll
    for (int r = 0; r < 4; ++r) { gci[r] = __shfl(gcL, 16 * w + 4 * fq + r); bi[r] = __shfl(bL, 16 * w + 4 * fq + r); }
#pragma unroll
    for (int nt = 0; nt < 4; ++nt) {
      const int j = 16 * nt + fr;
      const float gcj = __shfl(gcL, j);
      const int p = 32 * (nt >> 1) + 8 * (fr >> 2) + 4 * (nt & 1) + (fr & 3);
      float av[4];
#pragma unroll
      for (int r = 0; r < 4; ++r) {
        const int i = 16 * w + 4 * fq + r;
        const float dec = (j <= i) ? __expf(gci[r] - gcj) : 0.f;
        av[r] = (j < i) ? bi[r] * aKK[nt][r] * dec : 0.f;
        ATT[((size_t)item * 64 + i) * 64 + p] = (bf16_t)f2bf(aQK[nt][r] * scale * dec);
      }
      *(float4*)(AT + j * 68 + 16 * w + 4 * fq) = make_float4(av[0], av[1], av[2], av[3]);
    }
  }
  __syncthreads();
  if (w == 0) {
    float Tr[64];
    int ln = lane; asm volatile("" : "+v"(ln));
#pragma unroll
    for (int j = 0; j < 64; ++j) Tr[j] = 0.f;
#pragma unroll
    for (int c = 63; c >= 0; --c) {
      float a0 = 0.f, a1 = 0.f, a2 = 0.f, a3 = 0.f;
#pragma unroll
      for (int j4 = 15; j4 >= (c + 1) / 4; --j4) {
        const float4 a = *(const float4*)(AT + c * 68 + j4 * 4);
        asm volatile("v_fmac_f32 %0, %1, %2" : "+v"(a0) : "v"(Tr[4 * j4 + 0]), "v"(a.x));
        asm volatile("v_fmac_f32 %0, %1, %2" : "+v"(a1) : "v"(Tr[4 * j4 + 1]), "v"(a.y));
        asm volatile("v_fmac_f32 %0, %1, %2" : "+v"(a2) : "v"(Tr[4 * j4 + 2]), "v"(a.z));
        asm volatile("v_fmac_f32 %0, %1, %2" : "+v"(a3) : "v"(Tr[4 * j4 + 3]), "v"(a.w));
      }
      Tr[c] = ((ln == c) ? 1.f : 0.f) - ((a0 + a1) + (a2 + a3));
    }
    u32x4* tp = (u32x4*)(TM + ((size_t)item * 64 + lane) * 64);
#pragma unroll
    for (int oc = 0; oc < 8; ++oc) {
      const int k0 = 32 * (oc >> 2) + 4 * (oc & 3);
      u32x4 v;
      v[0] = pack2(Tr[k0 + 0], Tr[k0 + 1]); v[1] = pack2(Tr[k0 + 2], Tr[k0 + 3]);
      v[2] = pack2(Tr[k0 + 16], Tr[k0 + 17]); v[3] = pack2(Tr[k0 + 18], Tr[k0 + 19]);
      tp[oc] = v;
    }
  } else {
    const float gclast = __shfl(gcL, 63);
    if (tid == 64) GL[item] = __expf(gclast);
#pragma unroll 1
    for (int it = 0; it < 16; ++it) {
      const int idx = (tid - 64) + it * 192;
      const int mtx = idx >> 10, rem = idx & 1023;
      if (mtx < 2) {
        const int i = rem >> 4, oc = rem & 15;
        const float gi = __shfl(gcL, i), bi = __shfl(bL, i);
        const float f = (mtx == 0) ? scale * __expf(gi) : -bi * __expf(gi);
        const unsigned char* st = (mtx == 0) ? qs : ks;
        const int d0 = 32 * (oc >> 2) + 4 * (oc & 3);
        const uint2 lo = *(const uint2*)(st + i * 256 + ((((d0 >> 3) ^ (i & 15))) << 4) + (d0 & 7) * 2);
        const uint2 hi = *(const uint2*)(st + i * 256 + (((((d0 + 16) >> 3) ^ (i & 15))) << 4) + (d0 & 7) * 2);
        u32x4 v;
        v[0] = pack2(bflo(lo.x) * f, bfhi(lo.x) * f); v[1] = pack2(bflo(lo.y) * f, bfhi(lo.y) * f);
        v[2] = pack2(bflo(hi.x) * f, bfhi(hi.x) * f); v[3] = pack2(bflo(hi.y) * f, bfhi(hi.y) * f);
        bf16_t* dst = ((mtx == 0) ? QD : W0N) + ((size_t)item * 64 + i) * 128 + 8 * oc;
        *(u32x4*)dst = v;
      } else {
        const int d = rem & 127, oc = rem >> 7;
        const int j0 = 32 * (oc >> 2) + 4 * (oc & 3);
        float val[8];
#pragma unroll
        for (int e = 0; e < 8; ++e) {
          const int j = j0 + (e & 3) + ((e >> 2) << 4);
          const float f = __expf(gclast - __shfl(gcL, j));
          const unsigned short raw = *(const unsigned short*)(ks + j * 256 + ((((d >> 3) ^ (j & 15))) << 4) + (d & 7) * 2);
          val[e] = bf2f(raw) * f;
        }
        u32x4 v;
        v[0] = pack2(val[0], val[1]); v[1] = pack2(val[2], val[3]); v[2] = pack2(val[4], val[5]); v[3] = pack2(val[6], val[7]);
        *(u32x4*)(KTT + ((size_t)item * 128 + d) * 64 + 8 * oc) = v;
      }
    }
  }
  __syncthreads();
}

__device__ __forceinline__ void ph_dnscan(unsigned char* smem, int item, const bf16_t* __restrict__ QDp, const bf16_t* __restrict__ W0Np, const bf16_t* __restrict__ KTTp,
                                          const bf16_t* __restrict__ RVp, const bf16_t* __restrict__ TMp, const bf16_t* __restrict__ ATTp, const float* __restrict__ GLp,
                                          float* __restrict__ op) {
  const int tid = TIDX, lane = tid & 63, w = tid >> 6, fr = lane & 15, fq = lane >> 4;
  const int bh = item >> 1, half = item & 1, b = bh >> 2, h = bh & 3;
  const int vcol0 = (half * 4 + w) * 16;
  unsigned char* sW0 = smem; unsigned char* sQD = smem + 16384; unsigned char* sKT = smem + 32768; unsigned char* sT = smem + 49152; unsigned char* sAT = smem + 57344;
  f32x4 S[8];
#pragma unroll
  for (int t = 0; t < 8; ++t) S[t] = (f32x4){0.f, 0.f, 0.f, 0.f};
  u32x4 pf[8]; unsigned short rvp[16];
#define DN_LOAD_A(nn_) do { \
    const size_t ci = (size_t)bh * 64 + (nn_); \
    _Pragma("unroll") for (int i = 0; i < 4; ++i) pf[i] = *(const u32x4*)((const char*)W0Np + ci * 16384 + (size_t)(tid + 256 * i) * 16); \
    _Pragma("unroll") for (int i = 0; i < 4; ++i) pf[4 + i] = *(const u32x4*)((const char*)QDp + ci * 16384 + (size_t)(tid + 256 * i) * 16); \
    _Pragma("unroll") for (int mt = 0; mt < 4; ++mt) \
      _Pragma("unroll") for (int r = 0; r < 4; ++r) rvp[mt * 4 + r] = RVp[(ci * 64 + 16 * mt + 4 * fq + r) * 128 + vcol0 + fr]; \
  } while (0)
#define DN_STORE_A() do { \
    _Pragma("unroll") for (int i = 0; i < 4; ++i) { const int q = tid + 256 * i, row = q >> 4, ch = q & 15; *(u32x4*)(sW0 + row * 256 + ((ch ^ (row & 15)) << 4)) = pf[i]; } \
    _Pragma("unroll") for (int i = 0; i < 4; ++i) { const int q = tid + 256 * i, row = q >> 4, ch = q & 15; *(u32x4*)(sQD + row * 256 + ((ch ^ (row & 15)) << 4)) = pf[4 + i]; } \
  } while (0)
#define DN_LOAD_B(nn_) do { \
    const size_t ci = (size_t)bh * 64 + (nn_); \
    _Pragma("unroll") for (int i = 0; i < 4; ++i) pf[i] = *(const u32x4*)((const char*)KTTp + ci * 16384 + (size_t)(tid + 256 * i) * 16); \
    _Pragma("unroll") for (int i = 0; i < 2; ++i) pf[4 + i] = *(const u32x4*)((const char*)TMp + ci * 8192 + (size_t)(tid + 256 * i) * 16); \
    _Pragma("unroll") for (int i = 0; i < 2; ++i) pf[6 + i] = *(const u32x4*)((const char*)ATTp + ci * 8192 + (size_t)(tid + 256 * i) * 16); \
  } while (0)
#define DN_STORE_B() do { \
    _Pragma("unroll") for (int i = 0; i < 4; ++i) { const int q = tid + 256 * i, row = q >> 3, ch = q & 7; *(u32x4*)(sKT + row * 128 + ((ch ^ (row & 7)) << 4)) = pf[i]; } \
    _Pragma("unroll") for (int i = 0; i < 2; ++i) { const int q = tid + 256 * i, row = q >> 3, ch = q & 7; *(u32x4*)(sT + row * 128 + ((ch ^ (row & 7)) << 4)) = pf[4 + i]; } \
    _Pragma("unroll") for (int i = 0; i < 2; ++i) { const int q = tid + 256 * i, row = q >> 3, ch = q & 7; *(u32x4*)(sAT + row * 128 + ((ch ^ (row & 7)) << 4)) = pf[6 + i]; } \
  } while (0)
  __syncthreads();
  DN_LOAD_A(0);
  DN_STORE_A();
  for (int nn = 0; nn < 64; ++nn) {
    f32x4 Z[4];
#pragma unroll
    for (int mt = 0; mt < 4; ++mt) Z[mt] = (f32x4){bf2f(rvp[mt * 4 + 0]), bf2f(rvp[mt * 4 + 1]), bf2f(rvp[mt * 4 + 2]), bf2f(rvp[mt * 4 + 3])};
    const float gl = GLp[(size_t)bh * 64 + nn];
    DN_LOAD_B(nn);
    __syncthreads();
    bf16x8 Sb[4];
#pragma unroll
    for (int k4 = 0; k4 < 4; ++k4) Sb[k4] = pack8(S[2 * k4], S[2 * k4 + 1]);
    f32x4 O[4];
#pragma unroll
    for (int mt = 0; mt < 4; ++mt) {
      O[mt] = (f32x4){0.f, 0.f, 0.f, 0.f};
      const int row = 16 * mt + fr;
#pragma unroll
      for (int k4 = 0; k4 < 4; ++k4) {
        const int off = row * 256 + ((((k4 * 4 + fq) ^ fr)) << 4);
        const bf16x8 aw = *(const bf16x8*)(sW0 + off);
        const bf16x8 aq = *(const bf16x8*)(sQD + off);
        Z[mt] = __builtin_amdgcn_mfma_f32_16x16x32_bf16(aw, Sb[k4], Z[mt], 0, 0, 0);
        O[mt] = __builtin_amdgcn_mfma_f32_16x16x32_bf16(aq, Sb[k4], O[mt], 0, 0, 0);
      }
    }
    bf16x8 Zb[2];
    Zb[0] = pack8(Z[0], Z[1]); Zb[1] = pack8(Z[2], Z[3]);
    DN_STORE_B();
    if (nn + 1 < 64) DN_LOAD_A(nn + 1);
    __syncthreads();
    f32x4 Vn[4];
#pragma unroll
    for (int mt = 0; mt < 4; ++mt) {
      Vn[mt] = (f32x4){0.f, 0.f, 0.f, 0.f};
      const int row = 16 * mt + fr;
#pragma unroll
      for (int s = 0; s < 2; ++s) {
        if (s <= (mt >> 1)) {
          const bf16x8 at = *(const bf16x8*)(sT + row * 128 + ((((s * 4 + fq) ^ (row & 7))) << 4));
          Vn[mt] = __builtin_amdgcn_mfma_f32_16x16x32_bf16(at, Zb[s], Vn[mt], 0, 0, 0);
        }
      }
    }
    bf16x8 Vb[2];
    Vb[0] = pack8(Vn[0], Vn[1]); Vb[1] = pack8(Vn[2], Vn[3]);
#pragma unroll
    for (int mt = 0; mt < 4; ++mt) {
      const int row = 16 * mt + fr;
#pragma unroll
      for (int s = 0; s < 2; ++s) {
        if (s <= (mt >> 1)) {
          const bf16x8 aa = *(const bf16x8*)(sAT + row * 128 + ((((s * 4 + fq) ^ (row & 7))) << 4));
          O[mt] = __builtin_amdgcn_mfma_f32_16x16x32_bf16(aa, Vb[s], O[mt], 0, 0, 0);
        }
      }
      const size_t tok = (size_t)b * SEQ + nn * 64 + 16 * mt + 4 * fq;
#pragma unroll
      for (int r = 0; r < 4; ++r) op[(tok + r) * 512 + h * 128 + vcol0 + fr] = O[mt][r];
    }
#pragma unroll
    for (int t = 0; t < 8; ++t) {
      S[t] = S[t] * gl;
      const int row = 16 * t + fr;
#pragma unroll
      for (int s = 0; s < 2; ++s) {
        const bf16x8 ak = *(const bf16x8*)(sKT + row * 128 + ((((s * 4 + fq) ^ (row & 7))) << 4));
        S[t] = __builtin_amdgcn_mfma_f32_16x16x32_bf16(ak, Vb[s], S[t], 0, 0, 0);
      }
    }
    if (nn + 1 < 64) DN_STORE_A();
  }
  __syncthreads();
#undef DN_LOAD_A
#undef DN_STORE_A
#undef DN_LOAD_B
#undef DN_STORE_B
}

__device__ __forceinline__ void ph_dn_post(int n, const float* __restrict__ o, const bf16_t* __restrict__ proj, const float* __restrict__ dn_norm_g, bf16_t* __restrict__ mixed) {
  const int tid = TIDX, h = tid >> 6, lane = tid & 63;
  const float o0 = o[(size_t)n * 512 + h * 128 + lane], o1 = o[(size_t)n * 512 + h * 128 + 64 + lane];
  const float ss = wave_sum(o0 * o0 + o1 * o1);
  const float rn = rsqrtf(ss * (1.f / 128.f) + RMS_EPS);
  const float z0 = bf2f(proj[(size_t)n * PROJW + OFF_Z + h * 128 + lane]), z1 = bf2f(proj[(size_t)n * PROJW + OFF_Z + h * 128 + 64 + lane]);
  mixed[(size_t)n * DM + h * 128 + lane] = (bf16_t)f2bf(o0 * rn * dn_norm_g[lane] * siluf(z0));
  mixed[(size_t)n * DM + h * 128 + 64 + lane] = (bf16_t)f2bf(o1 * rn * dn_norm_g[64 + lane] * siluf(z1));
}

__device__ __forceinline__ void ph_swa(unsigned char* smem, int item, const bf16_t* __restrict__ proj, const bf16_t* __restrict__ vt, const float* __restrict__ sinks, bf16_t* __restrict__ mixed) {
  const int tid = TIDX, lane = tid & 63, w = tid >> 6, fr = lane & 15, fq = lane >> 4;
  const int qb = item & 31, kvh = (item >> 5) & 1, b = item >> 6;
  const int t0 = qb * 128;
  const size_t rowb = (size_t)b * SEQ;
  unsigned char* sK = smem;
  unsigned char* sV = smem + 32768;
  __syncthreads();
#pragma unroll
  for (int i = 0; i < 8; ++i) {
    const int q = tid + 256 * i, row = q >> 3, ch = q & 7;
    const int pos = t0 - 128 + row;
    u32x4 v = (u32x4){0u, 0u, 0u, 0u};
    if (pos >= 0) v = *(const u32x4*)(proj + (rowb + pos) * PROJW + OFF_SK + kvh * 64 + ch * 8);
    *(u32x4*)(sK + row * 128 + ((ch ^ (row & 7)) << 4)) = v;
  }
#pragma unroll
  for (int i = 0; i < 8; ++i) {
    const int q = tid + 256 * i, row = q >> 5, ch = q & 31;
    const int pos = t0 - 128 + ch * 8;
    u32x4 v = (u32x4){0u, 0u, 0u, 0u};
    if (pos >= 0) v = *(const u32x4*)(vt + ((size_t)(b * 128 + kvh * 64 + row)) * SEQ + pos);
    *(u32x4*)(sV + row * 512 + ((ch ^ (row & 15)) << 4)) = v;
  }
  __syncthreads();
  const int head = kvh * 4 + w;
  const float slope = exp2f(-(float)(head + 1));
  const float sink = sinks[head];
#pragma unroll 1
  for (int qt = 0; qt < 8; ++qt) {
    const bf16_t* qp = proj + (rowb + t0 + qt * 16 + fr) * PROJW + OFF_SQ + head * 64 + fq * 8;
    const bf16x8 qf0 = *(const bf16x8*)(qp), qf1 = *(const bf16x8*)(qp + 32);
    const int kp0 = qt >> 1;
    f32x4 st[10];
#pragma unroll
    for (int kt = 0; kt < 10; ++kt) {
      const int krow = (2 * kp0 + kt) * 16 + fr;
      st[kt] = (f32x4){0.f, 0.f, 0.f, 0.f};
      const bf16x8 k0 = *(const bf16x8*)(sK + krow * 128 + (((0 + fq) ^ (krow & 7)) << 4));
      const bf16x8 k1 = *(const bf16x8*)(sK + krow * 128 + (((4 + fq) ^ (krow & 7)) << 4));
      st[kt] = __builtin_amdgcn_mfma_f32_16x16x32_bf16(k0, qf0, st[kt], 0, 0, 0);
      st[kt] = __builtin_amdgcn_mfma_f32_16x16x32_bf16(k1, qf1, st[kt], 0, 0, 0);
    }
    const int i = qt * 16 + fr;
    float mx = sink;
#pragma unroll
    for (int kt = 0; kt < 10; ++kt)
#pragma unroll
      for (int r = 0; r < 4; ++r) {
        const int jb = (2 * kp0 + kt) * 16 + 4 * fq + r;
        const int dist = 128 + i - jb;
        const bool ok = (dist >= 0) && (dist < 128) && (t0 - 128 + jb >= 0);
        const float s = ok ? (st[kt][r] * 0.125f - slope * (float)dist) : -INFINITY;
        st[kt][r] = s;
        mx = fmaxf(mx, s);
      }
    mx = fmaxf(mx, __shfl_xor(mx, 16));
    mx = fmaxf(mx, __shfl_xor(mx, 32));
    float sum = 0.f;
#pragma unroll
    for (int kt = 0; kt < 10; ++kt)
#pragma unroll
      for (int r = 0; r < 4; ++r) { const float p = __expf(st[kt][r] - mx); st[kt][r] = p; sum += p; }
    sum += __shfl_xor(sum, 16);
    sum += __shfl_xor(sum, 32);
    const float inv = 1.f / (sum + __expf(sink - mx));
    f32x4 O[4];
#pragma unroll
    for (int nt = 0; nt < 4; ++nt) O[nt] = (f32x4){0.f, 0.f, 0.f, 0.f};
#pragma unroll
    for (int s5 = 0; s5 < 5; ++s5) {
      const bf16x8 pa = pack8(st[2 * s5] * inv, st[2 * s5 + 1] * inv);
      const int key0 = (2 * kp0 + 2 * s5) * 16 + 4 * fq;
#pragma unroll
      for (int nt = 0; nt < 4; ++nt) {
        const int drow = nt * 16 + fr;
        const int c0 = key0 >> 3, c1 = (key0 + 16) >> 3;
        const u32x2 lo = *(const u32x2*)(sV + drow * 512 + ((c0 ^ (drow & 15)) << 4) + ((key0 >> 2) & 1) * 8);
        const u32x2 hi = *(const u32x2*)(sV + drow * 512 + ((c1 ^ (drow & 15)) << 4) + ((key0 >> 2) & 1) * 8);
        const u32x4 vb = (u32x4){lo[0], lo[1], hi[0], hi[1]};
        O[nt] = __builtin_amdgcn_mfma_f32_16x16x32_bf16(pa, __builtin_bit_cast(bf16x8, vb), O[nt], 0, 0, 0);
      }
    }
#pragma unroll
    for (int nt = 0; nt < 4; ++nt)
#pragma unroll
      for (int r = 0; r < 4; ++r)
        mixed[(rowb + t0 + qt * 16 + 4 * fq + r) * DM + 512 + head * 64 + nt * 16 + fr] = (bf16_t)f2bf(O[nt][r]);
  }
}

__device__ __forceinline__ void ph_wout(unsigned char* smem, int tile, const bf16_t* __restrict__ mixed, const float* __restrict__ w_out, const float* __restrict__ x, float* __restrict__ y1) {
  GEMM_IDS
  const int n0 = (tile & 7) * 128, m0 = (tile >> 3) * 128;
  LdRowBF16 al; al.init([&](int r) { return mixed + (size_t)(m0 + r) * DM; });
  LdColF32 bl; bl.init(w_out + n0 + 4 * (tid & 31), DM, true);
  f32x4 acc[4][4];
  gemm128(smem, al, bl, DM / 64, acc);
#pragma unroll
  for (int m = 0; m < 4; ++m)
#pragma unroll
    for (int n = 0; n < 4; ++n) {
      const size_t idx = (size_t)(m0 + wr * 64 + m * 16 + fr) * DM + n0 + wc * 64 + n * 16 + fq * 4;
      const f32x4 xv = *(const f32x4*)(x + idx);
      *(f32x4*)(y1 + idx) = xv * ALPHA + acc[m][n];
    }
}

__device__ __forceinline__ void ph_ln1(int item, float* __restrict__ y, const float* __restrict__ gam, const float* __restrict__ bet, bf16_t* __restrict__ xbf) {
  const int row = item * 4 + (TIDX >> 6), lane = TIDX & 63;
  float4* p = (float4*)(y + (size_t)row * DM);
  float4 v[4]; float s = 0.f;
#pragma unroll
  for (int i = 0; i < 4; ++i) { v[i] = p[lane + i * 64]; s += v[i].x + v[i].y + v[i].z + v[i].w; }
  const float mu = wave_sum(s) * (1.f / DM);
  float q = 0.f;
#pragma unroll
  for (int i = 0; i < 4; ++i) { const float a = v[i].x - mu, b = v[i].y - mu, c = v[i].z - mu, d = v[i].w - mu; q += a * a + b * b + c * c + d * d; }
  const float rs = rsqrtf(wave_sum(q) * (1.f / DM) + LN_EPS);
#pragma unroll
  for (int i = 0; i < 4; ++i) {
    const float4 gg = ((const float4*)gam)[lane + i * 64], bb = ((const float4*)bet)[lane + i * 64];
    float4 r;
    r.x = (v[i].x - mu) * rs * gg.x + bb.x; r.y = (v[i].y - mu) * rs * gg.y + bb.y;
    r.z = (v[i].z - mu) * rs * gg.z + bb.z; r.w = (v[i].w - mu) * rs * gg.w + bb.w;
    p[lane + i * 64] = r;
    u32x2 w; w[0] = pack2(r.x, r.y); w[1] = pack2(r.z, r.w);
    ((u32x2*)(xbf + (size_t)row * DM))[lane + i * 64] = w;
  }
}

__device__ __forceinline__ void ph_router(unsigned char* smem, int tile, const bf16_t* __restrict__ xbf, const float* __restrict__ router_w, float* __restrict__ logits) {
  GEMM_IDS
  const int n0 = (tile & 1) * 128, m0 = (tile >> 1) * 128;
  LdRowBF16 al; al.init([&](int r) { return xbf + (size_t)(m0 + r) * DM; });
  LdColF32 bl; bl.init(router_w + n0 + 4 * (tid & 31), NEXP, true);
  f32x4 acc[4][4];
  gemm128(smem, al, bl, DM / 64, acc);
#pragma unroll
  for (int m = 0; m < 4; ++m)
#pragma unroll
    for (int n = 0; n < 4; ++n)
      *(f32x4*)(logits + (size_t)(m0 + wr * 64 + m * 16 + fr) * NEXP + n0 + wc * 64 + n * 16 + fq * 4) = acc[m][n];
}

__device__ __forceinline__ void ph_route(int item, const float* __restrict__ logits, const float* __restrict__ router_bias, int* __restrict__ cnt, int* __restrict__ list, float* __restrict__ gates) {
  const int n = item * 4 + (TIDX >> 6), lane = TIDX & 63;
  const float4 lg = ((const float4*)(logits + (size_t)n * NEXP))[lane];
  const float4 rb = ((const float4*)router_bias)[lane];
  float sc[4] = {sigmoidf(lg.x), sigmoidf(lg.y), sigmoidf(lg.z), sigmoidf(lg.w)};
  float sel[4] = {sc[0] + rb.x, sc[1] + rb.y, sc[2] + rb.z, sc[3] + rb.w};
  float t1 = fmaxf(sel[0], sel[1]), t2 = fminf(sel[0], sel[1]);
  { const float a = sel[2]; if (a > t1) { t2 = t1; t1 = a; } else if (a > t2) t2 = a; }
  { const float a = sel[3]; if (a > t1) { t2 = t1; t1 = a; } else if (a > t2) t2 = a; }
#pragma unroll
  for (int o = 1; o < 8; o <<= 1) {
    const float b1 = __shfl_xor(t1, o), b2 = __shfl_xor(t2, o);
    const float n1 = fmaxf(t1, b1), n2 = fmaxf(fminf(t1, b1), fmaxf(t2, b2));
    t1 = n1; t2 = n2;
  }
  const float gs = t1 + t2;
  const int mygrp = lane >> 3;
  int rank = 0;
#pragma unroll
  for (int j = 0; j < 8; ++j) {
    const float o = __shfl(gs, j * 8);
    rank += (o > gs || (o == gs && j < mygrp)) ? 1 : 0;
  }
  const bool gsel = rank < 4;
  float cand[4];
#pragma unroll
  for (int i = 0; i < 4; ++i) cand[i] = gsel ? sel[i] : -INFINITY;
  float gsum = 0.f; float myg = 0.f; int mye = 0;
#pragma unroll 1
  for (int r = 0; r < TOPK; ++r) {
    float bv = cand[0]; int bi = 0;
#pragma unroll
    for (int i = 1; i < 4; ++i) if (cand[i] > bv) { bv = cand[i]; bi = i; }
    int be = lane * 4 + bi;
    float bs = (bi == 0) ? sc[0] : (bi == 1) ? sc[1] : (bi == 2) ? sc[2] : sc[3];
#pragma unroll
    for (int o = 1; o < 64; o <<= 1) {
      const float ov = __shfl_xor(bv, o); const int oe = __shfl_xor(be, o); const float os = __shfl_xor(bs, o);
      if (ov > bv || (ov == bv && oe < be)) { bv = ov; be = oe; bs = os; }
    }
    if ((be >> 2) == lane) {
      const int bi2 = be & 3;
      if (bi2 == 0) cand[0] = -INFINITY; else if (bi2 == 1) cand[1] = -INFINITY; else if (bi2 == 2) cand[2] = -INFINITY; else cand[3] = -INFINITY;
    }
    gsum += bs;
    if (lane == r) { myg = bs; mye = be; }
  }
  if (lane < TOPK) {
    const int slot = atomicAdd(&cnt[mye], 1);
    list[(size_t)mye * CAP + slot] = n * TOPK + lane;
    gates[(size_t)n * TOPK + lane] = myg / gsum * 2.5f;
  }
}

__device__ __forceinline__ void moe_build_prefix(const int* __restrict__ cnt, int* sscan) {
  const int tid = TIDX;
  const int e = ((tid & 31) << 3) | (tid >> 5);
  const int c = cnt[e];
  __syncthreads();
  sscan[tid] = (c + 127) >> 7;
  __syncthreads();
  for (int o = 1; o < 256; o <<= 1) {
    const int v = (tid >= o) ? sscan[tid - o] : 0;
    __syncthreads();
    sscan[tid] += v;
    __syncthreads();
  }
}
__device__ __forceinline__ void moe_locate(const int* sscan, int x, int lt, int& e, int& rt) {
  const int base = x ? sscan[32 * x - 1] : 0;
  const int nrouted = sscan[32 * x + 31] - base;
  if (lt >= nrouted) { e = 256; rt = x * (NTOK / 128 / 8) + (lt - nrouted); return; }
  const int g = base + lt;
  int lo = 32 * x, hi = 32 * x + 31;
  while (lo < hi) { const int mid = (lo + hi) >> 1; if (sscan[mid] > g) hi = mid; else lo = mid + 1; }
  e = ((lo & 31) << 3) | (lo >> 5); rt = g - (lo ? sscan[lo - 1] : 0);
}

__device__ __forceinline__ void ph_moe1(unsigned char* smem, int e, int rt, int ct, const bf16_t* __restrict__ xbf, const int* __restrict__ cnt, const int* __restrict__ list,
                                        const float* __restrict__ w_gate, const float* __restrict__ w_up,
                                        const float* __restrict__ sw_gate, const float* __restrict__ sw_up, bf16_t* __restrict__ hbuf) {
  int* sasg = (int*)(smem + SM_MISC + 2048);
  GEMM_IDS
  const int rows = (e < 256) ? cnt[e] : NTOK;
  if (tid < 128) {
    const int r = rt * 128 + tid;
    int a = -1;
    if (r < rows) a = (e < 256) ? list[(size_t)e * CAP + r] : (NA + r);
    sasg[tid] = a;
  }
  __syncthreads();
  LdRowBF16 al; al.init([&](int r) { const int a = sasg[r]; const int tok = (a < 0) ? 0 : (a < NA ? (a >> 3) : (a - NA)); return xbf + (size_t)tok * DM; });
  LdColF32 bl;
  {
    const int jj = 4 * (tid & 31);
    const int bwc = jj >> 6, bn = (jj >> 4) & 3;
    const int ff = ct * 64 + bwc * 32 + (bn >> 1) * 16 + (jj & 15);
    const float* W = (e < 256) ? ((bn & 1) ? w_up : w_gate) + (size_t)e * DM * EFF : ((bn & 1) ? sw_up : sw_gate);
    bl.init(W + ff, EFF, true);
  }
  f32x4 acc[4][4];
  gemm128(smem, al, bl, DM / 64, acc);
#pragma unroll
  for (int m = 0; m < 4; ++m) {
    const int a = sasg[wr * 64 + m * 16 + fr];
    if (a >= 0) {
#pragma unroll
      for (int pp = 0; pp < 2; ++pp) {
        float hv[4];
#pragma unroll
        for (int r = 0; r < 4; ++r) hv[r] = siluf(acc[m][2 * pp][r]) * acc[m][2 * pp + 1][r];
        u32x2 w; w[0] = pack2(hv[0], hv[1]); w[1] = pack2(hv[2], hv[3]);
        *(u32x2*)(hbuf + (size_t)a * EFF + ct * 64 + wc * 32 + pp * 16 + fq * 4) = w;
      }
    }
  }
  __syncthreads();
}

__device__ __forceinline__ void ph_moe2(unsigned char* smem, int e, int rt, int ct, const bf16_t* __restrict__ hbuf, const int* __restrict__ cnt, const int* __restrict__ list, const float* __restrict__ gates,
                                        const float* __restrict__ w_down, const float* __restrict__ sw_down, bf16_t* __restrict__ ybuf) {
  int* sasg = (int*)(smem + SM_MISC + 2048);
  float* sgate = (float*)(smem + SM_MISC + 2048 + 512);
  GEMM_IDS
  const int rows = (e < 256) ? cnt[e] : NTOK;
  const int n0 = ct * 128;
  if (tid < 128) {
    const int r = rt * 128 + tid;
    int a = -1;
    if (r < rows) a = (e < 256) ? list[(size_t)e * CAP + r] : (NA + r);
    sasg[tid] = a;
    sgate[tid] = (a >= 0 && a < NA) ? gates[a] : 1.f;
  }
  __syncthreads();
  LdRowBF16 al; al.init([&](int r) { const int a = sasg[r]; return hbuf + (size_t)(a < 0 ? 0 : a) * EFF; });
  LdColF32 bl; bl.init(((e < 256) ? w_down + (size_t)e * EFF * DM : sw_down) + n0 + 4 * (tid & 31), DM, true);
  f32x4 acc[4][4];
  gemm128(smem, al, bl, EFF / 64, acc);
#pragma unroll
  for (int m = 0; m < 4; ++m) {
    const int r_ = wr * 64 + m * 16 + fr;
    const int a = sasg[r_];
    if (a >= 0) {
      const float gt = sgate[r_];
#pragma unroll
      for (int n = 0; n < 4; ++n) {
        u32x2 w; w[0] = pack2(acc[m][n][0] * gt, acc[m][n][1] * gt); w[1] = pack2(acc[m][n][2] * gt, acc[m][n][3] * gt);
        *(u32x2*)(ybuf + (size_t)a * DM + n0 + wc * 64 + n * 16 + fq * 4) = w;
      }
    }
  }
  __syncthreads();
}

__device__ __forceinline__ void ph_final(int item, float* __restrict__ out, const bf16_t* __restrict__ ybuf, const float* __restrict__ gam, const float* __restrict__ bet) {
  const int row = item * 4 + (TIDX >> 6), lane = TIDX & 63;
  float4* p = (float4*)(out + (size_t)row * DM);
  float4 v[4]; float s = 0.f;
#pragma unroll
  for (int i = 0; i < 4; ++i) {
    float4 a = p[lane + i * 64];
    a.x *= ALPHA; a.y *= ALPHA; a.z *= ALPHA; a.w *= ALPHA;
#pragma unroll
    for (int k = 0; k < 9; ++k) {
      const size_t yr = (k < 8) ? ((size_t)row * 8 + k) : ((size_t)NA + row);
      const uint2 w = ((const uint2*)(ybuf + yr * DM))[lane + i * 64];
      a.x += bflo(w.x); a.y += bfhi(w.x); a.z += bflo(w.y); a.w += bfhi(w.y);
    }
    v[i] = a; s += a.x + a.y + a.z + a.w;
  }
  const float mu = wave_sum(s) * (1.f / DM);
  float q = 0.f;
#pragma unroll
  for (int i = 0; i < 4; ++i) { const float a = v[i].x - mu, b = v[i].y - mu, c = v[i].z - mu, d = v[i].w - mu; q += a * a + b * b + c * c + d * d; }
  const float rs = rsqrtf(wave_sum(q) * (1.f / DM) + LN_EPS);
#pragma unroll
  for (int i = 0; i < 4; ++i) {
    const float4 gg = ((const float4*)gam)[lane + i * 64], bb = ((const float4*)bet)[lane + i * 64];
    float4 r;
    r.x = (v[i].x - mu) * rs * gg.x + bb.x; r.y = (v[i].y - mu) * rs * gg.y + bb.y;
    r.z = (v[i].z - mu) * rs * gg.z + bb.z; r.w = (v[i].w - mu) * rs * gg.w + bb.w;
    p[lane + i * 64] = r;
  }
}

#define XB_TMO      128
#define XB_XCNT(j)  (256  + 64 * (j))
#define XB_XSUB(j)  (1280 + 64 * (j))
#define XB_XGEN(j)  (2304 + 64 * (j))
#define XB_TOP      3328
#define XB_TOPGEN   3392
#define XCD_BAR_WORDS 3456
#define XB_SPIN_CAP (1u << 22)
#define LAS __attribute__((address_space(3)))
__device__ __forceinline__ unsigned xb_ld(unsigned* p)              { return __hip_atomic_load(p, __ATOMIC_RELAXED, __HIP_MEMORY_SCOPE_AGENT); }
__device__ __forceinline__ unsigned xb_add(unsigned* p, unsigned v) { return __hip_atomic_fetch_add(p, v, __ATOMIC_RELAXED, __HIP_MEMORY_SCOPE_AGENT); }
__device__ __forceinline__ unsigned xb_xcc_id() { return (unsigned)__builtin_amdgcn_s_getreg((3 << 11) | 20) & 0xFu; }
#define XB_SPIN(cond, bar) do { unsigned _sp = 0; while (cond) { __builtin_amdgcn_s_sleep(1); \
    if ((++_sp & 255u) == 0u) { if (xb_ld(&(bar)[XB_TMO])) break; if (_sp > XB_SPIN_CAP) { atomicAdd(&(bar)[XB_TMO], 1u); break; } } } } while (0)
struct XcdBarrier { unsigned* bar; unsigned x; volatile LAS unsigned* st; };
__device__ __forceinline__ XcdBarrier xcd_barrier_post(unsigned* bar, volatile LAS unsigned* st) {
  XcdBarrier b; b.bar = bar; b.x = xb_xcc_id(); b.st = st;
  if (threadIdx.x == 0) (void)xb_add(&bar[XB_XCNT(b.x)], 1u);
  return b;
}
__device__ __forceinline__ void xcd_barrier_complete(unsigned* bar, unsigned x, unsigned& nloc, unsigned& nx) {
  const unsigned G = gridDim.x * gridDim.y * gridDim.z;
  unsigned sum, cnt, mine, sp = 0u;
  for (;;) {
    sum = 0u; cnt = 0u; mine = 0u;
#pragma unroll
    for (unsigned j = 0; j < 16; ++j) { const unsigned c = xb_ld(&bar[XB_XCNT(j)]); sum += c; cnt += (c > 0u) ? 1u : 0u; mine = (j == x) ? c : mine; }
    if (sum == G) break;
    __builtin_amdgcn_s_sleep(1);
    if ((++sp & 255u) == 0u) { if (xb_ld(&bar[XB_TMO])) break; if (sp > XB_SPIN_CAP) { atomicAdd(&bar[XB_TMO], 1u); break; } }
  }
  nloc = mine > 0u ? mine : 1u; nx = cnt > 0u ? cnt : 1u;
}
__device__ __forceinline__ void xcd_barrier(const XcdBarrier& b) {
  asm volatile("s_waitcnt vmcnt(0)" ::: "memory");
  __syncthreads();
  if (threadIdx.x == 0) {
    unsigned* bar = b.bar;
    __builtin_amdgcn_s_waitcnt(0);
    unsigned nloc = b.st[0], nx = b.st[1];
    if (nloc == 0u) { xcd_barrier_complete(bar, b.x, nloc, nx); b.st[0] = nloc; b.st[1] = nx; }
    const unsigned old = xb_add(&bar[XB_XSUB(b.x)], 1u);
    const unsigned gen = old / nloc;
    if (old + 1u == (gen + 1u) * nloc) {
      __builtin_amdgcn_fence(__ATOMIC_RELEASE, "agent");
      asm volatile("s_waitcnt vmcnt(0)" ::: "memory");
      const unsigned og = xb_add(&bar[XB_TOP], 1u);
      const unsigned tg = og / nx;
      if (og + 1u == (tg + 1u) * nx) xb_add(&bar[XB_TOPGEN], 1u);
      else XB_SPIN(xb_ld(&bar[XB_TOPGEN]) == tg, bar);
      __builtin_amdgcn_fence(__ATOMIC_ACQUIRE, "agent");
      xb_add(&bar[XB_XGEN(b.x)], 1u);
      asm volatile("s_waitcnt vmcnt(0)" ::: "memory");
    } else {
      XB_SPIN(xb_ld(&bar[XB_XGEN(b.x)]) == gen, bar);
      __builtin_amdgcn_fence(__ATOMIC_ACQUIRE, "agent");
      asm volatile("s_waitcnt vmcnt(0)" ::: "memory");
    }
  }
  __syncthreads();
}

__global__ void __launch_bounds__(256, 2) mega(Params P) {
  __shared__ __attribute__((aligned(16))) unsigned char smem[SMEM_BYTES];
  cg::grid_group grid = cg::this_grid();
  const int bid = blockIdx.x, nblk = gridDim.x;
#define xin (P.in[0])
#define w_in (P.in[1])
#define conv_w (P.in[2])
#define a_log (P.in[3])
#define dt_bias (P.in[4])
#define dn_norm_g (P.in[5])
#define sinks (P.in[6])
#define w_out (P.in[7])
#define ln1_g (P.in[8])
#define ln1_b (P.in[9])
#define router_w (P.in[10])
#define router_bias (P.in[11])
#define w_gate (P.in[12])
#define w_up (P.in[13])
#define w_down (P.in[14])
#define sw_gate (P.in[15])
#define sw_up (P.in[16])
#define sw_down (P.in[17])
#define ln2_g (P.in[18])
#define ln2_b (P.in[19])
#define outp (P.out)
#define x1bf ((bf16_t*)(P.ws + WS_X1BF))
#define logits ((float*)(P.ws + WS_LOGIT))
#define list ((int*)(P.ws + WS_LIST))
#define gates ((float*)(P.ws + WS_GATES))
#define cnt ((int*)(P.ws + WS_CTRL))
#define barw ((unsigned*)(P.ws + WS_CTRL + 4096))
#define mixed ((bf16_t*)(P.ws + WS_MIXED))
#define proj ((bf16_t*)(P.ws + WS_PROJ))
#define ba ((float*)(P.ws + WS_BA))
#define QD ((bf16_t*)(P.ws + WS_QD))
#define W0N ((bf16_t*)(P.ws + WS_W0N))
#define KTT ((bf16_t*)(P.ws + WS_KTT))
#define RV ((bf16_t*)(P.ws + WS_RV))
#define TM ((bf16_t*)(P.ws + WS_TM))
#define ATT ((bf16_t*)(P.ws + WS_ATT))
#define GL ((float*)(P.ws + WS_GL))
#define obuf ((float*)(P.ws + WS_O))
#define VTb ((bf16_t*)(P.ws + WS_VT))
#define hbuf ((bf16_t*)(P.ws + WS_HBUF))
#define ybuf ((bf16_t*)(P.ws + WS_YBUF))
  {
    volatile LAS unsigned* st0 = (volatile LAS unsigned*)(smem + SM_MISC + 4080);
    if (threadIdx.x == 0) { st0[0] = 0u; st0[1] = 0u; }
    __syncthreads();
  }
  const int xcd = bid & 7, xloc = bid >> 3, xnl = nblk >> 3;
  XcdBarrier xb = xcd_barrier_post(barw, (volatile LAS unsigned*)(smem + SM_MISC + 4080));
  for (int i = xloc; i < 32 * 23; i += xnl) ph_proj(smem, (xcd * 32 + i / 23) * 23 + i % 23, xin, w_in, proj, ba, VTb);
  grid.sync();
  for (int it = bid; it < 2048; it += nblk) ph_dnchunk(smem, it, proj, ba, conv_w, a_log, dt_bias, QD, W0N, KTT, RV, TM, ATT, GL);
  for (int it = bid; it < 512; it += nblk) ph_swa(smem, it, proj, VTb, sinks, mixed);
  xcd_barrier(xb);
  for (int it = bid; it < 64; it += nblk) ph_dnscan(smem, it, QD, W0N, KTT, RV, TM, ATT, GL, obuf);
  xcd_barrier(xb);
  for (int n = bid; n < NTOK; n += nblk) ph_dn_post(n, obuf, proj, dn_norm_g, mixed);
  xcd_barrier(xb);
  for (int i = xloc; i < 32 * 8; i += xnl) ph_wout(smem, (xcd * 32 + i / 8) * 8 + i % 8, mixed, w_out, xin, outp);
  xcd_barrier(xb);
  for (int it = bid; it < NTOK / 4; it += nblk) ph_ln1(it, outp, ln1_g, ln1_b, x1bf);
  xcd_barrier(xb);
  for (int i = xloc; i < 32 * 2; i += xnl) ph_router(smem, (xcd * 32 + i / 2) * 2 + i % 2, x1bf, router_w, logits);
  xcd_barrier(xb);
  for (int it = bid; it < NTOK / 4; it += nblk) ph_route(it, logits, router_bias, cnt, list, gates);
  xcd_barrier(xb);
  int* sscan = (int*)(smem + SM_MISC);
  moe_build_prefix(cnt, sscan);
  const int ntile = sscan[32 * xcd + 31] - (xcd ? sscan[32 * xcd - 1] : 0) + NTOK / 128 / 8;
  for (int it = xloc; it < ntile * 4; it += xnl) {
    int e, rt; moe_locate(sscan, xcd, it >> 2, e, rt);
    ph_moe1(smem, e, rt, it & 3, x1bf, cnt, list, w_gate, w_up, sw_gate, sw_up, hbuf);
  }
  xcd_barrier(xb);
  for (int it = xloc; it < ntile * 8; it += xnl) {
    int e, rt; moe_locate(sscan, xcd, it >> 3, e, rt);
    ph_moe2(smem, e, rt, it & 7, hbuf, cnt, list, gates, w_down, sw_down, ybuf);
  }
  xcd_barrier(xb);
  for (int it = bid; it < NTOK / 4; it += nblk) ph_final(it, outp, ybuf, ln2_g, ln2_b);
}

#undef xin
#undef w_in
#undef conv_w
#undef a_log
#undef dt_bias
#undef dn_norm_g
#undef sinks
#undef w_out
#undef ln1_g
#undef ln1_b
#undef router_w
#undef router_bias
#undef w_gate
#undef w_up
#undef w_down
#undef sw_gate
#undef sw_up
#undef sw_down
#undef ln2_g
#undef ln2_b
#undef outp
#undef x1bf
#undef logits
#undef list
#undef gates
#undef cnt
#undef mixed
#undef proj
#undef ba
#undef QD
#undef W0N
#undef KTT
#undef RV
#undef TM
#undef ATT
#undef GL
#undef obuf
#undef hbuf
#undef ybuf
#undef VTb
#undef barw

extern "C" void kernel_launch(void* const* d_in, const int* in_sizes, int n_in, void* d_out, int out_size, void* d_ws, size_t ws_size, hipStream_t stream) {
  static int grid_blocks = 0;
  if (!grid_blocks) {
    int dev = 0, cus = 0, per_cu = 0;
    (void)hipGetDevice(&dev);
    (void)hipDeviceGetAttribute(&cus, hipDeviceAttributeMultiprocessorCount, dev);
    (void)hipOccupancyMaxActiveBlocksPerMultiprocessor(&per_cu, mega, 256, 0);
    if (per_cu > 2) per_cu = 2;
    if (per_cu < 1) per_cu = 1;
    grid_blocks = cus * per_cu;
  }
  Params p{};
  for (int i = 0; i < 20; ++i) p.in[i] = (const float*)d_in[i];
  p.out = (float*)d_out; p.ws = (char*)d_ws;
  (void)hipMemsetAsync((char*)d_ws + WS_CTRL, 0, 4096 + XCD_BAR_WORDS * 4, stream);
  void* args[] = {&p};
  hipError_t e = hipLaunchCooperativeKernel((void*)mega, dim3(grid_blocks), dim3(256), args, 0, stream);
  if (e != hipSuccess) fprintf(stderr, "cooperative launch failed: %s (grid %d)\n", hipGetErrorString(e), grid_blocks);
}
```

```cpp
#include <hip/hip_runtime.h>
#include <hip/hip_cooperative_groups.h>
#include <stdint.h>
#include <stdio.h>
namespace cg = cooperative_groups;

typedef __attribute__((ext_vector_type(8))) short bf16x8;
typedef __attribute__((ext_vector_type(4))) float f32x4;
typedef unsigned short bf16_t;
typedef __attribute__((ext_vector_type(4))) unsigned u32x4;
typedef __attribute__((ext_vector_type(2))) unsigned u32x2;

constexpr int NTOK = 32768, SEQ = 4096, DM = 1024;
constexpr int INC = 2824, PROJW = 2816;
constexpr int OFF_DQ = 0, OFF_DK = 512, OFF_DV = 1024, OFF_SQ = 1536, OFF_SK = 2048, OFF_SV = 2176, OFF_Z = 2304;
constexpr int NEXP = 256, TOPK = 8, EFF = 256;
constexpr int NA = NTOK * TOPK;
constexpr int CAP = NTOK;
constexpr float ALPHA = 1.189207115002721f;
constexpr float LN_EPS = 1e-5f, RMS_EPS = 1e-6f, L2_EPS = 1e-6f;

constexpr size_t MiB = 1024ull * 1024ull;
constexpr size_t WS_X1BF = 0;
constexpr size_t WS_LOGIT = 64 * MiB;
constexpr size_t WS_LIST = 96 * MiB;
constexpr size_t WS_GATES = 128 * MiB;
constexpr size_t WS_CTRL = 129 * MiB;
constexpr size_t WS_MIXED = 130 * MiB;
constexpr size_t WS_PROJ = 200 * MiB;
constexpr size_t WS_BA = 376 * MiB;
constexpr size_t WS_QD = 377 * MiB;
constexpr size_t WS_W0N = 409 * MiB;
constexpr size_t WS_KTT = 441 * MiB;
constexpr size_t WS_RV = 473 * MiB;
constexpr size_t WS_TM = 505 * MiB;
constexpr size_t WS_ATT = 521 * MiB;
constexpr size_t WS_GL = 537 * MiB;
constexpr size_t WS_O = 538 * MiB;
constexpr size_t WS_VT = 602 * MiB;
constexpr size_t WS_XBF = 0;
constexpr size_t WS_WTIN = 984 * MiB;
constexpr size_t WS_WTOUT = 990 * MiB;
constexpr size_t WS_WTR = 992 * MiB;
constexpr size_t WS_HBUF = 200 * MiB;
constexpr size_t WS_YBUF = 344 * MiB;

__device__ __forceinline__ int opaque_tid() { int t = threadIdx.x; asm volatile("" : "+v"(t)); return t; }
#define TIDX opaque_tid()
typedef __attribute__((ext_vector_type(2))) __bf16 hwbf16x2;
typedef __attribute__((ext_vector_type(2))) float hwf32x2;
__device__ __forceinline__ unsigned pack2(float lo, float hi) {
  hwf32x2 f = {lo, hi};
  return __builtin_bit_cast(unsigned, __builtin_convertvector(f, hwbf16x2));
}
__device__ __forceinline__ unsigned f2bf(float f) { return pack2(f, 0.f) & 0xffffu; }
__device__ __forceinline__ float bf2f(unsigned h) { return __uint_as_float(h << 16); }
__device__ __forceinline__ float bflo(unsigned w) { return __uint_as_float(w << 16); }
__device__ __forceinline__ float bfhi(unsigned w) { return __uint_as_float(w & 0xffff0000u); }
__device__ __forceinline__ float siluf(float x) { return x / (1.f + __expf(-x)); }
__device__ __forceinline__ float sigmoidf(float x) { return 1.f / (1.f + __expf(-x)); }
__device__ __forceinline__ float wave_sum(float v) {
#pragma unroll
  for (int o = 32; o > 0; o >>= 1) v += __shfl_xor(v, o);
  return v;
}

struct LdRowF32 {
  const char* p[8]; f32x4 r[8]; int row0, ch4;
  template <class F> __device__ __forceinline__ void init(F rowptr) {
    const int tid = TIDX; ch4 = tid & 15; row0 = tid >> 4;
#pragma unroll
    for (int i = 0; i < 8; ++i) p[i] = (const char*)rowptr(row0 + i * 16) + ch4 * 16;
  }
  __device__ __forceinline__ void load(int kt) {
#pragma unroll
    for (int i = 0; i < 8; ++i) r[i] = *(const f32x4*)(p[i] + (size_t)kt * 256);
  }
  __device__ __forceinline__ void store(unsigned char* s) {
#pragma unroll
    for (int i = 0; i < 8; ++i) {
      const int row = row0 + i * 16;
      u32x2 w; w[0] = pack2(r[i][0], r[i][1]); w[1] = pack2(r[i][2], r[i][3]);
      *(u32x2*)(s + row * 128 + ((((ch4 >> 1) ^ (row & 7))) << 4) + (ch4 & 1) * 8) = w;
    }
  }
};
struct LdRowBF16 {
  const char* p[4]; u32x4 r[4]; int row0, ch;
  template <class F> __device__ __forceinline__ void init(F rowptr) {
    const int tid = TIDX; ch = tid & 7; row0 = tid >> 3;
#pragma unroll
    for (int i = 0; i < 4; ++i) p[i] = (const char*)rowptr(row0 + i * 32) + ch * 16;
  }
  __device__ __forceinline__ void load(int kt) {
#pragma unroll
    for (int i = 0; i < 4; ++i) r[i] = *(const u32x4*)(p[i] + (size_t)kt * 128);
  }
  __device__ __forceinline__ void store(unsigned char* s) {
#pragma unroll
    for (int i = 0; i < 4; ++i) {
      const int row = row0 + i * 32;
      *(u32x4*)(s + row * 128 + ((ch ^ (row & 7)) << 4)) = r[i];
    }
  }
};
struct LdColF32 {
  const char* p; size_t ldb; f32x4 r[8]; int n4, kg; bool valid;
  __device__ __forceinline__ void init(const float* colptr, size_t ld, bool v) {
    const int tid = TIDX; n4 = tid & 31; kg = tid >> 5; ldb = ld * 4; valid = v;
    p = (const char*)colptr + (size_t)(kg * 8) * ldb;
  }
  __device__ __forceinline__ void load(int kt) {
#pragma unroll
    for (int j = 0; j < 8; ++j) {
      if (valid) r[j] = *(const f32x4*)(p + (size_t)(kt * 64 + j) * ldb);
      else r[j] = (f32x4){0.f, 0.f, 0.f, 0.f};
    }
  }
  __device__ __forceinline__ void store(unsigned char* s) {
    {
      const int row = n4 * 4 + 0; u32x4 w;
      w[0] = pack2(r[0][0], r[1][0]); w[1] = pack2(r[2][0], r[3][0]); w[2] = pack2(r[4][0], r[5][0]); w[3] = pack2(r[6][0], r[7][0]);
      *(u32x4*)(s + row * 128 + ((kg ^ (row & 7)) << 4)) = w;
    }
    {
      const int row = n4 * 4 + 1; u32x4 w;
      w[0] = pack2(r[0][1], r[1][1]); w[1] = pack2(r[2][1], r[3][1]); w[2] = pack2(r[4][1], r[5][1]); w[3] = pack2(r[6][1], r[7][1]);
      *(u32x4*)(s + row * 128 + ((kg ^ (row & 7)) << 4)) = w;
    }
    {
      const int row = n4 * 4 + 2; u32x4 w;
      w[0] = pack2(r[0][2], r[1][2]); w[1] = pack2(r[2][2], r[3][2]); w[2] = pack2(r[4][2], r[5][2]); w[3] = pack2(r[6][2], r[7][2]);
      *(u32x4*)(s + row * 128 + ((kg ^ (row & 7)) << 4)) = w;
    }
    {
      const int row = n4 * 4 + 3; u32x4 w;
      w[0] = pack2(r[0][3], r[1][3]); w[1] = pack2(r[2][3], r[3][3]); w[2] = pack2(r[4][3], r[5][3]); w[3] = pack2(r[6][3], r[7][3]);
      *(u32x4*)(s + row * 128 + ((kg ^ (row & 7)) << 4)) = w;
    }
  }
};

template <class AL, class BL>
__device__ __forceinline__ void gemm128(unsigned char* smem, AL& al, BL& bl, int nk, f32x4 (&acc)[4][4]) {
  const int tid = TIDX, lane = tid & 63, wid = tid >> 6, wr = wid >> 1, wc = wid & 1, fr = lane & 15, fq = lane >> 4;
#pragma unroll
  for (int m = 0; m < 4; ++m)
#pragma unroll
    for (int n = 0; n < 4; ++n) acc[m][n] = (f32x4){0.f, 0.f, 0.f, 0.f};
  al.load(0); bl.load(0);
  al.store(smem); bl.store(smem + 16384);
  if (nk > 1) { al.load(1); bl.load(1); }
  __syncthreads();
  for (int kt = 0; kt < nk; ++kt) {
    unsigned char* sA = smem + (kt & 1) * 32768; unsigned char* sB = sA + 16384;
    unsigned char* sAn = smem + ((kt & 1) ^ 1) * 32768;
    if (kt + 1 < nk) { al.store(sAn); bl.store(sAn + 16384); }
    if (kt + 2 < nk) { al.load(kt + 2); bl.load(kt + 2); }
#pragma unroll
    for (int ks = 0; ks < 2; ++ks) {
      bf16x8 a[4], b[4];
#pragma unroll
      for (int m = 0; m < 4; ++m) {
        const int row = wr * 64 + m * 16 + fr;
        a[m] = *(const bf16x8*)(sA + row * 128 + (((ks * 4 + fq) ^ (row & 7)) << 4));
      }
#pragma unroll
      for (int n = 0; n < 4; ++n) {
        const int row = wc * 64 + n * 16 + fr;
        b[n] = *(const bf16x8*)(sB + row * 128 + (((ks * 4 + fq) ^ (row & 7)) << 4));
      }
#pragma unroll
      for (int m = 0; m < 4; ++m)
#pragma unroll
        for (int n = 0; n < 4; ++n) acc[m][n] = __builtin_amdgcn_mfma_f32_16x16x32_bf16(b[n], a[m], acc[m][n], 0, 0, 0);
    }
    __syncthreads();
  }
}

#define GEMM_IDS const int tid = TIDX, lane = tid & 63, wid = tid >> 6, wr = wid >> 1, wc = wid & 1, fr = lane & 15, fq = lane >> 4; (void)tid; (void)lane;

struct Params {
  const float* in[20];
  float* out;
  char* ws;
};

constexpr int SMEM_BYTES = 69632;
constexpr int SM_MISC = 65536;

__device__ __forceinline__ void ph_cvt_x(int item, const float* __restrict__ x, bf16_t* __restrict__ xbf) {
  const int tid = TIDX;
  const size_t base = (size_t)item * 4096 + (size_t)tid * 4;
#pragma unroll
  for (int i = 0; i < 4; ++i) {
    const f32x4 v = *(const f32x4*)(x + base + (size_t)i * 1024);
    u32x2 w; w[0] = pack2(v[0], v[1]); w[1] = pack2(v[2], v[3]);
    *(u32x2*)(xbf + base + (size_t)i * 1024) = w;
  }
}
__device__ __forceinline__ void ph_cvt_wt(unsigned char* smem, int kt, int nt, const float* __restrict__ W, int K, int N, bf16_t* __restrict__ WT) {
  float* tile = (float*)smem;
  const int tid = TIDX;
  const int k0 = kt * 64, n0 = nt * 64;
  __syncthreads();
#pragma unroll
  for (int i = 0; i < 4; ++i) {
    const int k = (tid >> 4) + 16 * i, n = 4 * (tid & 15);
    f32x4 v = (f32x4){0.f, 0.f, 0.f, 0.f};
    if (n0 + n < N) v = *(const f32x4*)(W + (size_t)(k0 + k) * N + n0 + n);
    tile[k * 65 + n + 0] = v[0]; tile[k * 65 + n + 1] = v[1]; tile[k * 65 + n + 2] = v[2]; tile[k * 65 + n + 3] = v[3];
  }
  __syncthreads();
  const int n = tid >> 2, kq = tid & 3;
  u32x4 w0, w1;
#pragma unroll
  for (int j = 0; j < 4; ++j) {
    w0[j] = pack2(tile[(kq * 16 + 2 * j) * 65 + n], tile[(kq * 16 + 2 * j + 1) * 65 + n]);
    w1[j] = pack2(tile[(kq * 16 + 8 + 2 * j) * 65 + n], tile[(kq * 16 + 8 + 2 * j + 1) * 65 + n]);
  }
  bf16_t* dst = WT + (size_t)(n0 + n) * K + k0 + kq * 16;
  *(u32x4*)dst = w0; *(u32x4*)(dst + 8) = w1;
}

__device__ __forceinline__ void ph_proj(unsigned char* smem, int tile, const bf16_t* __restrict__ xbf, const bf16_t* __restrict__ wt, bf16_t* __restrict__ proj, float* __restrict__ ba, bf16_t* __restrict__ vt) {
  GEMM_IDS
  const int n0 = (tile % 23) * 128, m0 = (tile / 23) * 128;
  LdRowBF16 al; al.init([&](int r) { return xbf + (size_t)(m0 + r) * DM; });
  LdRowBF16 bl; bl.init([&](int r) { return wt + (size_t)(n0 + r) * DM; });
  f32x4 acc[4][4];
  gemm128(smem, al, bl, DM / 64, acc);
#pragma unroll
  for (int m = 0; m < 4; ++m)
#pragma unroll
    for (int n = 0; n < 4; ++n) {
      const int row = m0 + wr * 64 + m * 16 + fr, col = n0 + wc * 64 + n * 16 + fq * 4;
      if (col < PROJW) {
        u32x2 w; w[0] = pack2(acc[m][n][0], acc[m][n][1]); w[1] = pack2(acc[m][n][2], acc[m][n][3]);
        *(u32x2*)(proj + (size_t)row * PROJW + col) = w;
      } else if (col < INC) {
        *(f32x4*)(ba + (size_t)row * 8 + (col - PROJW)) = acc[m][n];
      }
    }
  if (n0 == OFF_SV) {
#pragma unroll
    for (int m = 0; m < 4; ++m)
#pragma unroll
      for (int n = 0; n < 4; ++n) {
        const int row = m0 + wr * 64 + m * 16 + fr, c = wc * 64 + n * 16 + fq * 4;
        const int bb = row / SEQ, t = row % SEQ;
#pragma unroll
        for (int r = 0; r < 4; ++r) vt[((size_t)(bb * 128 + c + r)) * SEQ + t] = (bf16_t)f2bf(acc[m][n][r]);
      }
  }
}

__device__ __forceinline__ bf16x8 pack8(f32x4 a, f32x4 b) {
  union { bf16x8 v; unsigned u[4]; } x;
  x.u[0] = pack2(a[0], a[1]); x.u[1] = pack2(a[2], a[3]); x.u[2] = pack2(b[0], b[1]); x.u[3] = pack2(b[2], b[3]);
  return x.v;
}
__device__ __forceinline__ void ph_dnchunk(unsigned char* smem, int item, const bf16_t* __restrict__ proj, const float* __restrict__ ba, const float* __restrict__ conv_w,
                                           const float* __restrict__ a_log, const float* __restrict__ dt_bias,
                                           bf16_t* __restrict__ QD, bf16_t* __restrict__ W0N, bf16_t* __restrict__ KTT, bf16_t* __restrict__ RV,
                                           bf16_t* __restrict__ TM, bf16_t* __restrict__ ATT, float* __restrict__ GL) {
  const int tid = TIDX, lane = tid & 63, w = tid >> 6, fr = lane & 15, fq = lane >> 4;
  const int n = item & 63, h = (item >> 6) & 3, b = item >> 8;
  const int t0 = n * 64; const size_t row0 = (size_t)b * SEQ + t0;
  unsigned char* qs = smem; unsigned char* ks = smem + 16384; float* AT = (float*)(smem + 32768);
  const float scale = 0.08838834764831845f;
  float bL, gcL;
  {
    const float* bap = ba + (row0 + lane) * 8;
    bL = sigmoidf(bap[h]);
    const float xx = bap[4 + h] + dt_bias[h];
    const float sp = fmaxf(xx, 0.f) + log1pf(__expf(-fabsf(xx)));
    float gg = -__expf(a_log[h]) * sp;
#pragma unroll
    for (int o = 1; o < 64; o <<= 1) { const float v = __shfl_up(gg, o); if (lane >= o) gg += v; }
    gcL = gg;
  }
  {
    const int d = 2 * lane;
    float cw[3][4][2], xw[3][4][2];
#pragma unroll
    for (int mx = 0; mx < 3; ++mx)
#pragma unroll
      for (int j = 0; j < 4; ++j) {
        const float2 c2 = *(const float2*)(conv_w + j * 1536 + mx * 512 + h * 128 + d);
        cw[mx][j][0] = c2.x; cw[mx][j][1] = c2.y;
      }
    const bf16_t* pbase = proj + (row0 + 16 * w) * PROJW + h * 128 + d;
#pragma unroll
    for (int j = 0; j < 3; ++j) {
      const bool ok = (t0 + 16 * w - 3 + j) >= 0;
#pragma unroll
      for (int mx = 0; mx < 3; ++mx) {
        unsigned u = 0;
        if (ok) u = *(const unsigned*)(pbase + (ptrdiff_t)(j - 3) * PROJW + mx * 512);
        xw[mx][j + 1][0] = bflo(u); xw[mx][j + 1][1] = bfhi(u);
      }
    }
#pragma unroll
    for (int i = 0; i < 16; ++i) {
      float s[3][2];
#pragma unroll
      for (int mx = 0; mx < 3; ++mx) {
        const unsigned u = *(const unsigned*)(pbase + (size_t)i * PROJW + mx * 512);
#pragma unroll
        for (int j = 0; j < 3; ++j) { xw[mx][j][0] = xw[mx][j + 1][0]; xw[mx][j][1] = xw[mx][j + 1][1]; }
        xw[mx][3][0] = bflo(u); xw[mx][3][1] = bfhi(u);
        float y0 = 0.f, y1 = 0.f;
#pragma unroll
        for (int j = 0; j < 4; ++j) { y0 += cw[mx][j][0] * xw[mx][j][0]; y1 += cw[mx][j][1] * xw[mx][j][1]; }
        s[mx][0] = siluf(y0); s[mx][1] = siluf(y1);
      }
      const int row = 16 * w + i;
      const float rq = rsqrtf(wave_sum(s[0][0] * s[0][0] + s[0][1] * s[0][1]) + L2_EPS);
      const float rk = rsqrtf(wave_sum(s[1][0] * s[1][0] + s[1][1] * s[1][1]) + L2_EPS);
      const int off = row * 256 + ((((lane >> 2) ^ (row & 15))) << 4) + (lane & 3) * 4;
      *(unsigned*)(qs + off) = pack2(s[0][0] * rq, s[0][1] * rq);
      *(unsigned*)(ks + off) = pack2(s[1][0] * rk, s[1][1] * rk);
      const float bi = __shfl(bL, row);
      *(unsigned*)(RV + ((size_t)item * 64 + row) * 128 + d) = pack2(bi * s[2][0], bi * s[2][1]);
    }
  }
  __syncthreads();
  {
    f32x4 aKK[4], aQK[4];
#pragma unroll
    for (int nt = 0; nt < 4; ++nt) { aKK[nt] = (f32x4){0.f, 0.f, 0.f, 0.f}; aQK[nt] = (f32x4){0.f, 0.f, 0.f, 0.f}; }
#pragma unroll
    for (int k4 = 0; k4 < 4; ++k4) {
      const int arow = 16 * w + fr;
      const bf16x8 aq = *(const bf16x8*)(qs + arow * 256 + ((((k4 * 4 + fq) ^ (arow & 15))) << 4));
      const bf16x8 ak = *(const bf16x8*)(ks + arow * 256 + ((((k4 * 4 + fq) ^ (arow & 15))) << 4));
#pragma unroll
      for (int nt = 0; nt < 4; ++nt) {
        const int brow = 16 * nt + fr;
        const bf16x8 bk = *(const bf16x8*)(ks + brow * 256 + ((((k4 * 4 + fq) ^ (brow & 15))) << 4));
        aKK[nt] = __builtin_amdgcn_mfma_f32_16x16x32_bf16(ak, bk, aKK[nt], 0, 0, 0);
        aQK[nt] = __builtin_amdgcn_mfma_f32_16x16x32_bf16(aq, bk, aQK[nt], 0, 0, 0);
      }
    }
    float gci[4], bi[4];
#pragma unroll
    for (int r = 0; r < 4; ++r) { gci[r] = __shfl(gcL, 16 * w + 4 * fq + r); bi[r] = __shfl(bL, 16 * w + 4 * fq + r); }
#pragma unroll
    for (int nt = 0; nt < 4; ++nt) {
      const int j = 16 * nt + fr;
      const float gcj = __shfl(gcL, j);
      const int p = 32 * (nt >> 1) + 8 * (fr >> 2) + 4 * (nt & 1) + (fr & 3);
      float av[4];
#pragma unroll
      for (int r = 0; r < 4; ++r) {
        const int i = 16 * w + 4 * fq + r;
        const float dec = (j <= i) ? __expf(gci[r] - gcj) : 0.f;
        av[r] = (j < i) ? bi[r] * aKK[nt][r] * dec : 0.f;
        ATT[((size_t)item * 64 + i) * 64 + p] = (bf16_t)f2bf(aQK[nt][r] * scale * dec);
      }
      *(float4*)(AT + j * 68 + 16 * w + 4 * fq) = make_float4(av[0], av[1], av[2], av[3]);
    }
  }
  __syncthreads();
  if (w == 0) {
    float Tr[64];
    int ln = lane; asm volatile("" : "+v"(ln));
#pragma unroll
    for (int j = 0; j < 64; ++j) Tr[j] = 0.f;
#pragma unroll
    for (int c = 63; c >= 0; --c) {
      float a0 = 0.f, a1 = 0.f, a2 = 0.f, a3 = 0.f;
#pragma unroll
      for (int j4 = 15; j4 >= (c + 1) / 4; --j4) {
        const float4 a = *(const float4*)(AT + c * 68 + j4 * 4);
        asm volatile("v_fmac_f32 %0, %1, %2" : "+v"(a0) : "v"(Tr[4 * j4 + 0]), "v"(a.x));
        asm volatile("v_fmac_f32 %0, %1, %2" : "+v"(a1) : "v"(Tr[4 * j4 + 1]), "v"(a.y));
        asm volatile("v_fmac_f32 %0, %1, %2" : "+v"(a2) : "v"(Tr[4 * j4 + 2]), "v"(a.z));
        asm volatile("v_fmac_f32 %0, %1, %2" : "+v"(a3) : "v"(Tr[4 * j4 + 3]), "v"(a.w));
      }
      Tr[c] = ((ln == c) ? 1.f : 0.f) - ((a0 + a1) + (a2 + a3));
    }
    u32x4* tp = (u32x4*)(TM + ((size_t)item * 64 + lane) * 64);
#pragma unroll
    for (int oc = 0; oc < 8; ++oc) {
      const int k0 = 32 * (oc >> 2) + 4 * (oc & 3);
      u32x4 v;
      v[0] = pack2(Tr[k0 + 0], Tr[k0 + 1]); v[1] = pack2(Tr[k0 + 2], Tr[k0 + 3]);
      v[2] = pack2(Tr[k0 + 16], Tr[k0 + 17]); v[3] = pack2(Tr[k0 + 18], Tr[k0 + 19]);
      tp[oc] = v;
    }
  } else {
    const float gclast = __shfl(gcL, 63);
    if (tid == 64) GL[item] = __expf(gclast);
#pragma unroll 1
    for (int it = 0; it < 16; ++it) {
      const int idx = (tid - 64) + it * 192;
      const int mtx = idx >> 10, rem = idx & 1023;
      if (mtx < 2) {
        const int i = rem >> 4, oc = rem & 15;
        const float gi = __shfl(gcL, i), bi = __shfl(bL, i);
        const float f = (mtx == 0) ? scale * __expf(gi) : -bi * __expf(gi);
        const unsigned char* st = (mtx == 0) ? qs : ks;
        const int d0 = 32 * (oc >> 2) + 4 * (oc & 3);
        const uint2 lo = *(const uint2*)(st + i * 256 + ((((d0 >> 3) ^ (i & 15))) << 4) + (d0 & 7) * 2);
        const uint2 hi = *(const uint2*)(st + i * 256 + (((((d0 + 16) >> 3) ^ (i & 15))) << 4) + (d0 & 7) * 2);
        u32x4 v;
        v[0] = pack2(bflo(lo.x) * f, bfhi(lo.x) * f); v[1] = pack2(bflo(lo.y) * f, bfhi(lo.y) * f);
        v[2] = pack2(bflo(hi.x) * f, bfhi(hi.x) * f); v[3] = pack2(bflo(hi.y) * f, bfhi(hi.y) * f);
        bf16_t* dst = ((mtx == 0) ? QD : W0N) + ((size_t)item * 64 + i) * 128 + 8 * oc;
        *(u32x4*)dst = v;
      } else {
        const int d = rem & 127, oc = rem >> 7;
        const int j0 = 32 * (oc >> 2) + 4 * (oc & 3);
        float val[8];
#pragma unroll
        for (int e = 0; e < 8; ++e) {
          const int j = j0 + (e & 3) + ((e >> 2) << 4);
          const float f = __expf(gclast - __shfl(gcL, j));
          const unsigned short raw = *(const unsigned short*)(ks + j * 256 + ((((d >> 3) ^ (j & 15))) << 4) + (d & 7) * 2);
          val[e] = bf2f(raw) * f;
        }
        u32x4 v;
        v[0] = pack2(val[0], val[1]); v[1] = pack2(val[2], val[3]); v[2] = pack2(val[4], val[5]); v[3] = pack2(val[6], val[7]);
        *(u32x4*)(KTT + ((size_t)item * 128 + d) * 64 + 8 * oc) = v;
      }
    }
  }
  __syncthreads();
}

__device__ __forceinline__ void ph_dnscan(unsigned char* smem, int item, const bf16_t* __restrict__ QDp, const bf16_t* __restrict__ W0Np, const bf16_t* __restrict__ KTTp,
                                          const bf16_t* __restrict__ RVp, const bf16_t* __restrict__ TMp, const bf16_t* __restrict__ ATTp, const float* __restrict__ GLp,
                                          float* __restrict__ op) {
  const int tid = TIDX, lane = tid & 63, w = tid >> 6, fr = lane & 15, fq = lane >> 4;
  const int bh = item >> 1, half = item & 1, b = bh >> 2, h = bh & 3;
  const int vcol0 = (half * 4 + w) * 16;
  unsigned char* sW0 = smem; unsigned char* sQD = smem + 16384; unsigned char* sKT = smem + 32768; unsigned char* sT = smem + 49152; unsigned char* sAT = smem + 57344;
  f32x4 S[8];
#pragma unroll
  for (int t = 0; t < 8; ++t) S[t] = (f32x4){0.f, 0.f, 0.f, 0.f};
  u32x4 pf[8]; unsigned short rvp[16];
#define DN_LOAD_A(nn_) do { \
    const size_t ci = (size_t)bh * 64 + (nn_); \
    _Pragma("unroll") for (int i = 0; i < 4; ++i) pf[i] = *(const u32x4*)((const char*)W0Np + ci * 16384 + (size_t)(tid + 256 * i) * 16); \
    _Pragma("unroll") for (int i = 0; i < 4; ++i) pf[4 + i] = *(const u32x4*)((const char*)QDp + ci * 16384 + (size_t)(tid + 256 * i) * 16); \
    _Pragma("unroll") for (int mt = 0; mt < 4; ++mt) \
      _Pragma("unroll") for (int r = 0; r < 4; ++r) rvp[mt * 4 + r] = RVp[(ci * 64 + 16 * mt + 4 * fq + r) * 128 + vcol0 + fr]; \
  } while (0)
#define DN_STORE_A() do { \
    _Pragma("unroll") for (int i = 0; i < 4; ++i) { const int q = tid + 256 * i, row = q >> 4, ch = q & 15; *(u32x4*)(sW0 + row * 256 + ((ch ^ (row & 15)) << 4)) = pf[i]; } \
    _Pragma("unroll") for (int i = 0; i < 4; ++i) { const int q = tid + 256 * i, row = q >> 4, ch = q & 15; *(u32x4*)(sQD + row * 256 + ((ch ^ (row & 15)) << 4)) = pf[4 + i]; } \
  } while (0)
#define DN_LOAD_B(nn_) do { \
    const size_t ci = (size_t)bh * 64 + (nn_); \
    _Pragma("unroll") for (int i = 0; i < 4; ++i) pf[i] = *(const u32x4*)((const char*)KTTp + ci * 16384 + (size_t)(tid + 256 * i) * 16); \
    _Pragma("unroll") for (int i = 0; i < 2; ++i) pf[4 + i] = *(const u32x4*)((const char*)TMp + ci * 8192 + (size_t)(tid + 256 * i) * 16); \
    _Pragma("unroll") for (int i = 0; i < 2; ++i) pf[6 + i] = *(const u32x4*)((const char*)ATTp + ci * 8192 + (size_t)(tid + 256 * i) * 16); \
  } while (0)
#define DN_STORE_B() do { \
    _Pragma("unroll") for (int i = 0; i < 4; ++i) { const int q = tid + 256 * i, row = q >> 3, ch = q & 7; *(u32x4*)(sKT + row * 128 + ((ch ^ (row & 7)) << 4)) = pf[i]; } \
    _Pragma("unroll") for (int i = 0; i < 2; ++i) { const int q = tid + 256 * i, row = q >> 3, ch = q & 7; *(u32x4*)(sT + row * 128 + ((ch ^ (row & 7)) << 4)) = pf[4 + i]; } \
    _Pragma("unroll") for (int i = 0; i < 2; ++i) { const int q = tid + 256 * i, row = q >> 3, ch = q & 7; *(u32x4*)(sAT + row * 128 + ((ch ^ (row & 7)) << 4)) = pf[6 + i]; } \
  } while (0)
  __syncthreads();
  DN_LOAD_A(0);
  DN_STORE_A();
  for (int nn = 0; nn < 64; ++nn) {
    f32x4 Z[4];
#pragma unroll
    for (int mt = 0; mt < 4; ++mt) Z[mt] = (f32x4){bf2f(rvp[mt * 4 + 0]), bf2f(rvp[mt * 4 + 1]), bf2f(rvp[mt * 4 + 2]), bf2f(rvp[mt * 4 + 3])};
    const float gl = GLp[(size_t)bh * 64 + nn];
    DN_LOAD_B(nn);
    __syncthreads();
    bf16x8 Sb[4];
#pragma unroll
    for (int k4 = 0; k4 < 4; ++k4) Sb[k4] = pack8(S[2 * k4], S[2 * k4 + 1]);
    f32x4 O[4];
#pragma unroll
    for (int mt = 0; mt < 4; ++mt) {
      O[mt] = (f32x4){0.f, 0.f, 0.f, 0.f};
      const int row = 16 * mt + fr;
#pragma unroll
      for (int k4 = 0; k4 < 4; ++k4) {
        const int off = row * 256 + ((((k4 * 4 + fq) ^ fr)) << 4);
        const bf16x8 aw = *(const bf16x8*)(sW0 + off);
        const bf16x8 aq = *(const bf16x8*)(sQD + off);
        Z[mt] = __builtin_amdgcn_mfma_f32_16x16x32_bf16(aw, Sb[k4], Z[mt], 0, 0, 0);
        O[mt] = __builtin_amdgcn_mfma_f32_16x16x32_bf16(aq, Sb[k4], O[mt], 0, 0, 0);
      }
    }
    bf16x8 Zb[2];
    Zb[0] = pack8(Z[0], Z[1]); Zb[1] = pack8(Z[2], Z[3]);
    DN_STORE_B();
    if (nn + 1 < 64) DN_LOAD_A(nn + 1);
    __syncthreads();
    f32x4 Vn[4];
#pragma unroll
    for (int mt = 0; mt < 4; ++mt) {
      Vn[mt] = (f32x4){0.f, 0.f, 0.f, 0.f};
      const int row = 16 * mt + fr;
#pragma unroll
      for (int s = 0; s < 2; ++s) {
        if (s <= (mt >> 1)) {
          const bf16x8 at = *(const bf16x8*)(sT + row * 128 + ((((s * 4 + fq) ^ (row & 7))) << 4));
          Vn[mt] = __builtin_amdgcn_mfma_f32_16x16x32_bf16(at, Zb[s], Vn[mt], 0, 0, 0);
        }
      }
    }
    bf16x8 Vb[2];
    Vb[0] = pack8(Vn[0], Vn[1]); Vb[1] = pack8(Vn[2], Vn[3]);
#pragma unroll
    for (int mt = 0; mt < 4; ++mt) {
      const int row = 16 * mt + fr;
#pragma unroll
      for (int s = 0; s < 2; ++s) {
        if (s <= (mt >> 1)) {
          const bf16x8 aa = *(const bf16x8*)(sAT + row * 128 + ((((s * 4 + fq) ^ (row & 7))) << 4));
          O[mt] = __builtin_amdgcn_mfma_f32_16x16x32_bf16(aa, Vb[s], O[mt], 0, 0, 0);
        }
      }
      const size_t tok = (size_t)b * SEQ + nn * 64 + 16 * mt + 4 * fq;
#pragma unroll
      for (int r = 0; r < 4; ++r) op[(tok + r) * 512 + h * 128 + vcol0 + fr] = O[mt][r];
    }
#pragma unroll
    for (int t = 0; t < 8; ++t) {
      S[t] = S[t] * gl;
      const int row = 16 * t + fr;
#pragma unroll
      for (int s = 0; s < 2; ++s) {
        const bf16x8 ak = *(const bf16x8*)(sKT + row * 128 + ((((s * 4 + fq) ^ (row & 7))) << 4));
        S[t] = __builtin_amdgcn_mfma_f32_16x16x32_bf16(ak, Vb[s], S[t], 0, 0, 0);
      }
    }
    if (nn + 1 < 64) DN_STORE_A();
  }
  __syncthreads();
#undef DN_LOAD_A
#undef DN_STORE_A
#undef DN_LOAD_B
#undef DN_STORE_B
}

__device__ __forceinline__ void ph_dn_post(int n, const float* __restrict__ o, const bf16_t* __restrict__ proj, const float* __restrict__ dn_norm_g, bf16_t* __restrict__ mixed) {
  const int tid = TIDX, h = tid >> 6, lane = tid & 63;
  const float o0 = o[(size_t)n * 512 + h * 128 + lane], o1 = o[(size_t)n * 512 + h * 128 + 64 + lane];
  const float ss = wave_sum(o0 * o0 + o1 * o1);
  const float rn = rsqrtf(ss * (1.f / 128.f) + RMS_EPS);
  const float z0 = bf2f(proj[(size_t)n * PROJW + OFF_Z + h * 128 + lane]), z1 = bf2f(proj[(size_t)n * PROJW + OFF_Z + h * 128 + 64 + lane]);
  mixed[(size_t)n * DM + h * 128 + lane] = (bf16_t)f2bf(o0 * rn * dn_norm_g[lane] * siluf(z0));
  mixed[(size_t)n * DM + h * 128 + 64 + lane] = (bf16_t)f2bf(o1 * rn * dn_norm_g[64 + lane] * siluf(z1));
}

__device__ __forceinline__ void ph_swa(unsigned char* smem, int item, const bf16_t* __restrict__ proj, const bf16_t* __restrict__ vt, const float* __restrict__ sinks, bf16_t* __restrict__ mixed) {
  const int tid = TIDX, lane = tid & 63, w = tid >> 6, fr = lane & 15, fq = lane >> 4;
  const int qb = item & 31, kvh = (item >> 5) & 1, b = item >> 6;
  const int t0 = qb * 128;
  const size_t rowb = (size_t)b * SEQ;
  unsigned char* sK = smem;
  unsigned char* sV = smem + 32768;
  __syncthreads();
#pragma unroll
  for (int i = 0; i < 8; ++i) {
    const int q = tid + 256 * i, row = q >> 3, ch = q & 7;
    const int pos = t0 - 128 + row;
    u32x4 v = (u32x4){0u, 0u, 0u, 0u};
    if (pos >= 0) v = *(const u32x4*)(proj + (rowb + pos) * PROJW + OFF_SK + kvh * 64 + ch * 8);
    *(u32x4*)(sK + row * 128 + ((ch ^ (row & 7)) << 4)) = v;
  }
#pragma unroll
  for (int i = 0; i < 8; ++i) {
    const int q = tid + 256 * i, row = q >> 5, ch = q & 31;
    const int pos = t0 - 128 + ch * 8;
    u32x4 v = (u32x4){0u, 0u, 0u, 0u};
    if (pos >= 0) v = *(const u32x4*)(vt + ((size_t)(b * 128 + kvh * 64 + row)) * SEQ + pos);
    *(u32x4*)(sV + row * 512 + ((ch ^ (row & 15)) << 4)) = v;
  }
  __syncthreads();
  const int head = kvh * 4 + w;
  const float slope = exp2f(-(float)(head + 1));
  const float sink = sinks[head];
#pragma unroll 1
  for (int qt = 0; qt < 8; ++qt) {
    const bf16_t* qp = proj + (rowb + t0 + qt * 16 + fr) * PROJW + OFF_SQ + head * 64 + fq * 8;
    const bf16x8 qf0 = *(const bf16x8*)(qp), qf1 = *(const bf16x8*)(qp + 32);
    const int kp0 = qt >> 1;
    f32x4 st[10];
#pragma unroll
    for (int kt = 0; kt < 10; ++kt) {
      const int krow = (2 * kp0 + kt) * 16 + fr;
      st[kt] = (f32x4){0.f, 0.f, 0.f, 0.f};
      const bf16x8 k0 = *(const bf16x8*)(sK + krow * 128 + (((0 + fq) ^ (krow & 7)) << 4));
      const bf16x8 k1 = *(const bf16x8*)(sK + krow * 128 + (((4 + fq) ^ (krow & 7)) << 4));
      st[kt] = __builtin_amdgcn_mfma_f32_16x16x32_bf16(k0, qf0, st[kt], 0, 0, 0);
      st[kt] = __builtin_amdgcn_mfma_f32_16x16x32_bf16(k1, qf1, st[kt], 0, 0, 0);
    }
    const int i = qt * 16 + fr;
    float mx = sink;
#pragma unroll
    for (int kt = 0; kt < 10; ++kt)
#pragma unroll
      for (int r = 0; r < 4; ++r) {
        const int jb = (2 * kp0 + kt) * 16 + 4 * fq + r;
        const int dist = 128 + i - jb;
        const bool ok = (dist >= 0) && (dist < 128) && (t0 - 128 + jb >= 0);
        const float s = ok ? (st[kt][r] * 0.125f - slope * (float)dist) : -INFINITY;
        st[kt][r] = s;
        mx = fmaxf(mx, s);
      }
    mx = fmaxf(mx, __shfl_xor(mx, 16));
    mx = fmaxf(mx, __shfl_xor(mx, 32));
    float sum = 0.f;
#pragma unroll
    for (int kt = 0; kt < 10; ++kt)
#pragma unroll
      for (int r = 0; r < 4; ++r) { const float p = __expf(st[kt][r] - mx); st[kt][r] = p; sum += p; }
    sum += __shfl_xor(sum, 16);
    sum += __shfl_xor(sum, 32);
    const float inv = 1.f / (sum + __expf(sink - mx));
    f32x4 O[4];
#pragma unroll
    for (int nt = 0; nt < 4; ++nt) O[nt] = (f32x4){0.f, 0.f, 0.f, 0.f};
#pragma unroll
    for (int s5 = 0; s5 < 5; ++s5) {
      const bf16x8 pa = pack8(st[2 * s5] * inv, st[2 * s5 + 1] * inv);
      const int key0 = (2 * kp0 + 2 * s5) * 16 + 4 * fq;
#pragma unroll
      for (int nt = 0; nt < 4; ++nt) {
        const int drow = nt * 16 + fr;
        const int c0 = key0 >> 3, c1 = (key0 + 16) >> 3;
        const u32x2 lo = *(const u32x2*)(sV + drow * 512 + ((c0 ^ (drow & 15)) << 4) + ((key0 >> 2) & 1) * 8);
        const u32x2 hi = *(const u32x2*)(sV + drow * 512 + ((c1 ^ (drow & 15)) << 4) + ((key0 >> 2) & 1) * 8);
        const u32x4 vb = (u32x4){lo[0], lo[1], hi[0], hi[1]};
        O[nt] = __builtin_amdgcn_mfma_f32_16x16x32_bf16(pa, __builtin_bit_cast(bf16x8, vb), O[nt], 0, 0, 0);
      }
    }
#pragma unroll
    for (int nt = 0; nt < 4; ++nt)
#pragma unroll
      for (int r = 0; r < 4; ++r)
        mixed[(rowb + t0 + qt * 16 + 4 * fq + r) * DM + 512 + head * 64 + nt * 16 + fr] = (bf16_t)f2bf(O[nt][r]);
  }
}

__device__ __forceinline__ void ph_wout(unsigned char* smem, int tile, const bf16_t* __restrict__ mixed, const bf16_t* __restrict__ wt, const float* __restrict__ x, float* __restrict__ y1) {
  GEMM_IDS
  const int n0 = (tile & 7) * 128, m0 = (tile >> 3) * 128;
  LdRowBF16 al; al.init([&](int r) { return mixed + (size_t)(m0 + r) * DM; });
  LdRowBF16 bl; bl.init([&](int r) { return wt + (size_t)(n0 + r) * DM; });
  f32x4 acc[4][4];
  gemm128(smem, al, bl, DM / 64, acc);
#pragma unroll
  for (int m = 0; m < 4; ++m)
#pragma unroll
    for (int n = 0; n < 4; ++n) {
      const size_t idx = (size_t)(m0 + wr * 64 + m * 16 + fr) * DM + n0 + wc * 64 + n * 16 + fq * 4;
      const f32x4 xv = *(const f32x4*)(x + idx);
      *(f32x4*)(y1 + idx) = xv * ALPHA + acc[m][n];
    }
}

__device__ __forceinline__ void ph_ln1(int item, float* __restrict__ y, const float* __restrict__ gam, const float* __restrict__ bet, bf16_t* __restrict__ xbf) {
  const int row = item * 4 + (TIDX >> 6), lane = TIDX & 63;
  float4* p = (float4*)(y + (size_t)row * DM);
  float4 v[4]; float s = 0.f;
#pragma unroll
  for (int i = 0; i < 4; ++i) { v[i] = p[lane + i * 64]; s += v[i].x + v[i].y + v[i].z + v[i].w; }
  const float mu = wave_sum(s) * (1.f / DM);
  float q = 0.f;
#pragma unroll
  for (int i = 0; i < 4; ++i) { const float a = v[i].x - mu, b = v[i].y - mu, c = v[i].z - mu, d = v[i].w - mu; q += a * a + b * b + c * c + d * d; }
  const float rs = rsqrtf(wave_sum(q) * (1.f / DM) + LN_EPS);
#pragma unroll
  for (int i = 0; i < 4; ++i) {
    const float4 gg = ((const float4*)gam)[lane + i * 64], bb = ((const float4*)bet)[lane + i * 64];
    float4 r;
    r.x = (v[i].x - mu) * rs * gg.x + bb.x; r.y = (v[i].y - mu) * rs * gg.y + bb.y;
    r.z = (v[i].z - mu) * rs * gg.z + bb.z; r.w = (v[i].w - mu) * rs * gg.w + bb.w;
    p[lane + i * 64] = r;
    u32x2 w; w[0] = pack2(r.x, r.y); w[1] = pack2(r.z, r.w);
    ((u32x2*)(xbf + (size_t)row * DM))[lane + i * 64] = w;
  }
}

__device__ __forceinline__ void ph_router(unsigned char* smem, int tile, const bf16_t* __restrict__ xbf, const bf16_t* __restrict__ wt, float* __restrict__ logits) {
  GEMM_IDS
  const int n0 = (tile & 1) * 128, m0 = (tile >> 1) * 128;
  LdRowBF16 al; al.init([&](int r) { return xbf + (size_t)(m0 + r) * DM; });
  LdRowBF16 bl; bl.init([&](int r) { return wt + (size_t)(n0 + r) * DM; });
  f32x4 acc[4][4];
  gemm128(smem, al, bl, DM / 64, acc);
#pragma unroll
  for (int m = 0; m < 4; ++m)
#pragma unroll
    for (int n = 0; n < 4; ++n)
      *(f32x4*)(logits + (size_t)(m0 + wr * 64 + m * 16 + fr) * NEXP + n0 + wc * 64 + n * 16 + fq * 4) = acc[m][n];
}

__device__ __forceinline__ void ph_route(int item, const float* __restrict__ logits, const float* __restrict__ router_bias, int* __restrict__ cnt, int* __restrict__ list, float* __restrict__ gates) {
  const int n = item * 4 + (TIDX >> 6), lane = TIDX & 63;
  const float4 lg = ((const float4*)(logits + (size_t)n * NEXP))[lane];
  const float4 rb = ((const float4*)router_bias)[lane];
  float sc[4] = {sigmoidf(lg.x), sigmoidf(lg.y), sigmoidf(lg.z), sigmoidf(lg.w)};
  float sel[4] = {sc[0] + rb.x, sc[1] + rb.y, sc[2] + rb.z, sc[3] + rb.w};
  float t1 = fmaxf(sel[0], sel[1]), t2 = fminf(sel[0], sel[1]);
  { const float a = sel[2]; if (a > t1) { t2 = t1; t1 = a; } else if (a > t2) t2 = a; }
  { const float a = sel[3]; if (a > t1) { t2 = t1; t1 = a; } else if (a > t2) t2 = a; }
#pragma unroll
  for (int o = 1; o < 8; o <<= 1) {
    const float b1 = __shfl_xor(t1, o), b2 = __shfl_xor(t2, o);
    const float n1 = fmaxf(t1, b1), n2 = fmaxf(fminf(t1, b1), fmaxf(t2, b2));
    t1 = n1; t2 = n2;
  }
  const float gs = t1 + t2;
  const int mygrp = lane >> 3;
  int rank = 0;
#pragma unroll
  for (int j = 0; j < 8; ++j) {
    const float o = __shfl(gs, j * 8);
    rank += (o > gs || (o == gs && j < mygrp)) ? 1 : 0;
  }
  const bool gsel = rank < 4;
  float cand[4];
#pragma unroll
  for (int i = 0; i < 4; ++i) cand[i] = gsel ? sel[i] : -INFINITY;
  float gsum = 0.f; float myg = 0.f; int mye = 0;
#pragma unroll 1
  for (int r = 0; r < TOPK; ++r) {
    float bv = cand[0]; int bi = 0;
#pragma unroll
    for (int i = 1; i < 4; ++i) if (cand[i] > bv) { bv = cand[i]; bi = i; }
    int be = lane * 4 + bi;
    float bs = (bi == 0) ? sc[0] : (bi == 1) ? sc[1] : (bi == 2) ? sc[2] : sc[3];
#pragma unroll
    for (int o = 1; o < 64; o <<= 1) {
      const float ov = __shfl_xor(bv, o); const int oe = __shfl_xor(be, o); const float os = __shfl_xor(bs, o);
      if (ov > bv || (ov == bv && oe < be)) { bv = ov; be = oe; bs = os; }
    }
    if ((be >> 2) == lane) {
      const int bi2 = be & 3;
      if (bi2 == 0) cand[0] = -INFINITY; else if (bi2 == 1) cand[1] = -INFINITY; else if (bi2 == 2) cand[2] = -INFINITY; else cand[3] = -INFINITY;
    }
    gsum += bs;
    if (lane == r) { myg = bs; mye = be; }
  }
  if (lane < TOPK) {
    const int slot = atomicAdd(&cnt[mye], 1);
    list[(size_t)mye * CAP + slot] = n * TOPK + lane;
    gates[(size_t)n * TOPK + lane] = myg / gsum * 2.5f;
  }
}

__device__ __forceinline__ void moe_build_prefix(const int* __restrict__ cnt, int* sscan) {
  const int tid = TIDX;
  const int e = ((tid & 31) << 3) | (tid >> 5);
  const int c = cnt[e];
  __syncthreads();
  sscan[tid] = (c + 127) >> 7;
  __syncthreads();
  for (int o = 1; o < 256; o <<= 1) {
    const int v = (tid >= o) ? sscan[tid - o] : 0;
    __syncthreads();
    sscan[tid] += v;
    __syncthreads();
  }
}
__device__ __forceinline__ void moe_locate(const int* sscan, int x, int lt, int& e, int& rt) {
  const int base = x ? sscan[32 * x - 1] : 0;
  const int nrouted = sscan[32 * x + 31] - base;
  if (lt >= nrouted) { e = 256; rt = x * (NTOK / 128 / 8) + (lt - nrouted); return; }
  const int g = base + lt;
  int lo = 32 * x, hi = 32 * x + 31;
  while (lo < hi) { const int mid = (lo + hi) >> 1; if (sscan[mid] > g) hi = mid; else lo = mid + 1; }
  e = ((lo & 31) << 3) | (lo >> 5); rt = g - (lo ? sscan[lo - 1] : 0);
}

__device__ __forceinline__ void ph_moe1(unsigned char* smem, int e, int rt, int ct, const bf16_t* __restrict__ xbf, const int* __restrict__ cnt, const int* __restrict__ list,
                                        const float* __restrict__ w_gate, const float* __restrict__ w_up,
                                        const float* __restrict__ sw_gate, const float* __restrict__ sw_up, bf16_t* __restrict__ hbuf) {
  int* sasg = (int*)(smem + SM_MISC + 2048);
  GEMM_IDS
  const int rows = (e < 256) ? cnt[e] : NTOK;
  if (tid < 128) {
    const int r = rt * 128 + tid;
    int a = -1;
    if (r < rows) a = (e < 256) ? list[(size_t)e * CAP + r] : (NA + r);
    sasg[tid] = a;
  }
  __syncthreads();
  LdRowBF16 al; al.init([&](int r) { const int a = sasg[r]; const int tok = (a < 0) ? 0 : (a < NA ? (a >> 3) : (a - NA)); return xbf + (size_t)tok * DM; });
  LdColF32 bl;
  {
    const int jj = 4 * (tid & 31);
    const int bwc = jj >> 6, bn = (jj >> 4) & 3;
    const int ff = ct * 64 + bwc * 32 + (bn >> 1) * 16 + (jj & 15);
    const float* W = (e < 256) ? ((bn & 1) ? w_up : w_gate) + (size_t)e * DM * EFF : ((bn & 1) ? sw_up : sw_gate);
    bl.init(W + ff, EFF, true);
  }
  f32x4 acc[4][4];
  gemm128(smem, al, bl, DM / 64, acc);
#pragma unroll
  for (int m = 0; m < 4; ++m) {
    const int a = sasg[wr * 64 + m * 16 + fr];
    if (a >= 0) {
#pragma unroll
      for (int pp = 0; pp < 2; ++pp) {
        float hv[4];
#pragma unroll
        for (int r = 0; r < 4; ++r) hv[r] = siluf(acc[m][2 * pp][r]) * acc[m][2 * pp + 1][r];
        u32x2 w; w[0] = pack2(hv[0], hv[1]); w[1] = pack2(hv[2], hv[3]);
        *(u32x2*)(hbuf + (size_t)a * EFF + ct * 64 + wc * 32 + pp * 16 + fq * 4) = w;
      }
    }
  }
  __syncthreads();
}

__device__ __forceinline__ void ph_moe2(unsigned char* smem, int e, int rt, int ct, const bf16_t* __restrict__ hbuf, const int* __restrict__ cnt, const int* __restrict__ list, const float* __restrict__ gates,
                                        const float* __restrict__ w_down, const float* __restrict__ sw_down, bf16_t* __restrict__ ybuf) {
  int* sasg = (int*)(smem + SM_MISC + 2048);
  float* sgate = (float*)(smem + SM_MISC + 2048 + 512);
  GEMM_IDS
  const int rows = (e < 256) ? cnt[e] : NTOK;
  const int n0 = ct * 128;
  if (tid < 128) {
    const int r = rt * 128 + tid;
    int a = -1;
    if (r < rows) a = (e < 256) ? list[(size_t)e * CAP + r] : (NA + r);
    sasg[tid] = a;
    sgate[tid] = (a >= 0 && a < NA) ? gates[a] : 1.f;
  }
  __syncthreads();
  LdRowBF16 al; al.init([&](int r) { const int a = sasg[r]; return hbuf + (size_t)(a < 0 ? 0 : a) * EFF; });
  LdColF32 bl; bl.init(((e < 256) ? w_down + (size_t)e * EFF * DM : sw_down) + n0 + 4 * (tid & 31), DM, true);
  f32x4 acc[4][4];
  gemm128(smem, al, bl, EFF / 64, acc);
#pragma unroll
  for (int m = 0; m < 4; ++m) {
    const int r_ = wr * 64 + m * 16 + fr;
    const int a = sasg[r_];
    if (a >= 0) {
      const float gt = sgate[r_];
#pragma unroll
      for (int n = 0; n < 4; ++n) {
        u32x2 w; w[0] = pack2(acc[m][n][0] * gt, acc[m][n][1] * gt); w[1] = pack2(acc[m][n][2] * gt, acc[m][n][3] * gt);
        *(u32x2*)(ybuf + (size_t)a * DM + n0 + wc * 64 + n * 16 + fq * 4) = w;
      }
    }
  }
  __syncthreads();
}

__device__ __forceinline__ void ph_final(int item, float* __restrict__ out, const bf16_t* __restrict__ ybuf, const float* __restrict__ gam, const float* __restrict__ bet) {
  const int row = item * 4 + (TIDX >> 6), lane = TIDX & 63;
  float4* p = (float4*)(out + (size_t)row * DM);
  float4 v[4]; float s = 0.f;
#pragma unroll
  for (int i = 0; i < 4; ++i) {
    float4 a = p[lane + i * 64];
    a.x *= ALPHA; a.y *= ALPHA; a.z *= ALPHA; a.w *= ALPHA;
#pragma unroll
    for (int k = 0; k < 9; ++k) {
      const size_t yr = (k < 8) ? ((size_t)row * 8 + k) : ((size_t)NA + row);
      const uint2 w = ((const uint2*)(ybuf + yr * DM))[lane + i * 64];
      a.x += bflo(w.x); a.y += bfhi(w.x); a.z += bflo(w.y); a.w += bfhi(w.y);
    }
    v[i] = a; s += a.x + a.y + a.z + a.w;
  }
  const float mu = wave_sum(s) * (1.f / DM);
  float q = 0.f;
#pragma unroll
  for (int i = 0; i < 4; ++i) { const float a = v[i].x - mu, b = v[i].y - mu, c = v[i].z - mu, d = v[i].w - mu; q += a * a + b * b + c * c + d * d; }
  const float rs = rsqrtf(wave_sum(q) * (1.f / DM) + LN_EPS);
#pragma unroll
  for (int i = 0; i < 4; ++i) {
    const float4 gg = ((const float4*)gam)[lane + i * 64], bb = ((const float4*)bet)[lane + i * 64];
    float4 r;
    r.x = (v[i].x - mu) * rs * gg.x + bb.x; r.y = (v[i].y - mu) * rs * gg.y + bb.y;
    r.z = (v[i].z - mu) * rs * gg.z + bb.z; r.w = (v[i].w - mu) * rs * gg.w + bb.w;
    p[lane + i * 64] = r;
  }
}

#define XB_TMO      128
#define XB_XCNT(j)  (256  + 64 * (j))
#define XB_XSUB(j)  (1280 + 64 * (j))
#define XB_XGEN(j)  (2304 + 64 * (j))
#define XB_TOP      3328
#define XB_TOPGEN   3392
#define XCD_BAR_WORDS 3456
#define XB_SPIN_CAP (1u << 22)
#define LAS __attribute__((address_space(3)))
__device__ __forceinline__ unsigned xb_ld(unsigned* p)              { return __hip_atomic_load(p, __ATOMIC_RELAXED, __HIP_MEMORY_SCOPE_AGENT); }
__device__ __forceinline__ unsigned xb_add(unsigned* p, unsigned v) { return __hip_atomic_fetch_add(p, v, __ATOMIC_RELAXED, __HIP_MEMORY_SCOPE_AGENT); }
__device__ __forceinline__ unsigned xb_xcc_id() { return (unsigned)__builtin_amdgcn_s_getreg((3 << 11) | 20) & 0xFu; }
#define XB_SPIN(cond, bar) do { unsigned _sp = 0; while (cond) { __builtin_amdgcn_s_sleep(1); \
    if ((++_sp & 255u) == 0u) { if (xb_ld(&(bar)[XB_TMO])) break; if (_sp > XB_SPIN_CAP) { atomicAdd(&(bar)[XB_TMO], 1u); break; } } } } while (0)
struct XcdBarrier { unsigned* bar; unsigned x; volatile LAS unsigned* st; };
__device__ __forceinline__ XcdBarrier xcd_barrier_post(unsigned* bar, volatile LAS unsigned* st) {
  XcdBarrier b; b.bar = bar; b.x = xb_xcc_id(); b.st = st;
  if (threadIdx.x == 0) (void)xb_add(&bar[XB_XCNT(b.x)], 1u);
  return b;
}
__device__ __forceinline__ void xcd_barrier_complete(unsigned* bar, unsigned x, unsigned& nloc, unsigned& nx) {
  const unsigned G = gridDim.x * gridDim.y * gridDim.z;
  unsigned sum, cnt, mine, sp = 0u;
  for (;;) {
    sum = 0u; cnt = 0u; mine = 0u;
#pragma unroll
    for (unsigned j = 0; j < 16; ++j) { const unsigned c = xb_ld(&bar[XB_XCNT(j)]); sum += c; cnt += (c > 0u) ? 1u : 0u; mine = (j == x) ? c : mine; }
    if (sum == G) break;
    __builtin_amdgcn_s_sleep(1);
    if ((++sp & 255u) == 0u) { if (xb_ld(&bar[XB_TMO])) break; if (sp > XB_SPIN_CAP) { atomicAdd(&bar[XB_TMO], 1u); break; } }
  }
  nloc = mine > 0u ? mine : 1u; nx = cnt > 0u ? cnt : 1u;
}
__device__ __forceinline__ void xcd_barrier(const XcdBarrier& b) {
  asm volatile("s_waitcnt vmcnt(0)" ::: "memory");
  __syncthreads();
  if (threadIdx.x == 0) {
    unsigned* bar = b.bar;
    __builtin_amdgcn_s_waitcnt(0);
    unsigned nloc = b.st[0], nx = b.st[1];
    if (nloc == 0u) { xcd_barrier_complete(bar, b.x, nloc, nx); b.st[0] = nloc; b.st[1] = nx; }
    const unsigned old = xb_add(&bar[XB_XSUB(b.x)], 1u);
    const unsigned gen = old / nloc;
    if (old + 1u == (gen + 1u) * nloc) {
      __builtin_amdgcn_fence(__ATOMIC_RELEASE, "agent");
      asm volatile("s_waitcnt vmcnt(0)" ::: "memory");
      const unsigned og = xb_add(&bar[XB_TOP], 1u);
      const unsigned tg = og / nx;
      if (og + 1u == (tg + 1u) * nx) xb_add(&bar[XB_TOPGEN], 1u);
      else XB_SPIN(xb_ld(&bar[XB_TOPGEN]) == tg, bar);
      __builtin_amdgcn_fence(__ATOMIC_ACQUIRE, "agent");
      xb_add(&bar[XB_XGEN(b.x)], 1u);
      asm volatile("s_waitcnt vmcnt(0)" ::: "memory");
    } else {
      XB_SPIN(xb_ld(&bar[XB_XGEN(b.x)]) == gen, bar);
      __builtin_amdgcn_fence(__ATOMIC_ACQUIRE, "agent");
      asm volatile("s_waitcnt vmcnt(0)" ::: "memory");
    }
  }
  __syncthreads();
}

__global__ void __launch_bounds__(256, 2) mega(Params P) {
  __shared__ __attribute__((aligned(16))) unsigned char smem[SMEM_BYTES];
  cg::grid_group grid = cg::this_grid();
  const int bid = blockIdx.x, nblk = gridDim.x;
#define xin (P.in[0])
#define w_in (P.in[1])
#define conv_w (P.in[2])
#define a_log (P.in[3])
#define dt_bias (P.in[4])
#define dn_norm_g (P.in[5])
#define sinks (P.in[6])
#define w_out (P.in[7])
#define ln1_g (P.in[8])
#define ln1_b (P.in[9])
#define router_w (P.in[10])
#define router_bias (P.in[11])
#define w_gate (P.in[12])
#define w_up (P.in[13])
#define w_down (P.in[14])
#define sw_gate (P.in[15])
#define sw_up (P.in[16])
#define sw_down (P.in[17])
#define ln2_g (P.in[18])
#define ln2_b (P.in[19])
#define outp (P.out)
#define x1bf ((bf16_t*)(P.ws + WS_X1BF))
#define logits ((float*)(P.ws + WS_LOGIT))
#define list ((int*)(P.ws + WS_LIST))
#define gates ((float*)(P.ws + WS_GATES))
#define cnt ((int*)(P.ws + WS_CTRL))
#define barw ((unsigned*)(P.ws + WS_CTRL + 4096))
#define mixed ((bf16_t*)(P.ws + WS_MIXED))
#define proj ((bf16_t*)(P.ws + WS_PROJ))
#define ba ((float*)(P.ws + WS_BA))
#define QD ((bf16_t*)(P.ws + WS_QD))
#define W0N ((bf16_t*)(P.ws + WS_W0N))
#define KTT ((bf16_t*)(P.ws + WS_KTT))
#define RV ((bf16_t*)(P.ws + WS_RV))
#define TM ((bf16_t*)(P.ws + WS_TM))
#define ATT ((bf16_t*)(P.ws + WS_ATT))
#define GL ((float*)(P.ws + WS_GL))
#define obuf ((float*)(P.ws + WS_O))
#define VTb ((bf16_t*)(P.ws + WS_VT))
#define XBF ((bf16_t*)(P.ws + WS_XBF))
#define WTIN ((bf16_t*)(P.ws + WS_WTIN))
#define WTOUT ((bf16_t*)(P.ws + WS_WTOUT))
#define WTR ((bf16_t*)(P.ws + WS_WTR))
#define hbuf ((bf16_t*)(P.ws + WS_HBUF))
#define ybuf ((bf16_t*)(P.ws + WS_YBUF))
  {
    volatile LAS unsigned* st0 = (volatile LAS unsigned*)(smem + SM_MISC + 4080);
    if (threadIdx.x == 0) { st0[0] = 0u; st0[1] = 0u; }
    __syncthreads();
  }
  const int xcd = bid & 7, xloc = bid >> 3, xnl = nblk >> 3;
  XcdBarrier xb = xcd_barrier_post(barw, (volatile LAS unsigned*)(smem + SM_MISC + 4080));
  for (int it = bid; it < NTOK / 4; it += nblk) ph_cvt_x(it, xin, XBF);
  for (int it = bid; it < 16 * 46 + 16 * 16 + 16 * 4; it += nblk) {
    if (it < 16 * 46) ph_cvt_wt(smem, it % 16, it / 16, w_in, DM, INC, WTIN);
    else if (it < 16 * 46 + 256) { const int j = it - 16 * 46; ph_cvt_wt(smem, j % 16, j / 16, w_out, DM, DM, WTOUT); }
    else { const int j = it - 16 * 46 - 256; ph_cvt_wt(smem, j % 16, j / 16, router_w, DM, NEXP, WTR); }
  }
  grid.sync();
  for (int i = xloc; i < 32 * 23; i += xnl) ph_proj(smem, (xcd * 32 + i / 23) * 23 + i % 23, XBF, WTIN, proj, ba, VTb);
  xcd_barrier(xb);
  for (int it = bid; it < 2048; it += nblk) ph_dnchunk(smem, it, proj, ba, conv_w, a_log, dt_bias, QD, W0N, KTT, RV, TM, ATT, GL);
  for (int it = bid; it < 512; it += nblk) ph_swa(smem, it, proj, VTb, sinks, mixed);
  xcd_barrier(xb);
  for (int it = bid; it < 64; it += nblk) ph_dnscan(smem, it, QD, W0N, KTT, RV, TM, ATT, GL, obuf);
  xcd_barrier(xb);
  for (int n = bid; n < NTOK; n += nblk) ph_dn_post(n, obuf, proj, dn_norm_g, mixed);
  xcd_barrier(xb);
  for (int i = xloc; i < 32 * 8; i += xnl) ph_wout(smem, (xcd * 32 + i / 8) * 8 + i % 8, mixed, WTOUT, xin, outp);
  xcd_barrier(xb);
  for (int it = bid; it < NTOK / 4; it += nblk) ph_ln1(it, outp, ln1_g, ln1_b, x1bf);
  xcd_barrier(xb);
  for (int i = xloc; i < 32 * 2; i += xnl) ph_router(smem, (xcd * 32 + i / 2) * 2 + i % 2, x1bf, WTR, logits);
  xcd_barrier(xb);
  for (int it = bid; it < NTOK / 4; it += nblk) ph_route(it, logits, router_bias, cnt, list, gates);
  xcd_barrier(xb);
  int* sscan = (int*)(smem + SM_MISC);
  moe_build_prefix(cnt, sscan);
  const int ntile = sscan[32 * xcd + 31] - (xcd ? sscan[32 * xcd - 1] : 0) + NTOK / 128 / 8;
  for (int it = xloc; it < ntile * 4; it += xnl) {
    int e, rt; moe_locate(sscan, xcd, it >> 2, e, rt);
    ph_moe1(smem, e, rt, it & 3, x1bf, cnt, list, w_gate, w_up, sw_gate, sw_up, hbuf);
  }
  xcd_barrier(xb);
  for (int it = xloc; it < ntile * 8; it += xnl) {
    int e, rt; moe_locate(sscan, xcd, it >> 3, e, rt);
    ph_moe2(smem, e, rt, it & 7, hbuf, cnt, list, gates, w_down, sw_down, ybuf);
  }
  xcd_barrier(xb);
  for (int it = bid; it < NTOK / 4; it += nblk) ph_final(it, outp, ybuf, ln2_g, ln2_b);
}

#undef xin
#undef w_in
#undef conv_w
#undef a_log
#undef dt_bias
#undef dn_norm_g
#undef sinks
#undef w_out
#undef ln1_g
#undef ln1_b
#undef router_w
#undef router_bias
#undef w_gate
#undef w_up
#undef w_down
#undef sw_gate
#undef sw_up
#undef sw_down
#undef ln2_g
#undef ln2_b
#undef outp
#undef x1bf
#undef logits
#undef list
#undef gates
#undef cnt
#undef mixed
#undef proj
#undef ba
#undef QD
#undef W0N
#undef KTT
#undef RV
#undef TM
#undef ATT
#undef GL
#undef obuf
#undef hbuf
#undef ybuf
#undef VTb
#undef XBF
#undef WTIN
#undef WTOUT
#undef WTR
#undef barw

extern "C" void kernel_launch(void* const* d_in, const int* in_sizes, int n_in, void* d_out, int out_size, void* d_ws, size_t ws_size, hipStream_t stream) {
  static int grid_blocks = 0;
  if (!grid_blocks) {
    int dev = 0, cus = 0, per_cu = 0;
    (void)hipGetDevice(&dev);
    (void)hipDeviceGetAttribute(&cus, hipDeviceAttributeMultiprocessorCount, dev);
    (void)hipOccupancyMaxActiveBlocksPerMultiprocessor(&per_cu, mega, 256, 0);
    if (per_cu > 2) per_cu = 2;
    if (per_cu < 1) per_cu = 1;
    grid_blocks = cus * per_cu;
  }
  Params p{};
  for (int i = 0; i < 20; ++i) p.in[i] = (const float*)d_in[i];
  p.out = (float*)d_out; p.ws = (char*)d_ws;
  (void)hipMemsetAsync((char*)d_ws + WS_CTRL, 0, 4096 + XCD_BAR_WORDS * 4, stream);
  void* args[] = {&p};
  hipError_t e = hipLaunchCooperativeKernel((void*)mega, dim3(grid_blocks), dim3(256), args, 0, stream);
  if (e != hipSuccess) fprintf(stderr, "cooperative launch failed: %s (grid %d)\n", hipGetErrorString(e), grid_blocks);
}
```

```cpp
#include <hip/hip_runtime.h>
#include <hip/hip_cooperative_groups.h>
#include <stdint.h>
#include <stdio.h>
namespace cg = cooperative_groups;

typedef __attribute__((ext_vector_type(8))) short bf16x8;
typedef __attribute__((ext_vector_type(4))) float f32x4;
typedef unsigned short bf16_t;
typedef __attribute__((ext_vector_type(4))) unsigned u32x4;
typedef __attribute__((ext_vector_type(2))) unsigned u32x2;

constexpr int NTOK = 32768, SEQ = 4096, DM = 1024;
constexpr int INC = 2824, PROJW = 2816;
constexpr int OFF_DQ = 0, OFF_DK = 512, OFF_DV = 1024, OFF_SQ = 1536, OFF_SK = 2048, OFF_SV = 2176, OFF_Z = 2304;
constexpr int NEXP = 256, TOPK = 8, EFF = 256;
constexpr int NA = NTOK * TOPK;
constexpr int CAP = NTOK;
constexpr float ALPHA = 1.189207115002721f;
constexpr float LN_EPS = 1e-5f, RMS_EPS = 1e-6f, L2_EPS = 1e-6f;

constexpr size_t MiB = 1024ull * 1024ull;
constexpr size_t WS_X1BF = 0;
constexpr size_t WS_LOGIT = 64 * MiB;
constexpr size_t WS_LIST = 96 * MiB;
constexpr size_t WS_GATES = 128 * MiB;
constexpr size_t WS_CTRL = 129 * MiB;
constexpr size_t WS_MIXED = 130 * MiB;
constexpr size_t WS_PROJ = 200 * MiB;
constexpr size_t WS_BA = 376 * MiB;
constexpr size_t WS_QD = 377 * MiB;
constexpr size_t WS_W0N = 409 * MiB;
constexpr size_t WS_KTT = 441 * MiB;
constexpr size_t WS_RV = 473 * MiB;
constexpr size_t WS_TM = 505 * MiB;
constexpr size_t WS_ATT = 521 * MiB;
constexpr size_t WS_GL = 537 * MiB;
constexpr size_t WS_O = 538 * MiB;
constexpr size_t WS_VT = 602 * MiB;
constexpr size_t WS_XBF = 0;
constexpr size_t WS_WTIN = 984 * MiB;
constexpr size_t WS_WTOUT = 990 * MiB;
constexpr size_t WS_WTR = 992 * MiB;
constexpr size_t WS_HBUF = 200 * MiB;
constexpr size_t WS_YBUF = 344 * MiB;

__device__ __forceinline__ int opaque_tid() { int t = threadIdx.x; asm volatile("" : "+v"(t)); return t; }
#define TIDX opaque_tid()
typedef __attribute__((ext_vector_type(2))) __bf16 hwbf16x2;
typedef __attribute__((ext_vector_type(2))) float hwf32x2;
__device__ __forceinline__ unsigned pack2(float lo, float hi) {
  hwf32x2 f = {lo, hi};
  return __builtin_bit_cast(unsigned, __builtin_convertvector(f, hwbf16x2));
}
__device__ __forceinline__ unsigned f2bf(float f) { return pack2(f, 0.f) & 0xffffu; }
__device__ __forceinline__ float bf2f(unsigned h) { return __uint_as_float(h << 16); }
__device__ __forceinline__ float bflo(unsigned w) { return __uint_as_float(w << 16); }
__device__ __forceinline__ float bfhi(unsigned w) { return __uint_as_float(w & 0xffff0000u); }
__device__ __forceinline__ float siluf(float x) { return x / (1.f + __expf(-x)); }
__device__ __forceinline__ float sigmoidf(float x) { return 1.f / (1.f + __expf(-x)); }
__device__ __forceinline__ float wave_sum(float v) {
#pragma unroll
  for (int o = 32; o > 0; o >>= 1) v += __shfl_xor(v, o);
  return v;
}

template <int SEGDIV>
struct LdRowBF16T {
  const char* p[4]; u32x4 r[2][4]; int row0, ch; size_t seghi, seglo;
  template <class F> __device__ __forceinline__ void init(F rowptr, size_t hi, size_t lo = 0) {
    const int tid = TIDX; ch = tid & 7; row0 = tid >> 3; seghi = hi; seglo = lo;
#pragma unroll
    for (int i = 0; i < 4; ++i) p[i] = (const char*)rowptr(row0 + i * 32) + ch * 16;
  }
  template <int S> __device__ __forceinline__ void load(int seg, int kk) {
    const size_t off = (size_t)(seg / SEGDIV) * seghi + (size_t)(seg % SEGDIV) * seglo + (size_t)kk * 128;
#pragma unroll
    for (int i = 0; i < 4; ++i) r[S][i] = *(const u32x4*)(p[i] + off);
  }
  template <int S> __device__ __forceinline__ void store(unsigned char* s) {
#pragma unroll
    for (int i = 0; i < 4; ++i) {
      const int row = row0 + i * 32;
      *(u32x4*)(s + row * 128 + ((ch ^ (row & 7)) << 4)) = r[S][i];
    }
  }
};
typedef LdRowBF16T<1> LdRowBF16;
struct LdColF32 {
  const char* p; size_t ldb, segb; f32x4 r[2][8]; int n4, kg;
  __device__ __forceinline__ void init(const float* colptr, size_t ld, size_t seg_bytes) {
    const int tid = TIDX; n4 = tid & 31; kg = tid >> 5; ldb = ld * 4; segb = seg_bytes;
    p = (const char*)colptr + (size_t)(kg * 8) * ldb;
  }
  template <int S> __device__ __forceinline__ void load(int seg, int kk) {
#pragma unroll
    for (int j = 0; j < 8; ++j) r[S][j] = *(const f32x4*)(p + (size_t)seg * segb + (size_t)(kk * 64 + j) * ldb);
  }
  template <int S> __device__ __forceinline__ void store(unsigned char* s) {
#pragma unroll
    for (int i = 0; i < 4; ++i) {
      const int row = n4 * 4 + i; u32x4 w;
      w[0] = pack2(r[S][0][i], r[S][1][i]); w[1] = pack2(r[S][2][i], r[S][3][i]); w[2] = pack2(r[S][4][i], r[S][5][i]); w[3] = pack2(r[S][6][i], r[S][7][i]);
      *(u32x4*)(s + row * 128 + ((kg ^ (row & 7)) << 4)) = w;
    }
  }
};

__device__ __forceinline__ void gemm_kstep(const unsigned char* sA, const unsigned char* sB, f32x4 (&acc)[4][4], int wr, int wc, int fr, int fq) {
#pragma unroll
  for (int ks = 0; ks < 2; ++ks) {
    bf16x8 a[4], b[4];
#pragma unroll
    for (int m = 0; m < 4; ++m) {
      const int row = wr * 64 + m * 16 + fr;
      a[m] = *(const bf16x8*)(sA + row * 128 + (((ks * 4 + fq) ^ (row & 7)) << 4));
    }
#pragma unroll
    for (int n = 0; n < 4; ++n) {
      const int row = wc * 64 + n * 16 + fr;
      b[n] = *(const bf16x8*)(sB + row * 128 + (((ks * 4 + fq) ^ (row & 7)) << 4));
    }
#pragma unroll
    for (int m = 0; m < 4; ++m)
#pragma unroll
      for (int n = 0; n < 4; ++n) acc[m][n] = __builtin_amdgcn_mfma_f32_16x16x32_bf16(b[n], a[m], acc[m][n], 0, 0, 0);
  }
}
template <int KPER, class AL, class BL, class Epi>
__device__ __forceinline__ void gemm_stream(unsigned char* smem, AL& al, BL& bl, int nseg, Epi epi) {
  static_assert(KPER % 2 == 0, "segments start on even k-steps");
  const int tid = TIDX, lane = tid & 63, wid = tid >> 6, wr = wid >> 1, wc = wid & 1, fr = lane & 15, fq = lane >> 4;
  const int total = nseg * KPER;
  unsigned char* buf0 = smem; unsigned char* buf1 = smem + 32768;
  f32x4 acc[4][4];
  al.template load<0>(0, 0); bl.template load<0>(0, 0);
  al.template load<1>(0, 1); bl.template load<1>(0, 1);
  al.template store<0>(buf0); bl.template store<0>(buf0 + 16384);
  if (total > 2) { al.template load<0>(2 / KPER, 2 % KPER); bl.template load<0>(2 / KPER, 2 % KPER); }
  __syncthreads();
  for (int j = 0; j < total; j += 2) {
    if (j % KPER == 0) {
#pragma unroll
      for (int m = 0; m < 4; ++m)
#pragma unroll
        for (int n = 0; n < 4; ++n) acc[m][n] = (f32x4){0.f, 0.f, 0.f, 0.f};
    }
    { al.template store<1>(buf1); bl.template store<1>(buf1 + 16384); }
    if (j + 3 < total) { al.template load<1>((j + 3) / KPER, (j + 3) % KPER); bl.template load<1>((j + 3) / KPER, (j + 3) % KPER); }
    gemm_kstep(buf0, buf0 + 16384, acc, wr, wc, fr, fq);
    __syncthreads();
    if (j + 2 < total) { al.template store<0>(buf0); bl.template store<0>(buf0 + 16384); }
    if (j + 4 < total) { al.template load<0>((j + 4) / KPER, (j + 4) % KPER); bl.template load<0>((j + 4) / KPER, (j + 4) % KPER); }
    gemm_kstep(buf1, buf1 + 16384, acc, wr, wc, fr, fq);
    __syncthreads();
    if ((j + 2) % KPER == 0) epi((j + 2) / KPER - 1, acc);
  }
}

#define GEMM_IDS const int tid = TIDX, lane = tid & 63, wid = tid >> 6, wr = wid >> 1, wc = wid & 1, fr = lane & 15, fq = lane >> 4; (void)tid; (void)lane;

struct Params {
  const float* in[20];
  float* out;
  char* ws;
};

constexpr int SMEM_BYTES = 69632;
constexpr int SM_MISC = 65536;

__device__ __forceinline__ void ph_cvt_x(int item, const float* __restrict__ x, bf16_t* __restrict__ xbf) {
  const int tid = TIDX;
  const size_t base = (size_t)item * 4096 + (size_t)tid * 4;
#pragma unroll
  for (int i = 0; i < 4; ++i) {
    const f32x4 v = *(const f32x4*)(x + base + (size_t)i * 1024);
    u32x2 w; w[0] = pack2(v[0], v[1]); w[1] = pack2(v[2], v[3]);
    *(u32x2*)(xbf + base + (size_t)i * 1024) = w;
  }
}
__device__ __forceinline__ void ph_cvt_wt(unsigned char* smem, int kt, int nt, const float* __restrict__ W, int K, int N, bf16_t* __restrict__ WT) {
  float* tile = (float*)smem;
  const int tid = TIDX;
  const int k0 = kt * 64, n0 = nt * 64;
  __syncthreads();
#pragma unroll
  for (int i = 0; i < 4; ++i) {
    const int k = (tid >> 4) + 16 * i, n = 4 * (tid & 15);
    f32x4 v = (f32x4){0.f, 0.f, 0.f, 0.f};
    if (n0 + n < N) v = *(const f32x4*)(W + (size_t)(k0 + k) * N + n0 + n);
    tile[k * 65 + n + 0] = v[0]; tile[k * 65 + n + 1] = v[1]; tile[k * 65 + n + 2] = v[2]; tile[k * 65 + n + 3] = v[3];
  }
  __syncthreads();
  const int n = tid >> 2, kq = tid & 3;
  u32x4 w0, w1;
#pragma unroll
  for (int j = 0; j < 4; ++j) {
    w0[j] = pack2(tile[(kq * 16 + 2 * j) * 65 + n], tile[(kq * 16 + 2 * j + 1) * 65 + n]);
    w1[j] = pack2(tile[(kq * 16 + 8 + 2 * j) * 65 + n], tile[(kq * 16 + 8 + 2 * j + 1) * 65 + n]);
  }
  bf16_t* dst = WT + (size_t)(n0 + n) * K + k0 + kq * 16;
  *(u32x4*)dst = w0; *(u32x4*)(dst + 8) = w1;
}

__device__ __forceinline__ void ph_proj(unsigned char* smem, int xcd, int l, const bf16_t* __restrict__ xbf, const bf16_t* __restrict__ wt, bf16_t* __restrict__ proj, float* __restrict__ ba, bf16_t* __restrict__ vt) {
  const int mi = l >> 3, ni = l & 7;
  LdRowBF16T<3> al; al.init([&](int r) { return xbf + (size_t)((xcd * 32 + mi) * 128 + r) * DM; }, (size_t)8 * 128 * DM * 2, 0);
  LdRowBF16T<3> bl; bl.init([&](int r) { return wt + (size_t)(ni * 128 + r) * DM; }, 0, (size_t)8 * 128 * DM * 2);
  gemm_stream<16>(smem, al, bl, 12, [&](int seg, f32x4 (&acc)[4][4]) {
    GEMM_IDS
    const int nt = (seg % 3) * 8 + ni;
    if (nt < 23) {
      const int m0 = (xcd * 32 + (seg / 3) * 8 + mi) * 128, n0 = nt * 128;
#pragma unroll
      for (int m = 0; m < 4; ++m)
#pragma unroll
        for (int n = 0; n < 4; ++n) {
          const int row = m0 + wr * 64 + m * 16 + fr, col = n0 + wc * 64 + n * 16 + fq * 4;
          if (col < PROJW) {
            u32x2 w; w[0] = pack2(acc[m][n][0], acc[m][n][1]); w[1] = pack2(acc[m][n][2], acc[m][n][3]);
            *(u32x2*)(proj + (size_t)row * PROJW + col) = w;
          } else if (col < INC) {
            *(f32x4*)(ba + (size_t)row * 8 + (col - PROJW)) = acc[m][n];
          }
        }
      if (n0 == OFF_SV) {
#pragma unroll
        for (int m = 0; m < 4; ++m)
#pragma unroll
          for (int n = 0; n < 4; ++n) {
            const int row = m0 + wr * 64 + m * 16 + fr, c = wc * 64 + n * 16 + fq * 4;
            const int bb = row / SEQ, t = row % SEQ;
#pragma unroll
            for (int r = 0; r < 4; ++r) vt[((size_t)(bb * 128 + c + r)) * SEQ + t] = (bf16_t)f2bf(acc[m][n][r]);
          }
      }
    }
  });
}

__device__ __forceinline__ bf16x8 pack8(f32x4 a, f32x4 b) {
  union { bf16x8 v; unsigned u[4]; } x;
  x.u[0] = pack2(a[0], a[1]); x.u[1] = pack2(a[2], a[3]); x.u[2] = pack2(b[0], b[1]); x.u[3] = pack2(b[2], b[3]);
  return x.v;
}
__device__ __forceinline__ void ph_dnchunk(unsigned char* smem, int item, const bf16_t* __restrict__ proj, const float* __restrict__ ba, const float* __restrict__ conv_w,
                                           const float* __restrict__ a_log, const float* __restrict__ dt_bias,
                                           bf16_t* __restrict__ QD, bf16_t* __restrict__ W0N, bf16_t* __restrict__ KTT, bf16_t* __restrict__ RV,
                                           bf16_t* __restrict__ TM, bf16_t* __restrict__ ATT, float* __restrict__ GL) {
  const int tid = TIDX, lane = tid & 63, w = tid >> 6, fr = lane & 15, fq = lane >> 4;
  const int n = item & 63, h = (item >> 6) & 3, b = item >> 8;
  const int t0 = n * 64; const size_t row0 = (size_t)b * SEQ + t0;
  unsigned char* qs = smem; unsigned char* ks = smem + 16384; float* AT = (float*)(smem + 32768);
  const float scale = 0.08838834764831845f;
  float bL, gcL;
  {
    const float* bap = ba + (row0 + lane) * 8;
    bL = sigmoidf(bap[h]);
    const float xx = bap[4 + h] + dt_bias[h];
    const float sp = fmaxf(xx, 0.f) + log1pf(__expf(-fabsf(xx)));
    float gg = -__expf(a_log[h]) * sp;
#pragma unroll
    for (int o = 1; o < 64; o <<= 1) { const float v = __shfl_up(gg, o); if (lane >= o) gg += v; }
    gcL = gg;
  }
  {
    const int d = 2 * lane;
    float cw[3][4][2];
#pragma unroll
    for (int mx = 0; mx < 3; ++mx)
#pragma unroll
      for (int j = 0; j < 4; ++j) {
        const float2 c2 = *(const float2*)(conv_w + j * 1536 + mx * 512 + h * 128 + d);
        cw[mx][j][0] = c2.x; cw[mx][j][1] = c2.y;
      }
    const bf16_t* pbase = proj + (row0 + 16 * w) * PROJW + h * 128 + d;
    unsigned raw[3][19];
#pragma unroll
    for (int j = 0; j < 19; ++j) {
      const bool ok = (t0 + 16 * w - 3 + j) >= 0;
#pragma unroll
      for (int mx = 0; mx < 3; ++mx) {
        unsigned u = 0;
        if (ok) u = *(const unsigned*)(pbase + (ptrdiff_t)(j - 3) * PROJW + mx * 512);
        raw[mx][j] = u;
      }
    }
#pragma unroll
    for (int i = 0; i < 16; ++i) {
      float s[3][2];
#pragma unroll
      for (int mx = 0; mx < 3; ++mx) {
        float y0 = 0.f, y1 = 0.f;
#pragma unroll
        for (int j = 0; j < 4; ++j) { y0 += cw[mx][j][0] * bflo(raw[mx][i + j]); y1 += cw[mx][j][1] * bfhi(raw[mx][i + j]); }
        s[mx][0] = siluf(y0); s[mx][1] = siluf(y1);
      }
      const int row = 16 * w + i;
      const float rq = rsqrtf(wave_sum(s[0][0] * s[0][0] + s[0][1] * s[0][1]) + L2_EPS);
      const float rk = rsqrtf(wave_sum(s[1][0] * s[1][0] + s[1][1] * s[1][1]) + L2_EPS);
      const int off = row * 256 + ((((lane >> 2) ^ (row & 15))) << 4) + (lane & 3) * 4;
      *(unsigned*)(qs + off) = pack2(s[0][0] * rq, s[0][1] * rq);
      *(unsigned*)(ks + off) = pack2(s[1][0] * rk, s[1][1] * rk);
      const float bi = __shfl(bL, row);
      *(unsigned*)(RV + ((size_t)item * 64 + row) * 128 + d) = pack2(bi * s[2][0], bi * s[2][1]);
    }
  }
  __syncthreads();
  {
    f32x4 aKK[4], aQK[4];
#pragma unroll
    for (int nt = 0; nt < 4; ++nt) { aKK[nt] = (f32x4){0.f, 0.f, 0.f, 0.f}; aQK[nt] = (f32x4){0.f, 0.f, 0.f, 0.f}; }
#pragma unroll
    for (int k4 = 0; k4 < 4; ++k4) {
      const int arow = 16 * w + fr;
      const bf16x8 aq = *(const bf16x8*)(qs + arow * 256 + ((((k4 * 4 + fq) ^ (arow & 15))) << 4));
      const bf16x8 ak = *(const bf16x8*)(ks + arow * 256 + ((((k4 * 4 + fq) ^ (arow & 15))) << 4));
#pragma unroll
      for (int nt = 0; nt < 4; ++nt) {
        const int brow = 16 * nt + fr;
        const bf16x8 bk = *(const bf16x8*)(ks + brow * 256 + ((((k4 * 4 + fq) ^ (brow & 15))) << 4));
        aKK[nt] = __builtin_amdgcn_mfma_f32_16x16x32_bf16(ak, bk, aKK[nt], 0, 0, 0);
        aQK[nt] = __builtin_amdgcn_mfma_f32_16x16x32_bf16(aq, bk, aQK[nt], 0, 0, 0);
      }
    }
    float gci[4], bi[4];
#pragma unroll
    for (int r = 0; r < 4; ++r) { gci[r] = __shfl(gcL, 16 * w + 4 * fq + r); bi[r] = __shfl(bL, 16 * w + 4 * fq + r); }
#pragma unroll
    for (int nt = 0; nt < 4; ++nt) {
      const int j = 16 * nt + fr;
      const float gcj = __shfl(gcL, j);
      const int p = 32 * (nt >> 1) + 8 * (fr >> 2) + 4 * (nt & 1) + (fr & 3);
      float av[4];
#pragma unroll
      for (int r = 0; r < 4; ++r) {
        const int i = 16 * w + 4 * fq + r;
        const float dec = (j <= i) ? __expf(gci[r] - gcj) : 0.f;
        av[r] = (j < i) ? bi[r] * aKK[nt][r] * dec : 0.f;
        ATT[((size_t)item * 64 + i) * 64 + p] = (bf16_t)f2bf(aQK[nt][r] * scale * dec);
      }
      *(float4*)(AT + j * 68 + 16 * w + 4 * fq) = make_float4(av[0], av[1], av[2], av[3]);
    }
  }
  __syncthreads();
  if (w == 0) {
    float Tr[64];
    int ln = lane; asm volatile("" : "+v"(ln));
#pragma unroll
    for (int j = 0; j < 64; ++j) Tr[j] = 0.f;
    f32x4 cur[16], nxt[16];
#pragma unroll
    for (int j4 = 0; j4 < 16; ++j4) nxt[j4] = (f32x4){0.f, 0.f, 0.f, 0.f};
#pragma unroll
    for (int j4 = 15; j4 >= 16; --j4) cur[j4] = *(const f32x4*)(AT + 63 * 68 + j4 * 4);
#pragma unroll
    for (int c = 63; c >= 0; --c) {
      if (c > 0) {
#pragma unroll
        for (int j4 = 15; j4 >= c / 4; --j4) nxt[j4] = *(const f32x4*)(AT + (c - 1) * 68 + j4 * 4);
      }
      float a0 = 0.f, a1 = 0.f, a2 = 0.f, a3 = 0.f;
#pragma unroll
      for (int j4 = 15; j4 >= (c + 1) / 4; --j4) {
        asm volatile("v_fmac_f32 %0, %1, %2" : "+v"(a0) : "v"(Tr[4 * j4 + 0]), "v"(cur[j4][0]));
        asm volatile("v_fmac_f32 %0, %1, %2" : "+v"(a1) : "v"(Tr[4 * j4 + 1]), "v"(cur[j4][1]));
        asm volatile("v_fmac_f32 %0, %1, %2" : "+v"(a2) : "v"(Tr[4 * j4 + 2]), "v"(cur[j4][2]));
        asm volatile("v_fmac_f32 %0, %1, %2" : "+v"(a3) : "v"(Tr[4 * j4 + 3]), "v"(cur[j4][3]));
      }
      Tr[c] = ((ln == c) ? 1.f : 0.f) - ((a0 + a1) + (a2 + a3));
#pragma unroll
      for (int j4 = 0; j4 < 16; ++j4) cur[j4] = nxt[j4];
    }
    u32x4* tp = (u32x4*)(TM + ((size_t)item * 64 + lane) * 64);
#pragma unroll
    for (int oc = 0; oc < 8; ++oc) {
      const int k0 = 32 * (oc >> 2) + 4 * (oc & 3);
      u32x4 v;
      v[0] = pack2(Tr[k0 + 0], Tr[k0 + 1]); v[1] = pack2(Tr[k0 + 2], Tr[k0 + 3]);
      v[2] = pack2(Tr[k0 + 16], Tr[k0 + 17]); v[3] = pack2(Tr[k0 + 18], Tr[k0 + 19]);
      tp[oc] = v;
    }
  } else {
    const float gclast = __shfl(gcL, 63);
    if (tid == 64) GL[item] = __expf(gclast);
#pragma unroll 1
    for (int it = 0; it < 16; ++it) {
      const int idx = (tid - 64) + it * 192;
      const int mtx = idx >> 10, rem = idx & 1023;
      if (mtx < 2) {
        const int i = rem >> 4, oc = rem & 15;
        const float gi = __shfl(gcL, i), bi = __shfl(bL, i);
        const float f = (mtx == 0) ? scale * __expf(gi) : -bi * __expf(gi);
        const unsigned char* st = (mtx == 0) ? qs : ks;
        const int d0 = 32 * (oc >> 2) + 4 * (oc & 3);
        const uint2 lo = *(const uint2*)(st + i * 256 + ((((d0 >> 3) ^ (i & 15))) << 4) + (d0 & 7) * 2);
        const uint2 hi = *(const uint2*)(st + i * 256 + (((((d0 + 16) >> 3) ^ (i & 15))) << 4) + (d0 & 7) * 2);
        u32x4 v;
        v[0] = pack2(bflo(lo.x) * f, bfhi(lo.x) * f); v[1] = pack2(bflo(lo.y) * f, bfhi(lo.y) * f);
        v[2] = pack2(bflo(hi.x) * f, bfhi(hi.x) * f); v[3] = pack2(bflo(hi.y) * f, bfhi(hi.y) * f);
        bf16_t* dst = ((mtx == 0) ? QD : W0N) + ((size_t)item * 64 + i) * 128 + 8 * oc;
        *(u32x4*)dst = v;
      } else {
        const int d = rem & 127, oc = rem >> 7;
        const int j0 = 32 * (oc >> 2) + 4 * (oc & 3);
        float val[8];
#pragma unroll
        for (int e = 0; e < 8; ++e) {
          const int j = j0 + (e & 3) + ((e >> 2) << 4);
          const float f = __expf(gclast - __shfl(gcL, j));
          const unsigned short raw = *(const unsigned short*)(ks + j * 256 + ((((d >> 3) ^ (j & 15))) << 4) + (d & 7) * 2);
          val[e] = bf2f(raw) * f;
        }
        u32x4 v;
        v[0] = pack2(val[0], val[1]); v[1] = pack2(val[2], val[3]); v[2] = pack2(val[4], val[5]); v[3] = pack2(val[6], val[7]);
        *(u32x4*)(KTT + ((size_t)item * 128 + d) * 64 + 8 * oc) = v;
      }
    }
  }
  __syncthreads();
}

__device__ __forceinline__ void ph_dnscan(unsigned char* smem, int item, const bf16_t* __restrict__ QDp, const bf16_t* __restrict__ W0Np, const bf16_t* __restrict__ KTTp,
                                          const bf16_t* __restrict__ RVp, const bf16_t* __restrict__ TMp, const bf16_t* __restrict__ ATTp, const float* __restrict__ GLp,
                                          float* __restrict__ op) {
  const int tid = TIDX, lane = tid & 63, w = tid >> 6, fr = lane & 15, fq = lane >> 4;
  const int bh = item >> 1, half = item & 1, b = bh >> 2, h = bh & 3;
  const int vcol0 = (half * 4 + w) * 16;
  unsigned char* sW0 = smem; unsigned char* sQD = smem + 16384; unsigned char* sKT = smem + 32768; unsigned char* sT = smem + 49152; unsigned char* sAT = smem + 57344;
  f32x4 S[8];
#pragma unroll
  for (int t = 0; t < 8; ++t) S[t] = (f32x4){0.f, 0.f, 0.f, 0.f};
  u32x4 pfA[8], pfB[8]; unsigned short rvp[16];
#define DN_LOAD_A(nn_) do { \
    const size_t ci = (size_t)bh * 64 + (nn_); \
    _Pragma("unroll") for (int i = 0; i < 4; ++i) pfA[i] = *(const u32x4*)((const char*)W0Np + ci * 16384 + (size_t)(tid + 256 * i) * 16); \
    _Pragma("unroll") for (int i = 0; i < 4; ++i) pfA[4 + i] = *(const u32x4*)((const char*)QDp + ci * 16384 + (size_t)(tid + 256 * i) * 16); \
    _Pragma("unroll") for (int mt = 0; mt < 4; ++mt) \
      _Pragma("unroll") for (int r = 0; r < 4; ++r) rvp[mt * 4 + r] = RVp[(ci * 64 + 16 * mt + 4 * fq + r) * 128 + vcol0 + fr]; \
  } while (0)
#define DN_STORE_A() do { \
    _Pragma("unroll") for (int i = 0; i < 4; ++i) { const int q = tid + 256 * i, row = q >> 4, ch = q & 15; *(u32x4*)(sW0 + row * 256 + ((ch ^ (row & 15)) << 4)) = pfA[i]; } \
    _Pragma("unroll") for (int i = 0; i < 4; ++i) { const int q = tid + 256 * i, row = q >> 4, ch = q & 15; *(u32x4*)(sQD + row * 256 + ((ch ^ (row & 15)) << 4)) = pfA[4 + i]; } \
  } while (0)
#define DN_LOAD_B(nn_) do { \
    const size_t ci = (size_t)bh * 64 + (nn_); \
    _Pragma("unroll") for (int i = 0; i < 4; ++i) pfB[i] = *(const u32x4*)((const char*)KTTp + ci * 16384 + (size_t)(tid + 256 * i) * 16); \
    _Pragma("unroll") for (int i = 0; i < 2; ++i) pfB[4 + i] = *(const u32x4*)((const char*)TMp + ci * 8192 + (size_t)(tid + 256 * i) * 16); \
    _Pragma("unroll") for (int i = 0; i < 2; ++i) pfB[6 + i] = *(const u32x4*)((const char*)ATTp + ci * 8192 + (size_t)(tid + 256 * i) * 16); \
  } while (0)
#define DN_STORE_B() do { \
    _Pragma("unroll") for (int i = 0; i < 4; ++i) { const int q = tid + 256 * i, row = q >> 3, ch = q & 7; *(u32x4*)(sKT + row * 128 + ((ch ^ (row & 7)) << 4)) = pfB[i]; } \
    _Pragma("unroll") for (int i = 0; i < 2; ++i) { const int q = tid + 256 * i, row = q >> 3, ch = q & 7; *(u32x4*)(sT + row * 128 + ((ch ^ (row & 7)) << 4)) = pfB[4 + i]; } \
    _Pragma("unroll") for (int i = 0; i < 2; ++i) { const int q = tid + 256 * i, row = q >> 3, ch = q & 7; *(u32x4*)(sAT + row * 128 + ((ch ^ (row & 7)) << 4)) = pfB[6 + i]; } \
  } while (0)
#define DN_ZINIT() do { _Pragma("unroll") for (int mt = 0; mt < 4; ++mt) Z[mt] = (f32x4){bf2f(rvp[mt * 4 + 0]), bf2f(rvp[mt * 4 + 1]), bf2f(rvp[mt * 4 + 2]), bf2f(rvp[mt * 4 + 3])}; } while (0)
  __syncthreads();
  f32x4 Z[4];
  DN_LOAD_A(0);
  DN_LOAD_B(0);
  DN_STORE_A();
  DN_ZINIT();
  DN_LOAD_A(1);
  for (int nn = 0; nn < 64; ++nn) {
    const float gl = GLp[(size_t)bh * 64 + nn];
    __syncthreads();
    bf16x8 Sb[4];
#pragma unroll
    for (int k4 = 0; k4 < 4; ++k4) Sb[k4] = pack8(S[2 * k4], S[2 * k4 + 1]);
    f32x4 O[4];
#pragma unroll
    for (int mt = 0; mt < 4; ++mt) {
      O[mt] = (f32x4){0.f, 0.f, 0.f, 0.f};
      const int row = 16 * mt + fr;
#pragma unroll
      for (int k4 = 0; k4 < 4; ++k4) {
        const int off = row * 256 + ((((k4 * 4 + fq) ^ fr)) << 4);
        const bf16x8 aw = *(const bf16x8*)(sW0 + off);
        const bf16x8 aq = *(const bf16x8*)(sQD + off);
        Z[mt] = __builtin_amdgcn_mfma_f32_16x16x32_bf16(aw, Sb[k4], Z[mt], 0, 0, 0);
        O[mt] = __builtin_amdgcn_mfma_f32_16x16x32_bf16(aq, Sb[k4], O[mt], 0, 0, 0);
      }
    }
    bf16x8 Zb[2];
    Zb[0] = pack8(Z[0], Z[1]); Zb[1] = pack8(Z[2], Z[3]);
    DN_STORE_B();
    if (nn + 1 < 64) DN_LOAD_B(nn + 1);
    __syncthreads();
    f32x4 Vn[4];
#pragma unroll
    for (int mt = 0; mt < 4; ++mt) {
      Vn[mt] = (f32x4){0.f, 0.f, 0.f, 0.f};
      const int row = 16 * mt + fr;
#pragma unroll
      for (int s = 0; s < 2; ++s) {
        if (s <= (mt >> 1)) {
          const bf16x8 at = *(const bf16x8*)(sT + row * 128 + ((((s * 4 + fq) ^ (row & 7))) << 4));
          Vn[mt] = __builtin_amdgcn_mfma_f32_16x16x32_bf16(at, Zb[s], Vn[mt], 0, 0, 0);
        }
      }
    }
    bf16x8 Vb[2];
    Vb[0] = pack8(Vn[0], Vn[1]); Vb[1] = pack8(Vn[2], Vn[3]);
#pragma unroll
    for (int mt = 0; mt < 4; ++mt) {
      const int row = 16 * mt + fr;
#pragma unroll
      for (int s = 0; s < 2; ++s) {
        if (s <= (mt >> 1)) {
          const bf16x8 aa = *(const bf16x8*)(sAT + row * 128 + ((((s * 4 + fq) ^ (row & 7))) << 4));
          O[mt] = __builtin_amdgcn_mfma_f32_16x16x32_bf16(aa, Vb[s], O[mt], 0, 0, 0);
        }
      }
      const size_t tok = (size_t)b * SEQ + nn * 64 + 16 * mt + 4 * fq;
#pragma unroll
      for (int r = 0; r < 4; ++r) op[(tok + r) * 512 + h * 128 + vcol0 + fr] = O[mt][r];
    }
#pragma unroll
    for (int t = 0; t < 8; ++t) {
      S[t] = S[t] * gl;
      const int row = 16 * t + fr;
#pragma unroll
      for (int s = 0; s < 2; ++s) {
        const bf16x8 ak = *(const bf16x8*)(sKT + row * 128 + ((((s * 4 + fq) ^ (row & 7))) << 4));
        S[t] = __builtin_amdgcn_mfma_f32_16x16x32_bf16(ak, Vb[s], S[t], 0, 0, 0);
      }
    }
    if (nn + 1 < 64) {
      DN_STORE_A();
      DN_ZINIT();
      if (nn + 2 < 64) DN_LOAD_A(nn + 2);
    }
  }
  __syncthreads();
#undef DN_ZINIT
#undef DN_LOAD_A
#undef DN_STORE_A
#undef DN_LOAD_B
#undef DN_STORE_B
}

__device__ __forceinline__ void ph_dn_post(int item, const float* __restrict__ o, const bf16_t* __restrict__ proj, const float* __restrict__ dn_norm_g, bf16_t* __restrict__ mixed) {
  const int tid = TIDX, h = tid >> 6, lane = tid & 63;
  const float2 g2 = *(const float2*)(dn_norm_g + 2 * lane);
  float2 ov[4]; unsigned zv[4];
#pragma unroll
  for (int i = 0; i < 4; ++i) {
    const size_t n = (size_t)item * 4 + i;
    ov[i] = *(const float2*)(o + n * 512 + h * 128 + 2 * lane);
    zv[i] = *(const unsigned*)(proj + n * PROJW + OFF_Z + h * 128 + 2 * lane);
  }
#pragma unroll
  for (int i = 0; i < 4; ++i) {
    const size_t n = (size_t)item * 4 + i;
    const float ss = wave_sum(ov[i].x * ov[i].x + ov[i].y * ov[i].y);
    const float rn = rsqrtf(ss * (1.f / 128.f) + RMS_EPS);
    *(unsigned*)(mixed + n * DM + h * 128 + 2 * lane) = pack2(ov[i].x * rn * g2.x * siluf(bflo(zv[i])), ov[i].y * rn * g2.y * siluf(bfhi(zv[i])));
  }
}

__device__ __forceinline__ void ph_swa(unsigned char* smem, int item, const bf16_t* __restrict__ proj, const bf16_t* __restrict__ vt, const float* __restrict__ sinks, bf16_t* __restrict__ mixed) {
  const int tid = TIDX, lane = tid & 63, w = tid >> 6, fr = lane & 15, fq = lane >> 4;
  const int qb = item & 31, kvh = (item >> 5) & 1, b = item >> 6;
  const int t0 = qb * 128;
  const size_t rowb = (size_t)b * SEQ;
  unsigned char* sK = smem;
  unsigned char* sV = smem + 32768;
  __syncthreads();
#pragma unroll
  for (int i = 0; i < 8; ++i) {
    const int q = tid + 256 * i, row = q >> 3, ch = q & 7;
    const int pos = t0 - 128 + row;
    u32x4 v = (u32x4){0u, 0u, 0u, 0u};
    if (pos >= 0) v = *(const u32x4*)(proj + (rowb + pos) * PROJW + OFF_SK + kvh * 64 + ch * 8);
    *(u32x4*)(sK + row * 128 + ((ch ^ (row & 7)) << 4)) = v;
  }
#pragma unroll
  for (int i = 0; i < 8; ++i) {
    const int q = tid + 256 * i, row = q >> 5, ch = q & 31;
    const int pos = t0 - 128 + ch * 8;
    u32x4 v = (u32x4){0u, 0u, 0u, 0u};
    if (pos >= 0) v = *(const u32x4*)(vt + ((size_t)(b * 128 + kvh * 64 + row)) * SEQ + pos);
    *(u32x4*)(sV + row * 512 + ((ch ^ (row & 15)) << 4)) = v;
  }
  __syncthreads();
  const int head = kvh * 4 + w;
  const float slope = exp2f(-(float)(head + 1));
  const float sink = sinks[head];
  const bf16_t* qp0 = proj + (rowb + t0 + fr) * PROJW + OFF_SQ + head * 64 + fq * 8;
  bf16x8 qn0 = *(const bf16x8*)(qp0), qn1 = *(const bf16x8*)(qp0 + 32);
#pragma unroll 1
  for (int qt = 0; qt < 8; ++qt) {
    const bf16x8 qf0 = qn0, qf1 = qn1;
    if (qt < 7) { const bf16_t* qp = qp0 + (size_t)(qt + 1) * 16 * PROJW; qn0 = *(const bf16x8*)(qp); qn1 = *(const bf16x8*)(qp + 32); }
    const int kp0 = qt >> 1;
    f32x4 st[10];
#pragma unroll
    for (int kt = 0; kt < 10; ++kt) {
      const int krow = (2 * kp0 + kt) * 16 + fr;
      st[kt] = (f32x4){0.f, 0.f, 0.f, 0.f};
      const bf16x8 k0 = *(const bf16x8*)(sK + krow * 128 + (((0 + fq) ^ (krow & 7)) << 4));
      const bf16x8 k1 = *(const bf16x8*)(sK + krow * 128 + (((4 + fq) ^ (krow & 7)) << 4));
      st[kt] = __builtin_amdgcn_mfma_f32_16x16x32_bf16(k0, qf0, st[kt], 0, 0, 0);
      st[kt] = __builtin_amdgcn_mfma_f32_16x16x32_bf16(k1, qf1, st[kt], 0, 0, 0);
    }
    const int i = qt * 16 + fr;
    float mx = sink;
#pragma unroll
    for (int kt = 0; kt < 10; ++kt)
#pragma unroll
      for (int r = 0; r < 4; ++r) {
        const int jb = (2 * kp0 + kt) * 16 + 4 * fq + r;
        const int dist = 128 + i - jb;
        const bool ok = (dist >= 0) && (dist < 128) && (t0 - 128 + jb >= 0);
        const float s = ok ? (st[kt][r] * 0.125f - slope * (float)dist) : -INFINITY;
        st[kt][r] = s;
        mx = fmaxf(mx, s);
      }
    mx = fmaxf(mx, __shfl_xor(mx, 16));
    mx = fmaxf(mx, __shfl_xor(mx, 32));
    float sum = 0.f;
#pragma unroll
    for (int kt = 0; kt < 10; ++kt)
#pragma unroll
      for (int r = 0; r < 4; ++r) { const float p = __expf(st[kt][r] - mx); st[kt][r] = p; sum += p; }
    sum += __shfl_xor(sum, 16);
    sum += __shfl_xor(sum, 32);
    const float inv = 1.f / (sum + __expf(sink - mx));
    f32x4 O[4];
#pragma unroll
    for (int nt = 0; nt < 4; ++nt) O[nt] = (f32x4){0.f, 0.f, 0.f, 0.f};
#pragma unroll
    for (int s5 = 0; s5 < 5; ++s5) {
      const bf16x8 pa = pack8(st[2 * s5] * inv, st[2 * s5 + 1] * inv);
      const int key0 = (2 * kp0 + 2 * s5) * 16 + 4 * fq;
#pragma unroll
      for (int nt = 0; nt < 4; ++nt) {
        const int drow = nt * 16 + fr;
        const int c0 = key0 >> 3, c1 = (key0 + 16) >> 3;
        const u32x2 lo = *(const u32x2*)(sV + drow * 512 + ((c0 ^ (drow & 15)) << 4) + ((key0 >> 2) & 1) * 8);
        const u32x2 hi = *(const u32x2*)(sV + drow * 512 + ((c1 ^ (drow & 15)) << 4) + ((key0 >> 2) & 1) * 8);
        const u32x4 vb = (u32x4){lo[0], lo[1], hi[0], hi[1]};
        O[nt] = __builtin_amdgcn_mfma_f32_16x16x32_bf16(pa, __builtin_bit_cast(bf16x8, vb), O[nt], 0, 0, 0);
      }
    }
#pragma unroll
    for (int nt = 0; nt < 4; ++nt)
#pragma unroll
      for (int r = 0; r < 4; ++r)
        mixed[(rowb + t0 + qt * 16 + 4 * fq + r) * DM + 512 + head * 64 + nt * 16 + fr] = (bf16_t)f2bf(O[nt][r]);
  }
}

__device__ __forceinline__ void ph_wout(unsigned char* smem, int xcd, int l, const bf16_t* __restrict__ mixed, const bf16_t* __restrict__ wt, const float* __restrict__ x, float* __restrict__ y1) {
  const int mi = l >> 3, ni = l & 7;
  LdRowBF16 al; al.init([&](int r) { return mixed + (size_t)((xcd * 32 + mi) * 128 + r) * DM; }, (size_t)8 * 128 * DM * 2);
  LdRowBF16 bl; bl.init([&](int r) { return wt + (size_t)(ni * 128 + r) * DM; }, 0);
  gemm_stream<16>(smem, al, bl, 4, [&](int seg, f32x4 (&acc)[4][4]) {
    GEMM_IDS
    const int m0 = (xcd * 32 + seg * 8 + mi) * 128, n0 = ni * 128;
#pragma unroll
    for (int m = 0; m < 4; ++m)
#pragma unroll
      for (int n = 0; n < 4; ++n) {
        const size_t idx = (size_t)(m0 + wr * 64 + m * 16 + fr) * DM + n0 + wc * 64 + n * 16 + fq * 4;
        const f32x4 xv = *(const f32x4*)(x + idx);
        *(f32x4*)(y1 + idx) = xv * ALPHA + acc[m][n];
      }
  });
}

__device__ __forceinline__ void ph_ln1(int item, float* __restrict__ y, const float* __restrict__ gam, const float* __restrict__ bet, bf16_t* __restrict__ xbf) {
  const int row = item * 4 + (TIDX >> 6), lane = TIDX & 63;
  float4* p = (float4*)(y + (size_t)row * DM);
  float4 v[4]; float s = 0.f;
#pragma unroll
  for (int i = 0; i < 4; ++i) { v[i] = p[lane + i * 64]; s += v[i].x + v[i].y + v[i].z + v[i].w; }
  const float mu = wave_sum(s) * (1.f / DM);
  float q = 0.f;
#pragma unroll
  for (int i = 0; i < 4; ++i) { const float a = v[i].x - mu, b = v[i].y - mu, c = v[i].z - mu, d = v[i].w - mu; q += a * a + b * b + c * c + d * d; }
  const float rs = rsqrtf(wave_sum(q) * (1.f / DM) + LN_EPS);
#pragma unroll
  for (int i = 0; i < 4; ++i) {
    const float4 gg = ((const float4*)gam)[lane + i * 64], bb = ((const float4*)bet)[lane + i * 64];
    float4 r;
    r.x = (v[i].x - mu) * rs * gg.x + bb.x; r.y = (v[i].y - mu) * rs * gg.y + bb.y;
    r.z = (v[i].z - mu) * rs * gg.z + bb.z; r.w = (v[i].w - mu) * rs * gg.w + bb.w;
    p[lane + i * 64] = r;
    u32x2 w; w[0] = pack2(r.x, r.y); w[1] = pack2(r.z, r.w);
    ((u32x2*)(xbf + (size_t)row * DM))[lane + i * 64] = w;
  }
}

__device__ __forceinline__ void ph_router(unsigned char* smem, int tile, const bf16_t* __restrict__ xbf, const bf16_t* __restrict__ wt, float* __restrict__ logits) {
  GEMM_IDS
  const int n0 = (tile & 1) * 128, m0 = (tile >> 1) * 128;
  LdRowBF16 al; al.init([&](int r) { return xbf + (size_t)(m0 + r) * DM; }, 0);
  LdRowBF16 bl; bl.init([&](int r) { return wt + (size_t)(n0 + r) * DM; }, 0);
  gemm_stream<16>(smem, al, bl, 1, [&](int seg, f32x4 (&acc)[4][4]) {
    GEMM_IDS
#pragma unroll
    for (int m = 0; m < 4; ++m)
#pragma unroll
      for (int n = 0; n < 4; ++n)
        *(f32x4*)(logits + (size_t)(m0 + wr * 64 + m * 16 + fr) * NEXP + n0 + wc * 64 + n * 16 + fq * 4) = acc[m][n];
  });
}

__device__ __forceinline__ void ph_route(int item, const float* __restrict__ logits, const float* __restrict__ router_bias, int* __restrict__ cnt, int* __restrict__ list, float* __restrict__ gates) {
  const int n = item * 4 + (TIDX >> 6), lane = TIDX & 63;
  const float4 lg = ((const float4*)(logits + (size_t)n * NEXP))[lane];
  const float4 rb = ((const float4*)router_bias)[lane];
  float sc[4] = {sigmoidf(lg.x), sigmoidf(lg.y), sigmoidf(lg.z), sigmoidf(lg.w)};
  float sel[4] = {sc[0] + rb.x, sc[1] + rb.y, sc[2] + rb.z, sc[3] + rb.w};
  float t1 = fmaxf(sel[0], sel[1]), t2 = fminf(sel[0], sel[1]);
  { const float a = sel[2]; if (a > t1) { t2 = t1; t1 = a; } else if (a > t2) t2 = a; }
  { const float a = sel[3]; if (a > t1) { t2 = t1; t1 = a; } else if (a > t2) t2 = a; }
#pragma unroll
  for (int o = 1; o < 8; o <<= 1) {
    const float b1 = __shfl_xor(t1, o), b2 = __shfl_xor(t2, o);
    const float n1 = fmaxf(t1, b1), n2 = fmaxf(fminf(t1, b1), fmaxf(t2, b2));
    t1 = n1; t2 = n2;
  }
  const float gs = t1 + t2;
  const int mygrp = lane >> 3;
  int rank = 0;
#pragma unroll
  for (int j = 0; j < 8; ++j) {
    const float o = __shfl(gs, j * 8);
    rank += (o > gs || (o == gs && j < mygrp)) ? 1 : 0;
  }
  const bool gsel = rank < 4;
  float cand[4];
#pragma unroll
  for (int i = 0; i < 4; ++i) cand[i] = gsel ? sel[i] : -INFINITY;
  float gsum = 0.f; float myg = 0.f; int mye = 0;
#pragma unroll 1
  for (int r = 0; r < TOPK; ++r) {
    float bv = cand[0]; int bi = 0;
#pragma unroll
    for (int i = 1; i < 4; ++i) if (cand[i] > bv) { bv = cand[i]; bi = i; }
    int be = lane * 4 + bi;
    float bs = (bi == 0) ? sc[0] : (bi == 1) ? sc[1] : (bi == 2) ? sc[2] : sc[3];
#pragma unroll
    for (int o = 1; o < 64; o <<= 1) {
      const float ov = __shfl_xor(bv, o); const int oe = __shfl_xor(be, o); const float os = __shfl_xor(bs, o);
      if (ov > bv || (ov == bv && oe < be)) { bv = ov; be = oe; bs = os; }
    }
    if ((be >> 2) == lane) {
      const int bi2 = be & 3;
      if (bi2 == 0) cand[0] = -INFINITY; else if (bi2 == 1) cand[1] = -INFINITY; else if (bi2 == 2) cand[2] = -INFINITY; else cand[3] = -INFINITY;
    }
    gsum += bs;
    if (lane == r) { myg = bs; mye = be; }
  }
  if (lane < TOPK) {
    const int slot = atomicAdd(&cnt[mye], 1);
    list[(size_t)mye * CAP + slot] = n * TOPK + lane;
    gates[(size_t)n * TOPK + lane] = myg / gsum * 2.5f;
  }
}

__device__ __forceinline__ void moe_build_prefix(const int* __restrict__ cnt, int* sscan) {
  const int tid = TIDX;
  const int e = ((tid & 31) << 3) | (tid >> 5);
  const int c = cnt[e];
  __syncthreads();
  sscan[tid] = (c + 127) >> 7;
  __syncthreads();
  for (int o = 1; o < 256; o <<= 1) {
    const int v = (tid >= o) ? sscan[tid - o] : 0;
    __syncthreads();
    sscan[tid] += v;
    __syncthreads();
  }
}
__device__ __forceinline__ void moe_locate(const int* sscan, int x, int lt, int& e, int& rt) {
  const int base = x ? sscan[32 * x - 1] : 0;
  const int nrouted = sscan[32 * x + 31] - base;
  if (lt >= nrouted) { e = 256; rt = x * (NTOK / 128 / 8) + (lt - nrouted); return; }
  const int g = base + lt;
  int lo = 32 * x, hi = 32 * x + 31;
  while (lo < hi) { const int mid = (lo + hi) >> 1; if (sscan[mid] > g) hi = mid; else lo = mid + 1; }
  e = ((lo & 31) << 3) | (lo >> 5); rt = g - (lo ? sscan[lo - 1] : 0);
}

__device__ __forceinline__ void ph_moe1(unsigned char* smem, int e, int rt, const bf16_t* __restrict__ xbf, const int* __restrict__ cnt, const int* __restrict__ list,
                                        const float* __restrict__ w_gate, const float* __restrict__ w_up,
                                        const float* __restrict__ sw_gate, const float* __restrict__ sw_up, bf16_t* __restrict__ hbuf) {
  int* sasg = (int*)(smem + SM_MISC + 2048);
  GEMM_IDS
  const int rows = (e < 256) ? cnt[e] : NTOK;
  __syncthreads();
  if (tid < 128) {
    const int r = rt * 128 + tid;
    int a = -1;
    if (r < rows) a = (e < 256) ? list[(size_t)e * CAP + r] : (NA + r);
    sasg[tid] = a;
  }
  __syncthreads();
  LdRowBF16 al; al.init([&](int r) { const int a = sasg[r]; const int tok = (a < 0) ? 0 : (a < NA ? (a >> 3) : (a - NA)); return xbf + (size_t)tok * DM; }, 0);
  LdColF32 bl;
  {
    const int jj = 4 * (tid & 31);
    const int bwc = jj >> 6, bn = (jj >> 4) & 3;
    const int ff = bwc * 32 + (bn >> 1) * 16 + (jj & 15);
    const float* W = (e < 256) ? ((bn & 1) ? w_up : w_gate) + (size_t)e * DM * EFF : ((bn & 1) ? sw_up : sw_gate);
    bl.init(W + ff, EFF, 64 * 4);
  }
  gemm_stream<16>(smem, al, bl, 4, [&](int ct, f32x4 (&acc)[4][4]) {
    GEMM_IDS
#pragma unroll
    for (int m = 0; m < 4; ++m) {
      const int a = sasg[wr * 64 + m * 16 + fr];
      if (a >= 0) {
#pragma unroll
        for (int pp = 0; pp < 2; ++pp) {
          float hv[4];
#pragma unroll
          for (int r = 0; r < 4; ++r) hv[r] = siluf(acc[m][2 * pp][r]) * acc[m][2 * pp + 1][r];
          u32x2 w; w[0] = pack2(hv[0], hv[1]); w[1] = pack2(hv[2], hv[3]);
          *(u32x2*)(hbuf + (size_t)a * EFF + ct * 64 + wc * 32 + pp * 16 + fq * 4) = w;
        }
      }
    }
  });
}

__device__ __forceinline__ void ph_moe2(unsigned char* smem, int e, int rt, const bf16_t* __restrict__ hbuf, const int* __restrict__ cnt, const int* __restrict__ list, const float* __restrict__ gates,
                                        const float* __restrict__ w_down, const float* __restrict__ sw_down, bf16_t* __restrict__ ybuf) {
  int* sasg = (int*)(smem + SM_MISC + 2048);
  float* sgate = (float*)(smem + SM_MISC + 2048 + 512);
  GEMM_IDS
  const int rows = (e < 256) ? cnt[e] : NTOK;
  __syncthreads();
  if (tid < 128) {
    const int r = rt * 128 + tid;
    int a = -1;
    if (r < rows) a = (e < 256) ? list[(size_t)e * CAP + r] : (NA + r);
    sasg[tid] = a;
    sgate[tid] = (a >= 0 && a < NA) ? gates[a] : 1.f;
  }
  __syncthreads();
  LdRowBF16 al; al.init([&](int r) { const int a = sasg[r]; return hbuf + (size_t)(a < 0 ? 0 : a) * EFF; }, 0);
  LdColF32 bl; bl.init(((e < 256) ? w_down + (size_t)e * EFF * DM : sw_down) + 4 * (tid & 31), DM, 128 * 4);
  gemm_stream<4>(smem, al, bl, 8, [&](int ct, f32x4 (&acc)[4][4]) {
    GEMM_IDS
    const int n0 = ct * 128;
#pragma unroll
    for (int m = 0; m < 4; ++m) {
      const int r_ = wr * 64 + m * 16 + fr;
      const int a = sasg[r_];
      if (a >= 0) {
        const float gt = sgate[r_];
#pragma unroll
        for (int n = 0; n < 4; ++n) {
          u32x2 w; w[0] = pack2(acc[m][n][0] * gt, acc[m][n][1] * gt); w[1] = pack2(acc[m][n][2] * gt, acc[m][n][3] * gt);
          *(u32x2*)(ybuf + (size_t)a * DM + n0 + wc * 64 + n * 16 + fq * 4) = w;
        }
      }
    }
  });
}

__device__ __forceinline__ void ph_final(int item, float* __restrict__ out, const bf16_t* __restrict__ ybuf, const float* __restrict__ gam, const float* __restrict__ bet) {
  const int row = item * 4 + (TIDX >> 6), lane = TIDX & 63;
  float4* p = (float4*)(out + (size_t)row * DM);
  float4 v[4]; float s = 0.f;
#pragma unroll
  for (int i = 0; i < 4; ++i) {
    float4 a = p[lane + i * 64];
    a.x *= ALPHA; a.y *= ALPHA; a.z *= ALPHA; a.w *= ALPHA;
#pragma unroll
    for (int k = 0; k < 9; ++k) {
      const size_t yr = (k < 8) ? ((size_t)row * 8 + k) : ((size_t)NA + row);
      const uint2 w = ((const uint2*)(ybuf + yr * DM))[lane + i * 64];
      a.x += bflo(w.x); a.y += bfhi(w.x); a.z += bflo(w.y); a.w += bfhi(w.y);
    }
    v[i] = a; s += a.x + a.y + a.z + a.w;
  }
  const float mu = wave_sum(s) * (1.f / DM);
  float q = 0.f;
#pragma unroll
  for (int i = 0; i < 4; ++i) { const float a = v[i].x - mu, b = v[i].y - mu, c = v[i].z - mu, d = v[i].w - mu; q += a * a + b * b + c * c + d * d; }
  const float rs = rsqrtf(wave_sum(q) * (1.f / DM) + LN_EPS);
#pragma unroll
  for (int i = 0; i < 4; ++i) {
    const float4 gg = ((const float4*)gam)[lane + i * 64], bb = ((const float4*)bet)[lane + i * 64];
    float4 r;
    r.x = (v[i].x - mu) * rs * gg.x + bb.x; r.y = (v[i].y - mu) * rs * gg.y + bb.y;
    r.z = (v[i].z - mu) * rs * gg.z + bb.z; r.w = (v[i].w - mu) * rs * gg.w + bb.w;
    p[lane + i * 64] = r;
  }
}

#define XB_TMO      128
#define XB_XCNT(j)  (256  + 64 * (j))
#define XB_XSUB(j)  (1280 + 64 * (j))
#define XB_XGEN(j)  (2304 + 64 * (j))
#define XB_TOP      3328
#define XB_TOPGEN   3392
#define XCD_BAR_WORDS 3456
#define XB_SPIN_CAP (1u << 22)
#define LAS __attribute__((address_space(3)))
__device__ __forceinline__ unsigned xb_ld(unsigned* p)              { return __hip_atomic_load(p, __ATOMIC_RELAXED, __HIP_MEMORY_SCOPE_AGENT); }
__device__ __forceinline__ unsigned xb_add(unsigned* p, unsigned v) { return __hip_atomic_fetch_add(p, v, __ATOMIC_RELAXED, __HIP_MEMORY_SCOPE_AGENT); }
__device__ __forceinline__ unsigned xb_xcc_id() { return (unsigned)__builtin_amdgcn_s_getreg((3 << 11) | 20) & 0xFu; }
#define XB_SPIN(cond, bar) do { unsigned _sp = 0; while (cond) { __builtin_amdgcn_s_sleep(1); \
    if ((++_sp & 255u) == 0u) { if (xb_ld(&(bar)[XB_TMO])) break; if (_sp > XB_SPIN_CAP) { atomicAdd(&(bar)[XB_TMO], 1u); break; } } } } while (0)
struct XcdBarrier { unsigned* bar; unsigned x; volatile LAS unsigned* st; };
__device__ __forceinline__ XcdBarrier xcd_barrier_post(unsigned* bar, volatile LAS unsigned* st) {
  XcdBarrier b; b.bar = bar; b.x = xb_xcc_id(); b.st = st;
  if (threadIdx.x == 0) (void)xb_add(&bar[XB_XCNT(b.x)], 1u);
  return b;
}
__device__ __forceinline__ void xcd_barrier_complete(unsigned* bar, unsigned x, unsigned& nloc, unsigned& nx) {
  const unsigned G = gridDim.x * gridDim.y * gridDim.z;
  unsigned sum, cnt, mine, sp = 0u;
  for (;;) {
    sum = 0u; cnt = 0u; mine = 0u;
#pragma unroll
    for (unsigned j = 0; j < 16; ++j) { const unsigned c = xb_ld(&bar[XB_XCNT(j)]); sum += c; cnt += (c > 0u) ? 1u : 0u; mine = (j == x) ? c : mine; }
    if (sum == G) break;
    __builtin_amdgcn_s_sleep(1);
    if ((++sp & 255u) == 0u) { if (xb_ld(&bar[XB_TMO])) break; if (sp > XB_SPIN_CAP) { atomicAdd(&bar[XB_TMO], 1u); break; } }
  }
  nloc = mine > 0u ? mine : 1u; nx = cnt > 0u ? cnt : 1u;
}
__device__ __forceinline__ void xcd_barrier(const XcdBarrier& b) {
  asm volatile("s_waitcnt vmcnt(0)" ::: "memory");
  __syncthreads();
  if (threadIdx.x == 0) {
    unsigned* bar = b.bar;
    __builtin_amdgcn_s_waitcnt(0);
    unsigned nloc = b.st[0], nx = b.st[1];
    if (nloc == 0u) { xcd_barrier_complete(bar, b.x, nloc, nx); b.st[0] = nloc; b.st[1] = nx; }
    const unsigned old = xb_add(&bar[XB_XSUB(b.x)], 1u);
    const unsigned gen = old / nloc;
    if (old + 1u == (gen + 1u) * nloc) {
      __builtin_amdgcn_fence(__ATOMIC_RELEASE, "agent");
      asm volatile("s_waitcnt vmcnt(0)" ::: "memory");
      const unsigned og = xb_add(&bar[XB_TOP], 1u);
      const unsigned tg = og / nx;
      if (og + 1u == (tg + 1u) * nx) xb_add(&bar[XB_TOPGEN], 1u);
      else XB_SPIN(xb_ld(&bar[XB_TOPGEN]) == tg, bar);
      __builtin_amdgcn_fence(__ATOMIC_ACQUIRE, "agent");
      xb_add(&bar[XB_XGEN(b.x)], 1u);
      asm volatile("s_waitcnt vmcnt(0)" ::: "memory");
    } else {
      XB_SPIN(xb_ld(&bar[XB_XGEN(b.x)]) == gen, bar);
      __builtin_amdgcn_fence(__ATOMIC_ACQUIRE, "agent");
      asm volatile("s_waitcnt vmcnt(0)" ::: "memory");
    }
  }
  __syncthreads();
}

__global__ void __launch_bounds__(256, 2) mega(Params P) {
  __shared__ __attribute__((aligned(16))) unsigned char smem[SMEM_BYTES];
  cg::grid_group grid = cg::this_grid();
  const int bid = blockIdx.x, nblk = gridDim.x;
#define xin (P.in[0])
#define w_in (P.in[1])
#define conv_w (P.in[2])
#define a_log (P.in[3])
#define dt_bias (P.in[4])
#define dn_norm_g (P.in[5])
#define sinks (P.in[6])
#define w_out (P.in[7])
#define ln1_g (P.in[8])
#define ln1_b (P.in[9])
#define router_w (P.in[10])
#define router_bias (P.in[11])
#define w_gate (P.in[12])
#define w_up (P.in[13])
#define w_down (P.in[14])
#define sw_gate (P.in[15])
#define sw_up (P.in[16])
#define sw_down (P.in[17])
#define ln2_g (P.in[18])
#define ln2_b (P.in[19])
#define outp (P.out)
#define x1bf ((bf16_t*)(P.ws + WS_X1BF))
#define logits ((float*)(P.ws + WS_LOGIT))
#define list ((int*)(P.ws + WS_LIST))
#define gates ((float*)(P.ws + WS_GATES))
#define cnt ((int*)(P.ws + WS_CTRL))
#define barw ((unsigned*)(P.ws + WS_CTRL + 4096))
#define mixed ((bf16_t*)(P.ws + WS_MIXED))
#define proj ((bf16_t*)(P.ws + WS_PROJ))
#define ba ((float*)(P.ws + WS_BA))
#define QD ((bf16_t*)(P.ws + WS_QD))
#define W0N ((bf16_t*)(P.ws + WS_W0N))
#define KTT ((bf16_t*)(P.ws + WS_KTT))
#define RV ((bf16_t*)(P.ws + WS_RV))
#define TM ((bf16_t*)(P.ws + WS_TM))
#define ATT ((bf16_t*)(P.ws + WS_ATT))
#define GL ((float*)(P.ws + WS_GL))
#define obuf ((float*)(P.ws + WS_O))
#define VTb ((bf16_t*)(P.ws + WS_VT))
#define XBF ((bf16_t*)(P.ws + WS_XBF))
#define WTIN ((bf16_t*)(P.ws + WS_WTIN))
#define WTOUT ((bf16_t*)(P.ws + WS_WTOUT))
#define WTR ((bf16_t*)(P.ws + WS_WTR))
#define hbuf ((bf16_t*)(P.ws + WS_HBUF))
#define ybuf ((bf16_t*)(P.ws + WS_YBUF))
  {
    volatile LAS unsigned* st0 = (volatile LAS unsigned*)(smem + SM_MISC + 4080);
    if (threadIdx.x == 0) { st0[0] = 0u; st0[1] = 0u; }
    __syncthreads();
  }
  const int xcd = bid & 7, xloc = bid >> 3, xnl = nblk >> 3;
  XcdBarrier xb = xcd_barrier_post(barw, (volatile LAS unsigned*)(smem + SM_MISC + 4080));
  for (int it = bid; it < NTOK / 4; it += nblk) ph_cvt_x(it, xin, XBF);
  for (int it = bid; it < 16 * 46 + 16 * 16 + 16 * 4; it += nblk) {
    if (it < 16 * 46) ph_cvt_wt(smem, it % 16, it / 16, w_in, DM, INC, WTIN);
    else if (it < 16 * 46 + 256) { const int j = it - 16 * 46; ph_cvt_wt(smem, j % 16, j / 16, w_out, DM, DM, WTOUT); }
    else { const int j = it - 16 * 46 - 256; ph_cvt_wt(smem, j % 16, j / 16, router_w, DM, NEXP, WTR); }
  }
  grid.sync();
  for (int l = xloc; l < 64; l += xnl) ph_proj(smem, xcd, l, XBF, WTIN, proj, ba, VTb);
  xcd_barrier(xb);
  for (int it = bid; it < 2048; it += nblk) ph_dnchunk(smem, it, proj, ba, conv_w, a_log, dt_bias, QD, W0N, KTT, RV, TM, ATT, GL);
  for (int it = bid; it < 512; it += nblk) ph_swa(smem, it, proj, VTb, sinks, mixed);
  xcd_barrier(xb);
  for (int it = bid; it < 64; it += nblk) ph_dnscan(smem, it, QD, W0N, KTT, RV, TM, ATT, GL, obuf);
  xcd_barrier(xb);
  for (int it = bid; it < NTOK / 4; it += nblk) ph_dn_post(it, obuf, proj, dn_norm_g, mixed);
  xcd_barrier(xb);
  for (int l = xloc; l < 64; l += xnl) ph_wout(smem, xcd, l, mixed, WTOUT, xin, outp);
  xcd_barrier(xb);
  for (int it = bid; it < NTOK / 4; it += nblk) ph_ln1(it, outp, ln1_g, ln1_b, x1bf);
  xcd_barrier(xb);
  for (int i = xloc; i < 32 * 2; i += xnl) ph_router(smem, (xcd * 32 + i / 2) * 2 + i % 2, x1bf, WTR, logits);
  xcd_barrier(xb);
  for (int it = bid; it < NTOK / 4; it += nblk) ph_route(it, logits, router_bias, cnt, list, gates);
  xcd_barrier(xb);
  int* sscan = (int*)(smem + SM_MISC);
  moe_build_prefix(cnt, sscan);
  const int ntile = sscan[32 * xcd + 31] - (xcd ? sscan[32 * xcd - 1] : 0) + NTOK / 128 / 8;
  for (int it = xloc; it < ntile; it += xnl) {
    int e, rt; moe_locate(sscan, xcd, it, e, rt);
    ph_moe1(smem, e, rt, x1bf, cnt, list, w_gate, w_up, sw_gate, sw_up, hbuf);
  }
  xcd_barrier(xb);
  for (int it = xloc; it < ntile; it += xnl) {
    int e, rt; moe_locate(sscan, xcd, it, e, rt);
    ph_moe2(smem, e, rt, hbuf, cnt, list, gates, w_down, sw_down, ybuf);
  }
  xcd_barrier(xb);
  for (int it = bid; it < NTOK / 4; it += nblk) ph_final(it, outp, ybuf, ln2_g, ln2_b);
}

#undef xin
#undef w_in
#undef conv_w
#undef a_log
#undef dt_bias
#undef dn_norm_g
#undef sinks
#undef w_out
#undef ln1_g
#undef ln1_b
#undef router_w
#undef router_bias
#undef w_gate
#undef w_up
#undef w_down
#undef sw_gate
#undef sw_up
#undef sw_down
#undef ln2_g
#undef ln2_b
#undef outp
#undef x1bf
#undef logits
#undef list
#undef gates
#undef cnt
#undef mixed
#undef proj
#undef ba
#undef QD
#undef W0N
#undef KTT
#undef RV
#undef TM
#undef ATT
#undef GL
#undef obuf
#undef hbuf
#undef ybuf
#undef VTb
#undef XBF
#undef WTIN
#undef WTOUT
#undef WTR
#undef barw

extern "C" void kernel_launch(void* const* d_in, const int* in_sizes, int n_in, void* d_out, int out_size, void* d_ws, size_t ws_size, hipStream_t stream) {
  static int grid_blocks = 0;
  if (!grid_blocks) {
    int dev = 0, cus = 0, per_cu = 0;
    (void)hipGetDevice(&dev);
    (void)hipDeviceGetAttribute(&cus, hipDeviceAttributeMultiprocessorCount, dev);
    (void)hipOccupancyMaxActiveBlocksPerMultiprocessor(&per_cu, mega, 256, 0);
    if (per_cu > 2) per_cu = 2;
    if (per_cu < 1) per_cu = 1;
    grid_blocks = cus * per_cu;
  }
  Params p{};
  for (int i = 0; i < 20; ++i) p.in[i] = (const float*)d_in[i];
  p.out = (float*)d_out; p.ws = (char*)d_ws;
  (void)hipMemsetAsync((char*)d_ws + WS_CTRL, 0, 4096 + XCD_BAR_WORDS * 4, stream);
  void* args[] = {&p};
  hipError_t e = hipLaunchCooperativeKernel((void*)mega, dim3(grid_blocks), dim3(256), args, 0, stream);
  if (e != hipSuccess) fprintf(stderr, "cooperative launch failed: %s (grid %d)\n", hipGetErrorString(e), grid_blocks);
}
```

```cpp
#include <hip/hip_runtime.h>
#include <hip/hip_cooperative_groups.h>
#include <stdint.h>
#include <stdio.h>
namespace cg = cooperative_groups;

typedef __attribute__((ext_vector_type(8))) short bf16x8;
typedef __attribute__((ext_vector_type(4))) float f32x4;
typedef unsigned short bf16_t;
typedef __attribute__((ext_vector_type(4))) unsigned u32x4;
typedef __attribute__((ext_vector_type(2))) unsigned u32x2;

constexpr int NTOK = 32768, SEQ = 4096, DM = 1024;
constexpr int INC = 2824, PROJW = 2816;
constexpr int OFF_DQ = 0, OFF_DK = 512, OFF_DV = 1024, OFF_SQ = 1536, OFF_SK = 2048, OFF_SV = 2176, OFF_Z = 2304;
constexpr int NEXP = 256, TOPK = 8, EFF = 256;
constexpr int NA = NTOK * TOPK;
constexpr int CAP = NTOK;
constexpr float ALPHA = 1.189207115002721f;
constexpr float LN_EPS = 1e-5f, RMS_EPS = 1e-6f, L2_EPS = 1e-6f;

constexpr size_t MiB = 1024ull * 1024ull;
constexpr size_t WS_WTD = 0;
constexpr size_t WS_WTG = 128 * MiB;
constexpr size_t WS_WTU = 256 * MiB;
constexpr size_t WS_YBUF = 128 * MiB;
constexpr size_t WS_HBUF = 640 * MiB;
constexpr size_t WS_X1BF = 784 * MiB;
constexpr size_t WS_LIST = 848 * MiB;
constexpr size_t WS_GATES = 880 * MiB;
constexpr size_t WS_CTRL = 881 * MiB;
constexpr size_t WS_LOGIT = 882 * MiB;
constexpr size_t WS_WTIN = 914 * MiB;
constexpr size_t WS_WTOUT = 920 * MiB;
constexpr size_t WS_WTR = 922 * MiB;
constexpr size_t WS_WTSG = 923 * MiB;
constexpr size_t WS_WTSU = WS_WTSG + 512 * 1024;
constexpr size_t WS_WTSD = 924 * MiB;
constexpr size_t WS_PROJ = 384 * MiB;
constexpr size_t WS_BA = 560 * MiB;
constexpr size_t WS_QD = 561 * MiB;
constexpr size_t WS_W0N = 593 * MiB;
constexpr size_t WS_KTT = 625 * MiB;
constexpr size_t WS_RV = 657 * MiB;
constexpr size_t WS_TM = 689 * MiB;
constexpr size_t WS_ATT = 705 * MiB;
constexpr size_t WS_GL = 721 * MiB;
constexpr size_t WS_O = 722 * MiB;
constexpr size_t WS_VT = 786 * MiB;
constexpr size_t WS_MIXED = 794 * MiB;
constexpr size_t WS_XBF = 640 * MiB;

__device__ __forceinline__ int opaque_tid() { int t = threadIdx.x; asm volatile("" : "+v"(t)); return t; }
#define TIDX opaque_tid()
typedef __attribute__((ext_vector_type(2))) __bf16 hwbf16x2;
typedef __attribute__((ext_vector_type(2))) float hwf32x2;
__device__ __forceinline__ unsigned pack2(float lo, float hi) {
  hwf32x2 f = {lo, hi};
  return __builtin_bit_cast(unsigned, __builtin_convertvector(f, hwbf16x2));
}
__device__ __forceinline__ unsigned f2bf(float f) { return pack2(f, 0.f) & 0xffffu; }
__device__ __forceinline__ float bf2f(unsigned h) { return __uint_as_float(h << 16); }
__device__ __forceinline__ float bflo(unsigned w) { return __uint_as_float(w << 16); }
__device__ __forceinline__ float bfhi(unsigned w) { return __uint_as_float(w & 0xffff0000u); }
__device__ __forceinline__ float siluf(float x) { return x / (1.f + __expf(-x)); }
__device__ __forceinline__ float sigmoidf(float x) { return 1.f / (1.f + __expf(-x)); }
__device__ __forceinline__ float wave_sum(float v) {
#pragma unroll
  for (int o = 32; o > 0; o >>= 1) v += __shfl_xor(v, o);
  return v;
}

template <int SEGDIV>
struct LdRowBF16T {
  const char* p[4]; u32x4 r[2][4]; int row0, ch; size_t seghi, seglo;
  template <class F> __device__ __forceinline__ void init(F rowptr, size_t hi, size_t lo = 0) {
    const int tid = TIDX; ch = tid & 7; row0 = tid >> 3; seghi = hi; seglo = lo;
#pragma unroll
    for (int i = 0; i < 4; ++i) p[i] = (const char*)rowptr(row0 + i * 32) + ch * 16;
  }
  template <int S> __device__ __forceinline__ void load(int seg, int kk) {
    const size_t off = (size_t)(seg / SEGDIV) * seghi + (size_t)(seg % SEGDIV) * seglo + (size_t)kk * 128;
#pragma unroll
    for (int i = 0; i < 4; ++i) r[S][i] = *(const u32x4*)(p[i] + off);
  }
  template <int S> __device__ __forceinline__ void store(unsigned char* s) {
#pragma unroll
    for (int i = 0; i < 4; ++i) {
      const int row = row0 + i * 32;
      *(u32x4*)(s + row * 128 + ((ch ^ (row & 7)) << 4)) = r[S][i];
    }
  }
};
typedef LdRowBF16T<1> LdRowBF16;
struct LdColF32 {
  const char* p; size_t ldb, segb; f32x4 r[2][8]; int n4, kg;
  __device__ __forceinline__ void init(const float* colptr, size_t ld, size_t seg_bytes) {
    const int tid = TIDX; n4 = tid & 31; kg = tid >> 5; ldb = ld * 4; segb = seg_bytes;
    p = (const char*)colptr + (size_t)(kg * 8) * ldb;
  }
  template <int S> __device__ __forceinline__ void load(int seg, int kk) {
#pragma unroll
    for (int j = 0; j < 8; ++j) r[S][j] = *(const f32x4*)(p + (size_t)seg * segb + (size_t)(kk * 64 + j) * ldb);
  }
  template <int S> __device__ __forceinline__ void store(unsigned char* s) {
#pragma unroll
    for (int i = 0; i < 4; ++i) {
      const int row = n4 * 4 + i; u32x4 w;
      w[0] = pack2(r[S][0][i], r[S][1][i]); w[1] = pack2(r[S][2][i], r[S][3][i]); w[2] = pack2(r[S][4][i], r[S][5][i]); w[3] = pack2(r[S][6][i], r[S][7][i]);
      *(u32x4*)(s + row * 128 + ((kg ^ (row & 7)) << 4)) = w;
    }
  }
};

__device__ __forceinline__ void gemm_kstep(const unsigned char* sA, const unsigned char* sB, f32x4 (&acc)[4][4], int wr, int wc, int fr, int fq) {
#pragma unroll
  for (int ks = 0; ks < 2; ++ks) {
    bf16x8 a[4], b[4];
#pragma unroll
    for (int m = 0; m < 4; ++m) {
      const int row = wr * 64 + m * 16 + fr;
      a[m] = *(const bf16x8*)(sA + row * 128 + (((ks * 4 + fq) ^ (row & 7)) << 4));
    }
#pragma unroll
    for (int n = 0; n < 4; ++n) {
      const int row = wc * 64 + n * 16 + fr;
      b[n] = *(const bf16x8*)(sB + row * 128 + (((ks * 4 + fq) ^ (row & 7)) << 4));
    }
#pragma unroll
    for (int m = 0; m < 4; ++m)
#pragma unroll
      for (int n = 0; n < 4; ++n) acc[m][n] = __builtin_amdgcn_mfma_f32_16x16x32_bf16(b[n], a[m], acc[m][n], 0, 0, 0);
  }
}
template <int KPER, class AL, class BL, class Epi>
__device__ __forceinline__ void gemm_stream(unsigned char* smem, AL& al, BL& bl, int nseg, Epi epi) {
  static_assert(KPER % 2 == 0, "segments start on even k-steps");
  const int tid = TIDX, lane = tid & 63, wid = tid >> 6, wr = wid >> 1, wc = wid & 1, fr = lane & 15, fq = lane >> 4;
  const int total = nseg * KPER;
  unsigned char* buf0 = smem; unsigned char* buf1 = smem + 32768;
  f32x4 acc[4][4];
  al.template load<0>(0, 0); bl.template load<0>(0, 0);
  al.template load<1>(0, 1); bl.template load<1>(0, 1);
  al.template store<0>(buf0); bl.template store<0>(buf0 + 16384);
  if (total > 2) { al.template load<0>(2 / KPER, 2 % KPER); bl.template load<0>(2 / KPER, 2 % KPER); }
  __syncthreads();
  for (int j = 0; j < total; j += 2) {
    if (j % KPER == 0) {
#pragma unroll
      for (int m = 0; m < 4; ++m)
#pragma unroll
        for (int n = 0; n < 4; ++n) acc[m][n] = (f32x4){0.f, 0.f, 0.f, 0.f};
    }
    { al.template store<1>(buf1); bl.template store<1>(buf1 + 16384); }
    if (j + 3 < total) { al.template load<1>((j + 3) / KPER, (j + 3) % KPER); bl.template load<1>((j + 3) / KPER, (j + 3) % KPER); }
    gemm_kstep(buf0, buf0 + 16384, acc, wr, wc, fr, fq);
    __syncthreads();
    if (j + 2 < total) { al.template store<0>(buf0); bl.template store<0>(buf0 + 16384); }
    if (j + 4 < total) { al.template load<0>((j + 4) / KPER, (j + 4) % KPER); bl.template load<0>((j + 4) / KPER, (j + 4) % KPER); }
    gemm_kstep(buf1, buf1 + 16384, acc, wr, wc, fr, fq);
    __syncthreads();
    if ((j + 2) % KPER == 0) epi((j + 2) / KPER - 1, acc);
  }
}

#define GEMM_IDS const int tid = TIDX, lane = tid & 63, wid = tid >> 6, wr = wid >> 1, wc = wid & 1, fr = lane & 15, fq = lane >> 4; (void)tid; (void)lane;

struct Params {
  const float* in[20];
  float* out;
  char* ws;
};

constexpr int SMEM_BYTES = 69632;
constexpr int SM_MISC = 65536;

__device__ __forceinline__ void ph_cvt_x(int item, const float* __restrict__ x, bf16_t* __restrict__ xbf) {
  const int tid = TIDX;
  const size_t base = (size_t)item * 4096 + (size_t)tid * 4;
#pragma unroll
  for (int i = 0; i < 4; ++i) {
    const f32x4 v = *(const f32x4*)(x + base + (size_t)i * 1024);
    u32x2 w; w[0] = pack2(v[0], v[1]); w[1] = pack2(v[2], v[3]);
    *(u32x2*)(xbf + base + (size_t)i * 1024) = w;
  }
}
__device__ __forceinline__ void ph_cvt_wt(unsigned char* smem, int kt, int nt, const float* __restrict__ W, int K, int N, bf16_t* __restrict__ WT) {
  float* tile = (float*)smem;
  const int tid = TIDX;
  const int k0 = kt * 64, n0 = nt * 64;
  __syncthreads();
#pragma unroll
  for (int i = 0; i < 4; ++i) {
    const int k = (tid >> 4) + 16 * i, n = 4 * (tid & 15);
    f32x4 v = (f32x4){0.f, 0.f, 0.f, 0.f};
    if (n0 + n < N) v = *(const f32x4*)(W + (size_t)(k0 + k) * N + n0 + n);
    tile[k * 65 + n + 0] = v[0]; tile[k * 65 + n + 1] = v[1]; tile[k * 65 + n + 2] = v[2]; tile[k * 65 + n + 3] = v[3];
  }
  __syncthreads();
  const int n = tid >> 2, kq = tid & 3;
  u32x4 w0, w1;
#pragma unroll
  for (int j = 0; j < 4; ++j) {
    w0[j] = pack2(tile[(kq * 16 + 2 * j) * 65 + n], tile[(kq * 16 + 2 * j + 1) * 65 + n]);
    w1[j] = pack2(tile[(kq * 16 + 8 + 2 * j) * 65 + n], tile[(kq * 16 + 8 + 2 * j + 1) * 65 + n]);
  }
  bf16_t* dst = WT + (size_t)(n0 + n) * K + k0 + kq * 16;
  *(u32x4*)dst = w0; *(u32x4*)(dst + 8) = w1;
}

struct CvtTile { const float* src; bf16_t* dst; int ldn; };
__device__ __forceinline__ CvtTile cvt_decode(int it, int lane, const float* __restrict__ w_gate, const float* __restrict__ w_up, const float* __restrict__ w_down,
                                              bf16_t* __restrict__ wtg, bf16_t* __restrict__ wtu, bf16_t* __restrict__ wtd) {
  const int e = it / 384, j = it % 384;
  const float* W; bf16_t* WT; int K, N, kt, nt;
  if (j < 128) { W = w_gate + (size_t)e * DM * EFF; WT = wtg + (size_t)e * EFF * DM; K = DM; N = EFF; kt = j & 31; nt = j >> 5; }
  else if (j < 256) { W = w_up + (size_t)e * DM * EFF; WT = wtu + (size_t)e * EFF * DM; K = DM; N = EFF; kt = (j - 128) & 31; nt = (j - 128) >> 5; }
  else { W = w_down + (size_t)e * EFF * DM; WT = wtd + (size_t)e * DM * EFF; K = EFF; N = DM; kt = (j - 256) & 7; nt = (j - 256) >> 3; }
  CvtTile t;
  t.src = W + (size_t)(kt * 32 + (lane >> 4)) * N + nt * 64 + 4 * (lane & 15);
  t.dst = WT + (size_t)(nt * 64 + lane) * K + kt * 32;
  t.ldn = 4 * N;
  return t;
}
__device__ __forceinline__ void cvt_load(const CvtTile& t, f32x4 (&v)[8]) {
#pragma unroll
  for (int i = 0; i < 8; ++i) v[i] = *(const f32x4*)(t.src + (size_t)i * t.ldn);
}
__device__ __forceinline__ void cvt_store(float* tile  , int lane, const CvtTile& t, const f32x4 (&v)[8]) {
#pragma unroll
  for (int i = 0; i < 8; ++i) {
    float* p = tile + ((lane >> 4) + 4 * i) * 65 + 4 * (lane & 15);
    p[0] = v[i][0]; p[1] = v[i][1]; p[2] = v[i][2]; p[3] = v[i][3];
  }
  u32x4 w[4];
#pragma unroll
  for (int q = 0; q < 4; ++q)
#pragma unroll
    for (int j = 0; j < 4; ++j) w[q][j] = pack2(tile[(8 * q + 2 * j) * 65 + lane], tile[(8 * q + 2 * j + 1) * 65 + lane]);
#pragma unroll
  for (int q = 0; q < 4; ++q) *(u32x4*)(t.dst + 8 * q) = w[q];
}

__device__ __forceinline__ void ph_proj(unsigned char* smem, int xcd, int l, const bf16_t* __restrict__ xbf, const bf16_t* __restrict__ wt, bf16_t* __restrict__ proj, float* __restrict__ ba, bf16_t* __restrict__ vt) {
  const int mi = l >> 3, ni = l & 7;
  LdRowBF16T<3> al; al.init([&](int r) { return xbf + (size_t)((xcd * 32 + mi) * 128 + r) * DM; }, (size_t)8 * 128 * DM * 2, 0);
  LdRowBF16T<3> bl; bl.init([&](int r) { return wt + (size_t)(ni * 128 + r) * DM; }, 0, (size_t)8 * 128 * DM * 2);
  gemm_stream<16>(smem, al, bl, 12, [&](int seg, f32x4 (&acc)[4][4]) {
    GEMM_IDS
    const int nt = (seg % 3) * 8 + ni;
    if (nt < 23) {
      const int m0 = (xcd * 32 + (seg / 3) * 8 + mi) * 128, n0 = nt * 128;
#pragma unroll
      for (int m = 0; m < 4; ++m)
#pragma unroll
        for (int n = 0; n < 4; ++n) {
          const int row = m0 + wr * 64 + m * 16 + fr, col = n0 + wc * 64 + n * 16 + fq * 4;
          if (col < PROJW) {
            u32x2 w; w[0] = pack2(acc[m][n][0], acc[m][n][1]); w[1] = pack2(acc[m][n][2], acc[m][n][3]);
            *(u32x2*)(proj + (size_t)row * PROJW + col) = w;
          } else if (col < INC) {
            *(f32x4*)(ba + (size_t)row * 8 + (col - PROJW)) = acc[m][n];
          }
        }
      if (n0 == OFF_SV) {
#pragma unroll
        for (int m = 0; m < 4; ++m)
#pragma unroll
          for (int n = 0; n < 4; ++n) {
            const int row = m0 + wr * 64 + m * 16 + fr, c = wc * 64 + n * 16 + fq * 4;
            const int bb = row / SEQ, t = row % SEQ;
#pragma unroll
            for (int r = 0; r < 4; ++r) vt[((size_t)(bb * 128 + c + r)) * SEQ + t] = (bf16_t)f2bf(acc[m][n][r]);
          }
      }
    }
  });
}

__device__ __forceinline__ bf16x8 pack8(f32x4 a, f32x4 b) {
  union { bf16x8 v; unsigned u[4]; } x;
  x.u[0] = pack2(a[0], a[1]); x.u[1] = pack2(a[2], a[3]); x.u[2] = pack2(b[0], b[1]); x.u[3] = pack2(b[2], b[3]);
  return x.v;
}
__device__ __forceinline__ void ph_dnchunk(unsigned char* smem, int item, const bf16_t* __restrict__ proj, const float* __restrict__ ba, const float* __restrict__ conv_w,
                                           const float* __restrict__ a_log, const float* __restrict__ dt_bias,
                                           bf16_t* __restrict__ QD, bf16_t* __restrict__ W0N, bf16_t* __restrict__ KTT, bf16_t* __restrict__ RV,
                                           bf16_t* __restrict__ TM, bf16_t* __restrict__ ATT, float* __restrict__ GL) {
  const int tid = TIDX, lane = tid & 63, w = tid >> 6, fr = lane & 15, fq = lane >> 4;
  const int n = item & 63, h = (item >> 6) & 3, b = item >> 8;
  const int t0 = n * 64; const size_t row0 = (size_t)b * SEQ + t0;
  unsigned char* qs = smem; unsigned char* ks = smem + 16384; float* AT = (float*)(smem + 32768);
  const float scale = 0.08838834764831845f;
  float bL, gcL;
  {
    const float* bap = ba + (row0 + lane) * 8;
    bL = sigmoidf(bap[h]);
    const float xx = bap[4 + h] + dt_bias[h];
    const float sp = fmaxf(xx, 0.f) + log1pf(__expf(-fabsf(xx)));
    float gg = -__expf(a_log[h]) * sp;
#pragma unroll
    for (int o = 1; o < 64; o <<= 1) { const float v = __shfl_up(gg, o); if (lane >= o) gg += v; }
    gcL = gg;
  }
  {
    const int d = 2 * lane;
    float cw[3][4][2];
#pragma unroll
    for (int mx = 0; mx < 3; ++mx)
#pragma unroll
      for (int j = 0; j < 4; ++j) {
        const float2 c2 = *(const float2*)(conv_w + j * 1536 + mx * 512 + h * 128 + d);
        cw[mx][j][0] = c2.x; cw[mx][j][1] = c2.y;
      }
    const bf16_t* pbase = proj + (row0 + 16 * w) * PROJW + h * 128 + d;
    unsigned raw[3][19];
#pragma unroll
    for (int j = 0; j < 19; ++j) {
      const bool ok = (t0 + 16 * w - 3 + j) >= 0;
#pragma unroll
      for (int mx = 0; mx < 3; ++mx) {
        unsigned u = 0;
        if (ok) u = *(const unsigned*)(pbase + (ptrdiff_t)(j - 3) * PROJW + mx * 512);
        raw[mx][j] = u;
      }
    }
#pragma unroll
    for (int i = 0; i < 16; ++i) {
      float s[3][2];
#pragma unroll
      for (int mx = 0; mx < 3; ++mx) {
        float y0 = 0.f, y1 = 0.f;
#pragma unroll
        for (int j = 0; j < 4; ++j) { y0 += cw[mx][j][0] * bflo(raw[mx][i + j]); y1 += cw[mx][j][1] * bfhi(raw[mx][i + j]); }
        s[mx][0] = siluf(y0); s[mx][1] = siluf(y1);
      }
      const int row = 16 * w + i;
      const float rq = rsqrtf(wave_sum(s[0][0] * s[0][0] + s[0][1] * s[0][1]) + L2_EPS);
      const float rk = rsqrtf(wave_sum(s[1][0] * s[1][0] + s[1][1] * s[1][1]) + L2_EPS);
      const int off = row * 256 + ((((lane >> 2) ^ (row & 15))) << 4) + (lane & 3) * 4;
      *(unsigned*)(qs + off) = pack2(s[0][0] * rq, s[0][1] * rq);
      *(unsigned*)(ks + off) = pack2(s[1][0] * rk, s[1][1] * rk);
      const float bi = __shfl(bL, row);
      *(unsigned*)(RV + ((size_t)item * 64 + row) * 128 + d) = pack2(bi * s[2][0], bi * s[2][1]);
    }
  }
  __syncthreads();
  {
    f32x4 aKK[4], aQK[4];
#pragma unroll
    for (int nt = 0; nt < 4; ++nt) { aKK[nt] = (f32x4){0.f, 0.f, 0.f, 0.f}; aQK[nt] = (f32x4){0.f, 0.f, 0.f, 0.f}; }
#pragma unroll
    for (int k4 = 0; k4 < 4; ++k4) {
      const int arow = 16 * w + fr;
      const bf16x8 aq = *(const bf16x8*)(qs + arow * 256 + ((((k4 * 4 + fq) ^ (arow & 15))) << 4));
      const bf16x8 ak = *(const bf16x8*)(ks + arow * 256 + ((((k4 * 4 + fq) ^ (arow & 15))) << 4));
#pragma unroll
      for (int nt = 0; nt < 4; ++nt) {
        const int brow = 16 * nt + fr;
        const bf16x8 bk = *(const bf16x8*)(ks + brow * 256 + ((((k4 * 4 + fq) ^ (brow & 15))) << 4));
        aKK[nt] = __builtin_amdgcn_mfma_f32_16x16x32_bf16(ak, bk, aKK[nt], 0, 0, 0);
        aQK[nt] = __builtin_amdgcn_mfma_f32_16x16x32_bf16(aq, bk, aQK[nt], 0, 0, 0);
      }
    }
    float gci[4], bi[4];
#pragma unroll
    for (int r = 0; r < 4; ++r) { gci[r] = __shfl(gcL, 16 * w + 4 * fq + r); bi[r] = __shfl(bL, 16 * w + 4 * fq + r); }
#pragma unroll
    for (int nt = 0; nt < 4; ++nt) {
      const int j = 16 * nt + fr;
      const float gcj = __shfl(gcL, j);
      const int p = 32 * (nt >> 1) + 8 * (fr >> 2) + 4 * (nt & 1) + (fr & 3);
      float av[4];
#pragma unroll
      for (int r = 0; r < 4; ++r) {
        const int i = 16 * w + 4 * fq + r;
        const float dec = (j <= i) ? __expf(gci[r] - gcj) : 0.f;
        av[r] = (j < i) ? bi[r] * aKK[nt][r] * dec : 0.f;
        ATT[((size_t)item * 64 + i) * 64 + p] = (bf16_t)f2bf(aQK[nt][r] * scale * dec);
      }
      *(float4*)(AT + j * 68 + 16 * w + 4 * fq) = make_float4(av[0], av[1], av[2], av[3]);
    }
  }
  __syncthreads();
  if (w == 0) {
    float Tr[64];
    int ln = lane; asm volatile("" : "+v"(ln));
#pragma unroll
    for (int j = 0; j < 64; ++j) Tr[j] = 0.f;
    f32x4 cur[16], nxt[16];
#pragma unroll
    for (int j4 = 0; j4 < 16; ++j4) nxt[j4] = (f32x4){0.f, 0.f, 0.f, 0.f};
#pragma unroll
    for (int j4 = 15; j4 >= 16; --j4) cur[j4] = *(const f32x4*)(AT + 63 * 68 + j4 * 4);
#pragma unroll
    for (int c = 63; c >= 0; --c) {
      if (c > 0) {
#pragma unroll
        for (int j4 = 15; j4 >= c / 4; --j4) nxt[j4] = *(const f32x4*)(AT + (c - 1) * 68 + j4 * 4);
      }
      float a0 = 0.f, a1 = 0.f, a2 = 0.f, a3 = 0.f;
#pragma unroll
      for (int j4 = 15; j4 >= (c + 1) / 4; --j4) {
        asm volatile("v_fmac_f32 %0, %1, %2" : "+v"(a0) : "v"(Tr[4 * j4 + 0]), "v"(cur[j4][0]));
        asm volatile("v_fmac_f32 %0, %1, %2" : "+v"(a1) : "v"(Tr[4 * j4 + 1]), "v"(cur[j4][1]));
        asm volatile("v_fmac_f32 %0, %1, %2" : "+v"(a2) : "v"(Tr[4 * j4 + 2]), "v"(cur[j4][2]));
        asm volatile("v_fmac_f32 %0, %1, %2" : "+v"(a3) : "v"(Tr[4 * j4 + 3]), "v"(cur[j4][3]));
      }
      Tr[c] = ((ln == c) ? 1.f : 0.f) - ((a0 + a1) + (a2 + a3));
#pragma unroll
      for (int j4 = 0; j4 < 16; ++j4) cur[j4] = nxt[j4];
    }
    u32x4* tp = (u32x4*)(TM + ((size_t)item * 64 + lane) * 64);
#pragma unroll
    for (int oc = 0; oc < 8; ++oc) {
      const int k0 = 32 * (oc >> 2) + 4 * (oc & 3);
      u32x4 v;
      v[0] = pack2(Tr[k0 + 0], Tr[k0 + 1]); v[1] = pack2(Tr[k0 + 2], Tr[k0 + 3]);
      v[2] = pack2(Tr[k0 + 16], Tr[k0 + 17]); v[3] = pack2(Tr[k0 + 18], Tr[k0 + 19]);
      tp[oc] = v;
    }
  } else {
    const float gclast = __shfl(gcL, 63);
    if (tid == 64) GL[item] = __expf(gclast);
#pragma unroll 1
    for (int it = 0; it < 16; ++it) {
      const int idx = (tid - 64) + it * 192;
      const int mtx = idx >> 10, rem = idx & 1023;
      if (mtx < 2) {
        const int i = rem >> 4, oc = rem & 15;
        const float gi = __shfl(gcL, i), bi = __shfl(bL, i);
        const float f = (mtx == 0) ? scale * __expf(gi) : -bi * __expf(gi);
        const unsigned char* st = (mtx == 0) ? qs : ks;
        const int d0 = 32 * (oc >> 2) + 4 * (oc & 3);
        const uint2 lo = *(const uint2*)(st + i * 256 + ((((d0 >> 3) ^ (i & 15))) << 4) + (d0 & 7) * 2);
        const uint2 hi = *(const uint2*)(st + i * 256 + (((((d0 + 16) >> 3) ^ (i & 15))) << 4) + (d0 & 7) * 2);
        u32x4 v;
        v[0] = pack2(bflo(lo.x) * f, bfhi(lo.x) * f); v[1] = pack2(bflo(lo.y) * f, bfhi(lo.y) * f);
        v[2] = pack2(bflo(hi.x) * f, bfhi(hi.x) * f); v[3] = pack2(bflo(hi.y) * f, bfhi(hi.y) * f);
        bf16_t* dst = ((mtx == 0) ? QD : W0N) + ((size_t)item * 64 + i) * 128 + 8 * oc;
        *(u32x4*)dst = v;
      } else {
        const int d = rem & 127, oc = rem >> 7;
        const int j0 = 32 * (oc >> 2) + 4 * (oc & 3);
        float val[8];
#pragma unroll
        for (int e = 0; e < 8; ++e) {
          const int j = j0 + (e & 3) + ((e >> 2) << 4);
          const float f = __expf(gclast - __shfl(gcL, j));
          const unsigned short raw = *(const unsigned short*)(ks + j * 256 + ((((d >> 3) ^ (j & 15))) << 4) + (d & 7) * 2);
          val[e] = bf2f(raw) * f;
        }
        u32x4 v;
        v[0] = pack2(val[0], val[1]); v[1] = pack2(val[2], val[3]); v[2] = pack2(val[4], val[5]); v[3] = pack2(val[6], val[7]);
        *(u32x4*)(KTT + ((size_t)item * 128 + d) * 64 + 8 * oc) = v;
      }
    }
  }
  __syncthreads();
}

__device__ __forceinline__ void ph_dnscan(unsigned char* smem, int item, const bf16_t* __restrict__ QDp, const bf16_t* __restrict__ W0Np, const bf16_t* __restrict__ KTTp,
                                          const bf16_t* __restrict__ RVp, const bf16_t* __restrict__ TMp, const bf16_t* __restrict__ ATTp, const float* __restrict__ GLp,
                                          float* __restrict__ op) {
  const int tid = TIDX, lane = tid & 63, w = tid >> 6, fr = lane & 15, fq = lane >> 4;
  const int bh = item >> 1, half = item & 1, b = bh >> 2, h = bh & 3;
  const int vcol0 = (half * 4 + w) * 16;
  unsigned char* sW0 = smem; unsigned char* sQD = smem + 16384; unsigned char* sKT = smem + 32768; unsigned char* sT = smem + 49152; unsigned char* sAT = smem + 57344;
  f32x4 S[8];
#pragma unroll
  for (int t = 0; t < 8; ++t) S[t] = (f32x4){0.f, 0.f, 0.f, 0.f};
  u32x4 pfA[8], pfB[8]; unsigned short rvp[16];
#define DN_LOAD_A(nn_) do { \
    const size_t ci = (size_t)bh * 64 + (nn_); \
    _Pragma("unroll") for (int i = 0; i < 4; ++i) pfA[i] = *(const u32x4*)((const char*)W0Np + ci * 16384 + (size_t)(tid + 256 * i) * 16); \
    _Pragma("unroll") for (int i = 0; i < 4; ++i) pfA[4 + i] = *(const u32x4*)((const char*)QDp + ci * 16384 + (size_t)(tid + 256 * i) * 16); \
    _Pragma("unroll") for (int mt = 0; mt < 4; ++mt) \
      _Pragma("unroll") for (int r = 0; r < 4; ++r) rvp[mt * 4 + r] = RVp[(ci * 64 + 16 * mt + 4 * fq + r) * 128 + vcol0 + fr]; \
  } while (0)
#define DN_STORE_A() do { \
    _Pragma("unroll") for (int i = 0; i < 4; ++i) { const int q = tid + 256 * i, row = q >> 4, ch = q & 15; *(u32x4*)(sW0 + row * 256 + ((ch ^ (row & 15)) << 4)) = pfA[i]; } \
    _Pragma("unroll") for (int i = 0; i < 4; ++i) { const int q = tid + 256 * i, row = q >> 4, ch = q & 15; *(u32x4*)(sQD + row * 256 + ((ch ^ (row & 15)) << 4)) = pfA[4 + i]; } \
  } while (0)
#define DN_LOAD_B(nn_) do { \
    const size_t ci = (size_t)bh * 64 + (nn_); \
    _Pragma("unroll") for (int i = 0; i < 4; ++i) pfB[i] = *(const u32x4*)((const char*)KTTp + ci * 16384 + (size_t)(tid + 256 * i) * 16); \
    _Pragma("unroll") for (int i = 0; i < 2; ++i) pfB[4 + i] = *(const u32x4*)((const char*)TMp + ci * 8192 + (size_t)(tid + 256 * i) * 16); \
    _Pragma("unroll") for (int i = 0; i < 2; ++i) pfB[6 + i] = *(const u32x4*)((const char*)ATTp + ci * 8192 + (size_t)(tid + 256 * i) * 16); \
  } while (0)
#define DN_STORE_B() do { \
    _Pragma("unroll") for (int i = 0; i < 4; ++i) { const int q = tid + 256 * i, row = q >> 3, ch = q & 7; *(u32x4*)(sKT + row * 128 + ((ch ^ (row & 7)) << 4)) = pfB[i]; } \
    _Pragma("unroll") for (int i = 0; i < 2; ++i) { const int q = tid + 256 * i, row = q >> 3, ch = q & 7; *(u32x4*)(sT + row * 128 + ((ch ^ (row & 7)) << 4)) = pfB[4 + i]; } \
    _Pragma("unroll") for (int i = 0; i < 2; ++i) { const int q = tid + 256 * i, row = q >> 3, ch = q & 7; *(u32x4*)(sAT + row * 128 + ((ch ^ (row & 7)) << 4)) = pfB[6 + i]; } \
  } while (0)
#define DN_ZINIT() do { _Pragma("unroll") for (int mt = 0; mt < 4; ++mt) Z[mt] = (f32x4){bf2f(rvp[mt * 4 + 0]), bf2f(rvp[mt * 4 + 1]), bf2f(rvp[mt * 4 + 2]), bf2f(rvp[mt * 4 + 3])}; } while (0)
  __syncthreads();
  f32x4 Z[4];
  DN_LOAD_A(0);
  DN_LOAD_B(0);
  DN_STORE_A();
  DN_ZINIT();
  DN_LOAD_A(1);
  for (int nn = 0; nn < 64; ++nn) {
    const float gl = GLp[(size_t)bh * 64 + nn];
    __syncthreads();
    bf16x8 Sb[4];
#pragma unroll
    for (int k4 = 0; k4 < 4; ++k4) Sb[k4] = pack8(S[2 * k4], S[2 * k4 + 1]);
    f32x4 O[4];
#pragma unroll
    for (int mt = 0; mt < 4; ++mt) {
      O[mt] = (f32x4){0.f, 0.f, 0.f, 0.f};
      const int row = 16 * mt + fr;
#pragma unroll
      for (int k4 = 0; k4 < 4; ++k4) {
        const int off = row * 256 + ((((k4 * 4 + fq) ^ fr)) << 4);
        const bf16x8 aw = *(const bf16x8*)(sW0 + off);
        const bf16x8 aq = *(const bf16x8*)(sQD + off);
        Z[mt] = __builtin_amdgcn_mfma_f32_16x16x32_bf16(aw, Sb[k4], Z[mt], 0, 0, 0);
        O[mt] = __builtin_amdgcn_mfma_f32_16x16x32_bf16(aq, Sb[k4], O[mt], 0, 0, 0);
      }
    }
    bf16x8 Zb[2];
    Zb[0] = pack8(Z[0], Z[1]); Zb[1] = pack8(Z[2], Z[3]);
    DN_STORE_B();
    if (nn + 1 < 64) DN_LOAD_B(nn + 1);
    __syncthreads();
    f32x4 Vn[4];
#pragma unroll
    for (int mt = 0; mt < 4; ++mt) {
      Vn[mt] = (f32x4){0.f, 0.f, 0.f, 0.f};
      const int row = 16 * mt + fr;
#pragma unroll
      for (int s = 0; s < 2; ++s) {
        if (s <= (mt >> 1)) {
          const bf16x8 at = *(const bf16x8*)(sT + row * 128 + ((((s * 4 + fq) ^ (row & 7))) << 4));
          Vn[mt] = __builtin_amdgcn_mfma_f32_16x16x32_bf16(at, Zb[s], Vn[mt], 0, 0, 0);
        }
      }
    }
    bf16x8 Vb[2];
    Vb[0] = pack8(Vn[0], Vn[1]); Vb[1] = pack8(Vn[2], Vn[3]);
#pragma unroll
    for (int mt = 0; mt < 4; ++mt) {
      const int row = 16 * mt + fr;
#pragma unroll
      for (int s = 0; s < 2; ++s) {
        if (s <= (mt >> 1)) {
          const bf16x8 aa = *(const bf16x8*)(sAT + row * 128 + ((((s * 4 + fq) ^ (row & 7))) << 4));
          O[mt] = __builtin_amdgcn_mfma_f32_16x16x32_bf16(aa, Vb[s], O[mt], 0, 0, 0);
        }
      }
      const size_t tok = (size_t)b * SEQ + nn * 64 + 16 * mt + 4 * fq;
#pragma unroll
      for (int r = 0; r < 4; ++r) op[(tok + r) * 512 + h * 128 + vcol0 + fr] = O[mt][r];
    }
#pragma unroll
    for (int t = 0; t < 8; ++t) {
      S[t] = S[t] * gl;
      const int row = 16 * t + fr;
#pragma unroll
      for (int s = 0; s < 2; ++s) {
        const bf16x8 ak = *(const bf16x8*)(sKT + row * 128 + ((((s * 4 + fq) ^ (row & 7))) << 4));
        S[t] = __builtin_amdgcn_mfma_f32_16x16x32_bf16(ak, Vb[s], S[t], 0, 0, 0);
      }
    }
    if (nn + 1 < 64) {
      DN_STORE_A();
      DN_ZINIT();
      if (nn + 2 < 64) DN_LOAD_A(nn + 2);
    }
  }
  __syncthreads();
#undef DN_ZINIT
#undef DN_LOAD_A
#undef DN_STORE_A
#undef DN_LOAD_B
#undef DN_STORE_B
}

__device__ __forceinline__ void ph_dn_post(int item, const float* __restrict__ o, const bf16_t* __restrict__ proj, const float* __restrict__ dn_norm_g, bf16_t* __restrict__ mixed) {
  const int tid = TIDX, h = tid >> 6, lane = tid & 63;
  const float2 g2 = *(const float2*)(dn_norm_g + 2 * lane);
  float2 ov[4]; unsigned zv[4];
#pragma unroll
  for (int i = 0; i < 4; ++i) {
    const size_t n = (size_t)item * 4 + i;
    ov[i] = *(const float2*)(o + n * 512 + h * 128 + 2 * lane);
    zv[i] = *(const unsigned*)(proj + n * PROJW + OFF_Z + h * 128 + 2 * lane);
  }
#pragma unroll
  for (int i = 0; i < 4; ++i) {
    const size_t n = (size_t)item * 4 + i;
    const float ss = wave_sum(ov[i].x * ov[i].x + ov[i].y * ov[i].y);
    const float rn = rsqrtf(ss * (1.f / 128.f) + RMS_EPS);
    *(unsigned*)(mixed + n * DM + h * 128 + 2 * lane) = pack2(ov[i].x * rn * g2.x * siluf(bflo(zv[i])), ov[i].y * rn * g2.y * siluf(bfhi(zv[i])));
  }
}

__device__ __forceinline__ void ph_swa(unsigned char* smem, int item, const bf16_t* __restrict__ proj, const bf16_t* __restrict__ vt, const float* __restrict__ sinks, bf16_t* __restrict__ mixed) {
  const int tid = TIDX, lane = tid & 63, w = tid >> 6, fr = lane & 15, fq = lane >> 4;
  const int qb = item & 31, kvh = (item >> 5) & 1, b = item >> 6;
  const int t0 = qb * 128;
  const size_t rowb = (size_t)b * SEQ;
  unsigned char* sK = smem;
  unsigned char* sV = smem + 32768;
  __syncthreads();
#pragma unroll
  for (int i = 0; i < 8; ++i) {
    const int q = tid + 256 * i, row = q >> 3, ch = q & 7;
    const int pos = t0 - 128 + row;
    u32x4 v = (u32x4){0u, 0u, 0u, 0u};
    if (pos >= 0) v = *(const u32x4*)(proj + (rowb + pos) * PROJW + OFF_SK + kvh * 64 + ch * 8);
    *(u32x4*)(sK + row * 128 + ((ch ^ (row & 7)) << 4)) = v;
  }
#pragma unroll
  for (int i = 0; i < 8; ++i) {
    const int q = tid + 256 * i, row = q >> 5, ch = q & 31;
    const int pos = t0 - 128 + ch * 8;
    u32x4 v = (u32x4){0u, 0u, 0u, 0u};
    if (pos >= 0) v = *(const u32x4*)(vt + ((size_t)(b * 128 + kvh * 64 + row)) * SEQ + pos);
    *(u32x4*)(sV + row * 512 + ((ch ^ (row & 15)) << 4)) = v;
  }
  __syncthreads();
  const int head = kvh * 4 + w;
  const float slope = exp2f(-(float)(head + 1));
  const float sink = sinks[head];
  const bf16_t* qp0 = proj + (rowb + t0 + fr) * PROJW + OFF_SQ + head * 64 + fq * 8;
  bf16x8 qn0 = *(const bf16x8*)(qp0), qn1 = *(const bf16x8*)(qp0 + 32);
#pragma unroll 1
  for (int qt = 0; qt < 8; ++qt) {
    const bf16x8 qf0 = qn0, qf1 = qn1;
    if (qt < 7) { const bf16_t* qp = qp0 + (size_t)(qt + 1) * 16 * PROJW; qn0 = *(const bf16x8*)(qp); qn1 = *(const bf16x8*)(qp + 32); }
    const int kp0 = qt >> 1;
    f32x4 st[10];
#pragma unroll
    for (int kt = 0; kt < 10; ++kt) {
      const int krow = (2 * kp0 + kt) * 16 + fr;
      st[kt] = (f32x4){0.f, 0.f, 0.f, 0.f};
      const bf16x8 k0 = *(const bf16x8*)(sK + krow * 128 + (((0 + fq) ^ (krow & 7)) << 4));
      const bf16x8 k1 = *(const bf16x8*)(sK + krow * 128 + (((4 + fq) ^ (krow & 7)) << 4));
      st[kt] = __builtin_amdgcn_mfma_f32_16x16x32_bf16(k0, qf0, st[kt], 0, 0, 0);
      st[kt] = __builtin_amdgcn_mfma_f32_16x16x32_bf16(k1, qf1, st[kt], 0, 0, 0);
    }
    const int i = qt * 16 + fr;
    float mx = sink;
#pragma unroll
    for (int kt = 0; kt < 10; ++kt)
#pragma unroll
      for (int r = 0; r < 4; ++r) {
        const int jb = (2 * kp0 + kt) * 16 + 4 * fq + r;
        const int dist = 128 + i - jb;
        const bool ok = (dist >= 0) && (dist < 128) && (t0 - 128 + jb >= 0);
        const float s = ok ? (st[kt][r] * 0.125f - slope * (float)dist) : -INFINITY;
        st[kt][r] = s;
        mx = fmaxf(mx, s);
      }
    mx = fmaxf(mx, __shfl_xor(mx, 16));
    mx = fmaxf(mx, __shfl_xor(mx, 32));
    float sum = 0.f;
#pragma unroll
    for (int kt = 0; kt < 10; ++kt)
#pragma unroll
      for (int r = 0; r < 4; ++r) { const float p = __expf(st[kt][r] - mx); st[kt][r] = p; sum += p; }
    sum += __shfl_xor(sum, 16);
    sum += __shfl_xor(sum, 32);
    const float inv = 1.f / (sum + __expf(sink - mx));
    f32x4 O[4];
#pragma unroll
    for (int nt = 0; nt < 4; ++nt) O[nt] = (f32x4){0.f, 0.f, 0.f, 0.f};
#pragma unroll
    for (int s5 = 0; s5 < 5; ++s5) {
      const bf16x8 pa = pack8(st[2 * s5] * inv, st[2 * s5 + 1] * inv);
      const int key0 = (2 * kp0 + 2 * s5) * 16 + 4 * fq;
#pragma unroll
      for (int nt = 0; nt < 4; ++nt) {
        const int drow = nt * 16 + fr;
        const int c0 = key0 >> 3, c1 = (key0 + 16) >> 3;
        const u32x2 lo = *(const u32x2*)(sV + drow * 512 + ((c0 ^ (drow & 15)) << 4) + ((key0 >> 2) & 1) * 8);
        const u32x2 hi = *(const u32x2*)(sV + drow * 512 + ((c1 ^ (drow & 15)) << 4) + ((key0 >> 2) & 1) * 8);
        const u32x4 vb = (u32x4){lo[0], lo[1], hi[0], hi[1]};
        O[nt] = __builtin_amdgcn_mfma_f32_16x16x32_bf16(pa, __builtin_bit_cast(bf16x8, vb), O[nt], 0, 0, 0);
      }
    }
#pragma unroll
    for (int nt = 0; nt < 4; ++nt)
#pragma unroll
      for (int r = 0; r < 4; ++r)
        mixed[(rowb + t0 + qt * 16 + 4 * fq + r) * DM + 512 + head * 64 + nt * 16 + fr] = (bf16_t)f2bf(O[nt][r]);
  }
}

__device__ __forceinline__ void ph_wout(unsigned char* smem, int xcd, int l, const bf16_t* __restrict__ mixed, const bf16_t* __restrict__ wt, const float* __restrict__ x, float* __restrict__ y1) {
  const int mi = l >> 3, ni = l & 7;
  LdRowBF16 al; al.init([&](int r) { return mixed + (size_t)((xcd * 32 + mi) * 128 + r) * DM; }, (size_t)8 * 128 * DM * 2);
  LdRowBF16 bl; bl.init([&](int r) { return wt + (size_t)(ni * 128 + r) * DM; }, 0);
  gemm_stream<16>(smem, al, bl, 4, [&](int seg, f32x4 (&acc)[4][4]) {
    GEMM_IDS
    const int m0 = (xcd * 32 + seg * 8 + mi) * 128, n0 = ni * 128;
#pragma unroll
    for (int m = 0; m < 4; ++m)
#pragma unroll
      for (int n = 0; n < 4; ++n) {
        const size_t idx = (size_t)(m0 + wr * 64 + m * 16 + fr) * DM + n0 + wc * 64 + n * 16 + fq * 4;
        const f32x4 xv = *(const f32x4*)(x + idx);
        *(f32x4*)(y1 + idx) = xv * ALPHA + acc[m][n];
      }
  });
}

__device__ __forceinline__ void ph_ln1(int item, float* __restrict__ y, const float* __restrict__ gam, const float* __restrict__ bet, bf16_t* __restrict__ xbf) {
  const int row = item * 4 + (TIDX >> 6), lane = TIDX & 63;
  float4* p = (float4*)(y + (size_t)row * DM);
  float4 v[4]; float s = 0.f;
#pragma unroll
  for (int i = 0; i < 4; ++i) { v[i] = p[lane + i * 64]; s += v[i].x + v[i].y + v[i].z + v[i].w; }
  const float mu = wave_sum(s) * (1.f / DM);
  float q = 0.f;
#pragma unroll
  for (int i = 0; i < 4; ++i) { const float a = v[i].x - mu, b = v[i].y - mu, c = v[i].z - mu, d = v[i].w - mu; q += a * a + b * b + c * c + d * d; }
  const float rs = rsqrtf(wave_sum(q) * (1.f / DM) + LN_EPS);
#pragma unroll
  for (int i = 0; i < 4; ++i) {
    const float4 gg = ((const float4*)gam)[lane + i * 64], bb = ((const float4*)bet)[lane + i * 64];
    float4 r;
    r.x = (v[i].x - mu) * rs * gg.x + bb.x; r.y = (v[i].y - mu) * rs * gg.y + bb.y;
    r.z = (v[i].z - mu) * rs * gg.z + bb.z; r.w = (v[i].w - mu) * rs * gg.w + bb.w;
    p[lane + i * 64] = r;
    u32x2 w; w[0] = pack2(r.x, r.y); w[1] = pack2(r.z, r.w);
    ((u32x2*)(xbf + (size_t)row * DM))[lane + i * 64] = w;
  }
}

__device__ __forceinline__ void ph_router(unsigned char* smem, int tile, const bf16_t* __restrict__ xbf, const bf16_t* __restrict__ wt, float* __restrict__ logits) {
  GEMM_IDS
  const int n0 = (tile & 1) * 128, m0 = (tile >> 1) * 128;
  LdRowBF16 al; al.init([&](int r) { return xbf + (size_t)(m0 + r) * DM; }, 0);
  LdRowBF16 bl; bl.init([&](int r) { return wt + (size_t)(n0 + r) * DM; }, 0);
  gemm_stream<16>(smem, al, bl, 1, [&](int seg, f32x4 (&acc)[4][4]) {
    GEMM_IDS
#pragma unroll
    for (int m = 0; m < 4; ++m)
#pragma unroll
      for (int n = 0; n < 4; ++n)
        *(f32x4*)(logits + (size_t)(m0 + wr * 64 + m * 16 + fr) * NEXP + n0 + wc * 64 + n * 16 + fq * 4) = acc[m][n];
  });
}

__device__ __forceinline__ void ph_route(int item, const float* __restrict__ logits, const float* __restrict__ router_bias, int* __restrict__ cnt, int* __restrict__ list, float* __restrict__ gates) {
  const int n = item * 4 + (TIDX >> 6), lane = TIDX & 63;
  const float4 lg = ((const float4*)(logits + (size_t)n * NEXP))[lane];
  const float4 rb = ((const float4*)router_bias)[lane];
  float sc[4] = {sigmoidf(lg.x), sigmoidf(lg.y), sigmoidf(lg.z), sigmoidf(lg.w)};
  float sel[4] = {sc[0] + rb.x, sc[1] + rb.y, sc[2] + rb.z, sc[3] + rb.w};
  float t1 = fmaxf(sel[0], sel[1]), t2 = fminf(sel[0], sel[1]);
  { const float a = sel[2]; if (a > t1) { t2 = t1; t1 = a; } else if (a > t2) t2 = a; }
  { const float a = sel[3]; if (a > t1) { t2 = t1; t1 = a; } else if (a > t2) t2 = a; }
#pragma unroll
  for (int o = 1; o < 8; o <<= 1) {
    const float b1 = __shfl_xor(t1, o), b2 = __shfl_xor(t2, o);
    const float n1 = fmaxf(t1, b1), n2 = fmaxf(fminf(t1, b1), fmaxf(t2, b2));
    t1 = n1; t2 = n2;
  }
  const float gs = t1 + t2;
  const int mygrp = lane >> 3;
  int rank = 0;
#pragma unroll
  for (int j = 0; j < 8; ++j) {
    const float o = __shfl(gs, j * 8);
    rank += (o > gs || (o == gs && j < mygrp)) ? 1 : 0;
  }
  const bool gsel = rank < 4;
  float cand[4];
#pragma unroll
  for (int i = 0; i < 4; ++i) cand[i] = gsel ? sel[i] : -INFINITY;
  float gsum = 0.f; float myg = 0.f; int mye = 0;
#pragma unroll 1
  for (int r = 0; r < TOPK; ++r) {
    float bv = cand[0]; int bi = 0;
#pragma unroll
    for (int i = 1; i < 4; ++i) if (cand[i] > bv) { bv = cand[i]; bi = i; }
    int be = lane * 4 + bi;
    float bs = (bi == 0) ? sc[0] : (bi == 1) ? sc[1] : (bi == 2) ? sc[2] : sc[3];
#pragma unroll
    for (int o = 1; o < 64; o <<= 1) {
      const float ov = __shfl_xor(bv, o); const int oe = __shfl_xor(be, o); const float os = __shfl_xor(bs, o);
      if (ov > bv || (ov == bv && oe < be)) { bv = ov; be = oe; bs = os; }
    }
    if ((be >> 2) == lane) {
      const int bi2 = be & 3;
      if (bi2 == 0) cand[0] = -INFINITY; else if (bi2 == 1) cand[1] = -INFINITY; else if (bi2 == 2) cand[2] = -INFINITY; else cand[3] = -INFINITY;
    }
    gsum += bs;
    if (lane == r) { myg = bs; mye = be; }
  }
  if (lane < TOPK) {
    const int slot = atomicAdd(&cnt[mye], 1);
    list[(size_t)mye * CAP + slot] = n * TOPK + lane;
    gates[(size_t)n * TOPK + lane] = myg / gsum * 2.5f;
  }
}

__device__ __forceinline__ void moe_build_prefix(const int* __restrict__ cnt, int* sscan) {
  const int tid = TIDX;
  const int e = ((tid & 31) << 3) | (tid >> 5);
  const int c = cnt[e];
  __syncthreads();
  sscan[tid] = (c + 127) >> 7;
  __syncthreads();
  for (int o = 1; o < 256; o <<= 1) {
    const int v = (tid >= o) ? sscan[tid - o] : 0;
    __syncthreads();
    sscan[tid] += v;
    __syncthreads();
  }
}
__device__ __forceinline__ void moe_locate(const int* sscan, int x, int lt, int& e, int& rt) {
  const int base = x ? sscan[32 * x - 1] : 0;
  const int nrouted = sscan[32 * x + 31] - base;
  if (lt >= nrouted) { e = 256; rt = x * (NTOK / 128 / 8) + (lt - nrouted); return; }
  const int g = base + lt;
  int lo = 32 * x, hi = 32 * x + 31;
  while (lo < hi) { const int mid = (lo + hi) >> 1; if (sscan[mid] > g) hi = mid; else lo = mid + 1; }
  e = ((lo & 31) << 3) | (lo >> 5); rt = g - (lo ? sscan[lo - 1] : 0);
}

__device__ __forceinline__ void ph_moe1(unsigned char* smem, int e, int rt, const bf16_t* __restrict__ xbf, const int* __restrict__ cnt, const int* __restrict__ list,
                                        const bf16_t* __restrict__ wge, const bf16_t* __restrict__ wue, bf16_t* __restrict__ hbuf) {
  int* sasg = (int*)(smem + SM_MISC + 2048);
  const int tid = TIDX;
  const int rows = (e < 256) ? cnt[e] : NTOK;
  __syncthreads();
  if (tid < 128) {
    const int r = rt * 128 + tid;
    int a = -1;
    if (r < rows) a = (e < 256) ? list[(size_t)e * CAP + r] : (NA + r);
    sasg[tid] = a;
  }
  __syncthreads();
  LdRowBF16 al; al.init([&](int r) { const int a = sasg[r]; const int tok = (a < 0) ? 0 : (a < NA ? (a >> 3) : (a - NA)); return xbf + (size_t)tok * DM; }, 0);
  LdRowBF16 bl; bl.init([&](int j) {
    const int bwc = j >> 6, bn = (j >> 4) & 3, ff = bwc * 32 + (bn >> 1) * 16 + (j & 15);
    return ((bn & 1) ? wue : wge) + (size_t)ff * DM; }, (size_t)64 * DM * 2);
  gemm_stream<16>(smem, al, bl, 4, [&](int ct, f32x4 (&acc)[4][4]) {
    GEMM_IDS
#pragma unroll
    for (int m = 0; m < 4; ++m) {
      const int a = sasg[wr * 64 + m * 16 + fr];
      if (a >= 0) {
#pragma unroll
        for (int pp = 0; pp < 2; ++pp) {
          float hv[4];
#pragma unroll
          for (int r = 0; r < 4; ++r) hv[r] = siluf(acc[m][2 * pp][r]) * acc[m][2 * pp + 1][r];
          u32x2 w; w[0] = pack2(hv[0], hv[1]); w[1] = pack2(hv[2], hv[3]);
          *(u32x2*)(hbuf + (size_t)a * EFF + ct * 64 + wc * 32 + pp * 16 + fq * 4) = w;
        }
      }
    }
  });
}

__device__ __forceinline__ void ph_moe2(unsigned char* smem, int e, int rt, const bf16_t* __restrict__ hbuf, const int* __restrict__ cnt, const int* __restrict__ list, const float* __restrict__ gates,
                                        const bf16_t* __restrict__ wde, bf16_t* __restrict__ ybuf, float* __restrict__ dout) {
  int* sasg = (int*)(smem + SM_MISC + 2048);
  float* sgate = (float*)(smem + SM_MISC + 2048 + 512);
  const int tid = TIDX;
  const int rows = (e < 256) ? cnt[e] : NTOK;
  __syncthreads();
  if (tid < 128) {
    const int r = rt * 128 + tid;
    int a = -1;
    if (r < rows) a = (e < 256) ? list[(size_t)e * CAP + r] : (NA + r);
    sasg[tid] = a;
    sgate[tid] = (a >= 0 && a < NA) ? gates[a] : 1.f;
  }
  __syncthreads();
  LdRowBF16 al; al.init([&](int r) { const int a = sasg[r]; return hbuf + (size_t)(a < 0 ? 0 : a) * EFF; }, 0);
  LdRowBF16 bl; bl.init([&](int j) { return wde + (size_t)j * EFF; }, (size_t)128 * EFF * 2);
  gemm_stream<4>(smem, al, bl, 8, [&](int ct, f32x4 (&acc)[4][4]) {
    GEMM_IDS
    const int n0 = ct * 128;
#pragma unroll
    for (int m = 0; m < 4; ++m) {
      const int r_ = wr * 64 + m * 16 + fr;
      const int a = sasg[r_];
      if (a >= NA) {
        float* dp = dout + (size_t)(a - NA) * DM + n0 + wc * 64 + fq * 4;
#pragma unroll
        for (int n = 0; n < 4; ++n) { const f32x4 xv = *(const f32x4*)(dp + n * 16); *(f32x4*)(dp + n * 16) = xv * ALPHA + acc[m][n]; }
      } else if (a >= 0) {
        const float gt = sgate[r_];
#pragma unroll
        for (int n = 0; n < 4; ++n) {
          u32x2 w; w[0] = pack2(acc[m][n][0] * gt, acc[m][n][1] * gt); w[1] = pack2(acc[m][n][2] * gt, acc[m][n][3] * gt);
          *(u32x2*)(ybuf + (size_t)a * DM + n0 + wc * 64 + n * 16 + fq * 4) = w;
        }
      }
    }
  });
}

__device__ __forceinline__ void ph_final(int item, float* __restrict__ out, const bf16_t* __restrict__ ybuf, const float* __restrict__ gam, const float* __restrict__ bet) {
  const int row = item * 4 + (TIDX >> 6), lane = TIDX & 63;
  float4* p = (float4*)(out + (size_t)row * DM);
  float4 v[4]; float s = 0.f;
#pragma unroll
  for (int i = 0; i < 4; ++i) {
    float4 a = p[lane + i * 64];
#pragma unroll
    for (int k = 0; k < 8; ++k) {
      const uint2 w = ((const uint2*)(ybuf + ((size_t)row * 8 + k) * DM))[lane + i * 64];
      a.x += bflo(w.x); a.y += bfhi(w.x); a.z += bflo(w.y); a.w += bfhi(w.y);
    }
    v[i] = a; s += a.x + a.y + a.z + a.w;
  }
  const float mu = wave_sum(s) * (1.f / DM);
  float q = 0.f;
#pragma unroll
  for (int i = 0; i < 4; ++i) { const float a = v[i].x - mu, b = v[i].y - mu, c = v[i].z - mu, d = v[i].w - mu; q += a * a + b * b + c * c + d * d; }
  const float rs = rsqrtf(wave_sum(q) * (1.f / DM) + LN_EPS);
#pragma unroll
  for (int i = 0; i < 4; ++i) {
    const float4 gg = ((const float4*)gam)[lane + i * 64], bb = ((const float4*)bet)[lane + i * 64];
    float4 r;
    r.x = (v[i].x - mu) * rs * gg.x + bb.x; r.y = (v[i].y - mu) * rs * gg.y + bb.y;
    r.z = (v[i].z - mu) * rs * gg.z + bb.z; r.w = (v[i].w - mu) * rs * gg.w + bb.w;
    p[lane + i * 64] = r;
  }
}

#define XB_TMO      128
#define XB_XCNT(j)  (256  + 64 * (j))
#define XB_XSUB(j)  (1280 + 64 * (j))
#define XB_XGEN(j)  (2304 + 64 * (j))
#define XB_TOP      3328
#define XB_TOPGEN   3392
#define XCD_BAR_WORDS 3456
#define XB_SPIN_CAP (1u << 22)
#define LAS __attribute__((address_space(3)))
__device__ __forceinline__ unsigned xb_ld(unsigned* p)              { return __hip_atomic_load(p, __ATOMIC_RELAXED, __HIP_MEMORY_SCOPE_AGENT); }
__device__ __forceinline__ unsigned xb_add(unsigned* p, unsigned v) { return __hip_atomic_fetch_add(p, v, __ATOMIC_RELAXED, __HIP_MEMORY_SCOPE_AGENT); }
__device__ __forceinline__ unsigned xb_xcc_id() { return (unsigned)__builtin_amdgcn_s_getreg((3 << 11) | 20) & 0xFu; }
#define XB_SPIN(cond, bar) do { unsigned _sp = 0; while (cond) { __builtin_amdgcn_s_sleep(1); \
    if ((++_sp & 255u) == 0u) { if (xb_ld(&(bar)[XB_TMO])) break; if (_sp > XB_SPIN_CAP) { atomicAdd(&(bar)[XB_TMO], 1u); break; } } } } while (0)
struct XcdBarrier { unsigned* bar; unsigned x; volatile LAS unsigned* st; };
__device__ __forceinline__ XcdBarrier xcd_barrier_post(unsigned* bar, volatile LAS unsigned* st) {
  XcdBarrier b; b.bar = bar; b.x = xb_xcc_id(); b.st = st;
  if (threadIdx.x == 0) (void)xb_add(&bar[XB_XCNT(b.x)], 1u);
  return b;
}
__device__ __forceinline__ void xcd_barrier_complete(unsigned* bar, unsigned x, unsigned& nloc, unsigned& nx) {
  const unsigned G = gridDim.x * gridDim.y * gridDim.z;
  unsigned sum, cnt, mine, sp = 0u;
  for (;;) {
    sum = 0u; cnt = 0u; mine = 0u;
#pragma unroll
    for (unsigned j = 0; j < 16; ++j) { const unsigned c = xb_ld(&bar[XB_XCNT(j)]); sum += c; cnt += (c > 0u) ? 1u : 0u; mine = (j == x) ? c : mine; }
    if (sum == G) break;
    __builtin_amdgcn_s_sleep(1);
    if ((++sp & 255u) == 0u) { if (xb_ld(&bar[XB_TMO])) break; if (sp > XB_SPIN_CAP) { atomicAdd(&bar[XB_TMO], 1u); break; } }
  }
  nloc = mine > 0u ? mine : 1u; nx = cnt > 0u ? cnt : 1u;
}
__device__ __forceinline__ void xcd_barrier(const XcdBarrier& b) {
  asm volatile("s_waitcnt vmcnt(0)" ::: "memory");
  __syncthreads();
  if (threadIdx.x == 0) {
    unsigned* bar = b.bar;
    __builtin_amdgcn_s_waitcnt(0);
    unsigned nloc = b.st[0], nx = b.st[1];
    if (nloc == 0u) { xcd_barrier_complete(bar, b.x, nloc, nx); b.st[0] = nloc; b.st[1] = nx; }
    const unsigned old = xb_add(&bar[XB_XSUB(b.x)], 1u);
    const unsigned gen = old / nloc;
    if (old + 1u == (gen + 1u) * nloc) {
      __builtin_amdgcn_fence(__ATOMIC_RELEASE, "agent");
      asm volatile("s_waitcnt vmcnt(0)" ::: "memory");
      const unsigned og = xb_add(&bar[XB_TOP], 1u);
      const unsigned tg = og / nx;
      if (og + 1u == (tg + 1u) * nx) xb_add(&bar[XB_TOPGEN], 1u);
      else XB_SPIN(xb_ld(&bar[XB_TOPGEN]) == tg, bar);
      __builtin_amdgcn_fence(__ATOMIC_ACQUIRE, "agent");
      xb_add(&bar[XB_XGEN(b.x)], 1u);
      asm volatile("s_waitcnt vmcnt(0)" ::: "memory");
    } else {
      XB_SPIN(xb_ld(&bar[XB_XGEN(b.x)]) == gen, bar);
      __builtin_amdgcn_fence(__ATOMIC_ACQUIRE, "agent");
      asm volatile("s_waitcnt vmcnt(0)" ::: "memory");
    }
  }
  __syncthreads();
}

__global__ void __launch_bounds__(256, 2) mega(Params P) {
  __shared__ __attribute__((aligned(16))) unsigned char smem[SMEM_BYTES];
  cg::grid_group grid = cg::this_grid();
  const int bid = blockIdx.x, nblk = gridDim.x;
#define xin (P.in[0])
#define w_in (P.in[1])
#define conv_w (P.in[2])
#define a_log (P.in[3])
#define dt_bias (P.in[4])
#define dn_norm_g (P.in[5])
#define sinks (P.in[6])
#define w_out (P.in[7])
#define ln1_g (P.in[8])
#define ln1_b (P.in[9])
#define router_w (P.in[10])
#define router_bias (P.in[11])
#define w_gate (P.in[12])
#define w_up (P.in[13])
#define w_down (P.in[14])
#define sw_gate (P.in[15])
#define sw_up (P.in[16])
#define sw_down (P.in[17])
#define ln2_g (P.in[18])
#define ln2_b (P.in[19])
#define outp (P.out)
#define x1bf ((bf16_t*)(P.ws + WS_X1BF))
#define logits ((float*)(P.ws + WS_LOGIT))
#define list ((int*)(P.ws + WS_LIST))
#define gates ((float*)(P.ws + WS_GATES))
#define cnt ((int*)(P.ws + WS_CTRL))
#define barw ((unsigned*)(P.ws + WS_CTRL + 4096))
#define mixed ((bf16_t*)(P.ws + WS_MIXED))
#define proj ((bf16_t*)(P.ws + WS_PROJ))
#define ba ((float*)(P.ws + WS_BA))
#define QD ((bf16_t*)(P.ws + WS_QD))
#define W0N ((bf16_t*)(P.ws + WS_W0N))
#define KTT ((bf16_t*)(P.ws + WS_KTT))
#define RV ((bf16_t*)(P.ws + WS_RV))
#define TM ((bf16_t*)(P.ws + WS_TM))
#define ATT ((bf16_t*)(P.ws + WS_ATT))
#define GL ((float*)(P.ws + WS_GL))
#define obuf ((float*)(P.ws + WS_O))
#define VTb ((bf16_t*)(P.ws + WS_VT))
#define XBF ((bf16_t*)(P.ws + WS_XBF))
#define WTIN ((bf16_t*)(P.ws + WS_WTIN))
#define WTOUT ((bf16_t*)(P.ws + WS_WTOUT))
#define WTR ((bf16_t*)(P.ws + WS_WTR))
#define WTG ((bf16_t*)(P.ws + WS_WTG))
#define WTU ((bf16_t*)(P.ws + WS_WTU))
#define WTD ((bf16_t*)(P.ws + WS_WTD))
#define WTSG ((bf16_t*)(P.ws + WS_WTSG))
#define WTSU ((bf16_t*)(P.ws + WS_WTSU))
#define WTSD ((bf16_t*)(P.ws + WS_WTSD))
#define hbuf ((bf16_t*)(P.ws + WS_HBUF))
#define ybuf ((bf16_t*)(P.ws + WS_YBUF))
  {
    volatile LAS unsigned* st0 = (volatile LAS unsigned*)(smem + SM_MISC + 4080);
    if (threadIdx.x == 0) { st0[0] = 0u; st0[1] = 0u; }
    __syncthreads();
  }
  const int xcd = bid & 7, xloc = bid >> 3, xnl = nblk >> 3;
  XcdBarrier xb = xcd_barrier_post(barw, (volatile LAS unsigned*)(smem + SM_MISC + 4080));
  for (int it = bid; it < NTOK / 4; it += nblk) ph_cvt_x(it, xin, XBF);
  for (int it = bid; it < 16 * 46 + 16 * 16 + 16 * 4; it += nblk) {
    if (it < 16 * 46) ph_cvt_wt(smem, it % 16, it / 16, w_in, DM, INC, WTIN);
    else if (it < 16 * 46 + 256) { const int j = it - 16 * 46; ph_cvt_wt(smem, j % 16, j / 16, w_out, DM, DM, WTOUT); }
    else { const int j = it - 16 * 46 - 256; ph_cvt_wt(smem, j % 16, j / 16, router_w, DM, NEXP, WTR); }
  }
  for (int it = bid; it < 192; it += nblk) {
    if (it < 64) ph_cvt_wt(smem, it % 16, it / 16, sw_gate, DM, EFF, WTSG);
    else if (it < 128) ph_cvt_wt(smem, (it - 64) % 16, (it - 64) / 16, sw_up, DM, EFF, WTSU);
    else ph_cvt_wt(smem, (it - 128) % 4, (it - 128) / 4, sw_down, EFF, DM, WTSD);
  }
  grid.sync();
  for (int l = xloc; l < 64; l += xnl) ph_proj(smem, xcd, l, XBF, WTIN, proj, ba, VTb);
  xcd_barrier(xb);
  for (int it = bid; it < 2048; it += nblk) ph_dnchunk(smem, it, proj, ba, conv_w, a_log, dt_bias, QD, W0N, KTT, RV, TM, ATT, GL);
  for (int it = bid; it < 512; it += nblk) ph_swa(smem, it, proj, VTb, sinks, mixed);
  xcd_barrier(xb);
  if (bid < 64 || nblk <= 64) {
    for (int it = bid; it < 64; it += nblk) ph_dnscan(smem, it, QD, W0N, KTT, RV, TM, ATT, GL, obuf);
  }
  if (bid >= 64 || nblk <= 64) {
    const int tid = TIDX, lane = tid & 63, wv = tid >> 6;
    float* tile = (float*)(smem + wv * 8448);
    const int nconv = (nblk > 64) ? (nblk - 64) : nblk, cb = (nblk > 64) ? (bid - 64) : bid;
    const int step = nconv * 4, total = 256 * 384;
    int it = cb * 4 + wv;
    f32x4 vc[8], vn[8];
    CvtTile tc = cvt_decode(it < total ? it : 0, lane, w_gate, w_up, w_down, WTG, WTU, WTD);
    if (it < total) cvt_load(tc, vc);
    while (it < total) {
      const int itn = it + step;
      CvtTile tn = cvt_decode(itn < total ? itn : 0, lane, w_gate, w_up, w_down, WTG, WTU, WTD);
      if (itn < total) cvt_load(tn, vn);
      cvt_store(tile, lane, tc, vc);
#pragma unroll
      for (int i = 0; i < 8; ++i) vc[i] = vn[i];
      tc = tn; it = itn;
    }
  }
  xcd_barrier(xb);
  for (int it = bid; it < NTOK / 4; it += nblk) ph_dn_post(it, obuf, proj, dn_norm_g, mixed);
  xcd_barrier(xb);
  for (int l = xloc; l < 64; l += xnl) ph_wout(smem, xcd, l, mixed, WTOUT, xin, outp);
  xcd_barrier(xb);
  for (int it = bid; it < NTOK / 4; it += nblk) ph_ln1(it, outp, ln1_g, ln1_b, x1bf);
  xcd_barrier(xb);
  for (int i = xloc; i < 32 * 2; i += xnl) ph_router(smem, (xcd * 32 + i / 2) * 2 + i % 2, x1bf, WTR, logits);
  xcd_barrier(xb);
  for (int it = bid; it < NTOK / 4; it += nblk) ph_route(it, logits, router_bias, cnt, list, gates);
  xcd_barrier(xb);
  int* sscan = (int*)(smem + SM_MISC);
  moe_build_prefix(cnt, sscan);
  const int ntile = sscan[32 * xcd + 31] - (xcd ? sscan[32 * xcd - 1] : 0) + NTOK / 128 / 8;
  for (int it = xloc; it < ntile; it += xnl) {
    int e, rt; moe_locate(sscan, xcd, it, e, rt);
    ph_moe1(smem, e, rt, x1bf, cnt, list, (e < 256) ? WTG + (size_t)e * EFF * DM : WTSG, (e < 256) ? WTU + (size_t)e * EFF * DM : WTSU, hbuf);
  }
  xcd_barrier(xb);
  for (int it = xloc; it < ntile; it += xnl) {
    int e, rt; moe_locate(sscan, xcd, it, e, rt);
    ph_moe2(smem, e, rt, hbuf, cnt, list, gates, (e < 256) ? WTD + (size_t)e * DM * EFF : WTSD, ybuf, outp);
  }
  xcd_barrier(xb);
  for (int it = bid; it < NTOK / 4; it += nblk) ph_final(it, outp, ybuf, ln2_g, ln2_b);
}

#undef xin
#undef w_in
#undef conv_w
#undef a_log
#undef dt_bias
#undef dn_norm_g
#undef sinks
#undef w_out
#undef ln1_g
#undef ln1_b
#undef router_w
#undef router_bias
#undef w_gate
#undef w_up
#undef w_down
#undef sw_gate
#undef sw_up
#undef sw_down
#undef ln2_g
#undef ln2_b
#undef outp
#undef x1bf
#undef logits
#undef list
#undef gates
#undef cnt
#undef mixed
#undef proj
#undef ba
#undef QD
#undef W0N
#undef KTT
#undef RV
#undef TM
#undef ATT
#undef GL
#undef obuf
#undef hbuf
#undef ybuf
#undef VTb
#undef XBF
#undef WTIN
#undef WTOUT
#undef WTR
#undef WTG
#undef WTU
#undef WTD
#undef WTSG
#undef WTSU
#undef WTSD
#undef barw

extern "C" void kernel_launch(void* const* d_in, const int* in_sizes, int n_in, void* d_out, int out_size, void* d_ws, size_t ws_size, hipStream_t stream) {
  static int grid_blocks = 0;
  if (!grid_blocks) {
    int dev = 0, cus = 0, per_cu = 0;
    (void)hipGetDevice(&dev);
    (void)hipDeviceGetAttribute(&cus, hipDeviceAttributeMultiprocessorCount, dev);
    (void)hipOccupancyMaxActiveBlocksPerMultiprocessor(&per_cu, mega, 256, 0);
    if (per_cu > 2) per_cu = 2;
    if (per_cu < 1) per_cu = 1;
    grid_blocks = cus * per_cu;
  }
  Params p{};
  for (int i = 0; i < 20; ++i) p.in[i] = (const float*)d_in[i];
  p.out = (float*)d_out; p.ws = (char*)d_ws;
  (void)hipMemsetAsync((char*)d_ws + WS_CTRL, 0, 4096 + XCD_BAR_WORDS * 4, stream);
  void* args[] = {&p};
  hipError_t e = hipLaunchCooperativeKernel((void*)mega, dim3(grid_blocks), dim3(256), args, 0, stream);
  if (e != hipSuccess) fprintf(stderr, "cooperative launch failed: %s (grid %d)\n", hipGetErrorString(e), grid_blocks);
}
```

```cpp
#include <hip/hip_runtime.h>
#include <hip/hip_cooperative_groups.h>
#include <stdint.h>
#include <stdio.h>
namespace cg = cooperative_groups;

typedef __attribute__((ext_vector_type(8))) short bf16x8;
typedef __attribute__((ext_vector_type(4))) float f32x4;
typedef unsigned short bf16_t;
typedef __attribute__((ext_vector_type(4))) unsigned u32x4;
typedef __attribute__((ext_vector_type(2))) unsigned u32x2;

constexpr int NTOK = 32768, SEQ = 4096, DM = 1024;
constexpr int INC = 2824, PROJW = 2816;
constexpr int OFF_DQ = 0, OFF_DK = 512, OFF_DV = 1024, OFF_SQ = 1536, OFF_SK = 2048, OFF_SV = 2176, OFF_Z = 2304;
constexpr int NEXP = 256, TOPK = 8, EFF = 256;
constexpr int NA = NTOK * TOPK;
constexpr int CAP = NTOK;
constexpr float ALPHA = 1.189207115002721f;
constexpr float LN_EPS = 1e-5f, RMS_EPS = 1e-6f, L2_EPS = 1e-6f;

constexpr size_t MiB = 1024ull * 1024ull;
constexpr size_t WS_WTD = 0;
constexpr size_t WS_WTG = 128 * MiB;
constexpr size_t WS_WTU = 256 * MiB;
constexpr size_t WS_YBUF = 128 * MiB;
constexpr size_t WS_HBUF = 640 * MiB;
constexpr size_t WS_X1BF = 784 * MiB;
constexpr size_t WS_LIST = 848 * MiB;
constexpr size_t WS_GATES = 880 * MiB;
constexpr size_t WS_CTRL = 881 * MiB;
constexpr size_t WS_LOGIT = 882 * MiB;
constexpr size_t WS_WTIN = 914 * MiB;
constexpr size_t WS_WTOUT = 920 * MiB;
constexpr size_t WS_WTR = 922 * MiB;
constexpr size_t WS_WTSG = 923 * MiB;
constexpr size_t WS_WTSU = WS_WTSG + 512 * 1024;
constexpr size_t WS_WTSD = 924 * MiB;
constexpr size_t WS_PROJ = 384 * MiB;
constexpr size_t WS_BA = 560 * MiB;
constexpr size_t WS_QD = 561 * MiB;
constexpr size_t WS_W0N = 593 * MiB;
constexpr size_t WS_KTT = 625 * MiB;
constexpr size_t WS_RV = 657 * MiB;
constexpr size_t WS_TM = 689 * MiB;
constexpr size_t WS_ATT = 705 * MiB;
constexpr size_t WS_GL = 721 * MiB;
constexpr size_t WS_O = 722 * MiB;
constexpr size_t WS_VT = 786 * MiB;
constexpr size_t WS_MIXED = 794 * MiB;
constexpr size_t WS_XBF = 640 * MiB;

__device__ __forceinline__ int opaque_tid() { int t = threadIdx.x; asm volatile("" : "+v"(t)); return t; }
#define TIDX opaque_tid()
typedef __attribute__((ext_vector_type(2))) __bf16 hwbf16x2;
typedef __attribute__((ext_vector_type(2))) float hwf32x2;
__device__ __forceinline__ unsigned pack2(float lo, float hi) {
  hwf32x2 f = {lo, hi};
  return __builtin_bit_cast(unsigned, __builtin_convertvector(f, hwbf16x2));
}
__device__ __forceinline__ unsigned f2bf(float f) { return pack2(f, 0.f) & 0xffffu; }
__device__ __forceinline__ float bf2f(unsigned h) { return __uint_as_float(h << 16); }
__device__ __forceinline__ float bflo(unsigned w) { return __uint_as_float(w << 16); }
__device__ __forceinline__ float bfhi(unsigned w) { return __uint_as_float(w & 0xffff0000u); }
__device__ __forceinline__ float siluf(float x) { return x / (1.f + __expf(-x)); }
__device__ __forceinline__ float sigmoidf(float x) { return 1.f / (1.f + __expf(-x)); }
__device__ __forceinline__ float wave_sum(float v) {
#pragma unroll
  for (int o = 32; o > 0; o >>= 1) v += __shfl_xor(v, o);
  return v;
}

template <int SEGDIV>
struct LdRowBF16T {
  const char* p[4]; size_t seghi, seglo; int tid16;
  template <class F> __device__ __forceinline__ void init(F rowptr, size_t hi, size_t lo = 0) {
    const int tid = TIDX; const int slot = tid & 7, row0 = tid >> 3; seghi = hi; seglo = lo; tid16 = tid * 16;
#pragma unroll
    for (int i = 0; i < 4; ++i) p[i] = (const char*)rowptr(row0 + i * 32) + ((slot ^ (row0 & 7)) << 4);
  }
  __device__ __forceinline__ void issue(int seg, int kk, unsigned char* lds) {
    const size_t off = (size_t)(seg / SEGDIV) * seghi + (size_t)(seg % SEGDIV) * seglo + (size_t)kk * 128;
#pragma unroll
    for (int i = 0; i < 4; ++i)
      __builtin_amdgcn_global_load_lds((const unsigned*)(p[i] + off), (__attribute__((address_space(3))) unsigned*)(lds + tid16 + i * 4096), 16, 0, 0);
  }
};
typedef LdRowBF16T<1> LdRowBF16;
struct LdColF32 {
  const char* p; size_t ldb, segb; f32x4 r[2][8]; int n4, kg;
  __device__ __forceinline__ void init(const float* colptr, size_t ld, size_t seg_bytes) {
    const int tid = TIDX; n4 = tid & 31; kg = tid >> 5; ldb = ld * 4; segb = seg_bytes;
    p = (const char*)colptr + (size_t)(kg * 8) * ldb;
  }
  template <int S> __device__ __forceinline__ void load(int seg, int kk) {
#pragma unroll
    for (int j = 0; j < 8; ++j) r[S][j] = *(const f32x4*)(p + (size_t)seg * segb + (size_t)(kk * 64 + j) * ldb);
  }
  template <int S> __device__ __forceinline__ void store(unsigned char* s) {
#pragma unroll
    for (int i = 0; i < 4; ++i) {
      const int row = n4 * 4 + i; u32x4 w;
      w[0] = pack2(r[S][0][i], r[S][1][i]); w[1] = pack2(r[S][2][i], r[S][3][i]); w[2] = pack2(r[S][4][i], r[S][5][i]); w[3] = pack2(r[S][6][i], r[S][7][i]);
      *(u32x4*)(s + row * 128 + ((kg ^ (row & 7)) << 4)) = w;
    }
  }
};

__device__ __forceinline__ void gemm_kstep(const unsigned char* sA, const unsigned char* sB, f32x4 (&acc)[4][4], int wr, int wc, int fr, int fq) {
#pragma unroll
  for (int ks = 0; ks < 2; ++ks) {
    bf16x8 a[4], b[4];
#pragma unroll
    for (int m = 0; m < 4; ++m) {
      const int row = wr * 64 + m * 16 + fr;
      a[m] = *(const bf16x8*)(sA + row * 128 + (((ks * 4 + fq) ^ (row & 7)) << 4));
    }
#pragma unroll
    for (int n = 0; n < 4; ++n) {
      const int row = wc * 64 + n * 16 + fr;
      b[n] = *(const bf16x8*)(sB + row * 128 + (((ks * 4 + fq) ^ (row & 7)) << 4));
    }
#pragma unroll
    for (int m = 0; m < 4; ++m)
#pragma unroll
      for (int n = 0; n < 4; ++n) acc[m][n] = __builtin_amdgcn_mfma_f32_16x16x32_bf16(b[n], a[m], acc[m][n], 0, 0, 0);
  }
}
template <int KPER, class AL, class BL, class Epi>
__device__ __forceinline__ void gemm_stream(unsigned char* smem, AL& al, BL& bl, int nseg, Epi epi) {
  const int tid = TIDX, lane = tid & 63, wid = tid >> 6, wr = wid >> 1, wc = wid & 1, fr = lane & 15, fq = lane >> 4;
  const int total = nseg * KPER;
  f32x4 acc[4][4];
  al.issue(0, 0, smem); bl.issue(0, 0, smem + 16384);
  asm volatile("s_waitcnt vmcnt(0)" ::: "memory");
  __syncthreads();
  for (int j = 0; j < total; ++j) {
    unsigned char* cur = smem + (j & 1) * 32768; unsigned char* nxt = smem + ((j & 1) ^ 1) * 32768;
    if (j + 1 < total) { al.issue((j + 1) / KPER, (j + 1) % KPER, nxt); bl.issue((j + 1) / KPER, (j + 1) % KPER, nxt + 16384); }
    if (j % KPER == 0) {
#pragma unroll
      for (int m = 0; m < 4; ++m)
#pragma unroll
        for (int n = 0; n < 4; ++n) acc[m][n] = (f32x4){0.f, 0.f, 0.f, 0.f};
    }
    gemm_kstep(cur, cur + 16384, acc, wr, wc, fr, fq);
    asm volatile("s_waitcnt vmcnt(0)" ::: "memory");
    __syncthreads();
    if ((j + 1) % KPER == 0) epi((j + 1) / KPER - 1, acc);
  }
}

#define GEMM_IDS const int tid = TIDX, lane = tid & 63, wid = tid >> 6, wr = wid >> 1, wc = wid & 1, fr = lane & 15, fq = lane >> 4; (void)tid; (void)lane;

struct Params {
  const float* in[20];
  float* out;
  char* ws;
};

constexpr int SMEM_BYTES = 69632;
constexpr int SM_MISC = 65536;

__device__ __forceinline__ void ph_cvt_x(int item, const float* __restrict__ x, bf16_t* __restrict__ xbf) {
  const int tid = TIDX;
  const size_t base = (size_t)item * 4096 + (size_t)tid * 4;
#pragma unroll
  for (int i = 0; i < 4; ++i) {
    const f32x4 v = *(const f32x4*)(x + base + (size_t)i * 1024);
    u32x2 w; w[0] = pack2(v[0], v[1]); w[1] = pack2(v[2], v[3]);
    *(u32x2*)(xbf + base + (size_t)i * 1024) = w;
  }
}
__device__ __forceinline__ void ph_cvt_wt(unsigned char* smem, int kt, int nt, const float* __restrict__ W, int K, int N, bf16_t* __restrict__ WT) {
  float* tile = (float*)smem;
  const int tid = TIDX;
  const int k0 = kt * 64, n0 = nt * 64;
  __syncthreads();
#pragma unroll
  for (int i = 0; i < 4; ++i) {
    const int k = (tid >> 4) + 16 * i, n = 4 * (tid & 15);
    f32x4 v = (f32x4){0.f, 0.f, 0.f, 0.f};
    if (n0 + n < N) v = *(const f32x4*)(W + (size_t)(k0 + k) * N + n0 + n);
    tile[k * 65 + n + 0] = v[0]; tile[k * 65 + n + 1] = v[1]; tile[k * 65 + n + 2] = v[2]; tile[k * 65 + n + 3] = v[3];
  }
  __syncthreads();
  const int n = tid >> 2, kq = tid & 3;
  u32x4 w0, w1;
#pragma unroll
  for (int j = 0; j < 4; ++j) {
    w0[j] = pack2(tile[(kq * 16 + 2 * j) * 65 + n], tile[(kq * 16 + 2 * j + 1) * 65 + n]);
    w1[j] = pack2(tile[(kq * 16 + 8 + 2 * j) * 65 + n], tile[(kq * 16 + 8 + 2 * j + 1) * 65 + n]);
  }
  bf16_t* dst = WT + (size_t)(n0 + n) * K + k0 + kq * 16;
  *(u32x4*)dst = w0; *(u32x4*)(dst + 8) = w1;
}

struct CvtTile { const float* src; bf16_t* dst; int ldn; };
__device__ __forceinline__ CvtTile cvt_decode(int it, int lane, const float* __restrict__ w_gate, const float* __restrict__ w_up, const float* __restrict__ w_down,
                                              bf16_t* __restrict__ wtg, bf16_t* __restrict__ wtu, bf16_t* __restrict__ wtd) {
  const int e = it / 384, j = it % 384;
  const float* W; bf16_t* WT; int K, N, kt, nt;
  if (j < 128) { W = w_gate + (size_t)e * DM * EFF; WT = wtg + (size_t)e * EFF * DM; K = DM; N = EFF; kt = j & 31; nt = j >> 5; }
  else if (j < 256) { W = w_up + (size_t)e * DM * EFF; WT = wtu + (size_t)e * EFF * DM; K = DM; N = EFF; kt = (j - 128) & 31; nt = (j - 128) >> 5; }
  else { W = w_down + (size_t)e * EFF * DM; WT = wtd + (size_t)e * DM * EFF; K = EFF; N = DM; kt = (j - 256) & 7; nt = (j - 256) >> 3; }
  CvtTile t;
  t.src = W + (size_t)(kt * 32 + (lane >> 4)) * N + nt * 64 + 4 * (lane & 15);
  t.dst = WT + (size_t)(nt * 64 + lane) * K + kt * 32;
  t.ldn = 4 * N;
  return t;
}
__device__ __forceinline__ void cvt_load(const CvtTile& t, f32x4 (&v)[8]) {
#pragma unroll
  for (int i = 0; i < 8; ++i) v[i] = *(const f32x4*)(t.src + (size_t)i * t.ldn);
}
__device__ __forceinline__ void cvt_store(float* tile  , int lane, const CvtTile& t, const f32x4 (&v)[8]) {
#pragma unroll
  for (int i = 0; i < 8; ++i) {
    float* p = tile + ((lane >> 4) + 4 * i) * 65 + 4 * (lane & 15);
    p[0] = v[i][0]; p[1] = v[i][1]; p[2] = v[i][2]; p[3] = v[i][3];
  }
  u32x4 w[4];
#pragma unroll
  for (int q = 0; q < 4; ++q)
#pragma unroll
    for (int j = 0; j < 4; ++j) w[q][j] = pack2(tile[(8 * q + 2 * j) * 65 + lane], tile[(8 * q + 2 * j + 1) * 65 + lane]);
#pragma unroll
  for (int q = 0; q < 4; ++q) *(u32x4*)(t.dst + 8 * q) = w[q];
}

__device__ __forceinline__ void ph_proj(unsigned char* smem, int xcd, int l, const bf16_t* __restrict__ xbf, const bf16_t* __restrict__ wt, bf16_t* __restrict__ proj, float* __restrict__ ba, bf16_t* __restrict__ vt) {
  const int mi = l >> 3, ni = l & 7;
  LdRowBF16T<3> al; al.init([&](int r) { return xbf + (size_t)((xcd * 32 + mi) * 128 + r) * DM; }, (size_t)8 * 128 * DM * 2, 0);
  LdRowBF16T<3> bl; bl.init([&](int r) { return wt + (size_t)(ni * 128 + r) * DM; }, 0, (size_t)8 * 128 * DM * 2);
  gemm_stream<16>(smem, al, bl, 12, [&](int seg, f32x4 (&acc)[4][4]) {
    GEMM_IDS
    const int nt = (seg % 3) * 8 + ni;
    if (nt < 23) {
      const int m0 = (xcd * 32 + (seg / 3) * 8 + mi) * 128, n0 = nt * 128;
#pragma unroll
      for (int m = 0; m < 4; ++m)
#pragma unroll
        for (int n = 0; n < 4; ++n) {
          const int row = m0 + wr * 64 + m * 16 + fr, col = n0 + wc * 64 + n * 16 + fq * 4;
          if (col < PROJW) {
            u32x2 w; w[0] = pack2(acc[m][n][0], acc[m][n][1]); w[1] = pack2(acc[m][n][2], acc[m][n][3]);
            *(u32x2*)(proj + (size_t)row * PROJW + col) = w;
          } else if (col < INC) {
            *(f32x4*)(ba + (size_t)row * 8 + (col - PROJW)) = acc[m][n];
          }
        }
      if (n0 == OFF_SV) {
#pragma unroll
        for (int m = 0; m < 4; ++m)
#pragma unroll
          for (int n = 0; n < 4; ++n) {
            const int row = m0 + wr * 64 + m * 16 + fr, c = wc * 64 + n * 16 + fq * 4;
            const int bb = row / SEQ, t = row % SEQ;
#pragma unroll
            for (int r = 0; r < 4; ++r) vt[((size_t)(bb * 128 + c + r)) * SEQ + t] = (bf16_t)f2bf(acc[m][n][r]);
          }
      }
    }
  });
}

__device__ __forceinline__ bf16x8 pack8(f32x4 a, f32x4 b) {
  union { bf16x8 v; unsigned u[4]; } x;
  x.u[0] = pack2(a[0], a[1]); x.u[1] = pack2(a[2], a[3]); x.u[2] = pack2(b[0], b[1]); x.u[3] = pack2(b[2], b[3]);
  return x.v;
}
__device__ __forceinline__ void ph_dnchunk(unsigned char* smem, int item, const bf16_t* __restrict__ proj, const float* __restrict__ ba, const float* __restrict__ conv_w,
                                           const float* __restrict__ a_log, const float* __restrict__ dt_bias,
                                           bf16_t* __restrict__ QD, bf16_t* __restrict__ W0N, bf16_t* __restrict__ KTT, bf16_t* __restrict__ RV,
                                           bf16_t* __restrict__ TM, bf16_t* __restrict__ ATT, float* __restrict__ GL) {
  const int tid = TIDX, lane = tid & 63, w = tid >> 6, fr = lane & 15, fq = lane >> 4;
  const int n = item & 63, h = (item >> 6) & 3, b = item >> 8;
  const int t0 = n * 64; const size_t row0 = (size_t)b * SEQ + t0;
  unsigned char* qs = smem; unsigned char* ks = smem + 16384; float* AT = (float*)(smem + 32768);
  const float scale = 0.08838834764831845f;
  float bL, gcL;
  {
    const float* bap = ba + (row0 + lane) * 8;
    bL = sigmoidf(bap[h]);
    const float xx = bap[4 + h] + dt_bias[h];
    const float sp = fmaxf(xx, 0.f) + log1pf(__expf(-fabsf(xx)));
    float gg = -__expf(a_log[h]) * sp;
#pragma unroll
    for (int o = 1; o < 64; o <<= 1) { const float v = __shfl_up(gg, o); if (lane >= o) gg += v; }
    gcL = gg;
  }
  {
    const int d = 2 * lane;
    float cw[3][4][2];
#pragma unroll
    for (int mx = 0; mx < 3; ++mx)
#pragma unroll
      for (int j = 0; j < 4; ++j) {
        const float2 c2 = *(const float2*)(conv_w + j * 1536 + mx * 512 + h * 128 + d);
        cw[mx][j][0] = c2.x; cw[mx][j][1] = c2.y;
      }
    const bf16_t* pbase = proj + (row0 + 16 * w) * PROJW + h * 128 + d;
    unsigned raw[3][19];
#pragma unroll
    for (int j = 0; j < 19; ++j) {
      const bool ok = (t0 + 16 * w - 3 + j) >= 0;
#pragma unroll
      for (int mx = 0; mx < 3; ++mx) {
        unsigned u = 0;
        if (ok) u = *(const unsigned*)(pbase + (ptrdiff_t)(j - 3) * PROJW + mx * 512);
        raw[mx][j] = u;
      }
    }
#pragma unroll
    for (int i = 0; i < 16; ++i) {
      float s[3][2];
#pragma unroll
      for (int mx = 0; mx < 3; ++mx) {
        float y0 = 0.f, y1 = 0.f;
#pragma unroll
        for (int j = 0; j < 4; ++j) { y0 += cw[mx][j][0] * bflo(raw[mx][i + j]); y1 += cw[mx][j][1] * bfhi(raw[mx][i + j]); }
        s[mx][0] = siluf(y0); s[mx][1] = siluf(y1);
      }
      const int row = 16 * w + i;
      const float rq = rsqrtf(wave_sum(s[0][0] * s[0][0] + s[0][1] * s[0][1]) + L2_EPS);
      const float rk = rsqrtf(wave_sum(s[1][0] * s[1][0] + s[1][1] * s[1][1]) + L2_EPS);
      const int off = row * 256 + ((((lane >> 2) ^ (row & 15))) << 4) + (lane & 3) * 4;
      *(unsigned*)(qs + off) = pack2(s[0][0] * rq, s[0][1] * rq);
      *(unsigned*)(ks + off) = pack2(s[1][0] * rk, s[1][1] * rk);
      const float bi = __shfl(bL, row);
      *(unsigned*)(RV + ((size_t)item * 64 + row) * 128 + d) = pack2(bi * s[2][0], bi * s[2][1]);
    }
  }
  __syncthreads();
  {
    f32x4 aKK[4], aQK[4];
#pragma unroll
    for (int nt = 0; nt < 4; ++nt) { aKK[nt] = (f32x4){0.f, 0.f, 0.f, 0.f}; aQK[nt] = (f32x4){0.f, 0.f, 0.f, 0.f}; }
#pragma unroll
    for (int k4 = 0; k4 < 4; ++k4) {
      const int arow = 16 * w + fr;
      const bf16x8 aq = *(const bf16x8*)(qs + arow * 256 + ((((k4 * 4 + fq) ^ (arow & 15))) << 4));
      const bf16x8 ak = *(const bf16x8*)(ks + arow * 256 + ((((k4 * 4 + fq) ^ (arow & 15))) << 4));
#pragma unroll
      for (int nt = 0; nt < 4; ++nt) {
        const int brow = 16 * nt + fr;
        const bf16x8 bk = *(const bf16x8*)(ks + brow * 256 + ((((k4 * 4 + fq) ^ (brow & 15))) << 4));
        aKK[nt] = __builtin_amdgcn_mfma_f32_16x16x32_bf16(ak, bk, aKK[nt], 0, 0, 0);
        aQK[nt] = __builtin_amdgcn_mfma_f32_16x16x32_bf16(aq, bk, aQK[nt], 0, 0, 0);
      }
    }
    float gci[4], bi[4];
#pragma unroll
    for (int r = 0; r < 4; ++r) { gci[r] = __shfl(gcL, 16 * w + 4 * fq + r); bi[r] = __shfl(bL, 16 * w + 4 * fq + r); }
#pragma unroll
    for (int nt = 0; nt < 4; ++nt) {
      const int j = 16 * nt + fr;
      const float gcj = __shfl(gcL, j);
      const int p = 32 * (nt >> 1) + 8 * (fr >> 2) + 4 * (nt & 1) + (fr & 3);
      float av[4];
#pragma unroll
      for (int r = 0; r < 4; ++r) {
        const int i = 16 * w + 4 * fq + r;
        const float dec = (j <= i) ? __expf(gci[r] - gcj) : 0.f;
        av[r] = (j < i) ? bi[r] * aKK[nt][r] * dec : 0.f;
        ATT[((size_t)item * 64 + i) * 64 + p] = (bf16_t)f2bf(aQK[nt][r] * scale * dec);
      }
      *(float4*)(AT + j * 68 + 16 * w + 4 * fq) = make_float4(av[0], av[1], av[2], av[3]);
    }
  }
  __syncthreads();
  if (w == 0) {
    float Tr[64];
    int ln = lane; asm volatile("" : "+v"(ln));
#pragma unroll
    for (int j = 0; j < 64; ++j) Tr[j] = 0.f;
    f32x4 cur[16], nxt[16];
#pragma unroll
    for (int j4 = 0; j4 < 16; ++j4) nxt[j4] = (f32x4){0.f, 0.f, 0.f, 0.f};
#pragma unroll
    for (int j4 = 15; j4 >= 16; --j4) cur[j4] = *(const f32x4*)(AT + 63 * 68 + j4 * 4);
#pragma unroll
    for (int c = 63; c >= 0; --c) {
      if (c > 0) {
#pragma unroll
        for (int j4 = 15; j4 >= c / 4; --j4) nxt[j4] = *(const f32x4*)(AT + (c - 1) * 68 + j4 * 4);
      }
      float a0 = 0.f, a1 = 0.f, a2 = 0.f, a3 = 0.f;
#pragma unroll
      for (int j4 = 15; j4 >= (c + 1) / 4; --j4) {
        asm volatile("v_fmac_f32 %0, %1, %2" : "+v"(a0) : "v"(Tr[4 * j4 + 0]), "v"(cur[j4][0]));
        asm volatile("v_fmac_f32 %0, %1, %2" : "+v"(a1) : "v"(Tr[4 * j4 + 1]), "v"(cur[j4][1]));
        asm volatile("v_fmac_f32 %0, %1, %2" : "+v"(a2) : "v"(Tr[4 * j4 + 2]), "v"(cur[j4][2]));
        asm volatile("v_fmac_f32 %0, %1, %2" : "+v"(a3) : "v"(Tr[4 * j4 + 3]), "v"(cur[j4][3]));
      }
      Tr[c] = ((ln == c) ? 1.f : 0.f) - ((a0 + a1) + (a2 + a3));
#pragma unroll
      for (int j4 = 0; j4 < 16; ++j4) cur[j4] = nxt[j4];
    }
    u32x4* tp = (u32x4*)(TM + ((size_t)item * 64 + lane) * 64);
#pragma unroll
    for (int oc = 0; oc < 8; ++oc) {
      const int k0 = 32 * (oc >> 2) + 4 * (oc & 3);
      u32x4 v;
      v[0] = pack2(Tr[k0 + 0], Tr[k0 + 1]); v[1] = pack2(Tr[k0 + 2], Tr[k0 + 3]);
      v[2] = pack2(Tr[k0 + 16], Tr[k0 + 17]); v[3] = pack2(Tr[k0 + 18], Tr[k0 + 19]);
      tp[oc] = v;
    }
  } else {
    const float gclast = __shfl(gcL, 63);
    if (tid == 64) GL[item] = __expf(gclast);
#pragma unroll 1
    for (int it = 0; it < 16; ++it) {
      const int idx = (tid - 64) + it * 192;
      const int mtx = idx >> 10, rem = idx & 1023;
      if (mtx < 2) {
        const int i = rem >> 4, oc = rem & 15;
        const float gi = __shfl(gcL, i), bi = __shfl(bL, i);
        const float f = (mtx == 0) ? scale * __expf(gi) : -bi * __expf(gi);
        const unsigned char* st = (mtx == 0) ? qs : ks;
        const int d0 = 32 * (oc >> 2) + 4 * (oc & 3);
        const uint2 lo = *(const uint2*)(st + i * 256 + ((((d0 >> 3) ^ (i & 15))) << 4) + (d0 & 7) * 2);
        const uint2 hi = *(const uint2*)(st + i * 256 + (((((d0 + 16) >> 3) ^ (i & 15))) << 4) + (d0 & 7) * 2);
        u32x4 v;
        v[0] = pack2(bflo(lo.x) * f, bfhi(lo.x) * f); v[1] = pack2(bflo(lo.y) * f, bfhi(lo.y) * f);
        v[2] = pack2(bflo(hi.x) * f, bfhi(hi.x) * f); v[3] = pack2(bflo(hi.y) * f, bfhi(hi.y) * f);
        bf16_t* dst = ((mtx == 0) ? QD : W0N) + ((size_t)item * 64 + i) * 128 + 8 * oc;
        *(u32x4*)dst = v;
      } else {
        const int d = rem & 127, oc = rem >> 7;
        const int j0 = 32 * (oc >> 2) + 4 * (oc & 3);
        float val[8];
#pragma unroll
        for (int e = 0; e < 8; ++e) {
          const int j = j0 + (e & 3) + ((e >> 2) << 4);
          const float f = __expf(gclast - __shfl(gcL, j));
          const unsigned short raw = *(const unsigned short*)(ks + j * 256 + ((((d >> 3) ^ (j & 15))) << 4) + (d & 7) * 2);
          val[e] = bf2f(raw) * f;
        }
        u32x4 v;
        v[0] = pack2(val[0], val[1]); v[1] = pack2(val[2], val[3]); v[2] = pack2(val[4], val[5]); v[3] = pack2(val[6], val[7]);
        *(u32x4*)(KTT + ((size_t)item * 128 + d) * 64 + 8 * oc) = v;
      }
    }
  }
  __syncthreads();
}

__device__ __forceinline__ void ph_dnscan(unsigned char* smem, int item, const bf16_t* __restrict__ QDp, const bf16_t* __restrict__ W0Np, const bf16_t* __restrict__ KTTp,
                                          const bf16_t* __restrict__ RVp, const bf16_t* __restrict__ TMp, const bf16_t* __restrict__ ATTp, const float* __restrict__ GLp,
                                          float* __restrict__ op) {
  const int tid = TIDX, lane = tid & 63, w = tid >> 6, fr = lane & 15, fq = lane >> 4;
  const int bh = item >> 1, half = item & 1, b = bh >> 2, h = bh & 3;
  const int vcol0 = (half * 4 + w) * 16;
  unsigned char* sW0 = smem; unsigned char* sQD = smem + 16384; unsigned char* sKT = smem + 32768; unsigned char* sT = smem + 49152; unsigned char* sAT = smem + 57344;
  f32x4 S[8];
#pragma unroll
  for (int t = 0; t < 8; ++t) S[t] = (f32x4){0.f, 0.f, 0.f, 0.f};
  u32x4 pfA[8], pfB[8]; unsigned short rvp[16];
#define DN_LOAD_A(nn_) do { \
    const size_t ci = (size_t)bh * 64 + (nn_); \
    _Pragma("unroll") for (int i = 0; i < 4; ++i) pfA[i] = *(const u32x4*)((const char*)W0Np + ci * 16384 + (size_t)(tid + 256 * i) * 16); \
    _Pragma("unroll") for (int i = 0; i < 4; ++i) pfA[4 + i] = *(const u32x4*)((const char*)QDp + ci * 16384 + (size_t)(tid + 256 * i) * 16); \
    _Pragma("unroll") for (int mt = 0; mt < 4; ++mt) \
      _Pragma("unroll") for (int r = 0; r < 4; ++r) rvp[mt * 4 + r] = RVp[(ci * 64 + 16 * mt + 4 * fq + r) * 128 + vcol0 + fr]; \
  } while (0)
#define DN_STORE_A() do { \
    _Pragma("unroll") for (int i = 0; i < 4; ++i) { const int q = tid + 256 * i, row = q >> 4, ch = q & 15; *(u32x4*)(sW0 + row * 256 + ((ch ^ (row & 15)) << 4)) = pfA[i]; } \
    _Pragma("unroll") for (int i = 0; i < 4; ++i) { const int q = tid + 256 * i, row = q >> 4, ch = q & 15; *(u32x4*)(sQD + row * 256 + ((ch ^ (row & 15)) << 4)) = pfA[4 + i]; } \
  } while (0)
#define DN_LOAD_B(nn_) do { \
    const size_t ci = (size_t)bh * 64 + (nn_); \
    _Pragma("unroll") for (int i = 0; i < 4; ++i) pfB[i] = *(const u32x4*)((const char*)KTTp + ci * 16384 + (size_t)(tid + 256 * i) * 16); \
    _Pragma("unroll") for (int i = 0; i < 2; ++i) pfB[4 + i] = *(const u32x4*)((const char*)TMp + ci * 8192 + (size_t)(tid + 256 * i) * 16); \
    _Pragma("unroll") for (int i = 0; i < 2; ++i) pfB[6 + i] = *(const u32x4*)((const char*)ATTp + ci * 8192 + (size_t)(tid + 256 * i) * 16); \
  } while (0)
#define DN_STORE_B() do { \
    _Pragma("unroll") for (int i = 0; i < 4; ++i) { const int q = tid + 256 * i, row = q >> 3, ch = q & 7; *(u32x4*)(sKT + row * 128 + ((ch ^ (row & 7)) << 4)) = pfB[i]; } \
    _Pragma("unroll") for (int i = 0; i < 2; ++i) { const int q = tid + 256 * i, row = q >> 3, ch = q & 7; *(u32x4*)(sT + row * 128 + ((ch ^ (row & 7)) << 4)) = pfB[4 + i]; } \
    _Pragma("unroll") for (int i = 0; i < 2; ++i) { const int q = tid + 256 * i, row = q >> 3, ch = q & 7; *(u32x4*)(sAT + row * 128 + ((ch ^ (row & 7)) << 4)) = pfB[6 + i]; } \
  } while (0)
#define DN_ZINIT() do { _Pragma("unroll") for (int mt = 0; mt < 4; ++mt) Z[mt] = (f32x4){bf2f(rvp[mt * 4 + 0]), bf2f(rvp[mt * 4 + 1]), bf2f(rvp[mt * 4 + 2]), bf2f(rvp[mt * 4 + 3])}; } while (0)
  __syncthreads();
  f32x4 Z[4];
  DN_LOAD_A(0);
  DN_LOAD_B(0);
  DN_STORE_A();
  DN_ZINIT();
  DN_LOAD_A(1);
  for (int nn = 0; nn < 64; ++nn) {
    const float gl = GLp[(size_t)bh * 64 + nn];
    __syncthreads();
    bf16x8 Sb[4];
#pragma unroll
    for (int k4 = 0; k4 < 4; ++k4) Sb[k4] = pack8(S[2 * k4], S[2 * k4 + 1]);
    f32x4 O[4];
#pragma unroll
    for (int mt = 0; mt < 4; ++mt) {
      O[mt] = (f32x4){0.f, 0.f, 0.f, 0.f};
      const int row = 16 * mt + fr;
#pragma unroll
      for (int k4 = 0; k4 < 4; ++k4) {
        const int off = row * 256 + ((((k4 * 4 + fq) ^ fr)) << 4);
        const bf16x8 aw = *(const bf16x8*)(sW0 + off);
        const bf16x8 aq = *(const bf16x8*)(sQD + off);
        Z[mt] = __builtin_amdgcn_mfma_f32_16x16x32_bf16(aw, Sb[k4], Z[mt], 0, 0, 0);
        O[mt] = __builtin_amdgcn_mfma_f32_16x16x32_bf16(aq, Sb[k4], O[mt], 0, 0, 0);
      }
    }
    bf16x8 Zb[2];
    Zb[0] = pack8(Z[0], Z[1]); Zb[1] = pack8(Z[2], Z[3]);
    DN_STORE_B();
    if (nn + 1 < 64) DN_LOAD_B(nn + 1);
    __syncthreads();
    f32x4 Vn[4];
#pragma unroll
    for (int mt = 0; mt < 4; ++mt) {
      Vn[mt] = (f32x4){0.f, 0.f, 0.f, 0.f};
      const int row = 16 * mt + fr;
#pragma unroll
      for (int s = 0; s < 2; ++s) {
        if (s <= (mt >> 1)) {
          const bf16x8 at = *(const bf16x8*)(sT + row * 128 + ((((s * 4 + fq) ^ (row & 7))) << 4));
          Vn[mt] = __builtin_amdgcn_mfma_f32_16x16x32_bf16(at, Zb[s], Vn[mt], 0, 0, 0);
        }
      }
    }
    bf16x8 Vb[2];
    Vb[0] = pack8(Vn[0], Vn[1]); Vb[1] = pack8(Vn[2], Vn[3]);
#pragma unroll
    for (int mt = 0; mt < 4; ++mt) {
      const int row = 16 * mt + fr;
#pragma unroll
      for (int s = 0; s < 2; ++s) {
        if (s <= (mt >> 1)) {
          const bf16x8 aa = *(const bf16x8*)(sAT + row * 128 + ((((s * 4 + fq) ^ (row & 7))) << 4));
          O[mt] = __builtin_amdgcn_mfma_f32_16x16x32_bf16(aa, Vb[s], O[mt], 0, 0, 0);
        }
      }
      const size_t tok = (size_t)b * SEQ + nn * 64 + 16 * mt + 4 * fq;
#pragma unroll
      for (int r = 0; r < 4; ++r) op[(tok + r) * 512 + h * 128 + vcol0 + fr] = O[mt][r];
    }
#pragma unroll
    for (int t = 0; t < 8; ++t) {
      S[t] = S[t] * gl;
      const int row = 16 * t + fr;
#pragma unroll
      for (int s = 0; s < 2; ++s) {
        const bf16x8 ak = *(const bf16x8*)(sKT + row * 128 + ((((s * 4 + fq) ^ (row & 7))) << 4));
        S[t] = __builtin_amdgcn_mfma_f32_16x16x32_bf16(ak, Vb[s], S[t], 0, 0, 0);
      }
    }
    if (nn + 1 < 64) {
      DN_STORE_A();
      DN_ZINIT();
      if (nn + 2 < 64) DN_LOAD_A(nn + 2);
    }
  }
  __syncthreads();
#undef DN_ZINIT
#undef DN_LOAD_A
#undef DN_STORE_A
#undef DN_LOAD_B
#undef DN_STORE_B
}

__device__ __forceinline__ void ph_dn_post(int item, const float* __restrict__ o, const bf16_t* __restrict__ proj, const float* __restrict__ dn_norm_g, bf16_t* __restrict__ mixed) {
  const int tid = TIDX, h = tid >> 6, lane = tid & 63;
  const float2 g2 = *(const float2*)(dn_norm_g + 2 * lane);
  float2 ov[4]; unsigned zv[4];
#pragma unroll
  for (int i = 0; i < 4; ++i) {
    const size_t n = (size_t)item * 4 + i;
    ov[i] = *(const float2*)(o + n * 512 + h * 128 + 2 * lane);
    zv[i] = *(const unsigned*)(proj + n * PROJW + OFF_Z + h * 128 + 2 * lane);
  }
#pragma unroll
  for (int i = 0; i < 4; ++i) {
    const size_t n = (size_t)item * 4 + i;
    const float ss = wave_sum(ov[i].x * ov[i].x + ov[i].y * ov[i].y);
    const float rn = rsqrtf(ss * (1.f / 128.f) + RMS_EPS);
    *(unsigned*)(mixed + n * DM + h * 128 + 2 * lane) = pack2(ov[i].x * rn * g2.x * siluf(bflo(zv[i])), ov[i].y * rn * g2.y * siluf(bfhi(zv[i])));
  }
}

__device__ __forceinline__ void ph_swa(unsigned char* smem, int item, const bf16_t* __restrict__ proj, const bf16_t* __restrict__ vt, const float* __restrict__ sinks, bf16_t* __restrict__ mixed) {
  const int tid = TIDX, lane = tid & 63, w = tid >> 6, fr = lane & 15, fq = lane >> 4;
  const int qb = item & 31, kvh = (item >> 5) & 1, b = item >> 6;
  const int t0 = qb * 128;
  const size_t rowb = (size_t)b * SEQ;
  unsigned char* sK = smem;
  unsigned char* sV = smem + 32768;
  __syncthreads();
#pragma unroll
  for (int i = 0; i < 8; ++i) {
    const int q = tid + 256 * i, row = q >> 3, ch = q & 7;
    const int pos = t0 - 128 + row;
    u32x4 v = (u32x4){0u, 0u, 0u, 0u};
    if (pos >= 0) v = *(const u32x4*)(proj + (rowb + pos) * PROJW + OFF_SK + kvh * 64 + ch * 8);
    *(u32x4*)(sK + row * 128 + ((ch ^ (row & 7)) << 4)) = v;
  }
#pragma unroll
  for (int i = 0; i < 8; ++i) {
    const int q = tid + 256 * i, row = q >> 5, ch = q & 31;
    const int pos = t0 - 128 + ch * 8;
    u32x4 v = (u32x4){0u, 0u, 0u, 0u};
    if (pos >= 0) v = *(const u32x4*)(vt + ((size_t)(b * 128 + kvh * 64 + row)) * SEQ + pos);
    *(u32x4*)(sV + row * 512 + ((ch ^ (row & 15)) << 4)) = v;
  }
  __syncthreads();
  const int head = kvh * 4 + w;
  const float slope = exp2f(-(float)(head + 1));
  const float sink = sinks[head];
  const bf16_t* qp0 = proj + (rowb + t0 + fr) * PROJW + OFF_SQ + head * 64 + fq * 8;
  bf16x8 qn0 = *(const bf16x8*)(qp0), qn1 = *(const bf16x8*)(qp0 + 32);
#pragma unroll 1
  for (int qt = 0; qt < 8; ++qt) {
    const bf16x8 qf0 = qn0, qf1 = qn1;
    if (qt < 7) { const bf16_t* qp = qp0 + (size_t)(qt + 1) * 16 * PROJW; qn0 = *(const bf16x8*)(qp); qn1 = *(const bf16x8*)(qp + 32); }
    const int kp0 = qt >> 1;
    f32x4 st[10];
#pragma unroll
    for (int kt = 0; kt < 10; ++kt) {
      const int krow = (2 * kp0 + kt) * 16 + fr;
      st[kt] = (f32x4){0.f, 0.f, 0.f, 0.f};
      const bf16x8 k0 = *(const bf16x8*)(sK + krow * 128 + (((0 + fq) ^ (krow & 7)) << 4));
      const bf16x8 k1 = *(const bf16x8*)(sK + krow * 128 + (((4 + fq) ^ (krow & 7)) << 4));
      st[kt] = __builtin_amdgcn_mfma_f32_16x16x32_bf16(k0, qf0, st[kt], 0, 0, 0);
      st[kt] = __builtin_amdgcn_mfma_f32_16x16x32_bf16(k1, qf1, st[kt], 0, 0, 0);
    }
    const int i = qt * 16 + fr;
    float mx = sink;
#pragma unroll
    for (int kt = 0; kt < 10; ++kt)
#pragma unroll
      for (int r = 0; r < 4; ++r) {
        const int jb = (2 * kp0 + kt) * 16 + 4 * fq + r;
        const int dist = 128 + i - jb;
        const bool ok = (dist >= 0) && (dist < 128) && (t0 - 128 + jb >= 0);
        const float s = ok ? (st[kt][r] * 0.125f - slope * (float)dist) : -INFINITY;
        st[kt][r] = s;
        mx = fmaxf(mx, s);
      }
    mx = fmaxf(mx, __shfl_xor(mx, 16));
    mx = fmaxf(mx, __shfl_xor(mx, 32));
    float sum = 0.f;
#pragma unroll
    for (int kt = 0; kt < 10; ++kt)
#pragma unroll
      for (int r = 0; r < 4; ++r) { const float p = __expf(st[kt][r] - mx); st[kt][r] = p; sum += p; }
    sum += __shfl_xor(sum, 16);
    sum += __shfl_xor(sum, 32);
    const float inv = 1.f / (sum + __expf(sink - mx));
    f32x4 O[4];
#pragma unroll
    for (int nt = 0; nt < 4; ++nt) O[nt] = (f32x4){0.f, 0.f, 0.f, 0.f};
#pragma unroll
    for (int s5 = 0; s5 < 5; ++s5) {
      const bf16x8 pa = pack8(st[2 * s5] * inv, st[2 * s5 + 1] * inv);
      const int key0 = (2 * kp0 + 2 * s5) * 16 + 4 * fq;
#pragma unroll
      for (int nt = 0; nt < 4; ++nt) {
        const int drow = nt * 16 + fr;
        const int c0 = key0 >> 3, c1 = (key0 + 16) >> 3;
        const u32x2 lo = *(const u32x2*)(sV + drow * 512 + ((c0 ^ (drow & 15)) << 4) + ((key0 >> 2) & 1) * 8);
        const u32x2 hi = *(const u32x2*)(sV + drow * 512 + ((c1 ^ (drow & 15)) << 4) + ((key0 >> 2) & 1) * 8);
        const u32x4 vb = (u32x4){lo[0], lo[1], hi[0], hi[1]};
        O[nt] = __builtin_amdgcn_mfma_f32_16x16x32_bf16(pa, __builtin_bit_cast(bf16x8, vb), O[nt], 0, 0, 0);
      }
    }
#pragma unroll
    for (int nt = 0; nt < 4; ++nt)
#pragma unroll
      for (int r = 0; r < 4; ++r)
        mixed[(rowb + t0 + qt * 16 + 4 * fq + r) * DM + 512 + head * 64 + nt * 16 + fr] = (bf16_t)f2bf(O[nt][r]);
  }
}

__device__ __forceinline__ void ph_wout(unsigned char* smem, int xcd, int l, const bf16_t* __restrict__ mixed, const bf16_t* __restrict__ wt, const float* __restrict__ x, float* __restrict__ y1) {
  const int mi = l >> 3, ni = l & 7;
  LdRowBF16 al; al.init([&](int r) { return mixed + (size_t)((xcd * 32 + mi) * 128 + r) * DM; }, (size_t)8 * 128 * DM * 2);
  LdRowBF16 bl; bl.init([&](int r) { return wt + (size_t)(ni * 128 + r) * DM; }, 0);
  gemm_stream<16>(smem, al, bl, 4, [&](int seg, f32x4 (&acc)[4][4]) {
    GEMM_IDS
    const int m0 = (xcd * 32 + seg * 8 + mi) * 128, n0 = ni * 128;
#pragma unroll
    for (int m = 0; m < 4; ++m)
#pragma unroll
      for (int n = 0; n < 4; ++n) {
        const size_t idx = (size_t)(m0 + wr * 64 + m * 16 + fr) * DM + n0 + wc * 64 + n * 16 + fq * 4;
        const f32x4 xv = *(const f32x4*)(x + idx);
        *(f32x4*)(y1 + idx) = xv * ALPHA + acc[m][n];
      }
  });
}

__device__ __forceinline__ void ph_ln1(int item, float* __restrict__ y, const float* __restrict__ gam, const float* __restrict__ bet, bf16_t* __restrict__ xbf) {
  const int row = item * 4 + (TIDX >> 6), lane = TIDX & 63;
  float4* p = (float4*)(y + (size_t)row * DM);
  float4 v[4]; float s = 0.f;
#pragma unroll
  for (int i = 0; i < 4; ++i) { v[i] = p[lane + i * 64]; s += v[i].x + v[i].y + v[i].z + v[i].w; }
  const float mu = wave_sum(s) * (1.f / DM);
  float q = 0.f;
#pragma unroll
  for (int i = 0; i < 4; ++i) { const float a = v[i].x - mu, b = v[i].y - mu, c = v[i].z - mu, d = v[i].w - mu; q += a * a + b * b + c * c + d * d; }
  const float rs = rsqrtf(wave_sum(q) * (1.f / DM) + LN_EPS);
#pragma unroll
  for (int i = 0; i < 4; ++i) {
    const float4 gg = ((const float4*)gam)[lane + i * 64], bb = ((const float4*)bet)[lane + i * 64];
    float4 r;
    r.x = (v[i].x - mu) * rs * gg.x + bb.x; r.y = (v[i].y - mu) * rs * gg.y + bb.y;
    r.z = (v[i].z - mu) * rs * gg.z + bb.z; r.w = (v[i].w - mu) * rs * gg.w + bb.w;
    p[lane + i * 64] = r;
    u32x2 w; w[0] = pack2(r.x, r.y); w[1] = pack2(r.z, r.w);
    ((u32x2*)(xbf + (size_t)row * DM))[lane + i * 64] = w;
  }
}

__device__ __forceinline__ void ph_router(unsigned char* smem, int tile, const bf16_t* __restrict__ xbf, const bf16_t* __restrict__ wt, float* __restrict__ logits) {
  GEMM_IDS
  const int n0 = (tile & 1) * 128, m0 = (tile >> 1) * 128;
  LdRowBF16 al; al.init([&](int r) { return xbf + (size_t)(m0 + r) * DM; }, 0);
  LdRowBF16 bl; bl.init([&](int r) { return wt + (size_t)(n0 + r) * DM; }, 0);
  gemm_stream<16>(smem, al, bl, 1, [&](int seg, f32x4 (&acc)[4][4]) {
    GEMM_IDS
#pragma unroll
    for (int m = 0; m < 4; ++m)
#pragma unroll
      for (int n = 0; n < 4; ++n)
        *(f32x4*)(logits + (size_t)(m0 + wr * 64 + m * 16 + fr) * NEXP + n0 + wc * 64 + n * 16 + fq * 4) = acc[m][n];
  });
}

__device__ __forceinline__ void ph_route(int item, const float* __restrict__ logits, const float* __restrict__ router_bias, int* __restrict__ cnt, int* __restrict__ list, float* __restrict__ gates) {
  const int n = item * 4 + (TIDX >> 6), lane = TIDX & 63;
  const float4 lg = ((const float4*)(logits + (size_t)n * NEXP))[lane];
  const float4 rb = ((const float4*)router_bias)[lane];
  float sc[4] = {sigmoidf(lg.x), sigmoidf(lg.y), sigmoidf(lg.z), sigmoidf(lg.w)};
  float sel[4] = {sc[0] + rb.x, sc[1] + rb.y, sc[2] + rb.z, sc[3] + rb.w};
  float t1 = fmaxf(sel[0], sel[1]), t2 = fminf(sel[0], sel[1]);
  { const float a = sel[2]; if (a > t1) { t2 = t1; t1 = a; } else if (a > t2) t2 = a; }
  { const float a = sel[3]; if (a > t1) { t2 = t1; t1 = a; } else if (a > t2) t2 = a; }
#pragma unroll
  for (int o = 1; o < 8; o <<= 1) {
    const float b1 = __shfl_xor(t1, o), b2 = __shfl_xor(t2, o);
    const float n1 = fmaxf(t1, b1), n2 = fmaxf(fminf(t1, b1), fmaxf(t2, b2));
    t1 = n1; t2 = n2;
  }
  const float gs = t1 + t2;
  const int mygrp = lane >> 3;
  int rank = 0;
#pragma unroll
  for (int j = 0; j < 8; ++j) {
    const float o = __shfl(gs, j * 8);
    rank += (o > gs || (o == gs && j < mygrp)) ? 1 : 0;
  }
  const bool gsel = rank < 4;
  float cand[4];
#pragma unroll
  for (int i = 0; i < 4; ++i) cand[i] = gsel ? sel[i] : -INFINITY;
  float gsum = 0.f; float myg = 0.f; int mye = 0;
#pragma unroll 1
  for (int r = 0; r < TOPK; ++r) {
    float bv = cand[0]; int bi = 0;
#pragma unroll
    for (int i = 1; i < 4; ++i) if (cand[i] > bv) { bv = cand[i]; bi = i; }
    int be = lane * 4 + bi;
    float bs = (bi == 0) ? sc[0] : (bi == 1) ? sc[1] : (bi == 2) ? sc[2] : sc[3];
#pragma unroll
    for (int o = 1; o < 64; o <<= 1) {
      const float ov = __shfl_xor(bv, o); const int oe = __shfl_xor(be, o); const float os = __shfl_xor(bs, o);
      if (ov > bv || (ov == bv && oe < be)) { bv = ov; be = oe; bs = os; }
    }
    if ((be >> 2) == lane) {
      const int bi2 = be & 3;
      if (bi2 == 0) cand[0] = -INFINITY; else if (bi2 == 1) cand[1] = -INFINITY; else if (bi2 == 2) cand[2] = -INFINITY; else cand[3] = -INFINITY;
    }
    gsum += bs;
    if (lane == r) { myg = bs; mye = be; }
  }
  if (lane < TOPK) {
    const int slot = atomicAdd(&cnt[mye], 1);
    list[(size_t)mye * CAP + slot] = n * TOPK + lane;
    gates[(size_t)n * TOPK + lane] = myg / gsum * 2.5f;
  }
}

__device__ __forceinline__ void moe_build_prefix(const int* __restrict__ cnt, int* sscan) {
  const int tid = TIDX;
  const int e = ((tid & 31) << 3) | (tid >> 5);
  const int c = cnt[e];
  __syncthreads();
  sscan[tid] = (c + 127) >> 7;
  __syncthreads();
  for (int o = 1; o < 256; o <<= 1) {
    const int v = (tid >= o) ? sscan[tid - o] : 0;
    __syncthreads();
    sscan[tid] += v;
    __syncthreads();
  }
}
__device__ __forceinline__ void moe_locate(const int* sscan, int x, int lt, int& e, int& rt) {
  const int base = x ? sscan[32 * x - 1] : 0;
  const int nrouted = sscan[32 * x + 31] - base;
  if (lt >= nrouted) { e = 256; rt = x * (NTOK / 128 / 8) + (lt - nrouted); return; }
  const int g = base + lt;
  int lo = 32 * x, hi = 32 * x + 31;
  while (lo < hi) { const int mid = (lo + hi) >> 1; if (sscan[mid] > g) hi = mid; else lo = mid + 1; }
  e = ((lo & 31) << 3) | (lo >> 5); rt = g - (lo ? sscan[lo - 1] : 0);
}

__device__ __forceinline__ void ph_moe1(unsigned char* smem, int e, int rt, const bf16_t* __restrict__ xbf, const int* __restrict__ cnt, const int* __restrict__ list,
                                        const bf16_t* __restrict__ wge, const bf16_t* __restrict__ wue, bf16_t* __restrict__ hbuf) {
  int* sasg = (int*)(smem + SM_MISC + 2048);
  const int tid = TIDX;
  const int rows = (e < 256) ? cnt[e] : NTOK;
  __syncthreads();
  if (tid < 128) {
    const int r = rt * 128 + tid;
    int a = -1;
    if (r < rows) a = (e < 256) ? list[(size_t)e * CAP + r] : (NA + r);
    sasg[tid] = a;
  }
  __syncthreads();
  LdRowBF16 al; al.init([&](int r) { const int a = sasg[r]; const int tok = (a < 0) ? 0 : (a < NA ? (a >> 3) : (a - NA)); return xbf + (size_t)tok * DM; }, 0);
  LdRowBF16 bl; bl.init([&](int j) {
    const int bwc = j >> 6, bn = (j >> 4) & 3, ff = bwc * 32 + (bn >> 1) * 16 + (j & 15);
    return ((bn & 1) ? wue : wge) + (size_t)ff * DM; }, (size_t)64 * DM * 2);
  gemm_stream<16>(smem, al, bl, 4, [&](int ct, f32x4 (&acc)[4][4]) {
    GEMM_IDS
#pragma unroll
    for (int m = 0; m < 4; ++m) {
      const int a = sasg[wr * 64 + m * 16 + fr];
      if (a >= 0) {
#pragma unroll
        for (int pp = 0; pp < 2; ++pp) {
          float hv[4];
#pragma unroll
          for (int r = 0; r < 4; ++r) hv[r] = siluf(acc[m][2 * pp][r]) * acc[m][2 * pp + 1][r];
          u32x2 w; w[0] = pack2(hv[0], hv[1]); w[1] = pack2(hv[2], hv[3]);
          *(u32x2*)(hbuf + (size_t)a * EFF + ct * 64 + wc * 32 + pp * 16 + fq * 4) = w;
        }
      }
    }
  });
}

__device__ __forceinline__ void ph_moe2(unsigned char* smem, int e, int rt, const bf16_t* __restrict__ hbuf, const int* __restrict__ cnt, const int* __restrict__ list, const float* __restrict__ gates,
                                        const bf16_t* __restrict__ wde, bf16_t* __restrict__ ybuf, float* __restrict__ dout) {
  int* sasg = (int*)(smem + SM_MISC + 2048);
  float* sgate = (float*)(smem + SM_MISC + 2048 + 512);
  const int tid = TIDX;
  const int rows = (e < 256) ? cnt[e] : NTOK;
  __syncthreads();
  if (tid < 128) {
    const int r = rt * 128 + tid;
    int a = -1;
    if (r < rows) a = (e < 256) ? list[(size_t)e * CAP + r] : (NA + r);
    sasg[tid] = a;
    sgate[tid] = (a >= 0 && a < NA) ? gates[a] : 1.f;
  }
  __syncthreads();
  LdRowBF16 al; al.init([&](int r) { const int a = sasg[r]; return hbuf + (size_t)(a < 0 ? 0 : a) * EFF; }, 0);
  LdRowBF16 bl; bl.init([&](int j) { return wde + (size_t)j * EFF; }, (size_t)128 * EFF * 2);
  gemm_stream<4>(smem, al, bl, 8, [&](int ct, f32x4 (&acc)[4][4]) {
    GEMM_IDS
    const int n0 = ct * 128;
#pragma unroll
    for (int m = 0; m < 4; ++m) {
      const int r_ = wr * 64 + m * 16 + fr;
      const int a = sasg[r_];
      if (a >= NA) {
        float* dp = dout + (size_t)(a - NA) * DM + n0 + wc * 64 + fq * 4;
#pragma unroll
        for (int n = 0; n < 4; ++n) { const f32x4 xv = *(const f32x4*)(dp + n * 16); *(f32x4*)(dp + n * 16) = xv * ALPHA + acc[m][n]; }
      } else if (a >= 0) {
        const float gt = sgate[r_];
#pragma unroll
        for (int n = 0; n < 4; ++n) {
          u32x2 w; w[0] = pack2(acc[m][n][0] * gt, acc[m][n][1] * gt); w[1] = pack2(acc[m][n][2] * gt, acc[m][n][3] * gt);
          *(u32x2*)(ybuf + (size_t)a * DM + n0 + wc * 64 + n * 16 + fq * 4) = w;
        }
      }
    }
  });
}

__device__ __forceinline__ void ph_final(int item, float* __restrict__ out, const bf16_t* __restrict__ ybuf, const float* __restrict__ gam, const float* __restrict__ bet) {
  const int row = item * 4 + (TIDX >> 6), lane = TIDX & 63;
  float4* p = (float4*)(out + (size_t)row * DM);
  float4 v[4]; float s = 0.f;
#pragma unroll
  for (int i = 0; i < 4; ++i) {
    float4 a = p[lane + i * 64];
#pragma unroll
    for (int k = 0; k < 8; ++k) {
      const uint2 w = ((const uint2*)(ybuf + ((size_t)row * 8 + k) * DM))[lane + i * 64];
      a.x += bflo(w.x); a.y += bfhi(w.x); a.z += bflo(w.y); a.w += bfhi(w.y);
    }
    v[i] = a; s += a.x + a.y + a.z + a.w;
  }
  const float mu = wave_sum(s) * (1.f / DM);
  float q = 0.f;
#pragma unroll
  for (int i = 0; i < 4; ++i) { const float a = v[i].x - mu, b = v[i].y - mu, c = v[i].z - mu, d = v[i].w - mu; q += a * a + b * b + c * c + d * d; }
  const float rs = rsqrtf(wave_sum(q) * (1.f / DM) + LN_EPS);
#pragma unroll
  for (int i = 0; i < 4; ++i) {
    const float4 gg = ((const float4*)gam)[lane + i * 64], bb = ((const float4*)bet)[lane + i * 64];
    float4 r;
    r.x = (v[i].x - mu) * rs * gg.x + bb.x; r.y = (v[i].y - mu) * rs * gg.y + bb.y;
    r.z = (v[i].z - mu) * rs * gg.z + bb.z; r.w = (v[i].w - mu) * rs * gg.w + bb.w;
    p[lane + i * 64] = r;
  }
}

#define XB_TMO      128
#define XB_XCNT(j)  (256  + 64 * (j))
#define XB_XSUB(j)  (1280 + 64 * (j))
#define XB_XGEN(j)  (2304 + 64 * (j))
#define XB_TOP      3328
#define XB_TOPGEN   3392
#define XCD_BAR_WORDS 3456
#define XB_SPIN_CAP (1u << 22)
#define LAS __attribute__((address_space(3)))
__device__ __forceinline__ unsigned xb_ld(unsigned* p)              { return __hip_atomic_load(p, __ATOMIC_RELAXED, __HIP_MEMORY_SCOPE_AGENT); }
__device__ __forceinline__ unsigned xb_add(unsigned* p, unsigned v) { return __hip_atomic_fetch_add(p, v, __ATOMIC_RELAXED, __HIP_MEMORY_SCOPE_AGENT); }
__device__ __forceinline__ unsigned xb_xcc_id() { return (unsigned)__builtin_amdgcn_s_getreg((3 << 11) | 20) & 0xFu; }
#define XB_SPIN(cond, bar) do { unsigned _sp = 0; while (cond) { __builtin_amdgcn_s_sleep(1); \
    if ((++_sp & 255u) == 0u) { if (xb_ld(&(bar)[XB_TMO])) break; if (_sp > XB_SPIN_CAP) { atomicAdd(&(bar)[XB_TMO], 1u); break; } } } } while (0)
struct XcdBarrier { unsigned* bar; unsigned x; volatile LAS unsigned* st; };
__device__ __forceinline__ XcdBarrier xcd_barrier_post(unsigned* bar, volatile LAS unsigned* st) {
  XcdBarrier b; b.bar = bar; b.x = xb_xcc_id(); b.st = st;
  if (threadIdx.x == 0) (void)xb_add(&bar[XB_XCNT(b.x)], 1u);
  return b;
}
__device__ __forceinline__ void xcd_barrier_complete(unsigned* bar, unsigned x, unsigned& nloc, unsigned& nx) {
  const unsigned G = gridDim.x * gridDim.y * gridDim.z;
  unsigned sum, cnt, mine, sp = 0u;
  for (;;) {
    sum = 0u; cnt = 0u; mine = 0u;
#pragma unroll
    for (unsigned j = 0; j < 16; ++j) { const unsigned c = xb_ld(&bar[XB_XCNT(j)]); sum += c; cnt += (c > 0u) ? 1u : 0u; mine = (j == x) ? c : mine; }
    if (sum == G) break;
    __builtin_amdgcn_s_sleep(1);
    if ((++sp & 255u) == 0u) { if (xb_ld(&bar[XB_TMO])) break; if (sp > XB_SPIN_CAP) { atomicAdd(&bar[XB_TMO], 1u); break; } }
  }
  nloc = mine > 0u ? mine : 1u; nx = cnt > 0u ? cnt : 1u;
}
__device__ __forceinline__ void xcd_barrier(const XcdBarrier& b) {
  asm volatile("s_waitcnt vmcnt(0)" ::: "memory");
  __syncthreads();
  if (threadIdx.x == 0) {
    unsigned* bar = b.bar;
    __builtin_amdgcn_s_waitcnt(0);
    unsigned nloc = b.st[0], nx = b.st[1];
    if (nloc == 0u) { xcd_barrier_complete(bar, b.x, nloc, nx); b.st[0] = nloc; b.st[1] = nx; }
    const unsigned old = xb_add(&bar[XB_XSUB(b.x)], 1u);
    const unsigned gen = old / nloc;
    if (old + 1u == (gen + 1u) * nloc) {
      __builtin_amdgcn_fence(__ATOMIC_RELEASE, "agent");
      asm volatile("s_waitcnt vmcnt(0)" ::: "memory");
      const unsigned og = xb_add(&bar[XB_TOP], 1u);
      const unsigned tg = og / nx;
      if (og + 1u == (tg + 1u) * nx) xb_add(&bar[XB_TOPGEN], 1u);
      else XB_SPIN(xb_ld(&bar[XB_TOPGEN]) == tg, bar);
      __builtin_amdgcn_fence(__ATOMIC_ACQUIRE, "agent");
      xb_add(&bar[XB_XGEN(b.x)], 1u);
      asm volatile("s_waitcnt vmcnt(0)" ::: "memory");
    } else {
      XB_SPIN(xb_ld(&bar[XB_XGEN(b.x)]) == gen, bar);
      __builtin_amdgcn_fence(__ATOMIC_ACQUIRE, "agent");
      asm volatile("s_waitcnt vmcnt(0)" ::: "memory");
    }
  }
  __syncthreads();
}

__global__ void __launch_bounds__(256, 2) mega(Params P) {
  __shared__ __attribute__((aligned(16))) unsigned char smem[SMEM_BYTES];
  cg::grid_group grid = cg::this_grid();
  const int bid = blockIdx.x, nblk = gridDim.x;
#define xin (P.in[0])
#define w_in (P.in[1])
#define conv_w (P.in[2])
#define a_log (P.in[3])
#define dt_bias (P.in[4])
#define dn_norm_g (P.in[5])
#define sinks (P.in[6])
#define w_out (P.in[7])
#define ln1_g (P.in[8])
#define ln1_b (P.in[9])
#define router_w (P.in[10])
#define router_bias (P.in[11])
#define w_gate (P.in[12])
#define w_up (P.in[13])
#define w_down (P.in[14])
#define sw_gate (P.in[15])
#define sw_up (P.in[16])
#define sw_down (P.in[17])
#define ln2_g (P.in[18])
#define ln2_b (P.in[19])
#define outp (P.out)
#define x1bf ((bf16_t*)(P.ws + WS_X1BF))
#define logits ((float*)(P.ws + WS_LOGIT))
#define list ((int*)(P.ws + WS_LIST))
#define gates ((float*)(P.ws + WS_GATES))
#define cnt ((int*)(P.ws + WS_CTRL))
#define barw ((unsigned*)(P.ws + WS_CTRL + 4096))
#define mixed ((bf16_t*)(P.ws + WS_MIXED))
#define proj ((bf16_t*)(P.ws + WS_PROJ))
#define ba ((float*)(P.ws + WS_BA))
#define QD ((bf16_t*)(P.ws + WS_QD))
#define W0N ((bf16_t*)(P.ws + WS_W0N))
#define KTT ((bf16_t*)(P.ws + WS_KTT))
#define RV ((bf16_t*)(P.ws + WS_RV))
#define TM ((bf16_t*)(P.ws + WS_TM))
#define ATT ((bf16_t*)(P.ws + WS_ATT))
#define GL ((float*)(P.ws + WS_GL))
#define obuf ((float*)(P.ws + WS_O))
#define VTb ((bf16_t*)(P.ws + WS_VT))
#define XBF ((bf16_t*)(P.ws + WS_XBF))
#define WTIN ((bf16_t*)(P.ws + WS_WTIN))
#define WTOUT ((bf16_t*)(P.ws + WS_WTOUT))
#define WTR ((bf16_t*)(P.ws + WS_WTR))
#define WTG ((bf16_t*)(P.ws + WS_WTG))
#define WTU ((bf16_t*)(P.ws + WS_WTU))
#define WTD ((bf16_t*)(P.ws + WS_WTD))
#define WTSG ((bf16_t*)(P.ws + WS_WTSG))
#define WTSU ((bf16_t*)(P.ws + WS_WTSU))
#define WTSD ((bf16_t*)(P.ws + WS_WTSD))
#define hbuf ((bf16_t*)(P.ws + WS_HBUF))
#define ybuf ((bf16_t*)(P.ws + WS_YBUF))
  {
    volatile LAS unsigned* st0 = (volatile LAS unsigned*)(smem + SM_MISC + 4080);
    if (threadIdx.x == 0) { st0[0] = 0u; st0[1] = 0u; }
    __syncthreads();
  }
  const int xcd = bid & 7, xloc = bid >> 3, xnl = nblk >> 3;
  XcdBarrier xb = xcd_barrier_post(barw, (volatile LAS unsigned*)(smem + SM_MISC + 4080));
  for (int it = bid; it < NTOK / 4; it += nblk) ph_cvt_x(it, xin, XBF);
  for (int it = bid; it < 16 * 46 + 16 * 16 + 16 * 4; it += nblk) {
    if (it < 16 * 46) ph_cvt_wt(smem, it % 16, it / 16, w_in, DM, INC, WTIN);
    else if (it < 16 * 46 + 256) { const int j = it - 16 * 46; ph_cvt_wt(smem, j % 16, j / 16, w_out, DM, DM, WTOUT); }
    else { const int j = it - 16 * 46 - 256; ph_cvt_wt(smem, j % 16, j / 16, router_w, DM, NEXP, WTR); }
  }
  for (int it = bid; it < 192; it += nblk) {
    if (it < 64) ph_cvt_wt(smem, it % 16, it / 16, sw_gate, DM, EFF, WTSG);
    else if (it < 128) ph_cvt_wt(smem, (it - 64) % 16, (it - 64) / 16, sw_up, DM, EFF, WTSU);
    else ph_cvt_wt(smem, (it - 128) % 4, (it - 128) / 4, sw_down, EFF, DM, WTSD);
  }
  grid.sync();
  for (int l = xloc; l < 64; l += xnl) ph_proj(smem, xcd, l, XBF, WTIN, proj, ba, VTb);
  xcd_barrier(xb);
  for (int it = bid; it < 2048; it += nblk) ph_dnchunk(smem, it, proj, ba, conv_w, a_log, dt_bias, QD, W0N, KTT, RV, TM, ATT, GL);
  for (int it = bid; it < 512; it += nblk) ph_swa(smem, it, proj, VTb, sinks, mixed);
  xcd_barrier(xb);
  if (bid < 64 || nblk <= 64) {
    for (int it = bid; it < 64; it += nblk) ph_dnscan(smem, it, QD, W0N, KTT, RV, TM, ATT, GL, obuf);
  }
  if (bid >= 64 || nblk <= 64) {
    const int tid = TIDX, lane = tid & 63, wv = tid >> 6;
    float* tile = (float*)(smem + wv * 8448);
    const int nconv = (nblk > 64) ? (nblk - 64) : nblk, cb = (nblk > 64) ? (bid - 64) : bid;
    const int step = nconv * 4, total = 256 * 384;
    int it = cb * 4 + wv;
    f32x4 vc[8], vn[8];
    CvtTile tc = cvt_decode(it < total ? it : 0, lane, w_gate, w_up, w_down, WTG, WTU, WTD);
    if (it < total) cvt_load(tc, vc);
    while (it < total) {
      const int itn = it + step;
      CvtTile tn = cvt_decode(itn < total ? itn : 0, lane, w_gate, w_up, w_down, WTG, WTU, WTD);
      if (itn < total) cvt_load(tn, vn);
      cvt_store(tile, lane, tc, vc);
#pragma unroll
      for (int i = 0; i < 8; ++i) vc[i] = vn[i];
      tc = tn; it = itn;
    }
  }
  xcd_barrier(xb);
  for (int it = bid; it < NTOK / 4; it += nblk) ph_dn_post(it, obuf, proj, dn_norm_g, mixed);
  xcd_barrier(xb);
  for (int l = xloc; l < 64; l += xnl) ph_wout(smem, xcd, l, mixed, WTOUT, xin, outp);
  xcd_barrier(xb);
  for (int it = bid; it < NTOK / 4; it += nblk) ph_ln1(it, outp, ln1_g, ln1_b, x1bf);
  xcd_barrier(xb);
  for (int i = xloc; i < 32 * 2; i += xnl) ph_router(smem, (xcd * 32 + i / 2) * 2 + i % 2, x1bf, WTR, logits);
  xcd_barrier(xb);
  for (int it = bid; it < NTOK / 4; it += nblk) ph_route(it, logits, router_bias, cnt, list, gates);
  xcd_barrier(xb);
  int* sscan = (int*)(smem + SM_MISC);
  moe_build_prefix(cnt, sscan);
  const int ntile = sscan[32 * xcd + 31] - (xcd ? sscan[32 * xcd - 1] : 0) + NTOK / 128 / 8;
  for (int it = xloc; it < ntile; it += xnl) {
    int e, rt; moe_locate(sscan, xcd, it, e, rt);
    ph_moe1(smem, e, rt, x1bf, cnt, list, (e < 256) ? WTG + (size_t)e * EFF * DM : WTSG, (e < 256) ? WTU + (size_t)e * EFF * DM : WTSU, hbuf);
  }
  xcd_barrier(xb);
  for (int it = xloc; it < ntile; it += xnl) {
    int e, rt; moe_locate(sscan, xcd, it, e, rt);
    ph_moe2(smem, e, rt, hbuf, cnt, list, gates, (e < 256) ? WTD + (size_t)e * DM * EFF : WTSD, ybuf, outp);
  }
  xcd_barrier(xb);
  for (int it = bid; it < NTOK / 4; it += nblk) ph_final(it, outp, ybuf, ln2_g, ln2_b);
}

#undef xin
#undef w_in
#undef conv_w
#undef a_log
#undef dt_bias
#undef dn_norm_g
#undef sinks
#undef w_out
#undef ln1_g
#undef ln1_b
#undef router_w
#undef router_bias
#undef w_gate
#undef w_up
#undef w_down
#undef sw_gate
#undef sw_up
#undef sw_down
#undef ln2_g
#undef ln2_b
#undef outp
#undef x1bf
#undef logits
#undef list
#undef gates
#undef cnt
#undef mixed
#undef proj
#undef ba
#undef QD
#undef W0N
#undef KTT
#undef RV
#undef TM
#undef ATT
#undef GL
#undef obuf
#undef hbuf
#undef ybuf
#undef VTb
#undef XBF
#undef WTIN
#undef WTOUT
#undef WTR
#undef WTG
#undef WTU
#undef WTD
#undef WTSG
#undef WTSU
#undef WTSD
#undef barw

extern "C" void kernel_launch(void* const* d_in, const int* in_sizes, int n_in, void* d_out, int out_size, void* d_ws, size_t ws_size, hipStream_t stream) {
  static int grid_blocks = 0;
  if (!grid_blocks) {
    int dev = 0, cus = 0, per_cu = 0;
    (void)hipGetDevice(&dev);
    (void)hipDeviceGetAttribute(&cus, hipDeviceAttributeMultiprocessorCount, dev);
    (void)hipOccupancyMaxActiveBlocksPerMultiprocessor(&per_cu, mega, 256, 0);
    if (per_cu > 2) per_cu = 2;
    if (per_cu < 1) per_cu = 1;
    grid_blocks = cus * per_cu;
  }
  Params p{};
  for (int i = 0; i < 20; ++i) p.in[i] = (const float*)d_in[i];
  p.out = (float*)d_out; p.ws = (char*)d_ws;
  (void)hipMemsetAsync((char*)d_ws + WS_CTRL, 0, 4096 + XCD_BAR_WORDS * 4, stream);
  void* args[] = {&p};
  hipError_t e = hipLaunchCooperativeKernel((void*)mega, dim3(grid_blocks), dim3(256), args, 0, stream);
  if (e != hipSuccess) fprintf(stderr, "cooperative launch failed: %s (grid %d)\n", hipGetErrorString(e), grid_blocks);
}
```

```cpp
#include <hip/hip_runtime.h>
#include <hip/hip_cooperative_groups.h>
#include <stdint.h>
#include <stdio.h>
namespace cg = cooperative_groups;

typedef __attribute__((ext_vector_type(8))) short bf16x8;
typedef __attribute__((ext_vector_type(4))) float f32x4;
typedef unsigned short bf16_t;
typedef __attribute__((ext_vector_type(4))) unsigned u32x4;
typedef __attribute__((ext_vector_type(2))) unsigned u32x2;

constexpr int NTOK = 32768, SEQ = 4096, DM = 1024;
constexpr int INC = 2824, PROJW = 2816;
constexpr int OFF_DQ = 0, OFF_DK = 512, OFF_DV = 1024, OFF_SQ = 1536, OFF_SK = 2048, OFF_SV = 2176, OFF_Z = 2304;
constexpr int NEXP = 256, TOPK = 8, EFF = 256;
constexpr int NA = NTOK * TOPK;
constexpr int CAP = NTOK;
constexpr float ALPHA = 1.189207115002721f;
constexpr float LN_EPS = 1e-5f, RMS_EPS = 1e-6f, L2_EPS = 1e-6f;

constexpr size_t MiB = 1024ull * 1024ull;
constexpr size_t WS_WTD = 0;
constexpr size_t WS_WTG = 128 * MiB;
constexpr size_t WS_WTU = 256 * MiB;
constexpr size_t WS_YBUF = 128 * MiB;
constexpr size_t WS_HBUF = 640 * MiB;
constexpr size_t WS_X1BF = 784 * MiB;
constexpr size_t WS_LIST = 848 * MiB;
constexpr size_t WS_GATES = 880 * MiB;
constexpr size_t WS_CTRL = 881 * MiB;
constexpr size_t WS_LOGIT = 882 * MiB;
constexpr size_t WS_WTIN = 914 * MiB;
constexpr size_t WS_WTOUT = 920 * MiB;
constexpr size_t WS_WTR = 922 * MiB;
constexpr size_t WS_WTSG = 923 * MiB;
constexpr size_t WS_WTSU = WS_WTSG + 512 * 1024;
constexpr size_t WS_WTSD = 924 * MiB;
constexpr size_t WS_PROJ = 384 * MiB;
constexpr size_t WS_BA = 560 * MiB;
constexpr size_t WS_QD = 561 * MiB;
constexpr size_t WS_W0N = 593 * MiB;
constexpr size_t WS_KTT = 625 * MiB;
constexpr size_t WS_RV = 657 * MiB;
constexpr size_t WS_TM = 689 * MiB;
constexpr size_t WS_ATT = 705 * MiB;
constexpr size_t WS_GL = 721 * MiB;
constexpr size_t WS_O = 722 * MiB;
constexpr size_t WS_VT = 786 * MiB;
constexpr size_t WS_MIXED = 794 * MiB;
constexpr size_t WS_XBF = 640 * MiB;

__device__ __forceinline__ int opaque_tid() { int t = threadIdx.x; asm volatile("" : "+v"(t)); return t; }
#define TIDX opaque_tid()
typedef __attribute__((ext_vector_type(2))) __bf16 hwbf16x2;
typedef __attribute__((ext_vector_type(2))) float hwf32x2;
__device__ __forceinline__ unsigned pack2(float lo, float hi) {
  hwf32x2 f = {lo, hi};
  return __builtin_bit_cast(unsigned, __builtin_convertvector(f, hwbf16x2));
}
__device__ __forceinline__ unsigned f2bf(float f) { return pack2(f, 0.f) & 0xffffu; }
__device__ __forceinline__ float bf2f(unsigned h) { return __uint_as_float(h << 16); }
__device__ __forceinline__ float bflo(unsigned w) { return __uint_as_float(w << 16); }
__device__ __forceinline__ float bfhi(unsigned w) { return __uint_as_float(w & 0xffff0000u); }
__device__ __forceinline__ float siluf(float x) { return x / (1.f + __expf(-x)); }
__device__ __forceinline__ float sigmoidf(float x) { return 1.f / (1.f + __expf(-x)); }
__device__ __forceinline__ float wave_sum(float v) {
#pragma unroll
  for (int o = 32; o > 0; o >>= 1) v += __shfl_xor(v, o);
  return v;
}

template <int SEGDIV>
struct LdRowBF16T {
  const char* p[4]; size_t seghi, seglo; int tid16;
  template <class F> __device__ __forceinline__ void init(F rowptr, size_t hi, size_t lo = 0) {
    const int tid = TIDX; const int slot = tid & 7, row0 = tid >> 3; seghi = hi; seglo = lo; tid16 = tid * 16;
#pragma unroll
    for (int i = 0; i < 4; ++i) p[i] = (const char*)rowptr(row0 + i * 32) + ((slot ^ (row0 & 7)) << 4);
  }
  __device__ __forceinline__ void issue(int seg, int kk, unsigned char* lds) {
    const size_t off = (size_t)(seg / SEGDIV) * seghi + (size_t)(seg % SEGDIV) * seglo + (size_t)kk * 128;
#pragma unroll
    for (int i = 0; i < 4; ++i)
      __builtin_amdgcn_global_load_lds((const unsigned*)(p[i] + off), (__attribute__((address_space(3))) unsigned*)(lds + tid16 + i * 4096), 16, 0, 0);
  }
};
typedef LdRowBF16T<1> LdRowBF16;
struct LdColF32 {
  const char* p; size_t ldb, segb; f32x4 r[2][8]; int n4, kg;
  __device__ __forceinline__ void init(const float* colptr, size_t ld, size_t seg_bytes) {
    const int tid = TIDX; n4 = tid & 31; kg = tid >> 5; ldb = ld * 4; segb = seg_bytes;
    p = (const char*)colptr + (size_t)(kg * 8) * ldb;
  }
  template <int S> __device__ __forceinline__ void load(int seg, int kk) {
#pragma unroll
    for (int j = 0; j < 8; ++j) r[S][j] = *(const f32x4*)(p + (size_t)seg * segb + (size_t)(kk * 64 + j) * ldb);
  }
  template <int S> __device__ __forceinline__ void store(unsigned char* s) {
#pragma unroll
    for (int i = 0; i < 4; ++i) {
      const int row = n4 * 4 + i; u32x4 w;
      w[0] = pack2(r[S][0][i], r[S][1][i]); w[1] = pack2(r[S][2][i], r[S][3][i]); w[2] = pack2(r[S][4][i], r[S][5][i]); w[3] = pack2(r[S][6][i], r[S][7][i]);
      *(u32x4*)(s + row * 128 + ((kg ^ (row & 7)) << 4)) = w;
    }
  }
};

__device__ __forceinline__ void gemm_kstep(const unsigned char* sA, const unsigned char* sB, f32x4 (&acc)[4][4], int wr, int wc, int fr, int fq) {
#pragma unroll
  for (int ks = 0; ks < 2; ++ks) {
    bf16x8 a[4], b[4];
#pragma unroll
    for (int m = 0; m < 4; ++m) {
      const int row = wr * 64 + m * 16 + fr;
      a[m] = *(const bf16x8*)(sA + row * 128 + (((ks * 4 + fq) ^ (row & 7)) << 4));
    }
#pragma unroll
    for (int n = 0; n < 4; ++n) {
      const int row = wc * 64 + n * 16 + fr;
      b[n] = *(const bf16x8*)(sB + row * 128 + (((ks * 4 + fq) ^ (row & 7)) << 4));
    }
#pragma unroll
    for (int m = 0; m < 4; ++m)
#pragma unroll
      for (int n = 0; n < 4; ++n) acc[m][n] = __builtin_amdgcn_mfma_f32_16x16x32_bf16(b[n], a[m], acc[m][n], 0, 0, 0);
  }
}
template <int KPER, class AL, class BL, class Epi>
__device__ __forceinline__ void gemm_stream(unsigned char* smem, AL& al, BL& bl, int nseg, Epi epi) {
  const int tid = TIDX, lane = tid & 63, wid = tid >> 6, wr = wid >> 1, wc = wid & 1, fr = lane & 15, fq = lane >> 4;
  const int total = nseg * KPER;
  f32x4 acc[4][4];
  al.issue(0, 0, smem); bl.issue(0, 0, smem + 16384);
  asm volatile("s_waitcnt vmcnt(0)" ::: "memory");
  __syncthreads();
  for (int j = 0; j < total; ++j) {
    unsigned char* cur = smem + (j & 1) * 32768; unsigned char* nxt = smem + ((j & 1) ^ 1) * 32768;
    if (j + 1 < total) { al.issue((j + 1) / KPER, (j + 1) % KPER, nxt); bl.issue((j + 1) / KPER, (j + 1) % KPER, nxt + 16384); }
    if (j % KPER == 0) {
#pragma unroll
      for (int m = 0; m < 4; ++m)
#pragma unroll
        for (int n = 0; n < 4; ++n) acc[m][n] = (f32x4){0.f, 0.f, 0.f, 0.f};
    }
    gemm_kstep(cur, cur + 16384, acc, wr, wc, fr, fq);
    asm volatile("s_waitcnt vmcnt(0)" ::: "memory");
    __syncthreads();
    if ((j + 1) % KPER == 0) epi((j + 1) / KPER - 1, acc);
  }
}

#define GEMM_IDS const int tid = TIDX, lane = tid & 63, wid = tid >> 6, wr = wid >> 1, wc = wid & 1, fr = lane & 15, fq = lane >> 4; (void)tid; (void)lane;

struct Params {
  const float* in[20];
  float* out;
  char* ws;
};

constexpr int SMEM_BYTES = 69632;
constexpr int SM_MISC = 65536;

__device__ __forceinline__ void ph_cvt_x(int item, const float* __restrict__ x, bf16_t* __restrict__ xbf) {
  const int tid = TIDX;
  const size_t base = (size_t)item * 4096 + (size_t)tid * 4;
#pragma unroll
  for (int i = 0; i < 4; ++i) {
    const f32x4 v = *(const f32x4*)(x + base + (size_t)i * 1024);
    u32x2 w; w[0] = pack2(v[0], v[1]); w[1] = pack2(v[2], v[3]);
    *(u32x2*)(xbf + base + (size_t)i * 1024) = w;
  }
}
__device__ __forceinline__ void ph_cvt_wt(unsigned char* smem, int kt, int nt, const float* __restrict__ W, int K, int N, bf16_t* __restrict__ WT) {
  float* tile = (float*)smem;
  const int tid = TIDX;
  const int k0 = kt * 64, n0 = nt * 64;
  __syncthreads();
#pragma unroll
  for (int i = 0; i < 4; ++i) {
    const int k = (tid >> 4) + 16 * i, n = 4 * (tid & 15);
    f32x4 v = (f32x4){0.f, 0.f, 0.f, 0.f};
    if (n0 + n < N) v = *(const f32x4*)(W + (size_t)(k0 + k) * N + n0 + n);
    tile[k * 65 + n + 0] = v[0]; tile[k * 65 + n + 1] = v[1]; tile[k * 65 + n + 2] = v[2]; tile[k * 65 + n + 3] = v[3];
  }
  __syncthreads();
  const int n = tid >> 2, kq = tid & 3;
  u32x4 w0, w1;
#pragma unroll
  for (int j = 0; j < 4; ++j) {
    w0[j] = pack2(tile[(kq * 16 + 2 * j) * 65 + n], tile[(kq * 16 + 2 * j + 1) * 65 + n]);
    w1[j] = pack2(tile[(kq * 16 + 8 + 2 * j) * 65 + n], tile[(kq * 16 + 8 + 2 * j + 1) * 65 + n]);
  }
  bf16_t* dst = WT + (size_t)(n0 + n) * K + k0 + kq * 16;
  *(u32x4*)dst = w0; *(u32x4*)(dst + 8) = w1;
}

struct CvtTile { const float* src; bf16_t* dst; int ldn; };
__device__ __forceinline__ CvtTile cvt_decode(int it, int lane, const float* __restrict__ w_gate, const float* __restrict__ w_up, const float* __restrict__ w_down,
                                              bf16_t* __restrict__ wtg, bf16_t* __restrict__ wtu, bf16_t* __restrict__ wtd) {
  const int e = it / 384, j = it % 384;
  const float* W; bf16_t* WT; int K, N, kt, nt;
  if (j < 128) { W = w_gate + (size_t)e * DM * EFF; WT = wtg + (size_t)e * EFF * DM; K = DM; N = EFF; kt = j & 31; nt = j >> 5; }
  else if (j < 256) { W = w_up + (size_t)e * DM * EFF; WT = wtu + (size_t)e * EFF * DM; K = DM; N = EFF; kt = (j - 128) & 31; nt = (j - 128) >> 5; }
  else { W = w_down + (size_t)e * EFF * DM; WT = wtd + (size_t)e * DM * EFF; K = EFF; N = DM; kt = (j - 256) & 7; nt = (j - 256) >> 3; }
  CvtTile t;
  t.src = W + (size_t)(kt * 32 + (lane >> 4)) * N + nt * 64 + 4 * (lane & 15);
  t.dst = WT + (size_t)(nt * 64 + lane) * K + kt * 32;
  t.ldn = 4 * N;
  return t;
}
__device__ __forceinline__ void cvt_load(const CvtTile& t, f32x4 (&v)[8]) {
#pragma unroll
  for (int i = 0; i < 8; ++i) v[i] = *(const f32x4*)(t.src + (size_t)i * t.ldn);
}
__device__ __forceinline__ void cvt_store(float* tile  , int lane, const CvtTile& t, const f32x4 (&v)[8]) {
#pragma unroll
  for (int i = 0; i < 8; ++i) {
    float* p = tile + ((lane >> 4) + 4 * i) * 65 + 4 * (lane & 15);
    p[0] = v[i][0]; p[1] = v[i][1]; p[2] = v[i][2]; p[3] = v[i][3];
  }
  u32x4 w[4];
#pragma unroll
  for (int q = 0; q < 4; ++q)
#pragma unroll
    for (int j = 0; j < 4; ++j) w[q][j] = pack2(tile[(8 * q + 2 * j) * 65 + lane], tile[(8 * q + 2 * j + 1) * 65 + lane]);
#pragma unroll
  for (int q = 0; q < 4; ++q) *(u32x4*)(t.dst + 8 * q) = w[q];
}

__device__ __forceinline__ void ph_proj(unsigned char* smem, int xcd, int l, const bf16_t* __restrict__ xbf, const bf16_t* __restrict__ wt, bf16_t* __restrict__ proj, float* __restrict__ ba, bf16_t* __restrict__ vt) {
  const int mi = l >> 3, ni = l & 7;
  LdRowBF16T<3> al; al.init([&](int r) { return xbf + (size_t)((xcd * 32 + mi) * 128 + r) * DM; }, (size_t)8 * 128 * DM * 2, 0);
  LdRowBF16T<3> bl; bl.init([&](int r) { return wt + (size_t)(ni * 128 + r) * DM; }, 0, (size_t)8 * 128 * DM * 2);
  gemm_stream<16>(smem, al, bl, 12, [&](int seg, f32x4 (&acc)[4][4]) {
    GEMM_IDS
    const int nt = (seg % 3) * 8 + ni;
    if (nt < 23) {
      const int m0 = (xcd * 32 + (seg / 3) * 8 + mi) * 128, n0 = nt * 128;
#pragma unroll
      for (int m = 0; m < 4; ++m)
#pragma unroll
        for (int n = 0; n < 4; ++n) {
          const int row = m0 + wr * 64 + m * 16 + fr, col = n0 + wc * 64 + n * 16 + fq * 4;
          if (col < PROJW) {
            u32x2 w; w[0] = pack2(acc[m][n][0], acc[m][n][1]); w[1] = pack2(acc[m][n][2], acc[m][n][3]);
            *(u32x2*)(proj + (size_t)row * PROJW + col) = w;
          } else if (col < INC) {
            *(f32x4*)(ba + (size_t)row * 8 + (col - PROJW)) = acc[m][n];
          }
        }
      if (n0 == OFF_SV) {
#pragma unroll
        for (int m = 0; m < 4; ++m)
#pragma unroll
          for (int n = 0; n < 4; ++n) {
            const int row = m0 + wr * 64 + m * 16 + fr, c = wc * 64 + n * 16 + fq * 4;
            const int bb = row / SEQ, t = row % SEQ;
#pragma unroll
            for (int r = 0; r < 4; ++r) vt[((size_t)(bb * 128 + c + r)) * SEQ + t] = (bf16_t)f2bf(acc[m][n][r]);
          }
      }
    }
  });
}

__device__ __forceinline__ bf16x8 pack8(f32x4 a, f32x4 b) {
  union { bf16x8 v; unsigned u[4]; } x;
  x.u[0] = pack2(a[0], a[1]); x.u[1] = pack2(a[2], a[3]); x.u[2] = pack2(b[0], b[1]); x.u[3] = pack2(b[2], b[3]);
  return x.v;
}
__device__ __forceinline__ void ph_dnchunk(unsigned char* smem, int item, const bf16_t* __restrict__ proj, const float* __restrict__ ba, const float* __restrict__ conv_w,
                                           const float* __restrict__ a_log, const float* __restrict__ dt_bias,
                                           bf16_t* __restrict__ QD, bf16_t* __restrict__ W0N, bf16_t* __restrict__ KTT, bf16_t* __restrict__ RV,
                                           bf16_t* __restrict__ TM, bf16_t* __restrict__ ATT, float* __restrict__ GL) {
  const int tid = TIDX, lane = tid & 63, w = tid >> 6, fr = lane & 15, fq = lane >> 4;
  const int n = item & 63, h = (item >> 6) & 3, b = item >> 8;
  const int t0 = n * 64; const size_t row0 = (size_t)b * SEQ + t0;
  unsigned char* qs = smem; unsigned char* ks = smem + 16384; float* AT = (float*)(smem + 32768);
  const float scale = 0.08838834764831845f;
  float bL, gcL;
  {
    const float* bap = ba + (row0 + lane) * 8;
    bL = sigmoidf(bap[h]);
    const float xx = bap[4 + h] + dt_bias[h];
    const float sp = fmaxf(xx, 0.f) + log1pf(__expf(-fabsf(xx)));
    float gg = -__expf(a_log[h]) * sp;
#pragma unroll
    for (int o = 1; o < 64; o <<= 1) { const float v = __shfl_up(gg, o); if (lane >= o) gg += v; }
    gcL = gg;
  }
  {
    const int d = 2 * lane;
    float cw[3][4][2];
#pragma unroll
    for (int mx = 0; mx < 3; ++mx)
#pragma unroll
      for (int j = 0; j < 4; ++j) {
        const float2 c2 = *(const float2*)(conv_w + j * 1536 + mx * 512 + h * 128 + d);
        cw[mx][j][0] = c2.x; cw[mx][j][1] = c2.y;
      }
    const bf16_t* pbase = proj + (row0 + 16 * w) * PROJW + h * 128 + d;
    unsigned raw[3][19];
#pragma unroll
    for (int j = 0; j < 19; ++j) {
      const bool ok = (t0 + 16 * w - 3 + j) >= 0;
#pragma unroll
      for (int mx = 0; mx < 3; ++mx) {
        unsigned u = 0;
        if (ok) u = *(const unsigned*)(pbase + (ptrdiff_t)(j - 3) * PROJW + mx * 512);
        raw[mx][j] = u;
      }
    }
#pragma unroll
    for (int i = 0; i < 16; ++i) {
      float s[3][2];
#pragma unroll
      for (int mx = 0; mx < 3; ++mx) {
        float y0 = 0.f, y1 = 0.f;
#pragma unroll
        for (int j = 0; j < 4; ++j) { y0 += cw[mx][j][0] * bflo(raw[mx][i + j]); y1 += cw[mx][j][1] * bfhi(raw[mx][i + j]); }
        s[mx][0] = siluf(y0); s[mx][1] = siluf(y1);
      }
      const int row = 16 * w + i;
      const float rq = rsqrtf(wave_sum(s[0][0] * s[0][0] + s[0][1] * s[0][1]) + L2_EPS);
      const float rk = rsqrtf(wave_sum(s[1][0] * s[1][0] + s[1][1] * s[1][1]) + L2_EPS);
      const int off = row * 256 + ((((lane >> 2) ^ (row & 15))) << 4) + (lane & 3) * 4;
      *(unsigned*)(qs + off) = pack2(s[0][0] * rq, s[0][1] * rq);
      *(unsigned*)(ks + off) = pack2(s[1][0] * rk, s[1][1] * rk);
      const float bi = __shfl(bL, row);
      *(unsigned*)(RV + ((size_t)item * 64 + row) * 128 + d) = pack2(bi * s[2][0], bi * s[2][1]);
    }
  }
  __syncthreads();
  {
    f32x4 aKK[4], aQK[4];
#pragma unroll
    for (int nt = 0; nt < 4; ++nt) { aKK[nt] = (f32x4){0.f, 0.f, 0.f, 0.f}; aQK[nt] = (f32x4){0.f, 0.f, 0.f, 0.f}; }
#pragma unroll
    for (int k4 = 0; k4 < 4; ++k4) {
      const int arow = 16 * w + fr;
      const bf16x8 aq = *(const bf16x8*)(qs + arow * 256 + ((((k4 * 4 + fq) ^ (arow & 15))) << 4));
      const bf16x8 ak = *(const bf16x8*)(ks + arow * 256 + ((((k4 * 4 + fq) ^ (arow & 15))) << 4));
#pragma unroll
      for (int nt = 0; nt < 4; ++nt) {
        const int brow = 16 * nt + fr;
        const bf16x8 bk = *(const bf16x8*)(ks + brow * 256 + ((((k4 * 4 + fq) ^ (brow & 15))) << 4));
        aKK[nt] = __builtin_amdgcn_mfma_f32_16x16x32_bf16(ak, bk, aKK[nt], 0, 0, 0);
        aQK[nt] = __builtin_amdgcn_mfma_f32_16x16x32_bf16(aq, bk, aQK[nt], 0, 0, 0);
      }
    }
    float gci[4], bi[4];
#pragma unroll
    for (int r = 0; r < 4; ++r) { gci[r] = __shfl(gcL, 16 * w + 4 * fq + r); bi[r] = __shfl(bL, 16 * w + 4 * fq + r); }
#pragma unroll
    for (int nt = 0; nt < 4; ++nt) {
      const int j = 16 * nt + fr;
      const float gcj = __shfl(gcL, j);
      const int p = 32 * (nt >> 1) + 8 * (fr >> 2) + 4 * (nt & 1) + (fr & 3);
      float av[4];
#pragma unroll
      for (int r = 0; r < 4; ++r) {
        const int i = 16 * w + 4 * fq + r;
        const float dec = (j <= i) ? __expf(gci[r] - gcj) : 0.f;
        av[r] = (j < i) ? bi[r] * aKK[nt][r] * dec : 0.f;
        ATT[((size_t)item * 64 + i) * 64 + p] = (bf16_t)f2bf(aQK[nt][r] * scale * dec);
      }
      *(float4*)(AT + j * 68 + 16 * w + 4 * fq) = make_float4(av[0], av[1], av[2], av[3]);
    }
  }
  __syncthreads();
  if (w == 0) {
    float Tr[64];
    int ln = lane; asm volatile("" : "+v"(ln));
#pragma unroll
    for (int j = 0; j < 64; ++j) Tr[j] = 0.f;
    f32x4 cur[16], nxt[16];
#pragma unroll
    for (int j4 = 0; j4 < 16; ++j4) nxt[j4] = (f32x4){0.f, 0.f, 0.f, 0.f};
#pragma unroll
    for (int j4 = 15; j4 >= 16; --j4) cur[j4] = *(const f32x4*)(AT + 63 * 68 + j4 * 4);
#pragma unroll
    for (int c = 63; c >= 0; --c) {
      if (c > 0) {
#pragma unroll
        for (int j4 = 15; j4 >= c / 4; --j4) nxt[j4] = *(const f32x4*)(AT + (c - 1) * 68 + j4 * 4);
      }
      float a0 = 0.f, a1 = 0.f, a2 = 0.f, a3 = 0.f;
#pragma unroll
      for (int j4 = 15; j4 >= (c + 1) / 4; --j4) {
        asm volatile("v_fmac_f32 %0, %1, %2" : "+v"(a0) : "v"(Tr[4 * j4 + 0]), "v"(cur[j4][0]));
        asm volatile("v_fmac_f32 %0, %1, %2" : "+v"(a1) : "v"(Tr[4 * j4 + 1]), "v"(cur[j4][1]));
        asm volatile("v_fmac_f32 %0, %1, %2" : "+v"(a2) : "v"(Tr[4 * j4 + 2]), "v"(cur[j4][2]));
        asm volatile("v_fmac_f32 %0, %1, %2" : "+v"(a3) : "v"(Tr[4 * j4 + 3]), "v"(cur[j4][3]));
      }
      Tr[c] = ((ln == c) ? 1.f : 0.f) - ((a0 + a1) + (a2 + a3));
#pragma unroll
      for (int j4 = 0; j4 < 16; ++j4) cur[j4] = nxt[j4];
    }
    u32x4* tp = (u32x4*)(TM + ((size_t)item * 64 + lane) * 64);
#pragma unroll
    for (int oc = 0; oc < 8; ++oc) {
      const int k0 = 32 * (oc >> 2) + 4 * (oc & 3);
      u32x4 v;
      v[0] = pack2(Tr[k0 + 0], Tr[k0 + 1]); v[1] = pack2(Tr[k0 + 2], Tr[k0 + 3]);
      v[2] = pack2(Tr[k0 + 16], Tr[k0 + 17]); v[3] = pack2(Tr[k0 + 18], Tr[k0 + 19]);
      tp[oc] = v;
    }
  } else {
    const float gclast = __shfl(gcL, 63);
    if (tid == 64) GL[item] = __expf(gclast);
#pragma unroll 1
    for (int it = 0; it < 16; ++it) {
      const int idx = (tid - 64) + it * 192;
      const int mtx = idx >> 10, rem = idx & 1023;
      if (mtx < 2) {
        const int i = rem >> 4, oc = rem & 15;
        const float gi = __shfl(gcL, i), bi = __shfl(bL, i);
        const float f = (mtx == 0) ? scale * __expf(gi) : -bi * __expf(gi);
        const unsigned char* st = (mtx == 0) ? qs : ks;
        const int d0 = 32 * (oc >> 2) + 4 * (oc & 3);
        const uint2 lo = *(const uint2*)(st + i * 256 + ((((d0 >> 3) ^ (i & 15))) << 4) + (d0 & 7) * 2);
        const uint2 hi = *(const uint2*)(st + i * 256 + (((((d0 + 16) >> 3) ^ (i & 15))) << 4) + (d0 & 7) * 2);
        u32x4 v;
        v[0] = pack2(bflo(lo.x) * f, bfhi(lo.x) * f); v[1] = pack2(bflo(lo.y) * f, bfhi(lo.y) * f);
        v[2] = pack2(bflo(hi.x) * f, bfhi(hi.x) * f); v[3] = pack2(bflo(hi.y) * f, bfhi(hi.y) * f);
        bf16_t* dst = ((mtx == 0) ? QD : W0N) + ((size_t)item * 64 + i) * 128 + 8 * oc;
        *(u32x4*)dst = v;
      } else {
        const int d = rem & 127, oc = rem >> 7;
        const int j0 = 32 * (oc >> 2) + 4 * (oc & 3);
        float val[8];
#pragma unroll
        for (int e = 0; e < 8; ++e) {
          const int j = j0 + (e & 3) + ((e >> 2) << 4);
          const float f = __expf(gclast - __shfl(gcL, j));
          const unsigned short raw = *(const unsigned short*)(ks + j * 256 + ((((d >> 3) ^ (j & 15))) << 4) + (d & 7) * 2);
          val[e] = bf2f(raw) * f;
        }
        u32x4 v;
        v[0] = pack2(val[0], val[1]); v[1] = pack2(val[2], val[3]); v[2] = pack2(val[4], val[5]); v[3] = pack2(val[6], val[7]);
        *(u32x4*)(KTT + ((size_t)item * 128 + d) * 64 + 8 * oc) = v;
      }
    }
  }
  __syncthreads();
}

__device__ __forceinline__ void ph_dnscan(unsigned char* smem, int item, const bf16_t* __restrict__ QDp, const bf16_t* __restrict__ W0Np, const bf16_t* __restrict__ KTTp,
                                          const bf16_t* __restrict__ RVp, const bf16_t* __restrict__ TMp, const bf16_t* __restrict__ ATTp, const float* __restrict__ GLp,
                                          float* __restrict__ op) {
  const int tid = TIDX, lane = tid & 63, w = tid >> 6, fr = lane & 15, fq = lane >> 4;
  const int bh = item >> 1, half = item & 1, b = bh >> 2, h = bh & 3;
  const int vcol0 = (half * 4 + w) * 16;
  unsigned char* sW0 = smem; unsigned char* sQD = smem + 16384; unsigned char* sKT = smem + 32768; unsigned char* sT = smem + 49152; unsigned char* sAT = smem + 57344;
  f32x4 S[8];
#pragma unroll
  for (int t = 0; t < 8; ++t) S[t] = (f32x4){0.f, 0.f, 0.f, 0.f};
  u32x4 pfA[8], pfB[8]; unsigned short rvp[16];
#define DN_LOAD_A(nn_) do { \
    const size_t ci = (size_t)bh * 64 + (nn_); \
    _Pragma("unroll") for (int i = 0; i < 4; ++i) pfA[i] = *(const u32x4*)((const char*)W0Np + ci * 16384 + (size_t)(tid + 256 * i) * 16); \
    _Pragma("unroll") for (int i = 0; i < 4; ++i) pfA[4 + i] = *(const u32x4*)((const char*)QDp + ci * 16384 + (size_t)(tid + 256 * i) * 16); \
    _Pragma("unroll") for (int mt = 0; mt < 4; ++mt) \
      _Pragma("unroll") for (int r = 0; r < 4; ++r) rvp[mt * 4 + r] = RVp[(ci * 64 + 16 * mt + 4 * fq + r) * 128 + vcol0 + fr]; \
  } while (0)
#define DN_STORE_A() do { \
    _Pragma("unroll") for (int i = 0; i < 4; ++i) { const int q = tid + 256 * i, row = q >> 4, ch = q & 15; *(u32x4*)(sW0 + row * 256 + ((ch ^ (row & 15)) << 4)) = pfA[i]; } \
    _Pragma("unroll") for (int i = 0; i < 4; ++i) { const int q = tid + 256 * i, row = q >> 4, ch = q & 15; *(u32x4*)(sQD + row * 256 + ((ch ^ (row & 15)) << 4)) = pfA[4 + i]; } \
  } while (0)
#define DN_LOAD_B(nn_) do { \
    const size_t ci = (size_t)bh * 64 + (nn_); \
    _Pragma("unroll") for (int i = 0; i < 4; ++i) pfB[i] = *(const u32x4*)((const char*)KTTp + ci * 16384 + (size_t)(tid + 256 * i) * 16); \
    _Pragma("unroll") for (int i = 0; i < 2; ++i) pfB[4 + i] = *(const u32x4*)((const char*)TMp + ci * 8192 + (size_t)(tid + 256 * i) * 16); \
    _Pragma("unroll") for (int i = 0; i < 2; ++i) pfB[6 + i] = *(const u32x4*)((const char*)ATTp + ci * 8192 + (size_t)(tid + 256 * i) * 16); \
  } while (0)
#define DN_STORE_B() do { \
    _Pragma("unroll") for (int i = 0; i < 4; ++i) { const int q = tid + 256 * i, row = q >> 3, ch = q & 7; *(u32x4*)(sKT + row * 128 + ((ch ^ (row & 7)) << 4)) = pfB[i]; } \
    _Pragma("unroll") for (int i = 0; i < 2; ++i) { const int q = tid + 256 * i, row = q >> 3, ch = q & 7; *(u32x4*)(sT + row * 128 + ((ch ^ (row & 7)) << 4)) = pfB[4 + i]; } \
    _Pragma("unroll") for (int i = 0; i < 2; ++i) { const int q = tid + 256 * i, row = q >> 3, ch = q & 7; *(u32x4*)(sAT + row * 128 + ((ch ^ (row & 7)) << 4)) = pfB[6 + i]; } \
  } while (0)
#define DN_ZINIT() do { _Pragma("unroll") for (int mt = 0; mt < 4; ++mt) Z[mt] = (f32x4){bf2f(rvp[mt * 4 + 0]), bf2f(rvp[mt * 4 + 1]), bf2f(rvp[mt * 4 + 2]), bf2f(rvp[mt * 4 + 3])}; } while (0)
  __syncthreads();
  f32x4 Z[4];
  DN_LOAD_A(0);
  DN_LOAD_B(0);
  DN_STORE_A();
  DN_ZINIT();
  DN_LOAD_A(1);
  for (int nn = 0; nn < 64; ++nn) {
    const float gl = GLp[(size_t)bh * 64 + nn];
    __syncthreads();
    bf16x8 Sb[4];
#pragma unroll
    for (int k4 = 0; k4 < 4; ++k4) Sb[k4] = pack8(S[2 * k4], S[2 * k4 + 1]);
    f32x4 O[4];
#pragma unroll
    for (int mt = 0; mt < 4; ++mt) {
      O[mt] = (f32x4){0.f, 0.f, 0.f, 0.f};
      const int row = 16 * mt + fr;
#pragma unroll
      for (int k4 = 0; k4 < 4; ++k4) {
        const int off = row * 256 + ((((k4 * 4 + fq) ^ fr)) << 4);
        const bf16x8 aw = *(const bf16x8*)(sW0 + off);
        const bf16x8 aq = *(const bf16x8*)(sQD + off);
        Z[mt] = __builtin_amdgcn_mfma_f32_16x16x32_bf16(aw, Sb[k4], Z[mt], 0, 0, 0);
        O[mt] = __builtin_amdgcn_mfma_f32_16x16x32_bf16(aq, Sb[k4], O[mt], 0, 0, 0);
      }
    }
    bf16x8 Zb[2];
    Zb[0] = pack8(Z[0], Z[1]); Zb[1] = pack8(Z[2], Z[3]);
    DN_STORE_B();
    if (nn + 1 < 64) DN_LOAD_B(nn + 1);
    __syncthreads();
    f32x4 Vn[4];
#pragma unroll
    for (int mt = 0; mt < 4; ++mt) {
      Vn[mt] = (f32x4){0.f, 0.f, 0.f, 0.f};
      const int row = 16 * mt + fr;
#pragma unroll
      for (int s = 0; s < 2; ++s) {
        if (s <= (mt >> 1)) {
          const bf16x8 at = *(const bf16x8*)(sT + row * 128 + ((((s * 4 + fq) ^ (row & 7))) << 4));
          Vn[mt] = __builtin_amdgcn_mfma_f32_16x16x32_bf16(at, Zb[s], Vn[mt], 0, 0, 0);
        }
      }
    }
    bf16x8 Vb[2];
    Vb[0] = pack8(Vn[0], Vn[1]); Vb[1] = pack8(Vn[2], Vn[3]);
#pragma unroll
    for (int mt = 0; mt < 4; ++mt) {
      const int row = 16 * mt + fr;
#pragma unroll
      for (int s = 0; s < 2; ++s) {
        if (s <= (mt >> 1)) {
          const bf16x8 aa = *(const bf16x8*)(sAT + row * 128 + ((((s * 4 + fq) ^ (row & 7))) << 4));
          O[mt] = __builtin_amdgcn_mfma_f32_16x16x32_bf16(aa, Vb[s], O[mt], 0, 0, 0);
        }
      }
      const size_t tok = (size_t)b * SEQ + nn * 64 + 16 * mt + 4 * fq;
#pragma unroll
      for (int r = 0; r < 4; ++r) op[(tok + r) * 512 + h * 128 + vcol0 + fr] = O[mt][r];
    }
#pragma unroll
    for (int t = 0; t < 8; ++t) {
      S[t] = S[t] * gl;
      const int row = 16 * t + fr;
#pragma unroll
      for (int s = 0; s < 2; ++s) {
        const bf16x8 ak = *(const bf16x8*)(sKT + row * 128 + ((((s * 4 + fq) ^ (row & 7))) << 4));
        S[t] = __builtin_amdgcn_mfma_f32_16x16x32_bf16(ak, Vb[s], S[t], 0, 0, 0);
      }
    }
    if (nn + 1 < 64) {
      DN_STORE_A();
      DN_ZINIT();
      if (nn + 2 < 64) DN_LOAD_A(nn + 2);
    }
  }
  __syncthreads();
#undef DN_ZINIT
#undef DN_LOAD_A
#undef DN_STORE_A
#undef DN_LOAD_B
#undef DN_STORE_B
}

__device__ __forceinline__ void ph_dn_post(int item, const float* __restrict__ o, const bf16_t* __restrict__ proj, const float* __restrict__ dn_norm_g, bf16_t* __restrict__ mixed) {
  const int tid = TIDX, h = tid >> 6, lane = tid & 63;
  const float2 g2 = *(const float2*)(dn_norm_g + 2 * lane);
  float2 ov[4]; unsigned zv[4];
#pragma unroll
  for (int i = 0; i < 4; ++i) {
    const size_t n = (size_t)item * 4 + i;
    ov[i] = *(const float2*)(o + n * 512 + h * 128 + 2 * lane);
    zv[i] = *(const unsigned*)(proj + n * PROJW + OFF_Z + h * 128 + 2 * lane);
  }
#pragma unroll
  for (int i = 0; i < 4; ++i) {
    const size_t n = (size_t)item * 4 + i;
    const float ss = wave_sum(ov[i].x * ov[i].x + ov[i].y * ov[i].y);
    const float rn = rsqrtf(ss * (1.f / 128.f) + RMS_EPS);
    *(unsigned*)(mixed + n * DM + h * 128 + 2 * lane) = pack2(ov[i].x * rn * g2.x * siluf(bflo(zv[i])), ov[i].y * rn * g2.y * siluf(bfhi(zv[i])));
  }
}

__device__ __forceinline__ void ph_swa(unsigned char* smem, int item, const bf16_t* __restrict__ proj, const bf16_t* __restrict__ vt, const float* __restrict__ sinks, bf16_t* __restrict__ mixed) {
  const int tid = TIDX, lane = tid & 63, w = tid >> 6, fr = lane & 15, fq = lane >> 4;
  const int qb = item & 31, kvh = (item >> 5) & 1, b = item >> 6;
  const int t0 = qb * 128;
  const size_t rowb = (size_t)b * SEQ;
  unsigned char* sK = smem;
  unsigned char* sV = smem + 32768;
  __syncthreads();
#pragma unroll
  for (int i = 0; i < 8; ++i) {
    const int q = tid + 256 * i, row = q >> 3, ch = q & 7;
    const int pos = t0 - 128 + row;
    u32x4 v = (u32x4){0u, 0u, 0u, 0u};
    if (pos >= 0) v = *(const u32x4*)(proj + (rowb + pos) * PROJW + OFF_SK + kvh * 64 + ch * 8);
    *(u32x4*)(sK + row * 128 + ((ch ^ (row & 7)) << 4)) = v;
  }
#pragma unroll
  for (int i = 0; i < 8; ++i) {
    const int q = tid + 256 * i, row = q >> 5, ch = q & 31;
    const int pos = t0 - 128 + ch * 8;
    u32x4 v = (u32x4){0u, 0u, 0u, 0u};
    if (pos >= 0) v = *(const u32x4*)(vt + ((size_t)(b * 128 + kvh * 64 + row)) * SEQ + pos);
    *(u32x4*)(sV + row * 512 + ((ch ^ (row & 15)) << 4)) = v;
  }
  __syncthreads();
  const int head = kvh * 4 + w;
  const float slope = exp2f(-(float)(head + 1));
  const float sink = sinks[head];
  const bf16_t* qp0 = proj + (rowb + t0 + fr) * PROJW + OFF_SQ + head * 64 + fq * 8;
  bf16x8 qn0 = *(const bf16x8*)(qp0), qn1 = *(const bf16x8*)(qp0 + 32);
#pragma unroll 1
  for (int qt = 0; qt < 8; ++qt) {
    const bf16x8 qf0 = qn0, qf1 = qn1;
    if (qt < 7) { const bf16_t* qp = qp0 + (size_t)(qt + 1) * 16 * PROJW; qn0 = *(const bf16x8*)(qp); qn1 = *(const bf16x8*)(qp + 32); }
    const int kp0 = qt >> 1;
    f32x4 st[10];
#pragma unroll
    for (int kt = 0; kt < 10; ++kt) {
      const int krow = (2 * kp0 + kt) * 16 + fr;
      st[kt] = (f32x4){0.f, 0.f, 0.f, 0.f};
      const bf16x8 k0 = *(const bf16x8*)(sK + krow * 128 + (((0 + fq) ^ (krow & 7)) << 4));
      const bf16x8 k1 = *(const bf16x8*)(sK + krow * 128 + (((4 + fq) ^ (krow & 7)) << 4));
      st[kt] = __builtin_amdgcn_mfma_f32_16x16x32_bf16(k0, qf0, st[kt], 0, 0, 0);
      st[kt] = __builtin_amdgcn_mfma_f32_16x16x32_bf16(k1, qf1, st[kt], 0, 0, 0);
    }
    const int i = qt * 16 + fr;
    float mx = sink;
#pragma unroll
    for (int kt = 0; kt < 10; ++kt)
#pragma unroll
      for (int r = 0; r < 4; ++r) {
        const int jb = (2 * kp0 + kt) * 16 + 4 * fq + r;
        const int dist = 128 + i - jb;
        const bool ok = (dist >= 0) && (dist < 128) && (t0 - 128 + jb >= 0);
        const float s = ok ? (st[kt][r] * 0.125f - slope * (float)dist) : -INFINITY;
        st[kt][r] = s;
        mx = fmaxf(mx, s);
      }
    mx = fmaxf(mx, __shfl_xor(mx, 16));
    mx = fmaxf(mx, __shfl_xor(mx, 32));
    float sum = 0.f;
#pragma unroll
    for (int kt = 0; kt < 10; ++kt)
#pragma unroll
      for (int r = 0; r < 4; ++r) { const float p = __expf(st[kt][r] - mx); st[kt][r] = p; sum += p; }
    sum += __shfl_xor(sum, 16);
    sum += __shfl_xor(sum, 32);
    const float inv = 1.f / (sum + __expf(sink - mx));
    f32x4 O[4];
#pragma unroll
    for (int nt = 0; nt < 4; ++nt) O[nt] = (f32x4){0.f, 0.f, 0.f, 0.f};
#pragma unroll
    for (int s5 = 0; s5 < 5; ++s5) {
      const bf16x8 pa = pack8(st[2 * s5] * inv, st[2 * s5 + 1] * inv);
      const int key0 = (2 * kp0 + 2 * s5) * 16 + 4 * fq;
#pragma unroll
      for (int nt = 0; nt < 4; ++nt) {
        const int drow = nt * 16 + fr;
        const int c0 = key0 >> 3, c1 = (key0 + 16) >> 3;
        const u32x2 lo = *(const u32x2*)(sV + drow * 512 + ((c0 ^ (drow & 15)) << 4) + ((key0 >> 2) & 1) * 8);
        const u32x2 hi = *(const u32x2*)(sV + drow * 512 + ((c1 ^ (drow & 15)) << 4) + ((key0 >> 2) & 1) * 8);
        const u32x4 vb = (u32x4){lo[0], lo[1], hi[0], hi[1]};
        O[nt] = __builtin_amdgcn_mfma_f32_16x16x32_bf16(pa, __builtin_bit_cast(bf16x8, vb), O[nt], 0, 0, 0);
      }
    }
#pragma unroll
    for (int nt = 0; nt < 4; ++nt)
#pragma unroll
      for (int r = 0; r < 4; ++r)
        mixed[(rowb + t0 + qt * 16 + 4 * fq + r) * DM + 512 + head * 64 + nt * 16 + fr] = (bf16_t)f2bf(O[nt][r]);
  }
}

__device__ __forceinline__ void ph_wout(unsigned char* smem, int xcd, int l, const bf16_t* __restrict__ mixed, const bf16_t* __restrict__ wt, const float* __restrict__ x, float* __restrict__ y1) {
  const int mi = l >> 3, ni = l & 7;
  LdRowBF16 al; al.init([&](int r) { return mixed + (size_t)((xcd * 32 + mi) * 128 + r) * DM; }, (size_t)8 * 128 * DM * 2);
  LdRowBF16 bl; bl.init([&](int r) { return wt + (size_t)(ni * 128 + r) * DM; }, 0);
  gemm_stream<16>(smem, al, bl, 4, [&](int seg, f32x4 (&acc)[4][4]) {
    GEMM_IDS
    const int m0 = (xcd * 32 + seg * 8 + mi) * 128, n0 = ni * 128;
#pragma unroll
    for (int m = 0; m < 4; ++m)
#pragma unroll
      for (int n = 0; n < 4; ++n) {
        const size_t idx = (size_t)(m0 + wr * 64 + m * 16 + fr) * DM + n0 + wc * 64 + n * 16 + fq * 4;
        const f32x4 xv = *(const f32x4*)(x + idx);
        *(f32x4*)(y1 + idx) = xv * ALPHA + acc[m][n];
      }
  });
}

__device__ __forceinline__ void ph_ln1(int item, const float* __restrict__ y, const float* __restrict__ gam, const float* __restrict__ bet, bf16_t* __restrict__ xbf) {
  const int row = item * 4 + (TIDX >> 6), lane = TIDX & 63;
  const float4* p = (const float4*)(y + (size_t)row * DM);
  float4 v[4]; float s = 0.f;
#pragma unroll
  for (int i = 0; i < 4; ++i) { v[i] = p[lane + i * 64]; s += v[i].x + v[i].y + v[i].z + v[i].w; }
  const float mu = wave_sum(s) * (1.f / DM);
  float q = 0.f;
#pragma unroll
  for (int i = 0; i < 4; ++i) { const float a = v[i].x - mu, b = v[i].y - mu, c = v[i].z - mu, d = v[i].w - mu; q += a * a + b * b + c * c + d * d; }
  const float rs = rsqrtf(wave_sum(q) * (1.f / DM) + LN_EPS);
#pragma unroll
  for (int i = 0; i < 4; ++i) {
    const float4 gg = ((const float4*)gam)[lane + i * 64], bb = ((const float4*)bet)[lane + i * 64];
    u32x2 w;
    w[0] = pack2((v[i].x - mu) * rs * gg.x + bb.x, (v[i].y - mu) * rs * gg.y + bb.y);
    w[1] = pack2((v[i].z - mu) * rs * gg.z + bb.z, (v[i].w - mu) * rs * gg.w + bb.w);
    ((u32x2*)(xbf + (size_t)row * DM))[lane + i * 64] = w;
  }
}

__device__ __forceinline__ void ph_router(unsigned char* smem, int tile, const bf16_t* __restrict__ xbf, const bf16_t* __restrict__ wt, float* __restrict__ logits) {
  GEMM_IDS
  const int n0 = (tile & 1) * 128, m0 = (tile >> 1) * 128;
  LdRowBF16 al; al.init([&](int r) { return xbf + (size_t)(m0 + r) * DM; }, 0);
  LdRowBF16 bl; bl.init([&](int r) { return wt + (size_t)(n0 + r) * DM; }, 0);
  gemm_stream<16>(smem, al, bl, 1, [&](int seg, f32x4 (&acc)[4][4]) {
    GEMM_IDS
#pragma unroll
    for (int m = 0; m < 4; ++m)
#pragma unroll
      for (int n = 0; n < 4; ++n)
        *(f32x4*)(logits + (size_t)(m0 + wr * 64 + m * 16 + fr) * NEXP + n0 + wc * 64 + n * 16 + fq * 4) = acc[m][n];
  });
}

__device__ __forceinline__ void ph_route(int item, const float* __restrict__ logits, const float* __restrict__ router_bias, int* __restrict__ cnt, int* __restrict__ list, float* __restrict__ gates) {
  const int n = item * 4 + (TIDX >> 6), lane = TIDX & 63;
  const float4 lg = ((const float4*)(logits + (size_t)n * NEXP))[lane];
  const float4 rb = ((const float4*)router_bias)[lane];
  float sc[4] = {sigmoidf(lg.x), sigmoidf(lg.y), sigmoidf(lg.z), sigmoidf(lg.w)};
  float sel[4] = {sc[0] + rb.x, sc[1] + rb.y, sc[2] + rb.z, sc[3] + rb.w};
  float t1 = fmaxf(sel[0], sel[1]), t2 = fminf(sel[0], sel[1]);
  { const float a = sel[2]; if (a > t1) { t2 = t1; t1 = a; } else if (a > t2) t2 = a; }
  { const float a = sel[3]; if (a > t1) { t2 = t1; t1 = a; } else if (a > t2) t2 = a; }
#pragma unroll
  for (int o = 1; o < 8; o <<= 1) {
    const float b1 = __shfl_xor(t1, o), b2 = __shfl_xor(t2, o);
    const float n1 = fmaxf(t1, b1), n2 = fmaxf(fminf(t1, b1), fmaxf(t2, b2));
    t1 = n1; t2 = n2;
  }
  const float gs = t1 + t2;
  const int mygrp = lane >> 3;
  int rank = 0;
#pragma unroll
  for (int j = 0; j < 8; ++j) {
    const float o = __shfl(gs, j * 8);
    rank += (o > gs || (o == gs && j < mygrp)) ? 1 : 0;
  }
  const bool gsel = rank < 4;
  float cand[4];
#pragma unroll
  for (int i = 0; i < 4; ++i) cand[i] = gsel ? sel[i] : -INFINITY;
  float gsum = 0.f; float myg = 0.f; int mye = 0;
#pragma unroll 1
  for (int r = 0; r < TOPK; ++r) {
    float bv = cand[0]; int bi = 0;
#pragma unroll
    for (int i = 1; i < 4; ++i) if (cand[i] > bv) { bv = cand[i]; bi = i; }
    int be = lane * 4 + bi;
    float bs = (bi == 0) ? sc[0] : (bi == 1) ? sc[1] : (bi == 2) ? sc[2] : sc[3];
#pragma unroll
    for (int o = 1; o < 64; o <<= 1) {
      const float ov = __shfl_xor(bv, o); const int oe = __shfl_xor(be, o); const float os = __shfl_xor(bs, o);
      if (ov > bv || (ov == bv && oe < be)) { bv = ov; be = oe; bs = os; }
    }
    if ((be >> 2) == lane) {
      const int bi2 = be & 3;
      if (bi2 == 0) cand[0] = -INFINITY; else if (bi2 == 1) cand[1] = -INFINITY; else if (bi2 == 2) cand[2] = -INFINITY; else cand[3] = -INFINITY;
    }
    gsum += bs;
    if (lane == r) { myg = bs; mye = be; }
  }
  if (lane < TOPK) {
    const int slot = atomicAdd(&cnt[mye], 1);
    list[(size_t)mye * CAP + slot] = n * TOPK + lane;
    gates[(size_t)n * TOPK + lane] = myg / gsum * 2.5f;
  }
}

__device__ __forceinline__ void moe_build_prefix(const int* __restrict__ cnt, int* sscan) {
  const int tid = TIDX;
  const int e = ((tid & 31) << 3) | (tid >> 5);
  const int c = cnt[e];
  __syncthreads();
  sscan[tid] = (c + 127) >> 7;
  __syncthreads();
  for (int o = 1; o < 256; o <<= 1) {
    const int v = (tid >= o) ? sscan[tid - o] : 0;
    __syncthreads();
    sscan[tid] += v;
    __syncthreads();
  }
}
__device__ __forceinline__ void moe_locate(const int* sscan, int x, int lt, int& e, int& rt) {
  const int base = x ? sscan[32 * x - 1] : 0;
  const int nrouted = sscan[32 * x + 31] - base;
  if (lt >= nrouted) { e = 256; rt = x * (NTOK / 128 / 8) + (lt - nrouted); return; }
  const int g = base + lt;
  int lo = 32 * x, hi = 32 * x + 31;
  while (lo < hi) { const int mid = (lo + hi) >> 1; if (sscan[mid] > g) hi = mid; else lo = mid + 1; }
  e = ((lo & 31) << 3) | (lo >> 5); rt = g - (lo ? sscan[lo - 1] : 0);
}

__device__ __forceinline__ void ph_moe1(unsigned char* smem, int e, int rt, const bf16_t* __restrict__ xbf, const int* __restrict__ cnt, const int* __restrict__ list,
                                        const bf16_t* __restrict__ wge, const bf16_t* __restrict__ wue, bf16_t* __restrict__ hbuf) {
  int* sasg = (int*)(smem + SM_MISC + 2048);
  const int tid = TIDX;
  const int rows = (e < 256) ? cnt[e] : NTOK;
  __syncthreads();
  if (tid < 128) {
    const int r = rt * 128 + tid;
    int a = -1;
    if (r < rows) a = (e < 256) ? list[(size_t)e * CAP + r] : (NA + r);
    sasg[tid] = a;
  }
  __syncthreads();
  LdRowBF16 al; al.init([&](int r) { const int a = sasg[r]; const int tok = (a < 0) ? 0 : (a < NA ? (a >> 3) : (a - NA)); return xbf + (size_t)tok * DM; }, 0);
  LdRowBF16 bl; bl.init([&](int j) {
    const int bwc = j >> 6, bn = (j >> 4) & 3, ff = bwc * 32 + (bn >> 1) * 16 + (j & 15);
    return ((bn & 1) ? wue : wge) + (size_t)ff * DM; }, (size_t)64 * DM * 2);
  gemm_stream<16>(smem, al, bl, 4, [&](int ct, f32x4 (&acc)[4][4]) {
    GEMM_IDS
#pragma unroll
    for (int m = 0; m < 4; ++m) {
      const int a = sasg[wr * 64 + m * 16 + fr];
      if (a >= 0) {
#pragma unroll
        for (int pp = 0; pp < 2; ++pp) {
          float hv[4];
#pragma unroll
          for (int r = 0; r < 4; ++r) hv[r] = siluf(acc[m][2 * pp][r]) * acc[m][2 * pp + 1][r];
          u32x2 w; w[0] = pack2(hv[0], hv[1]); w[1] = pack2(hv[2], hv[3]);
          *(u32x2*)(hbuf + (size_t)a * EFF + ct * 64 + wc * 32 + pp * 16 + fq * 4) = w;
        }
      }
    }
  });
}

__device__ __forceinline__ void ph_moe2(unsigned char* smem, int e, int rt, const bf16_t* __restrict__ hbuf, const int* __restrict__ cnt, const int* __restrict__ list, const float* __restrict__ gates,
                                        const bf16_t* __restrict__ wde, bf16_t* __restrict__ ybuf, float* __restrict__ dout, const bf16_t* __restrict__ x1b) {
  int* sasg = (int*)(smem + SM_MISC + 2048);
  float* sgate = (float*)(smem + SM_MISC + 2048 + 512);
  const int tid = TIDX;
  const int rows = (e < 256) ? cnt[e] : NTOK;
  __syncthreads();
  if (tid < 128) {
    const int r = rt * 128 + tid;
    int a = -1;
    if (r < rows) a = (e < 256) ? list[(size_t)e * CAP + r] : (NA + r);
    sasg[tid] = a;
    sgate[tid] = (a >= 0 && a < NA) ? gates[a] : 1.f;
  }
  __syncthreads();
  LdRowBF16 al; al.init([&](int r) { const int a = sasg[r]; return hbuf + (size_t)(a < 0 ? 0 : a) * EFF; }, 0);
  LdRowBF16 bl; bl.init([&](int j) { return wde + (size_t)j * EFF; }, (size_t)128 * EFF * 2);
  gemm_stream<4>(smem, al, bl, 8, [&](int ct, f32x4 (&acc)[4][4]) {
    GEMM_IDS
    const int n0 = ct * 128;
#pragma unroll
    for (int m = 0; m < 4; ++m) {
      const int r_ = wr * 64 + m * 16 + fr;
      const int a = sasg[r_];
      if (a >= NA) {
        float* dp = dout + (size_t)(a - NA) * DM + n0 + wc * 64 + fq * 4;
        const bf16_t* xp = x1b + (size_t)(a - NA) * DM + n0 + wc * 64 + fq * 4;
#pragma unroll
        for (int n = 0; n < 4; ++n) {
          const u32x2 xw = *(const u32x2*)(xp + n * 16);
          const f32x4 xv = (f32x4){bflo(xw[0]), bfhi(xw[0]), bflo(xw[1]), bfhi(xw[1])};
          *(f32x4*)(dp + n * 16) = xv * ALPHA + acc[m][n];
        }
      } else if (a >= 0) {
        const float gt = sgate[r_];
#pragma unroll
        for (int n = 0; n < 4; ++n) {
          u32x2 w; w[0] = pack2(acc[m][n][0] * gt, acc[m][n][1] * gt); w[1] = pack2(acc[m][n][2] * gt, acc[m][n][3] * gt);
          *(u32x2*)(ybuf + (size_t)a * DM + n0 + wc * 64 + n * 16 + fq * 4) = w;
        }
      }
    }
  });
}

__device__ __forceinline__ void ph_final(int item, float* __restrict__ out, const bf16_t* __restrict__ ybuf, const float* __restrict__ gam, const float* __restrict__ bet) {
  const int row = item * 4 + (TIDX >> 6), lane = TIDX & 63;
  float4* p = (float4*)(out + (size_t)row * DM);
  float4 v[4]; float s = 0.f;
#pragma unroll
  for (int i = 0; i < 4; ++i) {
    float4 a = p[lane + i * 64];
#pragma unroll
    for (int k = 0; k < 8; ++k) {
      const uint2 w = ((const uint2*)(ybuf + ((size_t)row * 8 + k) * DM))[lane + i * 64];
      a.x += bflo(w.x); a.y += bfhi(w.x); a.z += bflo(w.y); a.w += bfhi(w.y);
    }
    v[i] = a; s += a.x + a.y + a.z + a.w;
  }
  const float mu = wave_sum(s) * (1.f / DM);
  float q = 0.f;
#pragma unroll
  for (int i = 0; i < 4; ++i) { const float a = v[i].x - mu, b = v[i].y - mu, c = v[i].z - mu, d = v[i].w - mu; q += a * a + b * b + c * c + d * d; }
  const float rs = rsqrtf(wave_sum(q) * (1.f / DM) + LN_EPS);
#pragma unroll
  for (int i = 0; i < 4; ++i) {
    const float4 gg = ((const float4*)gam)[lane + i * 64], bb = ((const float4*)bet)[lane + i * 64];
    float4 r;
    r.x = (v[i].x - mu) * rs * gg.x + bb.x; r.y = (v[i].y - mu) * rs * gg.y + bb.y;
    r.z = (v[i].z - mu) * rs * gg.z + bb.z; r.w = (v[i].w - mu) * rs * gg.w + bb.w;
    p[lane + i * 64] = r;
  }
}

#define XB_TMO      128
#define XB_XCNT(j)  (256  + 64 * (j))
#define XB_XSUB(j)  (1280 + 64 * (j))
#define XB_XGEN(j)  (2304 + 64 * (j))
#define XB_TOP      3328
#define XB_TOPGEN   3392
#define XCD_BAR_WORDS 3456
#define XB_SPIN_CAP (1u << 22)
#define LAS __attribute__((address_space(3)))
__device__ __forceinline__ unsigned xb_ld(unsigned* p)              { return __hip_atomic_load(p, __ATOMIC_RELAXED, __HIP_MEMORY_SCOPE_AGENT); }
__device__ __forceinline__ unsigned xb_add(unsigned* p, unsigned v) { return __hip_atomic_fetch_add(p, v, __ATOMIC_RELAXED, __HIP_MEMORY_SCOPE_AGENT); }
__device__ __forceinline__ unsigned xb_xcc_id() { return (unsigned)__builtin_amdgcn_s_getreg((3 << 11) | 20) & 0xFu; }
#define XB_SPIN(cond, bar) do { unsigned _sp = 0; while (cond) { __builtin_amdgcn_s_sleep(1); \
    if ((++_sp & 255u) == 0u) { if (xb_ld(&(bar)[XB_TMO])) break; if (_sp > XB_SPIN_CAP) { atomicAdd(&(bar)[XB_TMO], 1u); break; } } } } while (0)
struct XcdBarrier { unsigned* bar; unsigned x; volatile LAS unsigned* st; };
__device__ __forceinline__ XcdBarrier xcd_barrier_post(unsigned* bar, volatile LAS unsigned* st) {
  XcdBarrier b; b.bar = bar; b.x = xb_xcc_id(); b.st = st;
  if (threadIdx.x == 0) (void)xb_add(&bar[XB_XCNT(b.x)], 1u);
  return b;
}
__device__ __forceinline__ void xcd_barrier_complete(unsigned* bar, unsigned x, unsigned& nloc, unsigned& nx) {
  const unsigned G = gridDim.x * gridDim.y * gridDim.z;
  unsigned sum, cnt, mine, sp = 0u;
  for (;;) {
    sum = 0u; cnt = 0u; mine = 0u;
#pragma unroll
    for (unsigned j = 0; j < 16; ++j) { const unsigned c = xb_ld(&bar[XB_XCNT(j)]); sum += c; cnt += (c > 0u) ? 1u : 0u; mine = (j == x) ? c : mine; }
    if (sum == G) break;
    __builtin_amdgcn_s_sleep(1);
    if ((++sp & 255u) == 0u) { if (xb_ld(&bar[XB_TMO])) break; if (sp > XB_SPIN_CAP) { atomicAdd(&bar[XB_TMO], 1u); break; } }
  }
  nloc = mine > 0u ? mine : 1u; nx = cnt > 0u ? cnt : 1u;
}
__device__ __forceinline__ void xcd_barrier(const XcdBarrier& b) {
  asm volatile("s_waitcnt vmcnt(0)" ::: "memory");
  __syncthreads();
  if (threadIdx.x == 0) {
    unsigned* bar = b.bar;
    __builtin_amdgcn_s_waitcnt(0);
    unsigned nloc = b.st[0], nx = b.st[1];
    if (nloc == 0u) { xcd_barrier_complete(bar, b.x, nloc, nx); b.st[0] = nloc; b.st[1] = nx; }
    const unsigned old = xb_add(&bar[XB_XSUB(b.x)], 1u);
    const unsigned gen = old / nloc;
    if (old + 1u == (gen + 1u) * nloc) {
      __builtin_amdgcn_fence(__ATOMIC_RELEASE, "agent");
      asm volatile("s_waitcnt vmcnt(0)" ::: "memory");
      const unsigned og = xb_add(&bar[XB_TOP], 1u);
      const unsigned tg = og / nx;
      if (og + 1u == (tg + 1u) * nx) xb_add(&bar[XB_TOPGEN], 1u);
      else XB_SPIN(xb_ld(&bar[XB_TOPGEN]) == tg, bar);
      __builtin_amdgcn_fence(__ATOMIC_ACQUIRE, "agent");
      xb_add(&bar[XB_XGEN(b.x)], 1u);
      asm volatile("s_waitcnt vmcnt(0)" ::: "memory");
    } else {
      XB_SPIN(xb_ld(&bar[XB_XGEN(b.x)]) == gen, bar);
      __builtin_amdgcn_fence(__ATOMIC_ACQUIRE, "agent");
      asm volatile("s_waitcnt vmcnt(0)" ::: "memory");
    }
  }
  __syncthreads();
}

__global__ void __launch_bounds__(256, 2) mega(Params P) {
  __shared__ __attribute__((aligned(16))) unsigned char smem[SMEM_BYTES];
  const int bid = blockIdx.x, nblk = gridDim.x;
#define xin (P.in[0])
#define w_in (P.in[1])
#define conv_w (P.in[2])
#define a_log (P.in[3])
#define dt_bias (P.in[4])
#define dn_norm_g (P.in[5])
#define sinks (P.in[6])
#define w_out (P.in[7])
#define ln1_g (P.in[8])
#define ln1_b (P.in[9])
#define router_w (P.in[10])
#define router_bias (P.in[11])
#define w_gate (P.in[12])
#define w_up (P.in[13])
#define w_down (P.in[14])
#define sw_gate (P.in[15])
#define sw_up (P.in[16])
#define sw_down (P.in[17])
#define ln2_g (P.in[18])
#define ln2_b (P.in[19])
#define outp (P.out)
#define x1bf ((bf16_t*)(P.ws + WS_X1BF))
#define logits ((float*)(P.ws + WS_LOGIT))
#define list ((int*)(P.ws + WS_LIST))
#define gates ((float*)(P.ws + WS_GATES))
#define cnt ((int*)(P.ws + WS_CTRL))
#define barw ((unsigned*)(P.ws + WS_CTRL + 4096))
#define mixed ((bf16_t*)(P.ws + WS_MIXED))
#define proj ((bf16_t*)(P.ws + WS_PROJ))
#define ba ((float*)(P.ws + WS_BA))
#define QD ((bf16_t*)(P.ws + WS_QD))
#define W0N ((bf16_t*)(P.ws + WS_W0N))
#define KTT ((bf16_t*)(P.ws + WS_KTT))
#define RV ((bf16_t*)(P.ws + WS_RV))
#define TM ((bf16_t*)(P.ws + WS_TM))
#define ATT ((bf16_t*)(P.ws + WS_ATT))
#define GL ((float*)(P.ws + WS_GL))
#define obuf ((float*)(P.ws + WS_O))
#define VTb ((bf16_t*)(P.ws + WS_VT))
#define XBF ((bf16_t*)(P.ws + WS_XBF))
#define WTIN ((bf16_t*)(P.ws + WS_WTIN))
#define WTOUT ((bf16_t*)(P.ws + WS_WTOUT))
#define WTR ((bf16_t*)(P.ws + WS_WTR))
#define WTG ((bf16_t*)(P.ws + WS_WTG))
#define WTU ((bf16_t*)(P.ws + WS_WTU))
#define WTD ((bf16_t*)(P.ws + WS_WTD))
#define WTSG ((bf16_t*)(P.ws + WS_WTSG))
#define WTSU ((bf16_t*)(P.ws + WS_WTSU))
#define WTSD ((bf16_t*)(P.ws + WS_WTSD))
#define hbuf ((bf16_t*)(P.ws + WS_HBUF))
#define ybuf ((bf16_t*)(P.ws + WS_YBUF))
  {
    volatile LAS unsigned* st0 = (volatile LAS unsigned*)(smem + SM_MISC + 4080);
    if (threadIdx.x == 0) { st0[0] = 0u; st0[1] = 0u; }
    __syncthreads();
  }
  const int xcd = bid & 7, xloc = bid >> 3, xnl = nblk >> 3;
  XcdBarrier xb = xcd_barrier_post(barw, (volatile LAS unsigned*)(smem + SM_MISC + 4080));
  for (int it = bid; it < NTOK / 4; it += nblk) ph_cvt_x(it, xin, XBF);
  for (int it = bid; it < 16 * 46 + 16 * 16 + 16 * 4; it += nblk) {
    if (it < 16 * 46) ph_cvt_wt(smem, it % 16, it / 16, w_in, DM, INC, WTIN);
    else if (it < 16 * 46 + 256) { const int j = it - 16 * 46; ph_cvt_wt(smem, j % 16, j / 16, w_out, DM, DM, WTOUT); }
    else { const int j = it - 16 * 46 - 256; ph_cvt_wt(smem, j % 16, j / 16, router_w, DM, NEXP, WTR); }
  }
  for (int it = bid; it < 192; it += nblk) {
    if (it < 64) ph_cvt_wt(smem, it % 16, it / 16, sw_gate, DM, EFF, WTSG);
    else if (it < 128) ph_cvt_wt(smem, (it - 64) % 16, (it - 64) / 16, sw_up, DM, EFF, WTSU);
    else ph_cvt_wt(smem, (it - 128) % 4, (it - 128) / 4, sw_down, EFF, DM, WTSD);
  }
  xcd_barrier(xb);
  for (int l = xloc; l < 64; l += xnl) ph_proj(smem, xcd, l, XBF, WTIN, proj, ba, VTb);
  xcd_barrier(xb);
  for (int it = bid; it < 2048; it += nblk) ph_dnchunk(smem, it, proj, ba, conv_w, a_log, dt_bias, QD, W0N, KTT, RV, TM, ATT, GL);
  for (int it = bid; it < 512; it += nblk) ph_swa(smem, it, proj, VTb, sinks, mixed);
  xcd_barrier(xb);
  if (bid < 64 || nblk <= 64) {
    for (int it = bid; it < 64; it += nblk) ph_dnscan(smem, it, QD, W0N, KTT, RV, TM, ATT, GL, obuf);
  }
  if (bid >= 64 || nblk <= 64) {
    const int tid = TIDX, lane = tid & 63, wv = tid >> 6;
    float* tile = (float*)(smem + wv * 8448);
    const int nconv = (nblk > 64) ? (nblk - 64) : nblk, cb = (nblk > 64) ? (bid - 64) : bid;
    const int step = nconv * 4, total = 256 * 384;
    int it = cb * 4 + wv;
    f32x4 vc[8], vn[8];
    CvtTile tc = cvt_decode(it < total ? it : 0, lane, w_gate, w_up, w_down, WTG, WTU, WTD);
    if (it < total) cvt_load(tc, vc);
    while (it < total) {
      const int itn = it + step;
      CvtTile tn = cvt_decode(itn < total ? itn : 0, lane, w_gate, w_up, w_down, WTG, WTU, WTD);
      if (itn < total) cvt_load(tn, vn);
      cvt_store(tile, lane, tc, vc);
#pragma unroll
      for (int i = 0; i < 8; ++i) vc[i] = vn[i];
      tc = tn; it = itn;
    }
  }
  xcd_barrier(xb);
  for (int it = bid; it < NTOK / 4; it += nblk) ph_dn_post(it, obuf, proj, dn_norm_g, mixed);
  xcd_barrier(xb);
  for (int l = xloc; l < 64; l += xnl) ph_wout(smem, xcd, l, mixed, WTOUT, xin, outp);
  xcd_barrier(xb);
  for (int it = bid; it < NTOK / 4; it += nblk) ph_ln1(it, outp, ln1_g, ln1_b, x1bf);
  xcd_barrier(xb);
  for (int i = xloc; i < 32 * 2; i += xnl) ph_router(smem, (xcd * 32 + i / 2) * 2 + i % 2, x1bf, WTR, logits);
  xcd_barrier(xb);
  for (int it = bid; it < NTOK / 4; it += nblk) ph_route(it, logits, router_bias, cnt, list, gates);
  xcd_barrier(xb);
  int* sscan = (int*)(smem + SM_MISC);
  moe_build_prefix(cnt, sscan);
  const int ntile = sscan[32 * xcd + 31] - (xcd ? sscan[32 * xcd - 1] : 0) + NTOK / 128 / 8;
  for (int it = xloc; it < ntile; it += xnl) {
    int e, rt; moe_locate(sscan, xcd, it, e, rt);
    ph_moe1(smem, e, rt, x1bf, cnt, list, (e < 256) ? WTG + (size_t)e * EFF * DM : WTSG, (e < 256) ? WTU + (size_t)e * EFF * DM : WTSU, hbuf);
  }
  xcd_barrier(xb);
  for (int it = xloc; it < ntile; it += xnl) {
    int e, rt; moe_locate(sscan, xcd, it, e, rt);
    ph_moe2(smem, e, rt, hbuf, cnt, list, gates, (e < 256) ? WTD + (size_t)e * DM * EFF : WTSD, ybuf, outp, x1bf);
  }
  xcd_barrier(xb);
  for (int it = bid; it < NTOK / 4; it += nblk) ph_final(it, outp, ybuf, ln2_g, ln2_b);
}

#undef xin
#undef w_in
#undef conv_w
#undef a_log
#undef dt_bias
#undef dn_norm_g
#undef sinks
#undef w_out
#undef ln1_g
#undef ln1_b
#undef router_w
#undef router_bias
#undef w_gate
#undef w_up
#undef w_down
#undef sw_gate
#undef sw_up
#undef sw_down
#undef ln2_g
#undef ln2_b
#undef outp
#undef x1bf
#undef logits
#undef list
#undef gates
#undef cnt
#undef mixed
#undef proj
#undef ba
#undef QD
#undef W0N
#undef KTT
#undef RV
#undef TM
#undef ATT
#undef GL
#undef obuf
#undef hbuf
#undef ybuf
#undef VTb
#undef XBF
#undef WTIN
#undef WTOUT
#undef WTR
#undef WTG
#undef WTU
#undef WTD
#undef WTSG
#undef WTSU
#undef WTSD
#undef barw

extern "C" void kernel_launch(void* const* d_in, const int* in_sizes, int n_in, void* d_out, int out_size, void* d_ws, size_t ws_size, hipStream_t stream) {
  static int grid_blocks = 0;
  if (!grid_blocks) {
    int dev = 0, cus = 0, per_cu = 0;
    (void)hipGetDevice(&dev);
    (void)hipDeviceGetAttribute(&cus, hipDeviceAttributeMultiprocessorCount, dev);
    (void)hipOccupancyMaxActiveBlocksPerMultiprocessor(&per_cu, mega, 256, 0);
    if (per_cu > 2) per_cu = 2;
    if (per_cu < 1) per_cu = 1;
    grid_blocks = cus * per_cu;
  }
  Params p{};
  for (int i = 0; i < 20; ++i) p.in[i] = (const float*)d_in[i];
  p.out = (float*)d_out; p.ws = (char*)d_ws;
  (void)hipMemsetAsync((char*)d_ws + WS_CTRL, 0, 4096 + XCD_BAR_WORDS * 4, stream);
  void* args[] = {&p};
  hipError_t e = hipLaunchCooperativeKernel((void*)mega, dim3(grid_blocks), dim3(256), args, 0, stream);
  if (e != hipSuccess) fprintf(stderr, "cooperative launch failed: %s (grid %d)\n", hipGetErrorString(e), grid_blocks);
}
```

```cpp
#include <hip/hip_runtime.h>
#include <hip/hip_cooperative_groups.h>
#include <stdint.h>
#include <stdio.h>
namespace cg = cooperative_groups;

typedef __attribute__((ext_vector_type(8))) short bf16x8;
typedef __attribute__((ext_vector_type(4))) float f32x4;
typedef unsigned short bf16_t;
typedef __attribute__((ext_vector_type(4))) unsigned u32x4;
typedef __attribute__((ext_vector_type(2))) unsigned u32x2;

constexpr int NTOK = 32768, SEQ = 4096, DM = 1024;
constexpr int INC = 2824, PROJW = 2816;
constexpr int OFF_DQ = 0, OFF_DK = 512, OFF_DV = 1024, OFF_SQ = 1536, OFF_SK = 2048, OFF_SV = 2176, OFF_Z = 2304;
constexpr int NEXP = 256, TOPK = 8, EFF = 256;
constexpr int NA = NTOK * TOPK;
constexpr int CAP = NTOK;
constexpr float ALPHA = 1.189207115002721f;
constexpr float LN_EPS = 1e-5f, RMS_EPS = 1e-6f, L2_EPS = 1e-6f;

constexpr size_t MiB = 1024ull * 1024ull;
constexpr size_t WS_WTD = 0;
constexpr size_t WS_WTG = 128 * MiB;
constexpr size_t WS_WTU = 256 * MiB;
constexpr size_t WS_YBUF = 384 * MiB;
constexpr size_t WS_LOGIT = 384 * MiB;
constexpr size_t WS_X1BF = 896 * MiB;
constexpr size_t WS_LIST = 960 * MiB;
constexpr size_t WS_GATES = 992 * MiB;
constexpr size_t WS_CTRL = 993 * MiB;
constexpr size_t WS_WTIN = 994 * MiB;
constexpr size_t WS_WTOUT = 1000 * MiB;
constexpr size_t WS_WTR = 1002 * MiB;
constexpr size_t WS_WTSG = 1003 * MiB;
constexpr size_t WS_WTSU = WS_WTSG + 512 * 1024;
constexpr size_t WS_WTSD = 1004 * MiB;
constexpr size_t WS_PROJ = 384 * MiB;
constexpr size_t WS_BA = 560 * MiB;
constexpr size_t WS_QD = 561 * MiB;
constexpr size_t WS_W0N = 593 * MiB;
constexpr size_t WS_KTT = 625 * MiB;
constexpr size_t WS_RV = 657 * MiB;
constexpr size_t WS_TM = 689 * MiB;
constexpr size_t WS_ATT = 705 * MiB;
constexpr size_t WS_GL = 721 * MiB;
constexpr size_t WS_O = 722 * MiB;
constexpr size_t WS_VT = 786 * MiB;
constexpr size_t WS_MIXED = 794 * MiB;
constexpr size_t WS_XBF = 640 * MiB;

__device__ __forceinline__ int opaque_tid() { int t = threadIdx.x; asm volatile("" : "+v"(t)); return t; }
#define TIDX opaque_tid()
typedef __attribute__((ext_vector_type(2))) __bf16 hwbf16x2;
typedef __attribute__((ext_vector_type(2))) float hwf32x2;
__device__ __forceinline__ unsigned pack2(float lo, float hi) {
  hwf32x2 f = {lo, hi};
  return __builtin_bit_cast(unsigned, __builtin_convertvector(f, hwbf16x2));
}
__device__ __forceinline__ unsigned f2bf(float f) { return pack2(f, 0.f) & 0xffffu; }
__device__ __forceinline__ float bf2f(unsigned h) { return __uint_as_float(h << 16); }
__device__ __forceinline__ float bflo(unsigned w) { return __uint_as_float(w << 16); }
__device__ __forceinline__ float bfhi(unsigned w) { return __uint_as_float(w & 0xffff0000u); }
__device__ __forceinline__ float siluf(float x) { return x / (1.f + __expf(-x)); }
__device__ __forceinline__ float sigmoidf(float x) { return 1.f / (1.f + __expf(-x)); }
__device__ __forceinline__ float wave_sum(float v) {
#pragma unroll
  for (int o = 32; o > 0; o >>= 1) v += __shfl_xor(v, o);
  return v;
}

template <int SEGDIV>
struct LdRowBF16T {
  const char* p[4]; size_t seghi, seglo; int tid16;
  template <class F> __device__ __forceinline__ void init(F rowptr, size_t hi, size_t lo = 0) {
    const int tid = TIDX; const int slot = tid & 7, row0 = tid >> 3; seghi = hi; seglo = lo; tid16 = tid * 16;
#pragma unroll
    for (int i = 0; i < 4; ++i) p[i] = (const char*)rowptr(row0 + i * 32) + ((slot ^ (row0 & 7)) << 4);
  }
  __device__ __forceinline__ void issue(int seg, int kk, unsigned char* lds) {
    const size_t off = (size_t)(seg / SEGDIV) * seghi + (size_t)(seg % SEGDIV) * seglo + (size_t)kk * 128;
#pragma unroll
    for (int i = 0; i < 4; ++i)
      __builtin_amdgcn_global_load_lds((const unsigned*)(p[i] + off), (__attribute__((address_space(3))) unsigned*)(lds + tid16 + i * 4096), 16, 0, 0);
  }
};
typedef LdRowBF16T<1> LdRowBF16;
struct LdColF32 {
  const char* p; size_t ldb, segb; f32x4 r[2][8]; int n4, kg;
  __device__ __forceinline__ void init(const float* colptr, size_t ld, size_t seg_bytes) {
    const int tid = TIDX; n4 = tid & 31; kg = tid >> 5; ldb = ld * 4; segb = seg_bytes;
    p = (const char*)colptr + (size_t)(kg * 8) * ldb;
  }
  template <int S> __device__ __forceinline__ void load(int seg, int kk) {
#pragma unroll
    for (int j = 0; j < 8; ++j) r[S][j] = *(const f32x4*)(p + (size_t)seg * segb + (size_t)(kk * 64 + j) * ldb);
  }
  template <int S> __device__ __forceinline__ void store(unsigned char* s) {
#pragma unroll
    for (int i = 0; i < 4; ++i) {
      const int row = n4 * 4 + i; u32x4 w;
      w[0] = pack2(r[S][0][i], r[S][1][i]); w[1] = pack2(r[S][2][i], r[S][3][i]); w[2] = pack2(r[S][4][i], r[S][5][i]); w[3] = pack2(r[S][6][i], r[S][7][i]);
      *(u32x4*)(s + row * 128 + ((kg ^ (row & 7)) << 4)) = w;
    }
  }
};

__device__ __forceinline__ void gemm_kstep(const unsigned char* sA, const unsigned char* sB, f32x4 (&acc)[4][4], int wr, int wc, int fr, int fq) {
#pragma unroll
  for (int ks = 0; ks < 2; ++ks) {
    bf16x8 a[4], b[4];
#pragma unroll
    for (int m = 0; m < 4; ++m) {
      const int row = wr * 64 + m * 16 + fr;
      a[m] = *(const bf16x8*)(sA + row * 128 + (((ks * 4 + fq) ^ (row & 7)) << 4));
    }
#pragma unroll
    for (int n = 0; n < 4; ++n) {
      const int row = wc * 64 + n * 16 + fr;
      b[n] = *(const bf16x8*)(sB + row * 128 + (((ks * 4 + fq) ^ (row & 7)) << 4));
    }
#pragma unroll
    for (int m = 0; m < 4; ++m)
#pragma unroll
      for (int n = 0; n < 4; ++n) acc[m][n] = __builtin_amdgcn_mfma_f32_16x16x32_bf16(b[n], a[m], acc[m][n], 0, 0, 0);
  }
}
template <int KPER, class AL, class BL, class Epi>
__device__ __forceinline__ void gemm_stream(unsigned char* smem, AL& al, BL& bl, int nseg, Epi epi) {
  const int tid = TIDX, lane = tid & 63, wid = tid >> 6, wr = wid >> 1, wc = wid & 1, fr = lane & 15, fq = lane >> 4;
  const int total = nseg * KPER;
  f32x4 acc[4][4];
  al.issue(0, 0, smem); bl.issue(0, 0, smem + 16384);
  asm volatile("s_waitcnt vmcnt(0)" ::: "memory");
  __syncthreads();
  for (int j = 0; j < total; ++j) {
    unsigned char* cur = smem + (j & 1) * 32768; unsigned char* nxt = smem + ((j & 1) ^ 1) * 32768;
    if (j + 1 < total) { al.issue((j + 1) / KPER, (j + 1) % KPER, nxt); bl.issue((j + 1) / KPER, (j + 1) % KPER, nxt + 16384); }
    if (j % KPER == 0) {
#pragma unroll
      for (int m = 0; m < 4; ++m)
#pragma unroll
        for (int n = 0; n < 4; ++n) acc[m][n] = (f32x4){0.f, 0.f, 0.f, 0.f};
    }
    gemm_kstep(cur, cur + 16384, acc, wr, wc, fr, fq);
    asm volatile("s_waitcnt vmcnt(0)" ::: "memory");
    __syncthreads();
    if ((j + 1) % KPER == 0) epi((j + 1) / KPER - 1, acc);
  }
}

#define GEMM_IDS const int tid = TIDX, lane = tid & 63, wid = tid >> 6, wr = wid >> 1, wc = wid & 1, fr = lane & 15, fq = lane >> 4; (void)tid; (void)lane;

struct Params {
  const float* in[20];
  float* out;
  char* ws;
};

constexpr int SMEM_BYTES = 69632;
constexpr int SM_MISC = 65536;

__device__ __forceinline__ void ph_cvt_x(int item, const float* __restrict__ x, bf16_t* __restrict__ xbf) {
  const int tid = TIDX;
  const size_t base = (size_t)item * 4096 + (size_t)tid * 4;
#pragma unroll
  for (int i = 0; i < 4; ++i) {
    const f32x4 v = *(const f32x4*)(x + base + (size_t)i * 1024);
    u32x2 w; w[0] = pack2(v[0], v[1]); w[1] = pack2(v[2], v[3]);
    *(u32x2*)(xbf + base + (size_t)i * 1024) = w;
  }
}
__device__ __forceinline__ void ph_cvt_wt(unsigned char* smem, int kt, int nt, const float* __restrict__ W, int K, int N, bf16_t* __restrict__ WT, bool perm = false) {
  float* tile = (float*)smem;
  const int tid = TIDX;
  const int k0 = kt * 64, n0 = nt * 64;
  __syncthreads();
#pragma unroll
  for (int i = 0; i < 4; ++i) {
    const int k = (tid >> 4) + 16 * i, n = 4 * (tid & 15);
    f32x4 v = (f32x4){0.f, 0.f, 0.f, 0.f};
    if (n0 + n < N) v = *(const f32x4*)(W + (size_t)(k0 + k) * N + n0 + n);
    tile[k * 65 + n + 0] = v[0]; tile[k * 65 + n + 1] = v[1]; tile[k * 65 + n + 2] = v[2]; tile[k * 65 + n + 3] = v[3];
  }
  __syncthreads();
  const int n = tid >> 2, kq = tid & 3;
  u32x4 w0, w1;
#pragma unroll
  for (int j = 0; j < 4; ++j) {
    w0[j] = pack2(tile[(kq * 16 + 2 * j) * 65 + n], tile[(kq * 16 + 2 * j + 1) * 65 + n]);
    w1[j] = pack2(tile[(kq * 16 + 8 + 2 * j) * 65 + n], tile[(kq * 16 + 8 + 2 * j + 1) * 65 + n]);
  }
  if (!perm) {
    bf16_t* dst = WT + (size_t)(n0 + n) * K + k0 + kq * 16;
    *(u32x4*)dst = w0; *(u32x4*)(dst + 8) = w1;
  } else {
    const int blk = kq >> 1, hi = kq & 1;
    bf16_t* dst = WT + (size_t)(n0 + n) * K + k0 + blk * 32 + 4 * hi;
    u32x2 a; a[0] = w0[0]; a[1] = w0[1]; *(u32x2*)(dst + 0) = a;
    a[0] = w0[2]; a[1] = w0[3]; *(u32x2*)(dst + 8) = a;
    a[0] = w1[0]; a[1] = w1[1]; *(u32x2*)(dst + 16) = a;
    a[0] = w1[2]; a[1] = w1[3]; *(u32x2*)(dst + 24) = a;
  }
}

struct CvtTile { const float* src; bf16_t* dst; int ldn; int perm; };
__device__ __forceinline__ CvtTile cvt_decode(int it, int lane, const float* __restrict__ w_gate, const float* __restrict__ w_up, const float* __restrict__ w_down,
                                              bf16_t* __restrict__ wtg, bf16_t* __restrict__ wtu, bf16_t* __restrict__ wtd) {
  const int e = it / 384, j = it % 384;
  const float* W; bf16_t* WT; int K, N, kt, nt;
  if (j < 128) { W = w_gate + (size_t)e * DM * EFF; WT = wtg + (size_t)e * EFF * DM; K = DM; N = EFF; kt = j & 31; nt = j >> 5; }
  else if (j < 256) { W = w_up + (size_t)e * DM * EFF; WT = wtu + (size_t)e * EFF * DM; K = DM; N = EFF; kt = (j - 128) & 31; nt = (j - 128) >> 5; }
  else { W = w_down + (size_t)e * EFF * DM; WT = wtd + (size_t)e * DM * EFF; K = EFF; N = DM; kt = (j - 256) & 7; nt = (j - 256) >> 3; }
  CvtTile t;
  t.src = W + (size_t)(kt * 32 + (lane >> 4)) * N + nt * 64 + 4 * (lane & 15);
  t.dst = WT + (size_t)(nt * 64 + lane) * K + kt * 32;
  t.ldn = 4 * N;
  t.perm = (j >= 256) ? 1 : 0;
  return t;
}
__device__ __forceinline__ void cvt_load(const CvtTile& t, f32x4 (&v)[8]) {
#pragma unroll
  for (int i = 0; i < 8; ++i) v[i] = *(const f32x4*)(t.src + (size_t)i * t.ldn);
}
__device__ __forceinline__ void cvt_store(float* tile  , int lane, const CvtTile& t, const f32x4 (&v)[8]) {
#pragma unroll
  for (int i = 0; i < 8; ++i) {
    float* p = tile + ((lane >> 4) + 4 * i) * 65 + 4 * (lane & 15);
    p[0] = v[i][0]; p[1] = v[i][1]; p[2] = v[i][2]; p[3] = v[i][3];
  }
  u32x4 w[4];
  if (t.perm) {
#pragma unroll
    for (int q = 0; q < 4; ++q) {
      w[q][0] = pack2(tile[(4 * q + 0) * 65 + lane], tile[(4 * q + 1) * 65 + lane]);
      w[q][1] = pack2(tile[(4 * q + 2) * 65 + lane], tile[(4 * q + 3) * 65 + lane]);
      w[q][2] = pack2(tile[(16 + 4 * q + 0) * 65 + lane], tile[(16 + 4 * q + 1) * 65 + lane]);
      w[q][3] = pack2(tile[(16 + 4 * q + 2) * 65 + lane], tile[(16 + 4 * q + 3) * 65 + lane]);
    }
  } else {
#pragma unroll
    for (int q = 0; q < 4; ++q)
#pragma unroll
      for (int j = 0; j < 4; ++j) w[q][j] = pack2(tile[(8 * q + 2 * j) * 65 + lane], tile[(8 * q + 2 * j + 1) * 65 + lane]);
  }
#pragma unroll
  for (int q = 0; q < 4; ++q) *(u32x4*)(t.dst + 8 * q) = w[q];
}

__device__ __forceinline__ void ph_proj(unsigned char* smem, int xcd, int l, const bf16_t* __restrict__ xbf, const bf16_t* __restrict__ wt, bf16_t* __restrict__ proj, float* __restrict__ ba, bf16_t* __restrict__ vt) {
  const int mi = l >> 3, ni = l & 7;
  LdRowBF16T<3> al; al.init([&](int r) { return xbf + (size_t)((xcd * 32 + mi) * 128 + r) * DM; }, (size_t)8 * 128 * DM * 2, 0);
  LdRowBF16T<3> bl; bl.init([&](int r) { return wt + (size_t)(ni * 128 + r) * DM; }, 0, (size_t)8 * 128 * DM * 2);
  gemm_stream<16>(smem, al, bl, 12, [&](int seg, f32x4 (&acc)[4][4]) {
    GEMM_IDS
    const int nt = (seg % 3) * 8 + ni;
    if (nt < 23) {
      const int m0 = (xcd * 32 + (seg / 3) * 8 + mi) * 128, n0 = nt * 128;
#pragma unroll
      for (int m = 0; m < 4; ++m)
#pragma unroll
        for (int n = 0; n < 4; ++n) {
          const int row = m0 + wr * 64 + m * 16 + fr, col = n0 + wc * 64 + n * 16 + fq * 4;
          if (col < PROJW) {
            u32x2 w; w[0] = pack2(acc[m][n][0], acc[m][n][1]); w[1] = pack2(acc[m][n][2], acc[m][n][3]);
            *(u32x2*)(proj + (size_t)row * PROJW + col) = w;
          } else if (col < INC) {
            *(f32x4*)(ba + (size_t)row * 8 + (col - PROJW)) = acc[m][n];
          }
        }
      if (n0 == OFF_SV) {
#pragma unroll
        for (int m = 0; m < 4; ++m)
#pragma unroll
          for (int n = 0; n < 4; ++n) {
            const int row = m0 + wr * 64 + m * 16 + fr, c = wc * 64 + n * 16 + fq * 4;
            const int bb = row / SEQ, t = row % SEQ;
#pragma unroll
            for (int r = 0; r < 4; ++r) vt[((size_t)(bb * 128 + c + r)) * SEQ + t] = (bf16_t)f2bf(acc[m][n][r]);
          }
      }
    }
  });
}

__device__ __forceinline__ bf16x8 pack8(f32x4 a, f32x4 b) {
  union { bf16x8 v; unsigned u[4]; } x;
  x.u[0] = pack2(a[0], a[1]); x.u[1] = pack2(a[2], a[3]); x.u[2] = pack2(b[0], b[1]); x.u[3] = pack2(b[2], b[3]);
  return x.v;
}
__device__ __forceinline__ void ph_dnchunk(unsigned char* smem, int item, const bf16_t* __restrict__ proj, const float* __restrict__ ba, const float* __restrict__ conv_w,
                                           const float* __restrict__ a_log, const float* __restrict__ dt_bias,
                                           bf16_t* __restrict__ QD, bf16_t* __restrict__ W0N, bf16_t* __restrict__ KTT, bf16_t* __restrict__ RV,
                                           bf16_t* __restrict__ TM, bf16_t* __restrict__ ATT, float* __restrict__ GL) {
  const int tid = TIDX, lane = tid & 63, w = tid >> 6, fr = lane & 15, fq = lane >> 4;
  const int n = item & 63, h = (item >> 6) & 3, b = item >> 8;
  const int t0 = n * 64; const size_t row0 = (size_t)b * SEQ + t0;
  unsigned char* qs = smem; unsigned char* ks = smem + 16384; float* AT = (float*)(smem + 32768);
  const float scale = 0.08838834764831845f;
  float bL, gcL;
  {
    const float* bap = ba + (row0 + lane) * 8;
    bL = sigmoidf(bap[h]);
    const float xx = bap[4 + h] + dt_bias[h];
    const float sp = fmaxf(xx, 0.f) + log1pf(__expf(-fabsf(xx)));
    float gg = -__expf(a_log[h]) * sp;
#pragma unroll
    for (int o = 1; o < 64; o <<= 1) { const float v = __shfl_up(gg, o); if (lane >= o) gg += v; }
    gcL = gg;
  }
  {
    const int d = 2 * lane;
    float cw[3][4][2];
#pragma unroll
    for (int mx = 0; mx < 3; ++mx)
#pragma unroll
      for (int j = 0; j < 4; ++j) {
        const float2 c2 = *(const float2*)(conv_w + j * 1536 + mx * 512 + h * 128 + d);
        cw[mx][j][0] = c2.x; cw[mx][j][1] = c2.y;
      }
    const bf16_t* pbase = proj + (row0 + 16 * w) * PROJW + h * 128 + d;
    unsigned raw[3][19];
#pragma unroll
    for (int j = 0; j < 19; ++j) {
      const bool ok = (t0 + 16 * w - 3 + j) >= 0;
#pragma unroll
      for (int mx = 0; mx < 3; ++mx) {
        unsigned u = 0;
        if (ok) u = *(const unsigned*)(pbase + (ptrdiff_t)(j - 3) * PROJW + mx * 512);
        raw[mx][j] = u;
      }
    }
#pragma unroll
    for (int i = 0; i < 16; ++i) {
      float s[3][2];
#pragma unroll
      for (int mx = 0; mx < 3; ++mx) {
        float y0 = 0.f, y1 = 0.f;
#pragma unroll
        for (int j = 0; j < 4; ++j) { y0 += cw[mx][j][0] * bflo(raw[mx][i + j]); y1 += cw[mx][j][1] * bfhi(raw[mx][i + j]); }
        s[mx][0] = siluf(y0); s[mx][1] = siluf(y1);
      }
      const int row = 16 * w + i;
      const float rq = rsqrtf(wave_sum(s[0][0] * s[0][0] + s[0][1] * s[0][1]) + L2_EPS);
      const float rk = rsqrtf(wave_sum(s[1][0] * s[1][0] + s[1][1] * s[1][1]) + L2_EPS);
      const int off = row * 256 + ((((lane >> 2) ^ (row & 15))) << 4) + (lane & 3) * 4;
      *(unsigned*)(qs + off) = pack2(s[0][0] * rq, s[0][1] * rq);
      *(unsigned*)(ks + off) = pack2(s[1][0] * rk, s[1][1] * rk);
      const float bi = __shfl(bL, row);
      *(unsigned*)(RV + ((size_t)item * 64 + row) * 128 + d) = pack2(bi * s[2][0], bi * s[2][1]);
    }
  }
  __syncthreads();
  {
    f32x4 aKK[4], aQK[4];
#pragma unroll
    for (int nt = 0; nt < 4; ++nt) { aKK[nt] = (f32x4){0.f, 0.f, 0.f, 0.f}; aQK[nt] = (f32x4){0.f, 0.f, 0.f, 0.f}; }
#pragma unroll
    for (int k4 = 0; k4 < 4; ++k4) {
      const int arow = 16 * w + fr;
      const bf16x8 aq = *(const bf16x8*)(qs + arow * 256 + ((((k4 * 4 + fq) ^ (arow & 15))) << 4));
      const bf16x8 ak = *(const bf16x8*)(ks + arow * 256 + ((((k4 * 4 + fq) ^ (arow & 15))) << 4));
#pragma unroll
      for (int nt = 0; nt < 4; ++nt) {
        const int brow = 16 * nt + fr;
        const bf16x8 bk = *(const bf16x8*)(ks + brow * 256 + ((((k4 * 4 + fq) ^ (brow & 15))) << 4));
        aKK[nt] = __builtin_amdgcn_mfma_f32_16x16x32_bf16(ak, bk, aKK[nt], 0, 0, 0);
        aQK[nt] = __builtin_amdgcn_mfma_f32_16x16x32_bf16(aq, bk, aQK[nt], 0, 0, 0);
      }
    }
    float gci[4], bi[4];
#pragma unroll
    for (int r = 0; r < 4; ++r) { gci[r] = __shfl(gcL, 16 * w + 4 * fq + r); bi[r] = __shfl(bL, 16 * w + 4 * fq + r); }
#pragma unroll
    for (int nt = 0; nt < 4; ++nt) {
      const int j = 16 * nt + fr;
      const float gcj = __shfl(gcL, j);
      const int p = 32 * (nt >> 1) + 8 * (fr >> 2) + 4 * (nt & 1) + (fr & 3);
      float av[4];
#pragma unroll
      for (int r = 0; r < 4; ++r) {
        const int i = 16 * w + 4 * fq + r;
        const float dec = (j <= i) ? __expf(gci[r] - gcj) : 0.f;
        av[r] = (j < i) ? bi[r] * aKK[nt][r] * dec : 0.f;
        ATT[((size_t)item * 64 + i) * 64 + p] = (bf16_t)f2bf(aQK[nt][r] * scale * dec);
      }
      *(float4*)(AT + j * 68 + 16 * w + 4 * fq) = make_float4(av[0], av[1], av[2], av[3]);
    }
  }
  __syncthreads();
  if (w == 0) {
    float Tr[64];
    int ln = lane; asm volatile("" : "+v"(ln));
#pragma unroll
    for (int j = 0; j < 64; ++j) Tr[j] = 0.f;
    f32x4 cur[16], nxt[16];
#pragma unroll
    for (int j4 = 0; j4 < 16; ++j4) nxt[j4] = (f32x4){0.f, 0.f, 0.f, 0.f};
#pragma unroll
    for (int j4 = 15; j4 >= 16; --j4) cur[j4] = *(const f32x4*)(AT + 63 * 68 + j4 * 4);
#pragma unroll
    for (int c = 63; c >= 0; --c) {
      if (c > 0) {
#pragma unroll
        for (int j4 = 15; j4 >= c / 4; --j4) nxt[j4] = *(const f32x4*)(AT + (c - 1) * 68 + j4 * 4);
      }
      float a0 = 0.f, a1 = 0.f, a2 = 0.f, a3 = 0.f;
#pragma unroll
      for (int j4 = 15; j4 >= (c + 1) / 4; --j4) {
        asm volatile("v_fmac_f32 %0, %1, %2" : "+v"(a0) : "v"(Tr[4 * j4 + 0]), "v"(cur[j4][0]));
        asm volatile("v_fmac_f32 %0, %1, %2" : "+v"(a1) : "v"(Tr[4 * j4 + 1]), "v"(cur[j4][1]));
        asm volatile("v_fmac_f32 %0, %1, %2" : "+v"(a2) : "v"(Tr[4 * j4 + 2]), "v"(cur[j4][2]));
        asm volatile("v_fmac_f32 %0, %1, %2" : "+v"(a3) : "v"(Tr[4 * j4 + 3]), "v"(cur[j4][3]));
      }
      Tr[c] = ((ln == c) ? 1.f : 0.f) - ((a0 + a1) + (a2 + a3));
#pragma unroll
      for (int j4 = 0; j4 < 16; ++j4) cur[j4] = nxt[j4];
    }
    u32x4* tp = (u32x4*)(TM + ((size_t)item * 64 + lane) * 64);
#pragma unroll
    for (int oc = 0; oc < 8; ++oc) {
      const int k0 = 32 * (oc >> 2) + 4 * (oc & 3);
      u32x4 v;
      v[0] = pack2(Tr[k0 + 0], Tr[k0 + 1]); v[1] = pack2(Tr[k0 + 2], Tr[k0 + 3]);
      v[2] = pack2(Tr[k0 + 16], Tr[k0 + 17]); v[3] = pack2(Tr[k0 + 18], Tr[k0 + 19]);
      tp[oc] = v;
    }
  } else {
    const float gclast = __shfl(gcL, 63);
    if (tid == 64) GL[item] = __expf(gclast);
#pragma unroll 1
    for (int it = 0; it < 16; ++it) {
      const int idx = (tid - 64) + it * 192;
      const int mtx = idx >> 10, rem = idx & 1023;
      if (mtx < 2) {
        const int i = rem >> 4, oc = rem & 15;
        const float gi = __shfl(gcL, i), bi = __shfl(bL, i);
        const float f = (mtx == 0) ? scale * __expf(gi) : -bi * __expf(gi);
        const unsigned char* st = (mtx == 0) ? qs : ks;
        const int d0 = 32 * (oc >> 2) + 4 * (oc & 3);
        const uint2 lo = *(const uint2*)(st + i * 256 + ((((d0 >> 3) ^ (i & 15))) << 4) + (d0 & 7) * 2);
        const uint2 hi = *(const uint2*)(st + i * 256 + (((((d0 + 16) >> 3) ^ (i & 15))) << 4) + (d0 & 7) * 2);
        u32x4 v;
        v[0] = pack2(bflo(lo.x) * f, bfhi(lo.x) * f); v[1] = pack2(bflo(lo.y) * f, bfhi(lo.y) * f);
        v[2] = pack2(bflo(hi.x) * f, bfhi(hi.x) * f); v[3] = pack2(bflo(hi.y) * f, bfhi(hi.y) * f);
        bf16_t* dst = ((mtx == 0) ? QD : W0N) + ((size_t)item * 64 + i) * 128 + 8 * oc;
        *(u32x4*)dst = v;
      } else {
        const int d = rem & 127, oc = rem >> 7;
        const int j0 = 32 * (oc >> 2) + 4 * (oc & 3);
        float val[8];
#pragma unroll
        for (int e = 0; e < 8; ++e) {
          const int j = j0 + (e & 3) + ((e >> 2) << 4);
          const float f = __expf(gclast - __shfl(gcL, j));
          const unsigned short raw = *(const unsigned short*)(ks + j * 256 + ((((d >> 3) ^ (j & 15))) << 4) + (d & 7) * 2);
          val[e] = bf2f(raw) * f;
        }
        u32x4 v;
        v[0] = pack2(val[0], val[1]); v[1] = pack2(val[2], val[3]); v[2] = pack2(val[4], val[5]); v[3] = pack2(val[6], val[7]);
        *(u32x4*)(KTT + ((size_t)item * 128 + d) * 64 + 8 * oc) = v;
      }
    }
  }
  __syncthreads();
}

__device__ __forceinline__ void ph_dnscan(unsigned char* smem, int item, const bf16_t* __restrict__ QDp, const bf16_t* __restrict__ W0Np, const bf16_t* __restrict__ KTTp,
                                          const bf16_t* __restrict__ RVp, const bf16_t* __restrict__ TMp, const bf16_t* __restrict__ ATTp, const float* __restrict__ GLp,
                                          float* __restrict__ op) {
  const int tid = TIDX, lane = tid & 63, w = tid >> 6, fr = lane & 15, fq = lane >> 4;
  const int bh = item >> 1, half = item & 1, b = bh >> 2, h = bh & 3;
  const int vcol0 = (half * 4 + w) * 16;
  unsigned char* sW0 = smem; unsigned char* sQD = smem + 16384; unsigned char* sKT = smem + 32768; unsigned char* sT = smem + 49152; unsigned char* sAT = smem + 57344;
  f32x4 S[8];
#pragma unroll
  for (int t = 0; t < 8; ++t) S[t] = (f32x4){0.f, 0.f, 0.f, 0.f};
  u32x4 pfA[8], pfB[8]; unsigned short rvp[16];
#define DN_LOAD_A(nn_) do { \
    const size_t ci = (size_t)bh * 64 + (nn_); \
    _Pragma("unroll") for (int i = 0; i < 4; ++i) pfA[i] = *(const u32x4*)((const char*)W0Np + ci * 16384 + (size_t)(tid + 256 * i) * 16); \
    _Pragma("unroll") for (int i = 0; i < 4; ++i) pfA[4 + i] = *(const u32x4*)((const char*)QDp + ci * 16384 + (size_t)(tid + 256 * i) * 16); \
    _Pragma("unroll") for (int mt = 0; mt < 4; ++mt) \
      _Pragma("unroll") for (int r = 0; r < 4; ++r) rvp[mt * 4 + r] = RVp[(ci * 64 + 16 * mt + 4 * fq + r) * 128 + vcol0 + fr]; \
  } while (0)
#define DN_STORE_A() do { \
    _Pragma("unroll") for (int i = 0; i < 4; ++i) { const int q = tid + 256 * i, row = q >> 4, ch = q & 15; *(u32x4*)(sW0 + row * 256 + ((ch ^ (row & 15)) << 4)) = pfA[i]; } \
    _Pragma("unroll") for (int i = 0; i < 4; ++i) { const int q = tid + 256 * i, row = q >> 4, ch = q & 15; *(u32x4*)(sQD + row * 256 + ((ch ^ (row & 15)) << 4)) = pfA[4 + i]; } \
  } while (0)
#define DN_LOAD_B(nn_) do { \
    const size_t ci = (size_t)bh * 64 + (nn_); \
    _Pragma("unroll") for (int i = 0; i < 4; ++i) pfB[i] = *(const u32x4*)((const char*)KTTp + ci * 16384 + (size_t)(tid + 256 * i) * 16); \
    _Pragma("unroll") for (int i = 0; i < 2; ++i) pfB[4 + i] = *(const u32x4*)((const char*)TMp + ci * 8192 + (size_t)(tid + 256 * i) * 16); \
    _Pragma("unroll") for (int i = 0; i < 2; ++i) pfB[6 + i] = *(const u32x4*)((const char*)ATTp + ci * 8192 + (size_t)(tid + 256 * i) * 16); \
  } while (0)
#define DN_STORE_B() do { \
    _Pragma("unroll") for (int i = 0; i < 4; ++i) { const int q = tid + 256 * i, row = q >> 3, ch = q & 7; *(u32x4*)(sKT + row * 128 + ((ch ^ (row & 7)) << 4)) = pfB[i]; } \
    _Pragma("unroll") for (int i = 0; i < 2; ++i) { const int q = tid + 256 * i, row = q >> 3, ch = q & 7; *(u32x4*)(sT + row * 128 + ((ch ^ (row & 7)) << 4)) = pfB[4 + i]; } \
    _Pragma("unroll") for (int i = 0; i < 2; ++i) { const int q = tid + 256 * i, row = q >> 3, ch = q & 7; *(u32x4*)(sAT + row * 128 + ((ch ^ (row & 7)) << 4)) = pfB[6 + i]; } \
  } while (0)
#define DN_ZINIT() do { _Pragma("unroll") for (int mt = 0; mt < 4; ++mt) Z[mt] = (f32x4){bf2f(rvp[mt * 4 + 0]), bf2f(rvp[mt * 4 + 1]), bf2f(rvp[mt * 4 + 2]), bf2f(rvp[mt * 4 + 3])}; } while (0)
  __syncthreads();
  f32x4 Z[4];
  DN_LOAD_A(0);
  DN_LOAD_B(0);
  DN_STORE_A();
  DN_ZINIT();
  DN_LOAD_A(1);
  for (int nn = 0; nn < 64; ++nn) {
    const float gl = GLp[(size_t)bh * 64 + nn];
    __syncthreads();
    bf16x8 Sb[4];
#pragma unroll
    for (int k4 = 0; k4 < 4; ++k4) Sb[k4] = pack8(S[2 * k4], S[2 * k4 + 1]);
    f32x4 O[4];
#pragma unroll
    for (int mt = 0; mt < 4; ++mt) {
      O[mt] = (f32x4){0.f, 0.f, 0.f, 0.f};
      const int row = 16 * mt + fr;
#pragma unroll
      for (int k4 = 0; k4 < 4; ++k4) {
        const int off = row * 256 + ((((k4 * 4 + fq) ^ fr)) << 4);
        const bf16x8 aw = *(const bf16x8*)(sW0 + off);
        const bf16x8 aq = *(const bf16x8*)(sQD + off);
        Z[mt] = __builtin_amdgcn_mfma_f32_16x16x32_bf16(aw, Sb[k4], Z[mt], 0, 0, 0);
        O[mt] = __builtin_amdgcn_mfma_f32_16x16x32_bf16(aq, Sb[k4], O[mt], 0, 0, 0);
      }
    }
    bf16x8 Zb[2];
    Zb[0] = pack8(Z[0], Z[1]); Zb[1] = pack8(Z[2], Z[3]);
    DN_STORE_B();
    if (nn + 1 < 64) DN_LOAD_B(nn + 1);
    __syncthreads();
    f32x4 Vn[4];
#pragma unroll
    for (int mt = 0; mt < 4; ++mt) {
      Vn[mt] = (f32x4){0.f, 0.f, 0.f, 0.f};
      const int row = 16 * mt + fr;
#pragma unroll
      for (int s = 0; s < 2; ++s) {
        if (s <= (mt >> 1)) {
          const bf16x8 at = *(const bf16x8*)(sT + row * 128 + ((((s * 4 + fq) ^ (row & 7))) << 4));
          Vn[mt] = __builtin_amdgcn_mfma_f32_16x16x32_bf16(at, Zb[s], Vn[mt], 0, 0, 0);
        }
      }
    }
    bf16x8 Vb[2];
    Vb[0] = pack8(Vn[0], Vn[1]); Vb[1] = pack8(Vn[2], Vn[3]);
#pragma unroll
    for (int mt = 0; mt < 4; ++mt) {
      const int row = 16 * mt + fr;
#pragma unroll
      for (int s = 0; s < 2; ++s) {
        if (s <= (mt >> 1)) {
          const bf16x8 aa = *(const bf16x8*)(sAT + row * 128 + ((((s * 4 + fq) ^ (row & 7))) << 4));
          O[mt] = __builtin_amdgcn_mfma_f32_16x16x32_bf16(aa, Vb[s], O[mt], 0, 0, 0);
        }
      }
      const size_t tok = (size_t)b * SEQ + nn * 64 + 16 * mt + 4 * fq;
#pragma unroll
      for (int r = 0; r < 4; ++r) op[(tok + r) * 512 + h * 128 + vcol0 + fr] = O[mt][r];
    }
#pragma unroll
    for (int t = 0; t < 8; ++t) {
      S[t] = S[t] * gl;
      const int row = 16 * t + fr;
#pragma unroll
      for (int s = 0; s < 2; ++s) {
        const bf16x8 ak = *(const bf16x8*)(sKT + row * 128 + ((((s * 4 + fq) ^ (row & 7))) << 4));
        S[t] = __builtin_amdgcn_mfma_f32_16x16x32_bf16(ak, Vb[s], S[t], 0, 0, 0);
      }
    }
    if (nn + 1 < 64) {
      DN_STORE_A();
      DN_ZINIT();
      if (nn + 2 < 64) DN_LOAD_A(nn + 2);
    }
  }
  __syncthreads();
#undef DN_ZINIT
#undef DN_LOAD_A
#undef DN_STORE_A
#undef DN_LOAD_B
#undef DN_STORE_B
}

__device__ __forceinline__ void ph_dn_post(int item, const float* __restrict__ o, const bf16_t* __restrict__ proj, const float* __restrict__ dn_norm_g, bf16_t* __restrict__ mixed) {
  const int tid = TIDX, h = tid >> 6, lane = tid & 63;
  const float2 g2 = *(const float2*)(dn_norm_g + 2 * lane);
  float2 ov[4]; unsigned zv[4];
#pragma unroll
  for (int i = 0; i < 4; ++i) {
    const size_t n = (size_t)item * 4 + i;
    ov[i] = *(const float2*)(o + n * 512 + h * 128 + 2 * lane);
    zv[i] = *(const unsigned*)(proj + n * PROJW + OFF_Z + h * 128 + 2 * lane);
  }
#pragma unroll
  for (int i = 0; i < 4; ++i) {
    const size_t n = (size_t)item * 4 + i;
    const float ss = wave_sum(ov[i].x * ov[i].x + ov[i].y * ov[i].y);
    const float rn = rsqrtf(ss * (1.f / 128.f) + RMS_EPS);
    *(unsigned*)(mixed + n * DM + h * 128 + 2 * lane) = pack2(ov[i].x * rn * g2.x * siluf(bflo(zv[i])), ov[i].y * rn * g2.y * siluf(bfhi(zv[i])));
  }
}

__device__ __forceinline__ void ph_swa(unsigned char* smem, int item, const bf16_t* __restrict__ proj, const bf16_t* __restrict__ vt, const float* __restrict__ sinks, bf16_t* __restrict__ mixed) {
  const int tid = TIDX, lane = tid & 63, w = tid >> 6, fr = lane & 15, fq = lane >> 4;
  const int qb = item & 31, kvh = (item >> 5) & 1, b = item >> 6;
  const int t0 = qb * 128;
  const size_t rowb = (size_t)b * SEQ;
  unsigned char* sK = smem;
  unsigned char* sV = smem + 32768;
  __syncthreads();
#pragma unroll
  for (int i = 0; i < 8; ++i) {
    const int q = tid + 256 * i, row = q >> 3, ch = q & 7;
    const int pos = t0 - 128 + row;
    u32x4 v = (u32x4){0u, 0u, 0u, 0u};
    if (pos >= 0) v = *(const u32x4*)(proj + (rowb + pos) * PROJW + OFF_SK + kvh * 64 + ch * 8);
    *(u32x4*)(sK + row * 128 + ((ch ^ (row & 7)) << 4)) = v;
  }
#pragma unroll
  for (int i = 0; i < 8; ++i) {
    const int q = tid + 256 * i, row = q >> 5, ch = q & 31;
    const int pos = t0 - 128 + ch * 8;
    u32x4 v = (u32x4){0u, 0u, 0u, 0u};
    if (pos >= 0) v = *(const u32x4*)(vt + ((size_t)(b * 128 + kvh * 64 + row)) * SEQ + pos);
    *(u32x4*)(sV + row * 512 + ((ch ^ (row & 15)) << 4)) = v;
  }
  __syncthreads();
  const int head = kvh * 4 + w;
  const float slope = exp2f(-(float)(head + 1));
  const float sink = sinks[head];
  const bf16_t* qp0 = proj + (rowb + t0 + fr) * PROJW + OFF_SQ + head * 64 + fq * 8;
  bf16x8 qn0 = *(const bf16x8*)(qp0), qn1 = *(const bf16x8*)(qp0 + 32);
#pragma unroll 1
  for (int qt = 0; qt < 8; ++qt) {
    const bf16x8 qf0 = qn0, qf1 = qn1;
    if (qt < 7) { const bf16_t* qp = qp0 + (size_t)(qt + 1) * 16 * PROJW; qn0 = *(const bf16x8*)(qp); qn1 = *(const bf16x8*)(qp + 32); }
    const int kp0 = qt >> 1;
    f32x4 st[10];
#pragma unroll
    for (int kt = 0; kt < 10; ++kt) {
      const int krow = (2 * kp0 + kt) * 16 + fr;
      st[kt] = (f32x4){0.f, 0.f, 0.f, 0.f};
      const bf16x8 k0 = *(const bf16x8*)(sK + krow * 128 + (((0 + fq) ^ (krow & 7)) << 4));
      const bf16x8 k1 = *(const bf16x8*)(sK + krow * 128 + (((4 + fq) ^ (krow & 7)) << 4));
      st[kt] = __builtin_amdgcn_mfma_f32_16x16x32_bf16(k0, qf0, st[kt], 0, 0, 0);
      st[kt] = __builtin_amdgcn_mfma_f32_16x16x32_bf16(k1, qf1, st[kt], 0, 0, 0);
    }
    const int i = qt * 16 + fr;
    float mx = sink;
#pragma unroll
    for (int kt = 0; kt < 10; ++kt)
#pragma unroll
      for (int r = 0; r < 4; ++r) {
        const int jb = (2 * kp0 + kt) * 16 + 4 * fq + r;
        const int dist = 128 + i - jb;
        const bool ok = (dist >= 0) && (dist < 128) && (t0 - 128 + jb >= 0);
        const float s = ok ? (st[kt][r] * 0.125f - slope * (float)dist) : -INFINITY;
        st[kt][r] = s;
        mx = fmaxf(mx, s);
      }
    mx = fmaxf(mx, __shfl_xor(mx, 16));
    mx = fmaxf(mx, __shfl_xor(mx, 32));
    float sum = 0.f;
#pragma unroll
    for (int kt = 0; kt < 10; ++kt)
#pragma unroll
      for (int r = 0; r < 4; ++r) { const float p = __expf(st[kt][r] - mx); st[kt][r] = p; sum += p; }
    sum += __shfl_xor(sum, 16);
    sum += __shfl_xor(sum, 32);
    const float inv = 1.f / (sum + __expf(sink - mx));
    f32x4 O[4];
#pragma unroll
    for (int nt = 0; nt < 4; ++nt) O[nt] = (f32x4){0.f, 0.f, 0.f, 0.f};
#pragma unroll
    for (int s5 = 0; s5 < 5; ++s5) {
      const bf16x8 pa = pack8(st[2 * s5] * inv, st[2 * s5 + 1] * inv);
      const int key0 = (2 * kp0 + 2 * s5) * 16 + 4 * fq;
#pragma unroll
      for (int nt = 0; nt < 4; ++nt) {
        const int drow = nt * 16 + fr;
        const int c0 = key0 >> 3, c1 = (key0 + 16) >> 3;
        const u32x2 lo = *(const u32x2*)(sV + drow * 512 + ((c0 ^ (drow & 15)) << 4) + ((key0 >> 2) & 1) * 8);
        const u32x2 hi = *(const u32x2*)(sV + drow * 512 + ((c1 ^ (drow & 15)) << 4) + ((key0 >> 2) & 1) * 8);
        const u32x4 vb = (u32x4){lo[0], lo[1], hi[0], hi[1]};
        O[nt] = __builtin_amdgcn_mfma_f32_16x16x32_bf16(pa, __builtin_bit_cast(bf16x8, vb), O[nt], 0, 0, 0);
      }
    }
#pragma unroll
    for (int nt = 0; nt < 4; ++nt)
#pragma unroll
      for (int r = 0; r < 4; ++r)
        mixed[(rowb + t0 + qt * 16 + 4 * fq + r) * DM + 512 + head * 64 + nt * 16 + fr] = (bf16_t)f2bf(O[nt][r]);
  }
}

__device__ __forceinline__ void ph_wout(unsigned char* smem, int xcd, int l, const bf16_t* __restrict__ mixed, const bf16_t* __restrict__ wt, const float* __restrict__ x, float* __restrict__ y1) {
  const int mi = l >> 3, ni = l & 7;
  LdRowBF16 al; al.init([&](int r) { return mixed + (size_t)((xcd * 32 + mi) * 128 + r) * DM; }, (size_t)8 * 128 * DM * 2);
  LdRowBF16 bl; bl.init([&](int r) { return wt + (size_t)(ni * 128 + r) * DM; }, 0);
  gemm_stream<16>(smem, al, bl, 4, [&](int seg, f32x4 (&acc)[4][4]) {
    GEMM_IDS
    const int m0 = (xcd * 32 + seg * 8 + mi) * 128, n0 = ni * 128;
#pragma unroll
    for (int m = 0; m < 4; ++m)
#pragma unroll
      for (int n = 0; n < 4; ++n) {
        const size_t idx = (size_t)(m0 + wr * 64 + m * 16 + fr) * DM + n0 + wc * 64 + n * 16 + fq * 4;
        const f32x4 xv = *(const f32x4*)(x + idx);
        *(f32x4*)(y1 + idx) = xv * ALPHA + acc[m][n];
      }
  });
}

__device__ __forceinline__ void ph_ln1(int item, const float* __restrict__ y, const float* __restrict__ gam, const float* __restrict__ bet, bf16_t* __restrict__ xbf) {
  const int row = item * 4 + (TIDX >> 6), lane = TIDX & 63;
  const float4* p = (const float4*)(y + (size_t)row * DM);
  float4 v[4]; float s = 0.f;
#pragma unroll
  for (int i = 0; i < 4; ++i) { v[i] = p[lane + i * 64]; s += v[i].x + v[i].y + v[i].z + v[i].w; }
  const float mu = wave_sum(s) * (1.f / DM);
  float q = 0.f;
#pragma unroll
  for (int i = 0; i < 4; ++i) { const float a = v[i].x - mu, b = v[i].y - mu, c = v[i].z - mu, d = v[i].w - mu; q += a * a + b * b + c * c + d * d; }
  const float rs = rsqrtf(wave_sum(q) * (1.f / DM) + LN_EPS);
#pragma unroll
  for (int i = 0; i < 4; ++i) {
    const float4 gg = ((const float4*)gam)[lane + i * 64], bb = ((const float4*)bet)[lane + i * 64];
    u32x2 w;
    w[0] = pack2((v[i].x - mu) * rs * gg.x + bb.x, (v[i].y - mu) * rs * gg.y + bb.y);
    w[1] = pack2((v[i].z - mu) * rs * gg.z + bb.z, (v[i].w - mu) * rs * gg.w + bb.w);
    ((u32x2*)(xbf + (size_t)row * DM))[lane + i * 64] = w;
  }
}

__device__ __forceinline__ void ph_router(unsigned char* smem, int tile, const bf16_t* __restrict__ xbf, const bf16_t* __restrict__ wt, float* __restrict__ logits) {
  GEMM_IDS
  const int n0 = (tile & 1) * 128, m0 = (tile >> 1) * 128;
  LdRowBF16 al; al.init([&](int r) { return xbf + (size_t)(m0 + r) * DM; }, 0);
  LdRowBF16 bl; bl.init([&](int r) { return wt + (size_t)(n0 + r) * DM; }, 0);
  gemm_stream<16>(smem, al, bl, 1, [&](int seg, f32x4 (&acc)[4][4]) {
    GEMM_IDS
#pragma unroll
    for (int m = 0; m < 4; ++m)
#pragma unroll
      for (int n = 0; n < 4; ++n)
        *(f32x4*)(logits + (size_t)(m0 + wr * 64 + m * 16 + fr) * NEXP + n0 + wc * 64 + n * 16 + fq * 4) = acc[m][n];
  });
}

__device__ __forceinline__ void ph_route(int item, const float* __restrict__ logits, const float* __restrict__ router_bias, int* __restrict__ cnt, int* __restrict__ list, float* __restrict__ gates) {
  const int n = item * 4 + (TIDX >> 6), lane = TIDX & 63;
  const float4 lg = ((const float4*)(logits + (size_t)n * NEXP))[lane];
  const float4 rb = ((const float4*)router_bias)[lane];
  float sc[4] = {sigmoidf(lg.x), sigmoidf(lg.y), sigmoidf(lg.z), sigmoidf(lg.w)};
  float sel[4] = {sc[0] + rb.x, sc[1] + rb.y, sc[2] + rb.z, sc[3] + rb.w};
  float t1 = fmaxf(sel[0], sel[1]), t2 = fminf(sel[0], sel[1]);
  { const float a = sel[2]; if (a > t1) { t2 = t1; t1 = a; } else if (a > t2) t2 = a; }
  { const float a = sel[3]; if (a > t1) { t2 = t1; t1 = a; } else if (a > t2) t2 = a; }
#pragma unroll
  for (int o = 1; o < 8; o <<= 1) {
    const float b1 = __shfl_xor(t1, o), b2 = __shfl_xor(t2, o);
    const float n1 = fmaxf(t1, b1), n2 = fmaxf(fminf(t1, b1), fmaxf(t2, b2));
    t1 = n1; t2 = n2;
  }
  const float gs = t1 + t2;
  const int mygrp = lane >> 3;
  int rank = 0;
#pragma unroll
  for (int j = 0; j < 8; ++j) {
    const float o = __shfl(gs, j * 8);
    rank += (o > gs || (o == gs && j < mygrp)) ? 1 : 0;
  }
  const bool gsel = rank < 4;
  float cand[4];
#pragma unroll
  for (int i = 0; i < 4; ++i) cand[i] = gsel ? sel[i] : -INFINITY;
  float gsum = 0.f; float myg = 0.f; int mye = 0;
#pragma unroll 1
  for (int r = 0; r < TOPK; ++r) {
    float bv = cand[0]; int bi = 0;
#pragma unroll
    for (int i = 1; i < 4; ++i) if (cand[i] > bv) { bv = cand[i]; bi = i; }
    int be = lane * 4 + bi;
    float bs = (bi == 0) ? sc[0] : (bi == 1) ? sc[1] : (bi == 2) ? sc[2] : sc[3];
#pragma unroll
    for (int o = 1; o < 64; o <<= 1) {
      const float ov = __shfl_xor(bv, o); const int oe = __shfl_xor(be, o); const float os = __shfl_xor(bs, o);
      if (ov > bv || (ov == bv && oe < be)) { bv = ov; be = oe; bs = os; }
    }
    if ((be >> 2) == lane) {
      const int bi2 = be & 3;
      if (bi2 == 0) cand[0] = -INFINITY; else if (bi2 == 1) cand[1] = -INFINITY; else if (bi2 == 2) cand[2] = -INFINITY; else cand[3] = -INFINITY;
    }
    gsum += bs;
    if (lane == r) { myg = bs; mye = be; }
  }
  if (lane < TOPK) {
    const int slot = atomicAdd(&cnt[mye], 1);
    list[(size_t)mye * CAP + slot] = n * TOPK + lane;
    gates[(size_t)n * TOPK + lane] = myg / gsum * 2.5f;
  }
}

__device__ __forceinline__ void moe_build_prefix(const int* __restrict__ cnt, int* sscan) {
  const int tid = TIDX;
  const int e = ((tid & 31) << 3) | (tid >> 5);
  const int c = cnt[e];
  __syncthreads();
  sscan[tid] = (c + 127) >> 7;
  __syncthreads();
  for (int o = 1; o < 256; o <<= 1) {
    const int v = (tid >= o) ? sscan[tid - o] : 0;
    __syncthreads();
    sscan[tid] += v;
    __syncthreads();
  }
}
__device__ __forceinline__ void moe_locate(const int* sscan, int x, int lt, int& e, int& rt) {
  const int base = x ? sscan[32 * x - 1] : 0;
  const int nrouted = sscan[32 * x + 31] - base;
  if (lt >= nrouted) { e = 256; rt = x * (NTOK / 128 / 8) + (lt - nrouted); return; }
  const int g = base + lt;
  int lo = 32 * x, hi = 32 * x + 31;
  while (lo < hi) { const int mid = (lo + hi) >> 1; if (sscan[mid] > g) hi = mid; else lo = mid + 1; }
  e = ((lo & 31) << 3) | (lo >> 5); rt = g - (lo ? sscan[lo - 1] : 0);
}

__device__ __forceinline__ void ph_moe(unsigned char* smem, int e, int rt, const bf16_t* __restrict__ xbf, const int* __restrict__ cnt, const int* __restrict__ list,
                                       const float* __restrict__ gates, const bf16_t* __restrict__ wge, const bf16_t* __restrict__ wue, const bf16_t* __restrict__ wde,
                                       bf16_t* __restrict__ ybuf, float* __restrict__ dout) {
  int* sasg = (int*)(smem + SM_MISC + 2048);
  float* sgate = (float*)(smem + SM_MISC + 2048 + 512);
  const int tid = TIDX, lane = tid & 63, w = tid >> 6, fr = lane & 15, fq = lane >> 4;
  const int rows = (e < 256) ? cnt[e] : NTOK;
  __syncthreads();
  if (tid < 128) {
    const int r = rt * 128 + tid;
    int a = -1;
    if (r < rows) a = (e < 256) ? list[(size_t)e * CAP + r] : (NA + r);
    sasg[tid] = a;
    sgate[tid] = (a >= 0 && a < NA) ? gates[a] : 1.f;
  }
  __syncthreads();
  bf16x8 hf[2][8];
  {
    LdRowBF16 al; al.init([&](int r) { const int a = sasg[r]; const int tok = (a < 0) ? 0 : (a < NA ? (a >> 3) : (a - NA)); return xbf + (size_t)tok * DM; }, 0);
    LdRowBF16 bl; bl.init([&](int j) {
      const int bn = j >> 4, ff = (bn >> 1) * 16 + (j & 15);
      return ((bn & 1) ? wue : wge) + (size_t)ff * DM; }, (size_t)64 * DM * 2);
    al.issue(0, 0, smem); bl.issue(0, 0, smem + 16384);
    asm volatile("s_waitcnt vmcnt(0)" ::: "memory");
    __syncthreads();
#pragma unroll
    for (int m = 0; m < 2; ++m)
#pragma unroll
      for (int s = 0; s < 8; ++s) hf[m][s] = (bf16x8){0, 0, 0, 0, 0, 0, 0, 0};
#pragma unroll 1
    for (int ct = 0; ct < 4; ++ct) {
      f32x4 acc[2][8];
#pragma unroll
      for (int m = 0; m < 2; ++m)
#pragma unroll
        for (int n = 0; n < 8; ++n) acc[m][n] = (f32x4){0.f, 0.f, 0.f, 0.f};
#pragma unroll 1
      for (int kk = 0; kk < 16; ++kk) {
        const int j = ct * 16 + kk;
        unsigned char* cur = smem + (j & 1) * 32768; unsigned char* nxt = smem + ((j & 1) ^ 1) * 32768;
        if (j + 1 < 64) { al.issue((j + 1) >> 4, (j + 1) & 15, nxt); bl.issue((j + 1) >> 4, (j + 1) & 15, nxt + 16384); }
#pragma unroll
        for (int ks = 0; ks < 2; ++ks) {
          bf16x8 a[2];
#pragma unroll
          for (int m = 0; m < 2; ++m) {
            const int row = w * 32 + m * 16 + fr;
            a[m] = *(const bf16x8*)(cur + row * 128 + (((ks * 4 + fq) ^ (row & 7)) << 4));
          }
#pragma unroll
          for (int n = 0; n < 8; ++n) {
            const int row = n * 16 + fr;
            const bf16x8 bfrag = *(const bf16x8*)(cur + 16384 + row * 128 + (((ks * 4 + fq) ^ (row & 7)) << 4));
#pragma unroll
            for (int m = 0; m < 2; ++m) acc[m][n] = __builtin_amdgcn_mfma_f32_16x16x32_bf16(bfrag, a[m], acc[m][n], 0, 0, 0);
          }
          __builtin_amdgcn_sched_barrier(0);
        }
        asm volatile("s_waitcnt vmcnt(0)" ::: "memory");
        __syncthreads();
      }
#pragma unroll
      for (int m = 0; m < 2; ++m) {
        f32x4 hv[4];
#pragma unroll
        for (int p = 0; p < 4; ++p)
#pragma unroll
          for (int r = 0; r < 4; ++r) hv[p][r] = siluf(acc[m][2 * p][r]) * acc[m][2 * p + 1][r];
        const bf16x8 h0 = pack8(hv[0], hv[1]), h1 = pack8(hv[2], hv[3]);
        if (ct == 0) { hf[m][0] = h0; hf[m][1] = h1; }
        else if (ct == 1) { hf[m][2] = h0; hf[m][3] = h1; }
        else if (ct == 2) { hf[m][4] = h0; hf[m][5] = h1; }
        else { hf[m][6] = h0; hf[m][7] = h1; }
      }
    }
  }
  {
    LdRowBF16 bl; bl.init([&](int j) { return wde + (size_t)j * EFF; }, (size_t)128 * EFF * 2);
    bl.issue(0, 0, smem + 16384);
    asm volatile("s_waitcnt vmcnt(0)" ::: "memory");
    __syncthreads();
#pragma unroll 1
    for (int ct = 0; ct < 8; ++ct) {
      f32x4 acc[2][8];
#pragma unroll
      for (int m = 0; m < 2; ++m)
#pragma unroll
        for (int n = 0; n < 8; ++n) acc[m][n] = (f32x4){0.f, 0.f, 0.f, 0.f};
#pragma unroll
      for (int kk = 0; kk < 4; ++kk) {
        const int j = ct * 4 + kk;
        unsigned char* cur = smem + (kk & 1) * 32768 + 16384; unsigned char* nxt = smem + ((kk & 1) ^ 1) * 32768 + 16384;
        if (j + 1 < 32) bl.issue((j + 1) >> 2, (j + 1) & 3, nxt);
#pragma unroll
        for (int ks = 0; ks < 2; ++ks) {
#pragma unroll
          for (int n = 0; n < 8; ++n) {
            const int row = n * 16 + fr;
            const bf16x8 wf = *(const bf16x8*)(cur + row * 128 + (((ks * 4 + fq) ^ (row & 7)) << 4));
#pragma unroll
            for (int m = 0; m < 2; ++m) acc[m][n] = __builtin_amdgcn_mfma_f32_16x16x32_bf16(wf, hf[m][kk * 2 + ks], acc[m][n], 0, 0, 0);
          }
          __builtin_amdgcn_sched_barrier(0);
        }
        asm volatile("s_waitcnt vmcnt(0)" ::: "memory");
        __syncthreads();
      }
      const int n0 = ct * 128;
#pragma unroll
      for (int m = 0; m < 2; ++m) {
        const int r_ = w * 32 + m * 16 + fr;
        const int a = sasg[r_];
        if (a >= NA) {
          float* dp = dout + (size_t)(a - NA) * DM + n0 + fq * 4;
          const bf16_t* xp = xbf + (size_t)(a - NA) * DM + n0 + fq * 4;
#pragma unroll
          for (int n = 0; n < 8; ++n) {
            const u32x2 xw = *(const u32x2*)(xp + n * 16);
            const f32x4 xv = (f32x4){bflo(xw[0]), bfhi(xw[0]), bflo(xw[1]), bfhi(xw[1])};
            *(f32x4*)(dp + n * 16) = xv * ALPHA + acc[m][n];
          }
        } else if (a >= 0) {
          const float gt = sgate[r_];
#pragma unroll
          for (int n = 0; n < 8; ++n) {
            u32x2 wv; wv[0] = pack2(acc[m][n][0] * gt, acc[m][n][1] * gt); wv[1] = pack2(acc[m][n][2] * gt, acc[m][n][3] * gt);
            *(u32x2*)(ybuf + (size_t)a * DM + n0 + n * 16 + fq * 4) = wv;
          }
        }
      }
    }
  }
}

__device__ __forceinline__ void ph_final(int item, float* __restrict__ out, const bf16_t* __restrict__ ybuf, const float* __restrict__ gam, const float* __restrict__ bet) {
  const int row = item * 4 + (TIDX >> 6), lane = TIDX & 63;
  float4* p = (float4*)(out + (size_t)row * DM);
  float4 v[4]; float s = 0.f;
#pragma unroll
  for (int i = 0; i < 4; ++i) {
    float4 a = p[lane + i * 64];
#pragma unroll
    for (int k = 0; k < 8; ++k) {
      const uint2 w = ((const uint2*)(ybuf + ((size_t)row * 8 + k) * DM))[lane + i * 64];
      a.x += bflo(w.x); a.y += bfhi(w.x); a.z += bflo(w.y); a.w += bfhi(w.y);
    }
    v[i] = a; s += a.x + a.y + a.z + a.w;
  }
  const float mu = wave_sum(s) * (1.f / DM);
  float q = 0.f;
#pragma unroll
  for (int i = 0; i < 4; ++i) { const float a = v[i].x - mu, b = v[i].y - mu, c = v[i].z - mu, d = v[i].w - mu; q += a * a + b * b + c * c + d * d; }
  const float rs = rsqrtf(wave_sum(q) * (1.f / DM) + LN_EPS);
#pragma unroll
  for (int i = 0; i < 4; ++i) {
    const float4 gg = ((const float4*)gam)[lane + i * 64], bb = ((const float4*)bet)[lane + i * 64];
    float4 r;
    r.x = (v[i].x - mu) * rs * gg.x + bb.x; r.y = (v[i].y - mu) * rs * gg.y + bb.y;
    r.z = (v[i].z - mu) * rs * gg.z + bb.z; r.w = (v[i].w - mu) * rs * gg.w + bb.w;
    p[lane + i * 64] = r;
  }
}

#define XB_TMO      128
#define XB_XCNT(j)  (256  + 64 * (j))
#define XB_XSUB(j)  (1280 + 64 * (j))
#define XB_XGEN(j)  (2304 + 64 * (j))
#define XB_TOP      3328
#define XB_TOPGEN   3392
#define XCD_BAR_WORDS 3456
#define XB_SPIN_CAP (1u << 22)
#define LAS __attribute__((address_space(3)))
__device__ __forceinline__ unsigned xb_ld(unsigned* p)              { return __hip_atomic_load(p, __ATOMIC_RELAXED, __HIP_MEMORY_SCOPE_AGENT); }
__device__ __forceinline__ unsigned xb_add(unsigned* p, unsigned v) { return __hip_atomic_fetch_add(p, v, __ATOMIC_RELAXED, __HIP_MEMORY_SCOPE_AGENT); }
__device__ __forceinline__ unsigned xb_xcc_id() { return (unsigned)__builtin_amdgcn_s_getreg((3 << 11) | 20) & 0xFu; }
#define XB_SPIN(cond, bar) do { unsigned _sp = 0; while (cond) { __builtin_amdgcn_s_sleep(1); \
    if ((++_sp & 255u) == 0u) { if (xb_ld(&(bar)[XB_TMO])) break; if (_sp > XB_SPIN_CAP) { atomicAdd(&(bar)[XB_TMO], 1u); break; } } } } while (0)
struct XcdBarrier { unsigned* bar; unsigned x; volatile LAS unsigned* st; };
__device__ __forceinline__ XcdBarrier xcd_barrier_post(unsigned* bar, volatile LAS unsigned* st) {
  XcdBarrier b; b.bar = bar; b.x = xb_xcc_id(); b.st = st;
  if (threadIdx.x == 0) (void)xb_add(&bar[XB_XCNT(b.x)], 1u);
  return b;
}
__device__ __forceinline__ void xcd_barrier_complete(unsigned* bar, unsigned x, unsigned& nloc, unsigned& nx) {
  const unsigned G = gridDim.x * gridDim.y * gridDim.z;
  unsigned sum, cnt, mine, sp = 0u;
  for (;;) {
    sum = 0u; cnt = 0u; mine = 0u;
#pragma unroll
    for (unsigned j = 0; j < 16; ++j) { const unsigned c = xb_ld(&bar[XB_XCNT(j)]); sum += c; cnt += (c > 0u) ? 1u : 0u; mine = (j == x) ? c : mine; }
    if (sum == G) break;
    __builtin_amdgcn_s_sleep(1);
    if ((++sp & 255u) == 0u) { if (xb_ld(&bar[XB_TMO])) break; if (sp > XB_SPIN_CAP) { atomicAdd(&bar[XB_TMO], 1u); break; } }
  }
  nloc = mine > 0u ? mine : 1u; nx = cnt > 0u ? cnt : 1u;
}
__device__ __forceinline__ void xcd_barrier(const XcdBarrier& b) {
  asm volatile("s_waitcnt vmcnt(0)" ::: "memory");
  __syncthreads();
  if (threadIdx.x == 0) {
    unsigned* bar = b.bar;
    __builtin_amdgcn_s_waitcnt(0);
    unsigned nloc = b.st[0], nx = b.st[1];
    if (nloc == 0u) { xcd_barrier_complete(bar, b.x, nloc, nx); b.st[0] = nloc; b.st[1] = nx; }
    const unsigned old = xb_add(&bar[XB_XSUB(b.x)], 1u);
    const unsigned gen = old / nloc;
    if (old + 1u == (gen + 1u) * nloc) {
      __builtin_amdgcn_fence(__ATOMIC_RELEASE, "agent");
      asm volatile("s_waitcnt vmcnt(0)" ::: "memory");
      const unsigned og = xb_add(&bar[XB_TOP], 1u);
      const unsigned tg = og / nx;
      if (og + 1u == (tg + 1u) * nx) xb_add(&bar[XB_TOPGEN], 1u);
      else XB_SPIN(xb_ld(&bar[XB_TOPGEN]) == tg, bar);
      __builtin_amdgcn_fence(__ATOMIC_ACQUIRE, "agent");
      xb_add(&bar[XB_XGEN(b.x)], 1u);
      asm volatile("s_waitcnt vmcnt(0)" ::: "memory");
    } else {
      XB_SPIN(xb_ld(&bar[XB_XGEN(b.x)]) == gen, bar);
      __builtin_amdgcn_fence(__ATOMIC_ACQUIRE, "agent");
      asm volatile("s_waitcnt vmcnt(0)" ::: "memory");
    }
  }
  __syncthreads();
}

__global__ void __launch_bounds__(256, 2) mega(Params P) {
  __shared__ __attribute__((aligned(16))) unsigned char smem[SMEM_BYTES];
  const int bid = blockIdx.x, nblk = gridDim.x;
#define xin (P.in[0])
#define w_in (P.in[1])
#define conv_w (P.in[2])
#define a_log (P.in[3])
#define dt_bias (P.in[4])
#define dn_norm_g (P.in[5])
#define sinks (P.in[6])
#define w_out (P.in[7])
#define ln1_g (P.in[8])
#define ln1_b (P.in[9])
#define router_w (P.in[10])
#define router_bias (P.in[11])
#define w_gate (P.in[12])
#define w_up (P.in[13])
#define w_down (P.in[14])
#define sw_gate (P.in[15])
#define sw_up (P.in[16])
#define sw_down (P.in[17])
#define ln2_g (P.in[18])
#define ln2_b (P.in[19])
#define outp (P.out)
#define x1bf ((bf16_t*)(P.ws + WS_X1BF))
#define logits ((float*)(P.ws + WS_LOGIT))
#define list ((int*)(P.ws + WS_LIST))
#define gates ((float*)(P.ws + WS_GATES))
#define cnt ((int*)(P.ws + WS_CTRL))
#define barw ((unsigned*)(P.ws + WS_CTRL + 4096))
#define mixed ((bf16_t*)(P.ws + WS_MIXED))
#define proj ((bf16_t*)(P.ws + WS_PROJ))
#define ba ((float*)(P.ws + WS_BA))
#define QD ((bf16_t*)(P.ws + WS_QD))
#define W0N ((bf16_t*)(P.ws + WS_W0N))
#define KTT ((bf16_t*)(P.ws + WS_KTT))
#define RV ((bf16_t*)(P.ws + WS_RV))
#define TM ((bf16_t*)(P.ws + WS_TM))
#define ATT ((bf16_t*)(P.ws + WS_ATT))
#define GL ((float*)(P.ws + WS_GL))
#define obuf ((float*)(P.ws + WS_O))
#define VTb ((bf16_t*)(P.ws + WS_VT))
#define XBF ((bf16_t*)(P.ws + WS_XBF))
#define WTIN ((bf16_t*)(P.ws + WS_WTIN))
#define WTOUT ((bf16_t*)(P.ws + WS_WTOUT))
#define WTR ((bf16_t*)(P.ws + WS_WTR))
#define WTG ((bf16_t*)(P.ws + WS_WTG))
#define WTU ((bf16_t*)(P.ws + WS_WTU))
#define WTD ((bf16_t*)(P.ws + WS_WTD))
#define WTSG ((bf16_t*)(P.ws + WS_WTSG))
#define WTSU ((bf16_t*)(P.ws + WS_WTSU))
#define WTSD ((bf16_t*)(P.ws + WS_WTSD))
#define ybuf ((bf16_t*)(P.ws + WS_YBUF))
  {
    volatile LAS unsigned* st0 = (volatile LAS unsigned*)(smem + SM_MISC + 4080);
    if (threadIdx.x == 0) { st0[0] = 0u; st0[1] = 0u; }
    __syncthreads();
  }
  const int xcd = bid & 7, xloc = bid >> 3, xnl = nblk >> 3;
  XcdBarrier xb = xcd_barrier_post(barw, (volatile LAS unsigned*)(smem + SM_MISC + 4080));
  for (int it = bid; it < NTOK / 4; it += nblk) ph_cvt_x(it, xin, XBF);
  for (int it = bid; it < 16 * 46 + 16 * 16 + 16 * 4; it += nblk) {
    if (it < 16 * 46) ph_cvt_wt(smem, it % 16, it / 16, w_in, DM, INC, WTIN);
    else if (it < 16 * 46 + 256) { const int j = it - 16 * 46; ph_cvt_wt(smem, j % 16, j / 16, w_out, DM, DM, WTOUT); }
    else { const int j = it - 16 * 46 - 256; ph_cvt_wt(smem, j % 16, j / 16, router_w, DM, NEXP, WTR); }
  }
  for (int it = bid; it < 192; it += nblk) {
    if (it < 64) ph_cvt_wt(smem, it % 16, it / 16, sw_gate, DM, EFF, WTSG);
    else if (it < 128) ph_cvt_wt(smem, (it - 64) % 16, (it - 64) / 16, sw_up, DM, EFF, WTSU);
    else ph_cvt_wt(smem, (it - 128) % 4, (it - 128) / 4, sw_down, EFF, DM, WTSD, true);
  }
  xcd_barrier(xb);
  for (int l = xloc; l < 64; l += xnl) ph_proj(smem, xcd, l, XBF, WTIN, proj, ba, VTb);
  xcd_barrier(xb);
  for (int it = bid; it < 2048; it += nblk) ph_dnchunk(smem, it, proj, ba, conv_w, a_log, dt_bias, QD, W0N, KTT, RV, TM, ATT, GL);
  for (int it = bid; it < 512; it += nblk) ph_swa(smem, it, proj, VTb, sinks, mixed);
  xcd_barrier(xb);
  if (bid < 64 || nblk <= 64) {
    for (int it = bid; it < 64; it += nblk) ph_dnscan(smem, it, QD, W0N, KTT, RV, TM, ATT, GL, obuf);
  }
  if (bid >= 64 || nblk <= 64) {
    const int tid = TIDX, lane = tid & 63, wv = tid >> 6;
    float* tile = (float*)(smem + wv * 8448);
    const int nconv = (nblk > 64) ? (nblk - 64) : nblk, cb = (nblk > 64) ? (bid - 64) : bid;
    const int step = nconv * 4, total = 256 * 384;
    int it = cb * 4 + wv;
    f32x4 vc[8], vn[8];
    CvtTile tc = cvt_decode(it < total ? it : 0, lane, w_gate, w_up, w_down, WTG, WTU, WTD);
    if (it < total) cvt_load(tc, vc);
    while (it < total) {
      const int itn = it + step;
      CvtTile tn = cvt_decode(itn < total ? itn : 0, lane, w_gate, w_up, w_down, WTG, WTU, WTD);
      if (itn < total) cvt_load(tn, vn);
      cvt_store(tile, lane, tc, vc);
#pragma unroll
      for (int i = 0; i < 8; ++i) vc[i] = vn[i];
      tc = tn; it = itn;
    }
  }
  xcd_barrier(xb);
  for (int it = bid; it < NTOK / 4; it += nblk) ph_dn_post(it, obuf, proj, dn_norm_g, mixed);
  xcd_barrier(xb);
  for (int l = xloc; l < 64; l += xnl) ph_wout(smem, xcd, l, mixed, WTOUT, xin, outp);
  xcd_barrier(xb);
  for (int it = bid; it < NTOK / 4; it += nblk) ph_ln1(it, outp, ln1_g, ln1_b, x1bf);
  xcd_barrier(xb);
  for (int i = xloc; i < 32 * 2; i += xnl) ph_router(smem, (xcd * 32 + i / 2) * 2 + i % 2, x1bf, WTR, logits);
  xcd_barrier(xb);
  for (int it = bid; it < NTOK / 4; it += nblk) ph_route(it, logits, router_bias, cnt, list, gates);
  xcd_barrier(xb);
  int* sscan = (int*)(smem + SM_MISC);
  moe_build_prefix(cnt, sscan);
  const int ntile = sscan[32 * xcd + 31] - (xcd ? sscan[32 * xcd - 1] : 0) + NTOK / 128 / 8;
  for (int it = xloc; it < ntile; it += xnl) {
    int e, rt; moe_locate(sscan, xcd, it, e, rt);
    ph_moe(smem, e, rt, x1bf, cnt, list, gates, (e < 256) ? WTG + (size_t)e * EFF * DM : WTSG, (e < 256) ? WTU + (size_t)e * EFF * DM : WTSU,
           (e < 256) ? WTD + (size_t)e * DM * EFF : WTSD, ybuf, outp);
  }
  xcd_barrier(xb);
  for (int it = bid; it < NTOK / 4; it += nblk) ph_final(it, outp, ybuf, ln2_g, ln2_b);
}

#undef xin
#undef w_in
#undef conv_w
#undef a_log
#undef dt_bias
#undef dn_norm_g
#undef sinks
#undef w_out
#undef ln1_g
#undef ln1_b
#undef router_w
#undef router_bias
#undef w_gate
#undef w_up
#undef w_down
#undef sw_gate
#undef sw_up
#undef sw_down
#undef ln2_g
#undef ln2_b
#undef outp
#undef x1bf
#undef logits
#undef list
#undef gates
#undef cnt
#undef mixed
#undef proj
#undef ba
#undef QD
#undef W0N
#undef KTT
#undef RV
#undef TM
#undef ATT
#undef GL
#undef obuf
#undef ybuf
#undef VTb
#undef XBF
#undef WTIN
#undef WTOUT
#undef WTR
#undef WTG
#undef WTU
#undef WTD
#undef WTSG
#undef WTSU
#undef WTSD
#undef barw

extern "C" void kernel_launch(void* const* d_in, const int* in_sizes, int n_in, void* d_out, int out_size, void* d_ws, size_t ws_size, hipStream_t stream) {
  static int grid_blocks = 0;
  if (!grid_blocks) {
    int dev = 0, cus = 0, per_cu = 0;
    (void)hipGetDevice(&dev);
    (void)hipDeviceGetAttribute(&cus, hipDeviceAttributeMultiprocessorCount, dev);
    (void)hipOccupancyMaxActiveBlocksPerMultiprocessor(&per_cu, mega, 256, 0);
    if (per_cu > 2) per_cu = 2;
    if (per_cu < 1) per_cu = 1;
    grid_blocks = cus * per_cu;
  }
  Params p{};
  for (int i = 0; i < 20; ++i) p.in[i] = (const float*)d_in[i];
  p.out = (float*)d_out; p.ws = (char*)d_ws;
  (void)hipMemsetAsync((char*)d_ws + WS_CTRL, 0, 4096 + XCD_BAR_WORDS * 4, stream);
  void* args[] = {&p};
  hipError_t e = hipLaunchCooperativeKernel((void*)mega, dim3(grid_blocks), dim3(256), args, 0, stream);
  if (e != hipSuccess) fprintf(stderr, "cooperative launch failed: %s (grid %d)\n", hipGetErrorString(e), grid_blocks);
}
```

```cpp
#include <hip/hip_runtime.h>
#include <hip/hip_cooperative_groups.h>
#include <stdint.h>
#include <stdio.h>
namespace cg = cooperative_groups;

typedef __attribute__((ext_vector_type(8))) short bf16x8;
typedef __attribute__((ext_vector_type(4))) float f32x4;
typedef unsigned short bf16_t;
typedef __attribute__((ext_vector_type(4))) unsigned u32x4;
typedef __attribute__((ext_vector_type(2))) unsigned u32x2;

constexpr int NTOK = 32768, SEQ = 4096, DM = 1024;
constexpr int INC = 2824, PROJW = 2816;
constexpr int OFF_DQ = 0, OFF_DK = 512, OFF_DV = 1024, OFF_SQ = 1536, OFF_SK = 2048, OFF_SV = 2176, OFF_Z = 2304;
constexpr int NEXP = 256, TOPK = 8, EFF = 256;
constexpr int NA = NTOK * TOPK;
constexpr int CAP = NTOK;
constexpr float ALPHA = 1.189207115002721f;
constexpr float LN_EPS = 1e-5f, RMS_EPS = 1e-6f, L2_EPS = 1e-6f;

constexpr size_t MiB = 1024ull * 1024ull;
constexpr size_t WS_WTD = 0;
constexpr size_t WS_WTG = 128 * MiB;
constexpr size_t WS_WTU = 256 * MiB;
constexpr size_t WS_YBUF = 384 * MiB;
constexpr size_t WS_LOGIT = 384 * MiB;
constexpr size_t WS_X1BF = 896 * MiB;
constexpr size_t WS_LIST = 960 * MiB;
constexpr size_t WS_GATES = 992 * MiB;
constexpr size_t WS_CTRL = 993 * MiB;
constexpr size_t WS_WTIN = 994 * MiB;
constexpr size_t WS_WTOUT = 1000 * MiB;
constexpr size_t WS_WTR = 1002 * MiB;
constexpr size_t WS_WTSG = 1003 * MiB;
constexpr size_t WS_WTSU = WS_WTSG + 512 * 1024;
constexpr size_t WS_WTSD = 1004 * MiB;
constexpr size_t WS_DUMMY = 1005 * MiB;
constexpr size_t WS_PROJ = 384 * MiB;
constexpr size_t WS_BA = 560 * MiB;
constexpr size_t WS_QD = 561 * MiB;
constexpr size_t WS_W0N = 593 * MiB;
constexpr size_t WS_KTT = 625 * MiB;
constexpr size_t WS_RV = 657 * MiB;
constexpr size_t WS_TM = 689 * MiB;
constexpr size_t WS_ATT = 705 * MiB;
constexpr size_t WS_GL = 721 * MiB;
constexpr size_t WS_O = 722 * MiB;
constexpr size_t WS_VT = 786 * MiB;
constexpr size_t WS_MIXED = 794 * MiB;
constexpr size_t WS_XBF = 640 * MiB;

__device__ __forceinline__ int opaque_tid() { int t = threadIdx.x; asm volatile("" : "+v"(t)); return t; }
#define TIDX opaque_tid()
typedef __attribute__((ext_vector_type(2))) __bf16 hwbf16x2;
typedef __attribute__((ext_vector_type(2))) float hwf32x2;
__device__ __forceinline__ unsigned pack2(float lo, float hi) {
  hwf32x2 f = {lo, hi};
  return __builtin_bit_cast(unsigned, __builtin_convertvector(f, hwbf16x2));
}
__device__ __forceinline__ unsigned f2bf(float f) { return pack2(f, 0.f) & 0xffffu; }
__device__ __forceinline__ float bf2f(unsigned h) { return __uint_as_float(h << 16); }
__device__ __forceinline__ float bflo(unsigned w) { return __uint_as_float(w << 16); }
__device__ __forceinline__ float bfhi(unsigned w) { return __uint_as_float(w & 0xffff0000u); }
__device__ __forceinline__ float siluf(float x) { return x / (1.f + __expf(-x)); }
__device__ __forceinline__ float sigmoidf(float x) { return 1.f / (1.f + __expf(-x)); }
__device__ __forceinline__ float wave_sum(float v) {
#pragma unroll
  for (int o = 32; o > 0; o >>= 1) v += __shfl_xor(v, o);
  return v;
}

template <int SEGDIV>
struct LdRowBF16T {
  const char* p[4]; size_t seghi, seglo; int tid16;
  template <class F> __device__ __forceinline__ void init(F rowptr, size_t hi, size_t lo = 0) {
    const int tid = TIDX; const int slot = tid & 7, row0 = tid >> 3; seghi = hi; seglo = lo; tid16 = tid * 16;
#pragma unroll
    for (int i = 0; i < 4; ++i) p[i] = (const char*)rowptr(row0 + i * 32) + ((slot ^ (row0 & 7)) << 4);
  }
  __device__ __forceinline__ void issue(int seg, int kk, unsigned char* lds) {
    const size_t off = (size_t)(seg / SEGDIV) * seghi + (size_t)(seg % SEGDIV) * seglo + (size_t)kk * 128;
#pragma unroll
    for (int i = 0; i < 4; ++i)
      __builtin_amdgcn_global_load_lds((const unsigned*)(p[i] + off), (__attribute__((address_space(3))) unsigned*)(lds + tid16 + i * 4096), 16, 0, 0);
  }
};
typedef LdRowBF16T<1> LdRowBF16;
struct LdColF32 {
  const char* p; size_t ldb, segb; f32x4 r[2][8]; int n4, kg;
  __device__ __forceinline__ void init(const float* colptr, size_t ld, size_t seg_bytes) {
    const int tid = TIDX; n4 = tid & 31; kg = tid >> 5; ldb = ld * 4; segb = seg_bytes;
    p = (const char*)colptr + (size_t)(kg * 8) * ldb;
  }
  template <int S> __device__ __forceinline__ void load(int seg, int kk) {
#pragma unroll
    for (int j = 0; j < 8; ++j) r[S][j] = *(const f32x4*)(p + (size_t)seg * segb + (size_t)(kk * 64 + j) * ldb);
  }
  template <int S> __device__ __forceinline__ void store(unsigned char* s) {
#pragma unroll
    for (int i = 0; i < 4; ++i) {
      const int row = n4 * 4 + i; u32x4 w;
      w[0] = pack2(r[S][0][i], r[S][1][i]); w[1] = pack2(r[S][2][i], r[S][3][i]); w[2] = pack2(r[S][4][i], r[S][5][i]); w[3] = pack2(r[S][6][i], r[S][7][i]);
      *(u32x4*)(s + row * 128 + ((kg ^ (row & 7)) << 4)) = w;
    }
  }
};

__device__ __forceinline__ void gemm_kstep(const unsigned char* sA, const unsigned char* sB, f32x4 (&acc)[4][4], int wr, int wc, int fr, int fq) {
#pragma unroll
  for (int ks = 0; ks < 2; ++ks) {
    bf16x8 a[4], b[4];
#pragma unroll
    for (int m = 0; m < 4; ++m) {
      const int row = wr * 64 + m * 16 + fr;
      a[m] = *(const bf16x8*)(sA + row * 128 + (((ks * 4 + fq) ^ (row & 7)) << 4));
    }
#pragma unroll
    for (int n = 0; n < 4; ++n) {
      const int row = wc * 64 + n * 16 + fr;
      b[n] = *(const bf16x8*)(sB + row * 128 + (((ks * 4 + fq) ^ (row & 7)) << 4));
    }
#pragma unroll
    for (int m = 0; m < 4; ++m)
#pragma unroll
      for (int n = 0; n < 4; ++n) acc[m][n] = __builtin_amdgcn_mfma_f32_16x16x32_bf16(b[n], a[m], acc[m][n], 0, 0, 0);
  }
}
template <int KPER, class AL, class BL, class Epi>
__device__ __forceinline__ void gemm_stream(unsigned char* smem, AL& al, BL& bl, int nseg, Epi epi) {
  const int tid = TIDX, lane = tid & 63, wid = tid >> 6, wr = wid >> 1, wc = wid & 1, fr = lane & 15, fq = lane >> 4;
  const int total = nseg * KPER;
  f32x4 acc[4][4];
  al.issue(0, 0, smem); bl.issue(0, 0, smem + 16384);
  asm volatile("s_waitcnt vmcnt(0)" ::: "memory");
  __syncthreads();
  for (int j = 0; j < total; ++j) {
    unsigned char* cur = smem + (j & 1) * 32768; unsigned char* nxt = smem + ((j & 1) ^ 1) * 32768;
    if (j + 1 < total) { al.issue((j + 1) / KPER, (j + 1) % KPER, nxt); bl.issue((j + 1) / KPER, (j + 1) % KPER, nxt + 16384); }
    if (j % KPER == 0) {
#pragma unroll
      for (int m = 0; m < 4; ++m)
#pragma unroll
        for (int n = 0; n < 4; ++n) acc[m][n] = (f32x4){0.f, 0.f, 0.f, 0.f};
    }
    gemm_kstep(cur, cur + 16384, acc, wr, wc, fr, fq);
    asm volatile("s_waitcnt vmcnt(0)" ::: "memory");
    __syncthreads();
    if ((j + 1) % KPER == 0) epi((j + 1) / KPER - 1, acc);
  }
}

#define GEMM_IDS const int tid = TIDX, lane = tid & 63, wid = tid >> 6, wr = wid >> 1, wc = wid & 1, fr = lane & 15, fq = lane >> 4; (void)tid; (void)lane;

struct Params {
  const float* in[20];
  float* out;
  char* ws;
};

constexpr int SMEM_BYTES = 69632;
constexpr int SM_MISC = 65536;

__device__ __forceinline__ void ph_cvt_x(int item, const float* __restrict__ x, bf16_t* __restrict__ xbf) {
  const int tid = TIDX;
  const size_t base = (size_t)item * 4096 + (size_t)tid * 4;
#pragma unroll
  for (int i = 0; i < 4; ++i) {
    const f32x4 v = *(const f32x4*)(x + base + (size_t)i * 1024);
    u32x2 w; w[0] = pack2(v[0], v[1]); w[1] = pack2(v[2], v[3]);
    *(u32x2*)(xbf + base + (size_t)i * 1024) = w;
  }
}
__device__ __forceinline__ void ph_cvt_wt(unsigned char* smem, int kt, int nt, const float* __restrict__ W, int K, int N, bf16_t* __restrict__ WT, bool perm = false) {
  float* tile = (float*)smem;
  const int tid = TIDX;
  const int k0 = kt * 64, n0 = nt * 64;
  __syncthreads();
#pragma unroll
  for (int i = 0; i < 4; ++i) {
    const int k = (tid >> 4) + 16 * i, n = 4 * (tid & 15);
    f32x4 v = (f32x4){0.f, 0.f, 0.f, 0.f};
    if (n0 + n < N) v = *(const f32x4*)(W + (size_t)(k0 + k) * N + n0 + n);
    tile[k * 65 + n + 0] = v[0]; tile[k * 65 + n + 1] = v[1]; tile[k * 65 + n + 2] = v[2]; tile[k * 65 + n + 3] = v[3];
  }
  __syncthreads();
  const int n = tid >> 2, kq = tid & 3;
  u32x4 w0, w1;
#pragma unroll
  for (int j = 0; j < 4; ++j) {
    w0[j] = pack2(tile[(kq * 16 + 2 * j) * 65 + n], tile[(kq * 16 + 2 * j + 1) * 65 + n]);
    w1[j] = pack2(tile[(kq * 16 + 8 + 2 * j) * 65 + n], tile[(kq * 16 + 8 + 2 * j + 1) * 65 + n]);
  }
  if (!perm) {
    bf16_t* dst = WT + (size_t)(n0 + n) * K + k0 + kq * 16;
    *(u32x4*)dst = w0; *(u32x4*)(dst + 8) = w1;
  } else {
    const int blk = kq >> 1, hi = kq & 1;
    bf16_t* dst = WT + (size_t)(n0 + n) * K + k0 + blk * 32 + 4 * hi;
    u32x2 a; a[0] = w0[0]; a[1] = w0[1]; *(u32x2*)(dst + 0) = a;
    a[0] = w0[2]; a[1] = w0[3]; *(u32x2*)(dst + 8) = a;
    a[0] = w1[0]; a[1] = w1[1]; *(u32x2*)(dst + 16) = a;
    a[0] = w1[2]; a[1] = w1[3]; *(u32x2*)(dst + 24) = a;
  }
}

struct CvtTile { const float* src; bf16_t* dst; int ldn; int perm; };
__device__ __forceinline__ CvtTile cvt_decode(int it, int lane, const float* __restrict__ w_gate, const float* __restrict__ w_up, const float* __restrict__ w_down,
                                              bf16_t* __restrict__ wtg, bf16_t* __restrict__ wtu, bf16_t* __restrict__ wtd) {
  const int e = it / 384, j = it % 384;
  const float* W; bf16_t* WT; int K, N, kt, nt;
  if (j < 128) { W = w_gate + (size_t)e * DM * EFF; WT = wtg + (size_t)e * EFF * DM; K = DM; N = EFF; kt = j & 31; nt = j >> 5; }
  else if (j < 256) { W = w_up + (size_t)e * DM * EFF; WT = wtu + (size_t)e * EFF * DM; K = DM; N = EFF; kt = (j - 128) & 31; nt = (j - 128) >> 5; }
  else { W = w_down + (size_t)e * EFF * DM; WT = wtd + (size_t)e * DM * EFF; K = EFF; N = DM; kt = (j - 256) & 7; nt = (j - 256) >> 3; }
  CvtTile t;
  t.src = W + (size_t)(kt * 32 + (lane >> 4)) * N + nt * 64 + 4 * (lane & 15);
  t.dst = WT + (size_t)(nt * 64 + lane) * K + kt * 32;
  t.ldn = 4 * N;
  t.perm = (j >= 256) ? 1 : 0;
  return t;
}
__device__ __forceinline__ void cvt_load(const CvtTile& t, f32x4 (&v)[8]) {
#pragma unroll
  for (int i = 0; i < 8; ++i) v[i] = *(const f32x4*)(t.src + (size_t)i * t.ldn);
}
__device__ __forceinline__ void cvt_store(float* tile  , int lane, const CvtTile& t, const f32x4 (&v)[8]) {
#pragma unroll
  for (int i = 0; i < 8; ++i) {
    float* p = tile + ((lane >> 4) + 4 * i) * 65 + 4 * (lane & 15);
    p[0] = v[i][0]; p[1] = v[i][1]; p[2] = v[i][2]; p[3] = v[i][3];
  }
  u32x4 w[4];
  if (t.perm) {
#pragma unroll
    for (int q = 0; q < 4; ++q) {
      w[q][0] = pack2(tile[(4 * q + 0) * 65 + lane], tile[(4 * q + 1) * 65 + lane]);
      w[q][1] = pack2(tile[(4 * q + 2) * 65 + lane], tile[(4 * q + 3) * 65 + lane]);
      w[q][2] = pack2(tile[(16 + 4 * q + 0) * 65 + lane], tile[(16 + 4 * q + 1) * 65 + lane]);
      w[q][3] = pack2(tile[(16 + 4 * q + 2) * 65 + lane], tile[(16 + 4 * q + 3) * 65 + lane]);
    }
  } else {
#pragma unroll
    for (int q = 0; q < 4; ++q)
#pragma unroll
      for (int j = 0; j < 4; ++j) w[q][j] = pack2(tile[(8 * q + 2 * j) * 65 + lane], tile[(8 * q + 2 * j + 1) * 65 + lane]);
  }
#pragma unroll
  for (int q = 0; q < 4; ++q) *(u32x4*)(t.dst + 8 * q) = w[q];
}

__device__ __forceinline__ void ph_proj(unsigned char* smem, int xcd, int l, const bf16_t* __restrict__ xbf, const bf16_t* __restrict__ wt, bf16_t* __restrict__ proj, float* __restrict__ ba, bf16_t* __restrict__ vt) {
  const int mi = l >> 3, ni = l & 7;
  LdRowBF16T<3> al; al.init([&](int r) { return xbf + (size_t)((xcd * 32 + mi) * 128 + r) * DM; }, (size_t)8 * 128 * DM * 2, 0);
  LdRowBF16T<3> bl; bl.init([&](int r) { return wt + (size_t)(ni * 128 + r) * DM; }, 0, (size_t)8 * 128 * DM * 2);
  gemm_stream<16>(smem, al, bl, 12, [&](int seg, f32x4 (&acc)[4][4]) {
    GEMM_IDS
    const int nt = (seg % 3) * 8 + ni;
    if (nt < 23) {
      const int m0 = (xcd * 32 + (seg / 3) * 8 + mi) * 128, n0 = nt * 128;
#pragma unroll
      for (int m = 0; m < 4; ++m)
#pragma unroll
        for (int n = 0; n < 4; ++n) {
          const int row = m0 + wr * 64 + m * 16 + fr, col = n0 + wc * 64 + n * 16 + fq * 4;
          if (col < PROJW) {
            u32x2 w; w[0] = pack2(acc[m][n][0], acc[m][n][1]); w[1] = pack2(acc[m][n][2], acc[m][n][3]);
            *(u32x2*)(proj + (size_t)row * PROJW + col) = w;
          } else if (col < INC) {
            *(f32x4*)(ba + (size_t)row * 8 + (col - PROJW)) = acc[m][n];
          }
        }
      if (n0 == OFF_SV) {
#pragma unroll
        for (int m = 0; m < 4; ++m)
#pragma unroll
          for (int n = 0; n < 4; ++n) {
            const int row = m0 + wr * 64 + m * 16 + fr, c = wc * 64 + n * 16 + fq * 4;
            const int bb = row / SEQ, t = row % SEQ;
#pragma unroll
            for (int r = 0; r < 4; ++r) vt[((size_t)(bb * 128 + c + r)) * SEQ + t] = (bf16_t)f2bf(acc[m][n][r]);
          }
      }
    }
  });
}

__device__ __forceinline__ bf16x8 pack8(f32x4 a, f32x4 b) {
  union { bf16x8 v; unsigned u[4]; } x;
  x.u[0] = pack2(a[0], a[1]); x.u[1] = pack2(a[2], a[3]); x.u[2] = pack2(b[0], b[1]); x.u[3] = pack2(b[2], b[3]);
  return x.v;
}
__device__ __forceinline__ void ph_dnchunk(unsigned char* smem, int item, const bf16_t* __restrict__ proj, const float* __restrict__ ba, const float* __restrict__ conv_w,
                                           const float* __restrict__ a_log, const float* __restrict__ dt_bias,
                                           bf16_t* __restrict__ QD, bf16_t* __restrict__ W0N, bf16_t* __restrict__ KTT, bf16_t* __restrict__ RV,
                                           bf16_t* __restrict__ TM, bf16_t* __restrict__ ATT, float* __restrict__ GL) {
  const int tid = TIDX, lane = tid & 63, w = tid >> 6, fr = lane & 15, fq = lane >> 4;
  const int n = item & 63, h = (item >> 6) & 3, b = item >> 8;
  const int t0 = n * 64; const size_t row0 = (size_t)b * SEQ + t0;
  unsigned char* qs = smem; unsigned char* ks = smem + 16384; float* AT = (float*)(smem + 32768);
  const float scale = 0.08838834764831845f;
  float bL, gcL;
  {
    const float* bap = ba + (row0 + lane) * 8;
    bL = sigmoidf(bap[h]);
    const float xx = bap[4 + h] + dt_bias[h];
    const float sp = fmaxf(xx, 0.f) + log1pf(__expf(-fabsf(xx)));
    float gg = -__expf(a_log[h]) * sp;
#pragma unroll
    for (int o = 1; o < 64; o <<= 1) { const float v = __shfl_up(gg, o); if (lane >= o) gg += v; }
    gcL = gg;
  }
  {
    const int d = 2 * lane;
    float cw[3][4][2];
#pragma unroll
    for (int mx = 0; mx < 3; ++mx)
#pragma unroll
      for (int j = 0; j < 4; ++j) {
        const float2 c2 = *(const float2*)(conv_w + j * 1536 + mx * 512 + h * 128 + d);
        cw[mx][j][0] = c2.x; cw[mx][j][1] = c2.y;
      }
    const bf16_t* pbase = proj + (row0 + 16 * w) * PROJW + h * 128 + d;
    unsigned raw[3][19];
#pragma unroll
    for (int j = 0; j < 19; ++j) {
      const bool ok = (t0 + 16 * w - 3 + j) >= 0;
#pragma unroll
      for (int mx = 0; mx < 3; ++mx) {
        unsigned u = 0;
        if (ok) u = *(const unsigned*)(pbase + (ptrdiff_t)(j - 3) * PROJW + mx * 512);
        raw[mx][j] = u;
      }
    }
#pragma unroll
    for (int i = 0; i < 16; ++i) {
      float s[3][2];
#pragma unroll
      for (int mx = 0; mx < 3; ++mx) {
        float y0 = 0.f, y1 = 0.f;
#pragma unroll
        for (int j = 0; j < 4; ++j) { y0 += cw[mx][j][0] * bflo(raw[mx][i + j]); y1 += cw[mx][j][1] * bfhi(raw[mx][i + j]); }
        s[mx][0] = siluf(y0); s[mx][1] = siluf(y1);
      }
      const int row = 16 * w + i;
      const float rq = rsqrtf(wave_sum(s[0][0] * s[0][0] + s[0][1] * s[0][1]) + L2_EPS);
      const float rk = rsqrtf(wave_sum(s[1][0] * s[1][0] + s[1][1] * s[1][1]) + L2_EPS);
      const int off = row * 256 + ((((lane >> 2) ^ (row & 15))) << 4) + (lane & 3) * 4;
      *(unsigned*)(qs + off) = pack2(s[0][0] * rq, s[0][1] * rq);
      *(unsigned*)(ks + off) = pack2(s[1][0] * rk, s[1][1] * rk);
      const float bi = __shfl(bL, row);
      *(unsigned*)(RV + ((size_t)item * 64 + row) * 128 + d) = pack2(bi * s[2][0], bi * s[2][1]);
    }
  }
  __syncthreads();
  {
    f32x4 aKK[4], aQK[4];
#pragma unroll
    for (int nt = 0; nt < 4; ++nt) { aKK[nt] = (f32x4){0.f, 0.f, 0.f, 0.f}; aQK[nt] = (f32x4){0.f, 0.f, 0.f, 0.f}; }
#pragma unroll
    for (int k4 = 0; k4 < 4; ++k4) {
      const int arow = 16 * w + fr;
      const bf16x8 aq = *(const bf16x8*)(qs + arow * 256 + ((((k4 * 4 + fq) ^ (arow & 15))) << 4));
      const bf16x8 ak = *(const bf16x8*)(ks + arow * 256 + ((((k4 * 4 + fq) ^ (arow & 15))) << 4));
#pragma unroll
      for (int nt = 0; nt < 4; ++nt) {
        const int brow = 16 * nt + fr;
        const bf16x8 bk = *(const bf16x8*)(ks + brow * 256 + ((((k4 * 4 + fq) ^ (brow & 15))) << 4));
        aKK[nt] = __builtin_amdgcn_mfma_f32_16x16x32_bf16(ak, bk, aKK[nt], 0, 0, 0);
        aQK[nt] = __builtin_amdgcn_mfma_f32_16x16x32_bf16(bk, aq, aQK[nt], 0, 0, 0);
      }
    }
    float gci[4], bi[4];
#pragma unroll
    for (int r = 0; r < 4; ++r) { gci[r] = __shfl(gcL, 16 * w + 4 * fq + r); bi[r] = __shfl(bL, 16 * w + 4 * fq + r); }
    const float gci2 = __shfl(gcL, 16 * w + fr);
#pragma unroll
    for (int nt = 0; nt < 4; ++nt) {
      const int j = 16 * nt + fr;
      const float gcj = __shfl(gcL, j);
      float av[4], at[4];
#pragma unroll
      for (int r = 0; r < 4; ++r) {
        const int i = 16 * w + 4 * fq + r;
        const float dec = (j <= i) ? __expf(gci[r] - gcj) : 0.f;
        av[r] = (j < i) ? bi[r] * aKK[nt][r] * dec : 0.f;
        const int i2 = 16 * w + fr, j2 = 16 * nt + 4 * fq + r;
        const float gcj2 = __shfl(gcL, j2);
        const float dec2 = (j2 <= i2) ? __expf(gci2 - gcj2) : 0.f;
        at[r] = aQK[nt][r] * scale * dec2;
      }
      *(float4*)(AT + j * 68 + 16 * w + 4 * fq) = make_float4(av[0], av[1], av[2], av[3]);
      u32x2 wv; wv[0] = pack2(at[0], at[1]); wv[1] = pack2(at[2], at[3]);
      *(u32x2*)(ATT + ((size_t)item * 64 + 16 * w + fr) * 64 + 32 * (nt >> 1) + 8 * fq + 4 * (nt & 1)) = wv;
    }
  }
  __syncthreads();
  if (w == 0) {
    float Tr[64];
    int ln = lane; asm volatile("" : "+v"(ln));
#pragma unroll
    for (int j = 0; j < 64; ++j) Tr[j] = 0.f;
    f32x4 cur[16], nxt[16];
#pragma unroll
    for (int j4 = 0; j4 < 16; ++j4) nxt[j4] = (f32x4){0.f, 0.f, 0.f, 0.f};
#pragma unroll
    for (int j4 = 15; j4 >= 16; --j4) cur[j4] = *(const f32x4*)(AT + 63 * 68 + j4 * 4);
#pragma unroll
    for (int c = 63; c >= 0; --c) {
      if (c > 0) {
#pragma unroll
        for (int j4 = 15; j4 >= c / 4; --j4) nxt[j4] = *(const f32x4*)(AT + (c - 1) * 68 + j4 * 4);
      }
      float a0 = 0.f, a1 = 0.f, a2 = 0.f, a3 = 0.f;
#pragma unroll
      for (int j4 = 15; j4 >= (c + 1) / 4; --j4) {
        asm volatile("v_fmac_f32 %0, %1, %2" : "+v"(a0) : "v"(Tr[4 * j4 + 0]), "v"(cur[j4][0]));
        asm volatile("v_fmac_f32 %0, %1, %2" : "+v"(a1) : "v"(Tr[4 * j4 + 1]), "v"(cur[j4][1]));
        asm volatile("v_fmac_f32 %0, %1, %2" : "+v"(a2) : "v"(Tr[4 * j4 + 2]), "v"(cur[j4][2]));
        asm volatile("v_fmac_f32 %0, %1, %2" : "+v"(a3) : "v"(Tr[4 * j4 + 3]), "v"(cur[j4][3]));
      }
      Tr[c] = ((ln == c) ? 1.f : 0.f) - ((a0 + a1) + (a2 + a3));
#pragma unroll
      for (int j4 = 0; j4 < 16; ++j4) cur[j4] = nxt[j4];
    }
    u32x4* tp = (u32x4*)(TM + ((size_t)item * 64 + lane) * 64);
#pragma unroll
    for (int oc = 0; oc < 8; ++oc) {
      const int k0 = 32 * (oc >> 2) + 4 * (oc & 3);
      u32x4 v;
      v[0] = pack2(Tr[k0 + 0], Tr[k0 + 1]); v[1] = pack2(Tr[k0 + 2], Tr[k0 + 3]);
      v[2] = pack2(Tr[k0 + 16], Tr[k0 + 17]); v[3] = pack2(Tr[k0 + 18], Tr[k0 + 19]);
      tp[oc] = v;
    }
  } else {
    const float gclast = __shfl(gcL, 63);
    if (tid == 64) GL[item] = __expf(gclast);
#pragma unroll 1
    for (int it = 0; it < 16; ++it) {
      const int idx = (tid - 64) + it * 192;
      const int mtx = idx >> 10, rem = idx & 1023;
      if (mtx < 2) {
        const int i = rem >> 4, oc = rem & 15;
        const float gi = __shfl(gcL, i), bi = __shfl(bL, i);
        const float f = (mtx == 0) ? scale * __expf(gi) : -bi * __expf(gi);
        const unsigned char* st = (mtx == 0) ? qs : ks;
        const int d0 = 32 * (oc >> 2) + 4 * (oc & 3);
        const uint2 lo = *(const uint2*)(st + i * 256 + ((((d0 >> 3) ^ (i & 15))) << 4) + (d0 & 7) * 2);
        const uint2 hi = *(const uint2*)(st + i * 256 + (((((d0 + 16) >> 3) ^ (i & 15))) << 4) + (d0 & 7) * 2);
        u32x4 v;
        v[0] = pack2(bflo(lo.x) * f, bfhi(lo.x) * f); v[1] = pack2(bflo(lo.y) * f, bfhi(lo.y) * f);
        v[2] = pack2(bflo(hi.x) * f, bfhi(hi.x) * f); v[3] = pack2(bflo(hi.y) * f, bfhi(hi.y) * f);
        bf16_t* dst = ((mtx == 0) ? QD : W0N) + ((size_t)item * 64 + i) * 128 + 8 * oc;
        *(u32x4*)dst = v;
      } else {
        const int d = rem & 127, oc = rem >> 7;
        const int j0 = 32 * (oc >> 2) + 4 * (oc & 3);
        float val[8];
#pragma unroll
        for (int e = 0; e < 8; ++e) {
          const int j = j0 + (e & 3) + ((e >> 2) << 4);
          const float f = __expf(gclast - __shfl(gcL, j));
          const unsigned short raw = *(const unsigned short*)(ks + j * 256 + ((((d >> 3) ^ (j & 15))) << 4) + (d & 7) * 2);
          val[e] = bf2f(raw) * f;
        }
        u32x4 v;
        v[0] = pack2(val[0], val[1]); v[1] = pack2(val[2], val[3]); v[2] = pack2(val[4], val[5]); v[3] = pack2(val[6], val[7]);
        *(u32x4*)(KTT + ((size_t)item * 128 + d) * 64 + 8 * oc) = v;
      }
    }
  }
  __syncthreads();
}

__device__ __forceinline__ void ph_dnscan(unsigned char* smem, int item, const bf16_t* __restrict__ QDp, const bf16_t* __restrict__ W0Np, const bf16_t* __restrict__ KTTp,
                                          const bf16_t* __restrict__ RVp, const bf16_t* __restrict__ TMp, const bf16_t* __restrict__ ATTp, const float* __restrict__ GLp,
                                          float* __restrict__ op) {
  const int tid = TIDX, lane = tid & 63, w = tid >> 6, fr = lane & 15, fq = lane >> 4;
  const int bh = item >> 1, half = item & 1, b = bh >> 2, h = bh & 3;
  const int vcol0 = (half * 4 + w) * 16;
  unsigned char* sW0 = smem; unsigned char* sQD = smem + 16384; unsigned char* sKT = smem + 32768; unsigned char* sT = smem + 49152; unsigned char* sAT = smem + 57344;
  f32x4 S[8];
#pragma unroll
  for (int t = 0; t < 8; ++t) S[t] = (f32x4){0.f, 0.f, 0.f, 0.f};
  u32x4 pfA[8], pfB[8]; unsigned short rvp[16];
#define DN_LOAD_A(nn_) do { \
    const size_t ci = (size_t)bh * 64 + (nn_); \
    _Pragma("unroll") for (int i = 0; i < 4; ++i) pfA[i] = *(const u32x4*)((const char*)W0Np + ci * 16384 + (size_t)(tid + 256 * i) * 16); \
    _Pragma("unroll") for (int i = 0; i < 4; ++i) pfA[4 + i] = *(const u32x4*)((const char*)QDp + ci * 16384 + (size_t)(tid + 256 * i) * 16); \
    _Pragma("unroll") for (int mt = 0; mt < 4; ++mt) \
      _Pragma("unroll") for (int r = 0; r < 4; ++r) rvp[mt * 4 + r] = RVp[(ci * 64 + 16 * mt + 4 * fq + r) * 128 + vcol0 + fr]; \
  } while (0)
#define DN_STORE_A() do { \
    _Pragma("unroll") for (int i = 0; i < 4; ++i) { const int q = tid + 256 * i, row = q >> 4, ch = q & 15; *(u32x4*)(sW0 + row * 256 + ((ch ^ (row & 15)) << 4)) = pfA[i]; } \
    _Pragma("unroll") for (int i = 0; i < 4; ++i) { const int q = tid + 256 * i, row = q >> 4, ch = q & 15; *(u32x4*)(sQD + row * 256 + ((ch ^ (row & 15)) << 4)) = pfA[4 + i]; } \
  } while (0)
#define DN_LOAD_B(nn_) do { \
    const size_t ci = (size_t)bh * 64 + (nn_); \
    _Pragma("unroll") for (int i = 0; i < 4; ++i) pfB[i] = *(const u32x4*)((const char*)KTTp + ci * 16384 + (size_t)(tid + 256 * i) * 16); \
    _Pragma("unroll") for (int i = 0; i < 2; ++i) pfB[4 + i] = *(const u32x4*)((const char*)TMp + ci * 8192 + (size_t)(tid + 256 * i) * 16); \
    _Pragma("unroll") for (int i = 0; i < 2; ++i) pfB[6 + i] = *(const u32x4*)((const char*)ATTp + ci * 8192 + (size_t)(tid + 256 * i) * 16); \
  } while (0)
#define DN_STORE_B() do { \
    _Pragma("unroll") for (int i = 0; i < 4; ++i) { const int q = tid + 256 * i, row = q >> 3, ch = q & 7; *(u32x4*)(sKT + row * 128 + ((ch ^ (row & 7)) << 4)) = pfB[i]; } \
    _Pragma("unroll") for (int i = 0; i < 2; ++i) { const int q = tid + 256 * i, row = q >> 3, ch = q & 7; *(u32x4*)(sT + row * 128 + ((ch ^ (row & 7)) << 4)) = pfB[4 + i]; } \
    _Pragma("unroll") for (int i = 0; i < 2; ++i) { const int q = tid + 256 * i, row = q >> 3, ch = q & 7; *(u32x4*)(sAT + row * 128 + ((ch ^ (row & 7)) << 4)) = pfB[6 + i]; } \
  } while (0)
#define DN_ZINIT() do { _Pragma("unroll") for (int mt = 0; mt < 4; ++mt) Z[mt] = (f32x4){bf2f(rvp[mt * 4 + 0]), bf2f(rvp[mt * 4 + 1]), bf2f(rvp[mt * 4 + 2]), bf2f(rvp[mt * 4 + 3])}; } while (0)
  __syncthreads();
  f32x4 Z[4];
  DN_LOAD_A(0);
  DN_LOAD_B(0);
  DN_STORE_A();
  DN_ZINIT();
  DN_LOAD_A(1);
  for (int nn = 0; nn < 64; ++nn) {
    const float gl = GLp[(size_t)bh * 64 + nn];
    __syncthreads();
    bf16x8 Sb[4];
#pragma unroll
    for (int k4 = 0; k4 < 4; ++k4) Sb[k4] = pack8(S[2 * k4], S[2 * k4 + 1]);
    f32x4 O[4];
#pragma unroll
    for (int mt = 0; mt < 4; ++mt) {
      O[mt] = (f32x4){0.f, 0.f, 0.f, 0.f};
      const int row = 16 * mt + fr;
#pragma unroll
      for (int k4 = 0; k4 < 4; ++k4) {
        const int off = row * 256 + ((((k4 * 4 + fq) ^ fr)) << 4);
        const bf16x8 aw = *(const bf16x8*)(sW0 + off);
        const bf16x8 aq = *(const bf16x8*)(sQD + off);
        Z[mt] = __builtin_amdgcn_mfma_f32_16x16x32_bf16(aw, Sb[k4], Z[mt], 0, 0, 0);
        O[mt] = __builtin_amdgcn_mfma_f32_16x16x32_bf16(Sb[k4], aq, O[mt], 0, 0, 0);
      }
    }
    bf16x8 Zb[2];
    Zb[0] = pack8(Z[0], Z[1]); Zb[1] = pack8(Z[2], Z[3]);
    DN_STORE_B();
    if (nn + 1 < 64) DN_LOAD_B(nn + 1);
    __syncthreads();
    f32x4 Vn[4];
#pragma unroll
    for (int mt = 0; mt < 4; ++mt) {
      Vn[mt] = (f32x4){0.f, 0.f, 0.f, 0.f};
      const int row = 16 * mt + fr;
#pragma unroll
      for (int s = 0; s < 2; ++s) {
        if (s <= (mt >> 1)) {
          const bf16x8 at = *(const bf16x8*)(sT + row * 128 + ((((s * 4 + fq) ^ (row & 7))) << 4));
          Vn[mt] = __builtin_amdgcn_mfma_f32_16x16x32_bf16(at, Zb[s], Vn[mt], 0, 0, 0);
        }
      }
    }
    bf16x8 Vb[2];
    Vb[0] = pack8(Vn[0], Vn[1]); Vb[1] = pack8(Vn[2], Vn[3]);
#pragma unroll
    for (int mt = 0; mt < 4; ++mt) {
      const int row = 16 * mt + fr;
#pragma unroll
      for (int s = 0; s < 2; ++s) {
        if (s <= (mt >> 1)) {
          const bf16x8 aa = *(const bf16x8*)(sAT + row * 128 + ((((s * 4 + fq) ^ (row & 7))) << 4));
          O[mt] = __builtin_amdgcn_mfma_f32_16x16x32_bf16(Vb[s], aa, O[mt], 0, 0, 0);
        }
      }
      *(f32x4*)(op + ((size_t)b * SEQ + nn * 64 + 16 * mt + fr) * 512 + h * 128 + vcol0 + 4 * fq) = O[mt];
    }
#pragma unroll
    for (int t = 0; t < 8; ++t) {
      S[t] = S[t] * gl;
      const int row = 16 * t + fr;
#pragma unroll
      for (int s = 0; s < 2; ++s) {
        const bf16x8 ak = *(const bf16x8*)(sKT + row * 128 + ((((s * 4 + fq) ^ (row & 7))) << 4));
        S[t] = __builtin_amdgcn_mfma_f32_16x16x32_bf16(ak, Vb[s], S[t], 0, 0, 0);
      }
    }
    if (nn + 1 < 64) {
      DN_STORE_A();
      DN_ZINIT();
      if (nn + 2 < 64) DN_LOAD_A(nn + 2);
    }
  }
  __syncthreads();
#undef DN_ZINIT
#undef DN_LOAD_A
#undef DN_STORE_A
#undef DN_LOAD_B
#undef DN_STORE_B
}

__device__ __forceinline__ void ph_dn_post(int item, const float* __restrict__ o, const bf16_t* __restrict__ proj, const float* __restrict__ dn_norm_g, bf16_t* __restrict__ mixed) {
  const int tid = TIDX, h = tid >> 6, lane = tid & 63;
  const float2 g2 = *(const float2*)(dn_norm_g + 2 * lane);
  float2 ov[4]; unsigned zv[4];
#pragma unroll
  for (int i = 0; i < 4; ++i) {
    const size_t n = (size_t)item * 4 + i;
    ov[i] = *(const float2*)(o + n * 512 + h * 128 + 2 * lane);
    zv[i] = *(const unsigned*)(proj + n * PROJW + OFF_Z + h * 128 + 2 * lane);
  }
#pragma unroll
  for (int i = 0; i < 4; ++i) {
    const size_t n = (size_t)item * 4 + i;
    const float ss = wave_sum(ov[i].x * ov[i].x + ov[i].y * ov[i].y);
    const float rn = rsqrtf(ss * (1.f / 128.f) + RMS_EPS);
    *(unsigned*)(mixed + n * DM + h * 128 + 2 * lane) = pack2(ov[i].x * rn * g2.x * siluf(bflo(zv[i])), ov[i].y * rn * g2.y * siluf(bfhi(zv[i])));
  }
}

__device__ __forceinline__ void ph_swa(unsigned char* smem, int item, const bf16_t* __restrict__ proj, const bf16_t* __restrict__ vt, const float* __restrict__ sinks, bf16_t* __restrict__ mixed) {
  const int tid = TIDX, lane = tid & 63, w = tid >> 6, fr = lane & 15, fq = lane >> 4;
  const int qb = item & 31, kvh = (item >> 5) & 1, b = item >> 6;
  const int t0 = qb * 128;
  const size_t rowb = (size_t)b * SEQ;
  unsigned char* sK = smem;
  unsigned char* sV = smem + 32768;
  __syncthreads();
#pragma unroll
  for (int i = 0; i < 8; ++i) {
    const int q = tid + 256 * i, row = q >> 3, ch = q & 7;
    const int pos = t0 - 128 + row;
    u32x4 v = (u32x4){0u, 0u, 0u, 0u};
    if (pos >= 0) v = *(const u32x4*)(proj + (rowb + pos) * PROJW + OFF_SK + kvh * 64 + ch * 8);
    *(u32x4*)(sK + row * 128 + ((ch ^ (row & 7)) << 4)) = v;
  }
#pragma unroll
  for (int i = 0; i < 8; ++i) {
    const int q = tid + 256 * i, row = q >> 5, ch = q & 31;
    const int pos = t0 - 128 + ch * 8;
    u32x4 v = (u32x4){0u, 0u, 0u, 0u};
    if (pos >= 0) v = *(const u32x4*)(vt + ((size_t)(b * 128 + kvh * 64 + row)) * SEQ + pos);
    *(u32x4*)(sV + row * 512 + ((ch ^ (row & 15)) << 4)) = v;
  }
  __syncthreads();
  const int head = kvh * 4 + w;
  const float slope = exp2f(-(float)(head + 1));
  const float sink = sinks[head];
  const bf16_t* qp0 = proj + (rowb + t0 + fr) * PROJW + OFF_SQ + head * 64 + fq * 8;
  bf16x8 qn0 = *(const bf16x8*)(qp0), qn1 = *(const bf16x8*)(qp0 + 32);
#pragma unroll 1
  for (int qt = 0; qt < 8; ++qt) {
    const bf16x8 qf0 = qn0, qf1 = qn1;
    if (qt < 7) { const bf16_t* qp = qp0 + (size_t)(qt + 1) * 16 * PROJW; qn0 = *(const bf16x8*)(qp); qn1 = *(const bf16x8*)(qp + 32); }
    const int kp0 = qt >> 1;
    f32x4 st[10];
#pragma unroll
    for (int kt = 0; kt < 10; ++kt) {
      const int krow = (2 * kp0 + kt) * 16 + fr;
      st[kt] = (f32x4){0.f, 0.f, 0.f, 0.f};
      const bf16x8 k0 = *(const bf16x8*)(sK + krow * 128 + (((0 + fq) ^ (krow & 7)) << 4));
      const bf16x8 k1 = *(const bf16x8*)(sK + krow * 128 + (((4 + fq) ^ (krow & 7)) << 4));
      st[kt] = __builtin_amdgcn_mfma_f32_16x16x32_bf16(k0, qf0, st[kt], 0, 0, 0);
      st[kt] = __builtin_amdgcn_mfma_f32_16x16x32_bf16(k1, qf1, st[kt], 0, 0, 0);
    }
    const int i = qt * 16 + fr;
    float mx = sink;
#pragma unroll
    for (int kt = 0; kt < 10; ++kt)
#pragma unroll
      for (int r = 0; r < 4; ++r) {
        const int jb = (2 * kp0 + kt) * 16 + 4 * fq + r;
        const int dist = 128 + i - jb;
        const bool ok = (dist >= 0) && (dist < 128) && (t0 - 128 + jb >= 0);
        const float s = ok ? (st[kt][r] * 0.125f - slope * (float)dist) : -INFINITY;
        st[kt][r] = s;
        mx = fmaxf(mx, s);
      }
    mx = fmaxf(mx, __shfl_xor(mx, 16));
    mx = fmaxf(mx, __shfl_xor(mx, 32));
    float sum = 0.f;
#pragma unroll
    for (int kt = 0; kt < 10; ++kt)
#pragma unroll
      for (int r = 0; r < 4; ++r) { const float p = __expf(st[kt][r] - mx); st[kt][r] = p; sum += p; }
    sum += __shfl_xor(sum, 16);
    sum += __shfl_xor(sum, 32);
    const float inv = 1.f / (sum + __expf(sink - mx));
    f32x4 O[4];
#pragma unroll
    for (int nt = 0; nt < 4; ++nt) O[nt] = (f32x4){0.f, 0.f, 0.f, 0.f};
#pragma unroll
    for (int s5 = 0; s5 < 5; ++s5) {
      const bf16x8 pa = pack8(st[2 * s5] * inv, st[2 * s5 + 1] * inv);
      const int key0 = (2 * kp0 + 2 * s5) * 16 + 4 * fq;
#pragma unroll
      for (int nt = 0; nt < 4; ++nt) {
        const int drow = nt * 16 + fr;
        const int c0 = key0 >> 3, c1 = (key0 + 16) >> 3;
        const u32x2 lo = *(const u32x2*)(sV + drow * 512 + ((c0 ^ (drow & 15)) << 4) + ((key0 >> 2) & 1) * 8);
        const u32x2 hi = *(const u32x2*)(sV + drow * 512 + ((c1 ^ (drow & 15)) << 4) + ((key0 >> 2) & 1) * 8);
        const u32x4 vb = (u32x4){lo[0], lo[1], hi[0], hi[1]};
        O[nt] = __builtin_amdgcn_mfma_f32_16x16x32_bf16(__builtin_bit_cast(bf16x8, vb), pa, O[nt], 0, 0, 0);
      }
    }
#pragma unroll
    for (int nt = 0; nt < 4; ++nt) {
      u32x2 wv; wv[0] = pack2(O[nt][0], O[nt][1]); wv[1] = pack2(O[nt][2], O[nt][3]);
      *(u32x2*)(mixed + (rowb + t0 + qt * 16 + fr) * DM + 512 + head * 64 + nt * 16 + 4 * fq) = wv;
    }
  }
}

__device__ __forceinline__ void ph_wout(unsigned char* smem, int xcd, int l, const bf16_t* __restrict__ mixed, const bf16_t* __restrict__ wt, const float* __restrict__ x, float* __restrict__ y1) {
  const int mi = l >> 3, ni = l & 7;
  LdRowBF16 al; al.init([&](int r) { return mixed + (size_t)((xcd * 32 + mi) * 128 + r) * DM; }, (size_t)8 * 128 * DM * 2);
  LdRowBF16 bl; bl.init([&](int r) { return wt + (size_t)(ni * 128 + r) * DM; }, 0);
  gemm_stream<16>(smem, al, bl, 4, [&](int seg, f32x4 (&acc)[4][4]) {
    GEMM_IDS
    const int m0 = (xcd * 32 + seg * 8 + mi) * 128, n0 = ni * 128;
#pragma unroll
    for (int m = 0; m < 4; ++m)
#pragma unroll
      for (int n = 0; n < 4; ++n) {
        const size_t idx = (size_t)(m0 + wr * 64 + m * 16 + fr) * DM + n0 + wc * 64 + n * 16 + fq * 4;
        const f32x4 xv = *(const f32x4*)(x + idx);
        *(f32x4*)(y1 + idx) = xv * ALPHA + acc[m][n];
      }
  });
}

__device__ __forceinline__ void ph_ln1(int item, const float* __restrict__ y, const float* __restrict__ gam, const float* __restrict__ bet, bf16_t* __restrict__ xbf) {
  const int row = item * 4 + (TIDX >> 6), lane = TIDX & 63;
  const float4* p = (const float4*)(y + (size_t)row * DM);
  float4 v[4]; float s = 0.f;
#pragma unroll
  for (int i = 0; i < 4; ++i) { v[i] = p[lane + i * 64]; s += v[i].x + v[i].y + v[i].z + v[i].w; }
  const float mu = wave_sum(s) * (1.f / DM);
  float q = 0.f;
#pragma unroll
  for (int i = 0; i < 4; ++i) { const float a = v[i].x - mu, b = v[i].y - mu, c = v[i].z - mu, d = v[i].w - mu; q += a * a + b * b + c * c + d * d; }
  const float rs = rsqrtf(wave_sum(q) * (1.f / DM) + LN_EPS);
#pragma unroll
  for (int i = 0; i < 4; ++i) {
    const float4 gg = ((const float4*)gam)[lane + i * 64], bb = ((const float4*)bet)[lane + i * 64];
    u32x2 w;
    w[0] = pack2((v[i].x - mu) * rs * gg.x + bb.x, (v[i].y - mu) * rs * gg.y + bb.y);
    w[1] = pack2((v[i].z - mu) * rs * gg.z + bb.z, (v[i].w - mu) * rs * gg.w + bb.w);
    ((u32x2*)(xbf + (size_t)row * DM))[lane + i * 64] = w;
  }
}

__device__ __forceinline__ void ph_router(unsigned char* smem, int tile, const bf16_t* __restrict__ xbf, const bf16_t* __restrict__ wt, float* __restrict__ logits) {
  GEMM_IDS
  const int n0 = (tile & 1) * 128, m0 = (tile >> 1) * 128;
  LdRowBF16 al; al.init([&](int r) { return xbf + (size_t)(m0 + r) * DM; }, 0);
  LdRowBF16 bl; bl.init([&](int r) { return wt + (size_t)(n0 + r) * DM; }, 0);
  gemm_stream<16>(smem, al, bl, 1, [&](int seg, f32x4 (&acc)[4][4]) {
    GEMM_IDS
#pragma unroll
    for (int m = 0; m < 4; ++m)
#pragma unroll
      for (int n = 0; n < 4; ++n)
        *(f32x4*)(logits + (size_t)(m0 + wr * 64 + m * 16 + fr) * NEXP + n0 + wc * 64 + n * 16 + fq * 4) = acc[m][n];
  });
}

__device__ __forceinline__ void ph_route(int item, const float* __restrict__ logits, const float* __restrict__ router_bias, int* __restrict__ cnt, int* __restrict__ list, float* __restrict__ gates) {
  const int n = item * 4 + (TIDX >> 6), lane = TIDX & 63;
  const float4 lg = ((const float4*)(logits + (size_t)n * NEXP))[lane];
  const float4 rb = ((const float4*)router_bias)[lane];
  float sc[4] = {sigmoidf(lg.x), sigmoidf(lg.y), sigmoidf(lg.z), sigmoidf(lg.w)};
  float sel[4] = {sc[0] + rb.x, sc[1] + rb.y, sc[2] + rb.z, sc[3] + rb.w};
  float t1 = fmaxf(sel[0], sel[1]), t2 = fminf(sel[0], sel[1]);
  { const float a = sel[2]; if (a > t1) { t2 = t1; t1 = a; } else if (a > t2) t2 = a; }
  { const float a = sel[3]; if (a > t1) { t2 = t1; t1 = a; } else if (a > t2) t2 = a; }
#pragma unroll
  for (int o = 1; o < 8; o <<= 1) {
    const float b1 = __shfl_xor(t1, o), b2 = __shfl_xor(t2, o);
    const float n1 = fmaxf(t1, b1), n2 = fmaxf(fminf(t1, b1), fmaxf(t2, b2));
    t1 = n1; t2 = n2;
  }
  const float gs = t1 + t2;
  const int mygrp = lane >> 3;
  int rank = 0;
#pragma unroll
  for (int j = 0; j < 8; ++j) {
    const float o = __shfl(gs, j * 8);
    rank += (o > gs || (o == gs && j < mygrp)) ? 1 : 0;
  }
  const bool gsel = rank < 4;
  float cand[4];
#pragma unroll
  for (int i = 0; i < 4; ++i) cand[i] = gsel ? sel[i] : -INFINITY;
  float gsum = 0.f; float myg = 0.f; int mye = 0;
#pragma unroll 1
  for (int r = 0; r < TOPK; ++r) {
    float bv = cand[0]; int bi = 0;
#pragma unroll
    for (int i = 1; i < 4; ++i) if (cand[i] > bv) { bv = cand[i]; bi = i; }
    int be = lane * 4 + bi;
    float bs = (bi == 0) ? sc[0] : (bi == 1) ? sc[1] : (bi == 2) ? sc[2] : sc[3];
#pragma unroll
    for (int o = 1; o < 64; o <<= 1) {
      const float ov = __shfl_xor(bv, o); const int oe = __shfl_xor(be, o); const float os = __shfl_xor(bs, o);
      if (ov > bv || (ov == bv && oe < be)) { bv = ov; be = oe; bs = os; }
    }
    if ((be >> 2) == lane) {
      const int bi2 = be & 3;
      if (bi2 == 0) cand[0] = -INFINITY; else if (bi2 == 1) cand[1] = -INFINITY; else if (bi2 == 2) cand[2] = -INFINITY; else cand[3] = -INFINITY;
    }
    gsum += bs;
    if (lane == r) { myg = bs; mye = be; }
  }
  if (lane < TOPK) {
    const int slot = atomicAdd(&cnt[mye], 1);
    list[(size_t)mye * CAP + slot] = n * TOPK + lane;
    gates[(size_t)n * TOPK + lane] = myg / gsum * 2.5f;
  }
}

__device__ __forceinline__ void moe_build_prefix(const int* __restrict__ cnt, int* sscan) {
  const int tid = TIDX;
  const int e = ((tid & 31) << 3) | (tid >> 5);
  const int c = cnt[e];
  __syncthreads();
  sscan[tid] = (c + 127) >> 7;
  __syncthreads();
  for (int o = 1; o < 256; o <<= 1) {
    const int v = (tid >= o) ? sscan[tid - o] : 0;
    __syncthreads();
    sscan[tid] += v;
    __syncthreads();
  }
}
__device__ __forceinline__ void moe_locate(const int* sscan, int x, int lt, int& e, int& rt) {
  const int base = x ? sscan[32 * x - 1] : 0;
  const int nrouted = sscan[32 * x + 31] - base;
  if (lt >= nrouted) { e = 256; rt = x * (NTOK / 128 / 8) + (lt - nrouted); return; }
  const int g = base + lt;
  int lo = 32 * x, hi = 32 * x + 31;
  while (lo < hi) { const int mid = (lo + hi) >> 1; if (sscan[mid] > g) hi = mid; else lo = mid + 1; }
  e = ((lo & 31) << 3) | (lo >> 5); rt = g - (lo ? sscan[lo - 1] : 0);
}

__device__ __forceinline__ void ph_moe(unsigned char* smem, int e, int rt, const bf16_t* __restrict__ xbf, const int* __restrict__ cnt, const int* __restrict__ list,
                                       const float* __restrict__ gates, const bf16_t* __restrict__ wge, const bf16_t* __restrict__ wue, const bf16_t* __restrict__ wde,
                                       bf16_t* __restrict__ ybuf, float* __restrict__ dout, bf16_t* __restrict__ dummy) {
  int* sasg = (int*)(smem + SM_MISC + 2048);
  float* sgate = (float*)(smem + SM_MISC + 2048 + 512);
  const int tid = TIDX, lane = tid & 63, w = tid >> 6, fr = lane & 15, fq = lane >> 4;
  const int rows = (e < 256) ? cnt[e] : NTOK;
  __syncthreads();
  if (tid < 128) {
    const int r = rt * 128 + tid;
    int a = -1;
    if (r < rows) a = (e < 256) ? list[(size_t)e * CAP + r] : (NA + r);
    sasg[tid] = a;
    sgate[tid] = (a >= 0 && a < NA) ? gates[a] : 1.f;
  }
  __syncthreads();
  bf16x8 hf[2][8];
  {
    LdRowBF16 al; al.init([&](int r) { const int a = sasg[r]; const int tok = (a < 0) ? 0 : (a < NA ? (a >> 3) : (a - NA)); return xbf + (size_t)tok * DM; }, 0);
    LdRowBF16 bl; bl.init([&](int j) {
      const int bn = j >> 4, ff = (bn >> 1) * 16 + (j & 15);
      return ((bn & 1) ? wue : wge) + (size_t)ff * DM; }, (size_t)64 * DM * 2);
    al.issue(0, 0, smem); bl.issue(0, 0, smem + 16384);
    asm volatile("s_waitcnt vmcnt(0)" ::: "memory");
    __syncthreads();
#pragma unroll
    for (int m = 0; m < 2; ++m)
#pragma unroll
      for (int s = 0; s < 8; ++s) hf[m][s] = (bf16x8){0, 0, 0, 0, 0, 0, 0, 0};
#pragma unroll 1
    for (int ct = 0; ct < 4; ++ct) {
      f32x4 acc[2][8];
#pragma unroll
      for (int m = 0; m < 2; ++m)
#pragma unroll
        for (int n = 0; n < 8; ++n) acc[m][n] = (f32x4){0.f, 0.f, 0.f, 0.f};
#pragma unroll 1
      for (int kk = 0; kk < 16; ++kk) {
        const int j = ct * 16 + kk;
        unsigned char* cur = smem + (j & 1) * 32768; unsigned char* nxt = smem + ((j & 1) ^ 1) * 32768;
        if (j + 1 < 64) { al.issue((j + 1) >> 4, (j + 1) & 15, nxt); bl.issue((j + 1) >> 4, (j + 1) & 15, nxt + 16384); }
#pragma unroll
        for (int ks = 0; ks < 2; ++ks) {
          bf16x8 a[2];
#pragma unroll
          for (int m = 0; m < 2; ++m) {
            const int row = w * 32 + m * 16 + fr;
            a[m] = *(const bf16x8*)(cur + row * 128 + (((ks * 4 + fq) ^ (row & 7)) << 4));
          }
          bf16x8 bfrag[8];
#pragma unroll
          for (int n = 0; n < 8; ++n) {
            const int row = n * 16 + fr;
            bfrag[n] = *(const bf16x8*)(cur + 16384 + row * 128 + (((ks * 4 + fq) ^ (row & 7)) << 4));
          }
#pragma unroll
          for (int n = 0; n < 8; ++n)
#pragma unroll
            for (int m = 0; m < 2; ++m) acc[m][n] = __builtin_amdgcn_mfma_f32_16x16x32_bf16(bfrag[n], a[m], acc[m][n], 0, 0, 0);
          __builtin_amdgcn_sched_group_barrier(0x100, 10, 0);
          __builtin_amdgcn_sched_group_barrier(0x008, 16, 0);
        }
        asm volatile("s_waitcnt vmcnt(0)" ::: "memory");
        __syncthreads();
      }
#pragma unroll
      for (int m = 0; m < 2; ++m) {
        f32x4 hv[4];
#pragma unroll
        for (int p = 0; p < 4; ++p)
#pragma unroll
          for (int r = 0; r < 4; ++r) hv[p][r] = siluf(acc[m][2 * p][r]) * acc[m][2 * p + 1][r];
        const bf16x8 h0 = pack8(hv[0], hv[1]), h1 = pack8(hv[2], hv[3]);
        if (ct == 0) { hf[m][0] = h0; hf[m][1] = h1; }
        else if (ct == 1) { hf[m][2] = h0; hf[m][3] = h1; }
        else if (ct == 2) { hf[m][4] = h0; hf[m][5] = h1; }
        else { hf[m][6] = h0; hf[m][7] = h1; }
      }
    }
  }
#define MOE_RAW_BARRIER() do { asm volatile("s_waitcnt lgkmcnt(0)" ::: "memory"); __builtin_amdgcn_s_barrier(); } while (0)
  {
    LdRowBF16 bl; bl.init([&](int j) { return wde + (size_t)j * EFF; }, (size_t)128 * EFF * 2);
    bl.issue(0, 0, smem); bl.issue(0, 1, smem + 16384); bl.issue(0, 2, smem + 32768);
#pragma unroll 1
    for (int ct = 0; ct < 8; ++ct) {
      f32x4 acc[2][8];
#pragma unroll
      for (int m = 0; m < 2; ++m)
#pragma unroll
        for (int n = 0; n < 8; ++n) acc[m][n] = (f32x4){0.f, 0.f, 0.f, 0.f};
#pragma unroll
      for (int kk = 0; kk < 4; ++kk) {
        const int j = ct * 4 + kk;
        if (e < 256 && ct > 0 && kk < 3) {
          if (j < 30) asm volatile("s_waitcnt vmcnt(16)" ::: "memory");
          else asm volatile("s_waitcnt vmcnt(12)" ::: "memory");
        } else {
          if (j < 30) asm volatile("s_waitcnt vmcnt(8)" ::: "memory");
          else if (j == 30) asm volatile("s_waitcnt vmcnt(4)" ::: "memory");
          else asm volatile("s_waitcnt vmcnt(0)" ::: "memory");
        }
        MOE_RAW_BARRIER();
        if (j + 3 < 32) bl.issue((j + 3) >> 2, (j + 3) & 3, smem + ((kk + 3) & 3) * 16384);
        const unsigned char* cur = smem + kk * 16384;
#pragma unroll
        for (int ks = 0; ks < 2; ++ks) {
          bf16x8 wf[8];
#pragma unroll
          for (int n = 0; n < 8; ++n) {
            const int row = n * 16 + fr;
            wf[n] = *(const bf16x8*)(cur + row * 128 + (((ks * 4 + fq) ^ (row & 7)) << 4));
          }
#pragma unroll
          for (int n = 0; n < 8; ++n)
#pragma unroll
            for (int m = 0; m < 2; ++m) acc[m][n] = __builtin_amdgcn_mfma_f32_16x16x32_bf16(wf[n], hf[m][kk * 2 + ks], acc[m][n], 0, 0, 0);
          __builtin_amdgcn_sched_group_barrier(0x100, 8, 0);
          __builtin_amdgcn_sched_group_barrier(0x008, 16, 0);
        }
      }
      const int n0 = ct * 128;
      if (e == 256) {
#pragma unroll
        for (int m = 0; m < 2; ++m) {
          const int a = sasg[w * 32 + m * 16 + fr];
          if (a >= NA) {
            float* dp = dout + (size_t)(a - NA) * DM + n0 + fq * 4;
            const bf16_t* xp = xbf + (size_t)(a - NA) * DM + n0 + fq * 4;
#pragma unroll
            for (int n = 0; n < 8; ++n) {
              const u32x2 xw = *(const u32x2*)(xp + n * 16);
              const f32x4 xv = (f32x4){bflo(xw[0]), bfhi(xw[0]), bflo(xw[1]), bfhi(xw[1])};
              *(f32x4*)(dp + n * 16) = xv * ALPHA + acc[m][n];
            }
          }
        }
      } else {
        unsigned char* stg = smem + 3 * 16384 + w * 4096;
        MOE_RAW_BARRIER();
#pragma unroll
        for (int hc = 0; hc < 2; ++hc) {
#pragma unroll
          for (int m = 0; m < 2; ++m) {
            const int row = m * 16 + fr;
            const float gt = sgate[w * 32 + row];
#pragma unroll
            for (int nn = 0; nn < 4; ++nn) {
              const int n = hc * 4 + nn, chunk = nn * 2 + (fq >> 1);
              u32x2 wv; wv[0] = pack2(acc[m][n][0] * gt, acc[m][n][1] * gt); wv[1] = pack2(acc[m][n][2] * gt, acc[m][n][3] * gt);
              *(u32x2*)(stg + row * 128 + ((chunk ^ (row & 7)) << 4) + (fq & 1) * 8) = wv;
            }
          }
#pragma unroll
          for (int i = 0; i < 4; ++i) {
            const int q = lane + 64 * i, row = q >> 3, ch = q & 7;
            const int a = sasg[w * 32 + row];
            bf16_t* yp = ((a >= 0) ? ybuf + (size_t)a * DM : dummy) + n0 + hc * 64 + ch * 8;
            *(u32x4*)yp = *(const u32x4*)(stg + row * 128 + ((ch ^ (row & 7)) << 4));
          }
        }
      }
    }
    MOE_RAW_BARRIER();
  }
#undef MOE_RAW_BARRIER
}

__device__ __forceinline__ void ph_final(int item, float* __restrict__ out, const bf16_t* __restrict__ ybuf, const float* __restrict__ gam, const float* __restrict__ bet) {
  const int row = item * 4 + (TIDX >> 6), lane = TIDX & 63;
  float4* p = (float4*)(out + (size_t)row * DM);
  float4 v[4]; float s = 0.f;
#pragma unroll
  for (int i = 0; i < 4; ++i) {
    float4 a = p[lane + i * 64];
#pragma unroll
    for (int k = 0; k < 8; ++k) {
      const uint2 w = ((const uint2*)(ybuf + ((size_t)row * 8 + k) * DM))[lane + i * 64];
      a.x += bflo(w.x); a.y += bfhi(w.x); a.z += bflo(w.y); a.w += bfhi(w.y);
    }
    v[i] = a; s += a.x + a.y + a.z + a.w;
  }
  const float mu = wave_sum(s) * (1.f / DM);
  float q = 0.f;
#pragma unroll
  for (int i = 0; i < 4; ++i) { const float a = v[i].x - mu, b = v[i].y - mu, c = v[i].z - mu, d = v[i].w - mu; q += a * a + b * b + c * c + d * d; }
  const float rs = rsqrtf(wave_sum(q) * (1.f / DM) + LN_EPS);
#pragma unroll
  for (int i = 0; i < 4; ++i) {
    const float4 gg = ((const float4*)gam)[lane + i * 64], bb = ((const float4*)bet)[lane + i * 64];
    float4 r;
    r.x = (v[i].x - mu) * rs * gg.x + bb.x; r.y = (v[i].y - mu) * rs * gg.y + bb.y;
    r.z = (v[i].z - mu) * rs * gg.z + bb.z; r.w = (v[i].w - mu) * rs * gg.w + bb.w;
    p[lane + i * 64] = r;
  }
}

#define XB_TMO      128
#define XB_XCNT(j)  (256  + 64 * (j))
#define XB_XSUB(j)  (1280 + 64 * (j))
#define XB_XGEN(j)  (2304 + 64 * (j))
#define XB_TOP      3328
#define XB_TOPGEN   3392
#define XCD_BAR_WORDS 3456
#define XB_SPIN_CAP (1u << 22)
#define LAS __attribute__((address_space(3)))
__device__ __forceinline__ unsigned xb_ld(unsigned* p)              { return __hip_atomic_load(p, __ATOMIC_RELAXED, __HIP_MEMORY_SCOPE_AGENT); }
__device__ __forceinline__ unsigned xb_add(unsigned* p, unsigned v) { return __hip_atomic_fetch_add(p, v, __ATOMIC_RELAXED, __HIP_MEMORY_SCOPE_AGENT); }
__device__ __forceinline__ unsigned xb_xcc_id() { return (unsigned)__builtin_amdgcn_s_getreg((3 << 11) | 20) & 0xFu; }
#define XB_SPIN(cond, bar) do { unsigned _sp = 0; while (cond) { __builtin_amdgcn_s_sleep(1); \
    if ((++_sp & 255u) == 0u) { if (xb_ld(&(bar)[XB_TMO])) break; if (_sp > XB_SPIN_CAP) { atomicAdd(&(bar)[XB_TMO], 1u); break; } } } } while (0)
struct XcdBarrier { unsigned* bar; unsigned x; volatile LAS unsigned* st; };
__device__ __forceinline__ XcdBarrier xcd_barrier_post(unsigned* bar, volatile LAS unsigned* st) {
  XcdBarrier b; b.bar = bar; b.x = xb_xcc_id(); b.st = st;
  if (threadIdx.x == 0) (void)xb_add(&bar[XB_XCNT(b.x)], 1u);
  return b;
}
__device__ __forceinline__ void xcd_barrier_complete(unsigned* bar, unsigned x, unsigned& nloc, unsigned& nx) {
  const unsigned G = gridDim.x * gridDim.y * gridDim.z;
  unsigned sum, cnt, mine, sp = 0u;
  for (;;) {
    sum = 0u; cnt = 0u; mine = 0u;
#pragma unroll
    for (unsigned j = 0; j < 16; ++j) { const unsigned c = xb_ld(&bar[XB_XCNT(j)]); sum += c; cnt += (c > 0u) ? 1u : 0u; mine = (j == x) ? c : mine; }
    if (sum == G) break;
    __builtin_amdgcn_s_sleep(1);
    if ((++sp & 255u) == 0u) { if (xb_ld(&bar[XB_TMO])) break; if (sp > XB_SPIN_CAP) { atomicAdd(&bar[XB_TMO], 1u); break; } }
  }
  nloc = mine > 0u ? mine : 1u; nx = cnt > 0u ? cnt : 1u;
}
__device__ __forceinline__ void xcd_barrier(const XcdBarrier& b) {
  asm volatile("s_waitcnt vmcnt(0)" ::: "memory");
  __syncthreads();
  if (threadIdx.x == 0) {
    unsigned* bar = b.bar;
    __builtin_amdgcn_s_waitcnt(0);
    unsigned nloc = b.st[0], nx = b.st[1];
    if (nloc == 0u) { xcd_barrier_complete(bar, b.x, nloc, nx); b.st[0] = nloc; b.st[1] = nx; }
    const unsigned old = xb_add(&bar[XB_XSUB(b.x)], 1u);
    const unsigned gen = old / nloc;
    if (old + 1u == (gen + 1u) * nloc) {
      __builtin_amdgcn_fence(__ATOMIC_RELEASE, "agent");
      asm volatile("s_waitcnt vmcnt(0)" ::: "memory");
      const unsigned og = xb_add(&bar[XB_TOP], 1u);
      const unsigned tg = og / nx;
      if (og + 1u == (tg + 1u) * nx) xb_add(&bar[XB_TOPGEN], 1u);
      else XB_SPIN(xb_ld(&bar[XB_TOPGEN]) == tg, bar);
      __builtin_amdgcn_fence(__ATOMIC_ACQUIRE, "agent");
      xb_add(&bar[XB_XGEN(b.x)], 1u);
      asm volatile("s_waitcnt vmcnt(0)" ::: "memory");
    } else {
      XB_SPIN(xb_ld(&bar[XB_XGEN(b.x)]) == gen, bar);
      __builtin_amdgcn_fence(__ATOMIC_ACQUIRE, "agent");
      asm volatile("s_waitcnt vmcnt(0)" ::: "memory");
    }
  }
  __syncthreads();
}

__global__ void __launch_bounds__(256, 2) mega(Params P) {
  __shared__ __attribute__((aligned(16))) unsigned char smem[SMEM_BYTES];
  const int bid = blockIdx.x, nblk = gridDim.x;
#define xin (P.in[0])
#define w_in (P.in[1])
#define conv_w (P.in[2])
#define a_log (P.in[3])
#define dt_bias (P.in[4])
#define dn_norm_g (P.in[5])
#define sinks (P.in[6])
#define w_out (P.in[7])
#define ln1_g (P.in[8])
#define ln1_b (P.in[9])
#define router_w (P.in[10])
#define router_bias (P.in[11])
#define w_gate (P.in[12])
#define w_up (P.in[13])
#define w_down (P.in[14])
#define sw_gate (P.in[15])
#define sw_up (P.in[16])
#define sw_down (P.in[17])
#define ln2_g (P.in[18])
#define ln2_b (P.in[19])
#define outp (P.out)
#define x1bf ((bf16_t*)(P.ws + WS_X1BF))
#define logits ((float*)(P.ws + WS_LOGIT))
#define list ((int*)(P.ws + WS_LIST))
#define gates ((float*)(P.ws + WS_GATES))
#define cnt ((int*)(P.ws + WS_CTRL))
#define barw ((unsigned*)(P.ws + WS_CTRL + 4096))
#define mixed ((bf16_t*)(P.ws + WS_MIXED))
#define proj ((bf16_t*)(P.ws + WS_PROJ))
#define ba ((float*)(P.ws + WS_BA))
#define QD ((bf16_t*)(P.ws + WS_QD))
#define W0N ((bf16_t*)(P.ws + WS_W0N))
#define KTT ((bf16_t*)(P.ws + WS_KTT))
#define RV ((bf16_t*)(P.ws + WS_RV))
#define TM ((bf16_t*)(P.ws + WS_TM))
#define ATT ((bf16_t*)(P.ws + WS_ATT))
#define GL ((float*)(P.ws + WS_GL))
#define obuf ((float*)(P.ws + WS_O))
#define VTb ((bf16_t*)(P.ws + WS_VT))
#define XBF ((bf16_t*)(P.ws + WS_XBF))
#define WTIN ((bf16_t*)(P.ws + WS_WTIN))
#define WTOUT ((bf16_t*)(P.ws + WS_WTOUT))
#define WTR ((bf16_t*)(P.ws + WS_WTR))
#define WTG ((bf16_t*)(P.ws + WS_WTG))
#define WTU ((bf16_t*)(P.ws + WS_WTU))
#define WTD ((bf16_t*)(P.ws + WS_WTD))
#define WTSG ((bf16_t*)(P.ws + WS_WTSG))
#define WTSU ((bf16_t*)(P.ws + WS_WTSU))
#define WTSD ((bf16_t*)(P.ws + WS_WTSD))
#define ybuf ((bf16_t*)(P.ws + WS_YBUF))
  {
    volatile LAS unsigned* st0 = (volatile LAS unsigned*)(smem + SM_MISC + 4080);
    if (threadIdx.x == 0) { st0[0] = 0u; st0[1] = 0u; }
    __syncthreads();
  }
  const int xcd = bid & 7, xloc = bid >> 3, xnl = nblk >> 3;
  XcdBarrier xb = xcd_barrier_post(barw, (volatile LAS unsigned*)(smem + SM_MISC + 4080));
  for (int it = bid; it < NTOK / 4; it += nblk) ph_cvt_x(it, xin, XBF);
  for (int it = bid; it < 16 * 46 + 16 * 16 + 16 * 4; it += nblk) {
    if (it < 16 * 46) ph_cvt_wt(smem, it % 16, it / 16, w_in, DM, INC, WTIN);
    else if (it < 16 * 46 + 256) { const int j = it - 16 * 46; ph_cvt_wt(smem, j % 16, j / 16, w_out, DM, DM, WTOUT); }
    else { const int j = it - 16 * 46 - 256; ph_cvt_wt(smem, j % 16, j / 16, router_w, DM, NEXP, WTR); }
  }
  for (int it = bid; it < 192; it += nblk) {
    if (it < 64) ph_cvt_wt(smem, it % 16, it / 16, sw_gate, DM, EFF, WTSG);
    else if (it < 128) ph_cvt_wt(smem, (it - 64) % 16, (it - 64) / 16, sw_up, DM, EFF, WTSU);
    else ph_cvt_wt(smem, (it - 128) % 4, (it - 128) / 4, sw_down, EFF, DM, WTSD, true);
  }
  xcd_barrier(xb);
  for (int l = xloc; l < 64; l += xnl) ph_proj(smem, xcd, l, XBF, WTIN, proj, ba, VTb);
  xcd_barrier(xb);
  for (int it = bid; it < 2048; it += nblk) ph_dnchunk(smem, it, proj, ba, conv_w, a_log, dt_bias, QD, W0N, KTT, RV, TM, ATT, GL);
  for (int it = bid; it < 512; it += nblk) ph_swa(smem, it, proj, VTb, sinks, mixed);
  xcd_barrier(xb);
  if (bid < 64 || nblk <= 64) {
    for (int it = bid; it < 64; it += nblk) ph_dnscan(smem, it, QD, W0N, KTT, RV, TM, ATT, GL, obuf);
  }
  if (bid >= 64 || nblk <= 64) {
    const int tid = TIDX, lane = tid & 63, wv = tid >> 6;
    float* tile = (float*)(smem + wv * 8448);
    const int nconv = (nblk > 64) ? (nblk - 64) : nblk, cb = (nblk > 64) ? (bid - 64) : bid;
    const int step = nconv * 4, total = 256 * 384;
    int it = cb * 4 + wv;
    f32x4 vc[8], vn[8];
    CvtTile tc = cvt_decode(it < total ? it : 0, lane, w_gate, w_up, w_down, WTG, WTU, WTD);
    if (it < total) cvt_load(tc, vc);
    while (it < total) {
      const int itn = it + step;
      CvtTile tn = cvt_decode(itn < total ? itn : 0, lane, w_gate, w_up, w_down, WTG, WTU, WTD);
      if (itn < total) cvt_load(tn, vn);
      cvt_store(tile, lane, tc, vc);
#pragma unroll
      for (int i = 0; i < 8; ++i) vc[i] = vn[i];
      tc = tn; it = itn;
    }
  }
  xcd_barrier(xb);
  for (int it = bid; it < NTOK / 4; it += nblk) ph_dn_post(it, obuf, proj, dn_norm_g, mixed);
  xcd_barrier(xb);
  for (int l = xloc; l < 64; l += xnl) ph_wout(smem, xcd, l, mixed, WTOUT, xin, outp);
  xcd_barrier(xb);
  for (int it = bid; it < NTOK / 4; it += nblk) ph_ln1(it, outp, ln1_g, ln1_b, x1bf);
  xcd_barrier(xb);
  for (int i = xloc; i < 32 * 2; i += xnl) ph_router(smem, (xcd * 32 + i / 2) * 2 + i % 2, x1bf, WTR, logits);
  xcd_barrier(xb);
  for (int it = bid; it < NTOK / 4; it += nblk) ph_route(it, logits, router_bias, cnt, list, gates);
  xcd_barrier(xb);
  int* sscan = (int*)(smem + SM_MISC);
  moe_build_prefix(cnt, sscan);
  const int ntile = sscan[32 * xcd + 31] - (xcd ? sscan[32 * xcd - 1] : 0) + NTOK / 128 / 8;
  for (int it = xloc; it < ntile; it += xnl) {
    int e, rt; moe_locate(sscan, xcd, it, e, rt);
    ph_moe(smem, e, rt, x1bf, cnt, list, gates, (e < 256) ? WTG + (size_t)e * EFF * DM : WTSG, (e < 256) ? WTU + (size_t)e * EFF * DM : WTSU,
           (e < 256) ? WTD + (size_t)e * DM * EFF : WTSD, ybuf, outp, (bf16_t*)(P.ws + WS_DUMMY));
  }
  xcd_barrier(xb);
  for (int it = bid; it < NTOK / 4; it += nblk) ph_final(it, outp, ybuf, ln2_g, ln2_b);
}

#undef xin
#undef w_in
#undef conv_w
#undef a_log
#undef dt_bias
#undef dn_norm_g
#undef sinks
#undef w_out
#undef ln1_g
#undef ln1_b
#undef router_w
#undef router_bias
#undef w_gate
#undef w_up
#undef w_down
#undef sw_gate
#undef sw_up
#undef sw_down
#undef ln2_g
#undef ln2_b
#undef outp
#undef x1bf
#undef logits
#undef list
#undef gates
#undef cnt
#undef mixed
#undef proj
#undef ba
#undef QD
#undef W0N
#undef KTT
#undef RV
#undef TM
#undef ATT
#undef GL
#undef obuf
#undef ybuf
#undef VTb
#undef XBF
#undef WTIN
#undef WTOUT
#undef WTR
#undef WTG
#undef WTU
#undef WTD
#undef WTSG
#undef WTSU
#undef WTSD
#undef barw

extern "C" void kernel_launch(void* const* d_in, const int* in_sizes, int n_in, void* d_out, int out_size, void* d_ws, size_t ws_size, hipStream_t stream) {
  static int grid_blocks = 0;
  if (!grid_blocks) {
    int dev = 0, cus = 0, per_cu = 0;
    (void)hipGetDevice(&dev);
    (void)hipDeviceGetAttribute(&cus, hipDeviceAttributeMultiprocessorCount, dev);
    (void)hipOccupancyMaxActiveBlocksPerMultiprocessor(&per_cu, mega, 256, 0);
    if (per_cu > 2) per_cu = 2;
    if (per_cu < 1) per_cu = 1;
    grid_blocks = cus * per_cu;
  }
  Params p{};
  for (int i = 0; i < 20; ++i) p.in[i] = (const float*)d_in[i];
  p.out = (float*)d_out; p.ws = (char*)d_ws;
  (void)hipMemsetAsync((char*)d_ws + WS_CTRL, 0, 4096 + XCD_BAR_WORDS * 4, stream);
  void* args[] = {&p};
  hipError_t e = hipLaunchCooperativeKernel((void*)mega, dim3(grid_blocks), dim3(256), args, 0, stream);
  if (e != hipSuccess) fprintf(stderr, "cooperative launch failed: %s (grid %d)\n", hipGetErrorString(e), grid_blocks);
}
```

```cpp
#include <hip/hip_runtime.h>
#include <hip/hip_cooperative_groups.h>
#include <stdint.h>
#include <stdio.h>
namespace cg = cooperative_groups;

typedef __attribute__((ext_vector_type(8))) short bf16x8;
typedef __attribute__((ext_vector_type(4))) float f32x4;
typedef unsigned short bf16_t;
typedef __attribute__((ext_vector_type(4))) unsigned u32x4;
typedef __attribute__((ext_vector_type(2))) unsigned u32x2;

constexpr int NTOK = 32768, SEQ = 4096, DM = 1024;
constexpr int INC = 2824, PROJW = 2816;
constexpr int OFF_DQ = 0, OFF_DK = 512, OFF_DV = 1024, OFF_SQ = 1536, OFF_SK = 2048, OFF_SV = 2176, OFF_Z = 2304;
constexpr int NEXP = 256, TOPK = 8, EFF = 256;
constexpr int NA = NTOK * TOPK;
constexpr int CAP = NTOK;
constexpr float ALPHA = 1.189207115002721f;
constexpr float LN_EPS = 1e-5f, RMS_EPS = 1e-6f, L2_EPS = 1e-6f;

constexpr size_t MiB = 1024ull * 1024ull;
constexpr size_t WS_WTD = 0;
constexpr size_t WS_WTG = 128 * MiB;
constexpr size_t WS_WTU = 256 * MiB;
constexpr size_t WS_YBUF = 384 * MiB;
constexpr size_t WS_LOGIT = 384 * MiB;
constexpr size_t WS_X1BF = 896 * MiB;
constexpr size_t WS_LIST = 960 * MiB;
constexpr size_t WS_GATES = 992 * MiB;
constexpr size_t WS_CTRL = 993 * MiB;
constexpr size_t WS_WTIN = 994 * MiB;
constexpr size_t WS_WTOUT = 1000 * MiB;
constexpr size_t WS_WTR = 1002 * MiB;
constexpr size_t WS_WTSG = 1003 * MiB;
constexpr size_t WS_WTSU = WS_WTSG + 512 * 1024;
constexpr size_t WS_WTSD = 1004 * MiB;
constexpr size_t WS_DUMMY = 1005 * MiB;
constexpr size_t WS_PROJ = 384 * MiB;
constexpr size_t WS_BA = 560 * MiB;
constexpr size_t WS_QD = 561 * MiB;
constexpr size_t WS_W0N = 593 * MiB;
constexpr size_t WS_KTT = 625 * MiB;
constexpr size_t WS_RV = 657 * MiB;
constexpr size_t WS_TM = 689 * MiB;
constexpr size_t WS_ATT = 705 * MiB;
constexpr size_t WS_GL = 721 * MiB;
constexpr size_t WS_O = 722 * MiB;
constexpr size_t WS_VT = 786 * MiB;
constexpr size_t WS_MIXED = 794 * MiB;
constexpr size_t WS_XBF = 640 * MiB;

__device__ __forceinline__ int opaque_tid() { int t = threadIdx.x; asm volatile("" : "+v"(t)); return t; }
#define TIDX opaque_tid()
typedef __attribute__((ext_vector_type(2))) __bf16 hwbf16x2;
typedef __attribute__((ext_vector_type(2))) float hwf32x2;
__device__ __forceinline__ unsigned pack2(float lo, float hi) {
  hwf32x2 f = {lo, hi};
  return __builtin_bit_cast(unsigned, __builtin_convertvector(f, hwbf16x2));
}
__device__ __forceinline__ unsigned f2bf(float f) { return pack2(f, 0.f) & 0xffffu; }
__device__ __forceinline__ float bf2f(unsigned h) { return __uint_as_float(h << 16); }
__device__ __forceinline__ float bflo(unsigned w) { return __uint_as_float(w << 16); }
__device__ __forceinline__ float bfhi(unsigned w) { return __uint_as_float(w & 0xffff0000u); }
__device__ __forceinline__ float siluf(float x) { return x / (1.f + __expf(-x)); }
__device__ __forceinline__ float sigmoidf(float x) { return 1.f / (1.f + __expf(-x)); }
__device__ __forceinline__ float wave_sum(float v) {
#pragma unroll
  for (int o = 32; o > 0; o >>= 1) v += __shfl_xor(v, o);
  return v;
}

template <int SEGDIV>
struct LdRowBF16T {
  const char* p[4]; size_t seghi, seglo; int tid16;
  template <class F> __device__ __forceinline__ void init(F rowptr, size_t hi, size_t lo = 0) {
    const int tid = TIDX; const int slot = tid & 7, row0 = tid >> 3; seghi = hi; seglo = lo; tid16 = tid * 16;
#pragma unroll
    for (int i = 0; i < 4; ++i) p[i] = (const char*)rowptr(row0 + i * 32) + ((slot ^ (row0 & 7)) << 4);
  }
  __device__ __forceinline__ void issue(int seg, int kk, unsigned char* lds) {
    const size_t off = (size_t)(seg / SEGDIV) * seghi + (size_t)(seg % SEGDIV) * seglo + (size_t)kk * 128;
#pragma unroll
    for (int i = 0; i < 4; ++i)
      __builtin_amdgcn_global_load_lds((const unsigned*)(p[i] + off), (__attribute__((address_space(3))) unsigned*)(lds + tid16 + i * 4096), 16, 0, 0);
  }
};
typedef LdRowBF16T<1> LdRowBF16;
struct LdColF32 {
  const char* p; size_t ldb, segb; f32x4 r[2][8]; int n4, kg;
  __device__ __forceinline__ void init(const float* colptr, size_t ld, size_t seg_bytes) {
    const int tid = TIDX; n4 = tid & 31; kg = tid >> 5; ldb = ld * 4; segb = seg_bytes;
    p = (const char*)colptr + (size_t)(kg * 8) * ldb;
  }
  template <int S> __device__ __forceinline__ void load(int seg, int kk) {
#pragma unroll
    for (int j = 0; j < 8; ++j) r[S][j] = *(const f32x4*)(p + (size_t)seg * segb + (size_t)(kk * 64 + j) * ldb);
  }
  template <int S> __device__ __forceinline__ void store(unsigned char* s) {
#pragma unroll
    for (int i = 0; i < 4; ++i) {
      const int row = n4 * 4 + i; u32x4 w;
      w[0] = pack2(r[S][0][i], r[S][1][i]); w[1] = pack2(r[S][2][i], r[S][3][i]); w[2] = pack2(r[S][4][i], r[S][5][i]); w[3] = pack2(r[S][6][i], r[S][7][i]);
      *(u32x4*)(s + row * 128 + ((kg ^ (row & 7)) << 4)) = w;
    }
  }
};

__device__ __forceinline__ void gemm_kstep(const unsigned char* sA, const unsigned char* sB, f32x4 (&acc)[4][4], int wr, int wc, int fr, int fq) {
#pragma unroll
  for (int ks = 0; ks < 2; ++ks) {
    bf16x8 a[4], b[4];
#pragma unroll
    for (int m = 0; m < 4; ++m) {
      const int row = wr * 64 + m * 16 + fr;
      a[m] = *(const bf16x8*)(sA + row * 128 + (((ks * 4 + fq) ^ (row & 7)) << 4));
    }
#pragma unroll
    for (int n = 0; n < 4; ++n) {
      const int row = wc * 64 + n * 16 + fr;
      b[n] = *(const bf16x8*)(sB + row * 128 + (((ks * 4 + fq) ^ (row & 7)) << 4));
    }
    __builtin_amdgcn_s_setprio(1);
#pragma unroll
    for (int m = 0; m < 4; ++m)
#pragma unroll
      for (int n = 0; n < 4; ++n) acc[m][n] = __builtin_amdgcn_mfma_f32_16x16x32_bf16(b[n], a[m], acc[m][n], 0, 0, 0);
    __builtin_amdgcn_s_setprio(0);
  }
}
template <int KPER, class AL, class BL, class Epi>
__device__ __forceinline__ void gemm_stream(unsigned char* smem, AL& al, BL& bl, int nseg, Epi epi) {
  const int tid = TIDX, lane = tid & 63, wid = tid >> 6, wr = wid >> 1, wc = wid & 1, fr = lane & 15, fq = lane >> 4;
  const int total = nseg * KPER;
  f32x4 acc[4][4];
  al.issue(0, 0, smem); bl.issue(0, 0, smem + 16384);
  asm volatile("s_waitcnt vmcnt(0)" ::: "memory");
  __syncthreads();
  for (int j = 0; j < total; ++j) {
    unsigned char* cur = smem + (j & 1) * 32768; unsigned char* nxt = smem + ((j & 1) ^ 1) * 32768;
    if (j + 1 < total) { al.issue((j + 1) / KPER, (j + 1) % KPER, nxt); bl.issue((j + 1) / KPER, (j + 1) % KPER, nxt + 16384); }
    if (j % KPER == 0) {
#pragma unroll
      for (int m = 0; m < 4; ++m)
#pragma unroll
        for (int n = 0; n < 4; ++n) acc[m][n] = (f32x4){0.f, 0.f, 0.f, 0.f};
    }
    gemm_kstep(cur, cur + 16384, acc, wr, wc, fr, fq);
    asm volatile("s_waitcnt vmcnt(0)" ::: "memory");
    __syncthreads();
    if ((j + 1) % KPER == 0) epi((j + 1) / KPER - 1, acc, cur);
  }
}

template <class RowDst>
__device__ __forceinline__ void store_tile_bf16(unsigned char* fbuf, const f32x4 (&acc)[4][4], RowDst rowdst) {
  const int tid = TIDX, lane = tid & 63, wid = tid >> 6, wr = wid >> 1, wc = wid & 1, fr = lane & 15, fq = lane >> 4;
#pragma unroll
  for (int m = 0; m < 4; ++m) {
    const int row = wr * 64 + m * 16 + fr;
#pragma unroll
    for (int n = 0; n < 4; ++n) {
      const int col = wc * 64 + n * 16 + fq * 4;
      u32x2 w; w[0] = pack2(acc[m][n][0], acc[m][n][1]); w[1] = pack2(acc[m][n][2], acc[m][n][3]);
      *(u32x2*)(fbuf + row * 256 + (((col >> 3) ^ (row & 15)) << 4) + ((col >> 2) & 1) * 8) = w;
    }
  }
  __syncthreads();
#pragma unroll
  for (int i = 0; i < 8; ++i) {
    const int q = tid + 256 * i, row = q >> 4, ch = q & 15;
    *(u32x4*)(rowdst(row) + ch * 8) = *(const u32x4*)(fbuf + row * 256 + ((ch ^ (row & 15)) << 4));
  }
  __syncthreads();
}

template <class RowDst>
__device__ __forceinline__ void store_tile_bf16_T(unsigned char* fbuf, const f32x4 (&acc)[4][4], RowDst rowdst) {
  const int tid = TIDX, lane = tid & 63, wid = tid >> 6, wr = wid >> 1, wc = wid & 1, fr = lane & 15, fq = lane >> 4;
#pragma unroll
  for (int m = 0; m < 4; ++m) {
    const int t = wr * 64 + m * 16 + fr;
#pragma unroll
    for (int n = 0; n < 4; ++n)
#pragma unroll
      for (int r = 0; r < 4; ++r) {
        const int c = wc * 64 + n * 16 + fq * 4 + r;
        *(unsigned short*)(fbuf + c * 256 + ((((t >> 3) ^ (c & 15))) << 4) + (t & 7) * 2) = (unsigned short)f2bf(acc[m][n][r]);
      }
  }
  __syncthreads();
#pragma unroll
  for (int i = 0; i < 8; ++i) {
    const int q = tid + 256 * i, row = q >> 4, ch = q & 15;
    *(u32x4*)(rowdst(row) + ch * 8) = *(const u32x4*)(fbuf + row * 256 + ((ch ^ (row & 15)) << 4));
  }
  __syncthreads();
}

#define GEMM_IDS const int tid = TIDX, lane = tid & 63, wid = tid >> 6, wr = wid >> 1, wc = wid & 1, fr = lane & 15, fq = lane >> 4; (void)tid; (void)lane;

struct Params {
  const float* in[20];
  float* out;
  char* ws;
};

constexpr int SMEM_BYTES = 69632;
constexpr int SM_MISC = 65536;

__device__ __forceinline__ void ph_cvt_x(int item, const float* __restrict__ x, bf16_t* __restrict__ xbf) {
  const int tid = TIDX;
  const size_t base = (size_t)item * 4096 + (size_t)tid * 4;
#pragma unroll
  for (int i = 0; i < 4; ++i) {
    const f32x4 v = *(const f32x4*)(x + base + (size_t)i * 1024);
    u32x2 w; w[0] = pack2(v[0], v[1]); w[1] = pack2(v[2], v[3]);
    *(u32x2*)(xbf + base + (size_t)i * 1024) = w;
  }
}
__device__ __forceinline__ void ph_cvt_wt(unsigned char* smem, int kt, int nt, const float* __restrict__ W, int K, int N, bf16_t* __restrict__ WT, bool perm = false) {
  float* tile = (float*)smem;
  const int tid = TIDX;
  const int k0 = kt * 64, n0 = nt * 64;
  __syncthreads();
#pragma unroll
  for (int i = 0; i < 4; ++i) {
    const int k = (tid >> 4) + 16 * i, n = 4 * (tid & 15);
    f32x4 v = (f32x4){0.f, 0.f, 0.f, 0.f};
    if (n0 + n < N) v = *(const f32x4*)(W + (size_t)(k0 + k) * N + n0 + n);
    tile[k * 65 + n + 0] = v[0]; tile[k * 65 + n + 1] = v[1]; tile[k * 65 + n + 2] = v[2]; tile[k * 65 + n + 3] = v[3];
  }
  __syncthreads();
  const int n = tid >> 2, kq = tid & 3;
  u32x4 w0, w1;
#pragma unroll
  for (int j = 0; j < 4; ++j) {
    w0[j] = pack2(tile[(kq * 16 + 2 * j) * 65 + n], tile[(kq * 16 + 2 * j + 1) * 65 + n]);
    w1[j] = pack2(tile[(kq * 16 + 8 + 2 * j) * 65 + n], tile[(kq * 16 + 8 + 2 * j + 1) * 65 + n]);
  }
  if (!perm) {
    bf16_t* dst = WT + (size_t)(n0 + n) * K + k0 + kq * 16;
    *(u32x4*)dst = w0; *(u32x4*)(dst + 8) = w1;
  } else {
    const int blk = kq >> 1, hi = kq & 1;
    bf16_t* dst = WT + (size_t)(n0 + n) * K + k0 + blk * 32 + 4 * hi;
    u32x2 a; a[0] = w0[0]; a[1] = w0[1]; *(u32x2*)(dst + 0) = a;
    a[0] = w0[2]; a[1] = w0[3]; *(u32x2*)(dst + 8) = a;
    a[0] = w1[0]; a[1] = w1[1]; *(u32x2*)(dst + 16) = a;
    a[0] = w1[2]; a[1] = w1[3]; *(u32x2*)(dst + 24) = a;
  }
}

struct CvtTile { const float* src; bf16_t* dst; int ldn; int K; int perm; };
__device__ __forceinline__ CvtTile cvt_decode(int it, int lane, const float* __restrict__ w_gate, const float* __restrict__ w_up, const float* __restrict__ w_down,
                                              bf16_t* __restrict__ wtg, bf16_t* __restrict__ wtu, bf16_t* __restrict__ wtd) {
  const int e = it / 192, j = it % 192;
  const float* W; bf16_t* WT; int K, N, kt, nt;
  if (j < 64) { W = w_gate + (size_t)e * DM * EFF; WT = wtg + (size_t)e * EFF * DM; K = DM; N = EFF; nt = j & 3; kt = j >> 2; }
  else if (j < 128) { W = w_up + (size_t)e * DM * EFF; WT = wtu + (size_t)e * EFF * DM; K = DM; N = EFF; nt = (j - 64) & 3; kt = (j - 64) >> 2; }
  else { W = w_down + (size_t)e * EFF * DM; WT = wtd + (size_t)e * DM * EFF; K = EFF; N = DM; nt = (j - 128) & 15; kt = (j - 128) >> 4; }
  CvtTile t;
  t.src = W + (size_t)(kt * 64 + (lane >> 4)) * N + nt * 64 + 4 * (lane & 15);
  t.dst = WT + (size_t)(nt * 64) * K + kt * 64;
  t.ldn = 4 * N; t.K = K;
  t.perm = (j >= 128) ? 1 : 0;
  return t;
}
__device__ __forceinline__ void cvt_load(const CvtTile& t, f32x4 (&v)[16]) {
#pragma unroll
  for (int i = 0; i < 16; ++i) v[i] = *(const f32x4*)(t.src + (size_t)i * t.ldn);
}
__device__ __forceinline__ void cvt_store(float* tile  , int lane, const CvtTile& t, const f32x4 (&v)[16]) {
#pragma unroll
  for (int i = 0; i < 16; ++i) {
    float* p = tile + ((lane >> 4) + 4 * i) * 65 + 4 * (lane & 15);
    p[0] = v[i][0]; p[1] = v[i][1]; p[2] = v[i][2]; p[3] = v[i][3];
  }
  const int c = lane & 7;
  const int ka = t.perm ? (32 * (c >> 2) + 4 * (c & 3)) : (8 * c), kb = t.perm ? (ka + 16) : (ka + 4);
#pragma unroll
  for (int i = 0; i < 8; ++i) {
    const int n = (lane >> 3) + 8 * i;
    u32x4 w;
    w[0] = pack2(tile[(ka + 0) * 65 + n], tile[(ka + 1) * 65 + n]); w[1] = pack2(tile[(ka + 2) * 65 + n], tile[(ka + 3) * 65 + n]);
    w[2] = pack2(tile[(kb + 0) * 65 + n], tile[(kb + 1) * 65 + n]); w[3] = pack2(tile[(kb + 2) * 65 + n], tile[(kb + 3) * 65 + n]);
    *(u32x4*)(t.dst + (size_t)n * t.K + 8 * c) = w;
  }
}

__device__ __forceinline__ void ph_proj(unsigned char* smem, int xcd, int l, const bf16_t* __restrict__ xbf, const bf16_t* __restrict__ wt, bf16_t* __restrict__ proj, float* __restrict__ ba, bf16_t* __restrict__ vt) {
  const int mi = l >> 3, ni = l & 7;
  LdRowBF16T<3> al; al.init([&](int r) { return xbf + (size_t)((xcd * 32 + mi) * 128 + r) * DM; }, (size_t)8 * 128 * DM * 2, 0);
  LdRowBF16T<3> bl; bl.init([&](int r) { return wt + (size_t)(ni * 128 + r) * DM; }, 0, (size_t)8 * 128 * DM * 2);
  gemm_stream<16>(smem, al, bl, 12, [&](int seg, f32x4 (&acc)[4][4], unsigned char* fbuf) {
    GEMM_IDS
    const int nt = (seg % 3) * 8 + ni;
    if (nt < 23) {
      const int m0 = (xcd * 32 + (seg / 3) * 8 + mi) * 128, n0 = nt * 128;
      if (n0 + 128 <= PROJW) store_tile_bf16(fbuf, acc, [&](int r) { return proj + (size_t)(m0 + r) * PROJW + n0; });
      else
#pragma unroll
      for (int m = 0; m < 4; ++m)
#pragma unroll
        for (int n = 0; n < 4; ++n) {
          const int row = m0 + wr * 64 + m * 16 + fr, col = n0 + wc * 64 + n * 16 + fq * 4;
          if (col < PROJW) {
            u32x2 w; w[0] = pack2(acc[m][n][0], acc[m][n][1]); w[1] = pack2(acc[m][n][2], acc[m][n][3]);
            *(u32x2*)(proj + (size_t)row * PROJW + col) = w;
          } else if (col < INC) {
            *(f32x4*)(ba + (size_t)row * 8 + (col - PROJW)) = acc[m][n];
          }
        }
      if (n0 == OFF_SV) {
        const int bb = m0 / SEQ, t0_ = m0 % SEQ;
        store_tile_bf16_T(fbuf, acc, [&](int c) { return vt + ((size_t)(bb * 128 + c)) * SEQ + t0_; });
      }
    }
  });
}

__device__ __forceinline__ bf16x8 pack8(f32x4 a, f32x4 b) {
  union { bf16x8 v; unsigned u[4]; } x;
  x.u[0] = pack2(a[0], a[1]); x.u[1] = pack2(a[2], a[3]); x.u[2] = pack2(b[0], b[1]); x.u[3] = pack2(b[2], b[3]);
  return x.v;
}
__device__ __forceinline__ void ph_dnchunk(unsigned char* smem, int item, const bf16_t* __restrict__ proj, const float* __restrict__ ba, const float* __restrict__ conv_w,
                                           const float* __restrict__ a_log, const float* __restrict__ dt_bias,
                                           bf16_t* __restrict__ QD, bf16_t* __restrict__ W0N, bf16_t* __restrict__ KTT, bf16_t* __restrict__ RV,
                                           bf16_t* __restrict__ TM, bf16_t* __restrict__ ATT, float* __restrict__ GL) {
  const int tid = TIDX, lane = tid & 63, w = tid >> 6, fr = lane & 15, fq = lane >> 4;
  const int n = item & 63, h = (item >> 6) & 3, b = item >> 8;
  const int t0 = n * 64; const size_t row0 = (size_t)b * SEQ + t0;
  unsigned char* qs = smem; unsigned char* ks = smem + 16384; float* AT = (float*)(smem + 32768);
  const float scale = 0.08838834764831845f;
  float bL, gcL;
  {
    const float* bap = ba + (row0 + lane) * 8;
    bL = sigmoidf(bap[h]);
    const float xx = bap[4 + h] + dt_bias[h];
    const float sp = fmaxf(xx, 0.f) + log1pf(__expf(-fabsf(xx)));
    float gg = -__expf(a_log[h]) * sp;
#pragma unroll
    for (int o = 1; o < 64; o <<= 1) { const float v = __shfl_up(gg, o); if (lane >= o) gg += v; }
    gcL = gg;
  }
  {
    const int d = 2 * lane;
    float cw[3][4][2];
#pragma unroll
    for (int mx = 0; mx < 3; ++mx)
#pragma unroll
      for (int j = 0; j < 4; ++j) {
        const float2 c2 = *(const float2*)(conv_w + j * 1536 + mx * 512 + h * 128 + d);
        cw[mx][j][0] = c2.x; cw[mx][j][1] = c2.y;
      }
    const bf16_t* pbase = proj + (row0 + 16 * w) * PROJW + h * 128 + d;
    unsigned raw[3][19];
#pragma unroll
    for (int j = 0; j < 19; ++j) {
      const bool ok = (t0 + 16 * w - 3 + j) >= 0;
#pragma unroll
      for (int mx = 0; mx < 3; ++mx) {
        unsigned u = 0;
        if (ok) u = *(const unsigned*)(pbase + (ptrdiff_t)(j - 3) * PROJW + mx * 512);
        raw[mx][j] = u;
      }
    }
#pragma unroll
    for (int i = 0; i < 16; ++i) {
      float s[3][2];
#pragma unroll
      for (int mx = 0; mx < 3; ++mx) {
        float y0 = 0.f, y1 = 0.f;
#pragma unroll
        for (int j = 0; j < 4; ++j) { y0 += cw[mx][j][0] * bflo(raw[mx][i + j]); y1 += cw[mx][j][1] * bfhi(raw[mx][i + j]); }
        s[mx][0] = siluf(y0); s[mx][1] = siluf(y1);
      }
      const int row = 16 * w + i;
      const float rq = rsqrtf(wave_sum(s[0][0] * s[0][0] + s[0][1] * s[0][1]) + L2_EPS);
      const float rk = rsqrtf(wave_sum(s[1][0] * s[1][0] + s[1][1] * s[1][1]) + L2_EPS);
      const int off = row * 256 + ((((lane >> 2) ^ (row & 15))) << 4) + (lane & 3) * 4;
      *(unsigned*)(qs + off) = pack2(s[0][0] * rq, s[0][1] * rq);
      *(unsigned*)(ks + off) = pack2(s[1][0] * rk, s[1][1] * rk);
      const float bi = __shfl(bL, row);
      *(unsigned*)(RV + ((size_t)item * 64 + row) * 128 + d) = pack2(bi * s[2][0], bi * s[2][1]);
    }
  }
  __syncthreads();
  {
    f32x4 aKK[4], aQK[4];
#pragma unroll
    for (int nt = 0; nt < 4; ++nt) { aKK[nt] = (f32x4){0.f, 0.f, 0.f, 0.f}; aQK[nt] = (f32x4){0.f, 0.f, 0.f, 0.f}; }
#pragma unroll
    for (int k4 = 0; k4 < 4; ++k4) {
      const int arow = 16 * w + fr;
      const bf16x8 aq = *(const bf16x8*)(qs + arow * 256 + ((((k4 * 4 + fq) ^ (arow & 15))) << 4));
      const bf16x8 ak = *(const bf16x8*)(ks + arow * 256 + ((((k4 * 4 + fq) ^ (arow & 15))) << 4));
#pragma unroll
      for (int nt = 0; nt < 4; ++nt) {
        const int brow = 16 * nt + fr;
        const bf16x8 bk = *(const bf16x8*)(ks + brow * 256 + ((((k4 * 4 + fq) ^ (brow & 15))) << 4));
        aKK[nt] = __builtin_amdgcn_mfma_f32_16x16x32_bf16(ak, bk, aKK[nt], 0, 0, 0);
        aQK[nt] = __builtin_amdgcn_mfma_f32_16x16x32_bf16(bk, aq, aQK[nt], 0, 0, 0);
      }
    }
    float gci[4], bi[4];
#pragma unroll
    for (int r = 0; r < 4; ++r) { gci[r] = __shfl(gcL, 16 * w + 4 * fq + r); bi[r] = __shfl(bL, 16 * w + 4 * fq + r); }
    const float gci2 = __shfl(gcL, 16 * w + fr);
#pragma unroll
    for (int nt = 0; nt < 4; ++nt) {
      const int j = 16 * nt + fr;
      const float gcj = __shfl(gcL, j);
      float av[4], at[4];
#pragma unroll
      for (int r = 0; r < 4; ++r) {
        const int i = 16 * w + 4 * fq + r;
        const float dec = (j <= i) ? __expf(gci[r] - gcj) : 0.f;
        av[r] = (j < i) ? bi[r] * aKK[nt][r] * dec : 0.f;
        const int i2 = 16 * w + fr, j2 = 16 * nt + 4 * fq + r;
        const float gcj2 = __shfl(gcL, j2);
        const float dec2 = (j2 <= i2) ? __expf(gci2 - gcj2) : 0.f;
        at[r] = aQK[nt][r] * scale * dec2;
      }
      *(float4*)(AT + j * 68 + 16 * w + 4 * fq) = make_float4(av[0], av[1], av[2], av[3]);
      u32x2 wv; wv[0] = pack2(at[0], at[1]); wv[1] = pack2(at[2], at[3]);
      *(u32x2*)(ATT + ((size_t)item * 64 + 16 * w + fr) * 64 + 32 * (nt >> 1) + 8 * fq + 4 * (nt & 1)) = wv;
    }
  }
  __syncthreads();
  if (w == 0) {
    float Tr[64];
    int ln = lane; asm volatile("" : "+v"(ln));
#pragma unroll
    for (int j = 0; j < 64; ++j) Tr[j] = 0.f;
    f32x4 cur[16], nxt[16];
#pragma unroll
    for (int j4 = 0; j4 < 16; ++j4) nxt[j4] = (f32x4){0.f, 0.f, 0.f, 0.f};
#pragma unroll
    for (int j4 = 15; j4 >= 16; --j4) cur[j4] = *(const f32x4*)(AT + 63 * 68 + j4 * 4);
#pragma unroll
    for (int c = 63; c >= 0; --c) {
      if (c > 0) {
#pragma unroll
        for (int j4 = 15; j4 >= c / 4; --j4) nxt[j4] = *(const f32x4*)(AT + (c - 1) * 68 + j4 * 4);
      }
      float a0 = 0.f, a1 = 0.f, a2 = 0.f, a3 = 0.f;
#pragma unroll
      for (int j4 = 15; j4 >= (c + 1) / 4; --j4) {
        asm volatile("v_fmac_f32 %0, %1, %2" : "+v"(a0) : "v"(Tr[4 * j4 + 0]), "v"(cur[j4][0]));
        asm volatile("v_fmac_f32 %0, %1, %2" : "+v"(a1) : "v"(Tr[4 * j4 + 1]), "v"(cur[j4][1]));
        asm volatile("v_fmac_f32 %0, %1, %2" : "+v"(a2) : "v"(Tr[4 * j4 + 2]), "v"(cur[j4][2]));
        asm volatile("v_fmac_f32 %0, %1, %2" : "+v"(a3) : "v"(Tr[4 * j4 + 3]), "v"(cur[j4][3]));
      }
      Tr[c] = ((ln == c) ? 1.f : 0.f) - ((a0 + a1) + (a2 + a3));
#pragma unroll
      for (int j4 = 0; j4 < 16; ++j4) cur[j4] = nxt[j4];
    }
    u32x4* tp = (u32x4*)(TM + ((size_t)item * 64 + lane) * 64);
#pragma unroll
    for (int oc = 0; oc < 8; ++oc) {
      const int k0 = 32 * (oc >> 2) + 4 * (oc & 3);
      u32x4 v;
      v[0] = pack2(Tr[k0 + 0], Tr[k0 + 1]); v[1] = pack2(Tr[k0 + 2], Tr[k0 + 3]);
      v[2] = pack2(Tr[k0 + 16], Tr[k0 + 17]); v[3] = pack2(Tr[k0 + 18], Tr[k0 + 19]);
      tp[oc] = v;
    }
  } else {
    const float gclast = __shfl(gcL, 63);
    if (tid == 64) GL[item] = __expf(gclast);
#pragma unroll 1
    for (int it = 0; it < 16; ++it) {
      const int idx = (tid - 64) + it * 192;
      const int mtx = idx >> 10, rem = idx & 1023;
      if (mtx < 2) {
        const int i = rem >> 4, oc = rem & 15;
        const float gi = __shfl(gcL, i), bi = __shfl(bL, i);
        const float f = (mtx == 0) ? scale * __expf(gi) : -bi * __expf(gi);
        const unsigned char* st = (mtx == 0) ? qs : ks;
        const int d0 = 32 * (oc >> 2) + 4 * (oc & 3);
        const uint2 lo = *(const uint2*)(st + i * 256 + ((((d0 >> 3) ^ (i & 15))) << 4) + (d0 & 7) * 2);
        const uint2 hi = *(const uint2*)(st + i * 256 + (((((d0 + 16) >> 3) ^ (i & 15))) << 4) + (d0 & 7) * 2);
        u32x4 v;
        v[0] = pack2(bflo(lo.x) * f, bfhi(lo.x) * f); v[1] = pack2(bflo(lo.y) * f, bfhi(lo.y) * f);
        v[2] = pack2(bflo(hi.x) * f, bfhi(hi.x) * f); v[3] = pack2(bflo(hi.y) * f, bfhi(hi.y) * f);
        bf16_t* dst = ((mtx == 0) ? QD : W0N) + ((size_t)item * 64 + i) * 128 + 8 * oc;
        *(u32x4*)dst = v;
      } else {
        const int d = rem & 127, oc = rem >> 7;
        const int j0 = 32 * (oc >> 2) + 4 * (oc & 3);
        float val[8];
#pragma unroll
        for (int e = 0; e < 8; ++e) {
          const int j = j0 + (e & 3) + ((e >> 2) << 4);
          const float f = __expf(gclast - __shfl(gcL, j));
          const unsigned short raw = *(const unsigned short*)(ks + j * 256 + ((((d >> 3) ^ (j & 15))) << 4) + (d & 7) * 2);
          val[e] = bf2f(raw) * f;
        }
        u32x4 v;
        v[0] = pack2(val[0], val[1]); v[1] = pack2(val[2], val[3]); v[2] = pack2(val[4], val[5]); v[3] = pack2(val[6], val[7]);
        *(u32x4*)(KTT + ((size_t)item * 128 + d) * 64 + 8 * oc) = v;
      }
    }
  }
  __syncthreads();
}

__device__ __forceinline__ void ph_dnscan(unsigned char* smem, int item, const bf16_t* __restrict__ QDp, const bf16_t* __restrict__ W0Np, const bf16_t* __restrict__ KTTp,
                                          const bf16_t* __restrict__ RVp, const bf16_t* __restrict__ TMp, const bf16_t* __restrict__ ATTp, const float* __restrict__ GLp,
                                          float* __restrict__ op) {
  const int tid = TIDX, lane = tid & 63, w = tid >> 6, fr = lane & 15, fq = lane >> 4;
  const int bh = item >> 1, half = item & 1, b = bh >> 2, h = bh & 3;
  const int vcol0 = (half * 4 + w) * 16;
  unsigned char* sW0 = smem; unsigned char* sQD = smem + 16384; unsigned char* sKT = smem + 32768; unsigned char* sT = smem + 49152; unsigned char* sAT = smem + 57344;
  f32x4 S[8];
#pragma unroll
  for (int t = 0; t < 8; ++t) S[t] = (f32x4){0.f, 0.f, 0.f, 0.f};
  u32x4 pfA[8], pfB[8]; unsigned short rvp[16];
#define DN_LOAD_A(nn_) do { \
    const size_t ci = (size_t)bh * 64 + (nn_); \
    _Pragma("unroll") for (int i = 0; i < 4; ++i) pfA[i] = *(const u32x4*)((const char*)W0Np + ci * 16384 + (size_t)(tid + 256 * i) * 16); \
    _Pragma("unroll") for (int i = 0; i < 4; ++i) pfA[4 + i] = *(const u32x4*)((const char*)QDp + ci * 16384 + (size_t)(tid + 256 * i) * 16); \
    _Pragma("unroll") for (int mt = 0; mt < 4; ++mt) \
      _Pragma("unroll") for (int r = 0; r < 4; ++r) rvp[mt * 4 + r] = RVp[(ci * 64 + 16 * mt + 4 * fq + r) * 128 + vcol0 + fr]; \
  } while (0)
#define DN_STORE_A() do { \
    _Pragma("unroll") for (int i = 0; i < 4; ++i) { const int q = tid + 256 * i, row = q >> 4, ch = q & 15; *(u32x4*)(sW0 + row * 256 + ((ch ^ (row & 15)) << 4)) = pfA[i]; } \
    _Pragma("unroll") for (int i = 0; i < 4; ++i) { const int q = tid + 256 * i, row = q >> 4, ch = q & 15; *(u32x4*)(sQD + row * 256 + ((ch ^ (row & 15)) << 4)) = pfA[4 + i]; } \
  } while (0)
#define DN_LOAD_B(nn_) do { \
    const size_t ci = (size_t)bh * 64 + (nn_); \
    _Pragma("unroll") for (int i = 0; i < 4; ++i) pfB[i] = *(const u32x4*)((const char*)KTTp + ci * 16384 + (size_t)(tid + 256 * i) * 16); \
    _Pragma("unroll") for (int i = 0; i < 2; ++i) pfB[4 + i] = *(const u32x4*)((const char*)TMp + ci * 8192 + (size_t)(tid + 256 * i) * 16); \
    _Pragma("unroll") for (int i = 0; i < 2; ++i) pfB[6 + i] = *(const u32x4*)((const char*)ATTp + ci * 8192 + (size_t)(tid + 256 * i) * 16); \
  } while (0)
#define DN_STORE_B() do { \
    _Pragma("unroll") for (int i = 0; i < 4; ++i) { const int q = tid + 256 * i, row = q >> 3, ch = q & 7; *(u32x4*)(sKT + row * 128 + ((ch ^ (row & 7)) << 4)) = pfB[i]; } \
    _Pragma("unroll") for (int i = 0; i < 2; ++i) { const int q = tid + 256 * i, row = q >> 3, ch = q & 7; *(u32x4*)(sT + row * 128 + ((ch ^ (row & 7)) << 4)) = pfB[4 + i]; } \
    _Pragma("unroll") for (int i = 0; i < 2; ++i) { const int q = tid + 256 * i, row = q >> 3, ch = q & 7; *(u32x4*)(sAT + row * 128 + ((ch ^ (row & 7)) << 4)) = pfB[6 + i]; } \
  } while (0)
#define DN_ZINIT() do { _Pragma("unroll") for (int mt = 0; mt < 4; ++mt) Z[mt] = (f32x4){bf2f(rvp[mt * 4 + 0]), bf2f(rvp[mt * 4 + 1]), bf2f(rvp[mt * 4 + 2]), bf2f(rvp[mt * 4 + 3])}; } while (0)
  __syncthreads();
  f32x4 Z[4];
  DN_LOAD_A(0);
  DN_LOAD_B(0);
  DN_STORE_A();
  DN_ZINIT();
  DN_LOAD_A(1);
  for (int nn = 0; nn < 64; ++nn) {
    const float gl = GLp[(size_t)bh * 64 + nn];
    __syncthreads();
    bf16x8 Sb[4];
#pragma unroll
    for (int k4 = 0; k4 < 4; ++k4) Sb[k4] = pack8(S[2 * k4], S[2 * k4 + 1]);
    f32x4 O[4];
#pragma unroll
    for (int mt = 0; mt < 4; ++mt) {
      O[mt] = (f32x4){0.f, 0.f, 0.f, 0.f};
      const int row = 16 * mt + fr;
#pragma unroll
      for (int k4 = 0; k4 < 4; ++k4) {
        const int off = row * 256 + ((((k4 * 4 + fq) ^ fr)) << 4);
        const bf16x8 aw = *(const bf16x8*)(sW0 + off);
        const bf16x8 aq = *(const bf16x8*)(sQD + off);
        Z[mt] = __builtin_amdgcn_mfma_f32_16x16x32_bf16(aw, Sb[k4], Z[mt], 0, 0, 0);
        O[mt] = __builtin_amdgcn_mfma_f32_16x16x32_bf16(Sb[k4], aq, O[mt], 0, 0, 0);
      }
    }
    bf16x8 Zb[2];
    Zb[0] = pack8(Z[0], Z[1]); Zb[1] = pack8(Z[2], Z[3]);
    DN_STORE_B();
    if (nn + 1 < 64) DN_LOAD_B(nn + 1);
    __syncthreads();
    f32x4 Vn[4];
#pragma unroll
    for (int mt = 0; mt < 4; ++mt) {
      Vn[mt] = (f32x4){0.f, 0.f, 0.f, 0.f};
      const int row = 16 * mt + fr;
#pragma unroll
      for (int s = 0; s < 2; ++s) {
        if (s <= (mt >> 1)) {
          const bf16x8 at = *(const bf16x8*)(sT + row * 128 + ((((s * 4 + fq) ^ (row & 7))) << 4));
          Vn[mt] = __builtin_amdgcn_mfma_f32_16x16x32_bf16(at, Zb[s], Vn[mt], 0, 0, 0);
        }
      }
    }
    bf16x8 Vb[2];
    Vb[0] = pack8(Vn[0], Vn[1]); Vb[1] = pack8(Vn[2], Vn[3]);
#pragma unroll
    for (int mt = 0; mt < 4; ++mt) {
      const int row = 16 * mt + fr;
#pragma unroll
      for (int s = 0; s < 2; ++s) {
        if (s <= (mt >> 1)) {
          const bf16x8 aa = *(const bf16x8*)(sAT + row * 128 + ((((s * 4 + fq) ^ (row & 7))) << 4));
          O[mt] = __builtin_amdgcn_mfma_f32_16x16x32_bf16(Vb[s], aa, O[mt], 0, 0, 0);
        }
      }
      *(f32x4*)(op + ((size_t)b * SEQ + nn * 64 + 16 * mt + fr) * 512 + h * 128 + vcol0 + 4 * fq) = O[mt];
    }
#pragma unroll
    for (int t = 0; t < 8; ++t) {
      S[t] = S[t] * gl;
      const int row = 16 * t + fr;
#pragma unroll
      for (int s = 0; s < 2; ++s) {
        const bf16x8 ak = *(const bf16x8*)(sKT + row * 128 + ((((s * 4 + fq) ^ (row & 7))) << 4));
        S[t] = __builtin_amdgcn_mfma_f32_16x16x32_bf16(ak, Vb[s], S[t], 0, 0, 0);
      }
    }
    if (nn + 1 < 64) {
      DN_STORE_A();
      DN_ZINIT();
      if (nn + 2 < 64) DN_LOAD_A(nn + 2);
    }
  }
  __syncthreads();
#undef DN_ZINIT
#undef DN_LOAD_A
#undef DN_STORE_A
#undef DN_LOAD_B
#undef DN_STORE_B
}

__device__ __forceinline__ void ph_dn_post(int item, const float* __restrict__ o, const bf16_t* __restrict__ proj, const float* __restrict__ dn_norm_g, bf16_t* __restrict__ mixed) {
  const int tid = TIDX, h = tid >> 6, lane = tid & 63;
  const float2 g2 = *(const float2*)(dn_norm_g + 2 * lane);
  float2 ov[4]; unsigned zv[4];
#pragma unroll
  for (int i = 0; i < 4; ++i) {
    const size_t n = (size_t)item * 4 + i;
    ov[i] = *(const float2*)(o + n * 512 + h * 128 + 2 * lane);
    zv[i] = *(const unsigned*)(proj + n * PROJW + OFF_Z + h * 128 + 2 * lane);
  }
#pragma unroll
  for (int i = 0; i < 4; ++i) {
    const size_t n = (size_t)item * 4 + i;
    const float ss = wave_sum(ov[i].x * ov[i].x + ov[i].y * ov[i].y);
    const float rn = rsqrtf(ss * (1.f / 128.f) + RMS_EPS);
    *(unsigned*)(mixed + n * DM + h * 128 + 2 * lane) = pack2(ov[i].x * rn * g2.x * siluf(bflo(zv[i])), ov[i].y * rn * g2.y * siluf(bfhi(zv[i])));
  }
}

__device__ __forceinline__ void ph_swa(unsigned char* smem, int item, const bf16_t* __restrict__ proj, const bf16_t* __restrict__ vt, const float* __restrict__ sinks, bf16_t* __restrict__ mixed) {
  const int tid = TIDX, lane = tid & 63, w = tid >> 6, fr = lane & 15, fq = lane >> 4;
  const int qb = item & 31, kvh = (item >> 5) & 1, b = item >> 6;
  const int t0 = qb * 128;
  const size_t rowb = (size_t)b * SEQ;
  unsigned char* sK = smem;
  unsigned char* sV = smem + 32768;
  __syncthreads();
#pragma unroll
  for (int i = 0; i < 8; ++i) {
    const int q = tid + 256 * i, row = q >> 3, ch = q & 7;
    const int pos = t0 - 128 + row;
    u32x4 v = (u32x4){0u, 0u, 0u, 0u};
    if (pos >= 0) v = *(const u32x4*)(proj + (rowb + pos) * PROJW + OFF_SK + kvh * 64 + ch * 8);
    *(u32x4*)(sK + row * 128 + ((ch ^ (row & 7)) << 4)) = v;
  }
#pragma unroll
  for (int i = 0; i < 8; ++i) {
    const int q = tid + 256 * i, row = q >> 5, ch = q & 31;
    const int pos = t0 - 128 + ch * 8;
    u32x4 v = (u32x4){0u, 0u, 0u, 0u};
    if (pos >= 0) v = *(const u32x4*)(vt + ((size_t)(b * 128 + kvh * 64 + row)) * SEQ + pos);
    *(u32x4*)(sV + row * 512 + ((ch ^ (row & 15)) << 4)) = v;
  }
  __syncthreads();
  const int head = kvh * 4 + w;
  const float slope = exp2f(-(float)(head + 1));
  const float sink = sinks[head];
  const bf16_t* qp0 = proj + (rowb + t0 + fr) * PROJW + OFF_SQ + head * 64 + fq * 8;
  bf16x8 qn0 = *(const bf16x8*)(qp0), qn1 = *(const bf16x8*)(qp0 + 32);
#pragma unroll 1
  for (int qt = 0; qt < 8; ++qt) {
    const bf16x8 qf0 = qn0, qf1 = qn1;
    if (qt < 7) { const bf16_t* qp = qp0 + (size_t)(qt + 1) * 16 * PROJW; qn0 = *(const bf16x8*)(qp); qn1 = *(const bf16x8*)(qp + 32); }
    const int kp0 = qt >> 1;
    f32x4 st[10];
#pragma unroll
    for (int kt = 0; kt < 10; ++kt) {
      const int krow = (2 * kp0 + kt) * 16 + fr;
      st[kt] = (f32x4){0.f, 0.f, 0.f, 0.f};
      const bf16x8 k0 = *(const bf16x8*)(sK + krow * 128 + (((0 + fq) ^ (krow & 7)) << 4));
      const bf16x8 k1 = *(const bf16x8*)(sK + krow * 128 + (((4 + fq) ^ (krow & 7)) << 4));
      st[kt] = __builtin_amdgcn_mfma_f32_16x16x32_bf16(k0, qf0, st[kt], 0, 0, 0);
      st[kt] = __builtin_amdgcn_mfma_f32_16x16x32_bf16(k1, qf1, st[kt], 0, 0, 0);
    }
    const int i = qt * 16 + fr;
    float mx = sink;
#pragma unroll
    for (int kt = 0; kt < 10; ++kt)
#pragma unroll
      for (int r = 0; r < 4; ++r) {
        const int jb = (2 * kp0 + kt) * 16 + 4 * fq + r;
        const int dist = 128 + i - jb;
        const bool ok = (dist >= 0) && (dist < 128) && (t0 - 128 + jb >= 0);
        const float s = ok ? (st[kt][r] * 0.125f - slope * (float)dist) : -INFINITY;
        st[kt][r] = s;
        mx = fmaxf(mx, s);
      }
    mx = fmaxf(mx, __shfl_xor(mx, 16));
    mx = fmaxf(mx, __shfl_xor(mx, 32));
    float sum = 0.f;
#pragma unroll
    for (int kt = 0; kt < 10; ++kt)
#pragma unroll
      for (int r = 0; r < 4; ++r) { const float p = __expf(st[kt][r] - mx); st[kt][r] = p; sum += p; }
    sum += __shfl_xor(sum, 16);
    sum += __shfl_xor(sum, 32);
    const float inv = 1.f / (sum + __expf(sink - mx));
    f32x4 O[4];
#pragma unroll
    for (int nt = 0; nt < 4; ++nt) O[nt] = (f32x4){0.f, 0.f, 0.f, 0.f};
#pragma unroll
    for (int s5 = 0; s5 < 5; ++s5) {
      const bf16x8 pa = pack8(st[2 * s5] * inv, st[2 * s5 + 1] * inv);
      const int key0 = (2 * kp0 + 2 * s5) * 16 + 4 * fq;
#pragma unroll
      for (int nt = 0; nt < 4; ++nt) {
        const int drow = nt * 16 + fr;
        const int c0 = key0 >> 3, c1 = (key0 + 16) >> 3;
        const u32x2 lo = *(const u32x2*)(sV + drow * 512 + ((c0 ^ (drow & 15)) << 4) + ((key0 >> 2) & 1) * 8);
        const u32x2 hi = *(const u32x2*)(sV + drow * 512 + ((c1 ^ (drow & 15)) << 4) + ((key0 >> 2) & 1) * 8);
        const u32x4 vb = (u32x4){lo[0], lo[1], hi[0], hi[1]};
        O[nt] = __builtin_amdgcn_mfma_f32_16x16x32_bf16(__builtin_bit_cast(bf16x8, vb), pa, O[nt], 0, 0, 0);
      }
    }
#pragma unroll
    for (int nt = 0; nt < 4; ++nt) {
      u32x2 wv; wv[0] = pack2(O[nt][0], O[nt][1]); wv[1] = pack2(O[nt][2], O[nt][3]);
      *(u32x2*)(mixed + (rowb + t0 + qt * 16 + fr) * DM + 512 + head * 64 + nt * 16 + 4 * fq) = wv;
    }
  }
}

__device__ __forceinline__ void ph_wout(unsigned char* smem, int xcd, int l, const bf16_t* __restrict__ mixed, const bf16_t* __restrict__ wt, const float* __restrict__ x, float* __restrict__ y1) {
  const int mi = l >> 3, ni = l & 7;
  LdRowBF16 al; al.init([&](int r) { return mixed + (size_t)((xcd * 32 + mi) * 128 + r) * DM; }, (size_t)8 * 128 * DM * 2);
  LdRowBF16 bl; bl.init([&](int r) { return wt + (size_t)(ni * 128 + r) * DM; }, 0);
  gemm_stream<16>(smem, al, bl, 4, [&](int seg, f32x4 (&acc)[4][4], unsigned char* fbuf) {
    GEMM_IDS
    const int m0 = (xcd * 32 + seg * 8 + mi) * 128, n0 = ni * 128;
#pragma unroll
    for (int m = 0; m < 4; ++m)
#pragma unroll
      for (int n = 0; n < 4; ++n) {
        const size_t idx = (size_t)(m0 + wr * 64 + m * 16 + fr) * DM + n0 + wc * 64 + n * 16 + fq * 4;
        const f32x4 xv = *(const f32x4*)(x + idx);
        *(f32x4*)(y1 + idx) = xv * ALPHA + acc[m][n];
      }
  });
}

__device__ __forceinline__ void ph_ln1(int item, const float* __restrict__ y, const float* __restrict__ gam, const float* __restrict__ bet, bf16_t* __restrict__ xbf) {
  const int row = item * 4 + (TIDX >> 6), lane = TIDX & 63;
  const float4* p = (const float4*)(y + (size_t)row * DM);
  float4 v[4]; float s = 0.f;
#pragma unroll
  for (int i = 0; i < 4; ++i) { v[i] = p[lane + i * 64]; s += v[i].x + v[i].y + v[i].z + v[i].w; }
  const float mu = wave_sum(s) * (1.f / DM);
  float q = 0.f;
#pragma unroll
  for (int i = 0; i < 4; ++i) { const float a = v[i].x - mu, b = v[i].y - mu, c = v[i].z - mu, d = v[i].w - mu; q += a * a + b * b + c * c + d * d; }
  const float rs = rsqrtf(wave_sum(q) * (1.f / DM) + LN_EPS);
#pragma unroll
  for (int i = 0; i < 4; ++i) {
    const float4 gg = ((const float4*)gam)[lane + i * 64], bb = ((const float4*)bet)[lane + i * 64];
    u32x2 w;
    w[0] = pack2((v[i].x - mu) * rs * gg.x + bb.x, (v[i].y - mu) * rs * gg.y + bb.y);
    w[1] = pack2((v[i].z - mu) * rs * gg.z + bb.z, (v[i].w - mu) * rs * gg.w + bb.w);
    ((u32x2*)(xbf + (size_t)row * DM))[lane + i * 64] = w;
  }
}

__device__ __forceinline__ void ph_router(unsigned char* smem, int tile, const bf16_t* __restrict__ xbf, const bf16_t* __restrict__ wt, float* __restrict__ logits) {
  GEMM_IDS
  const int n0 = (tile & 1) * 128, m0 = (tile >> 1) * 128;
  LdRowBF16 al; al.init([&](int r) { return xbf + (size_t)(m0 + r) * DM; }, 0);
  LdRowBF16 bl; bl.init([&](int r) { return wt + (size_t)(n0 + r) * DM; }, 0);
  gemm_stream<16>(smem, al, bl, 1, [&](int seg, f32x4 (&acc)[4][4], unsigned char* fbuf) {
    GEMM_IDS
#pragma unroll
    for (int m = 0; m < 4; ++m)
#pragma unroll
      for (int n = 0; n < 4; ++n)
        *(f32x4*)(logits + (size_t)(m0 + wr * 64 + m * 16 + fr) * NEXP + n0 + wc * 64 + n * 16 + fq * 4) = acc[m][n];
  });
}

__device__ __forceinline__ void ph_route(int item, const float* __restrict__ logits, const float* __restrict__ router_bias, int* __restrict__ cnt, int* __restrict__ list, float* __restrict__ gates) {
  const int n = item * 4 + (TIDX >> 6), lane = TIDX & 63;
  const float4 lg = ((const float4*)(logits + (size_t)n * NEXP))[lane];
  const float4 rb = ((const float4*)router_bias)[lane];
  float sc[4] = {sigmoidf(lg.x), sigmoidf(lg.y), sigmoidf(lg.z), sigmoidf(lg.w)};
  float sel[4] = {sc[0] + rb.x, sc[1] + rb.y, sc[2] + rb.z, sc[3] + rb.w};
  float t1 = fmaxf(sel[0], sel[1]), t2 = fminf(sel[0], sel[1]);
  { const float a = sel[2]; if (a > t1) { t2 = t1; t1 = a; } else if (a > t2) t2 = a; }
  { const float a = sel[3]; if (a > t1) { t2 = t1; t1 = a; } else if (a > t2) t2 = a; }
#pragma unroll
  for (int o = 1; o < 8; o <<= 1) {
    const float b1 = __shfl_xor(t1, o), b2 = __shfl_xor(t2, o);
    const float n1 = fmaxf(t1, b1), n2 = fmaxf(fminf(t1, b1), fmaxf(t2, b2));
    t1 = n1; t2 = n2;
  }
  const float gs = t1 + t2;
  const int mygrp = lane >> 3;
  int rank = 0;
#pragma unroll
  for (int j = 0; j < 8; ++j) {
    const float o = __shfl(gs, j * 8);
    rank += (o > gs || (o == gs && j < mygrp)) ? 1 : 0;
  }
  const bool gsel = rank < 4;
  float cand[4];
#pragma unroll
  for (int i = 0; i < 4; ++i) cand[i] = gsel ? sel[i] : -INFINITY;
  float gsum = 0.f; float myg = 0.f; int mye = 0;
#pragma unroll 1
  for (int r = 0; r < TOPK; ++r) {
    float bv = cand[0]; int bi = 0;
#pragma unroll
    for (int i = 1; i < 4; ++i) if (cand[i] > bv) { bv = cand[i]; bi = i; }
    int be = lane * 4 + bi;
    float bs = (bi == 0) ? sc[0] : (bi == 1) ? sc[1] : (bi == 2) ? sc[2] : sc[3];
#pragma unroll
    for (int o = 1; o < 64; o <<= 1) {
      const float ov = __shfl_xor(bv, o); const int oe = __shfl_xor(be, o); const float os = __shfl_xor(bs, o);
      if (ov > bv || (ov == bv && oe < be)) { bv = ov; be = oe; bs = os; }
    }
    if ((be >> 2) == lane) {
      const int bi2 = be & 3;
      if (bi2 == 0) cand[0] = -INFINITY; else if (bi2 == 1) cand[1] = -INFINITY; else if (bi2 == 2) cand[2] = -INFINITY; else cand[3] = -INFINITY;
    }
    gsum += bs;
    if (lane == r) { myg = bs; mye = be; }
  }
  if (lane < TOPK) {
    const int slot = atomicAdd(&cnt[mye], 1);
    list[(size_t)mye * CAP + slot] = n * TOPK + lane;
    gates[(size_t)n * TOPK + lane] = myg / gsum * 2.5f;
  }
}

__device__ __forceinline__ void moe_build_prefix(const int* __restrict__ cnt, int* sscan) {
  const int tid = TIDX;
  const int e = ((tid & 31) << 3) | (tid >> 5);
  const int c = cnt[e];
  __syncthreads();
  sscan[tid] = (c + 127) >> 7;
  __syncthreads();
  for (int o = 1; o < 256; o <<= 1) {
    const int v = (tid >= o) ? sscan[tid - o] : 0;
    __syncthreads();
    sscan[tid] += v;
    __syncthreads();
  }
}
__device__ __forceinline__ void moe_locate(const int* sscan, int x, int lt, int& e, int& rt) {
  const int base = x ? sscan[32 * x - 1] : 0;
  const int nrouted = sscan[32 * x + 31] - base;
  if (lt >= nrouted) { e = 256; rt = x * (NTOK / 128 / 8) + (lt - nrouted); return; }
  const int g = base + lt;
  int lo = 32 * x, hi = 32 * x + 31;
  while (lo < hi) { const int mid = (lo + hi) >> 1; if (sscan[mid] > g) hi = mid; else lo = mid + 1; }
  e = ((lo & 31) << 3) | (lo >> 5); rt = g - (lo ? sscan[lo - 1] : 0);
}

__device__ __forceinline__ void ph_moe(unsigned char* smem, int e, int rt, const bf16_t* __restrict__ xbf, const int* __restrict__ cnt, const int* __restrict__ list,
                                       const float* __restrict__ gates, const bf16_t* __restrict__ wge, const bf16_t* __restrict__ wue, const bf16_t* __restrict__ wde,
                                       bf16_t* __restrict__ ybuf, float* __restrict__ dout, bf16_t* __restrict__ dummy) {
  int* sasg = (int*)(smem + SM_MISC + 2048);
  float* sgate = (float*)(smem + SM_MISC + 2048 + 512);
  const int tid = TIDX, lane = tid & 63, w = tid >> 6, fr = lane & 15, fq = lane >> 4;
  const int rows = (e < 256) ? cnt[e] : NTOK;
  __syncthreads();
  if (tid < 128) {
    const int r = rt * 128 + tid;
    int a = -1;
    if (r < rows) a = (e < 256) ? list[(size_t)e * CAP + r] : (NA + r);
    sasg[tid] = a;
    sgate[tid] = (a >= 0 && a < NA) ? gates[a] : 1.f;
  }
  __syncthreads();
  bf16x8 hf[2][8];
  {
    LdRowBF16 al; al.init([&](int r) { const int a = sasg[r]; const int tok = (a < 0) ? 0 : (a < NA ? (a >> 3) : (a - NA)); return xbf + (size_t)tok * DM; }, 0);
    LdRowBF16 bl; bl.init([&](int j) {
      const int bn = j >> 4, ff = (bn >> 1) * 16 + (j & 15);
      return ((bn & 1) ? wue : wge) + (size_t)ff * DM; }, (size_t)64 * DM * 2);
    al.issue(0, 0, smem); bl.issue(0, 0, smem + 16384);
    asm volatile("s_waitcnt vmcnt(0)" ::: "memory");
    __syncthreads();
#pragma unroll
    for (int m = 0; m < 2; ++m)
#pragma unroll
      for (int s = 0; s < 8; ++s) hf[m][s] = (bf16x8){0, 0, 0, 0, 0, 0, 0, 0};
#pragma unroll 1
    for (int ct = 0; ct < 4; ++ct) {
      f32x4 acc[2][8];
#pragma unroll
      for (int m = 0; m < 2; ++m)
#pragma unroll
        for (int n = 0; n < 8; ++n) acc[m][n] = (f32x4){0.f, 0.f, 0.f, 0.f};
#pragma unroll 1
      for (int kk = 0; kk < 16; ++kk) {
        const int j = ct * 16 + kk;
        unsigned char* cur = smem + (j & 1) * 32768; unsigned char* nxt = smem + ((j & 1) ^ 1) * 32768;
        if (j + 1 < 64) { al.issue((j + 1) >> 4, (j + 1) & 15, nxt); bl.issue((j + 1) >> 4, (j + 1) & 15, nxt + 16384); }
#pragma unroll
        for (int ks = 0; ks < 2; ++ks) {
          bf16x8 a[2];
#pragma unroll
          for (int m = 0; m < 2; ++m) {
            const int row = w * 32 + m * 16 + fr;
            a[m] = *(const bf16x8*)(cur + row * 128 + (((ks * 4 + fq) ^ (row & 7)) << 4));
          }
          bf16x8 bfrag[8];
#pragma unroll
          for (int n = 0; n < 8; ++n) {
            const int row = n * 16 + fr;
            bfrag[n] = *(const bf16x8*)(cur + 16384 + row * 128 + (((ks * 4 + fq) ^ (row & 7)) << 4));
          }
          __builtin_amdgcn_s_setprio(1);
#pragma unroll
          for (int n = 0; n < 8; ++n)
#pragma unroll
            for (int m = 0; m < 2; ++m) acc[m][n] = __builtin_amdgcn_mfma_f32_16x16x32_bf16(bfrag[n], a[m], acc[m][n], 0, 0, 0);
          __builtin_amdgcn_s_setprio(0);
          __builtin_amdgcn_sched_group_barrier(0x100, 10, 0);
          __builtin_amdgcn_sched_group_barrier(0x008, 16, 0);
        }
        asm volatile("s_waitcnt vmcnt(0)" ::: "memory");
        __syncthreads();
      }
#pragma unroll
      for (int m = 0; m < 2; ++m) {
        f32x4 hv[4];
#pragma unroll
        for (int p = 0; p < 4; ++p)
#pragma unroll
          for (int r = 0; r < 4; ++r) hv[p][r] = siluf(acc[m][2 * p][r]) * acc[m][2 * p + 1][r];
        const bf16x8 h0 = pack8(hv[0], hv[1]), h1 = pack8(hv[2], hv[3]);
        if (ct == 0) { hf[m][0] = h0; hf[m][1] = h1; }
        else if (ct == 1) { hf[m][2] = h0; hf[m][3] = h1; }
        else if (ct == 2) { hf[m][4] = h0; hf[m][5] = h1; }
        else { hf[m][6] = h0; hf[m][7] = h1; }
      }
    }
  }
#define MOE_RAW_BARRIER() do { asm volatile("s_waitcnt lgkmcnt(0)" ::: "memory"); __builtin_amdgcn_s_barrier(); } while (0)
  {
    LdRowBF16 bl; bl.init([&](int j) { return wde + (size_t)j * EFF; }, (size_t)128 * EFF * 2);
    bl.issue(0, 0, smem); bl.issue(0, 1, smem + 16384); bl.issue(0, 2, smem + 32768);
#pragma unroll 1
    for (int ct = 0; ct < 8; ++ct) {
      f32x4 acc[2][8];
#pragma unroll
      for (int m = 0; m < 2; ++m)
#pragma unroll
        for (int n = 0; n < 8; ++n) acc[m][n] = (f32x4){0.f, 0.f, 0.f, 0.f};
#pragma unroll
      for (int kk = 0; kk < 4; ++kk) {
        const int j = ct * 4 + kk;
        if (e < 256 && ct > 0 && kk < 3) {
          if (j < 30) asm volatile("s_waitcnt vmcnt(16)" ::: "memory");
          else asm volatile("s_waitcnt vmcnt(12)" ::: "memory");
        } else {
          if (j < 30) asm volatile("s_waitcnt vmcnt(8)" ::: "memory");
          else if (j == 30) asm volatile("s_waitcnt vmcnt(4)" ::: "memory");
          else asm volatile("s_waitcnt vmcnt(0)" ::: "memory");
        }
        MOE_RAW_BARRIER();
        if (j + 3 < 32) bl.issue((j + 3) >> 2, (j + 3) & 3, smem + ((kk + 3) & 3) * 16384);
        const unsigned char* cur = smem + kk * 16384;
#pragma unroll
        for (int ks = 0; ks < 2; ++ks) {
          bf16x8 wf[8];
#pragma unroll
          for (int n = 0; n < 8; ++n) {
            const int row = n * 16 + fr;
            wf[n] = *(const bf16x8*)(cur + row * 128 + (((ks * 4 + fq) ^ (row & 7)) << 4));
          }
          __builtin_amdgcn_s_setprio(1);
#pragma unroll
          for (int n = 0; n < 8; ++n)
#pragma unroll
            for (int m = 0; m < 2; ++m) acc[m][n] = __builtin_amdgcn_mfma_f32_16x16x32_bf16(wf[n], hf[m][kk * 2 + ks], acc[m][n], 0, 0, 0);
          __builtin_amdgcn_s_setprio(0);
          __builtin_amdgcn_sched_group_barrier(0x100, 8, 0);
          __builtin_amdgcn_sched_group_barrier(0x008, 16, 0);
        }
      }
      const int n0 = ct * 128;
      if (e == 256) {
#pragma unroll
        for (int m = 0; m < 2; ++m) {
          const int a = sasg[w * 32 + m * 16 + fr];
          if (a >= NA) {
            float* dp = dout + (size_t)(a - NA) * DM + n0 + fq * 4;
            const bf16_t* xp = xbf + (size_t)(a - NA) * DM + n0 + fq * 4;
#pragma unroll
            for (int n = 0; n < 8; ++n) {
              const u32x2 xw = *(const u32x2*)(xp + n * 16);
              const f32x4 xv = (f32x4){bflo(xw[0]), bfhi(xw[0]), bflo(xw[1]), bfhi(xw[1])};
              *(f32x4*)(dp + n * 16) = xv * ALPHA + acc[m][n];
            }
          }
        }
      } else {
        unsigned char* stg = smem + 3 * 16384 + w * 4096;
        MOE_RAW_BARRIER();
#pragma unroll
        for (int hc = 0; hc < 2; ++hc) {
#pragma unroll
          for (int m = 0; m < 2; ++m) {
            const int row = m * 16 + fr;
            const float gt = sgate[w * 32 + row];
#pragma unroll
            for (int nn = 0; nn < 4; ++nn) {
              const int n = hc * 4 + nn, chunk = nn * 2 + (fq >> 1);
              u32x2 wv; wv[0] = pack2(acc[m][n][0] * gt, acc[m][n][1] * gt); wv[1] = pack2(acc[m][n][2] * gt, acc[m][n][3] * gt);
              *(u32x2*)(stg + row * 128 + ((chunk ^ (row & 7)) << 4) + (fq & 1) * 8) = wv;
            }
          }
#pragma unroll
          for (int i = 0; i < 4; ++i) {
            const int q = lane + 64 * i, row = q >> 3, ch = q & 7;
            const int a = sasg[w * 32 + row];
            bf16_t* yp = ((a >= 0) ? ybuf + (size_t)a * DM : dummy) + n0 + hc * 64 + ch * 8;
            *(u32x4*)yp = *(const u32x4*)(stg + row * 128 + ((ch ^ (row & 7)) << 4));
          }
        }
      }
    }
    MOE_RAW_BARRIER();
  }
#undef MOE_RAW_BARRIER
}

__device__ __forceinline__ void ph_final(int item, float* __restrict__ out, const bf16_t* __restrict__ ybuf, const float* __restrict__ gam, const float* __restrict__ bet) {
  const int row = item * 4 + (TIDX >> 6), lane = TIDX & 63;
  float4* p = (float4*)(out + (size_t)row * DM);
  float4 v[4]; float s = 0.f;
#pragma unroll
  for (int i = 0; i < 4; ++i) {
    float4 a = p[lane + i * 64];
#pragma unroll
    for (int k = 0; k < 8; ++k) {
      const uint2 w = ((const uint2*)(ybuf + ((size_t)row * 8 + k) * DM))[lane + i * 64];
      a.x += bflo(w.x); a.y += bfhi(w.x); a.z += bflo(w.y); a.w += bfhi(w.y);
    }
    v[i] = a; s += a.x + a.y + a.z + a.w;
  }
  const float mu = wave_sum(s) * (1.f / DM);
  float q = 0.f;
#pragma unroll
  for (int i = 0; i < 4; ++i) { const float a = v[i].x - mu, b = v[i].y - mu, c = v[i].z - mu, d = v[i].w - mu; q += a * a + b * b + c * c + d * d; }
  const float rs = rsqrtf(wave_sum(q) * (1.f / DM) + LN_EPS);
#pragma unroll
  for (int i = 0; i < 4; ++i) {
    const float4 gg = ((const float4*)gam)[lane + i * 64], bb = ((const float4*)bet)[lane + i * 64];
    float4 r;
    r.x = (v[i].x - mu) * rs * gg.x + bb.x; r.y = (v[i].y - mu) * rs * gg.y + bb.y;
    r.z = (v[i].z - mu) * rs * gg.z + bb.z; r.w = (v[i].w - mu) * rs * gg.w + bb.w;
    p[lane + i * 64] = r;
  }
}

#define XB_TMO      128
#define XB_XCNT(j)  (256  + 64 * (j))
#define XB_XSUB(j)  (1280 + 64 * (j))
#define XB_XGEN(j)  (2304 + 64 * (j))
#define XB_TOP      3328
#define XB_TOPGEN   3392
#define XCD_BAR_WORDS 3456
#define XB_SPIN_CAP (1u << 22)
#define LAS __attribute__((address_space(3)))
__device__ __forceinline__ unsigned xb_ld(unsigned* p)              { return __hip_atomic_load(p, __ATOMIC_RELAXED, __HIP_MEMORY_SCOPE_AGENT); }
__device__ __forceinline__ unsigned xb_add(unsigned* p, unsigned v) { return __hip_atomic_fetch_add(p, v, __ATOMIC_RELAXED, __HIP_MEMORY_SCOPE_AGENT); }
__device__ __forceinline__ unsigned xb_xcc_id() { return (unsigned)__builtin_amdgcn_s_getreg((3 << 11) | 20) & 0xFu; }
#define XB_SPIN(cond, bar) do { unsigned _sp = 0; while (cond) { __builtin_amdgcn_s_sleep(1); \
    if ((++_sp & 255u) == 0u) { if (xb_ld(&(bar)[XB_TMO])) break; if (_sp > XB_SPIN_CAP) { atomicAdd(&(bar)[XB_TMO], 1u); break; } } } } while (0)
struct XcdBarrier { unsigned* bar; unsigned x; volatile LAS unsigned* st; };
__device__ __forceinline__ XcdBarrier xcd_barrier_post(unsigned* bar, volatile LAS unsigned* st) {
  XcdBarrier b; b.bar = bar; b.x = xb_xcc_id(); b.st = st;
  if (threadIdx.x == 0) (void)xb_add(&bar[XB_XCNT(b.x)], 1u);
  return b;
}
__device__ __forceinline__ void xcd_barrier_complete(unsigned* bar, unsigned x, unsigned& nloc, unsigned& nx) {
  const unsigned G = gridDim.x * gridDim.y * gridDim.z;
  unsigned sum, cnt, mine, sp = 0u;
  for (;;) {
    sum = 0u; cnt = 0u; mine = 0u;
#pragma unroll
    for (unsigned j = 0; j < 16; ++j) { const unsigned c = xb_ld(&bar[XB_XCNT(j)]); sum += c; cnt += (c > 0u) ? 1u : 0u; mine = (j == x) ? c : mine; }
    if (sum == G) break;
    __builtin_amdgcn_s_sleep(1);
    if ((++sp & 255u) == 0u) { if (xb_ld(&bar[XB_TMO])) break; if (sp > XB_SPIN_CAP) { atomicAdd(&bar[XB_TMO], 1u); break; } }
  }
  nloc = mine > 0u ? mine : 1u; nx = cnt > 0u ? cnt : 1u;
}
__device__ __forceinline__ void xcd_barrier(const XcdBarrier& b) {
  asm volatile("s_waitcnt vmcnt(0)" ::: "memory");
  __syncthreads();
  if (threadIdx.x == 0) {
    unsigned* bar = b.bar;
    __builtin_amdgcn_s_waitcnt(0);
    unsigned nloc = b.st[0], nx = b.st[1];
    if (nloc == 0u) { xcd_barrier_complete(bar, b.x, nloc, nx); b.st[0] = nloc; b.st[1] = nx; }
    const unsigned old = xb_add(&bar[XB_XSUB(b.x)], 1u);
    const unsigned gen = old / nloc;
    if (old + 1u == (gen + 1u) * nloc) {
      __builtin_amdgcn_fence(__ATOMIC_RELEASE, "agent");
      asm volatile("s_waitcnt vmcnt(0)" ::: "memory");
      const unsigned og = xb_add(&bar[XB_TOP], 1u);
      const unsigned tg = og / nx;
      if (og + 1u == (tg + 1u) * nx) xb_add(&bar[XB_TOPGEN], 1u);
      else XB_SPIN(xb_ld(&bar[XB_TOPGEN]) == tg, bar);
      __builtin_amdgcn_fence(__ATOMIC_ACQUIRE, "agent");
      xb_add(&bar[XB_XGEN(b.x)], 1u);
      asm volatile("s_waitcnt vmcnt(0)" ::: "memory");
    } else {
      XB_SPIN(xb_ld(&bar[XB_XGEN(b.x)]) == gen, bar);
      __builtin_amdgcn_fence(__ATOMIC_ACQUIRE, "agent");
      asm volatile("s_waitcnt vmcnt(0)" ::: "memory");
    }
  }
  __syncthreads();
}

__global__ void __launch_bounds__(256, 2) mega(Params P) {
  __shared__ __attribute__((aligned(16))) unsigned char smem[SMEM_BYTES];
  const int bid = blockIdx.x, nblk = gridDim.x;
#define xin (P.in[0])
#define w_in (P.in[1])
#define conv_w (P.in[2])
#define a_log (P.in[3])
#define dt_bias (P.in[4])
#define dn_norm_g (P.in[5])
#define sinks (P.in[6])
#define w_out (P.in[7])
#define ln1_g (P.in[8])
#define ln1_b (P.in[9])
#define router_w (P.in[10])
#define router_bias (P.in[11])
#define w_gate (P.in[12])
#define w_up (P.in[13])
#define w_down (P.in[14])
#define sw_gate (P.in[15])
#define sw_up (P.in[16])
#define sw_down (P.in[17])
#define ln2_g (P.in[18])
#define ln2_b (P.in[19])
#define outp (P.out)
#define x1bf ((bf16_t*)(P.ws + WS_X1BF))
#define logits ((float*)(P.ws + WS_LOGIT))
#define list ((int*)(P.ws + WS_LIST))
#define gates ((float*)(P.ws + WS_GATES))
#define cnt ((int*)(P.ws + WS_CTRL))
#define barw ((unsigned*)(P.ws + WS_CTRL + 4096))
#define mixed ((bf16_t*)(P.ws + WS_MIXED))
#define proj ((bf16_t*)(P.ws + WS_PROJ))
#define ba ((float*)(P.ws + WS_BA))
#define QD ((bf16_t*)(P.ws + WS_QD))
#define W0N ((bf16_t*)(P.ws + WS_W0N))
#define KTT ((bf16_t*)(P.ws + WS_KTT))
#define RV ((bf16_t*)(P.ws + WS_RV))
#define TM ((bf16_t*)(P.ws + WS_TM))
#define ATT ((bf16_t*)(P.ws + WS_ATT))
#define GL ((float*)(P.ws + WS_GL))
#define obuf ((float*)(P.ws + WS_O))
#define VTb ((bf16_t*)(P.ws + WS_VT))
#define XBF ((bf16_t*)(P.ws + WS_XBF))
#define WTIN ((bf16_t*)(P.ws + WS_WTIN))
#define WTOUT ((bf16_t*)(P.ws + WS_WTOUT))
#define WTR ((bf16_t*)(P.ws + WS_WTR))
#define WTG ((bf16_t*)(P.ws + WS_WTG))
#define WTU ((bf16_t*)(P.ws + WS_WTU))
#define WTD ((bf16_t*)(P.ws + WS_WTD))
#define WTSG ((bf16_t*)(P.ws + WS_WTSG))
#define WTSU ((bf16_t*)(P.ws + WS_WTSU))
#define WTSD ((bf16_t*)(P.ws + WS_WTSD))
#define ybuf ((bf16_t*)(P.ws + WS_YBUF))
  {
    volatile LAS unsigned* st0 = (volatile LAS unsigned*)(smem + SM_MISC + 4080);
    if (threadIdx.x == 0) { st0[0] = 0u; st0[1] = 0u; }
    __syncthreads();
  }
  const int xcd = bid & 7, xloc = bid >> 3, xnl = nblk >> 3;
  XcdBarrier xb = xcd_barrier_post(barw, (volatile LAS unsigned*)(smem + SM_MISC + 4080));
  for (int it = bid; it < NTOK / 4; it += nblk) ph_cvt_x(it, xin, XBF);
  for (int it = bid; it < 16 * 46 + 16 * 16 + 16 * 4; it += nblk) {
    if (it < 16 * 46) ph_cvt_wt(smem, it % 16, it / 16, w_in, DM, INC, WTIN);
    else if (it < 16 * 46 + 256) { const int j = it - 16 * 46; ph_cvt_wt(smem, j % 16, j / 16, w_out, DM, DM, WTOUT); }
    else { const int j = it - 16 * 46 - 256; ph_cvt_wt(smem, j % 16, j / 16, router_w, DM, NEXP, WTR); }
  }
  for (int it = bid; it < 192; it += nblk) {
    if (it < 64) ph_cvt_wt(smem, it % 16, it / 16, sw_gate, DM, EFF, WTSG);
    else if (it < 128) ph_cvt_wt(smem, (it - 64) % 16, (it - 64) / 16, sw_up, DM, EFF, WTSU);
    else ph_cvt_wt(smem, (it - 128) % 4, (it - 128) / 4, sw_down, EFF, DM, WTSD, true);
  }
  xcd_barrier(xb);
  for (int l = xloc; l < 64; l += xnl) ph_proj(smem, xcd, l, XBF, WTIN, proj, ba, VTb);
  xcd_barrier(xb);
  for (int it = bid; it < 2048; it += nblk) ph_dnchunk(smem, it, proj, ba, conv_w, a_log, dt_bias, QD, W0N, KTT, RV, TM, ATT, GL);
  for (int it = bid; it < 512; it += nblk) ph_swa(smem, it, proj, VTb, sinks, mixed);
  xcd_barrier(xb);
  if (bid < 64 || nblk <= 64) {
    for (int it = bid; it < 64; it += nblk) ph_dnscan(smem, it, QD, W0N, KTT, RV, TM, ATT, GL, obuf);
  }
  if (bid >= 64 || nblk <= 64) {
    const int tid = TIDX, lane = tid & 63, wv = tid >> 6;
    float* tile = (float*)(smem + wv * 16640);
    const int nconv = (nblk > 64) ? (nblk - 64) : nblk, cb = (nblk > 64) ? (bid - 64) : bid;
    const int step = nconv * 4, total = 256 * 192;
    int it = cb * 4 + wv;
    f32x4 vc[16], vn[16];
    CvtTile tc = cvt_decode(it < total ? it : 0, lane, w_gate, w_up, w_down, WTG, WTU, WTD);
    if (it < total) cvt_load(tc, vc);
    while (it < total) {
      const int itn = it + step;
      CvtTile tn = cvt_decode(itn < total ? itn : 0, lane, w_gate, w_up, w_down, WTG, WTU, WTD);
      if (itn < total) cvt_load(tn, vn);
      cvt_store(tile, lane, tc, vc);
#pragma unroll
      for (int i = 0; i < 16; ++i) vc[i] = vn[i];
      tc = tn; it = itn;
    }
  }
  xcd_barrier(xb);
  for (int it = bid; it < NTOK / 4; it += nblk) ph_dn_post(it, obuf, proj, dn_norm_g, mixed);
  xcd_barrier(xb);
  for (int l = xloc; l < 64; l += xnl) ph_wout(smem, xcd, l, mixed, WTOUT, xin, outp);
  xcd_barrier(xb);
  for (int it = bid; it < NTOK / 4; it += nblk) ph_ln1(it, outp, ln1_g, ln1_b, x1bf);
  xcd_barrier(xb);
  for (int i = xloc; i < 32 * 2; i += xnl) ph_router(smem, (xcd * 32 + i / 2) * 2 + i % 2, x1bf, WTR, logits);
  xcd_barrier(xb);
  for (int it = bid; it < NTOK / 4; it += nblk) ph_route(it, logits, router_bias, cnt, list, gates);
  xcd_barrier(xb);
  int* sscan = (int*)(smem + SM_MISC);
  moe_build_prefix(cnt, sscan);
  const int ntile = sscan[32 * xcd + 31] - (xcd ? sscan[32 * xcd - 1] : 0) + NTOK / 128 / 8;
  for (int it = xloc; it < ntile; it += xnl) {
    int e, rt; moe_locate(sscan, xcd, it, e, rt);
    ph_moe(smem, e, rt, x1bf, cnt, list, gates, (e < 256) ? WTG + (size_t)e * EFF * DM : WTSG, (e < 256) ? WTU + (size_t)e * EFF * DM : WTSU,
           (e < 256) ? WTD + (size_t)e * DM * EFF : WTSD, ybuf, outp, (bf16_t*)(P.ws + WS_DUMMY));
  }
  xcd_barrier(xb);
  for (int it = bid; it < NTOK / 4; it += nblk) ph_final(it, outp, ybuf, ln2_g, ln2_b);
}

#undef xin
#undef w_in
#undef conv_w
#undef a_log
#undef dt_bias
#undef dn_norm_g
#undef sinks
#undef w_out
#undef ln1_g
#undef ln1_b
#undef router_w
#undef router_bias
#undef w_gate
#undef w_up
#undef w_down
#undef sw_gate
#undef sw_up
#undef sw_down
#undef ln2_g
#undef ln2_b
#undef outp
#undef x1bf
#undef logits
#undef list
#undef gates
#undef cnt
#undef mixed
#undef proj
#undef ba
#undef QD
#undef W0N
#undef KTT
#undef RV
#undef TM
#undef ATT
#undef GL
#undef obuf
#undef ybuf
#undef VTb
#undef XBF
#undef WTIN
#undef WTOUT
#undef WTR
#undef WTG
#undef WTU
#undef WTD
#undef WTSG
#undef WTSU
#undef WTSD
#undef barw

extern "C" void kernel_launch(void* const* d_in, const int* in_sizes, int n_in, void* d_out, int out_size, void* d_ws, size_t ws_size, hipStream_t stream) {
  static int grid_blocks = 0;
  if (!grid_blocks) {
    int dev = 0, cus = 0, per_cu = 0;
    (void)hipGetDevice(&dev);
    (void)hipDeviceGetAttribute(&cus, hipDeviceAttributeMultiprocessorCount, dev);
    (void)hipOccupancyMaxActiveBlocksPerMultiprocessor(&per_cu, mega, 256, 0);
    if (per_cu > 2) per_cu = 2;
    if (per_cu < 1) per_cu = 1;
    grid_blocks = cus * per_cu;
  }
  Params p{};
  for (int i = 0; i < 20; ++i) p.in[i] = (const float*)d_in[i];
  p.out = (float*)d_out; p.ws = (char*)d_ws;
  (void)hipMemsetAsync((char*)d_ws + WS_CTRL, 0, 4096 + XCD_BAR_WORDS * 4, stream);
  void* args[] = {&p};
  hipError_t e = hipLaunchCooperativeKernel((void*)mega, dim3(grid_blocks), dim3(256), args, 0, stream);
  if (e != hipSuccess) fprintf(stderr, "cooperative launch failed: %s (grid %d)\n", hipGetErrorString(e), grid_blocks);
}
```

```cpp
#include <hip/hip_runtime.h>
#include <hip/hip_cooperative_groups.h>
#include <stdint.h>
#include <stdio.h>
namespace cg = cooperative_groups;

typedef __attribute__((ext_vector_type(8))) short bf16x8;
typedef __attribute__((ext_vector_type(4))) float f32x4;
typedef unsigned short bf16_t;
typedef __attribute__((ext_vector_type(4))) unsigned u32x4;
typedef __attribute__((ext_vector_type(2))) unsigned u32x2;

constexpr int NTOK = 32768, SEQ = 4096, DM = 1024;
constexpr int INC = 2824, PROJW = 2816;
constexpr int OFF_DQ = 0, OFF_DK = 512, OFF_DV = 1024, OFF_SQ = 1536, OFF_SK = 2048, OFF_SV = 2176, OFF_Z = 2304;
constexpr int NEXP = 256, TOPK = 8, EFF = 256;
constexpr int NA = NTOK * TOPK;
constexpr int CAP = NTOK;
constexpr float ALPHA = 1.189207115002721f;
constexpr float LN_EPS = 1e-5f, RMS_EPS = 1e-6f, L2_EPS = 1e-6f;

constexpr size_t MiB = 1024ull * 1024ull;
constexpr size_t WS_WTD = 0;
constexpr size_t WS_WTG = 128 * MiB;
constexpr size_t WS_WTU = 256 * MiB;
constexpr size_t WS_YBUF = 384 * MiB;
constexpr size_t WS_LOGIT = 384 * MiB;
constexpr size_t WS_X1BF = 896 * MiB;
constexpr size_t WS_LIST = 960 * MiB;
constexpr size_t WS_GATES = 992 * MiB;
constexpr size_t WS_CTRL = 993 * MiB;
constexpr size_t WS_WTIN = 994 * MiB;
constexpr size_t WS_WTOUT = 1000 * MiB;
constexpr size_t WS_WTR = 1002 * MiB;
constexpr size_t WS_WTSG = 1003 * MiB;
constexpr size_t WS_WTSU = WS_WTSG + 512 * 1024;
constexpr size_t WS_WTSD = 1004 * MiB;
constexpr size_t WS_DUMMY = 1005 * MiB;
constexpr size_t WS_PROJ = 384 * MiB;
constexpr size_t WS_BA = 560 * MiB;
constexpr size_t WS_QD = 561 * MiB;
constexpr size_t WS_W0N = 593 * MiB;
constexpr size_t WS_KTT = 625 * MiB;
constexpr size_t WS_RV = 657 * MiB;
constexpr size_t WS_TM = 689 * MiB;
constexpr size_t WS_ATT = 705 * MiB;
constexpr size_t WS_GL = 721 * MiB;
constexpr size_t WS_O = 722 * MiB;
constexpr size_t WS_VT = 786 * MiB;
constexpr size_t WS_MIXED = 794 * MiB;
constexpr size_t WS_XBF = 640 * MiB;

__device__ __forceinline__ int opaque_tid() { int t = threadIdx.x; asm volatile("" : "+v"(t)); return t; }
#define TIDX opaque_tid()
typedef __attribute__((ext_vector_type(2))) __bf16 hwbf16x2;
typedef __attribute__((ext_vector_type(2))) float hwf32x2;
__device__ __forceinline__ unsigned pack2(float lo, float hi) {
  hwf32x2 f = {lo, hi};
  return __builtin_bit_cast(unsigned, __builtin_convertvector(f, hwbf16x2));
}
__device__ __forceinline__ unsigned f2bf(float f) { return pack2(f, 0.f) & 0xffffu; }
__device__ __forceinline__ float bf2f(unsigned h) { return __uint_as_float(h << 16); }
__device__ __forceinline__ float bflo(unsigned w) { return __uint_as_float(w << 16); }
__device__ __forceinline__ float bfhi(unsigned w) { return __uint_as_float(w & 0xffff0000u); }
__device__ __forceinline__ float siluf(float x) { return x / (1.f + __expf(-x)); }
__device__ __forceinline__ float sigmoidf(float x) { return 1.f / (1.f + __expf(-x)); }
__device__ __forceinline__ float wave_sum(float v) {
#pragma unroll
  for (int o = 32; o > 0; o >>= 1) v += __shfl_xor(v, o);
  return v;
}

template <int SEGDIV>
struct LdRowBF16T {
  const char* p[4]; size_t seghi, seglo; int tid16;
  template <class F> __device__ __forceinline__ void init(F rowptr, size_t hi, size_t lo = 0) {
    const int tid = TIDX; const int slot = tid & 7, row0 = tid >> 3; seghi = hi; seglo = lo; tid16 = tid * 16;
#pragma unroll
    for (int i = 0; i < 4; ++i) p[i] = (const char*)rowptr(row0 + i * 32) + ((slot ^ (row0 & 7)) << 4);
  }
  __device__ __forceinline__ void issue(int seg, int kk, unsigned char* lds) {
    const size_t off = (size_t)(seg / SEGDIV) * seghi + (size_t)(seg % SEGDIV) * seglo + (size_t)kk * 128;
#pragma unroll
    for (int i = 0; i < 4; ++i)
      __builtin_amdgcn_global_load_lds((const unsigned*)(p[i] + off), (__attribute__((address_space(3))) unsigned*)(lds + tid16 + i * 4096), 16, 0, 0);
  }
};
typedef LdRowBF16T<1> LdRowBF16;
struct LdColF32 {
  const char* p; size_t ldb, segb; f32x4 r[2][8]; int n4, kg;
  __device__ __forceinline__ void init(const float* colptr, size_t ld, size_t seg_bytes) {
    const int tid = TIDX; n4 = tid & 31; kg = tid >> 5; ldb = ld * 4; segb = seg_bytes;
    p = (const char*)colptr + (size_t)(kg * 8) * ldb;
  }
  template <int S> __device__ __forceinline__ void load(int seg, int kk) {
#pragma unroll
    for (int j = 0; j < 8; ++j) r[S][j] = *(const f32x4*)(p + (size_t)seg * segb + (size_t)(kk * 64 + j) * ldb);
  }
  template <int S> __device__ __forceinline__ void store(unsigned char* s) {
#pragma unroll
    for (int i = 0; i < 4; ++i) {
      const int row = n4 * 4 + i; u32x4 w;
      w[0] = pack2(r[S][0][i], r[S][1][i]); w[1] = pack2(r[S][2][i], r[S][3][i]); w[2] = pack2(r[S][4][i], r[S][5][i]); w[3] = pack2(r[S][6][i], r[S][7][i]);
      *(u32x4*)(s + row * 128 + ((kg ^ (row & 7)) << 4)) = w;
    }
  }
};

__device__ __forceinline__ void gemm_kstep(const unsigned char* sA, const unsigned char* sB, f32x4 (&acc)[4][4], int wr, int wc, int fr, int fq) {
#pragma unroll
  for (int ks = 0; ks < 2; ++ks) {
    bf16x8 a[4], b[4];
#pragma unroll
    for (int m = 0; m < 4; ++m) {
      const int row = wr * 64 + m * 16 + fr;
      a[m] = *(const bf16x8*)(sA + row * 128 + (((ks * 4 + fq) ^ (row & 7)) << 4));
    }
#pragma unroll
    for (int n = 0; n < 4; ++n) {
      const int row = wc * 64 + n * 16 + fr;
      b[n] = *(const bf16x8*)(sB + row * 128 + (((ks * 4 + fq) ^ (row & 7)) << 4));
    }
    __builtin_amdgcn_s_setprio(1);
#pragma unroll
    for (int m = 0; m < 4; ++m)
#pragma unroll
      for (int n = 0; n < 4; ++n) acc[m][n] = __builtin_amdgcn_mfma_f32_16x16x32_bf16(b[n], a[m], acc[m][n], 0, 0, 0);
    __builtin_amdgcn_s_setprio(0);
  }
}
template <int KPER, class AL, class BL, class Epi>
__device__ __forceinline__ void gemm_stream(unsigned char* smem, AL& al, BL& bl, int nseg, Epi epi) {
  const int tid = TIDX, lane = tid & 63, wid = tid >> 6, wr = wid >> 1, wc = wid & 1, fr = lane & 15, fq = lane >> 4;
  const int total = nseg * KPER;
  f32x4 acc[4][4];
  al.issue(0, 0, smem); bl.issue(0, 0, smem + 16384);
  asm volatile("s_waitcnt vmcnt(0)" ::: "memory");
  __syncthreads();
  for (int j = 0; j < total; ++j) {
    unsigned char* cur = smem + (j & 1) * 32768; unsigned char* nxt = smem + ((j & 1) ^ 1) * 32768;
    if (j + 1 < total) { al.issue((j + 1) / KPER, (j + 1) % KPER, nxt); bl.issue((j + 1) / KPER, (j + 1) % KPER, nxt + 16384); }
    if (j % KPER == 0) {
#pragma unroll
      for (int m = 0; m < 4; ++m)
#pragma unroll
        for (int n = 0; n < 4; ++n) acc[m][n] = (f32x4){0.f, 0.f, 0.f, 0.f};
    }
    gemm_kstep(cur, cur + 16384, acc, wr, wc, fr, fq);
    asm volatile("s_waitcnt vmcnt(0)" ::: "memory");
    __syncthreads();
    if ((j + 1) % KPER == 0) epi((j + 1) / KPER - 1, acc, cur);
  }
}

template <class RowDst>
__device__ __forceinline__ void store_tile_bf16(unsigned char* fbuf, const f32x4 (&acc)[4][4], RowDst rowdst) {
  const int tid = TIDX, lane = tid & 63, wid = tid >> 6, wr = wid >> 1, wc = wid & 1, fr = lane & 15, fq = lane >> 4;
#pragma unroll
  for (int m = 0; m < 4; ++m) {
    const int row = wr * 64 + m * 16 + fr;
#pragma unroll
    for (int n = 0; n < 4; ++n) {
      const int col = wc * 64 + n * 16 + fq * 4;
      u32x2 w; w[0] = pack2(acc[m][n][0], acc[m][n][1]); w[1] = pack2(acc[m][n][2], acc[m][n][3]);
      *(u32x2*)(fbuf + row * 256 + (((col >> 3) ^ (row & 15)) << 4) + ((col >> 2) & 1) * 8) = w;
    }
  }
  __syncthreads();
#pragma unroll
  for (int i = 0; i < 8; ++i) {
    const int q = tid + 256 * i, row = q >> 4, ch = q & 15;
    *(u32x4*)(rowdst(row) + ch * 8) = *(const u32x4*)(fbuf + row * 256 + ((ch ^ (row & 15)) << 4));
  }
  __syncthreads();
}

template <class RowDst>
__device__ __forceinline__ void store_tile_bf16_T(unsigned char* fbuf, const f32x4 (&acc)[4][4], RowDst rowdst) {
  const int tid = TIDX, lane = tid & 63, wid = tid >> 6, wr = wid >> 1, wc = wid & 1, fr = lane & 15, fq = lane >> 4;
#pragma unroll
  for (int m = 0; m < 4; ++m) {
    const int t = wr * 64 + m * 16 + fr;
#pragma unroll
    for (int n = 0; n < 4; ++n)
#pragma unroll
      for (int r = 0; r < 4; ++r) {
        const int c = wc * 64 + n * 16 + fq * 4 + r;
        *(unsigned short*)(fbuf + c * 256 + ((((t >> 3) ^ (c & 15))) << 4) + (t & 7) * 2) = (unsigned short)f2bf(acc[m][n][r]);
      }
  }
  __syncthreads();
#pragma unroll
  for (int i = 0; i < 8; ++i) {
    const int q = tid + 256 * i, row = q >> 4, ch = q & 15;
    *(u32x4*)(rowdst(row) + ch * 8) = *(const u32x4*)(fbuf + row * 256 + ((ch ^ (row & 15)) << 4));
  }
  __syncthreads();
}

#define GEMM_IDS const int tid = TIDX, lane = tid & 63, wid = tid >> 6, wr = wid >> 1, wc = wid & 1, fr = lane & 15, fq = lane >> 4; (void)tid; (void)lane;

struct Params {
  const float* in[20];
  float* out;
  char* ws;
};

constexpr int SMEM_BYTES = 69632;
constexpr int SM_MISC = 65536;

__device__ __forceinline__ void ph_cvt_x(int item, const float* __restrict__ x, bf16_t* __restrict__ xbf) {
  const int tid = TIDX;
  const size_t base = (size_t)item * 4096 + (size_t)tid * 4;
#pragma unroll
  for (int i = 0; i < 4; ++i) {
    const f32x4 v = *(const f32x4*)(x + base + (size_t)i * 1024);
    u32x2 w; w[0] = pack2(v[0], v[1]); w[1] = pack2(v[2], v[3]);
    *(u32x2*)(xbf + base + (size_t)i * 1024) = w;
  }
}
__device__ __forceinline__ void ph_cvt_wt(unsigned char* smem, int kt, int nt, const float* __restrict__ W, int K, int N, bf16_t* __restrict__ WT, bool perm = false) {
  float* tile = (float*)smem;
  const int tid = TIDX;
  const int k0 = kt * 64, n0 = nt * 64;
  __syncthreads();
#pragma unroll
  for (int i = 0; i < 4; ++i) {
    const int k = (tid >> 4) + 16 * i, n = 4 * (tid & 15);
    f32x4 v = (f32x4){0.f, 0.f, 0.f, 0.f};
    if (n0 + n < N) v = *(const f32x4*)(W + (size_t)(k0 + k) * N + n0 + n);
    tile[k * 65 + n + 0] = v[0]; tile[k * 65 + n + 1] = v[1]; tile[k * 65 + n + 2] = v[2]; tile[k * 65 + n + 3] = v[3];
  }
  __syncthreads();
  const int n = tid >> 2, kq = tid & 3;
  u32x4 w0, w1;
#pragma unroll
  for (int j = 0; j < 4; ++j) {
    w0[j] = pack2(tile[(kq * 16 + 2 * j) * 65 + n], tile[(kq * 16 + 2 * j + 1) * 65 + n]);
    w1[j] = pack2(tile[(kq * 16 + 8 + 2 * j) * 65 + n], tile[(kq * 16 + 8 + 2 * j + 1) * 65 + n]);
  }
  if (!perm) {
    bf16_t* dst = WT + (size_t)(n0 + n) * K + k0 + kq * 16;
    *(u32x4*)dst = w0; *(u32x4*)(dst + 8) = w1;
  } else {
    const int blk = kq >> 1, hi = kq & 1;
    bf16_t* dst = WT + (size_t)(n0 + n) * K + k0 + blk * 32 + 4 * hi;
    u32x2 a; a[0] = w0[0]; a[1] = w0[1]; *(u32x2*)(dst + 0) = a;
    a[0] = w0[2]; a[1] = w0[3]; *(u32x2*)(dst + 8) = a;
    a[0] = w1[0]; a[1] = w1[1]; *(u32x2*)(dst + 16) = a;
    a[0] = w1[2]; a[1] = w1[3]; *(u32x2*)(dst + 24) = a;
  }
}

struct CvtTile { const float* src; bf16_t* dst; int ldn; int K; int perm; };
__device__ __forceinline__ CvtTile cvt_decode(int it, int lane, const float* __restrict__ w_gate, const float* __restrict__ w_up, const float* __restrict__ w_down,
                                              bf16_t* __restrict__ wtg, bf16_t* __restrict__ wtu, bf16_t* __restrict__ wtd) {
  const int e = it / 192, j = it % 192;
  const float* W; bf16_t* WT; int K, N, kt, nt;
  if (j < 64) { W = w_gate + (size_t)e * DM * EFF; WT = wtg + (size_t)e * EFF * DM; K = DM; N = EFF; nt = j & 3; kt = j >> 2; }
  else if (j < 128) { W = w_up + (size_t)e * DM * EFF; WT = wtu + (size_t)e * EFF * DM; K = DM; N = EFF; nt = (j - 64) & 3; kt = (j - 64) >> 2; }
  else { W = w_down + (size_t)e * EFF * DM; WT = wtd + (size_t)e * DM * EFF; K = EFF; N = DM; nt = (j - 128) & 15; kt = (j - 128) >> 4; }
  CvtTile t;
  t.src = W + (size_t)(kt * 64 + (lane >> 4)) * N + nt * 64 + 4 * (lane & 15);
  t.dst = WT + (size_t)(nt * 64) * K + kt * 64;
  t.ldn = 4 * N; t.K = K;
  t.perm = (j >= 128) ? 1 : 0;
  return t;
}
__device__ __forceinline__ void cvt_load(const CvtTile& t, f32x4 (&v)[16]) {
#pragma unroll
  for (int i = 0; i < 16; ++i) v[i] = *(const f32x4*)(t.src + (size_t)i * t.ldn);
}
__device__ __forceinline__ void cvt_store(float* tile  , int lane, const CvtTile& t, const f32x4 (&v)[16]) {
#pragma unroll
  for (int i = 0; i < 16; ++i) {
    float* p = tile + ((lane >> 4) + 4 * i) * 65 + 4 * (lane & 15);
    p[0] = v[i][0]; p[1] = v[i][1]; p[2] = v[i][2]; p[3] = v[i][3];
  }
  const int c = lane & 7;
  const int ka = t.perm ? (32 * (c >> 2) + 4 * (c & 3)) : (8 * c), kb = t.perm ? (ka + 16) : (ka + 4);
#pragma unroll
  for (int i = 0; i < 8; ++i) {
    const int n = (lane >> 3) + 8 * i;
    u32x4 w;
    w[0] = pack2(tile[(ka + 0) * 65 + n], tile[(ka + 1) * 65 + n]); w[1] = pack2(tile[(ka + 2) * 65 + n], tile[(ka + 3) * 65 + n]);
    w[2] = pack2(tile[(kb + 0) * 65 + n], tile[(kb + 1) * 65 + n]); w[3] = pack2(tile[(kb + 2) * 65 + n], tile[(kb + 3) * 65 + n]);
    *(u32x4*)(t.dst + (size_t)n * t.K + 8 * c) = w;
  }
}

__device__ __forceinline__ void ph_proj(unsigned char* smem, int xcd, int l, const bf16_t* __restrict__ xbf, const bf16_t* __restrict__ wt, bf16_t* __restrict__ proj, float* __restrict__ ba, bf16_t* __restrict__ vt) {
  const int mi = l >> 3, ni = l & 7;
  LdRowBF16T<3> al; al.init([&](int r) { return xbf + (size_t)((xcd * 32 + mi) * 128 + r) * DM; }, (size_t)8 * 128 * DM * 2, 0);
  LdRowBF16T<3> bl; bl.init([&](int r) { return wt + (size_t)(ni * 128 + r) * DM; }, 0, (size_t)8 * 128 * DM * 2);
  gemm_stream<16>(smem, al, bl, 12, [&](int seg, f32x4 (&acc)[4][4], unsigned char* fbuf) {
    GEMM_IDS
    const int nt = (seg % 3) * 8 + ni;
    if (nt < 23) {
      const int m0 = (xcd * 32 + (seg / 3) * 8 + mi) * 128, n0 = nt * 128;
      if (n0 + 128 <= PROJW) store_tile_bf16(fbuf, acc, [&](int r) { return proj + (size_t)(m0 + r) * PROJW + n0; });
      else
#pragma unroll
      for (int m = 0; m < 4; ++m)
#pragma unroll
        for (int n = 0; n < 4; ++n) {
          const int row = m0 + wr * 64 + m * 16 + fr, col = n0 + wc * 64 + n * 16 + fq * 4;
          if (col < PROJW) {
            u32x2 w; w[0] = pack2(acc[m][n][0], acc[m][n][1]); w[1] = pack2(acc[m][n][2], acc[m][n][3]);
            *(u32x2*)(proj + (size_t)row * PROJW + col) = w;
          } else if (col < INC) {
            *(f32x4*)(ba + (size_t)row * 8 + (col - PROJW)) = acc[m][n];
          }
        }
      if (n0 == OFF_SV) {
        const int bb = m0 / SEQ, t0_ = m0 % SEQ;
        store_tile_bf16_T(fbuf, acc, [&](int c) { return vt + ((size_t)(bb * 128 + c)) * SEQ + t0_; });
      }
    }
  });
}

__device__ __forceinline__ bf16x8 pack8(f32x4 a, f32x4 b) {
  union { bf16x8 v; unsigned u[4]; } x;
  x.u[0] = pack2(a[0], a[1]); x.u[1] = pack2(a[2], a[3]); x.u[2] = pack2(b[0], b[1]); x.u[3] = pack2(b[2], b[3]);
  return x.v;
}
__device__ __forceinline__ void ph_dnchunk(unsigned char* smem, int item, const bf16_t* __restrict__ proj, const float* __restrict__ ba, const float* __restrict__ conv_w,
                                           const float* __restrict__ a_log, const float* __restrict__ dt_bias,
                                           bf16_t* __restrict__ QD, bf16_t* __restrict__ W0N, bf16_t* __restrict__ KTT, bf16_t* __restrict__ RV,
                                           bf16_t* __restrict__ TM, bf16_t* __restrict__ ATT, float* __restrict__ GL) {
  const int tid = TIDX, lane = tid & 63, w = tid >> 6, fr = lane & 15, fq = lane >> 4;
  const int n = item & 63, h = (item >> 6) & 3, b = item >> 8;
  const int t0 = n * 64; const size_t row0 = (size_t)b * SEQ + t0;
  unsigned char* qs = smem; unsigned char* ks = smem + 16384; float* AT = (float*)(smem + 32768);
  const float scale = 0.08838834764831845f;
  float bL, gcL;
  {
    const float* bap = ba + (row0 + lane) * 8;
    bL = sigmoidf(bap[h]);
    const float xx = bap[4 + h] + dt_bias[h];
    const float sp = fmaxf(xx, 0.f) + log1pf(__expf(-fabsf(xx)));
    float gg = -__expf(a_log[h]) * sp;
#pragma unroll
    for (int o = 1; o < 64; o <<= 1) { const float v = __shfl_up(gg, o); if (lane >= o) gg += v; }
    gcL = gg;
  }
  {
    const int d = 2 * lane;
    float cw[3][4][2];
#pragma unroll
    for (int mx = 0; mx < 3; ++mx)
#pragma unroll
      for (int j = 0; j < 4; ++j) {
        const float2 c2 = *(const float2*)(conv_w + j * 1536 + mx * 512 + h * 128 + d);
        cw[mx][j][0] = c2.x; cw[mx][j][1] = c2.y;
      }
    const bf16_t* pbase = proj + (row0 + 16 * w) * PROJW + h * 128 + d;
    unsigned raw[3][19];
#pragma unroll
    for (int j = 0; j < 19; ++j) {
      const bool ok = (t0 + 16 * w - 3 + j) >= 0;
#pragma unroll
      for (int mx = 0; mx < 3; ++mx) {
        unsigned u = 0;
        if (ok) u = *(const unsigned*)(pbase + (ptrdiff_t)(j - 3) * PROJW + mx * 512);
        raw[mx][j] = u;
      }
    }
#pragma unroll
    for (int i = 0; i < 16; ++i) {
      float s[3][2];
#pragma unroll
      for (int mx = 0; mx < 3; ++mx) {
        float y0 = 0.f, y1 = 0.f;
#pragma unroll
        for (int j = 0; j < 4; ++j) { y0 += cw[mx][j][0] * bflo(raw[mx][i + j]); y1 += cw[mx][j][1] * bfhi(raw[mx][i + j]); }
        s[mx][0] = siluf(y0); s[mx][1] = siluf(y1);
      }
      const int row = 16 * w + i;
      const float rq = rsqrtf(wave_sum(s[0][0] * s[0][0] + s[0][1] * s[0][1]) + L2_EPS);
      const float rk = rsqrtf(wave_sum(s[1][0] * s[1][0] + s[1][1] * s[1][1]) + L2_EPS);
      const int off = row * 256 + ((((lane >> 2) ^ (row & 15))) << 4) + (lane & 3) * 4;
      *(unsigned*)(qs + off) = pack2(s[0][0] * rq, s[0][1] * rq);
      *(unsigned*)(ks + off) = pack2(s[1][0] * rk, s[1][1] * rk);
      const float bi = __shfl(bL, row);
      *(unsigned*)(RV + ((size_t)item * 64 + row) * 128 + d) = pack2(bi * s[2][0], bi * s[2][1]);
    }
  }
  __syncthreads();
  {
    f32x4 aKK[4], aQK[4];
#pragma unroll
    for (int nt = 0; nt < 4; ++nt) { aKK[nt] = (f32x4){0.f, 0.f, 0.f, 0.f}; aQK[nt] = (f32x4){0.f, 0.f, 0.f, 0.f}; }
#pragma unroll
    for (int k4 = 0; k4 < 4; ++k4) {
      const int arow = 16 * w + fr;
      const bf16x8 aq = *(const bf16x8*)(qs + arow * 256 + ((((k4 * 4 + fq) ^ (arow & 15))) << 4));
      const bf16x8 ak = *(const bf16x8*)(ks + arow * 256 + ((((k4 * 4 + fq) ^ (arow & 15))) << 4));
#pragma unroll
      for (int nt = 0; nt < 4; ++nt) {
        const int brow = 16 * nt + fr;
        const bf16x8 bk = *(const bf16x8*)(ks + brow * 256 + ((((k4 * 4 + fq) ^ (brow & 15))) << 4));
        aKK[nt] = __builtin_amdgcn_mfma_f32_16x16x32_bf16(ak, bk, aKK[nt], 0, 0, 0);
        aQK[nt] = __builtin_amdgcn_mfma_f32_16x16x32_bf16(bk, aq, aQK[nt], 0, 0, 0);
      }
    }
    float gci[4], bi[4];
#pragma unroll
    for (int r = 0; r < 4; ++r) { gci[r] = __shfl(gcL, 16 * w + 4 * fq + r); bi[r] = __shfl(bL, 16 * w + 4 * fq + r); }
    const float gci2 = __shfl(gcL, 16 * w + fr);
#pragma unroll
    for (int nt = 0; nt < 4; ++nt) {
      const int j = 16 * nt + fr;
      const float gcj = __shfl(gcL, j);
      float av[4], at[4];
#pragma unroll
      for (int r = 0; r < 4; ++r) {
        const int i = 16 * w + 4 * fq + r;
        const float dec = (j <= i) ? __expf(gci[r] - gcj) : 0.f;
        av[r] = (j < i) ? bi[r] * aKK[nt][r] * dec : 0.f;
        const int i2 = 16 * w + fr, j2 = 16 * nt + 4 * fq + r;
        const float gcj2 = __shfl(gcL, j2);
        const float dec2 = (j2 <= i2) ? __expf(gci2 - gcj2) : 0.f;
        at[r] = aQK[nt][r] * scale * dec2;
      }
      *(float4*)(AT + j * 68 + 16 * w + 4 * fq) = make_float4(av[0], av[1], av[2], av[3]);
      u32x2 wv; wv[0] = pack2(at[0], at[1]); wv[1] = pack2(at[2], at[3]);
      *(u32x2*)(ATT + ((size_t)item * 64 + 16 * w + fr) * 64 + 32 * (nt >> 1) + 8 * fq + 4 * (nt & 1)) = wv;
    }
  }
  __syncthreads();
  if (w == 0) {
    float Tr[64];
    int ln = lane; asm volatile("" : "+v"(ln));
#pragma unroll
    for (int j = 0; j < 64; ++j) Tr[j] = 0.f;
    f32x4 cur[16], nxt[16];
#pragma unroll
    for (int j4 = 0; j4 < 16; ++j4) nxt[j4] = (f32x4){0.f, 0.f, 0.f, 0.f};
#pragma unroll
    for (int j4 = 15; j4 >= 16; --j4) cur[j4] = *(const f32x4*)(AT + 63 * 68 + j4 * 4);
#pragma unroll
    for (int c = 63; c >= 0; --c) {
      if (c > 0) {
#pragma unroll
        for (int j4 = 15; j4 >= c / 4; --j4) nxt[j4] = *(const f32x4*)(AT + (c - 1) * 68 + j4 * 4);
      }
      float a0 = 0.f, a1 = 0.f, a2 = 0.f, a3 = 0.f;
#pragma unroll
      for (int j4 = 15; j4 >= (c + 1) / 4; --j4) {
        asm volatile("v_fmac_f32 %0, %1, %2" : "+v"(a0) : "v"(Tr[4 * j4 + 0]), "v"(cur[j4][0]));
        asm volatile("v_fmac_f32 %0, %1, %2" : "+v"(a1) : "v"(Tr[4 * j4 + 1]), "v"(cur[j4][1]));
        asm volatile("v_fmac_f32 %0, %1, %2" : "+v"(a2) : "v"(Tr[4 * j4 + 2]), "v"(cur[j4][2]));
        asm volatile("v_fmac_f32 %0, %1, %2" : "+v"(a3) : "v"(Tr[4 * j4 + 3]), "v"(cur[j4][3]));
      }
      Tr[c] = ((ln == c) ? 1.f : 0.f) - ((a0 + a1) + (a2 + a3));
#pragma unroll
      for (int j4 = 0; j4 < 16; ++j4) cur[j4] = nxt[j4];
    }
    u32x4* tp = (u32x4*)(TM + ((size_t)item * 64 + lane) * 64);
#pragma unroll
    for (int oc = 0; oc < 8; ++oc) {
      const int k0 = 32 * (oc >> 2) + 4 * (oc & 3);
      u32x4 v;
      v[0] = pack2(Tr[k0 + 0], Tr[k0 + 1]); v[1] = pack2(Tr[k0 + 2], Tr[k0 + 3]);
      v[2] = pack2(Tr[k0 + 16], Tr[k0 + 17]); v[3] = pack2(Tr[k0 + 18], Tr[k0 + 19]);
      tp[oc] = v;
    }
  } else {
    const float gclast = __shfl(gcL, 63);
    if (tid == 64) GL[item] = __expf(gclast);
#pragma unroll 1
    for (int it = 0; it < 16; ++it) {
      const int idx = (tid - 64) + it * 192;
      const int mtx = idx >> 10, rem = idx & 1023;
      if (mtx < 2) {
        const int i = rem >> 4, oc = rem & 15;
        const float gi = __shfl(gcL, i), bi = __shfl(bL, i);
        const float f = (mtx == 0) ? scale * __expf(gi) : -bi * __expf(gi);
        const unsigned char* st = (mtx == 0) ? qs : ks;
        const int d0 = 32 * (oc >> 2) + 4 * (oc & 3);
        const uint2 lo = *(const uint2*)(st + i * 256 + ((((d0 >> 3) ^ (i & 15))) << 4) + (d0 & 7) * 2);
        const uint2 hi = *(const uint2*)(st + i * 256 + (((((d0 + 16) >> 3) ^ (i & 15))) << 4) + (d0 & 7) * 2);
        u32x4 v;
        v[0] = pack2(bflo(lo.x) * f, bfhi(lo.x) * f); v[1] = pack2(bflo(lo.y) * f, bfhi(lo.y) * f);
        v[2] = pack2(bflo(hi.x) * f, bfhi(hi.x) * f); v[3] = pack2(bflo(hi.y) * f, bfhi(hi.y) * f);
        bf16_t* dst = ((mtx == 0) ? QD : W0N) + ((size_t)item * 64 + i) * 128 + 8 * oc;
        *(u32x4*)dst = v;
      } else {
        const int d = rem & 127, oc = rem >> 7;
        const int j0 = 32 * (oc >> 2) + 4 * (oc & 3);
        float val[8];
#pragma unroll
        for (int e = 0; e < 8; ++e) {
          const int j = j0 + (e & 3) + ((e >> 2) << 4);
          const float f = __expf(gclast - __shfl(gcL, j));
          const unsigned short raw = *(const unsigned short*)(ks + j * 256 + ((((d >> 3) ^ (j & 15))) << 4) + (d & 7) * 2);
          val[e] = bf2f(raw) * f;
        }
        u32x4 v;
        v[0] = pack2(val[0], val[1]); v[1] = pack2(val[2], val[3]); v[2] = pack2(val[4], val[5]); v[3] = pack2(val[6], val[7]);
        *(u32x4*)(KTT + ((size_t)item * 128 + d) * 64 + 8 * oc) = v;
      }
    }
  }
  __syncthreads();
}

__device__ __forceinline__ void ph_dnscan(unsigned char* smem, int item, const bf16_t* __restrict__ QDp, const bf16_t* __restrict__ W0Np, const bf16_t* __restrict__ KTTp,
                                          const bf16_t* __restrict__ RVp, const bf16_t* __restrict__ TMp, const bf16_t* __restrict__ ATTp, const float* __restrict__ GLp,
                                          float* __restrict__ op) {
  const int tid = TIDX, lane = tid & 63, w = tid >> 6, fr = lane & 15, fq = lane >> 4;
  const int bh = item >> 1, half = item & 1, b = bh >> 2, h = bh & 3;
  const int vcol0 = (half * 4 + w) * 16;
  unsigned char* sW0 = smem; unsigned char* sQD = smem + 16384; unsigned char* sKT = smem + 32768; unsigned char* sT = smem + 49152; unsigned char* sAT = smem + 57344;
  f32x4 S[8];
#pragma unroll
  for (int t = 0; t < 8; ++t) S[t] = (f32x4){0.f, 0.f, 0.f, 0.f};
  u32x4 pfA[8], pfB[8]; unsigned short rvp[16];
#define DN_LOAD_A(nn_) do { \
    const size_t ci = (size_t)bh * 64 + (nn_); \
    _Pragma("unroll") for (int i = 0; i < 4; ++i) pfA[i] = *(const u32x4*)((const char*)W0Np + ci * 16384 + (size_t)(tid + 256 * i) * 16); \
    _Pragma("unroll") for (int i = 0; i < 4; ++i) pfA[4 + i] = *(const u32x4*)((const char*)QDp + ci * 16384 + (size_t)(tid + 256 * i) * 16); \
    _Pragma("unroll") for (int mt = 0; mt < 4; ++mt) \
      _Pragma("unroll") for (int r = 0; r < 4; ++r) rvp[mt * 4 + r] = RVp[(ci * 64 + 16 * mt + 4 * fq + r) * 128 + vcol0 + fr]; \
  } while (0)
#define DN_STORE_A() do { \
    _Pragma("unroll") for (int i = 0; i < 4; ++i) { const int q = tid + 256 * i, row = q >> 4, ch = q & 15; *(u32x4*)(sW0 + row * 256 + ((ch ^ (row & 15)) << 4)) = pfA[i]; } \
    _Pragma("unroll") for (int i = 0; i < 4; ++i) { const int q = tid + 256 * i, row = q >> 4, ch = q & 15; *(u32x4*)(sQD + row * 256 + ((ch ^ (row & 15)) << 4)) = pfA[4 + i]; } \
  } while (0)
#define DN_LOAD_B(nn_) do { \
    const size_t ci = (size_t)bh * 64 + (nn_); \
    _Pragma("unroll") for (int i = 0; i < 4; ++i) pfB[i] = *(const u32x4*)((const char*)KTTp + ci * 16384 + (size_t)(tid + 256 * i) * 16); \
    _Pragma("unroll") for (int i = 0; i < 2; ++i) pfB[4 + i] = *(const u32x4*)((const char*)TMp + ci * 8192 + (size_t)(tid + 256 * i) * 16); \
    _Pragma("unroll") for (int i = 0; i < 2; ++i) pfB[6 + i] = *(const u32x4*)((const char*)ATTp + ci * 8192 + (size_t)(tid + 256 * i) * 16); \
  } while (0)
#define DN_STORE_B() do { \
    _Pragma("unroll") for (int i = 0; i < 4; ++i) { const int q = tid + 256 * i, row = q >> 3, ch = q & 7; *(u32x4*)(sKT + row * 128 + ((ch ^ (row & 7)) << 4)) = pfB[i]; } \
    _Pragma("unroll") for (int i = 0; i < 2; ++i) { const int q = tid + 256 * i, row = q >> 3, ch = q & 7; *(u32x4*)(sT + row * 128 + ((ch ^ (row & 7)) << 4)) = pfB[4 + i]; } \
    _Pragma("unroll") for (int i = 0; i < 2; ++i) { const int q = tid + 256 * i, row = q >> 3, ch = q & 7; *(u32x4*)(sAT + row * 128 + ((ch ^ (row & 7)) << 4)) = pfB[6 + i]; } \
  } while (0)
#define DN_ZINIT() do { _Pragma("unroll") for (int mt = 0; mt < 4; ++mt) Z[mt] = (f32x4){bf2f(rvp[mt * 4 + 0]), bf2f(rvp[mt * 4 + 1]), bf2f(rvp[mt * 4 + 2]), bf2f(rvp[mt * 4 + 3])}; } while (0)
  __syncthreads();
  f32x4 Z[4];
  DN_LOAD_A(0);
  DN_LOAD_B(0);
  DN_STORE_A();
  DN_ZINIT();
  DN_LOAD_A(1);
  for (int nn = 0; nn < 64; ++nn) {
    const float gl = GLp[(size_t)bh * 64 + nn];
    __syncthreads();
    bf16x8 Sb[4];
#pragma unroll
    for (int k4 = 0; k4 < 4; ++k4) Sb[k4] = pack8(S[2 * k4], S[2 * k4 + 1]);
    f32x4 O[4];
#pragma unroll
    for (int mt = 0; mt < 4; ++mt) {
      O[mt] = (f32x4){0.f, 0.f, 0.f, 0.f};
      const int row = 16 * mt + fr;
#pragma unroll
      for (int k4 = 0; k4 < 4; ++k4) {
        const int off = row * 256 + ((((k4 * 4 + fq) ^ fr)) << 4);
        const bf16x8 aw = *(const bf16x8*)(sW0 + off);
        const bf16x8 aq = *(const bf16x8*)(sQD + off);
        Z[mt] = __builtin_amdgcn_mfma_f32_16x16x32_bf16(aw, Sb[k4], Z[mt], 0, 0, 0);
        O[mt] = __builtin_amdgcn_mfma_f32_16x16x32_bf16(Sb[k4], aq, O[mt], 0, 0, 0);
      }
    }
    bf16x8 Zb[2];
    Zb[0] = pack8(Z[0], Z[1]); Zb[1] = pack8(Z[2], Z[3]);
    DN_STORE_B();
    if (nn + 1 < 64) DN_LOAD_B(nn + 1);
    __syncthreads();
    f32x4 Vn[4];
#pragma unroll
    for (int mt = 0; mt < 4; ++mt) {
      Vn[mt] = (f32x4){0.f, 0.f, 0.f, 0.f};
      const int row = 16 * mt + fr;
#pragma unroll
      for (int s = 0; s < 2; ++s) {
        if (s <= (mt >> 1)) {
          const bf16x8 at = *(const bf16x8*)(sT + row * 128 + ((((s * 4 + fq) ^ (row & 7))) << 4));
          Vn[mt] = __builtin_amdgcn_mfma_f32_16x16x32_bf16(at, Zb[s], Vn[mt], 0, 0, 0);
        }
      }
    }
    bf16x8 Vb[2];
    Vb[0] = pack8(Vn[0], Vn[1]); Vb[1] = pack8(Vn[2], Vn[3]);
#pragma unroll
    for (int mt = 0; mt < 4; ++mt) {
      const int row = 16 * mt + fr;
#pragma unroll
      for (int s = 0; s < 2; ++s) {
        if (s <= (mt >> 1)) {
          const bf16x8 aa = *(const bf16x8*)(sAT + row * 128 + ((((s * 4 + fq) ^ (row & 7))) << 4));
          O[mt] = __builtin_amdgcn_mfma_f32_16x16x32_bf16(Vb[s], aa, O[mt], 0, 0, 0);
        }
      }
      *(f32x4*)(op + ((size_t)b * SEQ + nn * 64 + 16 * mt + fr) * 512 + h * 128 + vcol0 + 4 * fq) = O[mt];
    }
#pragma unroll
    for (int t = 0; t < 8; ++t) {
      S[t] = S[t] * gl;
      const int row = 16 * t + fr;
#pragma unroll
      for (int s = 0; s < 2; ++s) {
        const bf16x8 ak = *(const bf16x8*)(sKT + row * 128 + ((((s * 4 + fq) ^ (row & 7))) << 4));
        S[t] = __builtin_amdgcn_mfma_f32_16x16x32_bf16(ak, Vb[s], S[t], 0, 0, 0);
      }
    }
    if (nn + 1 < 64) {
      DN_STORE_A();
      DN_ZINIT();
      if (nn + 2 < 64) DN_LOAD_A(nn + 2);
    }
  }
  __syncthreads();
#undef DN_ZINIT
#undef DN_LOAD_A
#undef DN_STORE_A
#undef DN_LOAD_B
#undef DN_STORE_B
}

__device__ __forceinline__ void ph_dn_post(int item, const float* __restrict__ o, const bf16_t* __restrict__ proj, const float* __restrict__ dn_norm_g, bf16_t* __restrict__ mixed) {
  const int tid = TIDX, h = tid >> 6, lane = tid & 63;
  const float2 g2 = *(const float2*)(dn_norm_g + 2 * lane);
  float2 ov[4]; unsigned zv[4];
#pragma unroll
  for (int i = 0; i < 4; ++i) {
    const size_t n = (size_t)item * 4 + i;
    ov[i] = *(const float2*)(o + n * 512 + h * 128 + 2 * lane);
    zv[i] = *(const unsigned*)(proj + n * PROJW + OFF_Z + h * 128 + 2 * lane);
  }
#pragma unroll
  for (int i = 0; i < 4; ++i) {
    const size_t n = (size_t)item * 4 + i;
    const float ss = wave_sum(ov[i].x * ov[i].x + ov[i].y * ov[i].y);
    const float rn = rsqrtf(ss * (1.f / 128.f) + RMS_EPS);
    *(unsigned*)(mixed + n * DM + h * 128 + 2 * lane) = pack2(ov[i].x * rn * g2.x * siluf(bflo(zv[i])), ov[i].y * rn * g2.y * siluf(bfhi(zv[i])));
  }
}

__device__ __forceinline__ void ph_swa(unsigned char* smem, int item, const bf16_t* __restrict__ proj, const bf16_t* __restrict__ vt, const float* __restrict__ sinks, bf16_t* __restrict__ mixed) {
  const int tid = TIDX, lane = tid & 63, w = tid >> 6, fr = lane & 15, fq = lane >> 4;
  const int qb = item & 31, kvh = (item >> 5) & 1, b = item >> 6;
  const int t0 = qb * 128;
  const size_t rowb = (size_t)b * SEQ;
  unsigned char* sK = smem;
  unsigned char* sV = smem + 32768;
  __syncthreads();
#pragma unroll
  for (int i = 0; i < 8; ++i) {
    const int q = tid + 256 * i, row = q >> 3, ch = q & 7;
    const int pos = t0 - 128 + row;
    u32x4 v = (u32x4){0u, 0u, 0u, 0u};
    if (pos >= 0) v = *(const u32x4*)(proj + (rowb + pos) * PROJW + OFF_SK + kvh * 64 + ch * 8);
    *(u32x4*)(sK + row * 128 + ((ch ^ (row & 7)) << 4)) = v;
  }
#pragma unroll
  for (int i = 0; i < 8; ++i) {
    const int q = tid + 256 * i, row = q >> 5, ch = q & 31;
    const int pos = t0 - 128 + ch * 8;
    u32x4 v = (u32x4){0u, 0u, 0u, 0u};
    if (pos >= 0) v = *(const u32x4*)(vt + ((size_t)(b * 128 + kvh * 64 + row)) * SEQ + pos);
    *(u32x4*)(sV + row * 512 + ((ch ^ (row & 15)) << 4)) = v;
  }
  __syncthreads();
  const int head = kvh * 4 + w;
  const float slope = exp2f(-(float)(head + 1));
  const float sink = sinks[head];
  const bf16_t* qp0 = proj + (rowb + t0 + fr) * PROJW + OFF_SQ + head * 64 + fq * 8;
  bf16x8 qn0 = *(const bf16x8*)(qp0), qn1 = *(const bf16x8*)(qp0 + 32);
#pragma unroll 1
  for (int qt = 0; qt < 8; ++qt) {
    const bf16x8 qf0 = qn0, qf1 = qn1;
    if (qt < 7) { const bf16_t* qp = qp0 + (size_t)(qt + 1) * 16 * PROJW; qn0 = *(const bf16x8*)(qp); qn1 = *(const bf16x8*)(qp + 32); }
    const int kp0 = qt >> 1;
    f32x4 st[10];
#pragma unroll
    for (int kt = 0; kt < 10; ++kt) {
      const int krow = (2 * kp0 + kt) * 16 + fr;
      st[kt] = (f32x4){0.f, 0.f, 0.f, 0.f};
      const bf16x8 k0 = *(const bf16x8*)(sK + krow * 128 + (((0 + fq) ^ (krow & 7)) << 4));
      const bf16x8 k1 = *(const bf16x8*)(sK + krow * 128 + (((4 + fq) ^ (krow & 7)) << 4));
      st[kt] = __builtin_amdgcn_mfma_f32_16x16x32_bf16(k0, qf0, st[kt], 0, 0, 0);
      st[kt] = __builtin_amdgcn_mfma_f32_16x16x32_bf16(k1, qf1, st[kt], 0, 0, 0);
    }
    const int i = qt * 16 + fr;
    float mx = sink;
#pragma unroll
    for (int kt = 0; kt < 10; ++kt)
#pragma unroll
      for (int r = 0; r < 4; ++r) {
        const int jb = (2 * kp0 + kt) * 16 + 4 * fq + r;
        const int dist = 128 + i - jb;
        const bool ok = (dist >= 0) && (dist < 128) && (t0 - 128 + jb >= 0);
        const float s = ok ? (st[kt][r] * 0.125f - slope * (float)dist) : -INFINITY;
        st[kt][r] = s;
        mx = fmaxf(mx, s);
      }
    mx = fmaxf(mx, __shfl_xor(mx, 16));
    mx = fmaxf(mx, __shfl_xor(mx, 32));
    float sum = 0.f;
#pragma unroll
    for (int kt = 0; kt < 10; ++kt)
#pragma unroll
      for (int r = 0; r < 4; ++r) { const float p = __expf(st[kt][r] - mx); st[kt][r] = p; sum += p; }
    sum += __shfl_xor(sum, 16);
    sum += __shfl_xor(sum, 32);
    const float inv = 1.f / (sum + __expf(sink - mx));
    f32x4 O[4];
#pragma unroll
    for (int nt = 0; nt < 4; ++nt) O[nt] = (f32x4){0.f, 0.f, 0.f, 0.f};
#pragma unroll
    for (int s5 = 0; s5 < 5; ++s5) {
      const bf16x8 pa = pack8(st[2 * s5] * inv, st[2 * s5 + 1] * inv);
      const int key0 = (2 * kp0 + 2 * s5) * 16 + 4 * fq;
#pragma unroll
      for (int nt = 0; nt < 4; ++nt) {
        const int drow = nt * 16 + fr;
        const int c0 = key0 >> 3, c1 = (key0 + 16) >> 3;
        const u32x2 lo = *(const u32x2*)(sV + drow * 512 + ((c0 ^ (drow & 15)) << 4) + ((key0 >> 2) & 1) * 8);
        const u32x2 hi = *(const u32x2*)(sV + drow * 512 + ((c1 ^ (drow & 15)) << 4) + ((key0 >> 2) & 1) * 8);
        const u32x4 vb = (u32x4){lo[0], lo[1], hi[0], hi[1]};
        O[nt] = __builtin_amdgcn_mfma_f32_16x16x32_bf16(__builtin_bit_cast(bf16x8, vb), pa, O[nt], 0, 0, 0);
      }
    }
#pragma unroll
    for (int nt = 0; nt < 4; ++nt) {
      u32x2 wv; wv[0] = pack2(O[nt][0], O[nt][1]); wv[1] = pack2(O[nt][2], O[nt][3]);
      *(u32x2*)(mixed + (rowb + t0 + qt * 16 + fr) * DM + 512 + head * 64 + nt * 16 + 4 * fq) = wv;
    }
  }
}

__device__ __forceinline__ void ph_wout(unsigned char* smem, int xcd, int l, const bf16_t* __restrict__ mixed, const bf16_t* __restrict__ wt, bf16_t* __restrict__ mixo) {
  const int mi = l >> 3, ni = l & 7;
  LdRowBF16 al; al.init([&](int r) { return mixed + (size_t)((xcd * 32 + mi) * 128 + r) * DM; }, (size_t)8 * 128 * DM * 2);
  LdRowBF16 bl; bl.init([&](int r) { return wt + (size_t)(ni * 128 + r) * DM; }, 0);
  gemm_stream<16>(smem, al, bl, 4, [&](int seg, f32x4 (&acc)[4][4], unsigned char* fbuf) {
    const int m0 = (xcd * 32 + seg * 8 + mi) * 128, n0 = ni * 128;
    store_tile_bf16(fbuf, acc, [&](int r) { return mixo + (size_t)(m0 + r) * DM + n0; });
  });
}

__device__ __forceinline__ void ph_ln1(int item, const float* __restrict__ x, const bf16_t* __restrict__ mixo, const float* __restrict__ gam, const float* __restrict__ bet, bf16_t* __restrict__ xbf) {
  const int row = item * 4 + (TIDX >> 6), lane = TIDX & 63;
  const float4* p = (const float4*)(x + (size_t)row * DM);
  const u32x2* pm = (const u32x2*)(mixo + (size_t)row * DM);
  float4 v[4]; float s = 0.f;
#pragma unroll
  for (int i = 0; i < 4; ++i) {
    const float4 xv = p[lane + i * 64]; const u32x2 mv = pm[lane + i * 64];
    v[i].x = ALPHA * xv.x + bflo(mv[0]); v[i].y = ALPHA * xv.y + bfhi(mv[0]); v[i].z = ALPHA * xv.z + bflo(mv[1]); v[i].w = ALPHA * xv.w + bfhi(mv[1]);
    s += v[i].x + v[i].y + v[i].z + v[i].w;
  }
  const float mu = wave_sum(s) * (1.f / DM);
  float q = 0.f;
#pragma unroll
  for (int i = 0; i < 4; ++i) { const float a = v[i].x - mu, b = v[i].y - mu, c = v[i].z - mu, d = v[i].w - mu; q += a * a + b * b + c * c + d * d; }
  const float rs = rsqrtf(wave_sum(q) * (1.f / DM) + LN_EPS);
#pragma unroll
  for (int i = 0; i < 4; ++i) {
    const float4 gg = ((const float4*)gam)[lane + i * 64], bb = ((const float4*)bet)[lane + i * 64];
    u32x2 w;
    w[0] = pack2((v[i].x - mu) * rs * gg.x + bb.x, (v[i].y - mu) * rs * gg.y + bb.y);
    w[1] = pack2((v[i].z - mu) * rs * gg.z + bb.z, (v[i].w - mu) * rs * gg.w + bb.w);
    ((u32x2*)(xbf + (size_t)row * DM))[lane + i * 64] = w;
  }
}

__device__ __forceinline__ void ph_router(unsigned char* smem, int tile, const bf16_t* __restrict__ xbf, const bf16_t* __restrict__ wt, float* __restrict__ logits) {
  GEMM_IDS
  const int n0 = (tile & 1) * 128, m0 = (tile >> 1) * 128;
  LdRowBF16 al; al.init([&](int r) { return xbf + (size_t)(m0 + r) * DM; }, 0);
  LdRowBF16 bl; bl.init([&](int r) { return wt + (size_t)(n0 + r) * DM; }, 0);
  gemm_stream<16>(smem, al, bl, 1, [&](int seg, f32x4 (&acc)[4][4], unsigned char* fbuf) {
    GEMM_IDS
#pragma unroll
    for (int m = 0; m < 4; ++m)
#pragma unroll
      for (int n = 0; n < 4; ++n)
        *(f32x4*)(logits + (size_t)(m0 + wr * 64 + m * 16 + fr) * NEXP + n0 + wc * 64 + n * 16 + fq * 4) = acc[m][n];
  });
}

__device__ __forceinline__ void ph_route(int item, const float* __restrict__ logits, const float* __restrict__ router_bias, int* __restrict__ cnt, int* __restrict__ list, float* __restrict__ gates) {
  const int n = item * 4 + (TIDX >> 6), lane = TIDX & 63;
  const float4 lg = ((const float4*)(logits + (size_t)n * NEXP))[lane];
  const float4 rb = ((const float4*)router_bias)[lane];
  float sc[4] = {sigmoidf(lg.x), sigmoidf(lg.y), sigmoidf(lg.z), sigmoidf(lg.w)};
  float sel[4] = {sc[0] + rb.x, sc[1] + rb.y, sc[2] + rb.z, sc[3] + rb.w};
  float t1 = fmaxf(sel[0], sel[1]), t2 = fminf(sel[0], sel[1]);
  { const float a = sel[2]; if (a > t1) { t2 = t1; t1 = a; } else if (a > t2) t2 = a; }
  { const float a = sel[3]; if (a > t1) { t2 = t1; t1 = a; } else if (a > t2) t2 = a; }
#pragma unroll
  for (int o = 1; o < 8; o <<= 1) {
    const float b1 = __shfl_xor(t1, o), b2 = __shfl_xor(t2, o);
    const float n1 = fmaxf(t1, b1), n2 = fmaxf(fminf(t1, b1), fmaxf(t2, b2));
    t1 = n1; t2 = n2;
  }
  const float gs = t1 + t2;
  const int mygrp = lane >> 3;
  int rank = 0;
#pragma unroll
  for (int j = 0; j < 8; ++j) {
    const float o = __shfl(gs, j * 8);
    rank += (o > gs || (o == gs && j < mygrp)) ? 1 : 0;
  }
  const bool gsel = rank < 4;
  float cand[4];
#pragma unroll
  for (int i = 0; i < 4; ++i) cand[i] = gsel ? sel[i] : -INFINITY;
  float gsum = 0.f; float myg = 0.f; int mye = 0;
#pragma unroll 1
  for (int r = 0; r < TOPK; ++r) {
    float bv = cand[0]; int bi = 0;
#pragma unroll
    for (int i = 1; i < 4; ++i) if (cand[i] > bv) { bv = cand[i]; bi = i; }
    int be = lane * 4 + bi;
    float bs = (bi == 0) ? sc[0] : (bi == 1) ? sc[1] : (bi == 2) ? sc[2] : sc[3];
#pragma unroll
    for (int o = 1; o < 64; o <<= 1) {
      const float ov = __shfl_xor(bv, o); const int oe = __shfl_xor(be, o); const float os = __shfl_xor(bs, o);
      if (ov > bv || (ov == bv && oe < be)) { bv = ov; be = oe; bs = os; }
    }
    if ((be >> 2) == lane) {
      const int bi2 = be & 3;
      if (bi2 == 0) cand[0] = -INFINITY; else if (bi2 == 1) cand[1] = -INFINITY; else if (bi2 == 2) cand[2] = -INFINITY; else cand[3] = -INFINITY;
    }
    gsum += bs;
    if (lane == r) { myg = bs; mye = be; }
  }
  if (lane < TOPK) {
    const int slot = atomicAdd(&cnt[mye], 1);
    list[(size_t)mye * CAP + slot] = n * TOPK + lane;
    gates[(size_t)n * TOPK + lane] = myg / gsum * 2.5f;
  }
}

__device__ __forceinline__ void moe_build_prefix(const int* __restrict__ cnt, int* sscan) {
  const int tid = TIDX;
  const int e = ((tid & 31) << 3) | (tid >> 5);
  const int c = cnt[e];
  __syncthreads();
  sscan[tid] = (c + 127) >> 7;
  __syncthreads();
  for (int o = 1; o < 256; o <<= 1) {
    const int v = (tid >= o) ? sscan[tid - o] : 0;
    __syncthreads();
    sscan[tid] += v;
    __syncthreads();
  }
}
__device__ __forceinline__ void moe_locate(const int* sscan, int x, int lt, int& e, int& rt) {
  const int base = x ? sscan[32 * x - 1] : 0;
  const int nrouted = sscan[32 * x + 31] - base;
  if (lt >= nrouted) { e = 256; rt = x * (NTOK / 128 / 8) + (lt - nrouted); return; }
  const int g = base + lt;
  int lo = 32 * x, hi = 32 * x + 31;
  while (lo < hi) { const int mid = (lo + hi) >> 1; if (sscan[mid] > g) hi = mid; else lo = mid + 1; }
  e = ((lo & 31) << 3) | (lo >> 5); rt = g - (lo ? sscan[lo - 1] : 0);
}

__device__ __forceinline__ void ph_moe(unsigned char* smem, int e, int rt, const bf16_t* __restrict__ xbf, const int* __restrict__ cnt, const int* __restrict__ list,
                                       const float* __restrict__ gates, const bf16_t* __restrict__ wge, const bf16_t* __restrict__ wue, const bf16_t* __restrict__ wde,
                                       bf16_t* __restrict__ ybuf, float* __restrict__ dout, bf16_t* __restrict__ dummy) {
  int* sasg = (int*)(smem + SM_MISC + 2048);
  float* sgate = (float*)(smem + SM_MISC + 2048 + 512);
  const int tid = TIDX, lane = tid & 63, w = tid >> 6, fr = lane & 15, fq = lane >> 4;
  const int rows = (e < 256) ? cnt[e] : NTOK;
  __syncthreads();
  if (tid < 128) {
    const int r = rt * 128 + tid;
    int a = -1;
    if (r < rows) a = (e < 256) ? list[(size_t)e * CAP + r] : (NA + r);
    sasg[tid] = a;
    sgate[tid] = (a >= 0 && a < NA) ? gates[a] : 1.f;
  }
  __syncthreads();
  bf16x8 hf[2][8];
  {
    LdRowBF16 al; al.init([&](int r) { const int a = sasg[r]; const int tok = (a < 0) ? 0 : (a < NA ? (a >> 3) : (a - NA)); return xbf + (size_t)tok * DM; }, 0);
    LdRowBF16 bl; bl.init([&](int j) {
      const int bn = j >> 4, ff = (bn >> 1) * 16 + (j & 15);
      return ((bn & 1) ? wue : wge) + (size_t)ff * DM; }, (size_t)64 * DM * 2);
    al.issue(0, 0, smem); bl.issue(0, 0, smem + 16384);
    asm volatile("s_waitcnt vmcnt(0)" ::: "memory");
    __syncthreads();
#pragma unroll
    for (int m = 0; m < 2; ++m)
#pragma unroll
      for (int s = 0; s < 8; ++s) hf[m][s] = (bf16x8){0, 0, 0, 0, 0, 0, 0, 0};
#pragma unroll 1
    for (int ct = 0; ct < 4; ++ct) {
      f32x4 acc[2][8];
#pragma unroll
      for (int m = 0; m < 2; ++m)
#pragma unroll
        for (int n = 0; n < 8; ++n) acc[m][n] = (f32x4){0.f, 0.f, 0.f, 0.f};
#pragma unroll 1
      for (int kk = 0; kk < 16; ++kk) {
        const int j = ct * 16 + kk;
        unsigned char* cur = smem + (j & 1) * 32768; unsigned char* nxt = smem + ((j & 1) ^ 1) * 32768;
        if (j + 1 < 64) { al.issue((j + 1) >> 4, (j + 1) & 15, nxt); bl.issue((j + 1) >> 4, (j + 1) & 15, nxt + 16384); }
#pragma unroll
        for (int ks = 0; ks < 2; ++ks) {
          bf16x8 a[2];
#pragma unroll
          for (int m = 0; m < 2; ++m) {
            const int row = w * 32 + m * 16 + fr;
            a[m] = *(const bf16x8*)(cur + row * 128 + (((ks * 4 + fq) ^ (row & 7)) << 4));
          }
          bf16x8 bfrag[8];
#pragma unroll
          for (int n = 0; n < 8; ++n) {
            const int row = n * 16 + fr;
            bfrag[n] = *(const bf16x8*)(cur + 16384 + row * 128 + (((ks * 4 + fq) ^ (row & 7)) << 4));
          }
          __builtin_amdgcn_s_setprio(1);
#pragma unroll
          for (int n = 0; n < 8; ++n)
#pragma unroll
            for (int m = 0; m < 2; ++m) acc[m][n] = __builtin_amdgcn_mfma_f32_16x16x32_bf16(bfrag[n], a[m], acc[m][n], 0, 0, 0);
          __builtin_amdgcn_s_setprio(0);
          __builtin_amdgcn_sched_group_barrier(0x100, 10, 0);
          __builtin_amdgcn_sched_group_barrier(0x008, 16, 0);
        }
        asm volatile("s_waitcnt vmcnt(0)" ::: "memory");
        __syncthreads();
      }
#pragma unroll
      for (int m = 0; m < 2; ++m) {
        f32x4 hv[4];
#pragma unroll
        for (int p = 0; p < 4; ++p)
#pragma unroll
          for (int r = 0; r < 4; ++r) hv[p][r] = siluf(acc[m][2 * p][r]) * acc[m][2 * p + 1][r];
        const bf16x8 h0 = pack8(hv[0], hv[1]), h1 = pack8(hv[2], hv[3]);
        if (ct == 0) { hf[m][0] = h0; hf[m][1] = h1; }
        else if (ct == 1) { hf[m][2] = h0; hf[m][3] = h1; }
        else if (ct == 2) { hf[m][4] = h0; hf[m][5] = h1; }
        else { hf[m][6] = h0; hf[m][7] = h1; }
      }
    }
  }
#define MOE_RAW_BARRIER() do { asm volatile("s_waitcnt lgkmcnt(0)" ::: "memory"); __builtin_amdgcn_s_barrier(); } while (0)
  {
    LdRowBF16 bl; bl.init([&](int j) { return wde + (size_t)j * EFF; }, (size_t)128 * EFF * 2);
    bl.issue(0, 0, smem); bl.issue(0, 1, smem + 16384); bl.issue(0, 2, smem + 32768);
#pragma unroll 1
    for (int ct = 0; ct < 8; ++ct) {
      f32x4 acc[2][8];
#pragma unroll
      for (int m = 0; m < 2; ++m)
#pragma unroll
        for (int n = 0; n < 8; ++n) acc[m][n] = (f32x4){0.f, 0.f, 0.f, 0.f};
#pragma unroll
      for (int kk = 0; kk < 4; ++kk) {
        const int j = ct * 4 + kk;
        if (e < 256 && ct > 0 && kk < 3) {
          if (j < 30) asm volatile("s_waitcnt vmcnt(16)" ::: "memory");
          else asm volatile("s_waitcnt vmcnt(12)" ::: "memory");
        } else {
          if (j < 30) asm volatile("s_waitcnt vmcnt(8)" ::: "memory");
          else if (j == 30) asm volatile("s_waitcnt vmcnt(4)" ::: "memory");
          else asm volatile("s_waitcnt vmcnt(0)" ::: "memory");
        }
        MOE_RAW_BARRIER();
        if (j + 3 < 32) bl.issue((j + 3) >> 2, (j + 3) & 3, smem + ((kk + 3) & 3) * 16384);
        const unsigned char* cur = smem + kk * 16384;
#pragma unroll
        for (int ks = 0; ks < 2; ++ks) {
          bf16x8 wf[8];
#pragma unroll
          for (int n = 0; n < 8; ++n) {
            const int row = n * 16 + fr;
            wf[n] = *(const bf16x8*)(cur + row * 128 + (((ks * 4 + fq) ^ (row & 7)) << 4));
          }
          __builtin_amdgcn_s_setprio(1);
#pragma unroll
          for (int n = 0; n < 8; ++n)
#pragma unroll
            for (int m = 0; m < 2; ++m) acc[m][n] = __builtin_amdgcn_mfma_f32_16x16x32_bf16(wf[n], hf[m][kk * 2 + ks], acc[m][n], 0, 0, 0);
          __builtin_amdgcn_s_setprio(0);
          __builtin_amdgcn_sched_group_barrier(0x100, 8, 0);
          __builtin_amdgcn_sched_group_barrier(0x008, 16, 0);
        }
      }
      const int n0 = ct * 128;
      if (e == 256) {
#pragma unroll
        for (int m = 0; m < 2; ++m) {
          const int a = sasg[w * 32 + m * 16 + fr];
          if (a >= NA) {
            float* dp = dout + (size_t)(a - NA) * DM + n0 + fq * 4;
            const bf16_t* xp = xbf + (size_t)(a - NA) * DM + n0 + fq * 4;
#pragma unroll
            for (int n = 0; n < 8; ++n) {
              const u32x2 xw = *(const u32x2*)(xp + n * 16);
              const f32x4 xv = (f32x4){bflo(xw[0]), bfhi(xw[0]), bflo(xw[1]), bfhi(xw[1])};
              *(f32x4*)(dp + n * 16) = xv * ALPHA + acc[m][n];
            }
          }
        }
      } else {
        unsigned char* stg = smem + 3 * 16384 + w * 4096;
        MOE_RAW_BARRIER();
#pragma unroll
        for (int hc = 0; hc < 2; ++hc) {
#pragma unroll
          for (int m = 0; m < 2; ++m) {
            const int row = m * 16 + fr;
            const float gt = sgate[w * 32 + row];
#pragma unroll
            for (int nn = 0; nn < 4; ++nn) {
              const int n = hc * 4 + nn, chunk = nn * 2 + (fq >> 1);
              u32x2 wv; wv[0] = pack2(acc[m][n][0] * gt, acc[m][n][1] * gt); wv[1] = pack2(acc[m][n][2] * gt, acc[m][n][3] * gt);
              *(u32x2*)(stg + row * 128 + ((chunk ^ (row & 7)) << 4) + (fq & 1) * 8) = wv;
            }
          }
#pragma unroll
          for (int i = 0; i < 4; ++i) {
            const int q = lane + 64 * i, row = q >> 3, ch = q & 7;
            const int a = sasg[w * 32 + row];
            bf16_t* yp = ((a >= 0) ? ybuf + (size_t)a * DM : dummy) + n0 + hc * 64 + ch * 8;
            *(u32x4*)yp = *(const u32x4*)(stg + row * 128 + ((ch ^ (row & 7)) << 4));
          }
        }
      }
    }
    MOE_RAW_BARRIER();
  }
#undef MOE_RAW_BARRIER
}

__device__ __forceinline__ void ph_final(int item, float* __restrict__ out, const bf16_t* __restrict__ ybuf, const float* __restrict__ gam, const float* __restrict__ bet) {
  const int row = item * 4 + (TIDX >> 6), lane = TIDX & 63;
  float4* p = (float4*)(out + (size_t)row * DM);
  float4 v[4]; float s = 0.f;
#pragma unroll
  for (int i = 0; i < 4; ++i) {
    float4 a = p[lane + i * 64];
#pragma unroll
    for (int k = 0; k < 8; ++k) {
      const uint2 w = ((const uint2*)(ybuf + ((size_t)row * 8 + k) * DM))[lane + i * 64];
      a.x += bflo(w.x); a.y += bfhi(w.x); a.z += bflo(w.y); a.w += bfhi(w.y);
    }
    v[i] = a; s += a.x + a.y + a.z + a.w;
  }
  const float mu = wave_sum(s) * (1.f / DM);
  float q = 0.f;
#pragma unroll
  for (int i = 0; i < 4; ++i) { const float a = v[i].x - mu, b = v[i].y - mu, c = v[i].z - mu, d = v[i].w - mu; q += a * a + b * b + c * c + d * d; }
  const float rs = rsqrtf(wave_sum(q) * (1.f / DM) + LN_EPS);
#pragma unroll
  for (int i = 0; i < 4; ++i) {
    const float4 gg = ((const float4*)gam)[lane + i * 64], bb = ((const float4*)bet)[lane + i * 64];
    float4 r;
    r.x = (v[i].x - mu) * rs * gg.x + bb.x; r.y = (v[i].y - mu) * rs * gg.y + bb.y;
    r.z = (v[i].z - mu) * rs * gg.z + bb.z; r.w = (v[i].w - mu) * rs * gg.w + bb.w;
    p[lane + i * 64] = r;
  }
}

#define XB_TMO      128
#define XB_XCNT(j)  (256  + 64 * (j))
#define XB_XSUB(j)  (1280 + 64 * (j))
#define XB_XGEN(j)  (2304 + 64 * (j))
#define XB_TOP      3328
#define XB_TOPGEN   3392
#define XCD_BAR_WORDS 3456
#define XB_SPIN_CAP (1u << 22)
#define LAS __attribute__((address_space(3)))
__device__ __forceinline__ unsigned xb_ld(unsigned* p)              { return __hip_atomic_load(p, __ATOMIC_RELAXED, __HIP_MEMORY_SCOPE_AGENT); }
__device__ __forceinline__ unsigned xb_add(unsigned* p, unsigned v) { return __hip_atomic_fetch_add(p, v, __ATOMIC_RELAXED, __HIP_MEMORY_SCOPE_AGENT); }
__device__ __forceinline__ unsigned xb_xcc_id() { return (unsigned)__builtin_amdgcn_s_getreg((3 << 11) | 20) & 0xFu; }
#define XB_SPIN(cond, bar) do { unsigned _sp = 0; while (cond) { __builtin_amdgcn_s_sleep(1); \
    if ((++_sp & 255u) == 0u) { if (xb_ld(&(bar)[XB_TMO])) break; if (_sp > XB_SPIN_CAP) { atomicAdd(&(bar)[XB_TMO], 1u); break; } } } } while (0)
struct XcdBarrier { unsigned* bar; unsigned x; volatile LAS unsigned* st; };
__device__ __forceinline__ XcdBarrier xcd_barrier_post(unsigned* bar, volatile LAS unsigned* st) {
  XcdBarrier b; b.bar = bar; b.x = xb_xcc_id(); b.st = st;
  if (threadIdx.x == 0) (void)xb_add(&bar[XB_XCNT(b.x)], 1u);
  return b;
}
__device__ __forceinline__ void xcd_barrier_complete(unsigned* bar, unsigned x, unsigned& nloc, unsigned& nx) {
  const unsigned G = gridDim.x * gridDim.y * gridDim.z;
  unsigned sum, cnt, mine, sp = 0u;
  for (;;) {
    sum = 0u; cnt = 0u; mine = 0u;
#pragma unroll
    for (unsigned j = 0; j < 16; ++j) { const unsigned c = xb_ld(&bar[XB_XCNT(j)]); sum += c; cnt += (c > 0u) ? 1u : 0u; mine = (j == x) ? c : mine; }
    if (sum == G) break;
    __builtin_amdgcn_s_sleep(1);
    if ((++sp & 255u) == 0u) { if (xb_ld(&bar[XB_TMO])) break; if (sp > XB_SPIN_CAP) { atomicAdd(&bar[XB_TMO], 1u); break; } }
  }
  nloc = mine > 0u ? mine : 1u; nx = cnt > 0u ? cnt : 1u;
}
__device__ __forceinline__ void xcd_barrier(const XcdBarrier& b) {
  asm volatile("s_waitcnt vmcnt(0)" ::: "memory");
  __syncthreads();
  if (threadIdx.x == 0) {
    unsigned* bar = b.bar;
    __builtin_amdgcn_s_waitcnt(0);
    unsigned nloc = b.st[0], nx = b.st[1];
    if (nloc == 0u) { xcd_barrier_complete(bar, b.x, nloc, nx); b.st[0] = nloc; b.st[1] = nx; }
    const unsigned old = xb_add(&bar[XB_XSUB(b.x)], 1u);
    const unsigned gen = old / nloc;
    if (old + 1u == (gen + 1u) * nloc) {
      __builtin_amdgcn_fence(__ATOMIC_RELEASE, "agent");
      asm volatile("s_waitcnt vmcnt(0)" ::: "memory");
      const unsigned og = xb_add(&bar[XB_TOP], 1u);
      const unsigned tg = og / nx;
      if (og + 1u == (tg + 1u) * nx) xb_add(&bar[XB_TOPGEN], 1u);
      else XB_SPIN(xb_ld(&bar[XB_TOPGEN]) == tg, bar);
      __builtin_amdgcn_fence(__ATOMIC_ACQUIRE, "agent");
      xb_add(&bar[XB_XGEN(b.x)], 1u);
      asm volatile("s_waitcnt vmcnt(0)" ::: "memory");
    } else {
      XB_SPIN(xb_ld(&bar[XB_XGEN(b.x)]) == gen, bar);
      __builtin_amdgcn_fence(__ATOMIC_ACQUIRE, "agent");
      asm volatile("s_waitcnt vmcnt(0)" ::: "memory");
    }
  }
  __syncthreads();
}

__global__ void __launch_bounds__(256, 2) mega(Params P) {
  __shared__ __attribute__((aligned(16))) unsigned char smem[SMEM_BYTES];
  const int bid = blockIdx.x, nblk = gridDim.x;
#define xin (P.in[0])
#define w_in (P.in[1])
#define conv_w (P.in[2])
#define a_log (P.in[3])
#define dt_bias (P.in[4])
#define dn_norm_g (P.in[5])
#define sinks (P.in[6])
#define w_out (P.in[7])
#define ln1_g (P.in[8])
#define ln1_b (P.in[9])
#define router_w (P.in[10])
#define router_bias (P.in[11])
#define w_gate (P.in[12])
#define w_up (P.in[13])
#define w_down (P.in[14])
#define sw_gate (P.in[15])
#define sw_up (P.in[16])
#define sw_down (P.in[17])
#define ln2_g (P.in[18])
#define ln2_b (P.in[19])
#define outp (P.out)
#define x1bf ((bf16_t*)(P.ws + WS_X1BF))
#define logits ((float*)(P.ws + WS_LOGIT))
#define list ((int*)(P.ws + WS_LIST))
#define gates ((float*)(P.ws + WS_GATES))
#define cnt ((int*)(P.ws + WS_CTRL))
#define barw ((unsigned*)(P.ws + WS_CTRL + 4096))
#define mixed ((bf16_t*)(P.ws + WS_MIXED))
#define proj ((bf16_t*)(P.ws + WS_PROJ))
#define ba ((float*)(P.ws + WS_BA))
#define QD ((bf16_t*)(P.ws + WS_QD))
#define W0N ((bf16_t*)(P.ws + WS_W0N))
#define KTT ((bf16_t*)(P.ws + WS_KTT))
#define RV ((bf16_t*)(P.ws + WS_RV))
#define TM ((bf16_t*)(P.ws + WS_TM))
#define ATT ((bf16_t*)(P.ws + WS_ATT))
#define GL ((float*)(P.ws + WS_GL))
#define obuf ((float*)(P.ws + WS_O))
#define VTb ((bf16_t*)(P.ws + WS_VT))
#define MIXO ((bf16_t*)(P.ws + WS_O))
#define XBF ((bf16_t*)(P.ws + WS_XBF))
#define WTIN ((bf16_t*)(P.ws + WS_WTIN))
#define WTOUT ((bf16_t*)(P.ws + WS_WTOUT))
#define WTR ((bf16_t*)(P.ws + WS_WTR))
#define WTG ((bf16_t*)(P.ws + WS_WTG))
#define WTU ((bf16_t*)(P.ws + WS_WTU))
#define WTD ((bf16_t*)(P.ws + WS_WTD))
#define WTSG ((bf16_t*)(P.ws + WS_WTSG))
#define WTSU ((bf16_t*)(P.ws + WS_WTSU))
#define WTSD ((bf16_t*)(P.ws + WS_WTSD))
#define ybuf ((bf16_t*)(P.ws + WS_YBUF))
  {
    volatile LAS unsigned* st0 = (volatile LAS unsigned*)(smem + SM_MISC + 4080);
    if (threadIdx.x == 0) { st0[0] = 0u; st0[1] = 0u; }
    __syncthreads();
  }
  const int xcd = bid & 7, xloc = bid >> 3, xnl = nblk >> 3;
  XcdBarrier xb = xcd_barrier_post(barw, (volatile LAS unsigned*)(smem + SM_MISC + 4080));
  for (int it = bid; it < NTOK / 8; it += nblk) { ph_cvt_x(2 * it, xin, XBF); ph_cvt_x(2 * it + 1, xin, XBF); }
  for (int it = bid; it < 16 * 46 + 16 * 16 + 16 * 4; it += nblk) {
    if (it < 16 * 46) ph_cvt_wt(smem, it % 16, it / 16, w_in, DM, INC, WTIN);
    else if (it < 16 * 46 + 256) { const int j = it - 16 * 46; ph_cvt_wt(smem, j % 16, j / 16, w_out, DM, DM, WTOUT); }
    else { const int j = it - 16 * 46 - 256; ph_cvt_wt(smem, j % 16, j / 16, router_w, DM, NEXP, WTR); }
  }
  for (int it = bid; it < 192; it += nblk) {
    if (it < 64) ph_cvt_wt(smem, it % 16, it / 16, sw_gate, DM, EFF, WTSG);
    else if (it < 128) ph_cvt_wt(smem, (it - 64) % 16, (it - 64) / 16, sw_up, DM, EFF, WTSU);
    else ph_cvt_wt(smem, (it - 128) % 4, (it - 128) / 4, sw_down, EFF, DM, WTSD, true);
  }
  xcd_barrier(xb);
  for (int l = xloc; l < 64; l += xnl) ph_proj(smem, xcd, l, XBF, WTIN, proj, ba, VTb);
  xcd_barrier(xb);
  for (int it = bid; it < 2048; it += nblk) ph_dnchunk(smem, it, proj, ba, conv_w, a_log, dt_bias, QD, W0N, KTT, RV, TM, ATT, GL);
  for (int it = bid; it < 512; it += nblk) ph_swa(smem, it, proj, VTb, sinks, mixed);
  xcd_barrier(xb);
  if (bid < 64 || nblk <= 64) {
    for (int it = bid; it < 64; it += nblk) ph_dnscan(smem, it, QD, W0N, KTT, RV, TM, ATT, GL, obuf);
  }
  if ((bid >= 64 && !(nblk == 512 && bid >= 256 && bid < 320)) || nblk <= 64) {
    const int tid = TIDX, lane = tid & 63, wv = tid >> 6;
    float* tile = (float*)(smem + wv * 16640);
    const int nconv = (nblk == 512) ? 384 : ((nblk > 64) ? (nblk - 64) : nblk);
    const int cb = (nblk == 512) ? ((bid < 256) ? (bid - 64) : (bid - 128)) : ((nblk > 64) ? (bid - 64) : bid);
    const int step = nconv * 4, total = 256 * 192;
    int it = cb * 4 + wv;
    f32x4 vc[16], vn[16];
    CvtTile tc = cvt_decode(it < total ? it : 0, lane, w_gate, w_up, w_down, WTG, WTU, WTD);
    if (it < total) cvt_load(tc, vc);
    while (it < total) {
      const int itn = it + step;
      CvtTile tn = cvt_decode(itn < total ? itn : 0, lane, w_gate, w_up, w_down, WTG, WTU, WTD);
      if (itn < total) cvt_load(tn, vn);
      cvt_store(tile, lane, tc, vc);
#pragma unroll
      for (int i = 0; i < 16; ++i) vc[i] = vn[i];
      tc = tn; it = itn;
    }
  }
  xcd_barrier(xb);
  for (int it = bid; it < NTOK / 4; it += nblk) ph_dn_post(it, obuf, proj, dn_norm_g, mixed);
  xcd_barrier(xb);
  for (int l = xloc; l < 64; l += xnl) ph_wout(smem, xcd, l, mixed, WTOUT, MIXO);
  xcd_barrier(xb);
  for (int it = bid; it < NTOK / 4; it += nblk) ph_ln1(it, xin, MIXO, ln1_g, ln1_b, x1bf);
  xcd_barrier(xb);
  for (int i = xloc; i < 32 * 2; i += xnl) ph_router(smem, (xcd * 32 + i / 2) * 2 + i % 2, x1bf, WTR, logits);
  xcd_barrier(xb);
  for (int it = bid; it < NTOK / 4; it += nblk) ph_route(it, logits, router_bias, cnt, list, gates);
  xcd_barrier(xb);
  int* sscan = (int*)(smem + SM_MISC);
  moe_build_prefix(cnt, sscan);
  const int ntile = sscan[32 * xcd + 31] - (xcd ? sscan[32 * xcd - 1] : 0) + NTOK / 128 / 8;
  for (int it = xloc; it < ntile; it += xnl) {
    int e, rt; moe_locate(sscan, xcd, it, e, rt);
    ph_moe(smem, e, rt, x1bf, cnt, list, gates, (e < 256) ? WTG + (size_t)e * EFF * DM : WTSG, (e < 256) ? WTU + (size_t)e * EFF * DM : WTSU,
           (e < 256) ? WTD + (size_t)e * DM * EFF : WTSD, ybuf, outp, (bf16_t*)(P.ws + WS_DUMMY));
  }
  xcd_barrier(xb);
  for (int it = bid; it < NTOK / 4; it += nblk) ph_final(it, outp, ybuf, ln2_g, ln2_b);
}

#undef xin
#undef w_in
#undef conv_w
#undef a_log
#undef dt_bias
#undef dn_norm_g
#undef sinks
#undef w_out
#undef ln1_g
#undef ln1_b
#undef router_w
#undef router_bias
#undef w_gate
#undef w_up
#undef w_down
#undef sw_gate
#undef sw_up
#undef sw_down
#undef ln2_g
#undef ln2_b
#undef outp
#undef x1bf
#undef logits
#undef list
#undef gates
#undef cnt
#undef mixed
#undef proj
#undef ba
#undef QD
#undef W0N
#undef KTT
#undef RV
#undef TM
#undef ATT
#undef GL
#undef obuf
#undef ybuf
#undef VTb
#undef MIXO
#undef XBF
#undef WTIN
#undef WTOUT
#undef WTR
#undef WTG
#undef WTU
#undef WTD
#undef WTSG
#undef WTSU
#undef WTSD
#undef barw

extern "C" void kernel_launch(void* const* d_in, const int* in_sizes, int n_in, void* d_out, int out_size, void* d_ws, size_t ws_size, hipStream_t stream) {
  static int grid_blocks = 0;
  if (!grid_blocks) {
    int dev = 0, cus = 0, per_cu = 0;
    (void)hipGetDevice(&dev);
    (void)hipDeviceGetAttribute(&cus, hipDeviceAttributeMultiprocessorCount, dev);
    (void)hipOccupancyMaxActiveBlocksPerMultiprocessor(&per_cu, mega, 256, 0);
    if (per_cu > 2) per_cu = 2;
    if (per_cu < 1) per_cu = 1;
    grid_blocks = cus * per_cu;
  }
  Params p{};
  for (int i = 0; i < 20; ++i) p.in[i] = (const float*)d_in[i];
  p.out = (float*)d_out; p.ws = (char*)d_ws;
  (void)hipMemsetAsync((char*)d_ws + WS_CTRL, 0, 4096 + XCD_BAR_WORDS * 4, stream);
  void* args[] = {&p};
  hipError_t e = hipLaunchCooperativeKernel((void*)mega, dim3(grid_blocks), dim3(256), args, 0, stream);
  if (e != hipSuccess) fprintf(stderr, "cooperative launch failed: %s (grid %d)\n", hipGetErrorString(e), grid_blocks);
}
```

```cpp
#include <hip/hip_runtime.h>
#include <hip/hip_cooperative_groups.h>
#include <stdint.h>
#include <stdio.h>
namespace cg = cooperative_groups;

typedef __attribute__((ext_vector_type(8))) short bf16x8;
typedef __attribute__((ext_vector_type(4))) float f32x4;
typedef unsigned short bf16_t;
typedef __attribute__((ext_vector_type(4))) unsigned u32x4;
typedef __attribute__((ext_vector_type(2))) unsigned u32x2;

constexpr int NTOK = 32768, SEQ = 4096, DM = 1024;
constexpr int INC = 2824, PROJW = 2816;
constexpr int OFF_DQ = 0, OFF_DK = 512, OFF_DV = 1024, OFF_SQ = 1536, OFF_SK = 2048, OFF_SV = 2176, OFF_Z = 2304;
constexpr int NEXP = 256, TOPK = 8, EFF = 256;
constexpr int NA = NTOK * TOPK;
constexpr int CAP = NTOK;
constexpr float ALPHA = 1.189207115002721f;
constexpr float LN_EPS = 1e-5f, RMS_EPS = 1e-6f, L2_EPS = 1e-6f;
constexpr float SC_WG = 32.f, SC_WU = 64.f, SC_WD = 32.f, SC_H = 8.f, SC_Y = 32.f;

constexpr size_t MiB = 1024ull * 1024ull;
constexpr size_t WS_WTD8 = 0;
constexpr size_t WS_WTG8 = 64 * MiB;
constexpr size_t WS_WTU8 = 128 * MiB;
constexpr size_t WS_WTSG8 = 192 * MiB;
constexpr size_t WS_WTSU8 = WS_WTSG8 + 256 * 1024;
constexpr size_t WS_WTSD8 = WS_WTSG8 + 512 * 1024;
constexpr size_t WS_X1F8 = 200 * MiB;
constexpr size_t WS_YBUF = 384 * MiB;
constexpr size_t WS_LOGIT = 384 * MiB;
constexpr size_t WS_X1BF = 896 * MiB;
constexpr size_t WS_LIST = 960 * MiB;
constexpr size_t WS_GATES = 992 * MiB;
constexpr size_t WS_CTRL = 993 * MiB;
constexpr size_t WS_WTIN = 994 * MiB;
constexpr size_t WS_WTOUT = 1000 * MiB;
constexpr size_t WS_WTR = 1002 * MiB;
constexpr size_t WS_DUMMY = 1005 * MiB;
constexpr size_t WS_PROJ = 384 * MiB;
constexpr size_t WS_BA = 560 * MiB;
constexpr size_t WS_QD = 561 * MiB;
constexpr size_t WS_W0N = 593 * MiB;
constexpr size_t WS_KTT = 625 * MiB;
constexpr size_t WS_RV = 657 * MiB;
constexpr size_t WS_TM = 689 * MiB;
constexpr size_t WS_ATT = 705 * MiB;
constexpr size_t WS_GL = 721 * MiB;
constexpr size_t WS_O = 722 * MiB;
constexpr size_t WS_VT = 786 * MiB;
constexpr size_t WS_MIXED = 794 * MiB;
constexpr size_t WS_XBF = 640 * MiB;

__device__ __forceinline__ int opaque_tid() { int t = threadIdx.x; asm volatile("" : "+v"(t)); return t; }
#define TIDX opaque_tid()
typedef __attribute__((ext_vector_type(2))) __bf16 hwbf16x2;
typedef __attribute__((ext_vector_type(2))) float hwf32x2;
__device__ __forceinline__ unsigned pack2(float lo, float hi) {
  hwf32x2 f = {lo, hi};
  return __builtin_bit_cast(unsigned, __builtin_convertvector(f, hwbf16x2));
}
__device__ __forceinline__ unsigned f2bf(float f) { return pack2(f, 0.f) & 0xffffu; }
__device__ __forceinline__ float bf2f(unsigned h) { return __uint_as_float(h << 16); }
__device__ __forceinline__ float bflo(unsigned w) { return __uint_as_float(w << 16); }
__device__ __forceinline__ float bfhi(unsigned w) { return __uint_as_float(w & 0xffff0000u); }
__device__ __forceinline__ float siluf(float x) { return x * __builtin_amdgcn_rcpf(1.f + __expf(-x)); }
__device__ __forceinline__ float sigmoidf(float x) { return __builtin_amdgcn_rcpf(1.f + __expf(-x)); }
#define DPP_ADD_(v, ctrl, rmask) v += __builtin_bit_cast(float, __builtin_amdgcn_update_dpp(0, __builtin_bit_cast(int, v), ctrl, rmask, 0xf, false))
__device__ __forceinline__ float wave_sum(float v) {
  DPP_ADD_(v, 0xB1, 0xf);
  DPP_ADD_(v, 0x4E, 0xf);
  DPP_ADD_(v, 0x141, 0xf);
  DPP_ADD_(v, 0x140, 0xf);
  DPP_ADD_(v, 0x142, 0xa);
  DPP_ADD_(v, 0x143, 0xc);
  return __builtin_bit_cast(float, __builtin_amdgcn_readlane(__builtin_bit_cast(int, v), 63));
}

template <int SEGDIV>
struct LdRowBF16T {
  const char* p[4]; size_t seghi, seglo; int tid16;
  template <class F> __device__ __forceinline__ void init(F rowptr, size_t hi, size_t lo = 0) {
    const int tid = TIDX; const int slot = tid & 7, row0 = tid >> 3; seghi = hi; seglo = lo; tid16 = tid * 16;
#pragma unroll
    for (int i = 0; i < 4; ++i) p[i] = (const char*)rowptr(row0 + i * 32) + ((slot ^ (row0 & 7)) << 4);
  }
  __device__ __forceinline__ void issue(int seg, int kk, unsigned char* lds) {
    const size_t off = (size_t)(seg / SEGDIV) * seghi + (size_t)(seg % SEGDIV) * seglo + (size_t)kk * 128;
#pragma unroll
    for (int i = 0; i < 4; ++i)
      __builtin_amdgcn_global_load_lds((const unsigned*)(p[i] + off), (__attribute__((address_space(3))) unsigned*)(lds + tid16 + i * 4096), 16, 0, 0);
  }
};
typedef LdRowBF16T<1> LdRowBF16;
__device__ __forceinline__ void gemm_kstep(const unsigned char* sA, const unsigned char* sB, f32x4 (&acc)[4][4], int wr, int wc, int fr, int fq) {
#pragma unroll
  for (int ks = 0; ks < 2; ++ks) {
    bf16x8 a[4], b[4];
#pragma unroll
    for (int m = 0; m < 4; ++m) {
      const int row = wr * 64 + m * 16 + fr;
      a[m] = *(const bf16x8*)(sA + row * 128 + (((ks * 4 + fq) ^ (row & 7)) << 4));
    }
#pragma unroll
    for (int n = 0; n < 4; ++n) {
      const int row = wc * 64 + n * 16 + fr;
      b[n] = *(const bf16x8*)(sB + row * 128 + (((ks * 4 + fq) ^ (row & 7)) << 4));
    }
    __builtin_amdgcn_s_setprio(1);
#pragma unroll
    for (int m = 0; m < 4; ++m)
#pragma unroll
      for (int n = 0; n < 4; ++n) acc[m][n] = __builtin_amdgcn_mfma_f32_16x16x32_bf16(b[n], a[m], acc[m][n], 0, 0, 0);
    __builtin_amdgcn_s_setprio(0);
  }
}
template <int KPER, class AL, class BL, class Epi>
__device__ __forceinline__ void gemm_stream(unsigned char* smem, AL& al, BL& bl, int nseg, Epi epi) {
  const int tid = TIDX, lane = tid & 63, wid = tid >> 6, wr = wid >> 1, wc = wid & 1, fr = lane & 15, fq = lane >> 4;
  const int total = nseg * KPER;
  f32x4 acc[4][4];
  al.issue(0, 0, smem); bl.issue(0, 0, smem + 16384);
  asm volatile("s_waitcnt vmcnt(0)" ::: "memory");
  __syncthreads();
  for (int j = 0; j < total; ++j) {
    unsigned char* cur = smem + (j & 1) * 32768; unsigned char* nxt = smem + ((j & 1) ^ 1) * 32768;
    if (j + 1 < total) { al.issue((j + 1) / KPER, (j + 1) % KPER, nxt); bl.issue((j + 1) / KPER, (j + 1) % KPER, nxt + 16384); }
    if (j % KPER == 0) {
#pragma unroll
      for (int m = 0; m < 4; ++m)
#pragma unroll
        for (int n = 0; n < 4; ++n) acc[m][n] = (f32x4){0.f, 0.f, 0.f, 0.f};
    }
    gemm_kstep(cur, cur + 16384, acc, wr, wc, fr, fq);
    asm volatile("s_waitcnt vmcnt(0)" ::: "memory");
    __syncthreads();
    if ((j + 1) % KPER == 0) epi((j + 1) / KPER - 1, acc, cur);
  }
}

template <class RowDst>
__device__ __forceinline__ void store_tile_bf16(unsigned char* fbuf, const f32x4 (&acc)[4][4], RowDst rowdst) {
  const int tid = TIDX, lane = tid & 63, wid = tid >> 6, wr = wid >> 1, wc = wid & 1, fr = lane & 15, fq = lane >> 4;
#pragma unroll
  for (int m = 0; m < 4; ++m) {
    const int row = wr * 64 + m * 16 + fr;
#pragma unroll
    for (int n = 0; n < 4; ++n) {
      const int col = wc * 64 + n * 16 + fq * 4;
      u32x2 w; w[0] = pack2(acc[m][n][0], acc[m][n][1]); w[1] = pack2(acc[m][n][2], acc[m][n][3]);
      *(u32x2*)(fbuf + row * 256 + (((col >> 3) ^ (row & 15)) << 4) + ((col >> 2) & 1) * 8) = w;
    }
  }
  __syncthreads();
#pragma unroll
  for (int i = 0; i < 8; ++i) {
    const int q = tid + 256 * i, row = q >> 4, ch = q & 15;
    *(u32x4*)(rowdst(row) + ch * 8) = *(const u32x4*)(fbuf + row * 256 + ((ch ^ (row & 15)) << 4));
  }
  __syncthreads();
}

template <class RowDst>
__device__ __forceinline__ void store_tile_bf16_T(unsigned char* fbuf, const f32x4 (&acc)[4][4], RowDst rowdst) {
  const int tid = TIDX, lane = tid & 63, wid = tid >> 6, wr = wid >> 1, wc = wid & 1, fr = lane & 15, fq = lane >> 4;
#pragma unroll
  for (int m = 0; m < 4; ++m) {
    const int t = wr * 64 + m * 16 + fr;
#pragma unroll
    for (int n = 0; n < 4; ++n)
#pragma unroll
      for (int r = 0; r < 4; ++r) {
        const int c = wc * 64 + n * 16 + fq * 4 + r;
        *(unsigned short*)(fbuf + c * 256 + ((((t >> 3) ^ (c & 15))) << 4) + (t & 7) * 2) = (unsigned short)f2bf(acc[m][n][r]);
      }
  }
  __syncthreads();
#pragma unroll
  for (int i = 0; i < 8; ++i) {
    const int q = tid + 256 * i, row = q >> 4, ch = q & 15;
    *(u32x4*)(rowdst(row) + ch * 8) = *(const u32x4*)(fbuf + row * 256 + ((ch ^ (row & 15)) << 4));
  }
  __syncthreads();
}

#define GEMM_IDS const int tid = TIDX, lane = tid & 63, wid = tid >> 6, wr = wid >> 1, wc = wid & 1, fr = lane & 15, fq = lane >> 4; (void)tid; (void)lane;

struct Params {
  const float* in[20];
  float* out;
  char* ws;
};

constexpr int SMEM_BYTES = 69632;
constexpr int SM_MISC = 65536;

__device__ __forceinline__ void ph_cvt_x(int item, const float* __restrict__ x, bf16_t* __restrict__ xbf) {
  const int tid = TIDX;
  const size_t base = (size_t)item * 4096 + (size_t)tid * 4;
#pragma unroll
  for (int i = 0; i < 4; ++i) {
    const f32x4 v = *(const f32x4*)(x + base + (size_t)i * 1024);
    u32x2 w; w[0] = pack2(v[0], v[1]); w[1] = pack2(v[2], v[3]);
    *(u32x2*)(xbf + base + (size_t)i * 1024) = w;
  }
}
__device__ __forceinline__ void ph_cvt_wt(unsigned char* smem, int kt, int nt, const float* __restrict__ W, int K, int N, bf16_t* __restrict__ WT, bool perm = false) {
  float* tile = (float*)smem;
  const int tid = TIDX;
  const int k0 = kt * 64, n0 = nt * 64;
  __syncthreads();
#pragma unroll
  for (int i = 0; i < 4; ++i) {
    const int k = (tid >> 4) + 16 * i, n = 4 * (tid & 15);
    f32x4 v = (f32x4){0.f, 0.f, 0.f, 0.f};
    if (n0 + n < N) v = *(const f32x4*)(W + (size_t)(k0 + k) * N + n0 + n);
    tile[k * 65 + n + 0] = v[0]; tile[k * 65 + n + 1] = v[1]; tile[k * 65 + n + 2] = v[2]; tile[k * 65 + n + 3] = v[3];
  }
  __syncthreads();
  const int n = tid >> 2, kq = tid & 3;
  u32x4 w0, w1;
#pragma unroll
  for (int j = 0; j < 4; ++j) {
    w0[j] = pack2(tile[(kq * 16 + 2 * j) * 65 + n], tile[(kq * 16 + 2 * j + 1) * 65 + n]);
    w1[j] = pack2(tile[(kq * 16 + 8 + 2 * j) * 65 + n], tile[(kq * 16 + 8 + 2 * j + 1) * 65 + n]);
  }
  if (!perm) {
    bf16_t* dst = WT + (size_t)(n0 + n) * K + k0 + kq * 16;
    *(u32x4*)dst = w0; *(u32x4*)(dst + 8) = w1;
  } else {
    const int blk = kq >> 1, hi = kq & 1;
    bf16_t* dst = WT + (size_t)(n0 + n) * K + k0 + blk * 32 + 4 * hi;
    u32x2 a; a[0] = w0[0]; a[1] = w0[1]; *(u32x2*)(dst + 0) = a;
    a[0] = w0[2]; a[1] = w0[3]; *(u32x2*)(dst + 8) = a;
    a[0] = w1[0]; a[1] = w1[1]; *(u32x2*)(dst + 16) = a;
    a[0] = w1[2]; a[1] = w1[3]; *(u32x2*)(dst + 24) = a;
  }
}

struct CvtTile { const float* src; unsigned char* dst; int ldn; int K; int perm; float scale; };
__device__ __forceinline__ CvtTile cvt_decode(int it, int lane, const float* __restrict__ w_gate, const float* __restrict__ w_up, const float* __restrict__ w_down,
                                              const float* __restrict__ sw_gate, const float* __restrict__ sw_up, const float* __restrict__ sw_down, char* ws) {
  const int e = it / 192, j = it % 192;
  const float* W; unsigned char* WT; int K, N, kt, nt; float sc;
  if (j < 64) { W = (e < 256) ? w_gate + (size_t)e * DM * EFF : sw_gate; WT = (unsigned char*)ws + ((e < 256) ? WS_WTG8 + (size_t)e * EFF * DM : WS_WTSG8); K = DM; N = EFF; nt = j & 7; kt = j >> 3; sc = SC_WG; }
  else if (j < 128) { W = (e < 256) ? w_up + (size_t)e * DM * EFF : sw_up; WT = (unsigned char*)ws + ((e < 256) ? WS_WTU8 + (size_t)e * EFF * DM : WS_WTSU8); K = DM; N = EFF; nt = (j - 64) & 7; kt = (j - 64) >> 3; sc = SC_WU; }
  else { W = (e < 256) ? w_down + (size_t)e * EFF * DM : sw_down; WT = (unsigned char*)ws + ((e < 256) ? WS_WTD8 + (size_t)e * DM * EFF : WS_WTSD8); K = EFF; N = DM; nt = (j - 128) & 31; kt = (j - 128) >> 5; sc = SC_WD; }
  CvtTile t;
  t.src = W + (size_t)(kt * 128 + (lane >> 3)) * N + nt * 32 + 4 * (lane & 7);
  t.dst = WT + (size_t)(nt * 32) * K + kt * 128;
  t.ldn = 8 * N; t.K = K; t.scale = sc;
  t.perm = (j >= 128) ? 1 : 0;
  return t;
}
__device__ __forceinline__ void cvt_load(const CvtTile& t, f32x4 (&v)[16]) {
#pragma unroll
  for (int i = 0; i < 16; ++i) v[i] = *(const f32x4*)(t.src + (size_t)i * t.ldn);
}
__device__ __forceinline__ void cvt_store(float* tile  , int lane, const CvtTile& t, const f32x4 (&v)[16]) {
#pragma unroll
  for (int i = 0; i < 16; ++i) {
    float* p = tile + ((lane >> 3) + 8 * i) * 33 + 4 * (lane & 7);
    p[0] = v[i][0]; p[1] = v[i][1]; p[2] = v[i][2]; p[3] = v[i][3];
  }
  const int c = lane & 7;
  int kk[16];
#pragma unroll
  for (int tt = 0; tt < 16; ++tt)
    kk[tt] = t.perm ? (32 * (c >> 1) + 16 * ((tt >> 2) & 1) + 4 * (2 * (c & 1) + (tt >> 3)) + (tt & 3)) : (16 * c + tt);
  const float sc = t.scale;
#pragma unroll
  for (int i = 0; i < 4; ++i) {
    const int n = (lane >> 3) + 8 * i;
    u32x4 w;
#pragma unroll
    for (int d = 0; d < 4; ++d) {
      int pk = 0;
      pk = __builtin_amdgcn_cvt_pk_fp8_f32(tile[kk[4 * d + 0] * 33 + n] * sc, tile[kk[4 * d + 1] * 33 + n] * sc, pk, false);
      pk = __builtin_amdgcn_cvt_pk_fp8_f32(tile[kk[4 * d + 2] * 33 + n] * sc, tile[kk[4 * d + 3] * 33 + n] * sc, pk, true);
      w[d] = (unsigned)pk;
    }
    *(u32x4*)(t.dst + (size_t)n * t.K + 16 * c) = w;
  }
}

__device__ __forceinline__ void ph_proj(unsigned char* smem, int xcd, int l, const bf16_t* __restrict__ xbf, const bf16_t* __restrict__ wt, bf16_t* __restrict__ proj, float* __restrict__ ba, bf16_t* __restrict__ vt) {
  const int mi = l >> 3, ni = l & 7;
  LdRowBF16T<3> al; al.init([&](int r) { return xbf + (size_t)((xcd * 32 + mi) * 128 + r) * DM; }, (size_t)8 * 128 * DM * 2, 0);
  LdRowBF16T<3> bl; bl.init([&](int r) { return wt + (size_t)(ni * 128 + r) * DM; }, 0, (size_t)8 * 128 * DM * 2);
  gemm_stream<16>(smem, al, bl, 12, [&](int seg, f32x4 (&acc)[4][4], unsigned char* fbuf) {
    GEMM_IDS
    const int nt = (seg % 3) * 8 + ni;
    if (nt < 23) {
      const int m0 = (xcd * 32 + (seg / 3) * 8 + mi) * 128, n0 = nt * 128;
      if (n0 + 128 <= PROJW) store_tile_bf16(fbuf, acc, [&](int r) { return proj + (size_t)(m0 + r) * PROJW + n0; });
      else
#pragma unroll
      for (int m = 0; m < 4; ++m)
#pragma unroll
        for (int n = 0; n < 4; ++n) {
          const int row = m0 + wr * 64 + m * 16 + fr, col = n0 + wc * 64 + n * 16 + fq * 4;
          if (col < PROJW) {
            u32x2 w; w[0] = pack2(acc[m][n][0], acc[m][n][1]); w[1] = pack2(acc[m][n][2], acc[m][n][3]);
            *(u32x2*)(proj + (size_t)row * PROJW + col) = w;
          } else if (col < INC) {
            *(f32x4*)(ba + (size_t)row * 8 + (col - PROJW)) = acc[m][n];
          }
        }
      if (n0 == OFF_SV) {
        const int bb = m0 / SEQ, t0_ = m0 % SEQ;
        store_tile_bf16_T(fbuf, acc, [&](int c) { return vt + ((size_t)(bb * 128 + c)) * SEQ + t0_; });
      }
    }
  });
}

__device__ __forceinline__ bf16x8 pack8(f32x4 a, f32x4 b) {
  union { bf16x8 v; unsigned u[4]; } x;
  x.u[0] = pack2(a[0], a[1]); x.u[1] = pack2(a[2], a[3]); x.u[2] = pack2(b[0], b[1]); x.u[3] = pack2(b[2], b[3]);
  return x.v;
}
__device__ __forceinline__ void ph_dnchunk(unsigned char* smem, int item, const bf16_t* __restrict__ proj, const float* __restrict__ ba, const float* __restrict__ conv_w,
                                           const float* __restrict__ a_log, const float* __restrict__ dt_bias,
                                           bf16_t* __restrict__ QD, bf16_t* __restrict__ W0N, bf16_t* __restrict__ KTT, bf16_t* __restrict__ RV,
                                           bf16_t* __restrict__ TM, bf16_t* __restrict__ ATT, float* __restrict__ GL) {
  const int tid = TIDX, lane = tid & 63, w = tid >> 6, fr = lane & 15, fq = lane >> 4;
  const int n = item & 63, h = (item >> 6) & 3, b = item >> 8;
  const int t0 = n * 64; const size_t row0 = (size_t)b * SEQ + t0;
  unsigned char* qs = smem; unsigned char* ks = smem + 16384; float* AT = (float*)(smem + 32768);
  const float scale = 0.08838834764831845f;
  float bL, gcL;
  {
    const float* bap = ba + (row0 + lane) * 8;
    bL = sigmoidf(bap[h]);
    const float xx = bap[4 + h] + dt_bias[h];
    const float sp = fmaxf(xx, 0.f) + log1pf(__expf(-fabsf(xx)));
    float gg = -__expf(a_log[h]) * sp;
#pragma unroll
    for (int o = 1; o < 64; o <<= 1) { const float v = __shfl_up(gg, o); if (lane >= o) gg += v; }
    gcL = gg;
  }
  {
    const int d = 2 * lane;
    float cw[3][4][2];
#pragma unroll
    for (int mx = 0; mx < 3; ++mx)
#pragma unroll
      for (int j = 0; j < 4; ++j) {
        const float2 c2 = *(const float2*)(conv_w + j * 1536 + mx * 512 + h * 128 + d);
        cw[mx][j][0] = c2.x; cw[mx][j][1] = c2.y;
      }
    const bf16_t* pbase = proj + (row0 + 16 * w) * PROJW + h * 128 + d;
    unsigned raw[3][19];
#pragma unroll
    for (int j = 0; j < 19; ++j) {
      const bool ok = (t0 + 16 * w - 3 + j) >= 0;
#pragma unroll
      for (int mx = 0; mx < 3; ++mx) {
        unsigned u = 0;
        if (ok) u = *(const unsigned*)(pbase + (ptrdiff_t)(j - 3) * PROJW + mx * 512);
        raw[mx][j] = u;
      }
    }
#pragma unroll
    for (int i = 0; i < 16; ++i) {
      float s[3][2];
#pragma unroll
      for (int mx = 0; mx < 3; ++mx) {
        float y0 = 0.f, y1 = 0.f;
#pragma unroll
        for (int j = 0; j < 4; ++j) { y0 += cw[mx][j][0] * bflo(raw[mx][i + j]); y1 += cw[mx][j][1] * bfhi(raw[mx][i + j]); }
        s[mx][0] = siluf(y0); s[mx][1] = siluf(y1);
      }
      const int row = 16 * w + i;
      const float rq = rsqrtf(wave_sum(s[0][0] * s[0][0] + s[0][1] * s[0][1]) + L2_EPS);
      const float rk = rsqrtf(wave_sum(s[1][0] * s[1][0] + s[1][1] * s[1][1]) + L2_EPS);
      const int off = row * 256 + ((((lane >> 2) ^ (row & 15))) << 4) + (lane & 3) * 4;
      *(unsigned*)(qs + off) = pack2(s[0][0] * rq, s[0][1] * rq);
      *(unsigned*)(ks + off) = pack2(s[1][0] * rk, s[1][1] * rk);
      const float bi = __shfl(bL, row);
      *(unsigned*)(RV + ((size_t)item * 64 + row) * 128 + d) = pack2(bi * s[2][0], bi * s[2][1]);
    }
  }
  __syncthreads();
  {
    f32x4 aKK[4], aQK[4];
#pragma unroll
    for (int nt = 0; nt < 4; ++nt) { aKK[nt] = (f32x4){0.f, 0.f, 0.f, 0.f}; aQK[nt] = (f32x4){0.f, 0.f, 0.f, 0.f}; }
#pragma unroll
    for (int k4 = 0; k4 < 4; ++k4) {
      const int arow = 16 * w + fr;
      const bf16x8 aq = *(const bf16x8*)(qs + arow * 256 + ((((k4 * 4 + fq) ^ (arow & 15))) << 4));
      const bf16x8 ak = *(const bf16x8*)(ks + arow * 256 + ((((k4 * 4 + fq) ^ (arow & 15))) << 4));
#pragma unroll
      for (int nt = 0; nt < 4; ++nt) {
        const int brow = 16 * nt + fr;
        const bf16x8 bk = *(const bf16x8*)(ks + brow * 256 + ((((k4 * 4 + fq) ^ (brow & 15))) << 4));
        aKK[nt] = __builtin_amdgcn_mfma_f32_16x16x32_bf16(ak, bk, aKK[nt], 0, 0, 0);
        aQK[nt] = __builtin_amdgcn_mfma_f32_16x16x32_bf16(bk, aq, aQK[nt], 0, 0, 0);
      }
    }
    float gci[4], bi[4];
#pragma unroll
    for (int r = 0; r < 4; ++r) { gci[r] = __shfl(gcL, 16 * w + 4 * fq + r); bi[r] = __shfl(bL, 16 * w + 4 * fq + r); }
    const float gci2 = __shfl(gcL, 16 * w + fr);
#pragma unroll
    for (int nt = 0; nt < 4; ++nt) {
      const int j = 16 * nt + fr;
      const float gcj = __shfl(gcL, j);
      float av[4], at[4];
#pragma unroll
      for (int r = 0; r < 4; ++r) {
        const int i = 16 * w + 4 * fq + r;
        const float dec = (j <= i) ? __expf(gci[r] - gcj) : 0.f;
        av[r] = (j < i) ? bi[r] * aKK[nt][r] * dec : 0.f;
        const int i2 = 16 * w + fr, j2 = 16 * nt + 4 * fq + r;
        const float gcj2 = __shfl(gcL, j2);
        const float dec2 = (j2 <= i2) ? __expf(gci2 - gcj2) : 0.f;
        at[r] = aQK[nt][r] * scale * dec2;
      }
      *(float4*)(AT + j * 68 + 16 * w + 4 * fq) = make_float4(av[0], av[1], av[2], av[3]);
      u32x2 wv; wv[0] = pack2(at[0], at[1]); wv[1] = pack2(at[2], at[3]);
      *(u32x2*)(ATT + ((size_t)item * 64 + 16 * w + fr) * 64 + 32 * (nt >> 1) + 8 * fq + 4 * (nt & 1)) = wv;
    }
  }
  __syncthreads();
  if (w == 0) {
    float Tr[64];
    int ln = lane; asm volatile("" : "+v"(ln));
#pragma unroll
    for (int j = 0; j < 64; ++j) Tr[j] = 0.f;
    f32x4 cur[16], nxt[16];
#pragma unroll
    for (int j4 = 0; j4 < 16; ++j4) nxt[j4] = (f32x4){0.f, 0.f, 0.f, 0.f};
#pragma unroll
    for (int j4 = 15; j4 >= 16; --j4) cur[j4] = *(const f32x4*)(AT + 63 * 68 + j4 * 4);
#pragma unroll
    for (int c = 63; c >= 0; --c) {
      if (c > 0) {
#pragma unroll
        for (int j4 = 15; j4 >= c / 4; --j4) nxt[j4] = *(const f32x4*)(AT + (c - 1) * 68 + j4 * 4);
      }
      float a0 = 0.f, a1 = 0.f, a2 = 0.f, a3 = 0.f;
#pragma unroll
      for (int j4 = 15; j4 >= (c + 1) / 4; --j4) {
        asm volatile("v_fmac_f32 %0, %1, %2" : "+v"(a0) : "v"(Tr[4 * j4 + 0]), "v"(cur[j4][0]));
        asm volatile("v_fmac_f32 %0, %1, %2" : "+v"(a1) : "v"(Tr[4 * j4 + 1]), "v"(cur[j4][1]));
        asm volatile("v_fmac_f32 %0, %1, %2" : "+v"(a2) : "v"(Tr[4 * j4 + 2]), "v"(cur[j4][2]));
        asm volatile("v_fmac_f32 %0, %1, %2" : "+v"(a3) : "v"(Tr[4 * j4 + 3]), "v"(cur[j4][3]));
      }
      Tr[c] = ((ln == c) ? 1.f : 0.f) - ((a0 + a1) + (a2 + a3));
#pragma unroll
      for (int j4 = 0; j4 < 16; ++j4) cur[j4] = nxt[j4];
    }
    u32x4* tp = (u32x4*)(TM + ((size_t)item * 64 + lane) * 64);
#pragma unroll
    for (int oc = 0; oc < 8; ++oc) {
      const int k0 = 32 * (oc >> 2) + 4 * (oc & 3);
      u32x4 v;
      v[0] = pack2(Tr[k0 + 0], Tr[k0 + 1]); v[1] = pack2(Tr[k0 + 2], Tr[k0 + 3]);
      v[2] = pack2(Tr[k0 + 16], Tr[k0 + 17]); v[3] = pack2(Tr[k0 + 18], Tr[k0 + 19]);
      tp[oc] = v;
    }
  } else {
    const float gclast = __shfl(gcL, 63);
    if (tid == 64) GL[item] = __expf(gclast);
#pragma unroll 1
    for (int it = 0; it < 16; ++it) {
      const int idx = (tid - 64) + it * 192;
      const int mtx = idx >> 10, rem = idx & 1023;
      if (mtx < 2) {
        const int i = rem >> 4, oc = rem & 15;
        const float gi = __shfl(gcL, i), bi = __shfl(bL, i);
        const float f = (mtx == 0) ? scale * __expf(gi) : -bi * __expf(gi);
        const unsigned char* st = (mtx == 0) ? qs : ks;
        const int d0 = 32 * (oc >> 2) + 4 * (oc & 3);
        const uint2 lo = *(const uint2*)(st + i * 256 + ((((d0 >> 3) ^ (i & 15))) << 4) + (d0 & 7) * 2);
        const uint2 hi = *(const uint2*)(st + i * 256 + (((((d0 + 16) >> 3) ^ (i & 15))) << 4) + (d0 & 7) * 2);
        u32x4 v;
        v[0] = pack2(bflo(lo.x) * f, bfhi(lo.x) * f); v[1] = pack2(bflo(lo.y) * f, bfhi(lo.y) * f);
        v[2] = pack2(bflo(hi.x) * f, bfhi(hi.x) * f); v[3] = pack2(bflo(hi.y) * f, bfhi(hi.y) * f);
        bf16_t* dst = ((mtx == 0) ? QD : W0N) + ((size_t)item * 64 + i) * 128 + 8 * oc;
        *(u32x4*)dst = v;
      } else {
        const int d = rem & 127, oc = rem >> 7;
        const int j0 = 32 * (oc >> 2) + 4 * (oc & 3);
        float val[8];
#pragma unroll
        for (int e = 0; e < 8; ++e) {
          const int j = j0 + (e & 3) + ((e >> 2) << 4);
          const float f = __expf(gclast - __shfl(gcL, j));
          const unsigned short raw = *(const unsigned short*)(ks + j * 256 + ((((d >> 3) ^ (j & 15))) << 4) + (d & 7) * 2);
          val[e] = bf2f(raw) * f;
        }
        u32x4 v;
        v[0] = pack2(val[0], val[1]); v[1] = pack2(val[2], val[3]); v[2] = pack2(val[4], val[5]); v[3] = pack2(val[6], val[7]);
        *(u32x4*)(KTT + ((size_t)item * 128 + d) * 64 + 8 * oc) = v;
      }
    }
  }
  __syncthreads();
}

__device__ __forceinline__ void ph_dnscan(unsigned char* smem, int item, const bf16_t* __restrict__ QDp, const bf16_t* __restrict__ W0Np, const bf16_t* __restrict__ KTTp,
                                          const bf16_t* __restrict__ RVp, const bf16_t* __restrict__ TMp, const bf16_t* __restrict__ ATTp, const float* __restrict__ GLp,
                                          float* __restrict__ op) {
  const int tid = TIDX, lane = tid & 63, w = tid >> 6, fr = lane & 15, fq = lane >> 4;
  const int bh = item >> 1, half = item & 1, b = bh >> 2, h = bh & 3;
  const int vcol0 = (half * 4 + w) * 16;
  unsigned char* sW0 = smem; unsigned char* sQD = smem + 16384; unsigned char* sKT = smem + 32768; unsigned char* sT = smem + 49152; unsigned char* sAT = smem + 57344;
  f32x4 S[8];
#pragma unroll
  for (int t = 0; t < 8; ++t) S[t] = (f32x4){0.f, 0.f, 0.f, 0.f};
  u32x4 pfA[8], pfB[8]; unsigned short rvp[16];
#define DN_LOAD_A(nn_) do { \
    const size_t ci = (size_t)bh * 64 + (nn_); \
    _Pragma("unroll") for (int i = 0; i < 4; ++i) pfA[i] = *(const u32x4*)((const char*)W0Np + ci * 16384 + (size_t)(tid + 256 * i) * 16); \
    _Pragma("unroll") for (int i = 0; i < 4; ++i) pfA[4 + i] = *(const u32x4*)((const char*)QDp + ci * 16384 + (size_t)(tid + 256 * i) * 16); \
    _Pragma("unroll") for (int mt = 0; mt < 4; ++mt) \
      _Pragma("unroll") for (int r = 0; r < 4; ++r) rvp[mt * 4 + r] = RVp[(ci * 64 + 16 * mt + 4 * fq + r) * 128 + vcol0 + fr]; \
  } while (0)
#define DN_STORE_A() do { \
    _Pragma("unroll") for (int i = 0; i < 4; ++i) { const int q = tid + 256 * i, row = q >> 4, ch = q & 15; *(u32x4*)(sW0 + row * 256 + ((ch ^ (row & 15)) << 4)) = pfA[i]; } \
    _Pragma("unroll") for (int i = 0; i < 4; ++i) { const int q = tid + 256 * i, row = q >> 4, ch = q & 15; *(u32x4*)(sQD + row * 256 + ((ch ^ (row & 15)) << 4)) = pfA[4 + i]; } \
  } while (0)
#define DN_LOAD_B(nn_) do { \
    const size_t ci = (size_t)bh * 64 + (nn_); \
    _Pragma("unroll") for (int i = 0; i < 4; ++i) pfB[i] = *(const u32x4*)((const char*)KTTp + ci * 16384 + (size_t)(tid + 256 * i) * 16); \
    _Pragma("unroll") for (int i = 0; i < 2; ++i) pfB[4 + i] = *(const u32x4*)((const char*)TMp + ci * 8192 + (size_t)(tid + 256 * i) * 16); \
    _Pragma("unroll") for (int i = 0; i < 2; ++i) pfB[6 + i] = *(const u32x4*)((const char*)ATTp + ci * 8192 + (size_t)(tid + 256 * i) * 16); \
  } while (0)
#define DN_STORE_B() do { \
    _Pragma("unroll") for (int i = 0; i < 4; ++i) { const int q = tid + 256 * i, row = q >> 3, ch = q & 7; *(u32x4*)(sKT + row * 128 + ((ch ^ (row & 7)) << 4)) = pfB[i]; } \
    _Pragma("unroll") for (int i = 0; i < 2; ++i) { const int q = tid + 256 * i, row = q >> 3, ch = q & 7; *(u32x4*)(sT + row * 128 + ((ch ^ (row & 7)) << 4)) = pfB[4 + i]; } \
    _Pragma("unroll") for (int i = 0; i < 2; ++i) { const int q = tid + 256 * i, row = q >> 3, ch = q & 7; *(u32x4*)(sAT + row * 128 + ((ch ^ (row & 7)) << 4)) = pfB[6 + i]; } \
  } while (0)
#define DN_ZINIT() do { _Pragma("unroll") for (int mt = 0; mt < 4; ++mt) Z[mt] = (f32x4){bf2f(rvp[mt * 4 + 0]), bf2f(rvp[mt * 4 + 1]), bf2f(rvp[mt * 4 + 2]), bf2f(rvp[mt * 4 + 3])}; } while (0)
  __syncthreads();
  f32x4 Z[4];
  DN_LOAD_A(0);
  DN_LOAD_B(0);
  DN_STORE_A();
  DN_ZINIT();
  DN_LOAD_A(1);
  for (int nn = 0; nn < 64; ++nn) {
    const float gl = GLp[(size_t)bh * 64 + nn];
    __syncthreads();
    bf16x8 Sb[4];
#pragma unroll
    for (int k4 = 0; k4 < 4; ++k4) Sb[k4] = pack8(S[2 * k4], S[2 * k4 + 1]);
    f32x4 O[4];
#pragma unroll
    for (int mt = 0; mt < 4; ++mt) {
      O[mt] = (f32x4){0.f, 0.f, 0.f, 0.f};
      const int row = 16 * mt + fr;
#pragma unroll
      for (int k4 = 0; k4 < 4; ++k4) {
        const int off = row * 256 + ((((k4 * 4 + fq) ^ fr)) << 4);
        const bf16x8 aw = *(const bf16x8*)(sW0 + off);
        const bf16x8 aq = *(const bf16x8*)(sQD + off);
        Z[mt] = __builtin_amdgcn_mfma_f32_16x16x32_bf16(aw, Sb[k4], Z[mt], 0, 0, 0);
        O[mt] = __builtin_amdgcn_mfma_f32_16x16x32_bf16(Sb[k4], aq, O[mt], 0, 0, 0);
      }
    }
    bf16x8 Zb[2];
    Zb[0] = pack8(Z[0], Z[1]); Zb[1] = pack8(Z[2], Z[3]);
    DN_STORE_B();
    if (nn + 1 < 64) DN_LOAD_B(nn + 1);
    __syncthreads();
    f32x4 Vn[4];
#pragma unroll
    for (int mt = 0; mt < 4; ++mt) {
      Vn[mt] = (f32x4){0.f, 0.f, 0.f, 0.f};
      const int row = 16 * mt + fr;
#pragma unroll
      for (int s = 0; s < 2; ++s) {
        if (s <= (mt >> 1)) {
          const bf16x8 at = *(const bf16x8*)(sT + row * 128 + ((((s * 4 + fq) ^ (row & 7))) << 4));
          Vn[mt] = __builtin_amdgcn_mfma_f32_16x16x32_bf16(at, Zb[s], Vn[mt], 0, 0, 0);
        }
      }
    }
    bf16x8 Vb[2];
    Vb[0] = pack8(Vn[0], Vn[1]); Vb[1] = pack8(Vn[2], Vn[3]);
#pragma unroll
    for (int mt = 0; mt < 4; ++mt) {
      const int row = 16 * mt + fr;
#pragma unroll
      for (int s = 0; s < 2; ++s) {
        if (s <= (mt >> 1)) {
          const bf16x8 aa = *(const bf16x8*)(sAT + row * 128 + ((((s * 4 + fq) ^ (row & 7))) << 4));
          O[mt] = __builtin_amdgcn_mfma_f32_16x16x32_bf16(Vb[s], aa, O[mt], 0, 0, 0);
        }
      }
      *(f32x4*)(op + ((size_t)b * SEQ + nn * 64 + 16 * mt + fr) * 512 + h * 128 + vcol0 + 4 * fq) = O[mt];
    }
#pragma unroll
    for (int t = 0; t < 8; ++t) {
      S[t] = S[t] * gl;
      const int row = 16 * t + fr;
#pragma unroll
      for (int s = 0; s < 2; ++s) {
        const bf16x8 ak = *(const bf16x8*)(sKT + row * 128 + ((((s * 4 + fq) ^ (row & 7))) << 4));
        S[t] = __builtin_amdgcn_mfma_f32_16x16x32_bf16(ak, Vb[s], S[t], 0, 0, 0);
      }
    }
    if (nn + 1 < 64) {
      DN_STORE_A();
      DN_ZINIT();
      if (nn + 2 < 64) DN_LOAD_A(nn + 2);
    }
  }
  __syncthreads();
#undef DN_ZINIT
#undef DN_LOAD_A
#undef DN_STORE_A
#undef DN_LOAD_B
#undef DN_STORE_B
}

__device__ __forceinline__ void ph_dn_post(int item, const float* __restrict__ o, const bf16_t* __restrict__ proj, const float* __restrict__ dn_norm_g, bf16_t* __restrict__ mixed) {
  const int tid = TIDX, h = tid >> 6, lane = tid & 63;
  const float2 g2 = *(const float2*)(dn_norm_g + 2 * lane);
  float2 ov[4]; unsigned zv[4];
#pragma unroll
  for (int i = 0; i < 4; ++i) {
    const size_t n = (size_t)item * 4 + i;
    ov[i] = *(const float2*)(o + n * 512 + h * 128 + 2 * lane);
    zv[i] = *(const unsigned*)(proj + n * PROJW + OFF_Z + h * 128 + 2 * lane);
  }
#pragma unroll
  for (int i = 0; i < 4; ++i) {
    const size_t n = (size_t)item * 4 + i;
    const float ss = wave_sum(ov[i].x * ov[i].x + ov[i].y * ov[i].y);
    const float rn = rsqrtf(ss * (1.f / 128.f) + RMS_EPS);
    *(unsigned*)(mixed + n * DM + h * 128 + 2 * lane) = pack2(ov[i].x * rn * g2.x * siluf(bflo(zv[i])), ov[i].y * rn * g2.y * siluf(bfhi(zv[i])));
  }
}

__device__ __forceinline__ void ph_swa(unsigned char* smem, int item, const bf16_t* __restrict__ proj, const bf16_t* __restrict__ vt, const float* __restrict__ sinks, bf16_t* __restrict__ mixed) {
  const int tid = TIDX, lane = tid & 63, w = tid >> 6, fr = lane & 15, fq = lane >> 4;
  const int qb = item & 31, kvh = (item >> 5) & 1, b = item >> 6;
  const int t0 = qb * 128;
  const size_t rowb = (size_t)b * SEQ;
  unsigned char* sK = smem;
  unsigned char* sV = smem + 32768;
  __syncthreads();
#pragma unroll
  for (int i = 0; i < 8; ++i) {
    const int q = tid + 256 * i, row = q >> 3, ch = q & 7;
    const int pos = t0 - 128 + row;
    u32x4 v = (u32x4){0u, 0u, 0u, 0u};
    if (pos >= 0) v = *(const u32x4*)(proj + (rowb + pos) * PROJW + OFF_SK + kvh * 64 + ch * 8);
    *(u32x4*)(sK + row * 128 + ((ch ^ (row & 7)) << 4)) = v;
  }
#pragma unroll
  for (int i = 0; i < 8; ++i) {
    const int q = tid + 256 * i, row = q >> 5, ch = q & 31;
    const int pos = t0 - 128 + ch * 8;
    u32x4 v = (u32x4){0u, 0u, 0u, 0u};
    if (pos >= 0) v = *(const u32x4*)(vt + ((size_t)(b * 128 + kvh * 64 + row)) * SEQ + pos);
    *(u32x4*)(sV + row * 512 + ((ch ^ (row & 15)) << 4)) = v;
  }
  __syncthreads();
  const int head = kvh * 4 + w;
  const float slope = exp2f(-(float)(head + 1));
  const float sink = sinks[head];
  const bf16_t* qp0 = proj + (rowb + t0 + fr) * PROJW + OFF_SQ + head * 64 + fq * 8;
  bf16x8 qn0 = *(const bf16x8*)(qp0), qn1 = *(const bf16x8*)(qp0 + 32);
#pragma unroll 1
  for (int qt = 0; qt < 8; ++qt) {
    const bf16x8 qf0 = qn0, qf1 = qn1;
    if (qt < 7) { const bf16_t* qp = qp0 + (size_t)(qt + 1) * 16 * PROJW; qn0 = *(const bf16x8*)(qp); qn1 = *(const bf16x8*)(qp + 32); }
    const int kp0 = qt >> 1;
    f32x4 st[10];
#pragma unroll
    for (int kt = 0; kt < 10; ++kt) {
      const int krow = (2 * kp0 + kt) * 16 + fr;
      st[kt] = (f32x4){0.f, 0.f, 0.f, 0.f};
      const bf16x8 k0 = *(const bf16x8*)(sK + krow * 128 + (((0 + fq) ^ (krow & 7)) << 4));
      const bf16x8 k1 = *(const bf16x8*)(sK + krow * 128 + (((4 + fq) ^ (krow & 7)) << 4));
      st[kt] = __builtin_amdgcn_mfma_f32_16x16x32_bf16(k0, qf0, st[kt], 0, 0, 0);
      st[kt] = __builtin_amdgcn_mfma_f32_16x16x32_bf16(k1, qf1, st[kt], 0, 0, 0);
    }
    const int i = qt * 16 + fr;
    float mx = sink;
#pragma unroll
    for (int kt = 0; kt < 10; ++kt)
#pragma unroll
      for (int r = 0; r < 4; ++r) {
        const int jb = (2 * kp0 + kt) * 16 + 4 * fq + r;
        const int dist = 128 + i - jb;
        const bool ok = (dist >= 0) && (dist < 128) && (t0 - 128 + jb >= 0);
        const float s = ok ? (st[kt][r] * 0.125f - slope * (float)dist) : -INFINITY;
        st[kt][r] = s;
        mx = fmaxf(mx, s);
      }
    mx = fmaxf(mx, __shfl_xor(mx, 16));
    mx = fmaxf(mx, __shfl_xor(mx, 32));
    float sum = 0.f;
#pragma unroll
    for (int kt = 0; kt < 10; ++kt)
#pragma unroll
      for (int r = 0; r < 4; ++r) { const float p = __expf(st[kt][r] - mx); st[kt][r] = p; sum += p; }
    sum += __shfl_xor(sum, 16);
    sum += __shfl_xor(sum, 32);
    const float inv = 1.f / (sum + __expf(sink - mx));
    f32x4 O[4];
#pragma unroll
    for (int nt = 0; nt < 4; ++nt) O[nt] = (f32x4){0.f, 0.f, 0.f, 0.f};
#pragma unroll
    for (int s5 = 0; s5 < 5; ++s5) {
      const bf16x8 pa = pack8(st[2 * s5] * inv, st[2 * s5 + 1] * inv);
      const int key0 = (2 * kp0 + 2 * s5) * 16 + 4 * fq;
#pragma unroll
      for (int nt = 0; nt < 4; ++nt) {
        const int drow = nt * 16 + fr;
        const int c0 = key0 >> 3, c1 = (key0 + 16) >> 3;
        const u32x2 lo = *(const u32x2*)(sV + drow * 512 + ((c0 ^ (drow & 15)) << 4) + ((key0 >> 2) & 1) * 8);
        const u32x2 hi = *(const u32x2*)(sV + drow * 512 + ((c1 ^ (drow & 15)) << 4) + ((key0 >> 2) & 1) * 8);
        const u32x4 vb = (u32x4){lo[0], lo[1], hi[0], hi[1]};
        O[nt] = __builtin_amdgcn_mfma_f32_16x16x32_bf16(__builtin_bit_cast(bf16x8, vb), pa, O[nt], 0, 0, 0);
      }
    }
#pragma unroll
    for (int nt = 0; nt < 4; ++nt) {
      u32x2 wv; wv[0] = pack2(O[nt][0], O[nt][1]); wv[1] = pack2(O[nt][2], O[nt][3]);
      *(u32x2*)(mixed + (rowb + t0 + qt * 16 + fr) * DM + 512 + head * 64 + nt * 16 + 4 * fq) = wv;
    }
  }
}

__device__ __forceinline__ void ph_wout(unsigned char* smem, int xcd, int l, const bf16_t* __restrict__ mixed, const bf16_t* __restrict__ wt, bf16_t* __restrict__ mixo) {
  const int mi = l >> 3, ni = l & 7;
  LdRowBF16 al; al.init([&](int r) { return mixed + (size_t)((xcd * 32 + mi) * 128 + r) * DM; }, (size_t)8 * 128 * DM * 2);
  LdRowBF16 bl; bl.init([&](int r) { return wt + (size_t)(ni * 128 + r) * DM; }, 0);
  gemm_stream<16>(smem, al, bl, 4, [&](int seg, f32x4 (&acc)[4][4], unsigned char* fbuf) {
    const int m0 = (xcd * 32 + seg * 8 + mi) * 128, n0 = ni * 128;
    store_tile_bf16(fbuf, acc, [&](int r) { return mixo + (size_t)(m0 + r) * DM + n0; });
  });
}

__device__ __forceinline__ void ph_ln1(int item, const float* __restrict__ x, const bf16_t* __restrict__ mixo, const float* __restrict__ gam, const float* __restrict__ bet, bf16_t* __restrict__ xbf, unsigned char* __restrict__ x8) {
  const int row = item * 4 + (TIDX >> 6), lane = TIDX & 63;
  const float4* p = (const float4*)(x + (size_t)row * DM);
  const u32x2* pm = (const u32x2*)(mixo + (size_t)row * DM);
  float4 v[4]; float s = 0.f;
#pragma unroll
  for (int i = 0; i < 4; ++i) {
    const float4 xv = p[lane + i * 64]; const u32x2 mv = pm[lane + i * 64];
    v[i].x = ALPHA * xv.x + bflo(mv[0]); v[i].y = ALPHA * xv.y + bfhi(mv[0]); v[i].z = ALPHA * xv.z + bflo(mv[1]); v[i].w = ALPHA * xv.w + bfhi(mv[1]);
    s += v[i].x + v[i].y + v[i].z + v[i].w;
  }
  const float mu = wave_sum(s) * (1.f / DM);
  float q = 0.f;
#pragma unroll
  for (int i = 0; i < 4; ++i) { const float a = v[i].x - mu, b = v[i].y - mu, c = v[i].z - mu, d = v[i].w - mu; q += a * a + b * b + c * c + d * d; }
  const float rs = rsqrtf(wave_sum(q) * (1.f / DM) + LN_EPS);
#pragma unroll
  for (int i = 0; i < 4; ++i) {
    const float4 gg = ((const float4*)gam)[lane + i * 64], bb = ((const float4*)bet)[lane + i * 64];
    u32x2 w;
    w[0] = pack2((v[i].x - mu) * rs * gg.x + bb.x, (v[i].y - mu) * rs * gg.y + bb.y);
    w[1] = pack2((v[i].z - mu) * rs * gg.z + bb.z, (v[i].w - mu) * rs * gg.w + bb.w);
    ((u32x2*)(xbf + (size_t)row * DM))[lane + i * 64] = w;
    int pk = 0;
    pk = __builtin_amdgcn_cvt_pk_fp8_f32((v[i].x - mu) * rs * gg.x + bb.x, (v[i].y - mu) * rs * gg.y + bb.y, pk, false);
    pk = __builtin_amdgcn_cvt_pk_fp8_f32((v[i].z - mu) * rs * gg.z + bb.z, (v[i].w - mu) * rs * gg.w + bb.w, pk, true);
    ((int*)(x8 + (size_t)row * DM))[lane + i * 64] = pk;
  }
}

__device__ __forceinline__ void ph_router(unsigned char* smem, int tile, const bf16_t* __restrict__ xbf, const bf16_t* __restrict__ wt, float* __restrict__ logits) {
  GEMM_IDS
  const int n0 = (tile & 1) * 128, m0 = (tile >> 1) * 128;
  LdRowBF16 al; al.init([&](int r) { return xbf + (size_t)(m0 + r) * DM; }, 0);
  LdRowBF16 bl; bl.init([&](int r) { return wt + (size_t)(n0 + r) * DM; }, 0);
  gemm_stream<16>(smem, al, bl, 1, [&](int seg, f32x4 (&acc)[4][4], unsigned char* fbuf) {
    GEMM_IDS
#pragma unroll
    for (int m = 0; m < 4; ++m)
#pragma unroll
      for (int n = 0; n < 4; ++n)
        *(f32x4*)(logits + (size_t)(m0 + wr * 64 + m * 16 + fr) * NEXP + n0 + wc * 64 + n * 16 + fq * 4) = acc[m][n];
  });
}

__device__ __forceinline__ void ph_route(int item, const float* __restrict__ logits, const float* __restrict__ router_bias, int* __restrict__ cnt, int* __restrict__ list, float* __restrict__ gates) {
  const int n = item * 4 + (TIDX >> 6), lane = TIDX & 63;
  const float4 lg = ((const float4*)(logits + (size_t)n * NEXP))[lane];
  const float4 rb = ((const float4*)router_bias)[lane];
  float sc[4] = {sigmoidf(lg.x), sigmoidf(lg.y), sigmoidf(lg.z), sigmoidf(lg.w)};
  float sel[4] = {sc[0] + rb.x, sc[1] + rb.y, sc[2] + rb.z, sc[3] + rb.w};
  float t1 = fmaxf(sel[0], sel[1]), t2 = fminf(sel[0], sel[1]);
  { const float a = sel[2]; if (a > t1) { t2 = t1; t1 = a; } else if (a > t2) t2 = a; }
  { const float a = sel[3]; if (a > t1) { t2 = t1; t1 = a; } else if (a > t2) t2 = a; }
#pragma unroll
  for (int o = 1; o < 8; o <<= 1) {
    const float b1 = __shfl_xor(t1, o), b2 = __shfl_xor(t2, o);
    const float n1 = fmaxf(t1, b1), n2 = fmaxf(fminf(t1, b1), fmaxf(t2, b2));
    t1 = n1; t2 = n2;
  }
  const float gs = t1 + t2;
  const int mygrp = lane >> 3;
  int rank = 0;
#pragma unroll
  for (int j = 0; j < 8; ++j) {
    const float o = __shfl(gs, j * 8);
    rank += (o > gs || (o == gs && j < mygrp)) ? 1 : 0;
  }
  const bool gsel = rank < 4;
  float cand[4];
#pragma unroll
  for (int i = 0; i < 4; ++i) cand[i] = gsel ? sel[i] : -INFINITY;
  float gsum = 0.f; float myg = 0.f; int mye = 0;
#pragma unroll 1
  for (int r = 0; r < TOPK; ++r) {
    float bv = cand[0]; int bi = 0;
#pragma unroll
    for (int i = 1; i < 4; ++i) if (cand[i] > bv) { bv = cand[i]; bi = i; }
    int be = lane * 4 + bi;
    float bs = (bi == 0) ? sc[0] : (bi == 1) ? sc[1] : (bi == 2) ? sc[2] : sc[3];
#pragma unroll
    for (int o = 1; o < 64; o <<= 1) {
      const float ov = __shfl_xor(bv, o); const int oe = __shfl_xor(be, o); const float os = __shfl_xor(bs, o);
      if (ov > bv || (ov == bv && oe < be)) { bv = ov; be = oe; bs = os; }
    }
    if ((be >> 2) == lane) {
      const int bi2 = be & 3;
      if (bi2 == 0) cand[0] = -INFINITY; else if (bi2 == 1) cand[1] = -INFINITY; else if (bi2 == 2) cand[2] = -INFINITY; else cand[3] = -INFINITY;
    }
    gsum += bs;
    if (lane == r) { myg = bs; mye = be; }
  }
  if (lane < TOPK) {
    const int slot = atomicAdd(&cnt[mye], 1);
    list[(size_t)mye * CAP + slot] = n * TOPK + lane;
    gates[(size_t)n * TOPK + lane] = myg / gsum * 2.5f;
  }
}

__device__ __forceinline__ void moe_build_prefix(const int* __restrict__ cnt, int* sscan) {
  const int tid = TIDX;
  const int e = ((tid & 31) << 3) | (tid >> 5);
  const int c = cnt[e];
  __syncthreads();
  sscan[tid] = (c + 127) >> 7;
  __syncthreads();
  for (int o = 1; o < 256; o <<= 1) {
    const int v = (tid >= o) ? sscan[tid - o] : 0;
    __syncthreads();
    sscan[tid] += v;
    __syncthreads();
  }
}
__device__ __forceinline__ void moe_locate(const int* sscan, int x, int lt, int& e, int& rt) {
  const int base = x ? sscan[32 * x - 1] : 0;
  const int nrouted = sscan[32 * x + 31] - base;
  if (lt >= nrouted) { e = 256; rt = x * (NTOK / 128 / 8) + (lt - nrouted); return; }
  const int g = base + lt;
  int lo = 32 * x, hi = 32 * x + 31;
  while (lo < hi) { const int mid = (lo + hi) >> 1; if (sscan[mid] > g) hi = mid; else lo = mid + 1; }
  e = ((lo & 31) << 3) | (lo >> 5); rt = g - (lo ? sscan[lo - 1] : 0);
}

__device__ __forceinline__ long lo64(const u32x4& v) { return (long)(((unsigned long long)v[1] << 32) | (unsigned long long)v[0]); }
__device__ __forceinline__ long hi64(const u32x4& v) { return (long)(((unsigned long long)v[3] << 32) | (unsigned long long)v[2]); }
__device__ __forceinline__ void ph_moe(unsigned char* smem, int e, int rt, const unsigned char* __restrict__ x8, const bf16_t* __restrict__ xbf, const int* __restrict__ cnt,
                                       const int* __restrict__ list, const float* __restrict__ gates, const unsigned char* __restrict__ wge, const unsigned char* __restrict__ wue,
                                       const unsigned char* __restrict__ wde, unsigned char* __restrict__ ybuf, float* __restrict__ dout, unsigned char* __restrict__ dummy) {
  int* sasg = (int*)(smem + SM_MISC + 2048);
  float* sgate = (float*)(smem + SM_MISC + 2048 + 512);
  const int tid = TIDX, lane = tid & 63, w = tid >> 6, fr = lane & 15, fq = lane >> 4;
  const int rows = (e < 256) ? cnt[e] : NTOK;
  __syncthreads();
  if (tid < 128) {
    const int r = rt * 128 + tid;
    int a = -1;
    if (r < rows) a = (e < 256) ? list[(size_t)e * CAP + r] : (NA + r);
    sasg[tid] = a;
    sgate[tid] = (a >= 0 && a < NA) ? gates[a] : 1.f;
  }
  __syncthreads();
  long hf[2][8];
  {
    LdRowBF16 al; al.init([&](int r) { const int a = sasg[r]; const int tok = (a < 0) ? 0 : (a < NA ? (a >> 3) : (a - NA)); return x8 + (size_t)tok * DM; }, 0);
    LdRowBF16 bl; bl.init([&](int j) {
      const int bn = j >> 4, ff = (bn >> 1) * 16 + (j & 15);
      return ((bn & 1) ? wue : wge) + (size_t)ff * DM; }, (size_t)64 * DM);
    al.issue(0, 0, smem); bl.issue(0, 0, smem + 16384);
    asm volatile("s_waitcnt vmcnt(0)" ::: "memory");
    __syncthreads();
#pragma unroll
    for (int m = 0; m < 2; ++m)
#pragma unroll
      for (int s = 0; s < 8; ++s) hf[m][s] = 0;
#pragma unroll 1
    for (int ct = 0; ct < 4; ++ct) {
      f32x4 acc[2][8];
#pragma unroll
      for (int m = 0; m < 2; ++m)
#pragma unroll
        for (int n = 0; n < 8; ++n) acc[m][n] = (f32x4){0.f, 0.f, 0.f, 0.f};
#pragma unroll 1
      for (int kk = 0; kk < 8; ++kk) {
        const int j = ct * 8 + kk;
        unsigned char* cur = smem + (j & 1) * 32768; unsigned char* nxt = smem + ((j & 1) ^ 1) * 32768;
        if (j + 1 < 32) { al.issue((j + 1) >> 3, (j + 1) & 7, nxt); bl.issue((j + 1) >> 3, (j + 1) & 7, nxt + 16384); }
#pragma unroll
        for (int ks = 0; ks < 2; ++ks) {
          u32x4 a[2], bfrag[8];
#pragma unroll
          for (int m = 0; m < 2; ++m) {
            const int row = w * 32 + m * 16 + fr;
            a[m] = *(const u32x4*)(cur + row * 128 + (((ks * 4 + fq) ^ (row & 7)) << 4));
          }
#pragma unroll
          for (int n = 0; n < 8; ++n) {
            const int row = n * 16 + fr;
            bfrag[n] = *(const u32x4*)(cur + 16384 + row * 128 + (((ks * 4 + fq) ^ (row & 7)) << 4));
          }
          __builtin_amdgcn_s_setprio(1);
#pragma unroll
          for (int n = 0; n < 8; ++n)
#pragma unroll
            for (int m = 0; m < 2; ++m) {
              acc[m][n] = __builtin_amdgcn_mfma_f32_16x16x32_fp8_fp8(lo64(bfrag[n]), lo64(a[m]), acc[m][n], 0, 0, 0);
              acc[m][n] = __builtin_amdgcn_mfma_f32_16x16x32_fp8_fp8(hi64(bfrag[n]), hi64(a[m]), acc[m][n], 0, 0, 0);
            }
          __builtin_amdgcn_s_setprio(0);
          __builtin_amdgcn_sched_group_barrier(0x100, 10, 0);
          __builtin_amdgcn_sched_group_barrier(0x008, 32, 0);
        }
        asm volatile("s_waitcnt vmcnt(0)" ::: "memory");
        __syncthreads();
      }
#pragma unroll
      for (int m = 0; m < 2; ++m) {
        int hp[4][2];
#pragma unroll
        for (int p = 0; p < 4; ++p) {
          float hv[4];
#pragma unroll
          for (int r = 0; r < 4; ++r) hv[r] = siluf(acc[m][2 * p][r] * (1.f / SC_WG)) * acc[m][2 * p + 1][r] * (SC_H / SC_WU);
          int pk = 0;
          pk = __builtin_amdgcn_cvt_pk_fp8_f32(hv[0], hv[1], pk, false);
          pk = __builtin_amdgcn_cvt_pk_fp8_f32(hv[2], hv[3], pk, true);
          hp[p][0] = pk;
        }
        const long h0 = (long)(((unsigned long long)(unsigned)hp[1][0] << 32) | (unsigned long long)(unsigned)hp[0][0]);
        const long h1 = (long)(((unsigned long long)(unsigned)hp[3][0] << 32) | (unsigned long long)(unsigned)hp[2][0]);
        if (ct == 0) { hf[m][0] = h0; hf[m][1] = h1; }
        else if (ct == 1) { hf[m][2] = h0; hf[m][3] = h1; }
        else if (ct == 2) { hf[m][4] = h0; hf[m][5] = h1; }
        else { hf[m][6] = h0; hf[m][7] = h1; }
      }
    }
  }
#define MOE_RAW_BARRIER() do { asm volatile("s_waitcnt lgkmcnt(0)" ::: "memory"); __builtin_amdgcn_s_barrier(); } while (0)
  {
    LdRowBF16 bl; bl.init([&](int j) { return wde + (size_t)j * EFF; }, (size_t)128 * EFF);
    bl.issue(0, 0, smem); bl.issue(0, 1, smem + 16384); bl.issue(1, 0, smem + 32768);
#pragma unroll 1
    for (int ct = 0; ct < 8; ++ct) {
      f32x4 acc[2][8];
#pragma unroll
      for (int m = 0; m < 2; ++m)
#pragma unroll
        for (int n = 0; n < 8; ++n) acc[m][n] = (f32x4){0.f, 0.f, 0.f, 0.f};
#pragma unroll
      for (int kk = 0; kk < 2; ++kk) {
        const int j = ct * 2 + kk;
        if (e < 256) {
          if (kk == 0) {
            if (ct == 0) asm volatile("s_waitcnt vmcnt(8)" ::: "memory");
            else if (ct == 1) asm volatile("s_waitcnt vmcnt(12)" ::: "memory");
            else if (ct < 7) asm volatile("s_waitcnt vmcnt(16)" ::: "memory");
            else asm volatile("s_waitcnt vmcnt(12)" ::: "memory");
          } else {
            if (ct == 0) asm volatile("s_waitcnt vmcnt(8)" ::: "memory");
            else if (ct < 7) asm volatile("s_waitcnt vmcnt(12)" ::: "memory");
            else asm volatile("s_waitcnt vmcnt(4)" ::: "memory");
          }
        } else {
          if (j < 14) asm volatile("s_waitcnt vmcnt(8)" ::: "memory");
          else if (j == 14) asm volatile("s_waitcnt vmcnt(4)" ::: "memory");
          else asm volatile("s_waitcnt vmcnt(0)" ::: "memory");
        }
        MOE_RAW_BARRIER();
        if (j + 3 < 16) bl.issue((j + 3) >> 1, (j + 3) & 1, smem + ((j + 3) & 3) * 16384);
        const unsigned char* cur = smem + (j & 3) * 16384;
#pragma unroll
        for (int s4 = 0; s4 < 4; ++s4) {
          long wf[8];
#pragma unroll
          for (int n = 0; n < 8; ++n) {
            const int row = n * 16 + fr;
            wf[n] = *(const long*)(cur + row * 128 + ((((2 * s4 + (fq >> 1))) ^ (row & 7)) << 4) + (fq & 1) * 8);
          }
          __builtin_amdgcn_s_setprio(1);
#pragma unroll
          for (int n = 0; n < 8; ++n)
#pragma unroll
            for (int m = 0; m < 2; ++m) acc[m][n] = __builtin_amdgcn_mfma_f32_16x16x32_fp8_fp8(wf[n], hf[m][kk * 4 + s4], acc[m][n], 0, 0, 0);
          __builtin_amdgcn_s_setprio(0);
          __builtin_amdgcn_sched_group_barrier(0x100, 8, 0);
          __builtin_amdgcn_sched_group_barrier(0x008, 16, 0);
        }
      }
      const int n0 = ct * 128;
      if (e == 256) {
#pragma unroll
        for (int m = 0; m < 2; ++m) {
          const int a = sasg[w * 32 + m * 16 + fr];
          if (a >= NA) {
            float* dp = dout + (size_t)(a - NA) * DM + n0 + fq * 4;
            const bf16_t* xp = xbf + (size_t)(a - NA) * DM + n0 + fq * 4;
#pragma unroll
            for (int n = 0; n < 8; ++n) {
              const u32x2 xw = *(const u32x2*)(xp + n * 16);
              const f32x4 xv = (f32x4){bflo(xw[0]), bfhi(xw[0]), bflo(xw[1]), bfhi(xw[1])};
              *(f32x4*)(dp + n * 16) = xv * ALPHA + acc[m][n] * (1.f / (SC_H * SC_WD));
            }
          }
        }
      } else {
        unsigned char* stg = smem + ((2 * ct + 1) & 3) * 16384 + w * 4096;
        MOE_RAW_BARRIER();
#pragma unroll
        for (int m = 0; m < 2; ++m) {
          const int row = m * 16 + fr;
          const float gt = sgate[w * 32 + row] * (SC_Y / (SC_H * SC_WD));
#pragma unroll
          for (int n = 0; n < 8; ++n) {
            int pk = 0;
            pk = __builtin_amdgcn_cvt_pk_fp8_f32(acc[m][n][0] * gt, acc[m][n][1] * gt, pk, false);
            pk = __builtin_amdgcn_cvt_pk_fp8_f32(acc[m][n][2] * gt, acc[m][n][3] * gt, pk, true);
            *(int*)(stg + row * 128 + ((n ^ (row & 7)) << 4) + 4 * fq) = pk;
          }
        }
#pragma unroll
        for (int i = 0; i < 4; ++i) {
          const int q = lane + 64 * i, row = q >> 3, ch = q & 7;
          const int a = sasg[w * 32 + row];
          unsigned char* yp = ((a >= 0) ? ybuf + (size_t)a * DM : dummy) + n0 + ch * 16;
          *(u32x4*)yp = *(const u32x4*)(stg + row * 128 + ((ch ^ (row & 7)) << 4));
        }
      }
    }
    MOE_RAW_BARRIER();
  }
#undef MOE_RAW_BARRIER
}

__device__ __forceinline__ void ph_final(int item, float* __restrict__ out, const unsigned char* __restrict__ ybuf, const float* __restrict__ gam, const float* __restrict__ bet) {
  const int row = item * 4 + (TIDX >> 6), lane = TIDX & 63;
  f32x4* p = (f32x4*)(out + (size_t)row * DM + 16 * lane);
  f32x4 v[4];
#pragma unroll
  for (int i = 0; i < 4; ++i) v[i] = p[i];
  u32x4 yv[8];
#pragma unroll
  for (int k = 0; k < 8; ++k) yv[k] = *(const u32x4*)(ybuf + ((size_t)row * 8 + k) * DM + 16 * lane);
  float ys[16];
#pragma unroll
  for (int c = 0; c < 16; ++c) ys[c] = 0.f;
#pragma unroll
  for (int k = 0; k < 8; ++k)
#pragma unroll
    for (int d = 0; d < 4; ++d) {
      const hwf32x2 lo = __builtin_amdgcn_cvt_pk_f32_fp8((int)yv[k][d], false), hi = __builtin_amdgcn_cvt_pk_f32_fp8((int)yv[k][d], true);
      ys[4 * d + 0] += lo[0]; ys[4 * d + 1] += lo[1]; ys[4 * d + 2] += hi[0]; ys[4 * d + 3] += hi[1];
    }
  float s = 0.f;
#pragma unroll
  for (int i = 0; i < 4; ++i)
#pragma unroll
    for (int r = 0; r < 4; ++r) { v[i][r] += ys[4 * i + r] * (1.f / 32.f); s += v[i][r]; }
  const float mu = wave_sum(s) * (1.f / DM);
  float q = 0.f;
#pragma unroll
  for (int i = 0; i < 4; ++i)
#pragma unroll
    for (int r = 0; r < 4; ++r) { const float d = v[i][r] - mu; q += d * d; }
  const float rs = rsqrtf(wave_sum(q) * (1.f / DM) + LN_EPS);
#pragma unroll
  for (int i = 0; i < 4; ++i) {
    const f32x4 gg = *(const f32x4*)(gam + 16 * lane + 4 * i), bb = *(const f32x4*)(bet + 16 * lane + 4 * i);
    p[i] = (v[i] - mu) * rs * gg + bb;
  }
}

#define XB_TMO      128
#define XB_XCNT(j)  (256  + 64 * (j))
#define XB_XSUB(j)  (1280 + 64 * (j))
#define XB_XGEN(j)  (2304 + 64 * (j))
#define XB_TOP      3328
#define XB_TOPGEN   3392
#define XCD_BAR_WORDS 3456
#define XB_SPIN_CAP (1u << 22)
#define LAS __attribute__((address_space(3)))
__device__ __forceinline__ unsigned xb_ld(unsigned* p)              { return __hip_atomic_load(p, __ATOMIC_RELAXED, __HIP_MEMORY_SCOPE_AGENT); }
__device__ __forceinline__ unsigned xb_add(unsigned* p, unsigned v) { return __hip_atomic_fetch_add(p, v, __ATOMIC_RELAXED, __HIP_MEMORY_SCOPE_AGENT); }
__device__ __forceinline__ unsigned xb_xcc_id() { return (unsigned)__builtin_amdgcn_s_getreg((3 << 11) | 20) & 0xFu; }
#define XB_SPIN(cond, bar) do { unsigned _sp = 0; while (cond) { __builtin_amdgcn_s_sleep(1); \
    if ((++_sp & 255u) == 0u) { if (xb_ld(&(bar)[XB_TMO])) break; if (_sp > XB_SPIN_CAP) { atomicAdd(&(bar)[XB_TMO], 1u); break; } } } } while (0)
struct XcdBarrier { unsigned* bar; unsigned x; volatile LAS unsigned* st; };
__device__ __forceinline__ XcdBarrier xcd_barrier_post(unsigned* bar, volatile LAS unsigned* st) {
  XcdBarrier b; b.bar = bar; b.x = xb_xcc_id(); b.st = st;
  if (threadIdx.x == 0) (void)xb_add(&bar[XB_XCNT(b.x)], 1u);
  return b;
}
__device__ __forceinline__ void xcd_barrier_complete(unsigned* bar, unsigned x, unsigned& nloc, unsigned& nx) {
  const unsigned G = gridDim.x * gridDim.y * gridDim.z;
  unsigned sum, cnt, mine, sp = 0u;
  for (;;) {
    sum = 0u; cnt = 0u; mine = 0u;
#pragma unroll
    for (unsigned j = 0; j < 16; ++j) { const unsigned c = xb_ld(&bar[XB_XCNT(j)]); sum += c; cnt += (c > 0u) ? 1u : 0u; mine = (j == x) ? c : mine; }
    if (sum == G) break;
    __builtin_amdgcn_s_sleep(1);
    if ((++sp & 255u) == 0u) { if (xb_ld(&bar[XB_TMO])) break; if (sp > XB_SPIN_CAP) { atomicAdd(&bar[XB_TMO], 1u); break; } }
  }
  nloc = mine > 0u ? mine : 1u; nx = cnt > 0u ? cnt : 1u;
}
__device__ __forceinline__ void xcd_barrier(const XcdBarrier& b) {
  asm volatile("s_waitcnt vmcnt(0)" ::: "memory");
  __syncthreads();
  if (threadIdx.x == 0) {
    unsigned* bar = b.bar;
    __builtin_amdgcn_s_waitcnt(0);
    unsigned nloc = b.st[0], nx = b.st[1];
    if (nloc == 0u) { xcd_barrier_complete(bar, b.x, nloc, nx); b.st[0] = nloc; b.st[1] = nx; }
    const unsigned old = xb_add(&bar[XB_XSUB(b.x)], 1u);
    const unsigned gen = old / nloc;
    if (old + 1u == (gen + 1u) * nloc) {
      __builtin_amdgcn_fence(__ATOMIC_RELEASE, "agent");
      asm volatile("s_waitcnt vmcnt(0)" ::: "memory");
      const unsigned og = xb_add(&bar[XB_TOP], 1u);
      const unsigned tg = og / nx;
      if (og + 1u == (tg + 1u) * nx) xb_add(&bar[XB_TOPGEN], 1u);
      else XB_SPIN(xb_ld(&bar[XB_TOPGEN]) == tg, bar);
      __builtin_amdgcn_fence(__ATOMIC_ACQUIRE, "agent");
      xb_add(&bar[XB_XGEN(b.x)], 1u);
      asm volatile("s_waitcnt vmcnt(0)" ::: "memory");
    } else {
      XB_SPIN(xb_ld(&bar[XB_XGEN(b.x)]) == gen, bar);
      __builtin_amdgcn_fence(__ATOMIC_ACQUIRE, "agent");
      asm volatile("s_waitcnt vmcnt(0)" ::: "memory");
    }
  }
  __syncthreads();
}

__global__ void __launch_bounds__(256, 2) mega(Params P) {
  __shared__ __attribute__((aligned(16))) unsigned char smem[SMEM_BYTES];
  const int bid = blockIdx.x, nblk = gridDim.x;
#define xin (P.in[0])
#define w_in (P.in[1])
#define conv_w (P.in[2])
#define a_log (P.in[3])
#define dt_bias (P.in[4])
#define dn_norm_g (P.in[5])
#define sinks (P.in[6])
#define w_out (P.in[7])
#define ln1_g (P.in[8])
#define ln1_b (P.in[9])
#define router_w (P.in[10])
#define router_bias (P.in[11])
#define w_gate (P.in[12])
#define w_up (P.in[13])
#define w_down (P.in[14])
#define sw_gate (P.in[15])
#define sw_up (P.in[16])
#define sw_down (P.in[17])
#define ln2_g (P.in[18])
#define ln2_b (P.in[19])
#define outp (P.out)
#define x1bf ((bf16_t*)(P.ws + WS_X1BF))
#define logits ((float*)(P.ws + WS_LOGIT))
#define list ((int*)(P.ws + WS_LIST))
#define gates ((float*)(P.ws + WS_GATES))
#define cnt ((int*)(P.ws + WS_CTRL))
#define barw ((unsigned*)(P.ws + WS_CTRL + 4096))
#define mixed ((bf16_t*)(P.ws + WS_MIXED))
#define proj ((bf16_t*)(P.ws + WS_PROJ))
#define ba ((float*)(P.ws + WS_BA))
#define QD ((bf16_t*)(P.ws + WS_QD))
#define W0N ((bf16_t*)(P.ws + WS_W0N))
#define KTT ((bf16_t*)(P.ws + WS_KTT))
#define RV ((bf16_t*)(P.ws + WS_RV))
#define TM ((bf16_t*)(P.ws + WS_TM))
#define ATT ((bf16_t*)(P.ws + WS_ATT))
#define GL ((float*)(P.ws + WS_GL))
#define obuf ((float*)(P.ws + WS_O))
#define VTb ((bf16_t*)(P.ws + WS_VT))
#define MIXO ((bf16_t*)(P.ws + WS_O))
#define XBF ((bf16_t*)(P.ws + WS_XBF))
#define WTIN ((bf16_t*)(P.ws + WS_WTIN))
#define WTOUT ((bf16_t*)(P.ws + WS_WTOUT))
#define WTR ((bf16_t*)(P.ws + WS_WTR))
#define ybuf ((unsigned char*)(P.ws + WS_YBUF))
  {
    volatile LAS unsigned* st0 = (volatile LAS unsigned*)(smem + SM_MISC + 4080);
    if (threadIdx.x == 0) { st0[0] = 0u; st0[1] = 0u; }
    __syncthreads();
  }
  const int xcd = bid & 7, xloc = bid >> 3, xnl = nblk >> 3;
  XcdBarrier xb = xcd_barrier_post(barw, (volatile LAS unsigned*)(smem + SM_MISC + 4080));
  for (int it = bid; it < NTOK / 8; it += nblk) { ph_cvt_x(2 * it, xin, XBF); ph_cvt_x(2 * it + 1, xin, XBF); }
  for (int it = bid; it < 16 * 46 + 16 * 16 + 16 * 4; it += nblk) {
    if (it < 16 * 46) ph_cvt_wt(smem, it % 16, it / 16, w_in, DM, INC, WTIN);
    else if (it < 16 * 46 + 256) { const int j = it - 16 * 46; ph_cvt_wt(smem, j % 16, j / 16, w_out, DM, DM, WTOUT); }
    else { const int j = it - 16 * 46 - 256; ph_cvt_wt(smem, j % 16, j / 16, router_w, DM, NEXP, WTR); }
  }
  xcd_barrier(xb);
  for (int l = xloc; l < 64; l += xnl) ph_proj(smem, xcd, l, XBF, WTIN, proj, ba, VTb);
  xcd_barrier(xb);
  for (int it = bid; it < 2048; it += nblk) ph_dnchunk(smem, it, proj, ba, conv_w, a_log, dt_bias, QD, W0N, KTT, RV, TM, ATT, GL);
  for (int it = bid; it < 512; it += nblk) ph_swa(smem, it, proj, VTb, sinks, mixed);
  xcd_barrier(xb);
  {
    const bool is512 = (nblk == 512);
    const bool scan_blk = (bid < 64) || (nblk <= 64);
    const bool swa_blk = is512 && bid >= 256 && bid < 320;
    if (scan_blk) { for (int it = bid; it < 64; it += nblk) ph_dnscan(smem, it, QD, W0N, KTT, RV, TM, ATT, GL, obuf); }
    if (swa_blk) { }
    else {
      const int tid = TIDX, lane = tid & 63, wv = tid >> 6;
      float* tile = (float*)(smem + wv * 16896);
      const int total = 257 * 192;
      const int T1 = is512 ? (total - 64 * 4 * 12) : ((nblk > 64) ? total : 0);
      int it, step, end;
      if (is512 && bid < 64) { it = T1 + bid * 4 + wv; step = 64 * 4; end = total; }
      else if (is512) { const int cb = (bid < 256) ? (bid - 64) : (bid - 128); it = cb * 4 + wv; step = 384 * 4; end = T1; }
      else if (nblk > 64) { if (bid < 64) { it = 0; step = 1; end = 0; } else { it = (bid - 64) * 4 + wv; step = (nblk - 64) * 4; end = total; } }
      else { it = bid * 4 + wv; step = nblk * 4; end = total; }
      f32x4 vc[16], vn[16];
      CvtTile tc = cvt_decode(it < end ? it : 0, lane, w_gate, w_up, w_down, sw_gate, sw_up, sw_down, P.ws);
      if (it < end) cvt_load(tc, vc);
      while (it < end) {
        const int itn = it + step;
        CvtTile tn = cvt_decode(itn < end ? itn : 0, lane, w_gate, w_up, w_down, sw_gate, sw_up, sw_down, P.ws);
        if (itn < end) cvt_load(tn, vn);
        cvt_store(tile, lane, tc, vc);
#pragma unroll
        for (int i = 0; i < 16; ++i) vc[i] = vn[i];
        tc = tn; it = itn;
      }
    }
  }
  xcd_barrier(xb);
  for (int it = bid; it < NTOK / 4; it += nblk) ph_dn_post(it, obuf, proj, dn_norm_g, mixed);
  xcd_barrier(xb);
  for (int l = xloc; l < 64; l += xnl) ph_wout(smem, xcd, l, mixed, WTOUT, MIXO);
  xcd_barrier(xb);
  for (int it = bid; it < NTOK / 4; it += nblk) ph_ln1(it, xin, MIXO, ln1_g, ln1_b, x1bf, (unsigned char*)(P.ws + WS_X1F8));
  xcd_barrier(xb);
  for (int i = xloc; i < 32 * 2; i += xnl) ph_router(smem, (xcd * 32 + i / 2) * 2 + i % 2, x1bf, WTR, logits);
  xcd_barrier(xb);
  for (int it = bid; it < NTOK / 4; it += nblk) ph_route(it, logits, router_bias, cnt, list, gates);
  xcd_barrier(xb);
  int* sscan = (int*)(smem + SM_MISC);
  moe_build_prefix(cnt, sscan);
  const int ntile = sscan[32 * xcd + 31] - (xcd ? sscan[32 * xcd - 1] : 0) + NTOK / 128 / 8;
  for (int it = xloc; it < ntile; it += xnl) {
    int e, rt; moe_locate(sscan, xcd, it, e, rt);
    ph_moe(smem, e, rt, (const unsigned char*)(P.ws + WS_X1F8), x1bf, cnt, list, gates,
           (const unsigned char*)P.ws + ((e < 256) ? WS_WTG8 + (size_t)e * EFF * DM : WS_WTSG8), (const unsigned char*)P.ws + ((e < 256) ? WS_WTU8 + (size_t)e * EFF * DM : WS_WTSU8),
           (const unsigned char*)P.ws + ((e < 256) ? WS_WTD8 + (size_t)e * DM * EFF : WS_WTSD8), ybuf, outp, (unsigned char*)(P.ws + WS_DUMMY));
  }
  xcd_barrier(xb);
  for (int it = bid; it < NTOK / 4; it += nblk) ph_final(it, outp, ybuf, ln2_g, ln2_b);
}

#undef xin
#undef w_in
#undef conv_w
#undef a_log
#undef dt_bias
#undef dn_norm_g
#undef sinks
#undef w_out
#undef ln1_g
#undef ln1_b
#undef router_w
#undef router_bias
#undef w_gate
#undef w_up
#undef w_down
#undef sw_gate
#undef sw_up
#undef sw_down
#undef ln2_g
#undef ln2_b
#undef outp
#undef x1bf
#undef logits
#undef list
#undef gates
#undef cnt
#undef mixed
#undef proj
#undef ba
#undef QD
#undef W0N
#undef KTT
#undef RV
#undef TM
#undef ATT
#undef GL
#undef obuf
#undef ybuf
#undef VTb
#undef MIXO
#undef XBF
#undef WTIN
#undef WTOUT
#undef WTR
#undef barw

extern "C" void kernel_launch(void* const* d_in, const int* in_sizes, int n_in, void* d_out, int out_size, void* d_ws, size_t ws_size, hipStream_t stream) {
  static int grid_blocks = 0;
  if (!grid_blocks) {
    int dev = 0, cus = 0, per_cu = 0;
    (void)hipGetDevice(&dev);
    (void)hipDeviceGetAttribute(&cus, hipDeviceAttributeMultiprocessorCount, dev);
    (void)hipOccupancyMaxActiveBlocksPerMultiprocessor(&per_cu, mega, 256, 0);
    if (per_cu > 2) per_cu = 2;
    if (per_cu < 1) per_cu = 1;
    grid_blocks = cus * per_cu;
  }
  Params p{};
  for (int i = 0; i < 20; ++i) p.in[i] = (const float*)d_in[i];
  p.out = (float*)d_out; p.ws = (char*)d_ws;
  (void)hipMemsetAsync((char*)d_ws + WS_CTRL, 0, 4096 + XCD_BAR_WORDS * 4, stream);
  void* args[] = {&p};
  hipError_t e = hipLaunchCooperativeKernel((void*)mega, dim3(grid_blocks), dim3(256), args, 0, stream);
  if (e != hipSuccess) fprintf(stderr, "cooperative launch failed: %s (grid %d)\n", hipGetErrorString(e), grid_blocks);
}
```

```cpp
#include <hip/hip_runtime.h>
#include <hip/hip_cooperative_groups.h>
#include <stdint.h>
#include <stdio.h>
namespace cg = cooperative_groups;

typedef __attribute__((ext_vector_type(8))) short bf16x8;
typedef __attribute__((ext_vector_type(4))) float f32x4;
typedef unsigned short bf16_t;
typedef __attribute__((ext_vector_type(4))) unsigned u32x4;
typedef __attribute__((ext_vector_type(2))) unsigned u32x2;

constexpr int NTOK = 32768, SEQ = 4096, DM = 1024;
constexpr int INC = 2824, PROJW = 2816;
constexpr int OFF_DQ = 0, OFF_DK = 512, OFF_DV = 1024, OFF_SQ = 1536, OFF_SK = 2048, OFF_SV = 2176, OFF_Z = 2304;
constexpr int NEXP = 256, TOPK = 8, EFF = 256;
constexpr int NA = NTOK * TOPK;
constexpr int NSH = 16, CAPS = NTOK / NSH;
constexpr int CNT16_OFF = 32768;
constexpr float ALPHA = 1.189207115002721f;
constexpr float LN_EPS = 1e-5f, RMS_EPS = 1e-6f, L2_EPS = 1e-6f;
constexpr float SC_WG = 32.f, SC_WU = 64.f, SC_WD = 32.f, SC_H = 8.f, SC_Y = 32.f;

constexpr size_t MiB = 1024ull * 1024ull;
constexpr size_t WS_WTD8 = 0;
constexpr size_t WS_WTG8 = 64 * MiB;
constexpr size_t WS_WTU8 = 128 * MiB;
constexpr size_t WS_WTSG8 = 192 * MiB;
constexpr size_t WS_WTSU8 = WS_WTSG8 + 256 * 1024;
constexpr size_t WS_WTSD8 = WS_WTSG8 + 512 * 1024;
constexpr size_t WS_X1F8 = 200 * MiB;
constexpr size_t WS_YBUF = 384 * MiB;
constexpr size_t WS_LOGIT = 384 * MiB;
constexpr size_t WS_X1BF = 896 * MiB;
constexpr size_t WS_LIST = 960 * MiB;
constexpr size_t WS_GATES = 992 * MiB;
constexpr size_t WS_CTRL = 993 * MiB;
constexpr size_t WS_WTIN = 994 * MiB;
constexpr size_t WS_WTOUT = 1000 * MiB;
constexpr size_t WS_WTR = 1002 * MiB;
constexpr size_t WS_DUMMY = 1005 * MiB;
constexpr size_t WS_PROJ = 384 * MiB;
constexpr size_t WS_BA = 560 * MiB;
constexpr size_t WS_QD = 561 * MiB;
constexpr size_t WS_W0N = 593 * MiB;
constexpr size_t WS_KTT = 625 * MiB;
constexpr size_t WS_RV = 657 * MiB;
constexpr size_t WS_TM = 689 * MiB;
constexpr size_t WS_ATT = 705 * MiB;
constexpr size_t WS_GL = 721 * MiB;
constexpr size_t WS_O = 722 * MiB;
constexpr size_t WS_VT = 786 * MiB;
constexpr size_t WS_MIXED = 794 * MiB;
constexpr size_t WS_XBF = 640 * MiB;

__device__ __forceinline__ int opaque_tid() { int t = threadIdx.x; asm volatile("" : "+v"(t)); return t; }
#define TIDX opaque_tid()
typedef __attribute__((ext_vector_type(2))) __bf16 hwbf16x2;
typedef __attribute__((ext_vector_type(2))) float hwf32x2;
__device__ __forceinline__ unsigned pack2(float lo, float hi) {
  hwf32x2 f = {lo, hi};
  return __builtin_bit_cast(unsigned, __builtin_convertvector(f, hwbf16x2));
}
__device__ __forceinline__ unsigned f2bf(float f) { return pack2(f, 0.f) & 0xffffu; }
__device__ __forceinline__ float bf2f(unsigned h) { return __uint_as_float(h << 16); }
__device__ __forceinline__ float bflo(unsigned w) { return __uint_as_float(w << 16); }
__device__ __forceinline__ float bfhi(unsigned w) { return __uint_as_float(w & 0xffff0000u); }
__device__ __forceinline__ float siluf(float x) { return x * __builtin_amdgcn_rcpf(1.f + __expf(-x)); }
__device__ __forceinline__ float sigmoidf(float x) { return __builtin_amdgcn_rcpf(1.f + __expf(-x)); }
#define DPP_ADD_(v, ctrl, rmask) v += __builtin_bit_cast(float, __builtin_amdgcn_update_dpp(0, __builtin_bit_cast(int, v), ctrl, rmask, 0xf, false))
__device__ __forceinline__ float wave_sum(float v) {
  DPP_ADD_(v, 0xB1, 0xf);
  DPP_ADD_(v, 0x4E, 0xf);
  DPP_ADD_(v, 0x141, 0xf);
  DPP_ADD_(v, 0x140, 0xf);
  DPP_ADD_(v, 0x142, 0xa);
  DPP_ADD_(v, 0x143, 0xc);
  return __builtin_bit_cast(float, __builtin_amdgcn_readlane(__builtin_bit_cast(int, v), 63));
}

template <int SEGDIV>
struct LdRowBF16T {
  const char* p[4]; size_t seghi, seglo; int tid16;
  template <class F> __device__ __forceinline__ void init(F rowptr, size_t hi, size_t lo = 0) {
    const int tid = TIDX; const int slot = tid & 7, row0 = tid >> 3; seghi = hi; seglo = lo; tid16 = tid * 16;
#pragma unroll
    for (int i = 0; i < 4; ++i) p[i] = (const char*)rowptr(row0 + i * 32) + ((slot ^ (row0 & 7)) << 4);
  }
  __device__ __forceinline__ void issue(int seg, int kk, unsigned char* lds) {
    const size_t off = (size_t)(seg / SEGDIV) * seghi + (size_t)(seg % SEGDIV) * seglo + (size_t)kk * 128;
#pragma unroll
    for (int i = 0; i < 4; ++i)
      __builtin_amdgcn_global_load_lds((const unsigned*)(p[i] + off), (__attribute__((address_space(3))) unsigned*)(lds + tid16 + i * 4096), 16, 0, 0);
  }
};
typedef LdRowBF16T<1> LdRowBF16;
__device__ __forceinline__ void gemm_kstep(const unsigned char* sA, const unsigned char* sB, f32x4 (&acc)[4][4], int wr, int wc, int fr, int fq) {
#pragma unroll
  for (int ks = 0; ks < 2; ++ks) {
    bf16x8 a[4], b[4];
#pragma unroll
    for (int m = 0; m < 4; ++m) {
      const int row = wr * 64 + m * 16 + fr;
      a[m] = *(const bf16x8*)(sA + row * 128 + (((ks * 4 + fq) ^ (row & 7)) << 4));
    }
#pragma unroll
    for (int n = 0; n < 4; ++n) {
      const int row = wc * 64 + n * 16 + fr;
      b[n] = *(const bf16x8*)(sB + row * 128 + (((ks * 4 + fq) ^ (row & 7)) << 4));
    }
    __builtin_amdgcn_s_setprio(1);
#pragma unroll
    for (int m = 0; m < 4; ++m)
#pragma unroll
      for (int n = 0; n < 4; ++n) acc[m][n] = __builtin_amdgcn_mfma_f32_16x16x32_bf16(b[n], a[m], acc[m][n], 0, 0, 0);
    __builtin_amdgcn_s_setprio(0);
  }
}
template <int KPER, class AL, class BL, class Epi>
__device__ __forceinline__ void gemm_stream(unsigned char* smem, AL& al, BL& bl, int nseg, Epi epi) {
  const int tid = TIDX, lane = tid & 63, wid = tid >> 6, wr = wid >> 1, wc = wid & 1, fr = lane & 15, fq = lane >> 4;
  const int total = nseg * KPER;
  f32x4 acc[4][4];
  al.issue(0, 0, smem); bl.issue(0, 0, smem + 16384);
  asm volatile("s_waitcnt vmcnt(0)" ::: "memory");
  __syncthreads();
  for (int j = 0; j < total; ++j) {
    unsigned char* cur = smem + (j & 1) * 32768; unsigned char* nxt = smem + ((j & 1) ^ 1) * 32768;
    if (j + 1 < total) { al.issue((j + 1) / KPER, (j + 1) % KPER, nxt); bl.issue((j + 1) / KPER, (j + 1) % KPER, nxt + 16384); }
    if (j % KPER == 0) {
#pragma unroll
      for (int m = 0; m < 4; ++m)
#pragma unroll
        for (int n = 0; n < 4; ++n) acc[m][n] = (f32x4){0.f, 0.f, 0.f, 0.f};
    }
    gemm_kstep(cur, cur + 16384, acc, wr, wc, fr, fq);
    asm volatile("s_waitcnt vmcnt(0)" ::: "memory");
    __syncthreads();
    if ((j + 1) % KPER == 0) epi((j + 1) / KPER - 1, acc, cur);
  }
}

template <class RowDst>
__device__ __forceinline__ void store_tile_bf16(unsigned char* fbuf, const f32x4 (&acc)[4][4], RowDst rowdst) {
  const int tid = TIDX, lane = tid & 63, wid = tid >> 6, wr = wid >> 1, wc = wid & 1, fr = lane & 15, fq = lane >> 4;
#pragma unroll
  for (int m = 0; m < 4; ++m) {
    const int row = wr * 64 + m * 16 + fr;
#pragma unroll
    for (int n = 0; n < 4; ++n) {
      const int col = wc * 64 + n * 16 + fq * 4;
      u32x2 w; w[0] = pack2(acc[m][n][0], acc[m][n][1]); w[1] = pack2(acc[m][n][2], acc[m][n][3]);
      *(u32x2*)(fbuf + row * 256 + (((col >> 3) ^ (row & 15)) << 4) + ((col >> 2) & 1) * 8) = w;
    }
  }
  __syncthreads();
#pragma unroll
  for (int i = 0; i < 8; ++i) {
    const int q = tid + 256 * i, row = q >> 4, ch = q & 15;
    *(u32x4*)(rowdst(row) + ch * 8) = *(const u32x4*)(fbuf + row * 256 + ((ch ^ (row & 15)) << 4));
  }
  __syncthreads();
}

template <class RowDst>
__device__ __forceinline__ void store_tile_bf16_T(unsigned char* fbuf, const f32x4 (&acc)[4][4], RowDst rowdst) {
  const int tid = TIDX, lane = tid & 63, wid = tid >> 6, wr = wid >> 1, wc = wid & 1, fr = lane & 15, fq = lane >> 4;
#pragma unroll
  for (int m = 0; m < 4; ++m) {
    const int t = wr * 64 + m * 16 + fr;
#pragma unroll
    for (int n = 0; n < 4; ++n)
#pragma unroll
      for (int r = 0; r < 4; ++r) {
        const int c = wc * 64 + n * 16 + fq * 4 + r;
        *(unsigned short*)(fbuf + c * 256 + ((((t >> 3) ^ (c & 15))) << 4) + (t & 7) * 2) = (unsigned short)f2bf(acc[m][n][r]);
      }
  }
  __syncthreads();
#pragma unroll
  for (int i = 0; i < 8; ++i) {
    const int q = tid + 256 * i, row = q >> 4, ch = q & 15;
    *(u32x4*)(rowdst(row) + ch * 8) = *(const u32x4*)(fbuf + row * 256 + ((ch ^ (row & 15)) << 4));
  }
  __syncthreads();
}

#define GEMM_IDS const int tid = TIDX, lane = tid & 63, wid = tid >> 6, wr = wid >> 1, wc = wid & 1, fr = lane & 15, fq = lane >> 4; (void)tid; (void)lane;

struct Params {
  const float* in[20];
  float* out;
  char* ws;
};

constexpr int SMEM_BYTES = 69632;
constexpr int SM_MISC = 65536;

__device__ __forceinline__ void ph_cvt_x(int item, const float* __restrict__ x, bf16_t* __restrict__ xbf) {
  const int tid = TIDX;
  const size_t base = (size_t)item * 4096 + (size_t)tid * 4;
#pragma unroll
  for (int i = 0; i < 4; ++i) {
    const f32x4 v = *(const f32x4*)(x + base + (size_t)i * 1024);
    u32x2 w; w[0] = pack2(v[0], v[1]); w[1] = pack2(v[2], v[3]);
    *(u32x2*)(xbf + base + (size_t)i * 1024) = w;
  }
}
__device__ __forceinline__ void ph_cvt_wt(unsigned char* smem, int kt, int nt, const float* __restrict__ W, int K, int N, bf16_t* __restrict__ WT, bool perm = false) {
  float* tile = (float*)smem;
  const int tid = TIDX;
  const int k0 = kt * 64, n0 = nt * 64;
  __syncthreads();
#pragma unroll
  for (int i = 0; i < 4; ++i) {
    const int k = (tid >> 4) + 16 * i, n = 4 * (tid & 15);
    f32x4 v = (f32x4){0.f, 0.f, 0.f, 0.f};
    if (n0 + n < N) v = *(const f32x4*)(W + (size_t)(k0 + k) * N + n0 + n);
    tile[k * 65 + n + 0] = v[0]; tile[k * 65 + n + 1] = v[1]; tile[k * 65 + n + 2] = v[2]; tile[k * 65 + n + 3] = v[3];
  }
  __syncthreads();
  const int n = tid >> 2, kq = tid & 3;
  u32x4 w0, w1;
#pragma unroll
  for (int j = 0; j < 4; ++j) {
    w0[j] = pack2(tile[(kq * 16 + 2 * j) * 65 + n], tile[(kq * 16 + 2 * j + 1) * 65 + n]);
    w1[j] = pack2(tile[(kq * 16 + 8 + 2 * j) * 65 + n], tile[(kq * 16 + 8 + 2 * j + 1) * 65 + n]);
  }
  if (!perm) {
    bf16_t* dst = WT + (size_t)(n0 + n) * K + k0 + kq * 16;
    *(u32x4*)dst = w0; *(u32x4*)(dst + 8) = w1;
  } else {
    const int blk = kq >> 1, hi = kq & 1;
    bf16_t* dst = WT + (size_t)(n0 + n) * K + k0 + blk * 32 + 4 * hi;
    u32x2 a; a[0] = w0[0]; a[1] = w0[1]; *(u32x2*)(dst + 0) = a;
    a[0] = w0[2]; a[1] = w0[3]; *(u32x2*)(dst + 8) = a;
    a[0] = w1[0]; a[1] = w1[1]; *(u32x2*)(dst + 16) = a;
    a[0] = w1[2]; a[1] = w1[3]; *(u32x2*)(dst + 24) = a;
  }
}

struct CvtTile { const float* src; unsigned char* dst; int ldn; int K; int perm; float scale; };
__device__ __forceinline__ CvtTile cvt_decode(int it, int lane, const float* __restrict__ w_gate, const float* __restrict__ w_up, const float* __restrict__ w_down,
                                              const float* __restrict__ sw_gate, const float* __restrict__ sw_up, const float* __restrict__ sw_down, char* ws) {
  const int e = it / 192, j = it % 192;
  const float* W; unsigned char* WT; int K, N, kt, nt; float sc;
  if (j < 64) { W = (e < 256) ? w_gate + (size_t)e * DM * EFF : sw_gate; WT = (unsigned char*)ws + ((e < 256) ? WS_WTG8 + (size_t)e * EFF * DM : WS_WTSG8); K = DM; N = EFF; nt = j & 7; kt = j >> 3; sc = SC_WG; }
  else if (j < 128) { W = (e < 256) ? w_up + (size_t)e * DM * EFF : sw_up; WT = (unsigned char*)ws + ((e < 256) ? WS_WTU8 + (size_t)e * EFF * DM : WS_WTSU8); K = DM; N = EFF; nt = (j - 64) & 7; kt = (j - 64) >> 3; sc = SC_WU; }
  else { W = (e < 256) ? w_down + (size_t)e * EFF * DM : sw_down; WT = (unsigned char*)ws + ((e < 256) ? WS_WTD8 + (size_t)e * DM * EFF : WS_WTSD8); K = EFF; N = DM; nt = (j - 128) & 31; kt = (j - 128) >> 5; sc = SC_WD; }
  CvtTile t;
  t.src = W + (size_t)(kt * 128 + (lane >> 3)) * N + nt * 32 + 4 * (lane & 7);
  t.dst = WT + (size_t)(nt * 32) * K + kt * 128;
  t.ldn = 8 * N; t.K = K; t.scale = sc;
  t.perm = (j >= 128) ? 1 : 0;
  return t;
}
__device__ __forceinline__ void cvt_load(const CvtTile& t, f32x4 (&v)[16]) {
#pragma unroll
  for (int i = 0; i < 16; ++i) v[i] = *(const f32x4*)(t.src + (size_t)i * t.ldn);
}
__device__ __forceinline__ void cvt_store(float* tile  , int lane, const CvtTile& t, const f32x4 (&v)[16]) {
#pragma unroll
  for (int i = 0; i < 16; ++i) {
    float* p = tile + ((lane >> 3) + 8 * i) * 33 + 4 * (lane & 7);
    p[0] = v[i][0]; p[1] = v[i][1]; p[2] = v[i][2]; p[3] = v[i][3];
  }
  const int c = lane & 7;
  int kk[16];
#pragma unroll
  for (int tt = 0; tt < 16; ++tt)
    kk[tt] = t.perm ? (32 * (c >> 1) + 16 * ((tt >> 2) & 1) + 4 * (2 * (c & 1) + (tt >> 3)) + (tt & 3)) : (16 * c + tt);
  const float sc = t.scale;
#pragma unroll
  for (int i = 0; i < 4; ++i) {
    const int n = (lane >> 3) + 8 * i;
    u32x4 w;
#pragma unroll
    for (int d = 0; d < 4; ++d) {
      int pk = 0;
      pk = __builtin_amdgcn_cvt_pk_fp8_f32(tile[kk[4 * d + 0] * 33 + n] * sc, tile[kk[4 * d + 1] * 33 + n] * sc, pk, false);
      pk = __builtin_amdgcn_cvt_pk_fp8_f32(tile[kk[4 * d + 2] * 33 + n] * sc, tile[kk[4 * d + 3] * 33 + n] * sc, pk, true);
      w[d] = (unsigned)pk;
    }
    *(u32x4*)(t.dst + (size_t)n * t.K + 16 * c) = w;
  }
}

__device__ __forceinline__ void ph_proj(unsigned char* smem, int xcd, int l, const bf16_t* __restrict__ xbf, const bf16_t* __restrict__ wt, bf16_t* __restrict__ proj, float* __restrict__ ba, bf16_t* __restrict__ vt) {
  const int mi = l >> 3, ni = l & 7;
  LdRowBF16T<3> al; al.init([&](int r) { return xbf + (size_t)((xcd * 32 + mi) * 128 + r) * DM; }, (size_t)8 * 128 * DM * 2, 0);
  LdRowBF16T<3> bl; bl.init([&](int r) { return wt + (size_t)(ni * 128 + r) * DM; }, 0, (size_t)8 * 128 * DM * 2);
  gemm_stream<16>(smem, al, bl, 12, [&](int seg, f32x4 (&acc)[4][4], unsigned char* fbuf) {
    GEMM_IDS
    const int nt = (seg % 3) * 8 + ni;
    if (nt < 23) {
      const int m0 = (xcd * 32 + (seg / 3) * 8 + mi) * 128, n0 = nt * 128;
      if (n0 + 128 <= PROJW) store_tile_bf16(fbuf, acc, [&](int r) { return proj + (size_t)(m0 + r) * PROJW + n0; });
      else
#pragma unroll
      for (int m = 0; m < 4; ++m)
#pragma unroll
        for (int n = 0; n < 4; ++n) {
          const int row = m0 + wr * 64 + m * 16 + fr, col = n0 + wc * 64 + n * 16 + fq * 4;
          if (col < PROJW) {
            u32x2 w; w[0] = pack2(acc[m][n][0], acc[m][n][1]); w[1] = pack2(acc[m][n][2], acc[m][n][3]);
            *(u32x2*)(proj + (size_t)row * PROJW + col) = w;
          } else if (col < INC) {
            *(f32x4*)(ba + (size_t)row * 8 + (col - PROJW)) = acc[m][n];
          }
        }
      if (n0 == OFF_SV) {
        const int bb = m0 / SEQ, t0_ = m0 % SEQ;
        store_tile_bf16_T(fbuf, acc, [&](int c) { return vt + ((size_t)(bb * 128 + c)) * SEQ + t0_; });
      }
    }
  });
}

__device__ __forceinline__ bf16x8 pack8(f32x4 a, f32x4 b) {
  union { bf16x8 v; unsigned u[4]; } x;
  x.u[0] = pack2(a[0], a[1]); x.u[1] = pack2(a[2], a[3]); x.u[2] = pack2(b[0], b[1]); x.u[3] = pack2(b[2], b[3]);
  return x.v;
}
__device__ __forceinline__ void ph_dnchunk(unsigned char* smem, int item, const bf16_t* __restrict__ proj, const float* __restrict__ ba, const float* __restrict__ conv_w,
                                           const float* __restrict__ a_log, const float* __restrict__ dt_bias,
                                           bf16_t* __restrict__ QD, bf16_t* __restrict__ W0N, bf16_t* __restrict__ KTT, bf16_t* __restrict__ RV,
                                           bf16_t* __restrict__ TM, bf16_t* __restrict__ ATT, float* __restrict__ GL) {
  const int tid = TIDX, lane = tid & 63, w = tid >> 6, fr = lane & 15, fq = lane >> 4;
  const int n = item & 63, h = (item >> 6) & 3, b = item >> 8;
  const int t0 = n * 64; const size_t row0 = (size_t)b * SEQ + t0;
  unsigned char* qs = smem; unsigned char* ks = smem + 16384; float* AT = (float*)(smem + 32768);
  const float scale = 0.08838834764831845f;
  float bL, gcL;
  {
    const float* bap = ba + (row0 + lane) * 8;
    bL = sigmoidf(bap[h]);
    const float xx = bap[4 + h] + dt_bias[h];
    const float sp = fmaxf(xx, 0.f) + log1pf(__expf(-fabsf(xx)));
    float gg = -__expf(a_log[h]) * sp;
#pragma unroll
    for (int o = 1; o < 64; o <<= 1) { const float v = __shfl_up(gg, o); if (lane >= o) gg += v; }
    gcL = gg;
  }
  {
    const int d = 2 * lane;
    float cw[3][4][2];
#pragma unroll
    for (int mx = 0; mx < 3; ++mx)
#pragma unroll
      for (int j = 0; j < 4; ++j) {
        const float2 c2 = *(const float2*)(conv_w + j * 1536 + mx * 512 + h * 128 + d);
        cw[mx][j][0] = c2.x; cw[mx][j][1] = c2.y;
      }
    const bf16_t* pbase = proj + (row0 + 16 * w) * PROJW + h * 128 + d;
    unsigned raw[3][19];
#pragma unroll
    for (int j = 0; j < 19; ++j) {
      const bool ok = (t0 + 16 * w - 3 + j) >= 0;
#pragma unroll
      for (int mx = 0; mx < 3; ++mx) {
        unsigned u = 0;
        if (ok) u = *(const unsigned*)(pbase + (ptrdiff_t)(j - 3) * PROJW + mx * 512);
        raw[mx][j] = u;
      }
    }
#pragma unroll
    for (int i = 0; i < 16; ++i) {
      float s[3][2];
#pragma unroll
      for (int mx = 0; mx < 3; ++mx) {
        float y0 = 0.f, y1 = 0.f;
#pragma unroll
        for (int j = 0; j < 4; ++j) { y0 += cw[mx][j][0] * bflo(raw[mx][i + j]); y1 += cw[mx][j][1] * bfhi(raw[mx][i + j]); }
        s[mx][0] = siluf(y0); s[mx][1] = siluf(y1);
      }
      const int row = 16 * w + i;
      const float rq = rsqrtf(wave_sum(s[0][0] * s[0][0] + s[0][1] * s[0][1]) + L2_EPS);
      const float rk = rsqrtf(wave_sum(s[1][0] * s[1][0] + s[1][1] * s[1][1]) + L2_EPS);
      const int off = row * 256 + ((((lane >> 2) ^ (row & 15))) << 4) + (lane & 3) * 4;
      *(unsigned*)(qs + off) = pack2(s[0][0] * rq, s[0][1] * rq);
      *(unsigned*)(ks + off) = pack2(s[1][0] * rk, s[1][1] * rk);
      const float bi = __shfl(bL, row);
      *(unsigned*)(RV + ((size_t)item * 64 + row) * 128 + d) = pack2(bi * s[2][0], bi * s[2][1]);
    }
  }
  __syncthreads();
  {
    f32x4 aKK[4], aQK[4];
#pragma unroll
    for (int nt = 0; nt < 4; ++nt) { aKK[nt] = (f32x4){0.f, 0.f, 0.f, 0.f}; aQK[nt] = (f32x4){0.f, 0.f, 0.f, 0.f}; }
#pragma unroll
    for (int k4 = 0; k4 < 4; ++k4) {
      const int arow = 16 * w + fr;
      const bf16x8 aq = *(const bf16x8*)(qs + arow * 256 + ((((k4 * 4 + fq) ^ (arow & 15))) << 4));
      const bf16x8 ak = *(const bf16x8*)(ks + arow * 256 + ((((k4 * 4 + fq) ^ (arow & 15))) << 4));
#pragma unroll
      for (int nt = 0; nt < 4; ++nt) {
        const int brow = 16 * nt + fr;
        const bf16x8 bk = *(const bf16x8*)(ks + brow * 256 + ((((k4 * 4 + fq) ^ (brow & 15))) << 4));
        aKK[nt] = __builtin_amdgcn_mfma_f32_16x16x32_bf16(ak, bk, aKK[nt], 0, 0, 0);
        aQK[nt] = __builtin_amdgcn_mfma_f32_16x16x32_bf16(bk, aq, aQK[nt], 0, 0, 0);
      }
    }
    float gci[4], bi[4];
#pragma unroll
    for (int r = 0; r < 4; ++r) { gci[r] = __shfl(gcL, 16 * w + 4 * fq + r); bi[r] = __shfl(bL, 16 * w + 4 * fq + r); }
    const float gci2 = __shfl(gcL, 16 * w + fr);
#pragma unroll
    for (int nt = 0; nt < 4; ++nt) {
      const int j = 16 * nt + fr;
      const float gcj = __shfl(gcL, j);
      float av[4], at[4];
#pragma unroll
      for (int r = 0; r < 4; ++r) {
        const int i = 16 * w + 4 * fq + r;
        const float dec = (j <= i) ? __expf(gci[r] - gcj) : 0.f;
        av[r] = (j < i) ? bi[r] * aKK[nt][r] * dec : 0.f;
        const int i2 = 16 * w + fr, j2 = 16 * nt + 4 * fq + r;
        const float gcj2 = __shfl(gcL, j2);
        const float dec2 = (j2 <= i2) ? __expf(gci2 - gcj2) : 0.f;
        at[r] = aQK[nt][r] * scale * dec2;
      }
      *(float4*)(AT + j * 68 + 16 * w + 4 * fq) = make_float4(av[0], av[1], av[2], av[3]);
      u32x2 wv; wv[0] = pack2(at[0], at[1]); wv[1] = pack2(at[2], at[3]);
      *(u32x2*)(ATT + ((size_t)item * 64 + 16 * w + fr) * 64 + 32 * (nt >> 1) + 8 * fq + 4 * (nt & 1)) = wv;
    }
  }
  __syncthreads();
  if (w == 0) {
    float Tr[64];
    int ln = lane; asm volatile("" : "+v"(ln));
#pragma unroll
    for (int j = 0; j < 64; ++j) Tr[j] = 0.f;
    f32x4 cur[16], nxt[16];
#pragma unroll
    for (int j4 = 0; j4 < 16; ++j4) nxt[j4] = (f32x4){0.f, 0.f, 0.f, 0.f};
#pragma unroll
    for (int j4 = 15; j4 >= 16; --j4) cur[j4] = *(const f32x4*)(AT + 63 * 68 + j4 * 4);
#pragma unroll
    for (int c = 63; c >= 0; --c) {
      if (c > 0) {
#pragma unroll
        for (int j4 = 15; j4 >= c / 4; --j4) nxt[j4] = *(const f32x4*)(AT + (c - 1) * 68 + j4 * 4);
      }
      float a0 = 0.f, a1 = 0.f, a2 = 0.f, a3 = 0.f;
#pragma unroll
      for (int j4 = 15; j4 >= (c + 1) / 4; --j4) {
        asm volatile("v_fmac_f32 %0, %1, %2" : "+v"(a0) : "v"(Tr[4 * j4 + 0]), "v"(cur[j4][0]));
        asm volatile("v_fmac_f32 %0, %1, %2" : "+v"(a1) : "v"(Tr[4 * j4 + 1]), "v"(cur[j4][1]));
        asm volatile("v_fmac_f32 %0, %1, %2" : "+v"(a2) : "v"(Tr[4 * j4 + 2]), "v"(cur[j4][2]));
        asm volatile("v_fmac_f32 %0, %1, %2" : "+v"(a3) : "v"(Tr[4 * j4 + 3]), "v"(cur[j4][3]));
      }
      Tr[c] = ((ln == c) ? 1.f : 0.f) - ((a0 + a1) + (a2 + a3));
#pragma unroll
      for (int j4 = 0; j4 < 16; ++j4) cur[j4] = nxt[j4];
    }
    u32x4* tp = (u32x4*)(TM + ((size_t)item * 64 + lane) * 64);
#pragma unroll
    for (int oc = 0; oc < 8; ++oc) {
      const int k0 = 32 * (oc >> 2) + 4 * (oc & 3);
      u32x4 v;
      v[0] = pack2(Tr[k0 + 0], Tr[k0 + 1]); v[1] = pack2(Tr[k0 + 2], Tr[k0 + 3]);
      v[2] = pack2(Tr[k0 + 16], Tr[k0 + 17]); v[3] = pack2(Tr[k0 + 18], Tr[k0 + 19]);
      tp[oc] = v;
    }
  } else {
    const float gclast = __shfl(gcL, 63);
    if (tid == 64) GL[item] = __expf(gclast);
#pragma unroll 1
    for (int it = 0; it < 16; ++it) {
      const int idx = (tid - 64) + it * 192;
      const int mtx = idx >> 10, rem = idx & 1023;
      if (mtx < 2) {
        const int i = rem >> 4, oc = rem & 15;
        const float gi = __shfl(gcL, i), bi = __shfl(bL, i);
        const float f = (mtx == 0) ? scale * __expf(gi) : -bi * __expf(gi);
        const unsigned char* st = (mtx == 0) ? qs : ks;
        const int d0 = 32 * (oc >> 2) + 4 * (oc & 3);
        const uint2 lo = *(const uint2*)(st + i * 256 + ((((d0 >> 3) ^ (i & 15))) << 4) + (d0 & 7) * 2);
        const uint2 hi = *(const uint2*)(st + i * 256 + (((((d0 + 16) >> 3) ^ (i & 15))) << 4) + (d0 & 7) * 2);
        u32x4 v;
        v[0] = pack2(bflo(lo.x) * f, bfhi(lo.x) * f); v[1] = pack2(bflo(lo.y) * f, bfhi(lo.y) * f);
        v[2] = pack2(bflo(hi.x) * f, bfhi(hi.x) * f); v[3] = pack2(bflo(hi.y) * f, bfhi(hi.y) * f);
        bf16_t* dst = ((mtx == 0) ? QD : W0N) + ((size_t)item * 64 + i) * 128 + 8 * oc;
        *(u32x4*)dst = v;
      } else {
        const int d = rem & 127, oc = rem >> 7;
        const int j0 = 32 * (oc >> 2) + 4 * (oc & 3);
        float val[8];
#pragma unroll
        for (int e = 0; e < 8; ++e) {
          const int j = j0 + (e & 3) + ((e >> 2) << 4);
          const float f = __expf(gclast - __shfl(gcL, j));
          const unsigned short raw = *(const unsigned short*)(ks + j * 256 + ((((d >> 3) ^ (j & 15))) << 4) + (d & 7) * 2);
          val[e] = bf2f(raw) * f;
        }
        u32x4 v;
        v[0] = pack2(val[0], val[1]); v[1] = pack2(val[2], val[3]); v[2] = pack2(val[4], val[5]); v[3] = pack2(val[6], val[7]);
        *(u32x4*)(KTT + ((size_t)item * 128 + d) * 64 + 8 * oc) = v;
      }
    }
  }
  __syncthreads();
}

__device__ __forceinline__ void ph_dnscan(unsigned char* smem, int item, const bf16_t* __restrict__ QDp, const bf16_t* __restrict__ W0Np, const bf16_t* __restrict__ KTTp,
                                          const bf16_t* __restrict__ RVp, const bf16_t* __restrict__ TMp, const bf16_t* __restrict__ ATTp, const float* __restrict__ GLp,
                                          float* __restrict__ op) {
  const int tid = TIDX, lane = tid & 63, w = tid >> 6, fr = lane & 15, fq = lane >> 4;
  const int bh = item >> 1, half = item & 1, b = bh >> 2, h = bh & 3;
  const int vcol0 = (half * 4 + w) * 16;
  unsigned char* sW0 = smem; unsigned char* sQD = smem + 16384; unsigned char* sKT = smem + 32768; unsigned char* sT = smem + 49152; unsigned char* sAT = smem + 57344;
  f32x4 S[8];
#pragma unroll
  for (int t = 0; t < 8; ++t) S[t] = (f32x4){0.f, 0.f, 0.f, 0.f};
  u32x4 pfA[8], pfB[8]; unsigned short rvp[16];
#define DN_LOAD_A(nn_) do { \
    const size_t ci = (size_t)bh * 64 + (nn_); \
    _Pragma("unroll") for (int i = 0; i < 4; ++i) pfA[i] = *(const u32x4*)((const char*)W0Np + ci * 16384 + (size_t)(tid + 256 * i) * 16); \
    _Pragma("unroll") for (int i = 0; i < 4; ++i) pfA[4 + i] = *(const u32x4*)((const char*)QDp + ci * 16384 + (size_t)(tid + 256 * i) * 16); \
    _Pragma("unroll") for (int mt = 0; mt < 4; ++mt) \
      _Pragma("unroll") for (int r = 0; r < 4; ++r) rvp[mt * 4 + r] = RVp[(ci * 64 + 16 * mt + 4 * fq + r) * 128 + vcol0 + fr]; \
  } while (0)
#define DN_STORE_A() do { \
    _Pragma("unroll") for (int i = 0; i < 4; ++i) { const int q = tid + 256 * i, row = q >> 4, ch = q & 15; *(u32x4*)(sW0 + row * 256 + ((ch ^ (row & 15)) << 4)) = pfA[i]; } \
    _Pragma("unroll") for (int i = 0; i < 4; ++i) { const int q = tid + 256 * i, row = q >> 4, ch = q & 15; *(u32x4*)(sQD + row * 256 + ((ch ^ (row & 15)) << 4)) = pfA[4 + i]; } \
  } while (0)
#define DN_LOAD_B(nn_) do { \
    const size_t ci = (size_t)bh * 64 + (nn_); \
    _Pragma("unroll") for (int i = 0; i < 4; ++i) pfB[i] = *(const u32x4*)((const char*)KTTp + ci * 16384 + (size_t)(tid + 256 * i) * 16); \
    _Pragma("unroll") for (int i = 0; i < 2; ++i) pfB[4 + i] = *(const u32x4*)((const char*)TMp + ci * 8192 + (size_t)(tid + 256 * i) * 16); \
    _Pragma("unroll") for (int i = 0; i < 2; ++i) pfB[6 + i] = *(const u32x4*)((const char*)ATTp + ci * 8192 + (size_t)(tid + 256 * i) * 16); \
  } while (0)
#define DN_STORE_B() do { \
    _Pragma("unroll") for (int i = 0; i < 4; ++i) { const int q = tid + 256 * i, row = q >> 3, ch = q & 7; *(u32x4*)(sKT + row * 128 + ((ch ^ (row & 7)) << 4)) = pfB[i]; } \
    _Pragma("unroll") for (int i = 0; i < 2; ++i) { const int q = tid + 256 * i, row = q >> 3, ch = q & 7; *(u32x4*)(sT + row * 128 + ((ch ^ (row & 7)) << 4)) = pfB[4 + i]; } \
    _Pragma("unroll") for (int i = 0; i < 2; ++i) { const int q = tid + 256 * i, row = q >> 3, ch = q & 7; *(u32x4*)(sAT + row * 128 + ((ch ^ (row & 7)) << 4)) = pfB[6 + i]; } \
  } while (0)
#define DN_ZINIT() do { _Pragma("unroll") for (int mt = 0; mt < 4; ++mt) Z[mt] = (f32x4){bf2f(rvp[mt * 4 + 0]), bf2f(rvp[mt * 4 + 1]), bf2f(rvp[mt * 4 + 2]), bf2f(rvp[mt * 4 + 3])}; } while (0)
  __syncthreads();
  f32x4 Z[4];
  DN_LOAD_A(0);
  DN_LOAD_B(0);
  DN_STORE_A();
  DN_ZINIT();
  DN_LOAD_A(1);
  for (int nn = 0; nn < 64; ++nn) {
    const float gl = GLp[(size_t)bh * 64 + nn];
    __syncthreads();
    bf16x8 Sb[4];
#pragma unroll
    for (int k4 = 0; k4 < 4; ++k4) Sb[k4] = pack8(S[2 * k4], S[2 * k4 + 1]);
    f32x4 O[4];
#pragma unroll
    for (int mt = 0; mt < 4; ++mt) {
      O[mt] = (f32x4){0.f, 0.f, 0.f, 0.f};
      const int row = 16 * mt + fr;
#pragma unroll
      for (int k4 = 0; k4 < 4; ++k4) {
        const int off = row * 256 + ((((k4 * 4 + fq) ^ fr)) << 4);
        const bf16x8 aw = *(const bf16x8*)(sW0 + off);
        const bf16x8 aq = *(const bf16x8*)(sQD + off);
        Z[mt] = __builtin_amdgcn_mfma_f32_16x16x32_bf16(aw, Sb[k4], Z[mt], 0, 0, 0);
        O[mt] = __builtin_amdgcn_mfma_f32_16x16x32_bf16(Sb[k4], aq, O[mt], 0, 0, 0);
      }
    }
    bf16x8 Zb[2];
    Zb[0] = pack8(Z[0], Z[1]); Zb[1] = pack8(Z[2], Z[3]);
    DN_STORE_B();
    if (nn + 1 < 64) DN_LOAD_B(nn + 1);
    __syncthreads();
    f32x4 Vn[4];
#pragma unroll
    for (int mt = 0; mt < 4; ++mt) {
      Vn[mt] = (f32x4){0.f, 0.f, 0.f, 0.f};
      const int row = 16 * mt + fr;
#pragma unroll
      for (int s = 0; s < 2; ++s) {
        if (s <= (mt >> 1)) {
          const bf16x8 at = *(const bf16x8*)(sT + row * 128 + ((((s * 4 + fq) ^ (row & 7))) << 4));
          Vn[mt] = __builtin_amdgcn_mfma_f32_16x16x32_bf16(at, Zb[s], Vn[mt], 0, 0, 0);
        }
      }
    }
    bf16x8 Vb[2];
    Vb[0] = pack8(Vn[0], Vn[1]); Vb[1] = pack8(Vn[2], Vn[3]);
#pragma unroll
    for (int mt = 0; mt < 4; ++mt) {
      const int row = 16 * mt + fr;
#pragma unroll
      for (int s = 0; s < 2; ++s) {
        if (s <= (mt >> 1)) {
          const bf16x8 aa = *(const bf16x8*)(sAT + row * 128 + ((((s * 4 + fq) ^ (row & 7))) << 4));
          O[mt] = __builtin_amdgcn_mfma_f32_16x16x32_bf16(Vb[s], aa, O[mt], 0, 0, 0);
        }
      }
      *(f32x4*)(op + ((size_t)b * SEQ + nn * 64 + 16 * mt + fr) * 512 + h * 128 + vcol0 + 4 * fq) = O[mt];
    }
#pragma unroll
    for (int t = 0; t < 8; ++t) {
      S[t] = S[t] * gl;
      const int row = 16 * t + fr;
#pragma unroll
      for (int s = 0; s < 2; ++s) {
        const bf16x8 ak = *(const bf16x8*)(sKT + row * 128 + ((((s * 4 + fq) ^ (row & 7))) << 4));
        S[t] = __builtin_amdgcn_mfma_f32_16x16x32_bf16(ak, Vb[s], S[t], 0, 0, 0);
      }
    }
    if (nn + 1 < 64) {
      DN_STORE_A();
      DN_ZINIT();
      if (nn + 2 < 64) DN_LOAD_A(nn + 2);
    }
  }
  __syncthreads();
#undef DN_ZINIT
#undef DN_LOAD_A
#undef DN_STORE_A
#undef DN_LOAD_B
#undef DN_STORE_B
}

__device__ __forceinline__ void ph_dn_post(int item, const float* __restrict__ o, const bf16_t* __restrict__ proj, const float* __restrict__ dn_norm_g, bf16_t* __restrict__ mixed) {
  const int tid = TIDX, h = tid >> 6, lane = tid & 63;
  const float2 g2 = *(const float2*)(dn_norm_g + 2 * lane);
  float2 ov[4]; unsigned zv[4];
#pragma unroll
  for (int i = 0; i < 4; ++i) {
    const size_t n = (size_t)item * 4 + i;
    ov[i] = *(const float2*)(o + n * 512 + h * 128 + 2 * lane);
    zv[i] = *(const unsigned*)(proj + n * PROJW + OFF_Z + h * 128 + 2 * lane);
  }
#pragma unroll
  for (int i = 0; i < 4; ++i) {
    const size_t n = (size_t)item * 4 + i;
    const float ss = wave_sum(ov[i].x * ov[i].x + ov[i].y * ov[i].y);
    const float rn = rsqrtf(ss * (1.f / 128.f) + RMS_EPS);
    *(unsigned*)(mixed + n * DM + h * 128 + 2 * lane) = pack2(ov[i].x * rn * g2.x * siluf(bflo(zv[i])), ov[i].y * rn * g2.y * siluf(bfhi(zv[i])));
  }
}

__device__ __forceinline__ void ph_swa(unsigned char* smem, int item, const bf16_t* __restrict__ proj, const bf16_t* __restrict__ vt, const float* __restrict__ sinks, bf16_t* __restrict__ mixed) {
  const int tid = TIDX, lane = tid & 63, w = tid >> 6, fr = lane & 15, fq = lane >> 4;
  const int qb = item & 31, kvh = (item >> 5) & 1, b = item >> 6;
  const int t0 = qb * 128;
  const size_t rowb = (size_t)b * SEQ;
  unsigned char* sK = smem;
  unsigned char* sV = smem + 32768;
  __syncthreads();
#pragma unroll
  for (int i = 0; i < 8; ++i) {
    const int q = tid + 256 * i, row = q >> 3, ch = q & 7;
    const int pos = t0 - 128 + row;
    u32x4 v = (u32x4){0u, 0u, 0u, 0u};
    if (pos >= 0) v = *(const u32x4*)(proj + (rowb + pos) * PROJW + OFF_SK + kvh * 64 + ch * 8);
    *(u32x4*)(sK + row * 128 + ((ch ^ (row & 7)) << 4)) = v;
  }
#pragma unroll
  for (int i = 0; i < 8; ++i) {
    const int q = tid + 256 * i, row = q >> 5, ch = q & 31;
    const int pos = t0 - 128 + ch * 8;
    u32x4 v = (u32x4){0u, 0u, 0u, 0u};
    if (pos >= 0) v = *(const u32x4*)(vt + ((size_t)(b * 128 + kvh * 64 + row)) * SEQ + pos);
    *(u32x4*)(sV + row * 512 + ((ch ^ (row & 15)) << 4)) = v;
  }
  __syncthreads();
  const int head = kvh * 4 + w;
  const float slope = exp2f(-(float)(head + 1));
  const float sink = sinks[head];
  const bf16_t* qp0 = proj + (rowb + t0 + fr) * PROJW + OFF_SQ + head * 64 + fq * 8;
  bf16x8 qn0 = *(const bf16x8*)(qp0), qn1 = *(const bf16x8*)(qp0 + 32);
#pragma unroll 1
  for (int qt = 0; qt < 8; ++qt) {
    const bf16x8 qf0 = qn0, qf1 = qn1;
    if (qt < 7) { const bf16_t* qp = qp0 + (size_t)(qt + 1) * 16 * PROJW; qn0 = *(const bf16x8*)(qp); qn1 = *(const bf16x8*)(qp + 32); }
    const int kp0 = qt >> 1;
    f32x4 st[10];
#pragma unroll
    for (int kt = 0; kt < 10; ++kt) {
      const int krow = (2 * kp0 + kt) * 16 + fr;
      st[kt] = (f32x4){0.f, 0.f, 0.f, 0.f};
      const bf16x8 k0 = *(const bf16x8*)(sK + krow * 128 + (((0 + fq) ^ (krow & 7)) << 4));
      const bf16x8 k1 = *(const bf16x8*)(sK + krow * 128 + (((4 + fq) ^ (krow & 7)) << 4));
      st[kt] = __builtin_amdgcn_mfma_f32_16x16x32_bf16(k0, qf0, st[kt], 0, 0, 0);
      st[kt] = __builtin_amdgcn_mfma_f32_16x16x32_bf16(k1, qf1, st[kt], 0, 0, 0);
    }
    const int i = qt * 16 + fr;
    float mx = sink;
#pragma unroll
    for (int kt = 0; kt < 10; ++kt)
#pragma unroll
      for (int r = 0; r < 4; ++r) {
        const int jb = (2 * kp0 + kt) * 16 + 4 * fq + r;
        const int dist = 128 + i - jb;
        const bool ok = (dist >= 0) && (dist < 128) && (t0 - 128 + jb >= 0);
        const float s = ok ? (st[kt][r] * 0.125f - slope * (float)dist) : -INFINITY;
        st[kt][r] = s;
        mx = fmaxf(mx, s);
      }
    mx = fmaxf(mx, __shfl_xor(mx, 16));
    mx = fmaxf(mx, __shfl_xor(mx, 32));
    float sum = 0.f;
#pragma unroll
    for (int kt = 0; kt < 10; ++kt)
#pragma unroll
      for (int r = 0; r < 4; ++r) { const float p = __expf(st[kt][r] - mx); st[kt][r] = p; sum += p; }
    sum += __shfl_xor(sum, 16);
    sum += __shfl_xor(sum, 32);
    const float inv = 1.f / (sum + __expf(sink - mx));
    f32x4 O[4];
#pragma unroll
    for (int nt = 0; nt < 4; ++nt) O[nt] = (f32x4){0.f, 0.f, 0.f, 0.f};
#pragma unroll
    for (int s5 = 0; s5 < 5; ++s5) {
      const bf16x8 pa = pack8(st[2 * s5] * inv, st[2 * s5 + 1] * inv);
      const int key0 = (2 * kp0 + 2 * s5) * 16 + 4 * fq;
#pragma unroll
      for (int nt = 0; nt < 4; ++nt) {
        const int drow = nt * 16 + fr;
        const int c0 = key0 >> 3, c1 = (key0 + 16) >> 3;
        const u32x2 lo = *(const u32x2*)(sV + drow * 512 + ((c0 ^ (drow & 15)) << 4) + ((key0 >> 2) & 1) * 8);
        const u32x2 hi = *(const u32x2*)(sV + drow * 512 + ((c1 ^ (drow & 15)) << 4) + ((key0 >> 2) & 1) * 8);
        const u32x4 vb = (u32x4){lo[0], lo[1], hi[0], hi[1]};
        O[nt] = __builtin_amdgcn_mfma_f32_16x16x32_bf16(__builtin_bit_cast(bf16x8, vb), pa, O[nt], 0, 0, 0);
      }
    }
#pragma unroll
    for (int nt = 0; nt < 4; ++nt) {
      u32x2 wv; wv[0] = pack2(O[nt][0], O[nt][1]); wv[1] = pack2(O[nt][2], O[nt][3]);
      *(u32x2*)(mixed + (rowb + t0 + qt * 16 + fr) * DM + 512 + head * 64 + nt * 16 + 4 * fq) = wv;
    }
  }
}

__device__ __forceinline__ void ph_wout(unsigned char* smem, int xcd, int l, const bf16_t* __restrict__ mixed, const bf16_t* __restrict__ wt, bf16_t* __restrict__ mixo) {
  const int mi = l >> 3, ni = l & 7;
  LdRowBF16 al; al.init([&](int r) { return mixed + (size_t)((xcd * 32 + mi) * 128 + r) * DM; }, (size_t)8 * 128 * DM * 2);
  LdRowBF16 bl; bl.init([&](int r) { return wt + (size_t)(ni * 128 + r) * DM; }, 0);
  gemm_stream<16>(smem, al, bl, 4, [&](int seg, f32x4 (&acc)[4][4], unsigned char* fbuf) {
    const int m0 = (xcd * 32 + seg * 8 + mi) * 128, n0 = ni * 128;
    store_tile_bf16(fbuf, acc, [&](int r) { return mixo + (size_t)(m0 + r) * DM + n0; });
  });
}

__device__ __forceinline__ void ph_ln1(int item, const float* __restrict__ x, const bf16_t* __restrict__ mixo, const float* __restrict__ gam, const float* __restrict__ bet, bf16_t* __restrict__ xbf, unsigned char* __restrict__ x8) {
  const int row = item * 4 + (TIDX >> 6), lane = TIDX & 63;
  const float4* p = (const float4*)(x + (size_t)row * DM);
  const u32x2* pm = (const u32x2*)(mixo + (size_t)row * DM);
  float4 v[4]; float s = 0.f;
#pragma unroll
  for (int i = 0; i < 4; ++i) {
    const float4 xv = p[lane + i * 64]; const u32x2 mv = pm[lane + i * 64];
    v[i].x = ALPHA * xv.x + bflo(mv[0]); v[i].y = ALPHA * xv.y + bfhi(mv[0]); v[i].z = ALPHA * xv.z + bflo(mv[1]); v[i].w = ALPHA * xv.w + bfhi(mv[1]);
    s += v[i].x + v[i].y + v[i].z + v[i].w;
  }
  const float mu = wave_sum(s) * (1.f / DM);
  float q = 0.f;
#pragma unroll
  for (int i = 0; i < 4; ++i) { const float a = v[i].x - mu, b = v[i].y - mu, c = v[i].z - mu, d = v[i].w - mu; q += a * a + b * b + c * c + d * d; }
  const float rs = rsqrtf(wave_sum(q) * (1.f / DM) + LN_EPS);
#pragma unroll
  for (int i = 0; i < 4; ++i) {
    const float4 gg = ((const float4*)gam)[lane + i * 64], bb = ((const float4*)bet)[lane + i * 64];
    u32x2 w;
    w[0] = pack2((v[i].x - mu) * rs * gg.x + bb.x, (v[i].y - mu) * rs * gg.y + bb.y);
    w[1] = pack2((v[i].z - mu) * rs * gg.z + bb.z, (v[i].w - mu) * rs * gg.w + bb.w);
    ((u32x2*)(xbf + (size_t)row * DM))[lane + i * 64] = w;
    int pk = 0;
    pk = __builtin_amdgcn_cvt_pk_fp8_f32((v[i].x - mu) * rs * gg.x + bb.x, (v[i].y - mu) * rs * gg.y + bb.y, pk, false);
    pk = __builtin_amdgcn_cvt_pk_fp8_f32((v[i].z - mu) * rs * gg.z + bb.z, (v[i].w - mu) * rs * gg.w + bb.w, pk, true);
    ((int*)(x8 + (size_t)row * DM))[lane + i * 64] = pk;
  }
}

__device__ __forceinline__ void ph_router(unsigned char* smem, int tile, const bf16_t* __restrict__ xbf, const bf16_t* __restrict__ wt, float* __restrict__ logits) {
  GEMM_IDS
  const int n0 = (tile & 1) * 128, m0 = (tile >> 1) * 128;
  LdRowBF16 al; al.init([&](int r) { return xbf + (size_t)(m0 + r) * DM; }, 0);
  LdRowBF16 bl; bl.init([&](int r) { return wt + (size_t)(n0 + r) * DM; }, 0);
  gemm_stream<16>(smem, al, bl, 1, [&](int seg, f32x4 (&acc)[4][4], unsigned char* fbuf) {
    GEMM_IDS
#pragma unroll
    for (int m = 0; m < 4; ++m)
#pragma unroll
      for (int n = 0; n < 4; ++n)
        *(f32x4*)(logits + (size_t)(m0 + wr * 64 + m * 16 + fr) * NEXP + n0 + wc * 64 + n * 16 + fq * 4) = acc[m][n];
  });
}

__device__ __forceinline__ unsigned rt_fkey(float f) { const unsigned b = __float_as_uint(f); return (b & 0x80000000u) ? ~b : (b | 0x80000000u); }
#define RT_DPPF(x, ctrl) __builtin_bit_cast(float, __builtin_amdgcn_update_dpp(__builtin_bit_cast(int, x), __builtin_bit_cast(int, x), ctrl, 0xf, 0xf, false))
#define RT_DPPU(x, ctrl, rmask) (unsigned)__builtin_amdgcn_update_dpp((int)(x), (int)(x), ctrl, rmask, 0xf, false)
#define RT_KSTEP(hi, lo, ctrl, rmask) { const unsigned ph_ = RT_DPPU(hi, ctrl, rmask), pl_ = RT_DPPU(lo, ctrl, rmask); \
    const bool t_ = (ph_ > hi) || (ph_ == hi && pl_ > lo); hi = t_ ? ph_ : hi; lo = t_ ? pl_ : lo; }
__device__ __forceinline__ void ph_route(int item, const float* __restrict__ logits, const float* __restrict__ router_bias, int* __restrict__ cnt, int* __restrict__ list, float* __restrict__ gates) {
  const int n = item * 4 + (TIDX >> 6), lane = TIDX & 63;
  const float4 lg = ((const float4*)(logits + (size_t)n * NEXP))[lane];
  const float4 rb = ((const float4*)router_bias)[lane];
  const float sc0 = sigmoidf(lg.x), sc1 = sigmoidf(lg.y), sc2 = sigmoidf(lg.z), sc3 = sigmoidf(lg.w);
  const float sel0 = sc0 + rb.x, sel1 = sc1 + rb.y, sel2 = sc2 + rb.z, sel3 = sc3 + rb.w;
  float t1 = fmaxf(sel0, sel1), t2 = fminf(sel0, sel1);
  { const float a = sel2; if (a > t1) { t2 = t1; t1 = a; } else if (a > t2) t2 = a; }
  { const float a = sel3; if (a > t1) { t2 = t1; t1 = a; } else if (a > t2) t2 = a; }
  { const float b1 = RT_DPPF(t1, 0xB1), b2 = RT_DPPF(t2, 0xB1); const float n1 = fmaxf(t1, b1), n2 = fmaxf(fminf(t1, b1), fmaxf(t2, b2)); t1 = n1; t2 = n2; }
  { const float b1 = RT_DPPF(t1, 0x4E), b2 = RT_DPPF(t2, 0x4E); const float n1 = fmaxf(t1, b1), n2 = fmaxf(fminf(t1, b1), fmaxf(t2, b2)); t1 = n1; t2 = n2; }
  { const float b1 = RT_DPPF(t1, 0x141), b2 = RT_DPPF(t2, 0x141); const float n1 = fmaxf(t1, b1), n2 = fmaxf(fminf(t1, b1), fmaxf(t2, b2)); t1 = n1; t2 = n2; }
  const float gs = t1 + t2;
  const int mygrp = lane >> 3;
  int rank = 0;
#pragma unroll
  for (int j = 0; j < 8; ++j) {
    const float o = __builtin_bit_cast(float, __builtin_amdgcn_readlane(__builtin_bit_cast(int, gs), j * 8));
    rank += (o > gs || (o == gs && j < mygrp)) ? 1 : 0;
  }
  const bool gsel = rank < 4;
  unsigned k0 = gsel ? rt_fkey(sel0) : 0u, k1 = gsel ? rt_fkey(sel1) : 0u, k2 = gsel ? rt_fkey(sel2) : 0u, k3 = gsel ? rt_fkey(sel3) : 0u;
  float gsum = 0.f; float myg = 0.f; int mye = 0;
#pragma unroll 1
  for (int r = 0; r < TOPK; ++r) {
    unsigned hi = k0, lo = 255u - (unsigned)(lane * 4);
    if (k1 > hi) { hi = k1; lo = 255u - (unsigned)(lane * 4 + 1); }
    if (k2 > hi) { hi = k2; lo = 255u - (unsigned)(lane * 4 + 2); }
    if (k3 > hi) { hi = k3; lo = 255u - (unsigned)(lane * 4 + 3); }
    RT_KSTEP(hi, lo, 0xB1, 0xf) RT_KSTEP(hi, lo, 0x4E, 0xf) RT_KSTEP(hi, lo, 0x141, 0xf) RT_KSTEP(hi, lo, 0x140, 0xf)
    RT_KSTEP(hi, lo, 0x142, 0xa) RT_KSTEP(hi, lo, 0x143, 0xc)
    const int be = 255 - __builtin_amdgcn_readlane((int)lo, 63);
    const int owner = be >> 2, slot = be & 3;
    const float tsel = (slot == 0) ? sc0 : (slot == 1) ? sc1 : (slot == 2) ? sc2 : sc3;
    const float bs = __builtin_bit_cast(float, __builtin_amdgcn_readlane(__builtin_bit_cast(int, tsel), owner));
    if (lane == owner) { if (slot == 0) k0 = 0u; else if (slot == 1) k1 = 0u; else if (slot == 2) k2 = 0u; else k3 = 0u; }
    gsum += bs;
    if (lane == r) { myg = bs; mye = be; }
  }
  if (lane < TOPK) {
    const int sh = item & (NSH - 1);
    const int slot = atomicAdd(&cnt[sh * NEXP + mye], 1);
    list[((size_t)sh * NEXP + mye) * CAPS + slot] = n * TOPK + lane;
    gates[(size_t)n * TOPK + lane] = myg / gsum * 2.5f;
  }
}
#undef RT_KSTEP

__device__ __forceinline__ void moe_build_prefix(const int* __restrict__ cnt, int* sscan) {
  const int tid = TIDX;
  const int e = ((tid & 31) << 3) | (tid >> 5);
  int c = 0;
#pragma unroll
  for (int s = 0; s < NSH; ++s) c += cnt[s * NEXP + e];
  __syncthreads();
  sscan[tid] = (c + 127) >> 7;
  __syncthreads();
  for (int o = 1; o < 256; o <<= 1) {
    const int v = (tid >= o) ? sscan[tid - o] : 0;
    __syncthreads();
    sscan[tid] += v;
    __syncthreads();
  }
}
__device__ __forceinline__ void moe_locate(const int* sscan, int x, int lt, int& e, int& rt) {
  const int base = x ? sscan[32 * x - 1] : 0;
  const int nrouted = sscan[32 * x + 31] - base;
  if (lt >= nrouted) { e = 256; rt = x * (NTOK / 128 / 8) + (lt - nrouted); return; }
  const int g = base + lt;
  int lo = 32 * x, hi = 32 * x + 31;
  while (lo < hi) { const int mid = (lo + hi) >> 1; if (sscan[mid] > g) hi = mid; else lo = mid + 1; }
  e = ((lo & 31) << 3) | (lo >> 5); rt = g - (lo ? sscan[lo - 1] : 0);
}

__device__ __forceinline__ long lo64(const u32x4& v) { return (long)(((unsigned long long)v[1] << 32) | (unsigned long long)v[0]); }
__device__ __forceinline__ long hi64(const u32x4& v) { return (long)(((unsigned long long)v[3] << 32) | (unsigned long long)v[2]); }
__device__ __forceinline__ void ph_moe(unsigned char* smem, int e, int rt, const unsigned char* __restrict__ x8, const bf16_t* __restrict__ xbf, const int* __restrict__ cnt,
                                       const int* __restrict__ list, const float* __restrict__ gates, const unsigned char* __restrict__ wge, const unsigned char* __restrict__ wue,
                                       const unsigned char* __restrict__ wde, unsigned char* __restrict__ ybuf, float* __restrict__ dout, unsigned char* __restrict__ dummy) {
  int* sasg = (int*)(smem + SM_MISC + 2048);
  float* sgate = (float*)(smem + SM_MISC + 2048 + 512);
  const int tid = TIDX, lane = tid & 63, w = tid >> 6, fr = lane & 15, fq = lane >> 4;
  __syncthreads();
  if (tid < 128) {
    const int r = rt * 128 + tid;
    int a = -1;
    if (e < 256) {
      int cum = 0;
#pragma unroll
      for (int s = 0; s < NSH; ++s) {
        const int c = cnt[s * NEXP + e];
        if (r >= cum && r < cum + c) a = list[((size_t)s * NEXP + e) * CAPS + (r - cum)];
        cum += c;
      }
    } else if (r < NTOK) a = NA + r;
    sasg[tid] = a;
    sgate[tid] = (a >= 0 && a < NA) ? gates[a] : 1.f;
  }
  __syncthreads();
  long hf[2][8];
  {
    LdRowBF16 al; al.init([&](int r) { const int a = sasg[r]; const int tok = (a < 0) ? 0 : (a < NA ? (a >> 3) : (a - NA)); return x8 + (size_t)tok * DM; }, 0);
    LdRowBF16 bl; bl.init([&](int j) {
      const int bn = j >> 4, ff = (bn >> 1) * 16 + (j & 15);
      return ((bn & 1) ? wue : wge) + (size_t)ff * DM; }, (size_t)64 * DM);
    al.issue(0, 0, smem); bl.issue(0, 0, smem + 16384);
    asm volatile("s_waitcnt vmcnt(0)" ::: "memory");
    __syncthreads();
#pragma unroll
    for (int m = 0; m < 2; ++m)
#pragma unroll
      for (int s = 0; s < 8; ++s) hf[m][s] = 0;
#pragma unroll 1
    for (int ct = 0; ct < 4; ++ct) {
      f32x4 acc[2][8];
#pragma unroll
      for (int m = 0; m < 2; ++m)
#pragma unroll
        for (int n = 0; n < 8; ++n) acc[m][n] = (f32x4){0.f, 0.f, 0.f, 0.f};
#pragma unroll 1
      for (int kk = 0; kk < 8; ++kk) {
        const int j = ct * 8 + kk;
        unsigned char* cur = smem + (j & 1) * 32768; unsigned char* nxt = smem + ((j & 1) ^ 1) * 32768;
        if (j + 1 < 32) { al.issue((j + 1) >> 3, (j + 1) & 7, nxt); bl.issue((j + 1) >> 3, (j + 1) & 7, nxt + 16384); }
#pragma unroll
        for (int ks = 0; ks < 2; ++ks) {
          u32x4 a[2], bfrag[8];
#pragma unroll
          for (int m = 0; m < 2; ++m) {
            const int row = w * 32 + m * 16 + fr;
            a[m] = *(const u32x4*)(cur + row * 128 + (((ks * 4 + fq) ^ (row & 7)) << 4));
          }
#pragma unroll
          for (int n = 0; n < 8; ++n) {
            const int row = n * 16 + fr;
            bfrag[n] = *(const u32x4*)(cur + 16384 + row * 128 + (((ks * 4 + fq) ^ (row & 7)) << 4));
          }
          __builtin_amdgcn_s_setprio(1);
#pragma unroll
          for (int n = 0; n < 8; ++n)
#pragma unroll
            for (int m = 0; m < 2; ++m) {
              acc[m][n] = __builtin_amdgcn_mfma_f32_16x16x32_fp8_fp8(lo64(bfrag[n]), lo64(a[m]), acc[m][n], 0, 0, 0);
              acc[m][n] = __builtin_amdgcn_mfma_f32_16x16x32_fp8_fp8(hi64(bfrag[n]), hi64(a[m]), acc[m][n], 0, 0, 0);
            }
          __builtin_amdgcn_s_setprio(0);
          __builtin_amdgcn_sched_group_barrier(0x100, 10, 0);
          __builtin_amdgcn_sched_group_barrier(0x008, 32, 0);
        }
        asm volatile("s_waitcnt vmcnt(0)" ::: "memory");
        __syncthreads();
      }
#pragma unroll
      for (int m = 0; m < 2; ++m) {
        int hp[4][2];
#pragma unroll
        for (int p = 0; p < 4; ++p) {
          float hv[4];
#pragma unroll
          for (int r = 0; r < 4; ++r) hv[r] = siluf(acc[m][2 * p][r] * (1.f / SC_WG)) * acc[m][2 * p + 1][r] * (SC_H / SC_WU);
          int pk = 0;
          pk = __builtin_amdgcn_cvt_pk_fp8_f32(hv[0], hv[1], pk, false);
          pk = __builtin_amdgcn_cvt_pk_fp8_f32(hv[2], hv[3], pk, true);
          hp[p][0] = pk;
        }
        const long h0 = (long)(((unsigned long long)(unsigned)hp[1][0] << 32) | (unsigned long long)(unsigned)hp[0][0]);
        const long h1 = (long)(((unsigned long long)(unsigned)hp[3][0] << 32) | (unsigned long long)(unsigned)hp[2][0]);
        if (ct == 0) { hf[m][0] = h0; hf[m][1] = h1; }
        else if (ct == 1) { hf[m][2] = h0; hf[m][3] = h1; }
        else if (ct == 2) { hf[m][4] = h0; hf[m][5] = h1; }
        else { hf[m][6] = h0; hf[m][7] = h1; }
      }
    }
  }
#define MOE_RAW_BARRIER() do { asm volatile("s_waitcnt lgkmcnt(0)" ::: "memory"); __builtin_amdgcn_s_barrier(); } while (0)
  {
    LdRowBF16 bl; bl.init([&](int j) { return wde + (size_t)j * EFF; }, (size_t)128 * EFF);
    bl.issue(0, 0, smem); bl.issue(0, 1, smem + 16384); bl.issue(1, 0, smem + 32768);
#pragma unroll 1
    for (int ct = 0; ct < 8; ++ct) {
      f32x4 acc[2][8];
#pragma unroll
      for (int m = 0; m < 2; ++m)
#pragma unroll
        for (int n = 0; n < 8; ++n) acc[m][n] = (f32x4){0.f, 0.f, 0.f, 0.f};
#pragma unroll
      for (int kk = 0; kk < 2; ++kk) {
        const int j = ct * 2 + kk;
        if (e < 256) {
          if (kk == 0) {
            if (ct == 0) asm volatile("s_waitcnt vmcnt(8)" ::: "memory");
            else if (ct == 1) asm volatile("s_waitcnt vmcnt(12)" ::: "memory");
            else if (ct < 7) asm volatile("s_waitcnt vmcnt(16)" ::: "memory");
            else asm volatile("s_waitcnt vmcnt(12)" ::: "memory");
          } else {
            if (ct == 0) asm volatile("s_waitcnt vmcnt(8)" ::: "memory");
            else if (ct < 7) asm volatile("s_waitcnt vmcnt(12)" ::: "memory");
            else asm volatile("s_waitcnt vmcnt(4)" ::: "memory");
          }
        } else {
          if (j < 14) asm volatile("s_waitcnt vmcnt(8)" ::: "memory");
          else if (j == 14) asm volatile("s_waitcnt vmcnt(4)" ::: "memory");
          else asm volatile("s_waitcnt vmcnt(0)" ::: "memory");
        }
        MOE_RAW_BARRIER();
        if (j + 3 < 16) bl.issue((j + 3) >> 1, (j + 3) & 1, smem + ((j + 3) & 3) * 16384);
        const unsigned char* cur = smem + (j & 3) * 16384;
#pragma unroll
        for (int s4 = 0; s4 < 4; ++s4) {
          long wf[8];
#pragma unroll
          for (int n = 0; n < 8; ++n) {
            const int row = n * 16 + fr;
            wf[n] = *(const long*)(cur + row * 128 + ((((2 * s4 + (fq >> 1))) ^ (row & 7)) << 4) + (fq & 1) * 8);
          }
          __builtin_amdgcn_s_setprio(1);
#pragma unroll
          for (int n = 0; n < 8; ++n)
#pragma unroll
            for (int m = 0; m < 2; ++m) acc[m][n] = __builtin_amdgcn_mfma_f32_16x16x32_fp8_fp8(wf[n], hf[m][kk * 4 + s4], acc[m][n], 0, 0, 0);
          __builtin_amdgcn_s_setprio(0);
          __builtin_amdgcn_sched_group_barrier(0x100, 8, 0);
          __builtin_amdgcn_sched_group_barrier(0x008, 16, 0);
        }
      }
      const int n0 = ct * 128;
      if (e == 256) {
#pragma unroll
        for (int m = 0; m < 2; ++m) {
          const int a = sasg[w * 32 + m * 16 + fr];
          if (a >= NA) {
            float* dp = dout + (size_t)(a - NA) * DM + n0 + fq * 4;
            const bf16_t* xp = xbf + (size_t)(a - NA) * DM + n0 + fq * 4;
#pragma unroll
            for (int n = 0; n < 8; ++n) {
              const u32x2 xw = *(const u32x2*)(xp + n * 16);
              const f32x4 xv = (f32x4){bflo(xw[0]), bfhi(xw[0]), bflo(xw[1]), bfhi(xw[1])};
              *(f32x4*)(dp + n * 16) = xv * ALPHA + acc[m][n] * (1.f / (SC_H * SC_WD));
            }
          }
        }
      } else {
        unsigned char* stg = smem + ((2 * ct + 1) & 3) * 16384 + w * 4096;
        MOE_RAW_BARRIER();
#pragma unroll
        for (int m = 0; m < 2; ++m) {
          const int row = m * 16 + fr;
          const float gt = sgate[w * 32 + row] * (SC_Y / (SC_H * SC_WD));
#pragma unroll
          for (int n = 0; n < 8; ++n) {
            int pk = 0;
            pk = __builtin_amdgcn_cvt_pk_fp8_f32(acc[m][n][0] * gt, acc[m][n][1] * gt, pk, false);
            pk = __builtin_amdgcn_cvt_pk_fp8_f32(acc[m][n][2] * gt, acc[m][n][3] * gt, pk, true);
            *(int*)(stg + row * 128 + ((n ^ (row & 7)) << 4) + 4 * fq) = pk;
          }
        }
#pragma unroll
        for (int i = 0; i < 4; ++i) {
          const int q = lane + 64 * i, row = q >> 3, ch = q & 7;
          const int a = sasg[w * 32 + row];
          unsigned char* yp = ((a >= 0) ? ybuf + (size_t)a * DM : dummy) + n0 + ch * 16;
          *(u32x4*)yp = *(const u32x4*)(stg + row * 128 + ((ch ^ (row & 7)) << 4));
        }
      }
    }
    MOE_RAW_BARRIER();
  }
#undef MOE_RAW_BARRIER
}

__device__ __forceinline__ void ph_final(int item, float* __restrict__ out, const unsigned char* __restrict__ ybuf, const float* __restrict__ gam, const float* __restrict__ bet) {
  const int row = item * 4 + (TIDX >> 6), lane = TIDX & 63;
  f32x4* p = (f32x4*)(out + (size_t)row * DM + 16 * lane);
  f32x4 v[4];
#pragma unroll
  for (int i = 0; i < 4; ++i) v[i] = p[i];
  u32x4 yv[8];
#pragma unroll
  for (int k = 0; k < 8; ++k) yv[k] = *(const u32x4*)(ybuf + ((size_t)row * 8 + k) * DM + 16 * lane);
  float ys[16];
#pragma unroll
  for (int c = 0; c < 16; ++c) ys[c] = 0.f;
#pragma unroll
  for (int k = 0; k < 8; ++k)
#pragma unroll
    for (int d = 0; d < 4; ++d) {
      const hwf32x2 lo = __builtin_amdgcn_cvt_pk_f32_fp8((int)yv[k][d], false), hi = __builtin_amdgcn_cvt_pk_f32_fp8((int)yv[k][d], true);
      ys[4 * d + 0] += lo[0]; ys[4 * d + 1] += lo[1]; ys[4 * d + 2] += hi[0]; ys[4 * d + 3] += hi[1];
    }
  float s = 0.f;
#pragma unroll
  for (int i = 0; i < 4; ++i)
#pragma unroll
    for (int r = 0; r < 4; ++r) { v[i][r] += ys[4 * i + r] * (1.f / 32.f); s += v[i][r]; }
  const float mu = wave_sum(s) * (1.f / DM);
  float q = 0.f;
#pragma unroll
  for (int i = 0; i < 4; ++i)
#pragma unroll
    for (int r = 0; r < 4; ++r) { const float d = v[i][r] - mu; q += d * d; }
  const float rs = rsqrtf(wave_sum(q) * (1.f / DM) + LN_EPS);
#pragma unroll
  for (int i = 0; i < 4; ++i) {
    const f32x4 gg = *(const f32x4*)(gam + 16 * lane + 4 * i), bb = *(const f32x4*)(bet + 16 * lane + 4 * i);
    p[i] = (v[i] - mu) * rs * gg + bb;
  }
}

#define XB_TMO      128
#define XB_XCNT(j)  (256  + 64 * (j))
#define XB_XSUB(j)  (1280 + 64 * (j))
#define XB_XGEN(j)  (2304 + 64 * (j))
#define XB_TOP      3328
#define XB_TOPGEN   3392
#define XCD_BAR_WORDS 3456
#define XB_SPIN_CAP (1u << 22)
#define LAS __attribute__((address_space(3)))
__device__ __forceinline__ unsigned xb_ld(unsigned* p)              { return __hip_atomic_load(p, __ATOMIC_RELAXED, __HIP_MEMORY_SCOPE_AGENT); }
__device__ __forceinline__ unsigned xb_add(unsigned* p, unsigned v) { return __hip_atomic_fetch_add(p, v, __ATOMIC_RELAXED, __HIP_MEMORY_SCOPE_AGENT); }
__device__ __forceinline__ unsigned xb_xcc_id() { return (unsigned)__builtin_amdgcn_s_getreg((3 << 11) | 20) & 0xFu; }
#define XB_SPIN(cond, bar) do { unsigned _sp = 0; while (cond) { __builtin_amdgcn_s_sleep(1); \
    if ((++_sp & 255u) == 0u) { if (xb_ld(&(bar)[XB_TMO])) break; if (_sp > XB_SPIN_CAP) { atomicAdd(&(bar)[XB_TMO], 1u); break; } } } } while (0)
struct XcdBarrier { unsigned* bar; unsigned x; volatile LAS unsigned* st; };
__device__ __forceinline__ XcdBarrier xcd_barrier_post(unsigned* bar, volatile LAS unsigned* st) {
  XcdBarrier b; b.bar = bar; b.x = xb_xcc_id(); b.st = st;
  if (threadIdx.x == 0) (void)xb_add(&bar[XB_XCNT(b.x)], 1u);
  return b;
}
__device__ __forceinline__ void xcd_barrier_complete(unsigned* bar, unsigned x, unsigned& nloc, unsigned& nx) {
  const unsigned G = gridDim.x * gridDim.y * gridDim.z;
  unsigned sum, cnt, mine, sp = 0u;
  for (;;) {
    sum = 0u; cnt = 0u; mine = 0u;
#pragma unroll
    for (unsigned j = 0; j < 16; ++j) { const unsigned c = xb_ld(&bar[XB_XCNT(j)]); sum += c; cnt += (c > 0u) ? 1u : 0u; mine = (j == x) ? c : mine; }
    if (sum == G) break;
    __builtin_amdgcn_s_sleep(1);
    if ((++sp & 255u) == 0u) { if (xb_ld(&bar[XB_TMO])) break; if (sp > XB_SPIN_CAP) { atomicAdd(&bar[XB_TMO], 1u); break; } }
  }
  nloc = mine > 0u ? mine : 1u; nx = cnt > 0u ? cnt : 1u;
}
__device__ __forceinline__ void xcd_barrier(const XcdBarrier& b) {
  asm volatile("s_waitcnt vmcnt(0)" ::: "memory");
  __syncthreads();
  if (threadIdx.x == 0) {
    unsigned* bar = b.bar;
    __builtin_amdgcn_s_waitcnt(0);
    unsigned nloc = b.st[0], nx = b.st[1];
    if (nloc == 0u) { xcd_barrier_complete(bar, b.x, nloc, nx); b.st[0] = nloc; b.st[1] = nx; }
    const unsigned old = xb_add(&bar[XB_XSUB(b.x)], 1u);
    const unsigned gen = old / nloc;
    if (old + 1u == (gen + 1u) * nloc) {
      __builtin_amdgcn_fence(__ATOMIC_RELEASE, "agent");
      asm volatile("s_waitcnt vmcnt(0)" ::: "memory");
      const unsigned og = xb_add(&bar[XB_TOP], 1u);
      const unsigned tg = og / nx;
      if (og + 1u == (tg + 1u) * nx) xb_add(&bar[XB_TOPGEN], 1u);
      else XB_SPIN(xb_ld(&bar[XB_TOPGEN]) == tg, bar);
      __builtin_amdgcn_fence(__ATOMIC_ACQUIRE, "agent");
      xb_add(&bar[XB_XGEN(b.x)], 1u);
      asm volatile("s_waitcnt vmcnt(0)" ::: "memory");
    } else {
      XB_SPIN(xb_ld(&bar[XB_XGEN(b.x)]) == gen, bar);
      __builtin_amdgcn_fence(__ATOMIC_ACQUIRE, "agent");
      asm volatile("s_waitcnt vmcnt(0)" ::: "memory");
    }
  }
  __syncthreads();
}

__global__ void __launch_bounds__(256, 2) mega(Params P) {
  __shared__ __attribute__((aligned(16))) unsigned char smem[SMEM_BYTES];
  const int bid = blockIdx.x, nblk = gridDim.x;
#define xin (P.in[0])
#define w_in (P.in[1])
#define conv_w (P.in[2])
#define a_log (P.in[3])
#define dt_bias (P.in[4])
#define dn_norm_g (P.in[5])
#define sinks (P.in[6])
#define w_out (P.in[7])
#define ln1_g (P.in[8])
#define ln1_b (P.in[9])
#define router_w (P.in[10])
#define router_bias (P.in[11])
#define w_gate (P.in[12])
#define w_up (P.in[13])
#define w_down (P.in[14])
#define sw_gate (P.in[15])
#define sw_up (P.in[16])
#define sw_down (P.in[17])
#define ln2_g (P.in[18])
#define ln2_b (P.in[19])
#define outp (P.out)
#define x1bf ((bf16_t*)(P.ws + WS_X1BF))
#define logits ((float*)(P.ws + WS_LOGIT))
#define list ((int*)(P.ws + WS_LIST))
#define gates ((float*)(P.ws + WS_GATES))
#define cnt ((int*)(P.ws + WS_CTRL + CNT16_OFF))
#define barw ((unsigned*)(P.ws + WS_CTRL + 4096))
#define mixed ((bf16_t*)(P.ws + WS_MIXED))
#define proj ((bf16_t*)(P.ws + WS_PROJ))
#define ba ((float*)(P.ws + WS_BA))
#define QD ((bf16_t*)(P.ws + WS_QD))
#define W0N ((bf16_t*)(P.ws + WS_W0N))
#define KTT ((bf16_t*)(P.ws + WS_KTT))
#define RV ((bf16_t*)(P.ws + WS_RV))
#define TM ((bf16_t*)(P.ws + WS_TM))
#define ATT ((bf16_t*)(P.ws + WS_ATT))
#define GL ((float*)(P.ws + WS_GL))
#define obuf ((float*)(P.ws + WS_O))
#define VTb ((bf16_t*)(P.ws + WS_VT))
#define MIXO ((bf16_t*)(P.ws + WS_O))
#define XBF ((bf16_t*)(P.ws + WS_XBF))
#define WTIN ((bf16_t*)(P.ws + WS_WTIN))
#define WTOUT ((bf16_t*)(P.ws + WS_WTOUT))
#define WTR ((bf16_t*)(P.ws + WS_WTR))
#define ybuf ((unsigned char*)(P.ws + WS_YBUF))
  {
    volatile LAS unsigned* st0 = (volatile LAS unsigned*)(smem + SM_MISC + 4080);
    if (threadIdx.x == 0) { st0[0] = 0u; st0[1] = 0u; }
    __syncthreads();
  }
  const int xcd = bid & 7, xloc = bid >> 3, xnl = nblk >> 3;
  XcdBarrier xb = xcd_barrier_post(barw, (volatile LAS unsigned*)(smem + SM_MISC + 4080));
  for (int it = bid; it < NTOK / 8; it += nblk) { ph_cvt_x(2 * it, xin, XBF); ph_cvt_x(2 * it + 1, xin, XBF); }
  for (int it = bid; it < 16 * 46 + 16 * 16 + 16 * 4; it += nblk) {
    if (it < 16 * 46) ph_cvt_wt(smem, it % 16, it / 16, w_in, DM, INC, WTIN);
    else if (it < 16 * 46 + 256) { const int j = it - 16 * 46; ph_cvt_wt(smem, j % 16, j / 16, w_out, DM, DM, WTOUT); }
    else { const int j = it - 16 * 46 - 256; ph_cvt_wt(smem, j % 16, j / 16, router_w, DM, NEXP, WTR); }
  }
  xcd_barrier(xb);
  for (int l = xloc; l < 64; l += xnl) ph_proj(smem, xcd, l, XBF, WTIN, proj, ba, VTb);
  xcd_barrier(xb);
  for (int it = bid; it < 2048; it += nblk) ph_dnchunk(smem, it, proj, ba, conv_w, a_log, dt_bias, QD, W0N, KTT, RV, TM, ATT, GL);
  for (int it = bid; it < 512; it += nblk) ph_swa(smem, it, proj, VTb, sinks, mixed);
  xcd_barrier(xb);
  {
    const bool is512 = (nblk == 512);
    const bool scan_blk = (bid < 64) || (nblk <= 64);
    const bool swa_blk = is512 && bid >= 256 && bid < 320;
    if (scan_blk) { for (int it = bid; it < 64; it += nblk) ph_dnscan(smem, it, QD, W0N, KTT, RV, TM, ATT, GL, obuf); }
    if (swa_blk) { }
    else {
      const int tid = TIDX, lane = tid & 63, wv = tid >> 6;
      float* tile = (float*)(smem + wv * 16896);
      const int total = 257 * 192;
      const int T1 = is512 ? (total - 64 * 4 * 12) : ((nblk > 64) ? total : 0);
      int it, step, end;
      if (is512 && bid < 64) { it = T1 + bid * 4 + wv; step = 64 * 4; end = total; }
      else if (is512) { const int cb = (bid < 256) ? (bid - 64) : (bid - 128); it = cb * 4 + wv; step = 384 * 4; end = T1; }
      else if (nblk > 64) { if (bid < 64) { it = 0; step = 1; end = 0; } else { it = (bid - 64) * 4 + wv; step = (nblk - 64) * 4; end = total; } }
      else { it = bid * 4 + wv; step = nblk * 4; end = total; }
      f32x4 vc[16], vn[16];
      CvtTile tc = cvt_decode(it < end ? it : 0, lane, w_gate, w_up, w_down, sw_gate, sw_up, sw_down, P.ws);
      if (it < end) cvt_load(tc, vc);
      while (it < end) {
        const int itn = it + step;
        CvtTile tn = cvt_decode(itn < end ? itn : 0, lane, w_gate, w_up, w_down, sw_gate, sw_up, sw_down, P.ws);
        if (itn < end) cvt_load(tn, vn);
        cvt_store(tile, lane, tc, vc);
#pragma unroll
        for (int i = 0; i < 16; ++i) vc[i] = vn[i];
        tc = tn; it = itn;
      }
    }
  }
  xcd_barrier(xb);
  for (int it = bid; it < NTOK / 4; it += nblk) ph_dn_post(it, obuf, proj, dn_norm_g, mixed);
  xcd_barrier(xb);
  for (int l = xloc; l < 64; l += xnl) ph_wout(smem, xcd, l, mixed, WTOUT, MIXO);
  xcd_barrier(xb);
  for (int it = bid; it < NTOK / 4; it += nblk) ph_ln1(it, xin, MIXO, ln1_g, ln1_b, x1bf, (unsigned char*)(P.ws + WS_X1F8));
  xcd_barrier(xb);
  for (int i = xloc; i < 32 * 2; i += xnl) ph_router(smem, (xcd * 32 + i / 2) * 2 + i % 2, x1bf, WTR, logits);
  xcd_barrier(xb);
  for (int it = bid; it < NTOK / 4; it += nblk) ph_route(it, logits, router_bias, cnt, list, gates);
  xcd_barrier(xb);
  int* sscan = (int*)(smem + SM_MISC);
  moe_build_prefix(cnt, sscan);
  const int ntile = sscan[32 * xcd + 31] - (xcd ? sscan[32 * xcd - 1] : 0) + NTOK / 128 / 8;
  for (int it = xloc; it < ntile; it += xnl) {
    int e, rt; moe_locate(sscan, xcd, it, e, rt);
    ph_moe(smem, e, rt, (const unsigned char*)(P.ws + WS_X1F8), x1bf, cnt, list, gates,
           (const unsigned char*)P.ws + ((e < 256) ? WS_WTG8 + (size_t)e * EFF * DM : WS_WTSG8), (const unsigned char*)P.ws + ((e < 256) ? WS_WTU8 + (size_t)e * EFF * DM : WS_WTSU8),
           (const unsigned char*)P.ws + ((e < 256) ? WS_WTD8 + (size_t)e * DM * EFF : WS_WTSD8), ybuf, outp, (unsigned char*)(P.ws + WS_DUMMY));
  }
  xcd_barrier(xb);
  for (int it = bid; it < NTOK / 4; it += nblk) ph_final(it, outp, ybuf, ln2_g, ln2_b);
}

#undef xin
#undef w_in
#undef conv_w
#undef a_log
#undef dt_bias
#undef dn_norm_g
#undef sinks
#undef w_out
#undef ln1_g
#undef ln1_b
#undef router_w
#undef router_bias
#undef w_gate
#undef w_up
#undef w_down
#undef sw_gate
#undef sw_up
#undef sw_down
#undef ln2_g
#undef ln2_b
#undef outp
#undef x1bf
#undef logits
#undef list
#undef gates
#undef cnt
#undef mixed
#undef proj
#undef ba
#undef QD
#undef W0N
#undef KTT
#undef RV
#undef TM
#undef ATT
#undef GL
#undef obuf
#undef ybuf
#undef VTb
#undef MIXO
#undef XBF
#undef WTIN
#undef WTOUT
#undef WTR
#undef barw

extern "C" void kernel_launch(void* const* d_in, const int* in_sizes, int n_in, void* d_out, int out_size, void* d_ws, size_t ws_size, hipStream_t stream) {
  static int grid_blocks = 0;
  if (!grid_blocks) {
    int dev = 0, cus = 0, per_cu = 0;
    (void)hipGetDevice(&dev);
    (void)hipDeviceGetAttribute(&cus, hipDeviceAttributeMultiprocessorCount, dev);
    (void)hipOccupancyMaxActiveBlocksPerMultiprocessor(&per_cu, mega, 256, 0);
    if (per_cu > 2) per_cu = 2;
    if (per_cu < 1) per_cu = 1;
    grid_blocks = cus * per_cu;
  }
  Params p{};
  for (int i = 0; i < 20; ++i) p.in[i] = (const float*)d_in[i];
  p.out = (float*)d_out; p.ws = (char*)d_ws;
  (void)hipMemsetAsync((char*)d_ws + WS_CTRL, 0, CNT16_OFF + NSH * NEXP * 4, stream);
  void* args[] = {&p};
  hipError_t e = hipLaunchCooperativeKernel((void*)mega, dim3(grid_blocks), dim3(256), args, 0, stream);
  if (e != hipSuccess) fprintf(stderr, "cooperative launch failed: %s (grid %d)\n", hipGetErrorString(e), grid_blocks);
}
```

```cpp
#include <hip/hip_runtime.h>
#include <hip/hip_cooperative_groups.h>
#include <stdint.h>
#include <stdio.h>
namespace cg = cooperative_groups;

typedef __attribute__((ext_vector_type(8))) short bf16x8;
typedef __attribute__((ext_vector_type(4))) float f32x4;
typedef unsigned short bf16_t;
typedef __attribute__((ext_vector_type(4))) unsigned u32x4;
typedef __attribute__((ext_vector_type(2))) unsigned u32x2;

constexpr int NTOK = 32768, SEQ = 4096, DM = 1024;
constexpr int INC = 2824, PROJW = 2816;
constexpr int OFF_DQ = 0, OFF_DK = 512, OFF_DV = 1024, OFF_SQ = 1536, OFF_SK = 2048, OFF_SV = 2176, OFF_Z = 2304;
constexpr int NEXP = 256, TOPK = 8, EFF = 256;
constexpr int NA = NTOK * TOPK;
constexpr int NSH = 16, CAPS = NTOK / NSH;
constexpr int CNT16_OFF = 32768;
constexpr float ALPHA = 1.189207115002721f;
constexpr float LN_EPS = 1e-5f, RMS_EPS = 1e-6f, L2_EPS = 1e-6f;
constexpr float SC_WG = 32.f, SC_WU = 64.f, SC_WD = 32.f, SC_H = 8.f, SC_Y = 32.f;

constexpr size_t MiB = 1024ull * 1024ull;
constexpr size_t WS_WTD8 = 0;
constexpr size_t WS_WTG8 = 64 * MiB;
constexpr size_t WS_WTU8 = 128 * MiB;
constexpr size_t WS_WTSG8 = 192 * MiB;
constexpr size_t WS_WTSU8 = WS_WTSG8 + 256 * 1024;
constexpr size_t WS_WTSD8 = WS_WTSG8 + 512 * 1024;
constexpr size_t WS_X1F8 = 200 * MiB;
constexpr size_t WS_YBUF = 384 * MiB;
constexpr size_t WS_LOGIT = 384 * MiB;
constexpr size_t WS_X1BF = 896 * MiB;
constexpr size_t WS_LIST = 960 * MiB;
constexpr size_t WS_GATES = 992 * MiB;
constexpr size_t WS_CTRL = 993 * MiB;
constexpr size_t WS_WTIN = 994 * MiB;
constexpr size_t WS_WTOUT = 1000 * MiB;
constexpr size_t WS_WTR = 1002 * MiB;
constexpr size_t WS_DUMMY = 1005 * MiB;
constexpr size_t WS_PROJ = 384 * MiB;
constexpr size_t WS_BA = 560 * MiB;
constexpr size_t WS_QD = 561 * MiB;
constexpr size_t WS_W0N = 593 * MiB;
constexpr size_t WS_KTT = 625 * MiB;
constexpr size_t WS_RV = 657 * MiB;
constexpr size_t WS_TM = 689 * MiB;
constexpr size_t WS_ATT = 705 * MiB;
constexpr size_t WS_GL = 721 * MiB;
constexpr size_t WS_O = 722 * MiB;
constexpr size_t WS_VT = 786 * MiB;
constexpr size_t WS_MIXED = 794 * MiB;
constexpr size_t WS_XBF = 640 * MiB;

__device__ __forceinline__ int opaque_tid() { int t = threadIdx.x; asm volatile("" : "+v"(t)); return t; }
#define TIDX opaque_tid()
typedef __attribute__((ext_vector_type(2))) __bf16 hwbf16x2;
typedef __attribute__((ext_vector_type(2))) float hwf32x2;
__device__ __forceinline__ unsigned pack2(float lo, float hi) {
  hwf32x2 f = {lo, hi};
  return __builtin_bit_cast(unsigned, __builtin_convertvector(f, hwbf16x2));
}
__device__ __forceinline__ unsigned f2bf(float f) { return pack2(f, 0.f) & 0xffffu; }
__device__ __forceinline__ float bf2f(unsigned h) { return __uint_as_float(h << 16); }
__device__ __forceinline__ float bflo(unsigned w) { return __uint_as_float(w << 16); }
__device__ __forceinline__ float bfhi(unsigned w) { return __uint_as_float(w & 0xffff0000u); }
__device__ __forceinline__ float siluf(float x) { return x * __builtin_amdgcn_rcpf(1.f + __expf(-x)); }
__device__ __forceinline__ float sigmoidf(float x) { return __builtin_amdgcn_rcpf(1.f + __expf(-x)); }
#define DPP_ADD_(v, ctrl, rmask) v += __builtin_bit_cast(float, __builtin_amdgcn_update_dpp(0, __builtin_bit_cast(int, v), ctrl, rmask, 0xf, false))
__device__ __forceinline__ float wave_sum(float v) {
  DPP_ADD_(v, 0xB1, 0xf);
  DPP_ADD_(v, 0x4E, 0xf);
  DPP_ADD_(v, 0x141, 0xf);
  DPP_ADD_(v, 0x140, 0xf);
  DPP_ADD_(v, 0x142, 0xa);
  DPP_ADD_(v, 0x143, 0xc);
  return __builtin_bit_cast(float, __builtin_amdgcn_readlane(__builtin_bit_cast(int, v), 63));
}

template <int SEGDIV>
struct LdRowBF16T {
  const char* p[4]; size_t seghi, seglo; int tid16;
  template <class F> __device__ __forceinline__ void init(F rowptr, size_t hi, size_t lo = 0) {
    const int tid = TIDX; const int slot = tid & 7, row0 = tid >> 3; seghi = hi; seglo = lo; tid16 = tid * 16;
#pragma unroll
    for (int i = 0; i < 4; ++i) p[i] = (const char*)rowptr(row0 + i * 32) + ((slot ^ (row0 & 7)) << 4);
  }
  __device__ __forceinline__ void issue(int seg, int kk, unsigned char* lds) {
    const size_t off = (size_t)(seg / SEGDIV) * seghi + (size_t)(seg % SEGDIV) * seglo + (size_t)kk * 128;
#pragma unroll
    for (int i = 0; i < 4; ++i)
      __builtin_amdgcn_global_load_lds((const unsigned*)(p[i] + off), (__attribute__((address_space(3))) unsigned*)(lds + tid16 + i * 4096), 16, 0, 0);
  }
};
typedef LdRowBF16T<1> LdRowBF16;
__device__ __forceinline__ void gemm_kstep(const unsigned char* sA, const unsigned char* sB, f32x4 (&acc)[4][4], int wr, int wc, int fr, int fq) {
#pragma unroll
  for (int ks = 0; ks < 2; ++ks) {
    bf16x8 a[4], b[4];
#pragma unroll
    for (int m = 0; m < 4; ++m) {
      const int row = wr * 64 + m * 16 + fr;
      a[m] = *(const bf16x8*)(sA + row * 128 + (((ks * 4 + fq) ^ (row & 7)) << 4));
    }
#pragma unroll
    for (int n = 0; n < 4; ++n) {
      const int row = wc * 64 + n * 16 + fr;
      b[n] = *(const bf16x8*)(sB + row * 128 + (((ks * 4 + fq) ^ (row & 7)) << 4));
    }
    __builtin_amdgcn_s_setprio(1);
#pragma unroll
    for (int m = 0; m < 4; ++m)
#pragma unroll
      for (int n = 0; n < 4; ++n) acc[m][n] = __builtin_amdgcn_mfma_f32_16x16x32_bf16(b[n], a[m], acc[m][n], 0, 0, 0);
    __builtin_amdgcn_s_setprio(0);
  }
}
template <int KPER, class AL, class BL, class Epi>
__device__ __forceinline__ void gemm_stream(unsigned char* smem, AL& al, BL& bl, int nseg, Epi epi) {
  const int tid = TIDX, lane = tid & 63, wid = tid >> 6, wr = wid >> 1, wc = wid & 1, fr = lane & 15, fq = lane >> 4;
  const int total = nseg * KPER;
  f32x4 acc[4][4];
  al.issue(0, 0, smem); bl.issue(0, 0, smem + 16384);
  asm volatile("s_waitcnt vmcnt(0)" ::: "memory");
  __syncthreads();
  for (int j = 0; j < total; ++j) {
    unsigned char* cur = smem + (j & 1) * 32768; unsigned char* nxt = smem + ((j & 1) ^ 1) * 32768;
    if (j + 1 < total) { al.issue((j + 1) / KPER, (j + 1) % KPER, nxt); bl.issue((j + 1) / KPER, (j + 1) % KPER, nxt + 16384); }
    if (j % KPER == 0) {
#pragma unroll
      for (int m = 0; m < 4; ++m)
#pragma unroll
        for (int n = 0; n < 4; ++n) acc[m][n] = (f32x4){0.f, 0.f, 0.f, 0.f};
    }
    gemm_kstep(cur, cur + 16384, acc, wr, wc, fr, fq);
    asm volatile("s_waitcnt vmcnt(0)" ::: "memory");
    __syncthreads();
    if ((j + 1) % KPER == 0) epi((j + 1) / KPER - 1, acc, cur);
  }
}

template <class RowDst>
__device__ __forceinline__ void store_tile_bf16(unsigned char* fbuf, const f32x4 (&acc)[4][4], RowDst rowdst) {
  const int tid = TIDX, lane = tid & 63, wid = tid >> 6, wr = wid >> 1, wc = wid & 1, fr = lane & 15, fq = lane >> 4;
#pragma unroll
  for (int m = 0; m < 4; ++m) {
    const int row = wr * 64 + m * 16 + fr;
#pragma unroll
    for (int n = 0; n < 4; ++n) {
      const int col = wc * 64 + n * 16 + fq * 4;
      u32x2 w; w[0] = pack2(acc[m][n][0], acc[m][n][1]); w[1] = pack2(acc[m][n][2], acc[m][n][3]);
      *(u32x2*)(fbuf + row * 256 + (((col >> 3) ^ (row & 15)) << 4) + ((col >> 2) & 1) * 8) = w;
    }
  }
  __syncthreads();
#pragma unroll
  for (int i = 0; i < 8; ++i) {
    const int q = tid + 256 * i, row = q >> 4, ch = q & 15;
    *(u32x4*)(rowdst(row) + ch * 8) = *(const u32x4*)(fbuf + row * 256 + ((ch ^ (row & 15)) << 4));
  }
  __syncthreads();
}

template <class RowDst>
__device__ __forceinline__ void store_tile_bf16_T(unsigned char* fbuf, const f32x4 (&acc)[4][4], RowDst rowdst) {
  const int tid = TIDX, lane = tid & 63, wid = tid >> 6, wr = wid >> 1, wc = wid & 1, fr = lane & 15, fq = lane >> 4;
#pragma unroll
  for (int m = 0; m < 4; ++m) {
    const int t = wr * 64 + m * 16 + fr;
#pragma unroll
    for (int n = 0; n < 4; ++n)
#pragma unroll
      for (int r = 0; r < 4; ++r) {
        const int c = wc * 64 + n * 16 + fq * 4 + r;
        *(unsigned short*)(fbuf + c * 256 + ((((t >> 3) ^ (c & 15))) << 4) + (t & 7) * 2) = (unsigned short)f2bf(acc[m][n][r]);
      }
  }
  __syncthreads();
#pragma unroll
  for (int i = 0; i < 8; ++i) {
    const int q = tid + 256 * i, row = q >> 4, ch = q & 15;
    *(u32x4*)(rowdst(row) + ch * 8) = *(const u32x4*)(fbuf + row * 256 + ((ch ^ (row & 15)) << 4));
  }
  __syncthreads();
}

#define GEMM_IDS const int tid = TIDX, lane = tid & 63, wid = tid >> 6, wr = wid >> 1, wc = wid & 1, fr = lane & 15, fq = lane >> 4; (void)tid; (void)lane;

struct Params {
  const float* in[20];
  float* out;
  char* ws;
};

constexpr int SMEM_BYTES = 69632;
constexpr int SM_MISC = 65536;

__device__ __forceinline__ void ph_cvt_x(int item, const float* __restrict__ x, bf16_t* __restrict__ xbf) {
  const int tid = TIDX;
  const size_t base = (size_t)item * 4096 + (size_t)tid * 4;
#pragma unroll
  for (int i = 0; i < 4; ++i) {
    const f32x4 v = *(const f32x4*)(x + base + (size_t)i * 1024);
    u32x2 w; w[0] = pack2(v[0], v[1]); w[1] = pack2(v[2], v[3]);
    *(u32x2*)(xbf + base + (size_t)i * 1024) = w;
  }
}
__device__ __forceinline__ void ph_cvt_wt(unsigned char* smem, int kt, int nt, const float* __restrict__ W, int K, int N, bf16_t* __restrict__ WT, bool perm = false) {
  float* tile = (float*)smem;
  const int tid = TIDX;
  const int k0 = kt * 64, n0 = nt * 64;
  __syncthreads();
#pragma unroll
  for (int i = 0; i < 4; ++i) {
    const int k = (tid >> 4) + 16 * i, n = 4 * (tid & 15);
    f32x4 v = (f32x4){0.f, 0.f, 0.f, 0.f};
    if (n0 + n < N) v = *(const f32x4*)(W + (size_t)(k0 + k) * N + n0 + n);
    tile[k * 65 + n + 0] = v[0]; tile[k * 65 + n + 1] = v[1]; tile[k * 65 + n + 2] = v[2]; tile[k * 65 + n + 3] = v[3];
  }
  __syncthreads();
  const int n = tid >> 2, kq = tid & 3;
  u32x4 w0, w1;
#pragma unroll
  for (int j = 0; j < 4; ++j) {
    w0[j] = pack2(tile[(kq * 16 + 2 * j) * 65 + n], tile[(kq * 16 + 2 * j + 1) * 65 + n]);
    w1[j] = pack2(tile[(kq * 16 + 8 + 2 * j) * 65 + n], tile[(kq * 16 + 8 + 2 * j + 1) * 65 + n]);
  }
  if (!perm) {
    bf16_t* dst = WT + (size_t)(n0 + n) * K + k0 + kq * 16;
    *(u32x4*)dst = w0; *(u32x4*)(dst + 8) = w1;
  } else {
    const int blk = kq >> 1, hi = kq & 1;
    bf16_t* dst = WT + (size_t)(n0 + n) * K + k0 + blk * 32 + 4 * hi;
    u32x2 a; a[0] = w0[0]; a[1] = w0[1]; *(u32x2*)(dst + 0) = a;
    a[0] = w0[2]; a[1] = w0[3]; *(u32x2*)(dst + 8) = a;
    a[0] = w1[0]; a[1] = w1[1]; *(u32x2*)(dst + 16) = a;
    a[0] = w1[2]; a[1] = w1[3]; *(u32x2*)(dst + 24) = a;
  }
}

struct CvtTile { const float* src; unsigned char* dst; int ldn; int K; int perm; float scale; };
__device__ __forceinline__ CvtTile cvt_decode(int it, int lane, const float* __restrict__ w_gate, const float* __restrict__ w_up, const float* __restrict__ w_down,
                                              const float* __restrict__ sw_gate, const float* __restrict__ sw_up, const float* __restrict__ sw_down, char* ws) {
  const int e = it / 192, j = it % 192;
  const float* W; unsigned char* WT; int K, N, kt, nt; float sc;
  if (j < 64) { W = (e < 256) ? w_gate + (size_t)e * DM * EFF : sw_gate; WT = (unsigned char*)ws + ((e < 256) ? WS_WTG8 + (size_t)e * EFF * DM : WS_WTSG8); K = DM; N = EFF; nt = j & 7; kt = j >> 3; sc = SC_WG; }
  else if (j < 128) { W = (e < 256) ? w_up + (size_t)e * DM * EFF : sw_up; WT = (unsigned char*)ws + ((e < 256) ? WS_WTU8 + (size_t)e * EFF * DM : WS_WTSU8); K = DM; N = EFF; nt = (j - 64) & 7; kt = (j - 64) >> 3; sc = SC_WU; }
  else { W = (e < 256) ? w_down + (size_t)e * EFF * DM : sw_down; WT = (unsigned char*)ws + ((e < 256) ? WS_WTD8 + (size_t)e * DM * EFF : WS_WTSD8); K = EFF; N = DM; nt = (j - 128) & 31; kt = (j - 128) >> 5; sc = SC_WD; }
  CvtTile t;
  t.src = W + (size_t)(kt * 128 + (lane >> 3)) * N + nt * 32 + 4 * (lane & 7);
  t.dst = WT + (size_t)(nt * 32) * K + kt * 128;
  t.ldn = 8 * N; t.K = K; t.scale = sc;
  t.perm = (j >= 128) ? 1 : 0;
  return t;
}
__device__ __forceinline__ void cvt_load(const CvtTile& t, f32x4 (&v)[16]) {
#pragma unroll
  for (int i = 0; i < 16; ++i) v[i] = *(const f32x4*)(t.src + (size_t)i * t.ldn);
}
__device__ __forceinline__ void cvt_store(float* tile  , int lane, const CvtTile& t, const f32x4 (&v)[16]) {
#pragma unroll
  for (int i = 0; i < 16; ++i) {
    float* p = tile + ((lane >> 3) + 8 * i) * 33 + 4 * (lane & 7);
    p[0] = v[i][0]; p[1] = v[i][1]; p[2] = v[i][2]; p[3] = v[i][3];
  }
  const int c = lane & 7;
  int kk[16];
#pragma unroll
  for (int tt = 0; tt < 16; ++tt)
    kk[tt] = t.perm ? (32 * (c >> 1) + 16 * ((tt >> 2) & 1) + 4 * (2 * (c & 1) + (tt >> 3)) + (tt & 3)) : (16 * c + tt);
  const float sc = t.scale;
#pragma unroll
  for (int i = 0; i < 4; ++i) {
    const int n = (lane >> 3) + 8 * i;
    u32x4 w;
#pragma unroll
    for (int d = 0; d < 4; ++d) {
      int pk = 0;
      pk = __builtin_amdgcn_cvt_pk_fp8_f32(tile[kk[4 * d + 0] * 33 + n] * sc, tile[kk[4 * d + 1] * 33 + n] * sc, pk, false);
      pk = __builtin_amdgcn_cvt_pk_fp8_f32(tile[kk[4 * d + 2] * 33 + n] * sc, tile[kk[4 * d + 3] * 33 + n] * sc, pk, true);
      w[d] = (unsigned)pk;
    }
    *(u32x4*)(t.dst + (size_t)n * t.K + 16 * c) = w;
  }
}

__device__ __forceinline__ void ph_proj(unsigned char* smem, int xcd, int l, const bf16_t* __restrict__ xbf, const bf16_t* __restrict__ wt, bf16_t* __restrict__ proj, float* __restrict__ ba, bf16_t* __restrict__ vt) {
  const int mi = l >> 3, ni = l & 7;
  LdRowBF16T<3> al; al.init([&](int r) { return xbf + (size_t)((xcd * 32 + mi) * 128 + r) * DM; }, (size_t)8 * 128 * DM * 2, 0);
  LdRowBF16T<3> bl; bl.init([&](int r) { return wt + (size_t)(ni * 128 + r) * DM; }, 0, (size_t)8 * 128 * DM * 2);
  gemm_stream<16>(smem, al, bl, 12, [&](int seg, f32x4 (&acc)[4][4], unsigned char* fbuf) {
    GEMM_IDS
    const int nt = (seg % 3) * 8 + ni;
    if (nt < 23) {
      const int m0 = (xcd * 32 + (seg / 3) * 8 + mi) * 128, n0 = nt * 128;
      if (n0 + 128 <= PROJW) store_tile_bf16(fbuf, acc, [&](int r) { return proj + (size_t)(m0 + r) * PROJW + n0; });
      else
#pragma unroll
      for (int m = 0; m < 4; ++m)
#pragma unroll
        for (int n = 0; n < 4; ++n) {
          const int row = m0 + wr * 64 + m * 16 + fr, col = n0 + wc * 64 + n * 16 + fq * 4;
          if (col < PROJW) {
            u32x2 w; w[0] = pack2(acc[m][n][0], acc[m][n][1]); w[1] = pack2(acc[m][n][2], acc[m][n][3]);
            *(u32x2*)(proj + (size_t)row * PROJW + col) = w;
          } else if (col < INC) {
            *(f32x4*)(ba + (size_t)row * 8 + (col - PROJW)) = acc[m][n];
          }
        }
      if (n0 == OFF_SV) {
        const int bb = m0 / SEQ, t0_ = m0 % SEQ;
        store_tile_bf16_T(fbuf, acc, [&](int c) { return vt + ((size_t)(bb * 128 + c)) * SEQ + t0_; });
      }
    }
  });
}

__device__ __forceinline__ bf16x8 pack8(f32x4 a, f32x4 b) {
  union { bf16x8 v; unsigned u[4]; } x;
  x.u[0] = pack2(a[0], a[1]); x.u[1] = pack2(a[2], a[3]); x.u[2] = pack2(b[0], b[1]); x.u[3] = pack2(b[2], b[3]);
  return x.v;
}
__device__ __forceinline__ void ph_dnchunk(unsigned char* smem, int item, const bf16_t* __restrict__ proj, const float* __restrict__ ba, const float* __restrict__ conv_w,
                                           const float* __restrict__ a_log, const float* __restrict__ dt_bias,
                                           bf16_t* __restrict__ QD, bf16_t* __restrict__ W0N, bf16_t* __restrict__ KTT, bf16_t* __restrict__ RV,
                                           bf16_t* __restrict__ TM, bf16_t* __restrict__ ATT, float* __restrict__ GL) {
  const int tid = TIDX, lane = tid & 63, w = tid >> 6, fr = lane & 15, fq = lane >> 4;
  const int n = item & 63, h = (item >> 6) & 3, b = item >> 8;
  const int t0 = n * 64; const size_t row0 = (size_t)b * SEQ + t0;
  unsigned char* qs = smem; unsigned char* ks = smem + 16384; float* AT = (float*)(smem + 32768);
  const float scale = 0.08838834764831845f;
  float bL, gcL;
  {
    const float* bap = ba + (row0 + lane) * 8;
    bL = sigmoidf(bap[h]);
    const float xx = bap[4 + h] + dt_bias[h];
    const float sp = fmaxf(xx, 0.f) + log1pf(__expf(-fabsf(xx)));
    float gg = -__expf(a_log[h]) * sp;
#pragma unroll
    for (int o = 1; o < 64; o <<= 1) { const float v = __shfl_up(gg, o); if (lane >= o) gg += v; }
    gcL = gg;
  }
  {
    const int d = 2 * lane;
    float cw[3][4][2];
#pragma unroll
    for (int mx = 0; mx < 3; ++mx)
#pragma unroll
      for (int j = 0; j < 4; ++j) {
        const float2 c2 = *(const float2*)(conv_w + j * 1536 + mx * 512 + h * 128 + d);
        cw[mx][j][0] = c2.x; cw[mx][j][1] = c2.y;
      }
    const bf16_t* pbase = proj + (row0 + 16 * w) * PROJW + h * 128 + d;
    unsigned raw[3][19];
#pragma unroll
    for (int j = 0; j < 19; ++j) {
      const bool ok = (t0 + 16 * w - 3 + j) >= 0;
#pragma unroll
      for (int mx = 0; mx < 3; ++mx) {
        unsigned u = 0;
        if (ok) u = *(const unsigned*)(pbase + (ptrdiff_t)(j - 3) * PROJW + mx * 512);
        raw[mx][j] = u;
      }
    }
#pragma unroll
    for (int i = 0; i < 16; ++i) {
      float s[3][2];
#pragma unroll
      for (int mx = 0; mx < 3; ++mx) {
        float y0 = 0.f, y1 = 0.f;
#pragma unroll
        for (int j = 0; j < 4; ++j) { y0 += cw[mx][j][0] * bflo(raw[mx][i + j]); y1 += cw[mx][j][1] * bfhi(raw[mx][i + j]); }
        s[mx][0] = siluf(y0); s[mx][1] = siluf(y1);
      }
      const int row = 16 * w + i;
      const float rq = rsqrtf(wave_sum(s[0][0] * s[0][0] + s[0][1] * s[0][1]) + L2_EPS);
      const float rk = rsqrtf(wave_sum(s[1][0] * s[1][0] + s[1][1] * s[1][1]) + L2_EPS);
      const int off = row * 256 + ((((lane >> 2) ^ (row & 15))) << 4) + (lane & 3) * 4;
      *(unsigned*)(qs + off) = pack2(s[0][0] * rq, s[0][1] * rq);
      *(unsigned*)(ks + off) = pack2(s[1][0] * rk, s[1][1] * rk);
      const float bi = __shfl(bL, row);
      *(unsigned*)(RV + ((size_t)item * 64 + row) * 128 + d) = pack2(bi * s[2][0], bi * s[2][1]);
    }
  }
  __syncthreads();
  {
    f32x4 aKK[4], aQK[4];
#pragma unroll
    for (int nt = 0; nt < 4; ++nt) { aKK[nt] = (f32x4){0.f, 0.f, 0.f, 0.f}; aQK[nt] = (f32x4){0.f, 0.f, 0.f, 0.f}; }
#pragma unroll
    for (int k4 = 0; k4 < 4; ++k4) {
      const int arow = 16 * w + fr;
      const bf16x8 aq = *(const bf16x8*)(qs + arow * 256 + ((((k4 * 4 + fq) ^ (arow & 15))) << 4));
      const bf16x8 ak = *(const bf16x8*)(ks + arow * 256 + ((((k4 * 4 + fq) ^ (arow & 15))) << 4));
#pragma unroll
      for (int nt = 0; nt < 4; ++nt) {
        const int brow = 16 * nt + fr;
        const bf16x8 bk = *(const bf16x8*)(ks + brow * 256 + ((((k4 * 4 + fq) ^ (brow & 15))) << 4));
        aKK[nt] = __builtin_amdgcn_mfma_f32_16x16x32_bf16(ak, bk, aKK[nt], 0, 0, 0);
        aQK[nt] = __builtin_amdgcn_mfma_f32_16x16x32_bf16(bk, aq, aQK[nt], 0, 0, 0);
      }
    }
    float gci[4], bi[4];
#pragma unroll
    for (int r = 0; r < 4; ++r) { gci[r] = __shfl(gcL, 16 * w + 4 * fq + r); bi[r] = __shfl(bL, 16 * w + 4 * fq + r); }
    const float gci2 = __shfl(gcL, 16 * w + fr);
#pragma unroll
    for (int nt = 0; nt < 4; ++nt) {
      const int j = 16 * nt + fr;
      const float gcj = __shfl(gcL, j);
      float av[4], at[4];
#pragma unroll
      for (int r = 0; r < 4; ++r) {
        const int i = 16 * w + 4 * fq + r;
        const float dec = (j <= i) ? __expf(gci[r] - gcj) : 0.f;
        av[r] = (j < i) ? bi[r] * aKK[nt][r] * dec : 0.f;
        const int i2 = 16 * w + fr, j2 = 16 * nt + 4 * fq + r;
        const float gcj2 = __shfl(gcL, j2);
        const float dec2 = (j2 <= i2) ? __expf(gci2 - gcj2) : 0.f;
        at[r] = aQK[nt][r] * scale * dec2;
      }
      *(float4*)(AT + j * 68 + 16 * w + 4 * fq) = make_float4(av[0], av[1], av[2], av[3]);
      u32x2 wv; wv[0] = pack2(at[0], at[1]); wv[1] = pack2(at[2], at[3]);
      *(u32x2*)(ATT + ((size_t)item * 64 + 16 * w + fr) * 64 + 32 * (nt >> 1) + 8 * fq + 4 * (nt & 1)) = wv;
    }
  }
  __syncthreads();
  if (w == 0) {
    float Tr[64];
    int ln = lane; asm volatile("" : "+v"(ln));
#pragma unroll
    for (int j = 0; j < 64; ++j) Tr[j] = 0.f;
    f32x4 cur[16], nxt[16];
#pragma unroll
    for (int j4 = 0; j4 < 16; ++j4) nxt[j4] = (f32x4){0.f, 0.f, 0.f, 0.f};
#pragma unroll
    for (int j4 = 15; j4 >= 16; --j4) cur[j4] = *(const f32x4*)(AT + 63 * 68 + j4 * 4);
#pragma unroll
    for (int c = 63; c >= 0; --c) {
      if (c > 0) {
#pragma unroll
        for (int j4 = 15; j4 >= c / 4; --j4) nxt[j4] = *(const f32x4*)(AT + (c - 1) * 68 + j4 * 4);
      }
      float a0 = 0.f, a1 = 0.f, a2 = 0.f, a3 = 0.f;
#pragma unroll
      for (int j4 = 15; j4 >= (c + 1) / 4; --j4) {
        asm volatile("v_fmac_f32 %0, %1, %2" : "+v"(a0) : "v"(Tr[4 * j4 + 0]), "v"(cur[j4][0]));
        asm volatile("v_fmac_f32 %0, %1, %2" : "+v"(a1) : "v"(Tr[4 * j4 + 1]), "v"(cur[j4][1]));
        asm volatile("v_fmac_f32 %0, %1, %2" : "+v"(a2) : "v"(Tr[4 * j4 + 2]), "v"(cur[j4][2]));
        asm volatile("v_fmac_f32 %0, %1, %2" : "+v"(a3) : "v"(Tr[4 * j4 + 3]), "v"(cur[j4][3]));
      }
      Tr[c] = ((ln == c) ? 1.f : 0.f) - ((a0 + a1) + (a2 + a3));
#pragma unroll
      for (int j4 = 0; j4 < 16; ++j4) cur[j4] = nxt[j4];
    }
    u32x4* tp = (u32x4*)(TM + ((size_t)item * 64 + lane) * 64);
#pragma unroll
    for (int oc = 0; oc < 8; ++oc) {
      const int k0 = 32 * (oc >> 2) + 4 * (oc & 3);
      u32x4 v;
      v[0] = pack2(Tr[k0 + 0], Tr[k0 + 1]); v[1] = pack2(Tr[k0 + 2], Tr[k0 + 3]);
      v[2] = pack2(Tr[k0 + 16], Tr[k0 + 17]); v[3] = pack2(Tr[k0 + 18], Tr[k0 + 19]);
      tp[oc] = v;
    }
  } else {
    const float gclast = __shfl(gcL, 63);
    if (tid == 64) GL[item] = __expf(gclast);
#pragma unroll 1
    for (int it = 0; it < 16; ++it) {
      const int idx = (tid - 64) + it * 192;
      const int mtx = idx >> 10, rem = idx & 1023;
      if (mtx < 2) {
        const int i = rem >> 4, oc = rem & 15;
        const float gi = __shfl(gcL, i), bi = __shfl(bL, i);
        const float f = (mtx == 0) ? scale * __expf(gi) : -bi * __expf(gi);
        const unsigned char* st = (mtx == 0) ? qs : ks;
        const int d0 = 32 * (oc >> 2) + 4 * (oc & 3);
        const uint2 lo = *(const uint2*)(st + i * 256 + ((((d0 >> 3) ^ (i & 15))) << 4) + (d0 & 7) * 2);
        const uint2 hi = *(const uint2*)(st + i * 256 + (((((d0 + 16) >> 3) ^ (i & 15))) << 4) + (d0 & 7) * 2);
        u32x4 v;
        v[0] = pack2(bflo(lo.x) * f, bfhi(lo.x) * f); v[1] = pack2(bflo(lo.y) * f, bfhi(lo.y) * f);
        v[2] = pack2(bflo(hi.x) * f, bfhi(hi.x) * f); v[3] = pack2(bflo(hi.y) * f, bfhi(hi.y) * f);
        bf16_t* dst = ((mtx == 0) ? QD : W0N) + ((size_t)item * 64 + i) * 128 + 8 * oc;
        *(u32x4*)dst = v;
      } else {
        const int d = rem & 127, oc = rem >> 7;
        const int j0 = 32 * (oc >> 2) + 4 * (oc & 3);
        float val[8];
#pragma unroll
        for (int e = 0; e < 8; ++e) {
          const int j = j0 + (e & 3) + ((e >> 2) << 4);
          const float f = __expf(gclast - __shfl(gcL, j));
          const unsigned short raw = *(const unsigned short*)(ks + j * 256 + ((((d >> 3) ^ (j & 15))) << 4) + (d & 7) * 2);
          val[e] = bf2f(raw) * f;
        }
        u32x4 v;
        v[0] = pack2(val[0], val[1]); v[1] = pack2(val[2], val[3]); v[2] = pack2(val[4], val[5]); v[3] = pack2(val[6], val[7]);
        *(u32x4*)(KTT + ((size_t)item * 128 + d) * 64 + 8 * oc) = v;
      }
    }
  }
  __syncthreads();
}

__device__ __forceinline__ void ph_dnscan(unsigned char* smem, int item, const bf16_t* __restrict__ QDp, const bf16_t* __restrict__ W0Np, const bf16_t* __restrict__ KTTp,
                                          const bf16_t* __restrict__ RVp, const bf16_t* __restrict__ TMp, const bf16_t* __restrict__ ATTp, const float* __restrict__ GLp,
                                          float* __restrict__ op) {
  const int tid = TIDX, lane = tid & 63, w = tid >> 6, fr = lane & 15, fq = lane >> 4;
  const int bh = item >> 1, half = item & 1, b = bh >> 2, h = bh & 3;
  const int vcol0 = (half * 4 + w) * 16;
  unsigned char* sW0 = smem; unsigned char* sQD = smem + 16384; unsigned char* sKT = smem + 32768; unsigned char* sT = smem + 49152; unsigned char* sAT = smem + 57344;
  f32x4 S[8];
#pragma unroll
  for (int t = 0; t < 8; ++t) S[t] = (f32x4){0.f, 0.f, 0.f, 0.f};
  u32x4 pfA[8], pfB[8]; unsigned short rvp[16];
#define DN_LOAD_A(nn_) do { \
    const size_t ci = (size_t)bh * 64 + (nn_); \
    _Pragma("unroll") for (int i = 0; i < 4; ++i) pfA[i] = *(const u32x4*)((const char*)W0Np + ci * 16384 + (size_t)(tid + 256 * i) * 16); \
    _Pragma("unroll") for (int i = 0; i < 4; ++i) pfA[4 + i] = *(const u32x4*)((const char*)QDp + ci * 16384 + (size_t)(tid + 256 * i) * 16); \
    _Pragma("unroll") for (int mt = 0; mt < 4; ++mt) \
      _Pragma("unroll") for (int r = 0; r < 4; ++r) rvp[mt * 4 + r] = RVp[(ci * 64 + 16 * mt + 4 * fq + r) * 128 + vcol0 + fr]; \
  } while (0)
#define DN_STORE_A() do { \
    _Pragma("unroll") for (int i = 0; i < 4; ++i) { const int q = tid + 256 * i, row = q >> 4, ch = q & 15; *(u32x4*)(sW0 + row * 256 + ((ch ^ (row & 15)) << 4)) = pfA[i]; } \
    _Pragma("unroll") for (int i = 0; i < 4; ++i) { const int q = tid + 256 * i, row = q >> 4, ch = q & 15; *(u32x4*)(sQD + row * 256 + ((ch ^ (row & 15)) << 4)) = pfA[4 + i]; } \
  } while (0)
#define DN_LOAD_B(nn_) do { \
    const size_t ci = (size_t)bh * 64 + (nn_); \
    _Pragma("unroll") for (int i = 0; i < 4; ++i) pfB[i] = *(const u32x4*)((const char*)KTTp + ci * 16384 + (size_t)(tid + 256 * i) * 16); \
    _Pragma("unroll") for (int i = 0; i < 2; ++i) pfB[4 + i] = *(const u32x4*)((const char*)TMp + ci * 8192 + (size_t)(tid + 256 * i) * 16); \
    _Pragma("unroll") for (int i = 0; i < 2; ++i) pfB[6 + i] = *(const u32x4*)((const char*)ATTp + ci * 8192 + (size_t)(tid + 256 * i) * 16); \
  } while (0)
#define DN_STORE_B() do { \
    _Pragma("unroll") for (int i = 0; i < 4; ++i) { const int q = tid + 256 * i, row = q >> 3, ch = q & 7; *(u32x4*)(sKT + row * 128 + ((ch ^ (row & 7)) << 4)) = pfB[i]; } \
    _Pragma("unroll") for (int i = 0; i < 2; ++i) { const int q = tid + 256 * i, row = q >> 3, ch = q & 7; *(u32x4*)(sT + row * 128 + ((ch ^ (row & 7)) << 4)) = pfB[4 + i]; } \
    _Pragma("unroll") for (int i = 0; i < 2; ++i) { const int q = tid + 256 * i, row = q >> 3, ch = q & 7; *(u32x4*)(sAT + row * 128 + ((ch ^ (row & 7)) << 4)) = pfB[6 + i]; } \
  } while (0)
#define DN_ZINIT() do { _Pragma("unroll") for (int mt = 0; mt < 4; ++mt) Z[mt] = (f32x4){bf2f(rvp[mt * 4 + 0]), bf2f(rvp[mt * 4 + 1]), bf2f(rvp[mt * 4 + 2]), bf2f(rvp[mt * 4 + 3])}; } while (0)
  __syncthreads();
  f32x4 Z[4];
  DN_LOAD_A(0);
  DN_LOAD_B(0);
  DN_STORE_A();
  DN_ZINIT();
  DN_LOAD_A(1);
  for (int nn = 0; nn < 64; ++nn) {
    const float gl = GLp[(size_t)bh * 64 + nn];
    __syncthreads();
    bf16x8 Sb[4];
#pragma unroll
    for (int k4 = 0; k4 < 4; ++k4) Sb[k4] = pack8(S[2 * k4], S[2 * k4 + 1]);
    f32x4 O[4];
#pragma unroll
    for (int mt = 0; mt < 4; ++mt) {
      O[mt] = (f32x4){0.f, 0.f, 0.f, 0.f};
      const int row = 16 * mt + fr;
#pragma unroll
      for (int k4 = 0; k4 < 4; ++k4) {
        const int off = row * 256 + ((((k4 * 4 + fq) ^ fr)) << 4);
        const bf16x8 aw = *(const bf16x8*)(sW0 + off);
        const bf16x8 aq = *(const bf16x8*)(sQD + off);
        Z[mt] = __builtin_amdgcn_mfma_f32_16x16x32_bf16(aw, Sb[k4], Z[mt], 0, 0, 0);
        O[mt] = __builtin_amdgcn_mfma_f32_16x16x32_bf16(Sb[k4], aq, O[mt], 0, 0, 0);
      }
    }
    bf16x8 Zb[2];
    Zb[0] = pack8(Z[0], Z[1]); Zb[1] = pack8(Z[2], Z[3]);
    DN_STORE_B();
    if (nn + 1 < 64) DN_LOAD_B(nn + 1);
    __syncthreads();
    f32x4 Vn[4];
#pragma unroll
    for (int mt = 0; mt < 4; ++mt) {
      Vn[mt] = (f32x4){0.f, 0.f, 0.f, 0.f};
      const int row = 16 * mt + fr;
#pragma unroll
      for (int s = 0; s < 2; ++s) {
        if (s <= (mt >> 1)) {
          const bf16x8 at = *(const bf16x8*)(sT + row * 128 + ((((s * 4 + fq) ^ (row & 7))) << 4));
          Vn[mt] = __builtin_amdgcn_mfma_f32_16x16x32_bf16(at, Zb[s], Vn[mt], 0, 0, 0);
        }
      }
    }
    bf16x8 Vb[2];
    Vb[0] = pack8(Vn[0], Vn[1]); Vb[1] = pack8(Vn[2], Vn[3]);
#pragma unroll
    for (int mt = 0; mt < 4; ++mt) {
      const int row = 16 * mt + fr;
#pragma unroll
      for (int s = 0; s < 2; ++s) {
        if (s <= (mt >> 1)) {
          const bf16x8 aa = *(const bf16x8*)(sAT + row * 128 + ((((s * 4 + fq) ^ (row & 7))) << 4));
          O[mt] = __builtin_amdgcn_mfma_f32_16x16x32_bf16(Vb[s], aa, O[mt], 0, 0, 0);
        }
      }
      *(f32x4*)(op + ((size_t)b * SEQ + nn * 64 + 16 * mt + fr) * 512 + h * 128 + vcol0 + 4 * fq) = O[mt];
    }
#pragma unroll
    for (int t = 0; t < 8; ++t) {
      S[t] = S[t] * gl;
      const int row = 16 * t + fr;
#pragma unroll
      for (int s = 0; s < 2; ++s) {
        const bf16x8 ak = *(const bf16x8*)(sKT + row * 128 + ((((s * 4 + fq) ^ (row & 7))) << 4));
        S[t] = __builtin_amdgcn_mfma_f32_16x16x32_bf16(ak, Vb[s], S[t], 0, 0, 0);
      }
    }
    if (nn + 1 < 64) {
      DN_STORE_A();
      DN_ZINIT();
      if (nn + 2 < 64) DN_LOAD_A(nn + 2);
    }
  }
  __syncthreads();
#undef DN_ZINIT
#undef DN_LOAD_A
#undef DN_STORE_A
#undef DN_LOAD_B
#undef DN_STORE_B
}

__device__ __forceinline__ void ph_dn_post(int item, const float* __restrict__ o, const bf16_t* __restrict__ proj, const float* __restrict__ dn_norm_g, bf16_t* __restrict__ mixed) {
  const int tid = TIDX, h = tid >> 6, lane = tid & 63;
  const float2 g2 = *(const float2*)(dn_norm_g + 2 * lane);
  float2 ov[4]; unsigned zv[4];
#pragma unroll
  for (int i = 0; i < 4; ++i) {
    const size_t n = (size_t)item * 4 + i;
    ov[i] = *(const float2*)(o + n * 512 + h * 128 + 2 * lane);
    zv[i] = *(const unsigned*)(proj + n * PROJW + OFF_Z + h * 128 + 2 * lane);
  }
#pragma unroll
  for (int i = 0; i < 4; ++i) {
    const size_t n = (size_t)item * 4 + i;
    const float ss = wave_sum(ov[i].x * ov[i].x + ov[i].y * ov[i].y);
    const float rn = rsqrtf(ss * (1.f / 128.f) + RMS_EPS);
    *(unsigned*)(mixed + n * DM + h * 128 + 2 * lane) = pack2(ov[i].x * rn * g2.x * siluf(bflo(zv[i])), ov[i].y * rn * g2.y * siluf(bfhi(zv[i])));
  }
}

__device__ __forceinline__ void ph_swa(unsigned char* smem, int item, const bf16_t* __restrict__ proj, const bf16_t* __restrict__ vt, const float* __restrict__ sinks, bf16_t* __restrict__ mixed) {
  const int tid = TIDX, lane = tid & 63, w = tid >> 6, fr = lane & 15, fq = lane >> 4;
  const int qb = item & 31, kvh = (item >> 5) & 1, b = item >> 6;
  const int t0 = qb * 128;
  const size_t rowb = (size_t)b * SEQ;
  unsigned char* sK = smem;
  unsigned char* sV = smem + 32768;
  __syncthreads();
#pragma unroll
  for (int i = 0; i < 8; ++i) {
    const int q = tid + 256 * i, row = q >> 3, ch = q & 7;
    const int pos = t0 - 128 + row;
    u32x4 v = (u32x4){0u, 0u, 0u, 0u};
    if (pos >= 0) v = *(const u32x4*)(proj + (rowb + pos) * PROJW + OFF_SK + kvh * 64 + ch * 8);
    *(u32x4*)(sK + row * 128 + ((ch ^ (row & 7)) << 4)) = v;
  }
#pragma unroll
  for (int i = 0; i < 8; ++i) {
    const int q = tid + 256 * i, row = q >> 5, ch = q & 31;
    const int pos = t0 - 128 + ch * 8;
    u32x4 v = (u32x4){0u, 0u, 0u, 0u};
    if (pos >= 0) v = *(const u32x4*)(vt + ((size_t)(b * 128 + kvh * 64 + row)) * SEQ + pos);
    *(u32x4*)(sV + row * 512 + ((ch ^ (row & 15)) << 4)) = v;
  }
  __syncthreads();
  const int head = kvh * 4 + w;
  const float slope = exp2f(-(float)(head + 1));
  const float sink = sinks[head];
  const bf16_t* qp0 = proj + (rowb + t0 + fr) * PROJW + OFF_SQ + head * 64 + fq * 8;
  bf16x8 qn0 = *(const bf16x8*)(qp0), qn1 = *(const bf16x8*)(qp0 + 32);
#pragma unroll 1
  for (int qt = 0; qt < 8; ++qt) {
    const bf16x8 qf0 = qn0, qf1 = qn1;
    if (qt < 7) { const bf16_t* qp = qp0 + (size_t)(qt + 1) * 16 * PROJW; qn0 = *(const bf16x8*)(qp); qn1 = *(const bf16x8*)(qp + 32); }
    const int kp0 = qt >> 1;
    f32x4 st[10];
#pragma unroll
    for (int kt = 0; kt < 10; ++kt) {
      const int krow = (2 * kp0 + kt) * 16 + fr;
      st[kt] = (f32x4){0.f, 0.f, 0.f, 0.f};
      const bf16x8 k0 = *(const bf16x8*)(sK + krow * 128 + (((0 + fq) ^ (krow & 7)) << 4));
      const bf16x8 k1 = *(const bf16x8*)(sK + krow * 128 + (((4 + fq) ^ (krow & 7)) << 4));
      st[kt] = __builtin_amdgcn_mfma_f32_16x16x32_bf16(k0, qf0, st[kt], 0, 0, 0);
      st[kt] = __builtin_amdgcn_mfma_f32_16x16x32_bf16(k1, qf1, st[kt], 0, 0, 0);
    }
    const int i = qt * 16 + fr;
    float mx = sink;
#pragma unroll
    for (int kt = 0; kt < 10; ++kt)
#pragma unroll
      for (int r = 0; r < 4; ++r) {
        const int jb = (2 * kp0 + kt) * 16 + 4 * fq + r;
        const int dist = 128 + i - jb;
        const bool ok = (dist >= 0) && (dist < 128) && (t0 - 128 + jb >= 0);
        const float s = ok ? (st[kt][r] * 0.125f - slope * (float)dist) : -INFINITY;
        st[kt][r] = s;
        mx = fmaxf(mx, s);
      }
    mx = fmaxf(mx, __shfl_xor(mx, 16));
    mx = fmaxf(mx, __shfl_xor(mx, 32));
    float sum = 0.f;
#pragma unroll
    for (int kt = 0; kt < 10; ++kt)
#pragma unroll
      for (int r = 0; r < 4; ++r) { const float p = __expf(st[kt][r] - mx); st[kt][r] = p; sum += p; }
    sum += __shfl_xor(sum, 16);
    sum += __shfl_xor(sum, 32);
    const float inv = 1.f / (sum + __expf(sink - mx));
    f32x4 O[4];
#pragma unroll
    for (int nt = 0; nt < 4; ++nt) O[nt] = (f32x4){0.f, 0.f, 0.f, 0.f};
#pragma unroll
    for (int s5 = 0; s5 < 5; ++s5) {
      const bf16x8 pa = pack8(st[2 * s5] * inv, st[2 * s5 + 1] * inv);
      const int key0 = (2 * kp0 + 2 * s5) * 16 + 4 * fq;
#pragma unroll
      for (int nt = 0; nt < 4; ++nt) {
        const int drow = nt * 16 + fr;
        const int c0 = key0 >> 3, c1 = (key0 + 16) >> 3;
        const u32x2 lo = *(const u32x2*)(sV + drow * 512 + ((c0 ^ (drow & 15)) << 4) + ((key0 >> 2) & 1) * 8);
        const u32x2 hi = *(const u32x2*)(sV + drow * 512 + ((c1 ^ (drow & 15)) << 4) + ((key0 >> 2) & 1) * 8);
        const u32x4 vb = (u32x4){lo[0], lo[1], hi[0], hi[1]};
        O[nt] = __builtin_amdgcn_mfma_f32_16x16x32_bf16(__builtin_bit_cast(bf16x8, vb), pa, O[nt], 0, 0, 0);
      }
    }
#pragma unroll
    for (int nt = 0; nt < 4; ++nt) {
      u32x2 wv; wv[0] = pack2(O[nt][0], O[nt][1]); wv[1] = pack2(O[nt][2], O[nt][3]);
      *(u32x2*)(mixed + (rowb + t0 + qt * 16 + fr) * DM + 512 + head * 64 + nt * 16 + 4 * fq) = wv;
    }
  }
}

__device__ __forceinline__ void ph_wout(unsigned char* smem, int xcd, int l, const bf16_t* __restrict__ mixed, const bf16_t* __restrict__ wt, bf16_t* __restrict__ mixo) {
  const int mi = l >> 3, ni = l & 7;
  LdRowBF16 al; al.init([&](int r) { return mixed + (size_t)((xcd * 32 + mi) * 128 + r) * DM; }, (size_t)8 * 128 * DM * 2);
  LdRowBF16 bl; bl.init([&](int r) { return wt + (size_t)(ni * 128 + r) * DM; }, 0);
  gemm_stream<16>(smem, al, bl, 4, [&](int seg, f32x4 (&acc)[4][4], unsigned char* fbuf) {
    const int m0 = (xcd * 32 + seg * 8 + mi) * 128, n0 = ni * 128;
    store_tile_bf16(fbuf, acc, [&](int r) { return mixo + (size_t)(m0 + r) * DM + n0; });
  });
}

__device__ __forceinline__ void ph_ln1(int item, const float* __restrict__ x, const bf16_t* __restrict__ mixo, const float* __restrict__ gam, const float* __restrict__ bet, bf16_t* __restrict__ xbf, unsigned char* __restrict__ x8) {
  const int row = item * 4 + (TIDX >> 6), lane = TIDX & 63;
  const float4* p = (const float4*)(x + (size_t)row * DM);
  const u32x2* pm = (const u32x2*)(mixo + (size_t)row * DM);
  float4 v[4]; float s = 0.f;
#pragma unroll
  for (int i = 0; i < 4; ++i) {
    const float4 xv = p[lane + i * 64]; const u32x2 mv = pm[lane + i * 64];
    v[i].x = ALPHA * xv.x + bflo(mv[0]); v[i].y = ALPHA * xv.y + bfhi(mv[0]); v[i].z = ALPHA * xv.z + bflo(mv[1]); v[i].w = ALPHA * xv.w + bfhi(mv[1]);
    s += v[i].x + v[i].y + v[i].z + v[i].w;
  }
  const float mu = wave_sum(s) * (1.f / DM);
  float q = 0.f;
#pragma unroll
  for (int i = 0; i < 4; ++i) { const float a = v[i].x - mu, b = v[i].y - mu, c = v[i].z - mu, d = v[i].w - mu; q += a * a + b * b + c * c + d * d; }
  const float rs = rsqrtf(wave_sum(q) * (1.f / DM) + LN_EPS);
#pragma unroll
  for (int i = 0; i < 4; ++i) {
    const float4 gg = ((const float4*)gam)[lane + i * 64], bb = ((const float4*)bet)[lane + i * 64];
    u32x2 w;
    w[0] = pack2((v[i].x - mu) * rs * gg.x + bb.x, (v[i].y - mu) * rs * gg.y + bb.y);
    w[1] = pack2((v[i].z - mu) * rs * gg.z + bb.z, (v[i].w - mu) * rs * gg.w + bb.w);
    ((u32x2*)(xbf + (size_t)row * DM))[lane + i * 64] = w;
    int pk = 0;
    pk = __builtin_amdgcn_cvt_pk_fp8_f32((v[i].x - mu) * rs * gg.x + bb.x, (v[i].y - mu) * rs * gg.y + bb.y, pk, false);
    pk = __builtin_amdgcn_cvt_pk_fp8_f32((v[i].z - mu) * rs * gg.z + bb.z, (v[i].w - mu) * rs * gg.w + bb.w, pk, true);
    ((int*)(x8 + (size_t)row * DM))[lane + i * 64] = pk;
  }
}

__device__ __forceinline__ void ph_router(unsigned char* smem, int tile, const bf16_t* __restrict__ xbf, const bf16_t* __restrict__ wt, float* __restrict__ logits) {
  GEMM_IDS
  const int n0 = (tile & 1) * 128, m0 = (tile >> 1) * 128;
  LdRowBF16 al; al.init([&](int r) { return xbf + (size_t)(m0 + r) * DM; }, 0);
  LdRowBF16 bl; bl.init([&](int r) { return wt + (size_t)(n0 + r) * DM; }, 0);
  gemm_stream<16>(smem, al, bl, 1, [&](int seg, f32x4 (&acc)[4][4], unsigned char* fbuf) {
    GEMM_IDS
#pragma unroll
    for (int m = 0; m < 4; ++m)
#pragma unroll
      for (int n = 0; n < 4; ++n)
        *(f32x4*)(logits + (size_t)(m0 + wr * 64 + m * 16 + fr) * NEXP + n0 + wc * 64 + n * 16 + fq * 4) = acc[m][n];
  });
}

__device__ __forceinline__ unsigned rt_fkey(float f) { const unsigned b = __float_as_uint(f); return (b & 0x80000000u) ? ~b : (b | 0x80000000u); }
#define RT_DPPF(x, ctrl) __builtin_bit_cast(float, __builtin_amdgcn_update_dpp(__builtin_bit_cast(int, x), __builtin_bit_cast(int, x), ctrl, 0xf, 0xf, false))
#define RT_DPPU(x, ctrl, rmask) (unsigned)__builtin_amdgcn_update_dpp((int)(x), (int)(x), ctrl, rmask, 0xf, false)
#define RT_KSTEP(hi, lo, ctrl, rmask) { const unsigned ph_ = RT_DPPU(hi, ctrl, rmask), pl_ = RT_DPPU(lo, ctrl, rmask); \
    const bool t_ = (ph_ > hi) || (ph_ == hi && pl_ > lo); hi = t_ ? ph_ : hi; lo = t_ ? pl_ : lo; }
__device__ __forceinline__ void ph_route(int item, const float* __restrict__ logits, const float* __restrict__ router_bias, int* __restrict__ cnt, int* __restrict__ list, float* __restrict__ gates) {
  const int n = item * 4 + (TIDX >> 6), lane = TIDX & 63;
  const float4 lg = ((const float4*)(logits + (size_t)n * NEXP))[lane];
  const float4 rb = ((const float4*)router_bias)[lane];
  const float sc0 = sigmoidf(lg.x), sc1 = sigmoidf(lg.y), sc2 = sigmoidf(lg.z), sc3 = sigmoidf(lg.w);
  const float sel0 = sc0 + rb.x, sel1 = sc1 + rb.y, sel2 = sc2 + rb.z, sel3 = sc3 + rb.w;
  float t1 = fmaxf(sel0, sel1), t2 = fminf(sel0, sel1);
  { const float a = sel2; if (a > t1) { t2 = t1; t1 = a; } else if (a > t2) t2 = a; }
  { const float a = sel3; if (a > t1) { t2 = t1; t1 = a; } else if (a > t2) t2 = a; }
  { const float b1 = RT_DPPF(t1, 0xB1), b2 = RT_DPPF(t2, 0xB1); const float n1 = fmaxf(t1, b1), n2 = fmaxf(fminf(t1, b1), fmaxf(t2, b2)); t1 = n1; t2 = n2; }
  { const float b1 = RT_DPPF(t1, 0x4E), b2 = RT_DPPF(t2, 0x4E); const float n1 = fmaxf(t1, b1), n2 = fmaxf(fminf(t1, b1), fmaxf(t2, b2)); t1 = n1; t2 = n2; }
  { const float b1 = RT_DPPF(t1, 0x141), b2 = RT_DPPF(t2, 0x141); const float n1 = fmaxf(t1, b1), n2 = fmaxf(fminf(t1, b1), fmaxf(t2, b2)); t1 = n1; t2 = n2; }
  const float gs = t1 + t2;
  const int mygrp = lane >> 3;
  int rank = 0;
#pragma unroll
  for (int j = 0; j < 8; ++j) {
    const float o = __builtin_bit_cast(float, __builtin_amdgcn_readlane(__builtin_bit_cast(int, gs), j * 8));
    rank += (o > gs || (o == gs && j < mygrp)) ? 1 : 0;
  }
  const bool gsel = rank < 4;
  unsigned k0 = gsel ? rt_fkey(sel0) : 0u, k1 = gsel ? rt_fkey(sel1) : 0u, k2 = gsel ? rt_fkey(sel2) : 0u, k3 = gsel ? rt_fkey(sel3) : 0u;
  float gsum = 0.f; float myg = 0.f; int mye = 0;
#pragma unroll 1
  for (int r = 0; r < TOPK; ++r) {
    unsigned hi = k0, lo = 255u - (unsigned)(lane * 4);
    if (k1 > hi) { hi = k1; lo = 255u - (unsigned)(lane * 4 + 1); }
    if (k2 > hi) { hi = k2; lo = 255u - (unsigned)(lane * 4 + 2); }
    if (k3 > hi) { hi = k3; lo = 255u - (unsigned)(lane * 4 + 3); }
    RT_KSTEP(hi, lo, 0xB1, 0xf) RT_KSTEP(hi, lo, 0x4E, 0xf) RT_KSTEP(hi, lo, 0x141, 0xf) RT_KSTEP(hi, lo, 0x140, 0xf)
    RT_KSTEP(hi, lo, 0x142, 0xa) RT_KSTEP(hi, lo, 0x143, 0xc)
    const int be = 255 - __builtin_amdgcn_readlane((int)lo, 63);
    const int owner = be >> 2, slot = be & 3;
    const float tsel = (slot == 0) ? sc0 : (slot == 1) ? sc1 : (slot == 2) ? sc2 : sc3;
    const float bs = __builtin_bit_cast(float, __builtin_amdgcn_readlane(__builtin_bit_cast(int, tsel), owner));
    if (lane == owner) { if (slot == 0) k0 = 0u; else if (slot == 1) k1 = 0u; else if (slot == 2) k2 = 0u; else k3 = 0u; }
    gsum += bs;
    if (lane == r) { myg = bs; mye = be; }
  }
  if (lane < TOPK) {
    const int sh = item & (NSH - 1);
    const int slot = atomicAdd(&cnt[sh * NEXP + mye], 1);
    list[((size_t)sh * NEXP + mye) * CAPS + slot] = n * TOPK + lane;
    gates[(size_t)n * TOPK + lane] = myg / gsum * 2.5f;
  }
}
#undef RT_KSTEP

__device__ __forceinline__ void moe_build_prefix(const int* __restrict__ cnt, int* sscan) {
  const int tid = TIDX;
  const int e = ((tid & 31) << 3) | (tid >> 5);
  int c = 0;
#pragma unroll
  for (int s = 0; s < NSH; ++s) c += cnt[s * NEXP + e];
  __syncthreads();
  sscan[tid] = (c + 127) >> 7;
  __syncthreads();
  for (int o = 1; o < 256; o <<= 1) {
    const int v = (tid >= o) ? sscan[tid - o] : 0;
    __syncthreads();
    sscan[tid] += v;
    __syncthreads();
  }
}
__device__ __forceinline__ void moe_locate(const int* sscan, int x, int lt, int& e, int& rt) {
  const int base = x ? sscan[32 * x - 1] : 0;
  const int nrouted = sscan[32 * x + 31] - base;
  if (lt >= nrouted) { e = 256; rt = x * (NTOK / 128 / 8) + (lt - nrouted); return; }
  const int g = base + lt;
  int lo = 32 * x, hi = 32 * x + 31;
  while (lo < hi) { const int mid = (lo + hi) >> 1; if (sscan[mid] > g) hi = mid; else lo = mid + 1; }
  e = ((lo & 31) << 3) | (lo >> 5); rt = g - (lo ? sscan[lo - 1] : 0);
}

__device__ __forceinline__ long lo64(const u32x4& v) { return (long)(((unsigned long long)v[1] << 32) | (unsigned long long)v[0]); }
__device__ __forceinline__ long hi64(const u32x4& v) { return (long)(((unsigned long long)v[3] << 32) | (unsigned long long)v[2]); }
__device__ __forceinline__ void ph_moe(unsigned char* smem, int e, int rt, const unsigned char* __restrict__ x8, const bf16_t* __restrict__ xbf, const int* __restrict__ cnt,
                                       const int* __restrict__ list, const float* __restrict__ gates, const unsigned char* __restrict__ wge, const unsigned char* __restrict__ wue,
                                       const unsigned char* __restrict__ wde, unsigned char* __restrict__ ybuf, float* __restrict__ dout, unsigned char* __restrict__ dummy) {
  int* sasg = (int*)(smem + SM_MISC + 2048);
  float* sgate = (float*)(smem + SM_MISC + 2048 + 512);
  const int tid = TIDX, lane = tid & 63, w = tid >> 6, fr = lane & 15, fq = lane >> 4;
  __syncthreads();
  if (tid < 128) {
    const int r = rt * 128 + tid;
    int a = -1;
    if (e < 256) {
      int cum = 0;
#pragma unroll
      for (int s = 0; s < NSH; ++s) {
        const int c = cnt[s * NEXP + e];
        if (r >= cum && r < cum + c) a = list[((size_t)s * NEXP + e) * CAPS + (r - cum)];
        cum += c;
      }
    } else if (r < NTOK) a = NA + r;
    sasg[tid] = a;
    sgate[tid] = (a >= 0 && a < NA) ? gates[a] : 1.f;
  }
  __syncthreads();
  long hf[2][8];
  {
    LdRowBF16 al; al.init([&](int r) { const int a = sasg[r]; const int tok = (a < 0) ? 0 : (a < NA ? (a >> 3) : (a - NA)); return x8 + (size_t)tok * DM; }, 0);
    LdRowBF16 bl; bl.init([&](int j) {
      const int bn = j >> 4, ff = (bn >> 1) * 16 + (j & 15);
      return ((bn & 1) ? wue : wge) + (size_t)ff * DM; }, (size_t)64 * DM);
    al.issue(0, 0, smem); bl.issue(0, 0, smem + 16384);
    asm volatile("s_waitcnt vmcnt(0)" ::: "memory");
    __syncthreads();
#pragma unroll
    for (int m = 0; m < 2; ++m)
#pragma unroll
      for (int s = 0; s < 8; ++s) hf[m][s] = 0;
#pragma unroll 1
    for (int ct = 0; ct < 4; ++ct) {
      f32x4 acc[2][8];
#pragma unroll
      for (int m = 0; m < 2; ++m)
#pragma unroll
        for (int n = 0; n < 8; ++n) acc[m][n] = (f32x4){0.f, 0.f, 0.f, 0.f};
#pragma unroll 1
      for (int kk = 0; kk < 8; ++kk) {
        const int j = ct * 8 + kk;
        unsigned char* cur = smem + (j & 1) * 32768; unsigned char* nxt = smem + ((j & 1) ^ 1) * 32768;
        if (j + 1 < 32) { al.issue((j + 1) >> 3, (j + 1) & 7, nxt); bl.issue((j + 1) >> 3, (j + 1) & 7, nxt + 16384); }
#pragma unroll
        for (int ks = 0; ks < 2; ++ks) {
          u32x4 a[2], bfrag[8];
#pragma unroll
          for (int m = 0; m < 2; ++m) {
            const int row = w * 32 + m * 16 + fr;
            a[m] = *(const u32x4*)(cur + row * 128 + (((ks * 4 + fq) ^ (row & 7)) << 4));
          }
#pragma unroll
          for (int n = 0; n < 8; ++n) {
            const int row = n * 16 + fr;
            bfrag[n] = *(const u32x4*)(cur + 16384 + row * 128 + (((ks * 4 + fq) ^ (row & 7)) << 4));
          }
          __builtin_amdgcn_s_setprio(1);
#pragma unroll
          for (int n = 0; n < 8; ++n)
#pragma unroll
            for (int m = 0; m < 2; ++m) {
              acc[m][n] = __builtin_amdgcn_mfma_f32_16x16x32_fp8_fp8(lo64(bfrag[n]), lo64(a[m]), acc[m][n], 0, 0, 0);
              acc[m][n] = __builtin_amdgcn_mfma_f32_16x16x32_fp8_fp8(hi64(bfrag[n]), hi64(a[m]), acc[m][n], 0, 0, 0);
            }
          __builtin_amdgcn_s_setprio(0);
          __builtin_amdgcn_sched_group_barrier(0x100, 10, 0);
          __builtin_amdgcn_sched_group_barrier(0x008, 32, 0);
        }
        asm volatile("s_waitcnt vmcnt(0)" ::: "memory");
        __syncthreads();
      }
#pragma unroll
      for (int m = 0; m < 2; ++m) {
        int hp[4][2];
#pragma unroll
        for (int p = 0; p < 4; ++p) {
          float hv[4];
#pragma unroll
          for (int r = 0; r < 4; ++r) hv[r] = siluf(acc[m][2 * p][r] * (1.f / SC_WG)) * acc[m][2 * p + 1][r] * (SC_H / SC_WU);
          int pk = 0;
          pk = __builtin_amdgcn_cvt_pk_fp8_f32(hv[0], hv[1], pk, false);
          pk = __builtin_amdgcn_cvt_pk_fp8_f32(hv[2], hv[3], pk, true);
          hp[p][0] = pk;
        }
        const long h0 = (long)(((unsigned long long)(unsigned)hp[1][0] << 32) | (unsigned long long)(unsigned)hp[0][0]);
        const long h1 = (long)(((unsigned long long)(unsigned)hp[3][0] << 32) | (unsigned long long)(unsigned)hp[2][0]);
        if (ct == 0) { hf[m][0] = h0; hf[m][1] = h1; }
        else if (ct == 1) { hf[m][2] = h0; hf[m][3] = h1; }
        else if (ct == 2) { hf[m][4] = h0; hf[m][5] = h1; }
        else { hf[m][6] = h0; hf[m][7] = h1; }
      }
    }
  }
#define MOE_RAW_BARRIER() do { asm volatile("s_waitcnt lgkmcnt(0)" ::: "memory"); __builtin_amdgcn_s_barrier(); } while (0)
  {
    LdRowBF16 bl; bl.init([&](int j) { return wde + (size_t)j * EFF; }, (size_t)128 * EFF);
    bl.issue(0, 0, smem); bl.issue(0, 1, smem + 16384); bl.issue(1, 0, smem + 32768);
#pragma unroll 1
    for (int ct = 0; ct < 8; ++ct) {
      f32x4 acc[2][8];
#pragma unroll
      for (int m = 0; m < 2; ++m)
#pragma unroll
        for (int n = 0; n < 8; ++n) acc[m][n] = (f32x4){0.f, 0.f, 0.f, 0.f};
#pragma unroll
      for (int kk = 0; kk < 2; ++kk) {
        const int j = ct * 2 + kk;
        if (e < 256) {
          if (kk == 0) {
            if (ct == 0) asm volatile("s_waitcnt vmcnt(8)" ::: "memory");
            else if (ct == 1) asm volatile("s_waitcnt vmcnt(12)" ::: "memory");
            else if (ct < 7) asm volatile("s_waitcnt vmcnt(16)" ::: "memory");
            else asm volatile("s_waitcnt vmcnt(12)" ::: "memory");
          } else {
            if (ct == 0) asm volatile("s_waitcnt vmcnt(8)" ::: "memory");
            else if (ct < 7) asm volatile("s_waitcnt vmcnt(12)" ::: "memory");
            else asm volatile("s_waitcnt vmcnt(4)" ::: "memory");
          }
        } else {
          if (j < 14) asm volatile("s_waitcnt vmcnt(8)" ::: "memory");
          else if (j == 14) asm volatile("s_waitcnt vmcnt(4)" ::: "memory");
          else asm volatile("s_waitcnt vmcnt(0)" ::: "memory");
        }
        MOE_RAW_BARRIER();
        if (j + 3 < 16) bl.issue((j + 3) >> 1, (j + 3) & 1, smem + ((j + 3) & 3) * 16384);
        const unsigned char* cur = smem + (j & 3) * 16384;
#pragma unroll
        for (int s4 = 0; s4 < 4; ++s4) {
          long wf[8];
#pragma unroll
          for (int n = 0; n < 8; ++n) {
            const int row = n * 16 + fr;
            wf[n] = *(const long*)(cur + row * 128 + ((((2 * s4 + (fq >> 1))) ^ (row & 7)) << 4) + (fq & 1) * 8);
          }
          __builtin_amdgcn_s_setprio(1);
#pragma unroll
          for (int n = 0; n < 8; ++n)
#pragma unroll
            for (int m = 0; m < 2; ++m) acc[m][n] = __builtin_amdgcn_mfma_f32_16x16x32_fp8_fp8(wf[n], hf[m][kk * 4 + s4], acc[m][n], 0, 0, 0);
          __builtin_amdgcn_s_setprio(0);
          __builtin_amdgcn_sched_group_barrier(0x100, 8, 0);
          __builtin_amdgcn_sched_group_barrier(0x008, 16, 0);
        }
      }
      const int n0 = ct * 128;
      if (e == 256) {
#pragma unroll
        for (int m = 0; m < 2; ++m) {
          const int a = sasg[w * 32 + m * 16 + fr];
          if (a >= NA) {
            float* dp = dout + (size_t)(a - NA) * DM + n0 + fq * 4;
            const bf16_t* xp = xbf + (size_t)(a - NA) * DM + n0 + fq * 4;
#pragma unroll
            for (int n = 0; n < 8; ++n) {
              const u32x2 xw = *(const u32x2*)(xp + n * 16);
              const f32x4 xv = (f32x4){bflo(xw[0]), bfhi(xw[0]), bflo(xw[1]), bfhi(xw[1])};
              *(f32x4*)(dp + n * 16) = xv * ALPHA + acc[m][n] * (1.f / (SC_H * SC_WD));
            }
          }
        }
      } else {
        unsigned char* stg = smem + ((2 * ct + 1) & 3) * 16384 + w * 4096;
        MOE_RAW_BARRIER();
#pragma unroll
        for (int m = 0; m < 2; ++m) {
          const int row = m * 16 + fr;
          const float gt = sgate[w * 32 + row] * (SC_Y / (SC_H * SC_WD));
#pragma unroll
          for (int n = 0; n < 8; ++n) {
            int pk = 0;
            pk = __builtin_amdgcn_cvt_pk_fp8_f32(acc[m][n][0] * gt, acc[m][n][1] * gt, pk, false);
            pk = __builtin_amdgcn_cvt_pk_fp8_f32(acc[m][n][2] * gt, acc[m][n][3] * gt, pk, true);
            *(int*)(stg + row * 128 + ((n ^ (row & 7)) << 4) + 4 * fq) = pk;
          }
        }
#pragma unroll
        for (int i = 0; i < 4; ++i) {
          const int q = lane + 64 * i, row = q >> 3, ch = q & 7;
          const int a = sasg[w * 32 + row];
          unsigned char* yp = ((a >= 0) ? ybuf + (size_t)a * DM : dummy) + n0 + ch * 16;
          *(u32x4*)yp = *(const u32x4*)(stg + row * 128 + ((ch ^ (row & 7)) << 4));
        }
      }
    }
    MOE_RAW_BARRIER();
  }
#undef MOE_RAW_BARRIER
}

__device__ __forceinline__ void ph_final(int item, float* __restrict__ out, const unsigned char* __restrict__ ybuf, const float* __restrict__ gam, const float* __restrict__ bet) {
  const int row = item * 4 + (TIDX >> 6), lane = TIDX & 63;
  f32x4* p = (f32x4*)(out + (size_t)row * DM + 16 * lane);
  f32x4 v[4];
#pragma unroll
  for (int i = 0; i < 4; ++i) v[i] = p[i];
  u32x4 yv[8];
#pragma unroll
  for (int k = 0; k < 8; ++k) yv[k] = *(const u32x4*)(ybuf + ((size_t)row * 8 + k) * DM + 16 * lane);
  float ys[16];
#pragma unroll
  for (int c = 0; c < 16; ++c) ys[c] = 0.f;
#pragma unroll
  for (int k = 0; k < 8; ++k)
#pragma unroll
    for (int d = 0; d < 4; ++d) {
      const hwf32x2 lo = __builtin_amdgcn_cvt_pk_f32_fp8((int)yv[k][d], false), hi = __builtin_amdgcn_cvt_pk_f32_fp8((int)yv[k][d], true);
      ys[4 * d + 0] += lo[0]; ys[4 * d + 1] += lo[1]; ys[4 * d + 2] += hi[0]; ys[4 * d + 3] += hi[1];
    }
  float s = 0.f;
#pragma unroll
  for (int i = 0; i < 4; ++i)
#pragma unroll
    for (int r = 0; r < 4; ++r) { v[i][r] += ys[4 * i + r] * (1.f / 32.f); s += v[i][r]; }
  const float mu = wave_sum(s) * (1.f / DM);
  float q = 0.f;
#pragma unroll
  for (int i = 0; i < 4; ++i)
#pragma unroll
    for (int r = 0; r < 4; ++r) { const float d = v[i][r] - mu; q += d * d; }
  const float rs = rsqrtf(wave_sum(q) * (1.f / DM) + LN_EPS);
#pragma unroll
  for (int i = 0; i < 4; ++i) {
    const f32x4 gg = *(const f32x4*)(gam + 16 * lane + 4 * i), bb = *(const f32x4*)(bet + 16 * lane + 4 * i);
    p[i] = (v[i] - mu) * rs * gg + bb;
  }
}

#define XB_TMO      128
#define XB_XCNT(j)  (256  + 64 * (j))
#define XB_XSUB(j)  (1280 + 64 * (j))
#define XB_XGEN(j)  (2304 + 64 * (j))
#define XB_TOP      3328
#define XB_TOPGEN   3392
#define XCD_BAR_WORDS 3456
#define XB_SPIN_CAP (1u << 22)
#define LAS __attribute__((address_space(3)))
__device__ __forceinline__ unsigned xb_ld(unsigned* p)              { return __hip_atomic_load(p, __ATOMIC_RELAXED, __HIP_MEMORY_SCOPE_AGENT); }
__device__ __forceinline__ unsigned xb_add(unsigned* p, unsigned v) { return __hip_atomic_fetch_add(p, v, __ATOMIC_RELAXED, __HIP_MEMORY_SCOPE_AGENT); }
__device__ __forceinline__ unsigned xb_xcc_id() { return (unsigned)__builtin_amdgcn_s_getreg((3 << 11) | 20) & 0xFu; }
#define XB_SPIN(cond, bar) do { unsigned _sp = 0; while (cond) { __builtin_amdgcn_s_sleep(1); \
    if ((++_sp & 255u) == 0u) { if (xb_ld(&(bar)[XB_TMO])) break; if (_sp > XB_SPIN_CAP) { atomicAdd(&(bar)[XB_TMO], 1u); break; } } } } while (0)
struct XcdBarrier { unsigned* bar; unsigned x; volatile LAS unsigned* st; };
__device__ __forceinline__ XcdBarrier xcd_barrier_post(unsigned* bar, volatile LAS unsigned* st) {
  XcdBarrier b; b.bar = bar; b.x = xb_xcc_id(); b.st = st;
  if (threadIdx.x == 0) (void)xb_add(&bar[XB_XCNT(b.x)], 1u);
  return b;
}
__device__ __forceinline__ void xcd_barrier_complete(unsigned* bar, unsigned x, unsigned& nloc, unsigned& nx) {
  const unsigned G = gridDim.x * gridDim.y * gridDim.z;
  unsigned sum, cnt, mine, sp = 0u;
  for (;;) {
    sum = 0u; cnt = 0u; mine = 0u;
#pragma unroll
    for (unsigned j = 0; j < 16; ++j) { const unsigned c = xb_ld(&bar[XB_XCNT(j)]); sum += c; cnt += (c > 0u) ? 1u : 0u; mine = (j == x) ? c : mine; }
    if (sum == G) break;
    __builtin_amdgcn_s_sleep(1);
    if ((++sp & 255u) == 0u) { if (xb_ld(&bar[XB_TMO])) break; if (sp > XB_SPIN_CAP) { atomicAdd(&bar[XB_TMO], 1u); break; } }
  }
  nloc = mine > 0u ? mine : 1u; nx = cnt > 0u ? cnt : 1u;
}
__device__ __forceinline__ void xcd_barrier(const XcdBarrier& b) {
  asm volatile("s_waitcnt vmcnt(0)" ::: "memory");
  __syncthreads();
  if (threadIdx.x == 0) {
    unsigned* bar = b.bar;
    __builtin_amdgcn_s_waitcnt(0);
    unsigned nloc = b.st[0], nx = b.st[1];
    if (nloc == 0u) { xcd_barrier_complete(bar, b.x, nloc, nx); b.st[0] = nloc; b.st[1] = nx; }
    const unsigned old = xb_add(&bar[XB_XSUB(b.x)], 1u);
    const unsigned gen = old / nloc;
    if (old + 1u == (gen + 1u) * nloc) {
      __builtin_amdgcn_fence(__ATOMIC_RELEASE, "agent");
      asm volatile("s_waitcnt vmcnt(0)" ::: "memory");
      const unsigned og = xb_add(&bar[XB_TOP], 1u);
      const unsigned tg = og / nx;
      if (og + 1u == (tg + 1u) * nx) xb_add(&bar[XB_TOPGEN], 1u);
      else XB_SPIN(xb_ld(&bar[XB_TOPGEN]) == tg, bar);
      __builtin_amdgcn_fence(__ATOMIC_ACQUIRE, "agent");
      xb_add(&bar[XB_XGEN(b.x)], 1u);
      asm volatile("s_waitcnt vmcnt(0)" ::: "memory");
    } else {
      XB_SPIN(xb_ld(&bar[XB_XGEN(b.x)]) == gen, bar);
      __builtin_amdgcn_fence(__ATOMIC_ACQUIRE, "agent");
      asm volatile("s_waitcnt vmcnt(0)" ::: "memory");
    }
  }
  __syncthreads();
}

__global__ void __launch_bounds__(256, 2) mega(Params P) {
  __shared__ __attribute__((aligned(16))) unsigned char smem[SMEM_BYTES];
  const int bid = blockIdx.x, nblk = gridDim.x;
#define xin (P.in[0])
#define w_in (P.in[1])
#define conv_w (P.in[2])
#define a_log (P.in[3])
#define dt_bias (P.in[4])
#define dn_norm_g (P.in[5])
#define sinks (P.in[6])
#define w_out (P.in[7])
#define ln1_g (P.in[8])
#define ln1_b (P.in[9])
#define router_w (P.in[10])
#define router_bias (P.in[11])
#define w_gate (P.in[12])
#define w_up (P.in[13])
#define w_down (P.in[14])
#define sw_gate (P.in[15])
#define sw_up (P.in[16])
#define sw_down (P.in[17])
#define ln2_g (P.in[18])
#define ln2_b (P.in[19])
#define outp (P.out)
#define x1bf ((bf16_t*)(P.ws + WS_X1BF))
#define logits ((float*)(P.ws + WS_LOGIT))
#define list ((int*)(P.ws + WS_LIST))
#define gates ((float*)(P.ws + WS_GATES))
#define cnt ((int*)(P.ws + WS_CTRL + CNT16_OFF))
#define barw ((unsigned*)(P.ws + WS_CTRL + 4096))
#define mixed ((bf16_t*)(P.ws + WS_MIXED))
#define proj ((bf16_t*)(P.ws + WS_PROJ))
#define ba ((float*)(P.ws + WS_BA))
#define QD ((bf16_t*)(P.ws + WS_QD))
#define W0N ((bf16_t*)(P.ws + WS_W0N))
#define KTT ((bf16_t*)(P.ws + WS_KTT))
#define RV ((bf16_t*)(P.ws + WS_RV))
#define TM ((bf16_t*)(P.ws + WS_TM))
#define ATT ((bf16_t*)(P.ws + WS_ATT))
#define GL ((float*)(P.ws + WS_GL))
#define obuf ((float*)(P.ws + WS_O))
#define VTb ((bf16_t*)(P.ws + WS_VT))
#define MIXO ((bf16_t*)(P.ws + WS_O))
#define XBF ((bf16_t*)(P.ws + WS_XBF))
#define WTIN ((bf16_t*)(P.ws + WS_WTIN))
#define WTOUT ((bf16_t*)(P.ws + WS_WTOUT))
#define WTR ((bf16_t*)(P.ws + WS_WTR))
#define ybuf ((unsigned char*)(P.ws + WS_YBUF))
  {
    volatile LAS unsigned* st0 = (volatile LAS unsigned*)(smem + SM_MISC + 4080);
    if (threadIdx.x == 0) { st0[0] = 0u; st0[1] = 0u; }
    __syncthreads();
  }
  const int xcd = bid & 7, xloc = bid >> 3, xnl = nblk >> 3;
  XcdBarrier xb = xcd_barrier_post(barw, (volatile LAS unsigned*)(smem + SM_MISC + 4080));
  for (int it = bid; it < NTOK / 8; it += nblk) { ph_cvt_x(2 * it, xin, XBF); ph_cvt_x(2 * it + 1, xin, XBF); }
  for (int it = bid; it < 16 * 46 + 16 * 16 + 16 * 4; it += nblk) {
    if (it < 16 * 46) ph_cvt_wt(smem, it % 16, it / 16, w_in, DM, INC, WTIN);
    else if (it < 16 * 46 + 256) { const int j = it - 16 * 46; ph_cvt_wt(smem, j % 16, j / 16, w_out, DM, DM, WTOUT); }
    else { const int j = it - 16 * 46 - 256; ph_cvt_wt(smem, j % 16, j / 16, router_w, DM, NEXP, WTR); }
  }
  xcd_barrier(xb);
  for (int l = xloc; l < 64; l += xnl) ph_proj(smem, xcd, l, XBF, WTIN, proj, ba, VTb);
  xcd_barrier(xb);
  for (int it = bid; it < 2048; it += nblk) ph_dnchunk(smem, it, proj, ba, conv_w, a_log, dt_bias, QD, W0N, KTT, RV, TM, ATT, GL);
  for (int it = bid; it < 512; it += nblk) ph_swa(smem, it, proj, VTb, sinks, mixed);
  xcd_barrier(xb);
  {
    const bool is512 = (nblk == 512);
    const bool scan_blk = is512 ? (bid < 256 && (bid & 7) < 2) : ((bid < 64) || (nblk <= 64));
    const bool swa_blk = is512 && bid >= 256 && (bid & 7) < 2;
    if (scan_blk) {
      if (is512) ph_dnscan(smem, (bid & 1) * 32 + (bid >> 3), QD, W0N, KTT, RV, TM, ATT, GL, obuf);
      else for (int it = bid; it < 64; it += nblk) ph_dnscan(smem, it, QD, W0N, KTT, RV, TM, ATT, GL, obuf);
    }
    if (swa_blk) { }
    else {
      const int tid = TIDX, lane = tid & 63, wv = tid >> 6;
      float* tile = (float*)(smem + wv * 16896);
      const int total = 257 * 192;
      const int T1 = is512 ? (total - 64 * 4 * 12) : ((nblk > 64) ? total : 0);
      int it, step, end;
      if (is512 && scan_blk) { const int sb = (bid & 1) * 32 + (bid >> 3); it = T1 + sb * 4 + wv; step = 64 * 4; end = total; }
      else if (is512) { const int cb = (bid >> 3) * 6 + (bid & 7) - 2; it = cb * 4 + wv; step = 384 * 4; end = T1; }
      else if (nblk > 64) { if (bid < 64) { it = 0; step = 1; end = 0; } else { it = (bid - 64) * 4 + wv; step = (nblk - 64) * 4; end = total; } }
      else { it = bid * 4 + wv; step = nblk * 4; end = total; }
      f32x4 vc[16], vn[16];
      CvtTile tc = cvt_decode(it < end ? it : 0, lane, w_gate, w_up, w_down, sw_gate, sw_up, sw_down, P.ws);
      if (it < end) cvt_load(tc, vc);
      while (it < end) {
        const int itn = it + step;
        CvtTile tn = cvt_decode(itn < end ? itn : 0, lane, w_gate, w_up, w_down, sw_gate, sw_up, sw_down, P.ws);
        if (itn < end) cvt_load(tn, vn);
        cvt_store(tile, lane, tc, vc);
#pragma unroll
        for (int i = 0; i < 16; ++i) vc[i] = vn[i];
        tc = tn; it = itn;
      }
    }
  }
  xcd_barrier(xb);
  for (int it = bid; it < NTOK / 4; it += nblk) ph_dn_post(it, obuf, proj, dn_norm_g, mixed);
  xcd_barrier(xb);
  for (int l = xloc; l < 64; l += xnl) ph_wout(smem, xcd, l, mixed, WTOUT, MIXO);
  xcd_barrier(xb);
  for (int it = bid; it < NTOK / 4; it += nblk) ph_ln1(it, xin, MIXO, ln1_g, ln1_b, x1bf, (unsigned char*)(P.ws + WS_X1F8));
  xcd_barrier(xb);
  for (int i = xloc; i < 32 * 2; i += xnl) ph_router(smem, (xcd * 32 + i / 2) * 2 + i % 2, x1bf, WTR, logits);
  xcd_barrier(xb);
  for (int it = bid; it < NTOK / 4; it += nblk) ph_route(it, logits, router_bias, cnt, list, gates);
  xcd_barrier(xb);
  int* sscan = (int*)(smem + SM_MISC);
  moe_build_prefix(cnt, sscan);
  const int ntile = sscan[32 * xcd + 31] - (xcd ? sscan[32 * xcd - 1] : 0) + NTOK / 128 / 8;
  for (int it = xloc; it < ntile; it += xnl) {
    int e, rt; moe_locate(sscan, xcd, it, e, rt);
    ph_moe(smem, e, rt, (const unsigned char*)(P.ws + WS_X1F8), x1bf, cnt, list, gates,
           (const unsigned char*)P.ws + ((e < 256) ? WS_WTG8 + (size_t)e * EFF * DM : WS_WTSG8), (const unsigned char*)P.ws + ((e < 256) ? WS_WTU8 + (size_t)e * EFF * DM : WS_WTSU8),
           (const unsigned char*)P.ws + ((e < 256) ? WS_WTD8 + (size_t)e * DM * EFF : WS_WTSD8), ybuf, outp, (unsigned char*)(P.ws + WS_DUMMY));
  }
  xcd_barrier(xb);
  for (int it = bid; it < NTOK / 4; it += nblk) ph_final(it, outp, ybuf, ln2_g, ln2_b);
}

#undef xin
#undef w_in
#undef conv_w
#undef a_log
#undef dt_bias
#undef dn_norm_g
#undef sinks
#undef w_out
#undef ln1_g
#undef ln1_b
#undef router_w
#undef router_bias
#undef w_gate
#undef w_up
#undef w_down
#undef sw_gate
#undef sw_up
#undef sw_down
#undef ln2_g
#undef ln2_b
#undef outp
#undef x1bf
#undef logits
#undef list
#undef gates
#undef cnt
#undef mixed
#undef proj
#undef ba
#undef QD
#undef W0N
#undef KTT
#undef RV
#undef TM
#undef ATT
#undef GL
#undef obuf
#undef ybuf
#undef VTb
#undef MIXO
#undef XBF
#undef WTIN
#undef WTOUT
#undef WTR
#undef barw

extern "C" void kernel_launch(void* const* d_in, const int* in_sizes, int n_in, void* d_out, int out_size, void* d_ws, size_t ws_size, hipStream_t stream) {
  static int grid_blocks = 0;
  if (!grid_blocks) {
    int dev = 0, cus = 0, per_cu = 0;
    (void)hipGetDevice(&dev);
    (void)hipDeviceGetAttribute(&cus, hipDeviceAttributeMultiprocessorCount, dev);
    (void)hipOccupancyMaxActiveBlocksPerMultiprocessor(&per_cu, mega, 256, 0);
    if (per_cu > 2) per_cu = 2;
    if (per_cu < 1) per_cu = 1;
    grid_blocks = cus * per_cu;
  }
  Params p{};
  for (int i = 0; i < 20; ++i) p.in[i] = (const float*)d_in[i];
  p.out = (float*)d_out; p.ws = (char*)d_ws;
  (void)hipMemsetAsync((char*)d_ws + WS_CTRL, 0, CNT16_OFF + NSH * NEXP * 4, stream);
  void* args[] = {&p};
  hipError_t e = hipLaunchCooperativeKernel((void*)mega, dim3(grid_blocks), dim3(256), args, 0, stream);
  if (e != hipSuccess) fprintf(stderr, "cooperative launch failed: %s (grid %d)\n", hipGetErrorString(e), grid_blocks);
}
```

```cpp
#include <hip/hip_runtime.h>
#include <hip/hip_cooperative_groups.h>
#include <stdint.h>
#include <stdio.h>
namespace cg = cooperative_groups;

typedef __attribute__((ext_vector_type(8))) short bf16x8;
typedef __attribute__((ext_vector_type(4))) float f32x4;
typedef unsigned short bf16_t;
typedef __attribute__((ext_vector_type(4))) unsigned u32x4;
typedef __attribute__((ext_vector_type(2))) unsigned u32x2;

constexpr int NTOK = 32768, SEQ = 4096, DM = 1024;
constexpr int INC = 2824, PROJW = 2816;
constexpr int OFF_DQ = 0, OFF_DK = 512, OFF_DV = 1024, OFF_SQ = 1536, OFF_SK = 2048, OFF_SV = 2176, OFF_Z = 2304;
constexpr int NEXP = 256, TOPK = 8, EFF = 256;
constexpr int NA = NTOK * TOPK;
constexpr int NSH = 16, CAPS = NTOK / NSH;
constexpr int CNT16_OFF = 32768;
constexpr float ALPHA = 1.189207115002721f;
constexpr float LN_EPS = 1e-5f, RMS_EPS = 1e-6f, L2_EPS = 1e-6f;
constexpr float SC_WG = 32.f, SC_WU = 64.f, SC_WD = 32.f, SC_H = 8.f, SC_Y = 32.f;

constexpr size_t MiB = 1024ull * 1024ull;
constexpr size_t WS_WTD8 = 0;
constexpr size_t WS_WTG8 = 64 * MiB;
constexpr size_t WS_WTU8 = 128 * MiB;
constexpr size_t WS_WTSG8 = 192 * MiB;
constexpr size_t WS_WTSU8 = WS_WTSG8 + 256 * 1024;
constexpr size_t WS_WTSD8 = WS_WTSG8 + 512 * 1024;
constexpr size_t WS_X1F8 = 200 * MiB;
constexpr size_t WS_YBUF = 384 * MiB;
constexpr size_t WS_LOGIT = 384 * MiB;
constexpr size_t WS_X1BF = 896 * MiB;
constexpr size_t WS_LIST = 960 * MiB;
constexpr size_t WS_GATES = 992 * MiB;
constexpr size_t WS_CTRL = 993 * MiB;
constexpr size_t WS_WTIN = 994 * MiB;
constexpr size_t WS_WTOUT = 1000 * MiB;
constexpr size_t WS_WTR = 1002 * MiB;
constexpr size_t WS_DUMMY = 1005 * MiB;
constexpr size_t WS_PROJ = 384 * MiB;
constexpr size_t WS_BA = 560 * MiB;
constexpr size_t WS_QD = 561 * MiB;
constexpr size_t WS_W0N = 593 * MiB;
constexpr size_t WS_KTT = 625 * MiB;
constexpr size_t WS_RV = 657 * MiB;
constexpr size_t WS_TM = 689 * MiB;
constexpr size_t WS_ATT = 705 * MiB;
constexpr size_t WS_GL = 721 * MiB;
constexpr size_t WS_O = 722 * MiB;
constexpr size_t WS_VT = 786 * MiB;
constexpr size_t WS_MIXED = 794 * MiB;
constexpr size_t WS_XBF = 640 * MiB;

__device__ __forceinline__ int opaque_tid() { int t = threadIdx.x; asm volatile("" : "+v"(t)); return t; }
#define TIDX opaque_tid()
typedef __attribute__((ext_vector_type(2))) __bf16 hwbf16x2;
typedef __attribute__((ext_vector_type(2))) float hwf32x2;
__device__ __forceinline__ unsigned pack2(float lo, float hi) {
  hwf32x2 f = {lo, hi};
  return __builtin_bit_cast(unsigned, __builtin_convertvector(f, hwbf16x2));
}
__device__ __forceinline__ unsigned f2bf(float f) { return pack2(f, 0.f) & 0xffffu; }
__device__ __forceinline__ float bf2f(unsigned h) { return __uint_as_float(h << 16); }
__device__ __forceinline__ float bflo(unsigned w) { return __uint_as_float(w << 16); }
__device__ __forceinline__ float bfhi(unsigned w) { return __uint_as_float(w & 0xffff0000u); }
__device__ __forceinline__ float siluf(float x) { return x * __builtin_amdgcn_rcpf(1.f + __expf(-x)); }
__device__ __forceinline__ float sigmoidf(float x) { return __builtin_amdgcn_rcpf(1.f + __expf(-x)); }
#define DPP_ADD_(v, ctrl, rmask) v += __builtin_bit_cast(float, __builtin_amdgcn_update_dpp(0, __builtin_bit_cast(int, v), ctrl, rmask, 0xf, false))
__device__ __forceinline__ float wave_sum(float v) {
  DPP_ADD_(v, 0xB1, 0xf);
  DPP_ADD_(v, 0x4E, 0xf);
  DPP_ADD_(v, 0x141, 0xf);
  DPP_ADD_(v, 0x140, 0xf);
  DPP_ADD_(v, 0x142, 0xa);
  DPP_ADD_(v, 0x143, 0xc);
  return __builtin_bit_cast(float, __builtin_amdgcn_readlane(__builtin_bit_cast(int, v), 63));
}

template <int SEGDIV>
struct LdRowBF16T {
  const char* p[4]; size_t seghi, seglo; int tid16;
  template <class F> __device__ __forceinline__ void init(F rowptr, size_t hi, size_t lo = 0) {
    const int tid = TIDX; const int slot = tid & 7, row0 = tid >> 3; seghi = hi; seglo = lo; tid16 = tid * 16;
#pragma unroll
    for (int i = 0; i < 4; ++i) p[i] = (const char*)rowptr(row0 + i * 32) + ((slot ^ (row0 & 7)) << 4);
  }
  __device__ __forceinline__ void issue(int seg, int kk, unsigned char* lds) {
    const size_t off = (size_t)(seg / SEGDIV) * seghi + (size_t)(seg % SEGDIV) * seglo + (size_t)kk * 128;
#pragma unroll
    for (int i = 0; i < 4; ++i)
      __builtin_amdgcn_global_load_lds((const unsigned*)(p[i] + off), (__attribute__((address_space(3))) unsigned*)(lds + tid16 + i * 4096), 16, 0, 0);
  }
};
typedef LdRowBF16T<1> LdRowBF16;
__device__ __forceinline__ void gemm_kstep(const unsigned char* sA, const unsigned char* sB, f32x4 (&acc)[4][4], int wr, int wc, int fr, int fq) {
#pragma unroll
  for (int ks = 0; ks < 2; ++ks) {
    bf16x8 a[4], b[4];
#pragma unroll
    for (int m = 0; m < 4; ++m) {
      const int row = wr * 64 + m * 16 + fr;
      a[m] = *(const bf16x8*)(sA + row * 128 + (((ks * 4 + fq) ^ (row & 7)) << 4));
    }
#pragma unroll
    for (int n = 0; n < 4; ++n) {
      const int row = wc * 64 + n * 16 + fr;
      b[n] = *(const bf16x8*)(sB + row * 128 + (((ks * 4 + fq) ^ (row & 7)) << 4));
    }
    __builtin_amdgcn_s_setprio(1);
#pragma unroll
    for (int m = 0; m < 4; ++m)
#pragma unroll
      for (int n = 0; n < 4; ++n) acc[m][n] = __builtin_amdgcn_mfma_f32_16x16x32_bf16(b[n], a[m], acc[m][n], 0, 0, 0);
    __builtin_amdgcn_s_setprio(0);
  }
}
template <int KPER, class AL, class BL, class Epi>
__device__ __forceinline__ void gemm_stream(unsigned char* smem, AL& al, BL& bl, int nseg, Epi epi) {
  const int tid = TIDX, lane = tid & 63, wid = tid >> 6, wr = wid >> 1, wc = wid & 1, fr = lane & 15, fq = lane >> 4;
  const int total = nseg * KPER;
  f32x4 acc[4][4];
  al.issue(0, 0, smem); bl.issue(0, 0, smem + 16384);
  asm volatile("s_waitcnt vmcnt(0)" ::: "memory");
  __syncthreads();
  for (int j = 0; j < total; ++j) {
    unsigned char* cur = smem + (j & 1) * 32768; unsigned char* nxt = smem + ((j & 1) ^ 1) * 32768;
    if (j + 1 < total) { al.issue((j + 1) / KPER, (j + 1) % KPER, nxt); bl.issue((j + 1) / KPER, (j + 1) % KPER, nxt + 16384); }
    if (j % KPER == 0) {
#pragma unroll
      for (int m = 0; m < 4; ++m)
#pragma unroll
        for (int n = 0; n < 4; ++n) acc[m][n] = (f32x4){0.f, 0.f, 0.f, 0.f};
    }
    gemm_kstep(cur, cur + 16384, acc, wr, wc, fr, fq);
    asm volatile("s_waitcnt vmcnt(0)" ::: "memory");
    __syncthreads();
    if ((j + 1) % KPER == 0) epi((j + 1) / KPER - 1, acc, cur);
  }
}

template <class RowDst>
__device__ __forceinline__ void store_tile_bf16(unsigned char* fbuf, const f32x4 (&acc)[4][4], RowDst rowdst) {
  const int tid = TIDX, lane = tid & 63, wid = tid >> 6, wr = wid >> 1, wc = wid & 1, fr = lane & 15, fq = lane >> 4;
#pragma unroll
  for (int m = 0; m < 4; ++m) {
    const int row = wr * 64 + m * 16 + fr;
#pragma unroll
    for (int n = 0; n < 4; ++n) {
      const int col = wc * 64 + n * 16 + fq * 4;
      u32x2 w; w[0] = pack2(acc[m][n][0], acc[m][n][1]); w[1] = pack2(acc[m][n][2], acc[m][n][3]);
      *(u32x2*)(fbuf + row * 256 + (((col >> 3) ^ (row & 15)) << 4) + ((col >> 2) & 1) * 8) = w;
    }
  }
  __syncthreads();
#pragma unroll
  for (int i = 0; i < 8; ++i) {
    const int q = tid + 256 * i, row = q >> 4, ch = q & 15;
    *(u32x4*)(rowdst(row) + ch * 8) = *(const u32x4*)(fbuf + row * 256 + ((ch ^ (row & 15)) << 4));
  }
  __syncthreads();
}

template <class RowDst>
__device__ __forceinline__ void store_tile_bf16_T(unsigned char* fbuf, const f32x4 (&acc)[4][4], RowDst rowdst) {
  const int tid = TIDX, lane = tid & 63, wid = tid >> 6, wr = wid >> 1, wc = wid & 1, fr = lane & 15, fq = lane >> 4;
#pragma unroll
  for (int m = 0; m < 4; ++m) {
    const int t = wr * 64 + m * 16 + fr;
#pragma unroll
    for (int n = 0; n < 4; ++n)
#pragma unroll
      for (int r = 0; r < 4; ++r) {
        const int c = wc * 64 + n * 16 + fq * 4 + r;
        *(unsigned short*)(fbuf + c * 256 + ((((t >> 3) ^ (c & 15))) << 4) + (t & 7) * 2) = (unsigned short)f2bf(acc[m][n][r]);
      }
  }
  __syncthreads();
#pragma unroll
  for (int i = 0; i < 8; ++i) {
    const int q = tid + 256 * i, row = q >> 4, ch = q & 15;
    *(u32x4*)(rowdst(row) + ch * 8) = *(const u32x4*)(fbuf + row * 256 + ((ch ^ (row & 15)) << 4));
  }
  __syncthreads();
}

#define GEMM_IDS const int tid = TIDX, lane = tid & 63, wid = tid >> 6, wr = wid >> 1, wc = wid & 1, fr = lane & 15, fq = lane >> 4; (void)tid; (void)lane;

struct Params {
  const float* in[20];
  float* out;
  char* ws;
};

constexpr int SMEM_BYTES = 69632;
constexpr int SM_MISC = 65536;

__device__ __forceinline__ void ph_cvt_x(int item, const float* __restrict__ x, bf16_t* __restrict__ xbf) {
  const int tid = TIDX;
  const size_t base = (size_t)item * 4096 + (size_t)tid * 4;
#pragma unroll
  for (int i = 0; i < 4; ++i) {
    const f32x4 v = *(const f32x4*)(x + base + (size_t)i * 1024);
    u32x2 w; w[0] = pack2(v[0], v[1]); w[1] = pack2(v[2], v[3]);
    *(u32x2*)(xbf + base + (size_t)i * 1024) = w;
  }
}
__device__ __forceinline__ void ph_cvt_wt(unsigned char* smem, int kt, int nt, const float* __restrict__ W, int K, int N, bf16_t* __restrict__ WT, bool perm = false) {
  float* tile = (float*)smem;
  const int tid = TIDX;
  const int k0 = kt * 64, n0 = nt * 64;
  __syncthreads();
#pragma unroll
  for (int i = 0; i < 4; ++i) {
    const int k = (tid >> 4) + 16 * i, n = 4 * (tid & 15);
    f32x4 v = (f32x4){0.f, 0.f, 0.f, 0.f};
    if (n0 + n < N) v = *(const f32x4*)(W + (size_t)(k0 + k) * N + n0 + n);
    tile[k * 65 + n + 0] = v[0]; tile[k * 65 + n + 1] = v[1]; tile[k * 65 + n + 2] = v[2]; tile[k * 65 + n + 3] = v[3];
  }
  __syncthreads();
  const int n = tid >> 2, kq = tid & 3;
  u32x4 w0, w1;
#pragma unroll
  for (int j = 0; j < 4; ++j) {
    w0[j] = pack2(tile[(kq * 16 + 2 * j) * 65 + n], tile[(kq * 16 + 2 * j + 1) * 65 + n]);
    w1[j] = pack2(tile[(kq * 16 + 8 + 2 * j) * 65 + n], tile[(kq * 16 + 8 + 2 * j + 1) * 65 + n]);
  }
  if (!perm) {
    bf16_t* dst = WT + (size_t)(n0 + n) * K + k0 + kq * 16;
    *(u32x4*)dst = w0; *(u32x4*)(dst + 8) = w1;
  } else {
    const int blk = kq >> 1, hi = kq & 1;
    bf16_t* dst = WT + (size_t)(n0 + n) * K + k0 + blk * 32 + 4 * hi;
    u32x2 a; a[0] = w0[0]; a[1] = w0[1]; *(u32x2*)(dst + 0) = a;
    a[0] = w0[2]; a[1] = w0[3]; *(u32x2*)(dst + 8) = a;
    a[0] = w1[0]; a[1] = w1[1]; *(u32x2*)(dst + 16) = a;
    a[0] = w1[2]; a[1] = w1[3]; *(u32x2*)(dst + 24) = a;
  }
}

struct CvtTile { const float* src; unsigned char* dst; int ldn; int K; int perm; float scale; };
__device__ __forceinline__ CvtTile cvt_decode(int it, int lane, const float* __restrict__ w_gate, const float* __restrict__ w_up, const float* __restrict__ w_down,
                                              const float* __restrict__ sw_gate, const float* __restrict__ sw_up, const float* __restrict__ sw_down, char* ws) {
  const int e = it / 192, j = it % 192;
  const float* W; unsigned char* WT; int K, N, kt, nt; float sc;
  if (j < 64) { W = (e < 256) ? w_gate + (size_t)e * DM * EFF : sw_gate; WT = (unsigned char*)ws + ((e < 256) ? WS_WTG8 + (size_t)e * EFF * DM : WS_WTSG8); K = DM; N = EFF; nt = j & 7; kt = j >> 3; sc = SC_WG; }
  else if (j < 128) { W = (e < 256) ? w_up + (size_t)e * DM * EFF : sw_up; WT = (unsigned char*)ws + ((e < 256) ? WS_WTU8 + (size_t)e * EFF * DM : WS_WTSU8); K = DM; N = EFF; nt = (j - 64) & 7; kt = (j - 64) >> 3; sc = SC_WU; }
  else { W = (e < 256) ? w_down + (size_t)e * EFF * DM : sw_down; WT = (unsigned char*)ws + ((e < 256) ? WS_WTD8 + (size_t)e * DM * EFF : WS_WTSD8); K = EFF; N = DM; nt = (j - 128) & 31; kt = (j - 128) >> 5; sc = SC_WD; }
  CvtTile t;
  t.src = W + (size_t)(kt * 128 + (lane >> 3)) * N + nt * 32 + 4 * (lane & 7);
  t.dst = WT + (size_t)(nt * 32) * K + kt * 128;
  t.ldn = 8 * N; t.K = K; t.scale = sc;
  t.perm = (j >= 128) ? 1 : 0;
  return t;
}
__device__ __forceinline__ void cvt_load(const CvtTile& t, f32x4 (&v)[16]) {
#pragma unroll
  for (int i = 0; i < 16; ++i) v[i] = *(const f32x4*)(t.src + (size_t)i * t.ldn);
}
__device__ __forceinline__ void cvt_store(float* tile  , int lane, const CvtTile& t, const f32x4 (&v)[16]) {
#pragma unroll
  for (int i = 0; i < 16; ++i) {
    float* p = tile + ((lane >> 3) + 8 * i) * 33 + 4 * (lane & 7);
    p[0] = v[i][0]; p[1] = v[i][1]; p[2] = v[i][2]; p[3] = v[i][3];
  }
  const int c = lane & 7;
  int kk[16];
#pragma unroll
  for (int tt = 0; tt < 16; ++tt)
    kk[tt] = t.perm ? (64 * (c >> 2) + 16 * (tt >> 2) + 4 * (c & 3) + (tt & 3)) : (16 * c + tt);
  const float sc = t.scale;
#pragma unroll
  for (int i = 0; i < 4; ++i) {
    const int n = (lane >> 3) + 8 * i;
    u32x4 w;
#pragma unroll
    for (int d = 0; d < 4; ++d) {
      int pk = 0;
      pk = __builtin_amdgcn_cvt_pk_fp8_f32(tile[kk[4 * d + 0] * 33 + n] * sc, tile[kk[4 * d + 1] * 33 + n] * sc, pk, false);
      pk = __builtin_amdgcn_cvt_pk_fp8_f32(tile[kk[4 * d + 2] * 33 + n] * sc, tile[kk[4 * d + 3] * 33 + n] * sc, pk, true);
      w[d] = (unsigned)pk;
    }
    *(u32x4*)(t.dst + (size_t)n * t.K + 16 * c) = w;
  }
}

__device__ __forceinline__ void ph_proj(unsigned char* smem, int xcd, int l, const bf16_t* __restrict__ xbf, const bf16_t* __restrict__ wt, bf16_t* __restrict__ proj, float* __restrict__ ba, bf16_t* __restrict__ vt) {
  const int mi = l >> 3, ni = l & 7;
  LdRowBF16T<3> al; al.init([&](int r) { return xbf + (size_t)((xcd * 32 + mi) * 128 + r) * DM; }, (size_t)8 * 128 * DM * 2, 0);
  LdRowBF16T<3> bl; bl.init([&](int r) { return wt + (size_t)(ni * 128 + r) * DM; }, 0, (size_t)8 * 128 * DM * 2);
  gemm_stream<16>(smem, al, bl, 12, [&](int seg, f32x4 (&acc)[4][4], unsigned char* fbuf) {
    GEMM_IDS
    const int nt = (seg % 3) * 8 + ni;
    if (nt < 23) {
      const int m0 = (xcd * 32 + (seg / 3) * 8 + mi) * 128, n0 = nt * 128;
      if (n0 + 128 <= PROJW) store_tile_bf16(fbuf, acc, [&](int r) { return proj + (size_t)(m0 + r) * PROJW + n0; });
      else
#pragma unroll
      for (int m = 0; m < 4; ++m)
#pragma unroll
        for (int n = 0; n < 4; ++n) {
          const int row = m0 + wr * 64 + m * 16 + fr, col = n0 + wc * 64 + n * 16 + fq * 4;
          if (col < PROJW) {
            u32x2 w; w[0] = pack2(acc[m][n][0], acc[m][n][1]); w[1] = pack2(acc[m][n][2], acc[m][n][3]);
            *(u32x2*)(proj + (size_t)row * PROJW + col) = w;
          } else if (col < INC) {
            *(f32x4*)(ba + (size_t)row * 8 + (col - PROJW)) = acc[m][n];
          }
        }
      if (n0 == OFF_SV) {
        const int bb = m0 / SEQ, t0_ = m0 % SEQ;
        store_tile_bf16_T(fbuf, acc, [&](int c) { return vt + ((size_t)(bb * 128 + c)) * SEQ + t0_; });
      }
    }
  });
}

__device__ __forceinline__ bf16x8 pack8(f32x4 a, f32x4 b) {
  union { bf16x8 v; unsigned u[4]; } x;
  x.u[0] = pack2(a[0], a[1]); x.u[1] = pack2(a[2], a[3]); x.u[2] = pack2(b[0], b[1]); x.u[3] = pack2(b[2], b[3]);
  return x.v;
}
__device__ __forceinline__ void ph_dnchunk(unsigned char* smem, int item, const bf16_t* __restrict__ proj, const float* __restrict__ ba, const float* __restrict__ conv_w,
                                           const float* __restrict__ a_log, const float* __restrict__ dt_bias,
                                           bf16_t* __restrict__ QD, bf16_t* __restrict__ W0N, bf16_t* __restrict__ KTT, bf16_t* __restrict__ RV,
                                           bf16_t* __restrict__ TM, bf16_t* __restrict__ ATT, float* __restrict__ GL) {
  const int tid = TIDX, lane = tid & 63, w = tid >> 6, fr = lane & 15, fq = lane >> 4;
  const int n = item & 63, h = (item >> 6) & 3, b = item >> 8;
  const int t0 = n * 64; const size_t row0 = (size_t)b * SEQ + t0;
  unsigned char* qs = smem; unsigned char* ks = smem + 16384; float* AT = (float*)(smem + 32768);
  const float scale = 0.08838834764831845f;
  float bL, gcL;
  {
    const float* bap = ba + (row0 + lane) * 8;
    bL = sigmoidf(bap[h]);
    const float xx = bap[4 + h] + dt_bias[h];
    const float sp = fmaxf(xx, 0.f) + log1pf(__expf(-fabsf(xx)));
    float gg = -__expf(a_log[h]) * sp;
#pragma unroll
    for (int o = 1; o < 64; o <<= 1) { const float v = __shfl_up(gg, o); if (lane >= o) gg += v; }
    gcL = gg;
  }
  {
    const int d = 2 * lane;
    float cw[3][4][2];
#pragma unroll
    for (int mx = 0; mx < 3; ++mx)
#pragma unroll
      for (int j = 0; j < 4; ++j) {
        const float2 c2 = *(const float2*)(conv_w + j * 1536 + mx * 512 + h * 128 + d);
        cw[mx][j][0] = c2.x; cw[mx][j][1] = c2.y;
      }
    const bf16_t* pbase = proj + (row0 + 16 * w) * PROJW + h * 128 + d;
    unsigned raw[3][19];
#pragma unroll
    for (int j = 0; j < 19; ++j) {
      const bool ok = (t0 + 16 * w - 3 + j) >= 0;
#pragma unroll
      for (int mx = 0; mx < 3; ++mx) {
        unsigned u = 0;
        if (ok) u = *(const unsigned*)(pbase + (ptrdiff_t)(j - 3) * PROJW + mx * 512);
        raw[mx][j] = u;
      }
    }
#pragma unroll
    for (int i = 0; i < 16; ++i) {
      float s[3][2];
#pragma unroll
      for (int mx = 0; mx < 3; ++mx) {
        float y0 = 0.f, y1 = 0.f;
#pragma unroll
        for (int j = 0; j < 4; ++j) { y0 += cw[mx][j][0] * bflo(raw[mx][i + j]); y1 += cw[mx][j][1] * bfhi(raw[mx][i + j]); }
        s[mx][0] = siluf(y0); s[mx][1] = siluf(y1);
      }
      const int row = 16 * w + i;
      const float rq = rsqrtf(wave_sum(s[0][0] * s[0][0] + s[0][1] * s[0][1]) + L2_EPS);
      const float rk = rsqrtf(wave_sum(s[1][0] * s[1][0] + s[1][1] * s[1][1]) + L2_EPS);
      const int off = row * 256 + ((((lane >> 2) ^ (row & 15))) << 4) + (lane & 3) * 4;
      *(unsigned*)(qs + off) = pack2(s[0][0] * rq, s[0][1] * rq);
      *(unsigned*)(ks + off) = pack2(s[1][0] * rk, s[1][1] * rk);
      const float bi = __shfl(bL, row);
      *(unsigned*)(RV + ((size_t)item * 64 + row) * 128 + d) = pack2(bi * s[2][0], bi * s[2][1]);
    }
  }
  __syncthreads();
  {
    f32x4 aKK[4], aQK[4];
#pragma unroll
    for (int nt = 0; nt < 4; ++nt) { aKK[nt] = (f32x4){0.f, 0.f, 0.f, 0.f}; aQK[nt] = (f32x4){0.f, 0.f, 0.f, 0.f}; }
#pragma unroll
    for (int k4 = 0; k4 < 4; ++k4) {
      const int arow = 16 * w + fr;
      const bf16x8 aq = *(const bf16x8*)(qs + arow * 256 + ((((k4 * 4 + fq) ^ (arow & 15))) << 4));
      const bf16x8 ak = *(const bf16x8*)(ks + arow * 256 + ((((k4 * 4 + fq) ^ (arow & 15))) << 4));
#pragma unroll
      for (int nt = 0; nt < 4; ++nt) {
        const int brow = 16 * nt + fr;
        const bf16x8 bk = *(const bf16x8*)(ks + brow * 256 + ((((k4 * 4 + fq) ^ (brow & 15))) << 4));
        aKK[nt] = __builtin_amdgcn_mfma_f32_16x16x32_bf16(ak, bk, aKK[nt], 0, 0, 0);
        aQK[nt] = __builtin_amdgcn_mfma_f32_16x16x32_bf16(bk, aq, aQK[nt], 0, 0, 0);
      }
    }
    float gci[4], bi[4];
#pragma unroll
    for (int r = 0; r < 4; ++r) { gci[r] = __shfl(gcL, 16 * w + 4 * fq + r); bi[r] = __shfl(bL, 16 * w + 4 * fq + r); }
    const float gci2 = __shfl(gcL, 16 * w + fr);
#pragma unroll
    for (int nt = 0; nt < 4; ++nt) {
      const int j = 16 * nt + fr;
      const float gcj = __shfl(gcL, j);
      float av[4], at[4];
#pragma unroll
      for (int r = 0; r < 4; ++r) {
        const int i = 16 * w + 4 * fq + r;
        const float dec = (j <= i) ? __expf(gci[r] - gcj) : 0.f;
        av[r] = (j < i) ? bi[r] * aKK[nt][r] * dec : 0.f;
        const int i2 = 16 * w + fr, j2 = 16 * nt + 4 * fq + r;
        const float gcj2 = __shfl(gcL, j2);
        const float dec2 = (j2 <= i2) ? __expf(gci2 - gcj2) : 0.f;
        at[r] = aQK[nt][r] * scale * dec2;
      }
      *(float4*)(AT + j * 68 + 16 * w + 4 * fq) = make_float4(av[0], av[1], av[2], av[3]);
      u32x2 wv; wv[0] = pack2(at[0], at[1]); wv[1] = pack2(at[2], at[3]);
      *(u32x2*)(ATT + ((size_t)item * 64 + 16 * w + fr) * 64 + 32 * (nt >> 1) + 8 * fq + 4 * (nt & 1)) = wv;
    }
  }
  __syncthreads();
  if (w == 0) {
    float Tr[64];
    int ln = lane; asm volatile("" : "+v"(ln));
#pragma unroll
    for (int j = 0; j < 64; ++j) Tr[j] = 0.f;
    f32x4 cur[16], nxt[16];
#pragma unroll
    for (int j4 = 0; j4 < 16; ++j4) nxt[j4] = (f32x4){0.f, 0.f, 0.f, 0.f};
#pragma unroll
    for (int j4 = 15; j4 >= 16; --j4) cur[j4] = *(const f32x4*)(AT + 63 * 68 + j4 * 4);
#pragma unroll
    for (int c = 63; c >= 0; --c) {
      if (c > 0) {
#pragma unroll
        for (int j4 = 15; j4 >= c / 4; --j4) nxt[j4] = *(const f32x4*)(AT + (c - 1) * 68 + j4 * 4);
      }
      float a0 = 0.f, a1 = 0.f, a2 = 0.f, a3 = 0.f;
#pragma unroll
      for (int j4 = 15; j4 >= (c + 1) / 4; --j4) {
        asm volatile("v_fmac_f32 %0, %1, %2" : "+v"(a0) : "v"(Tr[4 * j4 + 0]), "v"(cur[j4][0]));
        asm volatile("v_fmac_f32 %0, %1, %2" : "+v"(a1) : "v"(Tr[4 * j4 + 1]), "v"(cur[j4][1]));
        asm volatile("v_fmac_f32 %0, %1, %2" : "+v"(a2) : "v"(Tr[4 * j4 + 2]), "v"(cur[j4][2]));
        asm volatile("v_fmac_f32 %0, %1, %2" : "+v"(a3) : "v"(Tr[4 * j4 + 3]), "v"(cur[j4][3]));
      }
      Tr[c] = ((ln == c) ? 1.f : 0.f) - ((a0 + a1) + (a2 + a3));
#pragma unroll
      for (int j4 = 0; j4 < 16; ++j4) cur[j4] = nxt[j4];
    }
    u32x4* tp = (u32x4*)(TM + ((size_t)item * 64 + lane) * 64);
#pragma unroll
    for (int oc = 0; oc < 8; ++oc) {
      const int k0 = 32 * (oc >> 2) + 4 * (oc & 3);
      u32x4 v;
      v[0] = pack2(Tr[k0 + 0], Tr[k0 + 1]); v[1] = pack2(Tr[k0 + 2], Tr[k0 + 3]);
      v[2] = pack2(Tr[k0 + 16], Tr[k0 + 17]); v[3] = pack2(Tr[k0 + 18], Tr[k0 + 19]);
      tp[oc] = v;
    }
  } else {
    const float gclast = __shfl(gcL, 63);
    if (tid == 64) GL[item] = __expf(gclast);
#pragma unroll 1
    for (int it = 0; it < 16; ++it) {
      const int idx = (tid - 64) + it * 192;
      const int mtx = idx >> 10, rem = idx & 1023;
      if (mtx < 2) {
        const int i = rem >> 4, oc = rem & 15;
        const float gi = __shfl(gcL, i), bi = __shfl(bL, i);
        const float f = (mtx == 0) ? scale * __expf(gi) : -bi * __expf(gi);
        const unsigned char* st = (mtx == 0) ? qs : ks;
        const int d0 = 32 * (oc >> 2) + 4 * (oc & 3);
        const uint2 lo = *(const uint2*)(st + i * 256 + ((((d0 >> 3) ^ (i & 15))) << 4) + (d0 & 7) * 2);
        const uint2 hi = *(const uint2*)(st + i * 256 + (((((d0 + 16) >> 3) ^ (i & 15))) << 4) + (d0 & 7) * 2);
        u32x4 v;
        v[0] = pack2(bflo(lo.x) * f, bfhi(lo.x) * f); v[1] = pack2(bflo(lo.y) * f, bfhi(lo.y) * f);
        v[2] = pack2(bflo(hi.x) * f, bfhi(hi.x) * f); v[3] = pack2(bflo(hi.y) * f, bfhi(hi.y) * f);
        bf16_t* dst = ((mtx == 0) ? QD : W0N) + ((size_t)item * 64 + i) * 128 + 8 * oc;
        *(u32x4*)dst = v;
      } else {
        const int d = rem & 127, oc = rem >> 7;
        const int j0 = 32 * (oc >> 2) + 4 * (oc & 3);
        float val[8];
#pragma unroll
        for (int e = 0; e < 8; ++e) {
          const int j = j0 + (e & 3) + ((e >> 2) << 4);
          const float f = __expf(gclast - __shfl(gcL, j));
          const unsigned short raw = *(const unsigned short*)(ks + j * 256 + ((((d >> 3) ^ (j & 15))) << 4) + (d & 7) * 2);
          val[e] = bf2f(raw) * f;
        }
        u32x4 v;
        v[0] = pack2(val[0], val[1]); v[1] = pack2(val[2], val[3]); v[2] = pack2(val[4], val[5]); v[3] = pack2(val[6], val[7]);
        *(u32x4*)(KTT + ((size_t)item * 128 + d) * 64 + 8 * oc) = v;
      }
    }
  }
  __syncthreads();
}

__device__ __forceinline__ void ph_dnscan(unsigned char* smem, int item, const bf16_t* __restrict__ QDp, const bf16_t* __restrict__ W0Np, const bf16_t* __restrict__ KTTp,
                                          const bf16_t* __restrict__ RVp, const bf16_t* __restrict__ TMp, const bf16_t* __restrict__ ATTp, const float* __restrict__ GLp,
                                          float* __restrict__ op) {
  const int tid = TIDX, lane = tid & 63, w = tid >> 6, fr = lane & 15, fq = lane >> 4;
  const int bh = item >> 1, half = item & 1, b = bh >> 2, h = bh & 3;
  const int vcol0 = (half * 4 + w) * 16;
  unsigned char* sW0 = smem; unsigned char* sQD = smem + 16384; unsigned char* sKT = smem + 32768; unsigned char* sT = smem + 49152; unsigned char* sAT = smem + 57344;
  f32x4 S[8];
#pragma unroll
  for (int t = 0; t < 8; ++t) S[t] = (f32x4){0.f, 0.f, 0.f, 0.f};
  u32x4 pfA[8], pfB[8]; unsigned short rvp[16];
#define DN_LOAD_A(nn_) do { \
    const size_t ci = (size_t)bh * 64 + (nn_); \
    _Pragma("unroll") for (int i = 0; i < 4; ++i) pfA[i] = *(const u32x4*)((const char*)W0Np + ci * 16384 + (size_t)(tid + 256 * i) * 16); \
    _Pragma("unroll") for (int i = 0; i < 4; ++i) pfA[4 + i] = *(const u32x4*)((const char*)QDp + ci * 16384 + (size_t)(tid + 256 * i) * 16); \
    _Pragma("unroll") for (int mt = 0; mt < 4; ++mt) \
      _Pragma("unroll") for (int r = 0; r < 4; ++r) rvp[mt * 4 + r] = RVp[(ci * 64 + 16 * mt + 4 * fq + r) * 128 + vcol0 + fr]; \
  } while (0)
#define DN_STORE_A() do { \
    _Pragma("unroll") for (int i = 0; i < 4; ++i) { const int q = tid + 256 * i, row = q >> 4, ch = q & 15; *(u32x4*)(sW0 + row * 256 + ((ch ^ (row & 15)) << 4)) = pfA[i]; } \
    _Pragma("unroll") for (int i = 0; i < 4; ++i) { const int q = tid + 256 * i, row = q >> 4, ch = q & 15; *(u32x4*)(sQD + row * 256 + ((ch ^ (row & 15)) << 4)) = pfA[4 + i]; } \
  } while (0)
#define DN_LOAD_B(nn_) do { \
    const size_t ci = (size_t)bh * 64 + (nn_); \
    _Pragma("unroll") for (int i = 0; i < 4; ++i) pfB[i] = *(const u32x4*)((const char*)KTTp + ci * 16384 + (size_t)(tid + 256 * i) * 16); \
    _Pragma("unroll") for (int i = 0; i < 2; ++i) pfB[4 + i] = *(const u32x4*)((const char*)TMp + ci * 8192 + (size_t)(tid + 256 * i) * 16); \
    _Pragma("unroll") for (int i = 0; i < 2; ++i) pfB[6 + i] = *(const u32x4*)((const char*)ATTp + ci * 8192 + (size_t)(tid + 256 * i) * 16); \
  } while (0)
#define DN_STORE_B() do { \
    _Pragma("unroll") for (int i = 0; i < 4; ++i) { const int q = tid + 256 * i, row = q >> 3, ch = q & 7; *(u32x4*)(sKT + row * 128 + ((ch ^ (row & 7)) << 4)) = pfB[i]; } \
    _Pragma("unroll") for (int i = 0; i < 2; ++i) { const int q = tid + 256 * i, row = q >> 3, ch = q & 7; *(u32x4*)(sT + row * 128 + ((ch ^ (row & 7)) << 4)) = pfB[4 + i]; } \
    _Pragma("unroll") for (int i = 0; i < 2; ++i) { const int q = tid + 256 * i, row = q >> 3, ch = q & 7; *(u32x4*)(sAT + row * 128 + ((ch ^ (row & 7)) << 4)) = pfB[6 + i]; } \
  } while (0)
#define DN_ZINIT() do { _Pragma("unroll") for (int mt = 0; mt < 4; ++mt) Z[mt] = (f32x4){bf2f(rvp[mt * 4 + 0]), bf2f(rvp[mt * 4 + 1]), bf2f(rvp[mt * 4 + 2]), bf2f(rvp[mt * 4 + 3])}; } while (0)
  __syncthreads();
  f32x4 Z[4];
  DN_LOAD_A(0);
  DN_LOAD_B(0);
  DN_STORE_A();
  DN_ZINIT();
  DN_LOAD_A(1);
  for (int nn = 0; nn < 64; ++nn) {
    const float gl = GLp[(size_t)bh * 64 + nn];
    __syncthreads();
    bf16x8 Sb[4];
#pragma unroll
    for (int k4 = 0; k4 < 4; ++k4) Sb[k4] = pack8(S[2 * k4], S[2 * k4 + 1]);
    f32x4 O[4];
#pragma unroll
    for (int mt = 0; mt < 4; ++mt) {
      O[mt] = (f32x4){0.f, 0.f, 0.f, 0.f};
      const int row = 16 * mt + fr;
#pragma unroll
      for (int k4 = 0; k4 < 4; ++k4) {
        const int off = row * 256 + ((((k4 * 4 + fq) ^ fr)) << 4);
        const bf16x8 aw = *(const bf16x8*)(sW0 + off);
        const bf16x8 aq = *(const bf16x8*)(sQD + off);
        Z[mt] = __builtin_amdgcn_mfma_f32_16x16x32_bf16(aw, Sb[k4], Z[mt], 0, 0, 0);
        O[mt] = __builtin_amdgcn_mfma_f32_16x16x32_bf16(Sb[k4], aq, O[mt], 0, 0, 0);
      }
    }
    bf16x8 Zb[2];
    Zb[0] = pack8(Z[0], Z[1]); Zb[1] = pack8(Z[2], Z[3]);
    DN_STORE_B();
    if (nn + 1 < 64) DN_LOAD_B(nn + 1);
    __syncthreads();
    f32x4 Vn[4];
#pragma unroll
    for (int mt = 0; mt < 4; ++mt) {
      Vn[mt] = (f32x4){0.f, 0.f, 0.f, 0.f};
      const int row = 16 * mt + fr;
#pragma unroll
      for (int s = 0; s < 2; ++s) {
        if (s <= (mt >> 1)) {
          const bf16x8 at = *(const bf16x8*)(sT + row * 128 + ((((s * 4 + fq) ^ (row & 7))) << 4));
          Vn[mt] = __builtin_amdgcn_mfma_f32_16x16x32_bf16(at, Zb[s], Vn[mt], 0, 0, 0);
        }
      }
    }
    bf16x8 Vb[2];
    Vb[0] = pack8(Vn[0], Vn[1]); Vb[1] = pack8(Vn[2], Vn[3]);
#pragma unroll
    for (int mt = 0; mt < 4; ++mt) {
      const int row = 16 * mt + fr;
#pragma unroll
      for (int s = 0; s < 2; ++s) {
        if (s <= (mt >> 1)) {
          const bf16x8 aa = *(const bf16x8*)(sAT + row * 128 + ((((s * 4 + fq) ^ (row & 7))) << 4));
          O[mt] = __builtin_amdgcn_mfma_f32_16x16x32_bf16(Vb[s], aa, O[mt], 0, 0, 0);
        }
      }
      *(f32x4*)(op + ((size_t)b * SEQ + nn * 64 + 16 * mt + fr) * 512 + h * 128 + vcol0 + 4 * fq) = O[mt];
    }
#pragma unroll
    for (int t = 0; t < 8; ++t) {
      S[t] = S[t] * gl;
      const int row = 16 * t + fr;
#pragma unroll
      for (int s = 0; s < 2; ++s) {
        const bf16x8 ak = *(const bf16x8*)(sKT + row * 128 + ((((s * 4 + fq) ^ (row & 7))) << 4));
        S[t] = __builtin_amdgcn_mfma_f32_16x16x32_bf16(ak, Vb[s], S[t], 0, 0, 0);
      }
    }
    if (nn + 1 < 64) {
      DN_STORE_A();
      DN_ZINIT();
      if (nn + 2 < 64) DN_LOAD_A(nn + 2);
    }
  }
  __syncthreads();
#undef DN_ZINIT
#undef DN_LOAD_A
#undef DN_STORE_A
#undef DN_LOAD_B
#undef DN_STORE_B
}

__device__ __forceinline__ void ph_dn_post(int item, const float* __restrict__ o, const bf16_t* __restrict__ proj, const float* __restrict__ dn_norm_g, bf16_t* __restrict__ mixed) {
  const int tid = TIDX, h = tid >> 6, lane = tid & 63;
  const float2 g2 = *(const float2*)(dn_norm_g + 2 * lane);
  float2 ov[4]; unsigned zv[4];
#pragma unroll
  for (int i = 0; i < 4; ++i) {
    const size_t n = (size_t)item * 4 + i;
    ov[i] = *(const float2*)(o + n * 512 + h * 128 + 2 * lane);
    zv[i] = *(const unsigned*)(proj + n * PROJW + OFF_Z + h * 128 + 2 * lane);
  }
#pragma unroll
  for (int i = 0; i < 4; ++i) {
    const size_t n = (size_t)item * 4 + i;
    const float ss = wave_sum(ov[i].x * ov[i].x + ov[i].y * ov[i].y);
    const float rn = rsqrtf(ss * (1.f / 128.f) + RMS_EPS);
    *(unsigned*)(mixed + n * DM + h * 128 + 2 * lane) = pack2(ov[i].x * rn * g2.x * siluf(bflo(zv[i])), ov[i].y * rn * g2.y * siluf(bfhi(zv[i])));
  }
}

__device__ __forceinline__ void ph_swa(unsigned char* smem, int item, const bf16_t* __restrict__ proj, const bf16_t* __restrict__ vt, const float* __restrict__ sinks, bf16_t* __restrict__ mixed) {
  const int tid = TIDX, lane = tid & 63, w = tid >> 6, fr = lane & 15, fq = lane >> 4;
  const int qb = item & 31, kvh = (item >> 5) & 1, b = item >> 6;
  const int t0 = qb * 128;
  const size_t rowb = (size_t)b * SEQ;
  unsigned char* sK = smem;
  unsigned char* sV = smem + 32768;
  __syncthreads();
#pragma unroll
  for (int i = 0; i < 8; ++i) {
    const int q = tid + 256 * i, row = q >> 3, ch = q & 7;
    const int pos = t0 - 128 + row;
    u32x4 v = (u32x4){0u, 0u, 0u, 0u};
    if (pos >= 0) v = *(const u32x4*)(proj + (rowb + pos) * PROJW + OFF_SK + kvh * 64 + ch * 8);
    *(u32x4*)(sK + row * 128 + ((ch ^ (row & 7)) << 4)) = v;
  }
#pragma unroll
  for (int i = 0; i < 8; ++i) {
    const int q = tid + 256 * i, row = q >> 5, ch = q & 31;
    const int pos = t0 - 128 + ch * 8;
    u32x4 v = (u32x4){0u, 0u, 0u, 0u};
    if (pos >= 0) v = *(const u32x4*)(vt + ((size_t)(b * 128 + kvh * 64 + row)) * SEQ + pos);
    *(u32x4*)(sV + row * 512 + ((ch ^ (row & 15)) << 4)) = v;
  }
  __syncthreads();
  const int head = kvh * 4 + w;
  const float slope = exp2f(-(float)(head + 1));
  const float sink = sinks[head];
  const bf16_t* qp0 = proj + (rowb + t0 + fr) * PROJW + OFF_SQ + head * 64 + fq * 8;
  bf16x8 qn0 = *(const bf16x8*)(qp0), qn1 = *(const bf16x8*)(qp0 + 32);
#pragma unroll 1
  for (int qt = 0; qt < 8; ++qt) {
    const bf16x8 qf0 = qn0, qf1 = qn1;
    if (qt < 7) { const bf16_t* qp = qp0 + (size_t)(qt + 1) * 16 * PROJW; qn0 = *(const bf16x8*)(qp); qn1 = *(const bf16x8*)(qp + 32); }
    const int kp0 = qt >> 1;
    f32x4 st[10];
#pragma unroll
    for (int kt = 0; kt < 10; ++kt) {
      const int krow = (2 * kp0 + kt) * 16 + fr;
      st[kt] = (f32x4){0.f, 0.f, 0.f, 0.f};
      const bf16x8 k0 = *(const bf16x8*)(sK + krow * 128 + (((0 + fq) ^ (krow & 7)) << 4));
      const bf16x8 k1 = *(const bf16x8*)(sK + krow * 128 + (((4 + fq) ^ (krow & 7)) << 4));
      st[kt] = __builtin_amdgcn_mfma_f32_16x16x32_bf16(k0, qf0, st[kt], 0, 0, 0);
      st[kt] = __builtin_amdgcn_mfma_f32_16x16x32_bf16(k1, qf1, st[kt], 0, 0, 0);
    }
    const int i = qt * 16 + fr;
    float mx = sink;
#pragma unroll
    for (int kt = 0; kt < 10; ++kt)
#pragma unroll
      for (int r = 0; r < 4; ++r) {
        const int jb = (2 * kp0 + kt) * 16 + 4 * fq + r;
        const int dist = 128 + i - jb;
        const bool ok = (dist >= 0) && (dist < 128) && (t0 - 128 + jb >= 0);
        const float s = ok ? (st[kt][r] * 0.125f - slope * (float)dist) : -INFINITY;
        st[kt][r] = s;
        mx = fmaxf(mx, s);
      }
    mx = fmaxf(mx, __shfl_xor(mx, 16));
    mx = fmaxf(mx, __shfl_xor(mx, 32));
    float sum = 0.f;
#pragma unroll
    for (int kt = 0; kt < 10; ++kt)
#pragma unroll
      for (int r = 0; r < 4; ++r) { const float p = __expf(st[kt][r] - mx); st[kt][r] = p; sum += p; }
    sum += __shfl_xor(sum, 16);
    sum += __shfl_xor(sum, 32);
    const float inv = 1.f / (sum + __expf(sink - mx));
    f32x4 O[4];
#pragma unroll
    for (int nt = 0; nt < 4; ++nt) O[nt] = (f32x4){0.f, 0.f, 0.f, 0.f};
#pragma unroll
    for (int s5 = 0; s5 < 5; ++s5) {
      const bf16x8 pa = pack8(st[2 * s5] * inv, st[2 * s5 + 1] * inv);
      const int key0 = (2 * kp0 + 2 * s5) * 16 + 4 * fq;
#pragma unroll
      for (int nt = 0; nt < 4; ++nt) {
        const int drow = nt * 16 + fr;
        const int c0 = key0 >> 3, c1 = (key0 + 16) >> 3;
        const u32x2 lo = *(const u32x2*)(sV + drow * 512 + ((c0 ^ (drow & 15)) << 4) + ((key0 >> 2) & 1) * 8);
        const u32x2 hi = *(const u32x2*)(sV + drow * 512 + ((c1 ^ (drow & 15)) << 4) + ((key0 >> 2) & 1) * 8);
        const u32x4 vb = (u32x4){lo[0], lo[1], hi[0], hi[1]};
        O[nt] = __builtin_amdgcn_mfma_f32_16x16x32_bf16(__builtin_bit_cast(bf16x8, vb), pa, O[nt], 0, 0, 0);
      }
    }
#pragma unroll
    for (int nt = 0; nt < 4; ++nt) {
      u32x2 wv; wv[0] = pack2(O[nt][0], O[nt][1]); wv[1] = pack2(O[nt][2], O[nt][3]);
      *(u32x2*)(mixed + (rowb + t0 + qt * 16 + fr) * DM + 512 + head * 64 + nt * 16 + 4 * fq) = wv;
    }
  }
}

__device__ __forceinline__ void ph_wout(unsigned char* smem, int xcd, int l, const bf16_t* __restrict__ mixed, const bf16_t* __restrict__ wt, bf16_t* __restrict__ mixo) {
  const int mi = l >> 3, ni = l & 7;
  LdRowBF16 al; al.init([&](int r) { return mixed + (size_t)((xcd * 32 + mi) * 128 + r) * DM; }, (size_t)8 * 128 * DM * 2);
  LdRowBF16 bl; bl.init([&](int r) { return wt + (size_t)(ni * 128 + r) * DM; }, 0);
  gemm_stream<16>(smem, al, bl, 4, [&](int seg, f32x4 (&acc)[4][4], unsigned char* fbuf) {
    const int m0 = (xcd * 32 + seg * 8 + mi) * 128, n0 = ni * 128;
    store_tile_bf16(fbuf, acc, [&](int r) { return mixo + (size_t)(m0 + r) * DM + n0; });
  });
}

__device__ __forceinline__ void ph_ln1(int item, const float* __restrict__ x, const bf16_t* __restrict__ mixo, const float* __restrict__ gam, const float* __restrict__ bet, bf16_t* __restrict__ xbf, unsigned char* __restrict__ x8) {
  const int row = item * 4 + (TIDX >> 6), lane = TIDX & 63;
  const float4* p = (const float4*)(x + (size_t)row * DM);
  const u32x2* pm = (const u32x2*)(mixo + (size_t)row * DM);
  float4 v[4]; float s = 0.f;
#pragma unroll
  for (int i = 0; i < 4; ++i) {
    const float4 xv = p[lane + i * 64]; const u32x2 mv = pm[lane + i * 64];
    v[i].x = ALPHA * xv.x + bflo(mv[0]); v[i].y = ALPHA * xv.y + bfhi(mv[0]); v[i].z = ALPHA * xv.z + bflo(mv[1]); v[i].w = ALPHA * xv.w + bfhi(mv[1]);
    s += v[i].x + v[i].y + v[i].z + v[i].w;
  }
  const float mu = wave_sum(s) * (1.f / DM);
  float q = 0.f;
#pragma unroll
  for (int i = 0; i < 4; ++i) { const float a = v[i].x - mu, b = v[i].y - mu, c = v[i].z - mu, d = v[i].w - mu; q += a * a + b * b + c * c + d * d; }
  const float rs = rsqrtf(wave_sum(q) * (1.f / DM) + LN_EPS);
#pragma unroll
  for (int i = 0; i < 4; ++i) {
    const float4 gg = ((const float4*)gam)[lane + i * 64], bb = ((const float4*)bet)[lane + i * 64];
    u32x2 w;
    w[0] = pack2((v[i].x - mu) * rs * gg.x + bb.x, (v[i].y - mu) * rs * gg.y + bb.y);
    w[1] = pack2((v[i].z - mu) * rs * gg.z + bb.z, (v[i].w - mu) * rs * gg.w + bb.w);
    ((u32x2*)(xbf + (size_t)row * DM))[lane + i * 64] = w;
    int pk = 0;
    pk = __builtin_amdgcn_cvt_pk_fp8_f32((v[i].x - mu) * rs * gg.x + bb.x, (v[i].y - mu) * rs * gg.y + bb.y, pk, false);
    pk = __builtin_amdgcn_cvt_pk_fp8_f32((v[i].z - mu) * rs * gg.z + bb.z, (v[i].w - mu) * rs * gg.w + bb.w, pk, true);
    ((int*)(x8 + (size_t)row * DM))[lane + i * 64] = pk;
  }
}

__device__ __forceinline__ void ph_router(unsigned char* smem, int tile, const bf16_t* __restrict__ xbf, const bf16_t* __restrict__ wt, float* __restrict__ logits) {
  GEMM_IDS
  const int n0 = (tile & 1) * 128, m0 = (tile >> 1) * 128;
  LdRowBF16 al; al.init([&](int r) { return xbf + (size_t)(m0 + r) * DM; }, 0);
  LdRowBF16 bl; bl.init([&](int r) { return wt + (size_t)(n0 + r) * DM; }, 0);
  gemm_stream<16>(smem, al, bl, 1, [&](int seg, f32x4 (&acc)[4][4], unsigned char* fbuf) {
    GEMM_IDS
#pragma unroll
    for (int m = 0; m < 4; ++m)
#pragma unroll
      for (int n = 0; n < 4; ++n)
        *(f32x4*)(logits + (size_t)(m0 + wr * 64 + m * 16 + fr) * NEXP + n0 + wc * 64 + n * 16 + fq * 4) = acc[m][n];
  });
}

__device__ __forceinline__ unsigned rt_fkey(float f) { const unsigned b = __float_as_uint(f); return (b & 0x80000000u) ? ~b : (b | 0x80000000u); }
#define RT_DPPF(x, ctrl) __builtin_bit_cast(float, __builtin_amdgcn_update_dpp(__builtin_bit_cast(int, x), __builtin_bit_cast(int, x), ctrl, 0xf, 0xf, false))
#define RT_DPPU(x, ctrl, rmask) (unsigned)__builtin_amdgcn_update_dpp((int)(x), (int)(x), ctrl, rmask, 0xf, false)
#define RT_KSTEP(hi, lo, ctrl, rmask) { const unsigned ph_ = RT_DPPU(hi, ctrl, rmask), pl_ = RT_DPPU(lo, ctrl, rmask); \
    const bool t_ = (ph_ > hi) || (ph_ == hi && pl_ > lo); hi = t_ ? ph_ : hi; lo = t_ ? pl_ : lo; }
__device__ __forceinline__ void ph_route(int item, const float* __restrict__ logits, const float* __restrict__ router_bias, int* __restrict__ cnt, int* __restrict__ list, float* __restrict__ gates) {
  const int n = item * 4 + (TIDX >> 6), lane = TIDX & 63;
  const float4 lg = ((const float4*)(logits + (size_t)n * NEXP))[lane];
  const float4 rb = ((const float4*)router_bias)[lane];
  const float sc0 = sigmoidf(lg.x), sc1 = sigmoidf(lg.y), sc2 = sigmoidf(lg.z), sc3 = sigmoidf(lg.w);
  const float sel0 = sc0 + rb.x, sel1 = sc1 + rb.y, sel2 = sc2 + rb.z, sel3 = sc3 + rb.w;
  float t1 = fmaxf(sel0, sel1), t2 = fminf(sel0, sel1);
  { const float a = sel2; if (a > t1) { t2 = t1; t1 = a; } else if (a > t2) t2 = a; }
  { const float a = sel3; if (a > t1) { t2 = t1; t1 = a; } else if (a > t2) t2 = a; }
  { const float b1 = RT_DPPF(t1, 0xB1), b2 = RT_DPPF(t2, 0xB1); const float n1 = fmaxf(t1, b1), n2 = fmaxf(fminf(t1, b1), fmaxf(t2, b2)); t1 = n1; t2 = n2; }
  { const float b1 = RT_DPPF(t1, 0x4E), b2 = RT_DPPF(t2, 0x4E); const float n1 = fmaxf(t1, b1), n2 = fmaxf(fminf(t1, b1), fmaxf(t2, b2)); t1 = n1; t2 = n2; }
  { const float b1 = RT_DPPF(t1, 0x141), b2 = RT_DPPF(t2, 0x141); const float n1 = fmaxf(t1, b1), n2 = fmaxf(fminf(t1, b1), fmaxf(t2, b2)); t1 = n1; t2 = n2; }
  const float gs = t1 + t2;
  const int mygrp = lane >> 3;
  int rank = 0;
#pragma unroll
  for (int j = 0; j < 8; ++j) {
    const float o = __builtin_bit_cast(float, __builtin_amdgcn_readlane(__builtin_bit_cast(int, gs), j * 8));
    rank += (o > gs || (o == gs && j < mygrp)) ? 1 : 0;
  }
  const bool gsel = rank < 4;
  unsigned k0 = gsel ? rt_fkey(sel0) : 0u, k1 = gsel ? rt_fkey(sel1) : 0u, k2 = gsel ? rt_fkey(sel2) : 0u, k3 = gsel ? rt_fkey(sel3) : 0u;
  float gsum = 0.f; float myg = 0.f; int mye = 0;
#pragma unroll 1
  for (int r = 0; r < TOPK; ++r) {
    unsigned hi = k0, lo = 255u - (unsigned)(lane * 4);
    if (k1 > hi) { hi = k1; lo = 255u - (unsigned)(lane * 4 + 1); }
    if (k2 > hi) { hi = k2; lo = 255u - (unsigned)(lane * 4 + 2); }
    if (k3 > hi) { hi = k3; lo = 255u - (unsigned)(lane * 4 + 3); }
    RT_KSTEP(hi, lo, 0xB1, 0xf) RT_KSTEP(hi, lo, 0x4E, 0xf) RT_KSTEP(hi, lo, 0x141, 0xf) RT_KSTEP(hi, lo, 0x140, 0xf)
    RT_KSTEP(hi, lo, 0x142, 0xa) RT_KSTEP(hi, lo, 0x143, 0xc)
    const int be = 255 - __builtin_amdgcn_readlane((int)lo, 63);
    const int owner = be >> 2, slot = be & 3;
    const float tsel = (slot == 0) ? sc0 : (slot == 1) ? sc1 : (slot == 2) ? sc2 : sc3;
    const float bs = __builtin_bit_cast(float, __builtin_amdgcn_readlane(__builtin_bit_cast(int, tsel), owner));
    if (lane == owner) { if (slot == 0) k0 = 0u; else if (slot == 1) k1 = 0u; else if (slot == 2) k2 = 0u; else k3 = 0u; }
    gsum += bs;
    if (lane == r) { myg = bs; mye = be; }
  }
  if (lane < TOPK) {
    const int sh = item & (NSH - 1);
    const int slot = atomicAdd(&cnt[sh * NEXP + mye], 1);
    list[((size_t)sh * NEXP + mye) * CAPS + slot] = n * TOPK + lane;
    gates[(size_t)n * TOPK + lane] = myg / gsum * 2.5f;
  }
}
#undef RT_KSTEP

__device__ __forceinline__ void moe_build_prefix(const int* __restrict__ cnt, int* sscan) {
  const int tid = TIDX;
  const int e = ((tid & 31) << 3) | (tid >> 5);
  int c = 0;
#pragma unroll
  for (int s = 0; s < NSH; ++s) c += cnt[s * NEXP + e];
  __syncthreads();
  sscan[tid] = (c + 127) >> 7;
  __syncthreads();
  for (int o = 1; o < 256; o <<= 1) {
    const int v = (tid >= o) ? sscan[tid - o] : 0;
    __syncthreads();
    sscan[tid] += v;
    __syncthreads();
  }
}
__device__ __forceinline__ void moe_locate(const int* sscan, int x, int lt, int& e, int& rt) {
  const int base = x ? sscan[32 * x - 1] : 0;
  const int nrouted = sscan[32 * x + 31] - base;
  if (lt >= nrouted) { e = 256; rt = x * (NTOK / 128 / 8) + (lt - nrouted); return; }
  const int g = base + lt;
  int lo = 32 * x, hi = 32 * x + 31;
  while (lo < hi) { const int mid = (lo + hi) >> 1; if (sscan[mid] > g) hi = mid; else lo = mid + 1; }
  e = ((lo & 31) << 3) | (lo >> 5); rt = g - (lo ? sscan[lo - 1] : 0);
}

typedef int v8i __attribute__((ext_vector_type(8)));
typedef int i32x4 __attribute__((ext_vector_type(4)));
#define MX_ONE 0x7f7f7f7f
__device__ __forceinline__ long lo64(const u32x4& v) { return (long)(((unsigned long long)v[1] << 32) | (unsigned long long)v[0]); }
__device__ __forceinline__ long hi64(const u32x4& v) { return (long)(((unsigned long long)v[3] << 32) | (unsigned long long)v[2]); }
__device__ __forceinline__ void ph_moe(unsigned char* smem, int e, int rt, const unsigned char* __restrict__ x8, const bf16_t* __restrict__ xbf, const int* __restrict__ cnt,
                                       const int* __restrict__ list, const float* __restrict__ gates, const unsigned char* __restrict__ wge, const unsigned char* __restrict__ wue,
                                       const unsigned char* __restrict__ wde, unsigned char* __restrict__ ybuf, float* __restrict__ dout, unsigned char* __restrict__ dummy) {
  int* sasg = (int*)(smem + SM_MISC + 2048);
  float* sgate = (float*)(smem + SM_MISC + 2048 + 512);
  const int tid = TIDX, lane = tid & 63, w = tid >> 6, fr = lane & 15, fq = lane >> 4;
  __syncthreads();
  if (tid < 128) {
    const int r = rt * 128 + tid;
    int a = -1;
    if (e < 256) {
      int cum = 0;
#pragma unroll
      for (int s = 0; s < NSH; ++s) {
        const int c = cnt[s * NEXP + e];
        if (r >= cum && r < cum + c) a = list[((size_t)s * NEXP + e) * CAPS + (r - cum)];
        cum += c;
      }
    } else if (r < NTOK) a = NA + r;
    sasg[tid] = a;
    sgate[tid] = (a >= 0 && a < NA) ? gates[a] : 1.f;
  }
  __syncthreads();
  v8i hf[2][2];
  {
    LdRowBF16 al; al.init([&](int r) { const int a = sasg[r]; const int tok = (a < 0) ? 0 : (a < NA ? (a >> 3) : (a - NA)); return x8 + (size_t)tok * DM; }, 0);
    LdRowBF16 bl; bl.init([&](int j) {
      const int bn = j >> 4, ff = (bn >> 1) * 16 + (j & 15);
      return ((bn & 1) ? wue : wge) + (size_t)ff * DM; }, (size_t)64 * DM);
    al.issue(0, 0, smem); bl.issue(0, 0, smem + 16384);
    asm volatile("s_waitcnt vmcnt(0)" ::: "memory");
    __syncthreads();
#pragma unroll
    for (int m = 0; m < 2; ++m)
#pragma unroll
      for (int s = 0; s < 2; ++s) hf[m][s] = (v8i){0, 0, 0, 0, 0, 0, 0, 0};
#pragma unroll 1
    for (int ct = 0; ct < 4; ++ct) {
      f32x4 acc[2][8];
#pragma unroll
      for (int m = 0; m < 2; ++m)
#pragma unroll
        for (int n = 0; n < 8; ++n) acc[m][n] = (f32x4){0.f, 0.f, 0.f, 0.f};
#pragma unroll 1
      for (int kk = 0; kk < 8; ++kk) {
        const int j = ct * 8 + kk;
        unsigned char* cur = smem + (j & 1) * 32768; unsigned char* nxt = smem + ((j & 1) ^ 1) * 32768;
        if (j + 1 < 32) { al.issue((j + 1) >> 3, (j + 1) & 7, nxt); bl.issue((j + 1) >> 3, (j + 1) & 7, nxt + 16384); }
        {
          v8i a[2], bfrag[8];
#pragma unroll
          for (int m = 0; m < 2; ++m) {
            const int row = w * 32 + m * 16 + fr;
            const i32x4 lo = *(const i32x4*)(cur + row * 128 + ((fq ^ (row & 7)) << 4));
            const i32x4 hi = *(const i32x4*)(cur + row * 128 + (((4 + fq) ^ (row & 7)) << 4));
            a[m] = __builtin_shufflevector(lo, hi, 0, 1, 2, 3, 4, 5, 6, 7);
          }
#pragma unroll
          for (int n = 0; n < 8; ++n) {
            const int row = n * 16 + fr;
            const i32x4 lo = *(const i32x4*)(cur + 16384 + row * 128 + ((fq ^ (row & 7)) << 4));
            const i32x4 hi = *(const i32x4*)(cur + 16384 + row * 128 + (((4 + fq) ^ (row & 7)) << 4));
            bfrag[n] = __builtin_shufflevector(lo, hi, 0, 1, 2, 3, 4, 5, 6, 7);
          }
          __builtin_amdgcn_s_setprio(1);
#pragma unroll
          for (int n = 0; n < 8; ++n)
#pragma unroll
            for (int m = 0; m < 2; ++m)
              acc[m][n] = __builtin_amdgcn_mfma_scale_f32_16x16x128_f8f6f4(bfrag[n], a[m], acc[m][n], 0, 0, 0, MX_ONE, 0, MX_ONE);
          __builtin_amdgcn_s_setprio(0);
          __builtin_amdgcn_sched_group_barrier(0x100, 20, 0);
          __builtin_amdgcn_sched_group_barrier(0x008, 16, 0);
        }
        asm volatile("s_waitcnt vmcnt(0)" ::: "memory");
        __syncthreads();
      }
#pragma unroll
      for (int m = 0; m < 2; ++m) {
        int hp[4][2];
#pragma unroll
        for (int p = 0; p < 4; ++p) {
          float hv[4];
#pragma unroll
          for (int r = 0; r < 4; ++r) hv[r] = siluf(acc[m][2 * p][r] * (1.f / SC_WG)) * acc[m][2 * p + 1][r] * (SC_H / SC_WU);
          int pk = 0;
          pk = __builtin_amdgcn_cvt_pk_fp8_f32(hv[0], hv[1], pk, false);
          pk = __builtin_amdgcn_cvt_pk_fp8_f32(hv[2], hv[3], pk, true);
          hp[p][0] = pk;
        }
        if (ct == 0) { hf[m][0][0] = hp[0][0]; hf[m][0][1] = hp[1][0]; hf[m][0][2] = hp[2][0]; hf[m][0][3] = hp[3][0]; }
        else if (ct == 1) { hf[m][0][4] = hp[0][0]; hf[m][0][5] = hp[1][0]; hf[m][0][6] = hp[2][0]; hf[m][0][7] = hp[3][0]; }
        else if (ct == 2) { hf[m][1][0] = hp[0][0]; hf[m][1][1] = hp[1][0]; hf[m][1][2] = hp[2][0]; hf[m][1][3] = hp[3][0]; }
        else { hf[m][1][4] = hp[0][0]; hf[m][1][5] = hp[1][0]; hf[m][1][6] = hp[2][0]; hf[m][1][7] = hp[3][0]; }
      }
    }
  }
#define MOE_RAW_BARRIER() do { asm volatile("s_waitcnt lgkmcnt(0)" ::: "memory"); __builtin_amdgcn_s_barrier(); } while (0)
  {
    LdRowBF16 bl; bl.init([&](int j) { return wde + (size_t)j * EFF; }, (size_t)128 * EFF);
    bl.issue(0, 0, smem); bl.issue(0, 1, smem + 16384); bl.issue(1, 0, smem + 32768);
#pragma unroll 1
    for (int ct = 0; ct < 8; ++ct) {
      f32x4 acc[2][8];
#pragma unroll
      for (int m = 0; m < 2; ++m)
#pragma unroll
        for (int n = 0; n < 8; ++n) acc[m][n] = (f32x4){0.f, 0.f, 0.f, 0.f};
#pragma unroll
      for (int kk = 0; kk < 2; ++kk) {
        const int j = ct * 2 + kk;
        if (e < 256) {
          if (kk == 0) {
            if (ct == 0) asm volatile("s_waitcnt vmcnt(8)" ::: "memory");
            else if (ct == 1) asm volatile("s_waitcnt vmcnt(12)" ::: "memory");
            else if (ct < 7) asm volatile("s_waitcnt vmcnt(16)" ::: "memory");
            else asm volatile("s_waitcnt vmcnt(12)" ::: "memory");
          } else {
            if (ct == 0) asm volatile("s_waitcnt vmcnt(8)" ::: "memory");
            else if (ct < 7) asm volatile("s_waitcnt vmcnt(12)" ::: "memory");
            else asm volatile("s_waitcnt vmcnt(4)" ::: "memory");
          }
        } else {
          if (j < 14) asm volatile("s_waitcnt vmcnt(8)" ::: "memory");
          else if (j == 14) asm volatile("s_waitcnt vmcnt(4)" ::: "memory");
          else asm volatile("s_waitcnt vmcnt(0)" ::: "memory");
        }
        MOE_RAW_BARRIER();
        if (j + 3 < 16) bl.issue((j + 3) >> 1, (j + 3) & 1, smem + ((j + 3) & 3) * 16384);
        const unsigned char* cur = smem + (j & 3) * 16384;
        {
          v8i wf[8];
#pragma unroll
          for (int n = 0; n < 8; ++n) {
            const int row = n * 16 + fr;
            const i32x4 lo = *(const i32x4*)(cur + row * 128 + ((fq ^ (row & 7)) << 4));
            const i32x4 hi = *(const i32x4*)(cur + row * 128 + (((4 + fq) ^ (row & 7)) << 4));
            wf[n] = __builtin_shufflevector(lo, hi, 0, 1, 2, 3, 4, 5, 6, 7);
          }
          __builtin_amdgcn_s_setprio(1);
#pragma unroll
          for (int n = 0; n < 8; ++n)
#pragma unroll
            for (int m = 0; m < 2; ++m) acc[m][n] = __builtin_amdgcn_mfma_scale_f32_16x16x128_f8f6f4(wf[n], hf[m][kk], acc[m][n], 0, 0, 0, MX_ONE, 0, MX_ONE);
          __builtin_amdgcn_s_setprio(0);
          __builtin_amdgcn_sched_group_barrier(0x100, 16, 0);
          __builtin_amdgcn_sched_group_barrier(0x008, 16, 0);
        }
      }
      const int n0 = ct * 128;
      if (e == 256) {
#pragma unroll
        for (int m = 0; m < 2; ++m) {
          const int a = sasg[w * 32 + m * 16 + fr];
          if (a >= NA) {
            float* dp = dout + (size_t)(a - NA) * DM + n0 + fq * 4;
            const bf16_t* xp = xbf + (size_t)(a - NA) * DM + n0 + fq * 4;
#pragma unroll
            for (int n = 0; n < 8; ++n) {
              const u32x2 xw = *(const u32x2*)(xp + n * 16);
              const f32x4 xv = (f32x4){bflo(xw[0]), bfhi(xw[0]), bflo(xw[1]), bfhi(xw[1])};
              *(f32x4*)(dp + n * 16) = xv * ALPHA + acc[m][n] * (1.f / (SC_H * SC_WD));
            }
          }
        }
      } else {
        unsigned char* stg = smem + ((2 * ct + 1) & 3) * 16384 + w * 4096;
        MOE_RAW_BARRIER();
#pragma unroll
        for (int m = 0; m < 2; ++m) {
          const int row = m * 16 + fr;
          const float gt = sgate[w * 32 + row] * (SC_Y / (SC_H * SC_WD));
#pragma unroll
          for (int n = 0; n < 8; ++n) {
            int pk = 0;
            pk = __builtin_amdgcn_cvt_pk_fp8_f32(acc[m][n][0] * gt, acc[m][n][1] * gt, pk, false);
            pk = __builtin_amdgcn_cvt_pk_fp8_f32(acc[m][n][2] * gt, acc[m][n][3] * gt, pk, true);
            *(int*)(stg + row * 128 + ((n ^ (row & 7)) << 4) + 4 * fq) = pk;
          }
        }
#pragma unroll
        for (int i = 0; i < 4; ++i) {
          const int q = lane + 64 * i, row = q >> 3, ch = q & 7;
          const int a = sasg[w * 32 + row];
          unsigned char* yp = ((a >= 0) ? ybuf + (size_t)a * DM : dummy) + n0 + ch * 16;
          *(u32x4*)yp = *(const u32x4*)(stg + row * 128 + ((ch ^ (row & 7)) << 4));
        }
      }
    }
    MOE_RAW_BARRIER();
  }
#undef MOE_RAW_BARRIER
}

__device__ __forceinline__ void ph_final(int item, float* __restrict__ out, const unsigned char* __restrict__ ybuf, const float* __restrict__ gam, const float* __restrict__ bet) {
  const int row = item * 4 + (TIDX >> 6), lane = TIDX & 63;
  f32x4* p = (f32x4*)(out + (size_t)row * DM + 16 * lane);
  f32x4 v[4];
#pragma unroll
  for (int i = 0; i < 4; ++i) v[i] = p[i];
  u32x4 yv[8];
#pragma unroll
  for (int k = 0; k < 8; ++k) yv[k] = *(const u32x4*)(ybuf + ((size_t)row * 8 + k) * DM + 16 * lane);
  float ys[16];
#pragma unroll
  for (int c = 0; c < 16; ++c) ys[c] = 0.f;
#pragma unroll
  for (int k = 0; k < 8; ++k)
#pragma unroll
    for (int d = 0; d < 4; ++d) {
      const hwf32x2 lo = __builtin_amdgcn_cvt_pk_f32_fp8((int)yv[k][d], false), hi = __builtin_amdgcn_cvt_pk_f32_fp8((int)yv[k][d], true);
      ys[4 * d + 0] += lo[0]; ys[4 * d + 1] += lo[1]; ys[4 * d + 2] += hi[0]; ys[4 * d + 3] += hi[1];
    }
  float s = 0.f;
#pragma unroll
  for (int i = 0; i < 4; ++i)
#pragma unroll
    for (int r = 0; r < 4; ++r) { v[i][r] += ys[4 * i + r] * (1.f / 32.f); s += v[i][r]; }
  const float mu = wave_sum(s) * (1.f / DM);
  float q = 0.f;
#pragma unroll
  for (int i = 0; i < 4; ++i)
#pragma unroll
    for (int r = 0; r < 4; ++r) { const float d = v[i][r] - mu; q += d * d; }
  const float rs = rsqrtf(wave_sum(q) * (1.f / DM) + LN_EPS);
#pragma unroll
  for (int i = 0; i < 4; ++i) {
    const f32x4 gg = *(const f32x4*)(gam + 16 * lane + 4 * i), bb = *(const f32x4*)(bet + 16 * lane + 4 * i);
    p[i] = (v[i] - mu) * rs * gg + bb;
  }
}

#define XB_TMO      128
#define XB_XCNT(j)  (256  + 64 * (j))
#define XB_XSUB(j)  (1280 + 64 * (j))
#define XB_XGEN(j)  (2304 + 64 * (j))
#define XB_TOP      3328
#define XB_TOPGEN   3392
#define XCD_BAR_WORDS 3456
#define XB_SPIN_CAP (1u << 22)
#define LAS __attribute__((address_space(3)))
__device__ __forceinline__ unsigned xb_ld(unsigned* p)              { return __hip_atomic_load(p, __ATOMIC_RELAXED, __HIP_MEMORY_SCOPE_AGENT); }
__device__ __forceinline__ unsigned xb_add(unsigned* p, unsigned v) { return __hip_atomic_fetch_add(p, v, __ATOMIC_RELAXED, __HIP_MEMORY_SCOPE_AGENT); }
__device__ __forceinline__ unsigned xb_xcc_id() { return (unsigned)__builtin_amdgcn_s_getreg((3 << 11) | 20) & 0xFu; }
#define XB_SPIN(cond, bar) do { unsigned _sp = 0; while (cond) { __builtin_amdgcn_s_sleep(1); \
    if ((++_sp & 255u) == 0u) { if (xb_ld(&(bar)[XB_TMO])) break; if (_sp > XB_SPIN_CAP) { atomicAdd(&(bar)[XB_TMO], 1u); break; } } } } while (0)
struct XcdBarrier { unsigned* bar; unsigned x; volatile LAS unsigned* st; };
__device__ __forceinline__ XcdBarrier xcd_barrier_post(unsigned* bar, volatile LAS unsigned* st) {
  XcdBarrier b; b.bar = bar; b.x = xb_xcc_id(); b.st = st;
  if (threadIdx.x == 0) (void)xb_add(&bar[XB_XCNT(b.x)], 1u);
  return b;
}
__device__ __forceinline__ void xcd_barrier_complete(unsigned* bar, unsigned x, unsigned& nloc, unsigned& nx) {
  const unsigned G = gridDim.x * gridDim.y * gridDim.z;
  unsigned sum, cnt, mine, sp = 0u;
  for (;;) {
    sum = 0u; cnt = 0u; mine = 0u;
#pragma unroll
    for (unsigned j = 0; j < 16; ++j) { const unsigned c = xb_ld(&bar[XB_XCNT(j)]); sum += c; cnt += (c > 0u) ? 1u : 0u; mine = (j == x) ? c : mine; }
    if (sum == G) break;
    __builtin_amdgcn_s_sleep(1);
    if ((++sp & 255u) == 0u) { if (xb_ld(&bar[XB_TMO])) break; if (sp > XB_SPIN_CAP) { atomicAdd(&bar[XB_TMO], 1u); break; } }
  }
  nloc = mine > 0u ? mine : 1u; nx = cnt > 0u ? cnt : 1u;
}
__device__ __forceinline__ void xcd_barrier(const XcdBarrier& b) {
  asm volatile("s_waitcnt vmcnt(0)" ::: "memory");
  __syncthreads();
  if (threadIdx.x == 0) {
    unsigned* bar = b.bar;
    __builtin_amdgcn_s_waitcnt(0);
    unsigned nloc = b.st[0], nx = b.st[1];
    if (nloc == 0u) { xcd_barrier_complete(bar, b.x, nloc, nx); b.st[0] = nloc; b.st[1] = nx; }
    const unsigned old = xb_add(&bar[XB_XSUB(b.x)], 1u);
    const unsigned gen = old / nloc;
    if (old + 1u == (gen + 1u) * nloc) {
      __builtin_amdgcn_fence(__ATOMIC_RELEASE, "agent");
      asm volatile("s_waitcnt vmcnt(0)" ::: "memory");
      const unsigned og = xb_add(&bar[XB_TOP], 1u);
      const unsigned tg = og / nx;
      if (og + 1u == (tg + 1u) * nx) xb_add(&bar[XB_TOPGEN], 1u);
      else XB_SPIN(xb_ld(&bar[XB_TOPGEN]) == tg, bar);
      __builtin_amdgcn_fence(__ATOMIC_ACQUIRE, "agent");
      xb_add(&bar[XB_XGEN(b.x)], 1u);
      asm volatile("s_waitcnt vmcnt(0)" ::: "memory");
    } else {
      XB_SPIN(xb_ld(&bar[XB_XGEN(b.x)]) == gen, bar);
      __builtin_amdgcn_fence(__ATOMIC_ACQUIRE, "agent");
      asm volatile("s_waitcnt vmcnt(0)" ::: "memory");
    }
  }
  __syncthreads();
}

__global__ void __launch_bounds__(256, 2) mega(Params P) {
  __shared__ __attribute__((aligned(16))) unsigned char smem[SMEM_BYTES];
  const int bid = blockIdx.x, nblk = gridDim.x;
#define xin (P.in[0])
#define w_in (P.in[1])
#define conv_w (P.in[2])
#define a_log (P.in[3])
#define dt_bias (P.in[4])
#define dn_norm_g (P.in[5])
#define sinks (P.in[6])
#define w_out (P.in[7])
#define ln1_g (P.in[8])
#define ln1_b (P.in[9])
#define router_w (P.in[10])
#define router_bias (P.in[11])
#define w_gate (P.in[12])
#define w_up (P.in[13])
#define w_down (P.in[14])
#define sw_gate (P.in[15])
#define sw_up (P.in[16])
#define sw_down (P.in[17])
#define ln2_g (P.in[18])
#define ln2_b (P.in[19])
#define outp (P.out)
#define x1bf ((bf16_t*)(P.ws + WS_X1BF))
#define logits ((float*)(P.ws + WS_LOGIT))
#define list ((int*)(P.ws + WS_LIST))
#define gates ((float*)(P.ws + WS_GATES))
#define cnt ((int*)(P.ws + WS_CTRL + CNT16_OFF))
#define barw ((unsigned*)(P.ws + WS_CTRL + 4096))
#define mixed ((bf16_t*)(P.ws + WS_MIXED))
#define proj ((bf16_t*)(P.ws + WS_PROJ))
#define ba ((float*)(P.ws + WS_BA))
#define QD ((bf16_t*)(P.ws + WS_QD))
#define W0N ((bf16_t*)(P.ws + WS_W0N))
#define KTT ((bf16_t*)(P.ws + WS_KTT))
#define RV ((bf16_t*)(P.ws + WS_RV))
#define TM ((bf16_t*)(P.ws + WS_TM))
#define ATT ((bf16_t*)(P.ws + WS_ATT))
#define GL ((float*)(P.ws + WS_GL))
#define obuf ((float*)(P.ws + WS_O))
#define VTb ((bf16_t*)(P.ws + WS_VT))
#define MIXO ((bf16_t*)(P.ws + WS_O))
#define XBF ((bf16_t*)(P.ws + WS_XBF))
#define WTIN ((bf16_t*)(P.ws + WS_WTIN))
#define WTOUT ((bf16_t*)(P.ws + WS_WTOUT))
#define WTR ((bf16_t*)(P.ws + WS_WTR))
#define ybuf ((unsigned char*)(P.ws + WS_YBUF))
  {
    volatile LAS unsigned* st0 = (volatile LAS unsigned*)(smem + SM_MISC + 4080);
    if (threadIdx.x == 0) { st0[0] = 0u; st0[1] = 0u; }
    __syncthreads();
  }
  const int xcd = bid & 7, xloc = bid >> 3, xnl = nblk >> 3;
  XcdBarrier xb = xcd_barrier_post(barw, (volatile LAS unsigned*)(smem + SM_MISC + 4080));
  for (int it = bid; it < NTOK / 8; it += nblk) { ph_cvt_x(2 * it, xin, XBF); ph_cvt_x(2 * it + 1, xin, XBF); }
  for (int it = bid; it < 16 * 46 + 16 * 16 + 16 * 4; it += nblk) {
    if (it < 16 * 46) ph_cvt_wt(smem, it % 16, it / 16, w_in, DM, INC, WTIN);
    else if (it < 16 * 46 + 256) { const int j = it - 16 * 46; ph_cvt_wt(smem, j % 16, j / 16, w_out, DM, DM, WTOUT); }
    else { const int j = it - 16 * 46 - 256; ph_cvt_wt(smem, j % 16, j / 16, router_w, DM, NEXP, WTR); }
  }
  xcd_barrier(xb);
  for (int l = xloc; l < 64; l += xnl) ph_proj(smem, xcd, l, XBF, WTIN, proj, ba, VTb);
  xcd_barrier(xb);
  for (int it = bid; it < 2048; it += nblk) ph_dnchunk(smem, it, proj, ba, conv_w, a_log, dt_bias, QD, W0N, KTT, RV, TM, ATT, GL);
  for (int it = bid; it < 512; it += nblk) ph_swa(smem, it, proj, VTb, sinks, mixed);
  xcd_barrier(xb);
  {
    const bool is512 = (nblk == 512);
    const bool scan_blk = is512 ? (bid < 256 && (bid & 7) < 2) : ((bid < 64) || (nblk <= 64));
    const bool swa_blk = is512 && bid >= 256 && (bid & 7) < 2;
    if (scan_blk) {
      if (is512) ph_dnscan(smem, (bid & 1) * 32 + (bid >> 3), QD, W0N, KTT, RV, TM, ATT, GL, obuf);
      else for (int it = bid; it < 64; it += nblk) ph_dnscan(smem, it, QD, W0N, KTT, RV, TM, ATT, GL, obuf);
    }
    if (swa_blk) { }
    else {
      const int tid = TIDX, lane = tid & 63, wv = tid >> 6;
      float* tile = (float*)(smem + wv * 16896);
      const int total = 257 * 192;
      const int T1 = is512 ? (total - 64 * 4 * 12) : ((nblk > 64) ? total : 0);
      int it, step, end;
      if (is512 && scan_blk) { const int sb = (bid & 1) * 32 + (bid >> 3); it = T1 + sb * 4 + wv; step = 64 * 4; end = total; }
      else if (is512) { const int cb = (bid >> 3) * 6 + (bid & 7) - 2; it = cb * 4 + wv; step = 384 * 4; end = T1; }
      else if (nblk > 64) { if (bid < 64) { it = 0; step = 1; end = 0; } else { it = (bid - 64) * 4 + wv; step = (nblk - 64) * 4; end = total; } }
      else { it = bid * 4 + wv; step = nblk * 4; end = total; }
      f32x4 vc[16], vn[16];
      CvtTile tc = cvt_decode(it < end ? it : 0, lane, w_gate, w_up, w_down, sw_gate, sw_up, sw_down, P.ws);
      if (it < end) cvt_load(tc, vc);
      while (it < end) {
        const int itn = it + step;
        CvtTile tn = cvt_decode(itn < end ? itn : 0, lane, w_gate, w_up, w_down, sw_gate, sw_up, sw_down, P.ws);
        if (itn < end) cvt_load(tn, vn);
        cvt_store(tile, lane, tc, vc);
#pragma unroll
        for (int i = 0; i < 16; ++i) vc[i] = vn[i];
        tc = tn; it = itn;
      }
    }
  }
  xcd_barrier(xb);
  for (int it = bid; it < NTOK / 4; it += nblk) ph_dn_post(it, obuf, proj, dn_norm_g, mixed);
  xcd_barrier(xb);
  for (int l = xloc; l < 64; l += xnl) ph_wout(smem, xcd, l, mixed, WTOUT, MIXO);
  xcd_barrier(xb);
  for (int it = bid; it < NTOK / 4; it += nblk) ph_ln1(it, xin, MIXO, ln1_g, ln1_b, x1bf, (unsigned char*)(P.ws + WS_X1F8));
  xcd_barrier(xb);
  for (int i = xloc; i < 32 * 2; i += xnl) ph_router(smem, (xcd * 32 + i / 2) * 2 + i % 2, x1bf, WTR, logits);
  xcd_barrier(xb);
  for (int it = bid; it < NTOK / 4; it += nblk) ph_route(it, logits, router_bias, cnt, list, gates);
  xcd_barrier(xb);
  int* sscan = (int*)(smem + SM_MISC);
  moe_build_prefix(cnt, sscan);
  const int ntile = sscan[32 * xcd + 31] - (xcd ? sscan[32 * xcd - 1] : 0) + NTOK / 128 / 8;
  for (int it = xloc; it < ntile; it += xnl) {
    int e, rt; moe_locate(sscan, xcd, it, e, rt);
    ph_moe(smem, e, rt, (const unsigned char*)(P.ws + WS_X1F8), x1bf, cnt, list, gates,
           (const unsigned char*)P.ws + ((e < 256) ? WS_WTG8 + (size_t)e * EFF * DM : WS_WTSG8), (const unsigned char*)P.ws + ((e < 256) ? WS_WTU8 + (size_t)e * EFF * DM : WS_WTSU8),
           (const unsigned char*)P.ws + ((e < 256) ? WS_WTD8 + (size_t)e * DM * EFF : WS_WTSD8), ybuf, outp, (unsigned char*)(P.ws + WS_DUMMY));
  }
  xcd_barrier(xb);
  for (int it = bid; it < NTOK / 4; it += nblk) ph_final(it, outp, ybuf, ln2_g, ln2_b);
}

#undef xin
#undef w_in
#undef conv_w
#undef a_log
#undef dt_bias
#undef dn_norm_g
#undef sinks
#undef w_out
#undef ln1_g
#undef ln1_b
#undef router_w
#undef router_bias
#undef w_gate
#undef w_up
#undef w_down
#undef sw_gate
#undef sw_up
#undef sw_down
#undef ln2_g
#undef ln2_b
#undef outp
#undef x1bf
#undef logits
#undef list
#undef gates
#undef cnt
#undef mixed
#undef proj
#undef ba
#undef QD
#undef W0N
#undef KTT
#undef RV
#undef TM
#undef ATT
#undef GL
#undef obuf
#undef ybuf
#undef VTb
#undef MIXO
#undef XBF
#undef WTIN
#undef WTOUT
#undef WTR
#undef barw

extern "C" void kernel_launch(void* const* d_in, const int* in_sizes, int n_in, void* d_out, int out_size, void* d_ws, size_t ws_size, hipStream_t stream) {
  static int grid_blocks = 0;
  if (!grid_blocks) {
    int dev = 0, cus = 0, per_cu = 0;
    (void)hipGetDevice(&dev);
    (void)hipDeviceGetAttribute(&cus, hipDeviceAttributeMultiprocessorCount, dev);
    (void)hipOccupancyMaxActiveBlocksPerMultiprocessor(&per_cu, mega, 256, 0);
    if (per_cu > 2) per_cu = 2;
    if (per_cu < 1) per_cu = 1;
    grid_blocks = cus * per_cu;
  }
  Params p{};
  for (int i = 0; i < 20; ++i) p.in[i] = (const float*)d_in[i];
  p.out = (float*)d_out; p.ws = (char*)d_ws;
  (void)hipMemsetAsync((char*)d_ws + WS_CTRL, 0, CNT16_OFF + NSH * NEXP * 4, stream);
  void* args[] = {&p};
  hipError_t e = hipLaunchCooperativeKernel((void*)mega, dim3(grid_blocks), dim3(256), args, 0, stream);
  if (e != hipSuccess) fprintf(stderr, "cooperative launch failed: %s (grid %d)\n", hipGetErrorString(e), grid_blocks);
}
```

```cpp
#include <hip/hip_runtime.h>
#include <hip/hip_cooperative_groups.h>
#include <stdint.h>
#include <stdio.h>
namespace cg = cooperative_groups;

typedef __attribute__((ext_vector_type(8))) short bf16x8;
typedef __attribute__((ext_vector_type(4))) float f32x4;
typedef unsigned short bf16_t;
typedef __attribute__((ext_vector_type(4))) unsigned u32x4;
typedef __attribute__((ext_vector_type(2))) unsigned u32x2;

constexpr int NTOK = 32768, SEQ = 4096, DM = 1024;
constexpr int INC = 2824, PROJW = 2816;
constexpr int OFF_DQ = 0, OFF_DK = 512, OFF_DV = 1024, OFF_SQ = 1536, OFF_SK = 2048, OFF_SV = 2176, OFF_Z = 2304;
constexpr int NEXP = 256, TOPK = 8, EFF = 256;
constexpr int NA = NTOK * TOPK;
constexpr int NSH = 16, CAPS = NTOK / NSH;
constexpr int CNT16_OFF = 32768;
constexpr float ALPHA = 1.189207115002721f;
constexpr float LN_EPS = 1e-5f, RMS_EPS = 1e-6f, L2_EPS = 1e-6f;
constexpr float SC_WG = 32.f, SC_WU = 64.f, SC_WD = 32.f, SC_H = 8.f, SC_Y = 32.f;

constexpr size_t MiB = 1024ull * 1024ull;
constexpr size_t WS_WTD8 = 0;
constexpr size_t WS_WTG8 = 64 * MiB;
constexpr size_t WS_WTU8 = 128 * MiB;
constexpr size_t WS_WTSG8 = 192 * MiB;
constexpr size_t WS_WTSU8 = WS_WTSG8 + 256 * 1024;
constexpr size_t WS_WTSD8 = WS_WTSG8 + 512 * 1024;
constexpr size_t WS_X1F8 = 200 * MiB;
constexpr size_t WS_YBUF = 384 * MiB;
constexpr size_t WS_LOGIT = 384 * MiB;
constexpr size_t WS_X1BF = 896 * MiB;
constexpr size_t WS_LIST = 960 * MiB;
constexpr size_t WS_GATES = 992 * MiB;
constexpr size_t WS_CTRL = 993 * MiB;
constexpr size_t WS_WTIN = 994 * MiB;
constexpr size_t WS_WTOUT = 1000 * MiB;
constexpr size_t WS_WTR = 1002 * MiB;
constexpr size_t WS_DUMMY = 1005 * MiB;
constexpr size_t WS_PROJ = 384 * MiB;
constexpr size_t WS_BA = 560 * MiB;
constexpr size_t WS_QD = 561 * MiB;
constexpr size_t WS_W0N = 593 * MiB;
constexpr size_t WS_KTT = 625 * MiB;
constexpr size_t WS_RV = 657 * MiB;
constexpr size_t WS_TM = 689 * MiB;
constexpr size_t WS_ATT = 705 * MiB;
constexpr size_t WS_GL = 721 * MiB;
constexpr size_t WS_O = 722 * MiB;
constexpr size_t WS_VT = 786 * MiB;
constexpr size_t WS_MIXED = 794 * MiB;
constexpr size_t WS_XBF = 640 * MiB;

__device__ __forceinline__ int opaque_tid() { int t = threadIdx.x; asm volatile("" : "+v"(t)); return t; }
#define TIDX opaque_tid()
typedef __attribute__((ext_vector_type(2))) __bf16 hwbf16x2;
typedef __attribute__((ext_vector_type(2))) float hwf32x2;
__device__ __forceinline__ unsigned pack2(float lo, float hi) {
  hwf32x2 f = {lo, hi};
  return __builtin_bit_cast(unsigned, __builtin_convertvector(f, hwbf16x2));
}
__device__ __forceinline__ unsigned f2bf(float f) { return pack2(f, 0.f) & 0xffffu; }
__device__ __forceinline__ float bf2f(unsigned h) { return __uint_as_float(h << 16); }
__device__ __forceinline__ float bflo(unsigned w) { return __uint_as_float(w << 16); }
__device__ __forceinline__ float bfhi(unsigned w) { return __uint_as_float(w & 0xffff0000u); }
__device__ __forceinline__ float siluf(float x) { return x * __builtin_amdgcn_rcpf(1.f + __expf(-x)); }
__device__ __forceinline__ float sigmoidf(float x) { return __builtin_amdgcn_rcpf(1.f + __expf(-x)); }
#define DPP_ADD_(v, ctrl, rmask) v += __builtin_bit_cast(float, __builtin_amdgcn_update_dpp(0, __builtin_bit_cast(int, v), ctrl, rmask, 0xf, false))
__device__ __forceinline__ float wave_sum(float v) {
  DPP_ADD_(v, 0xB1, 0xf);
  DPP_ADD_(v, 0x4E, 0xf);
  DPP_ADD_(v, 0x141, 0xf);
  DPP_ADD_(v, 0x140, 0xf);
  DPP_ADD_(v, 0x142, 0xa);
  DPP_ADD_(v, 0x143, 0xc);
  return __builtin_bit_cast(float, __builtin_amdgcn_readlane(__builtin_bit_cast(int, v), 63));
}

template <int SEGDIV>
struct LdRowBF16T {
  const char* p[4]; size_t seghi, seglo; int tid16;
  template <class F> __device__ __forceinline__ void init(F rowptr, size_t hi, size_t lo = 0) {
    const int tid = TIDX; const int slot = tid & 7, row0 = tid >> 3; seghi = hi; seglo = lo; tid16 = tid * 16;
#pragma unroll
    for (int i = 0; i < 4; ++i) p[i] = (const char*)rowptr(row0 + i * 32) + ((slot ^ (row0 & 7)) << 4);
  }
  __device__ __forceinline__ void issue(int seg, int kk, unsigned char* lds) {
    const size_t off = (size_t)(seg / SEGDIV) * seghi + (size_t)(seg % SEGDIV) * seglo + (size_t)kk * 128;
#pragma unroll
    for (int i = 0; i < 4; ++i)
      __builtin_amdgcn_global_load_lds((const unsigned*)(p[i] + off), (__attribute__((address_space(3))) unsigned*)(lds + tid16 + i * 4096), 16, 0, 0);
  }
};
typedef LdRowBF16T<1> LdRowBF16;
__device__ __forceinline__ void gemm_kstep(const unsigned char* sA, const unsigned char* sB, f32x4 (&acc)[4][4], int wr, int wc, int fr, int fq) {
#pragma unroll
  for (int ks = 0; ks < 2; ++ks) {
    bf16x8 a[4], b[4];
#pragma unroll
    for (int m = 0; m < 4; ++m) {
      const int row = wr * 64 + m * 16 + fr;
      a[m] = *(const bf16x8*)(sA + row * 128 + (((ks * 4 + fq) ^ (row & 7)) << 4));
    }
#pragma unroll
    for (int n = 0; n < 4; ++n) {
      const int row = wc * 64 + n * 16 + fr;
      b[n] = *(const bf16x8*)(sB + row * 128 + (((ks * 4 + fq) ^ (row & 7)) << 4));
    }
    __builtin_amdgcn_s_setprio(1);
#pragma unroll
    for (int m = 0; m < 4; ++m)
#pragma unroll
      for (int n = 0; n < 4; ++n) acc[m][n] = __builtin_amdgcn_mfma_f32_16x16x32_bf16(b[n], a[m], acc[m][n], 0, 0, 0);
    __builtin_amdgcn_s_setprio(0);
  }
}
template <int KPER, class AL, class BL, class Epi>
__device__ __forceinline__ void gemm_stream(unsigned char* smem, AL& al, BL& bl, int nseg, Epi epi) {
  const int tid = TIDX, lane = tid & 63, wid = tid >> 6, wr = wid >> 1, wc = wid & 1, fr = lane & 15, fq = lane >> 4;
  const int total = nseg * KPER;
  f32x4 acc[4][4];
  al.issue(0, 0, smem); bl.issue(0, 0, smem + 16384);
  asm volatile("s_waitcnt vmcnt(0)" ::: "memory");
  __syncthreads();
  for (int j = 0; j < total; ++j) {
    unsigned char* cur = smem + (j & 1) * 32768; unsigned char* nxt = smem + ((j & 1) ^ 1) * 32768;
    if (j + 1 < total) { al.issue((j + 1) / KPER, (j + 1) % KPER, nxt); bl.issue((j + 1) / KPER, (j + 1) % KPER, nxt + 16384); }
    if (j % KPER == 0) {
#pragma unroll
      for (int m = 0; m < 4; ++m)
#pragma unroll
        for (int n = 0; n < 4; ++n) acc[m][n] = (f32x4){0.f, 0.f, 0.f, 0.f};
    }
    gemm_kstep(cur, cur + 16384, acc, wr, wc, fr, fq);
    asm volatile("s_waitcnt vmcnt(0)" ::: "memory");
    __syncthreads();
    if ((j + 1) % KPER == 0) epi((j + 1) / KPER - 1, acc, cur);
  }
}

template <class RowDst>
__device__ __forceinline__ void store_tile_bf16(unsigned char* fbuf, const f32x4 (&acc)[4][4], RowDst rowdst) {
  const int tid = TIDX, lane = tid & 63, wid = tid >> 6, wr = wid >> 1, wc = wid & 1, fr = lane & 15, fq = lane >> 4;
#pragma unroll
  for (int m = 0; m < 4; ++m) {
    const int row = wr * 64 + m * 16 + fr;
#pragma unroll
    for (int n = 0; n < 4; ++n) {
      const int col = wc * 64 + n * 16 + fq * 4;
      u32x2 w; w[0] = pack2(acc[m][n][0], acc[m][n][1]); w[1] = pack2(acc[m][n][2], acc[m][n][3]);
      *(u32x2*)(fbuf + row * 256 + (((col >> 3) ^ (row & 15)) << 4) + ((col >> 2) & 1) * 8) = w;
    }
  }
  __syncthreads();
#pragma unroll
  for (int i = 0; i < 8; ++i) {
    const int q = tid + 256 * i, row = q >> 4, ch = q & 15;
    *(u32x4*)(rowdst(row) + ch * 8) = *(const u32x4*)(fbuf + row * 256 + ((ch ^ (row & 15)) << 4));
  }
  __syncthreads();
}

template <class RowDst>
__device__ __forceinline__ void store_tile_bf16_T(unsigned char* fbuf, const f32x4 (&acc)[4][4], RowDst rowdst) {
  const int tid = TIDX, lane = tid & 63, wid = tid >> 6, wr = wid >> 1, wc = wid & 1, fr = lane & 15, fq = lane >> 4;
#pragma unroll
  for (int m = 0; m < 4; ++m) {
    const int t = wr * 64 + m * 16 + fr;
#pragma unroll
    for (int n = 0; n < 4; ++n)
#pragma unroll
      for (int r = 0; r < 4; ++r) {
        const int c = wc * 64 + n * 16 + fq * 4 + r;
        *(unsigned short*)(fbuf + c * 256 + ((((t >> 3) ^ (c & 15))) << 4) + (t & 7) * 2) = (unsigned short)f2bf(acc[m][n][r]);
      }
  }
  __syncthreads();
#pragma unroll
  for (int i = 0; i < 8; ++i) {
    const int q = tid + 256 * i, row = q >> 4, ch = q & 15;
    *(u32x4*)(rowdst(row) + ch * 8) = *(const u32x4*)(fbuf + row * 256 + ((ch ^ (row & 15)) << 4));
  }
  __syncthreads();
}

#define GEMM_IDS const int tid = TIDX, lane = tid & 63, wid = tid >> 6, wr = wid >> 1, wc = wid & 1, fr = lane & 15, fq = lane >> 4; (void)tid; (void)lane;

struct Params {
  const float* in[20];
  float* out;
  char* ws;
};

constexpr int SMEM_BYTES = 69632;
constexpr int SM_MISC = 65536;

__device__ __forceinline__ void ph_cvt_x(int item, const float* __restrict__ x, bf16_t* __restrict__ xbf) {
  const int tid = TIDX;
  const size_t base = (size_t)item * 4096 + (size_t)tid * 4;
#pragma unroll
  for (int i = 0; i < 4; ++i) {
    const f32x4 v = *(const f32x4*)(x + base + (size_t)i * 1024);
    u32x2 w; w[0] = pack2(v[0], v[1]); w[1] = pack2(v[2], v[3]);
    *(u32x2*)(xbf + base + (size_t)i * 1024) = w;
  }
}
__device__ __forceinline__ void ph_cvt_wt(unsigned char* smem, int kt, int nt, const float* __restrict__ W, int K, int N, bf16_t* __restrict__ WT, bool perm = false) {
  float* tile = (float*)smem;
  const int tid = TIDX;
  const int k0 = kt * 64, n0 = nt * 64;
  __syncthreads();
#pragma unroll
  for (int i = 0; i < 4; ++i) {
    const int k = (tid >> 4) + 16 * i, n = 4 * (tid & 15);
    f32x4 v = (f32x4){0.f, 0.f, 0.f, 0.f};
    if (n0 + n < N) v = *(const f32x4*)(W + (size_t)(k0 + k) * N + n0 + n);
    tile[k * 65 + n + 0] = v[0]; tile[k * 65 + n + 1] = v[1]; tile[k * 65 + n + 2] = v[2]; tile[k * 65 + n + 3] = v[3];
  }
  __syncthreads();
  const int n = tid >> 2, kq = tid & 3;
  u32x4 w0, w1;
#pragma unroll
  for (int j = 0; j < 4; ++j) {
    w0[j] = pack2(tile[(kq * 16 + 2 * j) * 65 + n], tile[(kq * 16 + 2 * j + 1) * 65 + n]);
    w1[j] = pack2(tile[(kq * 16 + 8 + 2 * j) * 65 + n], tile[(kq * 16 + 8 + 2 * j + 1) * 65 + n]);
  }
  if (!perm) {
    bf16_t* dst = WT + (size_t)(n0 + n) * K + k0 + kq * 16;
    *(u32x4*)dst = w0; *(u32x4*)(dst + 8) = w1;
  } else {
    const int blk = kq >> 1, hi = kq & 1;
    bf16_t* dst = WT + (size_t)(n0 + n) * K + k0 + blk * 32 + 4 * hi;
    u32x2 a; a[0] = w0[0]; a[1] = w0[1]; *(u32x2*)(dst + 0) = a;
    a[0] = w0[2]; a[1] = w0[3]; *(u32x2*)(dst + 8) = a;
    a[0] = w1[0]; a[1] = w1[1]; *(u32x2*)(dst + 16) = a;
    a[0] = w1[2]; a[1] = w1[3]; *(u32x2*)(dst + 24) = a;
  }
}

struct CvtTile { const float* src; unsigned char* dst; int ldn; int K; int perm; float scale; };
__device__ __forceinline__ CvtTile cvt_decode(int it, int lane, const float* __restrict__ w_gate, const float* __restrict__ w_up, const float* __restrict__ w_down,
                                              const float* __restrict__ sw_gate, const float* __restrict__ sw_up, const float* __restrict__ sw_down, char* ws) {
  const int e = it / 192, j = it % 192;
  const float* W; unsigned char* WT; int K, N, kt, nt; float sc;
  if (j < 64) { W = (e < 256) ? w_gate + (size_t)e * DM * EFF : sw_gate; WT = (unsigned char*)ws + ((e < 256) ? WS_WTG8 + (size_t)e * EFF * DM : WS_WTSG8); K = DM; N = EFF; nt = j & 7; kt = j >> 3; sc = SC_WG; }
  else if (j < 128) { W = (e < 256) ? w_up + (size_t)e * DM * EFF : sw_up; WT = (unsigned char*)ws + ((e < 256) ? WS_WTU8 + (size_t)e * EFF * DM : WS_WTSU8); K = DM; N = EFF; nt = (j - 64) & 7; kt = (j - 64) >> 3; sc = SC_WU; }
  else { W = (e < 256) ? w_down + (size_t)e * EFF * DM : sw_down; WT = (unsigned char*)ws + ((e < 256) ? WS_WTD8 + (size_t)e * DM * EFF : WS_WTSD8); K = EFF; N = DM; nt = (j - 128) & 31; kt = (j - 128) >> 5; sc = SC_WD; }
  CvtTile t;
  t.src = W + (size_t)(kt * 128 + (lane >> 3)) * N + nt * 32 + 4 * (lane & 7);
  t.dst = WT + (size_t)(nt * 32) * K + kt * 128;
  t.ldn = 8 * N; t.K = K; t.scale = sc;
  t.perm = (j >= 128) ? 1 : 0;
  return t;
}
__device__ __forceinline__ void cvt_load(const CvtTile& t, f32x4 (&v)[16]) {
#pragma unroll
  for (int i = 0; i < 16; ++i) v[i] = *(const f32x4*)(t.src + (size_t)i * t.ldn);
}
__device__ __forceinline__ void cvt_store(float* tile  , int lane, const CvtTile& t, const f32x4 (&v)[16]) {
#pragma unroll
  for (int i = 0; i < 16; ++i) {
    float* p = tile + ((lane >> 3) + 8 * i) * 33 + 4 * (lane & 7);
    p[0] = v[i][0]; p[1] = v[i][1]; p[2] = v[i][2]; p[3] = v[i][3];
  }
  const int c = lane & 7;
  int kk[16];
#pragma unroll
  for (int tt = 0; tt < 16; ++tt)
    kk[tt] = t.perm ? (64 * (c >> 2) + 16 * (tt >> 2) + 4 * (c & 3) + (tt & 3)) : (16 * c + tt);
  const float sc = t.scale;
#pragma unroll
  for (int i = 0; i < 4; ++i) {
    const int n = (lane >> 3) + 8 * i;
    u32x4 w;
#pragma unroll
    for (int d = 0; d < 4; ++d) {
      int pk = 0;
      pk = __builtin_amdgcn_cvt_pk_fp8_f32(tile[kk[4 * d + 0] * 33 + n] * sc, tile[kk[4 * d + 1] * 33 + n] * sc, pk, false);
      pk = __builtin_amdgcn_cvt_pk_fp8_f32(tile[kk[4 * d + 2] * 33 + n] * sc, tile[kk[4 * d + 3] * 33 + n] * sc, pk, true);
      w[d] = (unsigned)pk;
    }
    *(u32x4*)(t.dst + (size_t)n * t.K + 16 * c) = w;
  }
}

__device__ __forceinline__ void ph_proj(unsigned char* smem, int xcd, int l, const bf16_t* __restrict__ xbf, const bf16_t* __restrict__ wt, bf16_t* __restrict__ proj, float* __restrict__ ba, bf16_t* __restrict__ vt) {
  const int mi = l >> 3, ni = l & 7;
  LdRowBF16T<3> al; al.init([&](int r) { return xbf + (size_t)((xcd * 32 + mi) * 128 + r) * DM; }, (size_t)8 * 128 * DM * 2, 0);
  LdRowBF16T<3> bl; bl.init([&](int r) { return wt + (size_t)(ni * 128 + r) * DM; }, 0, (size_t)8 * 128 * DM * 2);
  gemm_stream<16>(smem, al, bl, 12, [&](int seg, f32x4 (&acc)[4][4], unsigned char* fbuf) {
    GEMM_IDS
    const int nt = (seg % 3) * 8 + ni;
    if (nt < 23) {
      const int m0 = (xcd * 32 + (seg / 3) * 8 + mi) * 128, n0 = nt * 128;
      if (n0 + 128 <= PROJW) store_tile_bf16(fbuf, acc, [&](int r) { return proj + (size_t)(m0 + r) * PROJW + n0; });
      else
#pragma unroll
      for (int m = 0; m < 4; ++m)
#pragma unroll
        for (int n = 0; n < 4; ++n) {
          const int row = m0 + wr * 64 + m * 16 + fr, col = n0 + wc * 64 + n * 16 + fq * 4;
          if (col < PROJW) {
            u32x2 w; w[0] = pack2(acc[m][n][0], acc[m][n][1]); w[1] = pack2(acc[m][n][2], acc[m][n][3]);
            *(u32x2*)(proj + (size_t)row * PROJW + col) = w;
          } else if (col < INC) {
            *(f32x4*)(ba + (size_t)row * 8 + (col - PROJW)) = acc[m][n];
          }
        }
      if (n0 == OFF_SV) {
        const int bb = m0 / SEQ, t0_ = m0 % SEQ;
        store_tile_bf16_T(fbuf, acc, [&](int c) { return vt + ((size_t)(bb * 128 + c)) * SEQ + t0_; });
      }
    }
  });
}

__device__ __forceinline__ bf16x8 pack8(f32x4 a, f32x4 b) {
  union { bf16x8 v; unsigned u[4]; } x;
  x.u[0] = pack2(a[0], a[1]); x.u[1] = pack2(a[2], a[3]); x.u[2] = pack2(b[0], b[1]); x.u[3] = pack2(b[2], b[3]);
  return x.v;
}
__device__ __forceinline__ void ph_dnchunk(unsigned char* smem, int item, const bf16_t* __restrict__ proj, const float* __restrict__ ba, const float* __restrict__ conv_w,
                                           const float* __restrict__ a_log, const float* __restrict__ dt_bias,
                                           bf16_t* __restrict__ QD, bf16_t* __restrict__ W0N, bf16_t* __restrict__ KTT, bf16_t* __restrict__ RV,
                                           bf16_t* __restrict__ TM, bf16_t* __restrict__ ATT, float* __restrict__ GL) {
  const int tid = TIDX, lane = tid & 63, w = tid >> 6, fr = lane & 15, fq = lane >> 4;
  const int n = item & 63, h = (item >> 6) & 3, b = item >> 8;
  const int t0 = n * 64; const size_t row0 = (size_t)b * SEQ + t0;
  unsigned char* qs = smem; unsigned char* ks = smem + 16384; float* AT = (float*)(smem + 32768);
  const float scale = 0.08838834764831845f;
  float bL, gcL;
  {
    const float* bap = ba + (row0 + lane) * 8;
    bL = sigmoidf(bap[h]);
    const float xx = bap[4 + h] + dt_bias[h];
    const float sp = fmaxf(xx, 0.f) + log1pf(__expf(-fabsf(xx)));
    float gg = -__expf(a_log[h]) * sp;
#pragma unroll
    for (int o = 1; o < 64; o <<= 1) { const float v = __shfl_up(gg, o); if (lane >= o) gg += v; }
    gcL = gg;
  }
  {
    const int d = 2 * lane;
    float cw[3][4][2];
#pragma unroll
    for (int mx = 0; mx < 3; ++mx)
#pragma unroll
      for (int j = 0; j < 4; ++j) {
        const float2 c2 = *(const float2*)(conv_w + j * 1536 + mx * 512 + h * 128 + d);
        cw[mx][j][0] = c2.x; cw[mx][j][1] = c2.y;
      }
    const bf16_t* pbase = proj + (row0 + 16 * w) * PROJW + h * 128 + d;
    unsigned raw[3][19];
#pragma unroll
    for (int j = 0; j < 19; ++j) {
      const bool ok = (t0 + 16 * w - 3 + j) >= 0;
#pragma unroll
      for (int mx = 0; mx < 3; ++mx) {
        unsigned u = 0;
        if (ok) u = *(const unsigned*)(pbase + (ptrdiff_t)(j - 3) * PROJW + mx * 512);
        raw[mx][j] = u;
      }
    }
#pragma unroll
    for (int i = 0; i < 16; ++i) {
      float s[3][2];
#pragma unroll
      for (int mx = 0; mx < 3; ++mx) {
        float y0 = 0.f, y1 = 0.f;
#pragma unroll
        for (int j = 0; j < 4; ++j) { y0 += cw[mx][j][0] * bflo(raw[mx][i + j]); y1 += cw[mx][j][1] * bfhi(raw[mx][i + j]); }
        s[mx][0] = siluf(y0); s[mx][1] = siluf(y1);
      }
      const int row = 16 * w + i;
      const float rq = rsqrtf(wave_sum(s[0][0] * s[0][0] + s[0][1] * s[0][1]) + L2_EPS);
      const float rk = rsqrtf(wave_sum(s[1][0] * s[1][0] + s[1][1] * s[1][1]) + L2_EPS);
      const int off = row * 256 + ((((lane >> 2) ^ (row & 15))) << 4) + (lane & 3) * 4;
      *(unsigned*)(qs + off) = pack2(s[0][0] * rq, s[0][1] * rq);
      *(unsigned*)(ks + off) = pack2(s[1][0] * rk, s[1][1] * rk);
      const float bi = __shfl(bL, row);
      *(unsigned*)(RV + ((size_t)item * 64 + row) * 128 + d) = pack2(bi * s[2][0], bi * s[2][1]);
    }
  }
  __syncthreads();
  {
    f32x4 aKK[4], aQK[4];
#pragma unroll
    for (int nt = 0; nt < 4; ++nt) { aKK[nt] = (f32x4){0.f, 0.f, 0.f, 0.f}; aQK[nt] = (f32x4){0.f, 0.f, 0.f, 0.f}; }
#pragma unroll
    for (int k4 = 0; k4 < 4; ++k4) {
      const int arow = 16 * w + fr;
      const bf16x8 aq = *(const bf16x8*)(qs + arow * 256 + ((((k4 * 4 + fq) ^ (arow & 15))) << 4));
      const bf16x8 ak = *(const bf16x8*)(ks + arow * 256 + ((((k4 * 4 + fq) ^ (arow & 15))) << 4));
#pragma unroll
      for (int nt = 0; nt < 4; ++nt) {
        const int brow = 16 * nt + fr;
        const bf16x8 bk = *(const bf16x8*)(ks + brow * 256 + ((((k4 * 4 + fq) ^ (brow & 15))) << 4));
        aKK[nt] = __builtin_amdgcn_mfma_f32_16x16x32_bf16(ak, bk, aKK[nt], 0, 0, 0);
        aQK[nt] = __builtin_amdgcn_mfma_f32_16x16x32_bf16(bk, aq, aQK[nt], 0, 0, 0);
      }
    }
    float gci[4], bi[4];
#pragma unroll
    for (int r = 0; r < 4; ++r) { gci[r] = __shfl(gcL, 16 * w + 4 * fq + r); bi[r] = __shfl(bL, 16 * w + 4 * fq + r); }
    const float gci2 = __shfl(gcL, 16 * w + fr);
#pragma unroll
    for (int nt = 0; nt < 4; ++nt) {
      const int j = 16 * nt + fr;
      const float gcj = __shfl(gcL, j);
      float av[4], at[4];
#pragma unroll
      for (int r = 0; r < 4; ++r) {
        const int i = 16 * w + 4 * fq + r;
        const float dec = (j <= i) ? __expf(gci[r] - gcj) : 0.f;
        av[r] = (j < i) ? bi[r] * aKK[nt][r] * dec : 0.f;
        const int i2 = 16 * w + fr, j2 = 16 * nt + 4 * fq + r;
        const float gcj2 = __shfl(gcL, j2);
        const float dec2 = (j2 <= i2) ? __expf(gci2 - gcj2) : 0.f;
        at[r] = aQK[nt][r] * scale * dec2;
      }
      *(float4*)(AT + j * 68 + 16 * w + 4 * fq) = make_float4(av[0], av[1], av[2], av[3]);
      u32x2 wv; wv[0] = pack2(at[0], at[1]); wv[1] = pack2(at[2], at[3]);
      *(u32x2*)(ATT + ((size_t)item * 64 + 16 * w + fr) * 64 + 32 * (nt >> 1) + 8 * fq + 4 * (nt & 1)) = wv;
    }
  }
  __syncthreads();
  if (w == 0) {
    float Tr[64];
    int ln = lane; asm volatile("" : "+v"(ln));
#pragma unroll
    for (int j = 0; j < 64; ++j) Tr[j] = 0.f;
    f32x4 cur[16], nxt[16];
#pragma unroll
    for (int j4 = 0; j4 < 16; ++j4) nxt[j4] = (f32x4){0.f, 0.f, 0.f, 0.f};
#pragma unroll
    for (int j4 = 15; j4 >= 16; --j4) cur[j4] = *(const f32x4*)(AT + 63 * 68 + j4 * 4);
#pragma unroll
    for (int c = 63; c >= 0; --c) {
      if (c > 0) {
#pragma unroll
        for (int j4 = 15; j4 >= c / 4; --j4) nxt[j4] = *(const f32x4*)(AT + (c - 1) * 68 + j4 * 4);
      }
      float a0 = 0.f, a1 = 0.f, a2 = 0.f, a3 = 0.f;
#pragma unroll
      for (int j4 = 15; j4 >= (c + 1) / 4; --j4) {
        asm volatile("v_fmac_f32 %0, %1, %2" : "+v"(a0) : "v"(Tr[4 * j4 + 0]), "v"(cur[j4][0]));
        asm volatile("v_fmac_f32 %0, %1, %2" : "+v"(a1) : "v"(Tr[4 * j4 + 1]), "v"(cur[j4][1]));
        asm volatile("v_fmac_f32 %0, %1, %2" : "+v"(a2) : "v"(Tr[4 * j4 + 2]), "v"(cur[j4][2]));
        asm volatile("v_fmac_f32 %0, %1, %2" : "+v"(a3) : "v"(Tr[4 * j4 + 3]), "v"(cur[j4][3]));
      }
      Tr[c] = ((ln == c) ? 1.f : 0.f) - ((a0 + a1) + (a2 + a3));
#pragma unroll
      for (int j4 = 0; j4 < 16; ++j4) cur[j4] = nxt[j4];
    }
    u32x4* tp = (u32x4*)(TM + ((size_t)item * 64 + lane) * 64);
#pragma unroll
    for (int oc = 0; oc < 8; ++oc) {
      const int k0 = 32 * (oc >> 2) + 4 * (oc & 3);
      u32x4 v;
      v[0] = pack2(Tr[k0 + 0], Tr[k0 + 1]); v[1] = pack2(Tr[k0 + 2], Tr[k0 + 3]);
      v[2] = pack2(Tr[k0 + 16], Tr[k0 + 17]); v[3] = pack2(Tr[k0 + 18], Tr[k0 + 19]);
      tp[oc] = v;
    }
  } else {
    const float gclast = __shfl(gcL, 63);
    if (tid == 64) GL[item] = __expf(gclast);
#pragma unroll 1
    for (int it = 0; it < 16; ++it) {
      const int idx = (tid - 64) + it * 192;
      const int mtx = idx >> 10, rem = idx & 1023;
      if (mtx < 2) {
        const int i = rem >> 4, oc = rem & 15;
        const float gi = __shfl(gcL, i), bi = __shfl(bL, i);
        const float f = (mtx == 0) ? scale * __expf(gi) : -bi * __expf(gi);
        const unsigned char* st = (mtx == 0) ? qs : ks;
        const int d0 = 32 * (oc >> 2) + 4 * (oc & 3);
        const uint2 lo = *(const uint2*)(st + i * 256 + ((((d0 >> 3) ^ (i & 15))) << 4) + (d0 & 7) * 2);
        const uint2 hi = *(const uint2*)(st + i * 256 + (((((d0 + 16) >> 3) ^ (i & 15))) << 4) + (d0 & 7) * 2);
        u32x4 v;
        v[0] = pack2(bflo(lo.x) * f, bfhi(lo.x) * f); v[1] = pack2(bflo(lo.y) * f, bfhi(lo.y) * f);
        v[2] = pack2(bflo(hi.x) * f, bfhi(hi.x) * f); v[3] = pack2(bflo(hi.y) * f, bfhi(hi.y) * f);
        bf16_t* dst = ((mtx == 0) ? QD : W0N) + ((size_t)item * 64 + i) * 128 + 8 * oc;
        *(u32x4*)dst = v;
      } else {
        const int d = rem & 127, oc = rem >> 7;
        const int j0 = 32 * (oc >> 2) + 4 * (oc & 3);
        float val[8];
#pragma unroll
        for (int e = 0; e < 8; ++e) {
          const int j = j0 + (e & 3) + ((e >> 2) << 4);
          const float f = __expf(gclast - __shfl(gcL, j));
          const unsigned short raw = *(const unsigned short*)(ks + j * 256 + ((((d >> 3) ^ (j & 15))) << 4) + (d & 7) * 2);
          val[e] = bf2f(raw) * f;
        }
        u32x4 v;
        v[0] = pack2(val[0], val[1]); v[1] = pack2(val[2], val[3]); v[2] = pack2(val[4], val[5]); v[3] = pack2(val[6], val[7]);
        *(u32x4*)(KTT + ((size_t)item * 128 + d) * 64 + 8 * oc) = v;
      }
    }
  }
  __syncthreads();
}

__device__ __forceinline__ void ph_dnscan(unsigned char* smem, int item, const bf16_t* __restrict__ QDp, const bf16_t* __restrict__ W0Np, const bf16_t* __restrict__ KTTp,
                                          const bf16_t* __restrict__ RVp, const bf16_t* __restrict__ TMp, const bf16_t* __restrict__ ATTp, const float* __restrict__ GLp,
                                          float* __restrict__ op) {
  const int tid = TIDX, lane = tid & 63, w = tid >> 6, fr = lane & 15, fq = lane >> 4;
  const int bh = item >> 1, half = item & 1, b = bh >> 2, h = bh & 3;
  const int vcol0 = (half * 4 + w) * 16;
  unsigned char* sW0 = smem; unsigned char* sQD = smem + 16384; unsigned char* sKT = smem + 32768; unsigned char* sT = smem + 49152; unsigned char* sAT = smem + 57344;
  f32x4 S[8];
#pragma unroll
  for (int t = 0; t < 8; ++t) S[t] = (f32x4){0.f, 0.f, 0.f, 0.f};
  u32x4 pfA[8], pfB[8]; unsigned short rvp[16];
#define DN_LOAD_A(nn_) do { \
    const size_t ci = (size_t)bh * 64 + (nn_); \
    _Pragma("unroll") for (int i = 0; i < 4; ++i) pfA[i] = *(const u32x4*)((const char*)W0Np + ci * 16384 + (size_t)(tid + 256 * i) * 16); \
    _Pragma("unroll") for (int i = 0; i < 4; ++i) pfA[4 + i] = *(const u32x4*)((const char*)QDp + ci * 16384 + (size_t)(tid + 256 * i) * 16); \
    _Pragma("unroll") for (int mt = 0; mt < 4; ++mt) \
      _Pragma("unroll") for (int r = 0; r < 4; ++r) rvp[mt * 4 + r] = RVp[(ci * 64 + 16 * mt + 4 * fq + r) * 128 + vcol0 + fr]; \
  } while (0)
#define DN_STORE_A() do { \
    _Pragma("unroll") for (int i = 0; i < 4; ++i) { const int q = tid + 256 * i, row = q >> 4, ch = q & 15; *(u32x4*)(sW0 + row * 256 + ((ch ^ (row & 15)) << 4)) = pfA[i]; } \
    _Pragma("unroll") for (int i = 0; i < 4; ++i) { const int q = tid + 256 * i, row = q >> 4, ch = q & 15; *(u32x4*)(sQD + row * 256 + ((ch ^ (row & 15)) << 4)) = pfA[4 + i]; } \
  } while (0)
#define DN_LOAD_B(nn_) do { \
    const size_t ci = (size_t)bh * 64 + (nn_); \
    _Pragma("unroll") for (int i = 0; i < 4; ++i) pfB[i] = *(const u32x4*)((const char*)KTTp + ci * 16384 + (size_t)(tid + 256 * i) * 16); \
    _Pragma("unroll") for (int i = 0; i < 2; ++i) pfB[4 + i] = *(const u32x4*)((const char*)TMp + ci * 8192 + (size_t)(tid + 256 * i) * 16); \
    _Pragma("unroll") for (int i = 0; i < 2; ++i) pfB[6 + i] = *(const u32x4*)((const char*)ATTp + ci * 8192 + (size_t)(tid + 256 * i) * 16); \
  } while (0)
#define DN_STORE_B() do { \
    _Pragma("unroll") for (int i = 0; i < 4; ++i) { const int q = tid + 256 * i, row = q >> 3, ch = q & 7; *(u32x4*)(sKT + row * 128 + ((ch ^ (row & 7)) << 4)) = pfB[i]; } \
    _Pragma("unroll") for (int i = 0; i < 2; ++i) { const int q = tid + 256 * i, row = q >> 3, ch = q & 7; *(u32x4*)(sT + row * 128 + ((ch ^ (row & 7)) << 4)) = pfB[4 + i]; } \
    _Pragma("unroll") for (int i = 0; i < 2; ++i) { const int q = tid + 256 * i, row = q >> 3, ch = q & 7; *(u32x4*)(sAT + row * 128 + ((ch ^ (row & 7)) << 4)) = pfB[6 + i]; } \
  } while (0)
#define DN_ZINIT() do { _Pragma("unroll") for (int mt = 0; mt < 4; ++mt) Z[mt] = (f32x4){bf2f(rvp[mt * 4 + 0]), bf2f(rvp[mt * 4 + 1]), bf2f(rvp[mt * 4 + 2]), bf2f(rvp[mt * 4 + 3])}; } while (0)
  __syncthreads();
  f32x4 Z[4];
  DN_LOAD_A(0);
  DN_LOAD_B(0);
  DN_STORE_A();
  DN_ZINIT();
  DN_LOAD_A(1);
  for (int nn = 0; nn < 64; ++nn) {
    const float gl = GLp[(size_t)bh * 64 + nn];
    __syncthreads();
    bf16x8 Sb[4];
#pragma unroll
    for (int k4 = 0; k4 < 4; ++k4) Sb[k4] = pack8(S[2 * k4], S[2 * k4 + 1]);
    f32x4 O[4];
#pragma unroll
    for (int mt = 0; mt < 4; ++mt) {
      O[mt] = (f32x4){0.f, 0.f, 0.f, 0.f};
      const int row = 16 * mt + fr;
#pragma unroll
      for (int k4 = 0; k4 < 4; ++k4) {
        const int off = row * 256 + ((((k4 * 4 + fq) ^ fr)) << 4);
        const bf16x8 aw = *(const bf16x8*)(sW0 + off);
        const bf16x8 aq = *(const bf16x8*)(sQD + off);
        Z[mt] = __builtin_amdgcn_mfma_f32_16x16x32_bf16(aw, Sb[k4], Z[mt], 0, 0, 0);
        O[mt] = __builtin_amdgcn_mfma_f32_16x16x32_bf16(Sb[k4], aq, O[mt], 0, 0, 0);
      }
    }
    bf16x8 Zb[2];
    Zb[0] = pack8(Z[0], Z[1]); Zb[1] = pack8(Z[2], Z[3]);
    DN_STORE_B();
    if (nn + 1 < 64) DN_LOAD_B(nn + 1);
    __syncthreads();
    f32x4 Vn[4];
#pragma unroll
    for (int mt = 0; mt < 4; ++mt) {
      Vn[mt] = (f32x4){0.f, 0.f, 0.f, 0.f};
      const int row = 16 * mt + fr;
#pragma unroll
      for (int s = 0; s < 2; ++s) {
        if (s <= (mt >> 1)) {
          const bf16x8 at = *(const bf16x8*)(sT + row * 128 + ((((s * 4 + fq) ^ (row & 7))) << 4));
          Vn[mt] = __builtin_amdgcn_mfma_f32_16x16x32_bf16(at, Zb[s], Vn[mt], 0, 0, 0);
        }
      }
    }
    bf16x8 Vb[2];
    Vb[0] = pack8(Vn[0], Vn[1]); Vb[1] = pack8(Vn[2], Vn[3]);
#pragma unroll
    for (int mt = 0; mt < 4; ++mt) {
      const int row = 16 * mt + fr;
#pragma unroll
      for (int s = 0; s < 2; ++s) {
        if (s <= (mt >> 1)) {
          const bf16x8 aa = *(const bf16x8*)(sAT + row * 128 + ((((s * 4 + fq) ^ (row & 7))) << 4));
          O[mt] = __builtin_amdgcn_mfma_f32_16x16x32_bf16(Vb[s], aa, O[mt], 0, 0, 0);
        }
      }
      *(f32x4*)(op + ((size_t)b * SEQ + nn * 64 + 16 * mt + fr) * 512 + h * 128 + vcol0 + 4 * fq) = O[mt];
    }
#pragma unroll
    for (int t = 0; t < 8; ++t) {
      S[t] = S[t] * gl;
      const int row = 16 * t + fr;
#pragma unroll
      for (int s = 0; s < 2; ++s) {
        const bf16x8 ak = *(const bf16x8*)(sKT + row * 128 + ((((s * 4 + fq) ^ (row & 7))) << 4));
        S[t] = __builtin_amdgcn_mfma_f32_16x16x32_bf16(ak, Vb[s], S[t], 0, 0, 0);
      }
    }
    if (nn + 1 < 64) {
      DN_STORE_A();
      DN_ZINIT();
      if (nn + 2 < 64) DN_LOAD_A(nn + 2);
    }
  }
  __syncthreads();
#undef DN_ZINIT
#undef DN_LOAD_A
#undef DN_STORE_A
#undef DN_LOAD_B
#undef DN_STORE_B
}

__device__ __forceinline__ void ph_dn_post(int item, const float* __restrict__ o, const bf16_t* __restrict__ proj, const float* __restrict__ dn_norm_g, bf16_t* __restrict__ mixed) {
  const int tid = TIDX, h = tid >> 6, lane = tid & 63;
  const float2 g2 = *(const float2*)(dn_norm_g + 2 * lane);
  float2 ov[4]; unsigned zv[4];
#pragma unroll
  for (int i = 0; i < 4; ++i) {
    const size_t n = (size_t)item * 4 + i;
    ov[i] = *(const float2*)(o + n * 512 + h * 128 + 2 * lane);
    zv[i] = *(const unsigned*)(proj + n * PROJW + OFF_Z + h * 128 + 2 * lane);
  }
#pragma unroll
  for (int i = 0; i < 4; ++i) {
    const size_t n = (size_t)item * 4 + i;
    const float ss = wave_sum(ov[i].x * ov[i].x + ov[i].y * ov[i].y);
    const float rn = rsqrtf(ss * (1.f / 128.f) + RMS_EPS);
    *(unsigned*)(mixed + n * DM + h * 128 + 2 * lane) = pack2(ov[i].x * rn * g2.x * siluf(bflo(zv[i])), ov[i].y * rn * g2.y * siluf(bfhi(zv[i])));
  }
}

__device__ __forceinline__ void ph_swa(unsigned char* smem, int item, const bf16_t* __restrict__ proj, const bf16_t* __restrict__ vt, const float* __restrict__ sinks, bf16_t* __restrict__ mixed) {
  const int tid = TIDX, lane = tid & 63, w = tid >> 6, fr = lane & 15, fq = lane >> 4;
  const int qb = item & 31, kvh = (item >> 5) & 1, b = item >> 6;
  const int t0 = qb * 128;
  const size_t rowb = (size_t)b * SEQ;
  unsigned char* sK = smem;
  unsigned char* sV = smem + 32768;
  __syncthreads();
#pragma unroll
  for (int i = 0; i < 8; ++i) {
    const int q = tid + 256 * i, row = q >> 3, ch = q & 7;
    const int pos = t0 - 128 + row;
    u32x4 v = (u32x4){0u, 0u, 0u, 0u};
    if (pos >= 0) v = *(const u32x4*)(proj + (rowb + pos) * PROJW + OFF_SK + kvh * 64 + ch * 8);
    *(u32x4*)(sK + row * 128 + ((ch ^ (row & 7)) << 4)) = v;
  }
#pragma unroll
  for (int i = 0; i < 8; ++i) {
    const int q = tid + 256 * i, row = q >> 5, ch = q & 31;
    const int pos = t0 - 128 + ch * 8;
    u32x4 v = (u32x4){0u, 0u, 0u, 0u};
    if (pos >= 0) v = *(const u32x4*)(vt + ((size_t)(b * 128 + kvh * 64 + row)) * SEQ + pos);
    *(u32x4*)(sV + row * 512 + ((ch ^ (row & 15)) << 4)) = v;
  }
  __syncthreads();
  const int head = kvh * 4 + w;
  const float slope = exp2f(-(float)(head + 1));
  const float sink = sinks[head];
  const bf16_t* qp0 = proj + (rowb + t0 + fr) * PROJW + OFF_SQ + head * 64 + fq * 8;
  bf16x8 qn0 = *(const bf16x8*)(qp0), qn1 = *(const bf16x8*)(qp0 + 32);
#pragma unroll 1
  for (int qt = 0; qt < 8; ++qt) {
    const bf16x8 qf0 = qn0, qf1 = qn1;
    if (qt < 7) { const bf16_t* qp = qp0 + (size_t)(qt + 1) * 16 * PROJW; qn0 = *(const bf16x8*)(qp); qn1 = *(const bf16x8*)(qp + 32); }
    const int kp0 = qt >> 1;
    f32x4 st[10];
#pragma unroll
    for (int kt = 0; kt < 10; ++kt) {
      const int krow = (2 * kp0 + kt) * 16 + fr;
      st[kt] = (f32x4){0.f, 0.f, 0.f, 0.f};
      const bf16x8 k0 = *(const bf16x8*)(sK + krow * 128 + (((0 + fq) ^ (krow & 7)) << 4));
      const bf16x8 k1 = *(const bf16x8*)(sK + krow * 128 + (((4 + fq) ^ (krow & 7)) << 4));
      st[kt] = __builtin_amdgcn_mfma_f32_16x16x32_bf16(k0, qf0, st[kt], 0, 0, 0);
      st[kt] = __builtin_amdgcn_mfma_f32_16x16x32_bf16(k1, qf1, st[kt], 0, 0, 0);
    }
    const int i = qt * 16 + fr;
    float mx = sink;
#pragma unroll
    for (int kt = 0; kt < 10; ++kt)
#pragma unroll
      for (int r = 0; r < 4; ++r) {
        const int jb = (2 * kp0 + kt) * 16 + 4 * fq + r;
        const int dist = 128 + i - jb;
        const bool ok = (dist >= 0) && (dist < 128) && (t0 - 128 + jb >= 0);
        const float s = ok ? (st[kt][r] * 0.125f - slope * (float)dist) : -INFINITY;
        st[kt][r] = s;
        mx = fmaxf(mx, s);
      }
    mx = fmaxf(mx, __shfl_xor(mx, 16));
    mx = fmaxf(mx, __shfl_xor(mx, 32));
    float sum = 0.f;
#pragma unroll
    for (int kt = 0; kt < 10; ++kt)
#pragma unroll
      for (int r = 0; r < 4; ++r) { const float p = __expf(st[kt][r] - mx); st[kt][r] = p; sum += p; }
    sum += __shfl_xor(sum, 16);
    sum += __shfl_xor(sum, 32);
    const float inv = 1.f / (sum + __expf(sink - mx));
    f32x4 O[4];
#pragma unroll
    for (int nt = 0; nt < 4; ++nt) O[nt] = (f32x4){0.f, 0.f, 0.f, 0.f};
#pragma unroll
    for (int s5 = 0; s5 < 5; ++s5) {
      const bf16x8 pa = pack8(st[2 * s5] * inv, st[2 * s5 + 1] * inv);
      const int key0 = (2 * kp0 + 2 * s5) * 16 + 4 * fq;
#pragma unroll
      for (int nt = 0; nt < 4; ++nt) {
        const int drow = nt * 16 + fr;
        const int c0 = key0 >> 3, c1 = (key0 + 16) >> 3;
        const u32x2 lo = *(const u32x2*)(sV + drow * 512 + ((c0 ^ (drow & 15)) << 4) + ((key0 >> 2) & 1) * 8);
        const u32x2 hi = *(const u32x2*)(sV + drow * 512 + ((c1 ^ (drow & 15)) << 4) + ((key0 >> 2) & 1) * 8);
        const u32x4 vb = (u32x4){lo[0], lo[1], hi[0], hi[1]};
        O[nt] = __builtin_amdgcn_mfma_f32_16x16x32_bf16(__builtin_bit_cast(bf16x8, vb), pa, O[nt], 0, 0, 0);
      }
    }
#pragma unroll
    for (int nt = 0; nt < 4; ++nt) {
      u32x2 wv; wv[0] = pack2(O[nt][0], O[nt][1]); wv[1] = pack2(O[nt][2], O[nt][3]);
      *(u32x2*)(mixed + (rowb + t0 + qt * 16 + fr) * DM + 512 + head * 64 + nt * 16 + 4 * fq) = wv;
    }
  }
}

__device__ __forceinline__ void ph_wout(unsigned char* smem, int xcd, int l, const bf16_t* __restrict__ mixed, const bf16_t* __restrict__ wt, bf16_t* __restrict__ mixo) {
  const int mi = l >> 3, ni = l & 7;
  LdRowBF16 al; al.init([&](int r) { return mixed + (size_t)((xcd * 32 + mi) * 128 + r) * DM; }, (size_t)8 * 128 * DM * 2);
  LdRowBF16 bl; bl.init([&](int r) { return wt + (size_t)(ni * 128 + r) * DM; }, 0);
  gemm_stream<16>(smem, al, bl, 4, [&](int seg, f32x4 (&acc)[4][4], unsigned char* fbuf) {
    const int m0 = (xcd * 32 + seg * 8 + mi) * 128, n0 = ni * 128;
    store_tile_bf16(fbuf, acc, [&](int r) { return mixo + (size_t)(m0 + r) * DM + n0; });
  });
}

__device__ __forceinline__ void ph_ln1(int item, const float* __restrict__ x, const bf16_t* __restrict__ mixo, const float* __restrict__ gam, const float* __restrict__ bet, bf16_t* __restrict__ xbf, unsigned char* __restrict__ x8) {
  const int row = item * 4 + (TIDX >> 6), lane = TIDX & 63;
  const float4* p = (const float4*)(x + (size_t)row * DM);
  const u32x2* pm = (const u32x2*)(mixo + (size_t)row * DM);
  float4 v[4]; float s = 0.f;
#pragma unroll
  for (int i = 0; i < 4; ++i) {
    const float4 xv = p[lane + i * 64]; const u32x2 mv = pm[lane + i * 64];
    v[i].x = ALPHA * xv.x + bflo(mv[0]); v[i].y = ALPHA * xv.y + bfhi(mv[0]); v[i].z = ALPHA * xv.z + bflo(mv[1]); v[i].w = ALPHA * xv.w + bfhi(mv[1]);
    s += v[i].x + v[i].y + v[i].z + v[i].w;
  }
  const float mu = wave_sum(s) * (1.f / DM);
  float q = 0.f;
#pragma unroll
  for (int i = 0; i < 4; ++i) { const float a = v[i].x - mu, b = v[i].y - mu, c = v[i].z - mu, d = v[i].w - mu; q += a * a + b * b + c * c + d * d; }
  const float rs = rsqrtf(wave_sum(q) * (1.f / DM) + LN_EPS);
#pragma unroll
  for (int i = 0; i < 4; ++i) {
    const float4 gg = ((const float4*)gam)[lane + i * 64], bb = ((const float4*)bet)[lane + i * 64];
    u32x2 w;
    w[0] = pack2((v[i].x - mu) * rs * gg.x + bb.x, (v[i].y - mu) * rs * gg.y + bb.y);
    w[1] = pack2((v[i].z - mu) * rs * gg.z + bb.z, (v[i].w - mu) * rs * gg.w + bb.w);
    ((u32x2*)(xbf + (size_t)row * DM))[lane + i * 64] = w;
    int pk = 0;
    pk = __builtin_amdgcn_cvt_pk_fp8_f32((v[i].x - mu) * rs * gg.x + bb.x, (v[i].y - mu) * rs * gg.y + bb.y, pk, false);
    pk = __builtin_amdgcn_cvt_pk_fp8_f32((v[i].z - mu) * rs * gg.z + bb.z, (v[i].w - mu) * rs * gg.w + bb.w, pk, true);
    ((int*)(x8 + (size_t)row * DM))[lane + i * 64] = pk;
  }
}

__device__ __forceinline__ void ph_router(unsigned char* smem, int tile, const bf16_t* __restrict__ xbf, const bf16_t* __restrict__ wt, float* __restrict__ logits) {
  GEMM_IDS
  const int n0 = (tile & 1) * 128, m0 = (tile >> 1) * 128;
  LdRowBF16 al; al.init([&](int r) { return xbf + (size_t)(m0 + r) * DM; }, 0);
  LdRowBF16 bl; bl.init([&](int r) { return wt + (size_t)(n0 + r) * DM; }, 0);
  gemm_stream<16>(smem, al, bl, 1, [&](int seg, f32x4 (&acc)[4][4], unsigned char* fbuf) {
    GEMM_IDS
#pragma unroll
    for (int m = 0; m < 4; ++m)
#pragma unroll
      for (int n = 0; n < 4; ++n)
        *(f32x4*)(logits + (size_t)(m0 + wr * 64 + m * 16 + fr) * NEXP + n0 + wc * 64 + n * 16 + fq * 4) = acc[m][n];
  });
}

__device__ __forceinline__ unsigned rt_fkey(float f) { const unsigned b = __float_as_uint(f); return (b & 0x80000000u) ? ~b : (b | 0x80000000u); }
#define RT_DPPF(x, ctrl) __builtin_bit_cast(float, __builtin_amdgcn_update_dpp(__builtin_bit_cast(int, x), __builtin_bit_cast(int, x), ctrl, 0xf, 0xf, false))
#define RT_DPPU(x, ctrl, rmask) (unsigned)__builtin_amdgcn_update_dpp((int)(x), (int)(x), ctrl, rmask, 0xf, false)
#define RT_KSTEP(hi, lo, ctrl, rmask) { const unsigned ph_ = RT_DPPU(hi, ctrl, rmask), pl_ = RT_DPPU(lo, ctrl, rmask); \
    const bool t_ = (ph_ > hi) || (ph_ == hi && pl_ > lo); hi = t_ ? ph_ : hi; lo = t_ ? pl_ : lo; }
__device__ __forceinline__ void ph_route(int item, const float* __restrict__ logits, const float* __restrict__ router_bias, int* __restrict__ cnt, int* __restrict__ list, float* __restrict__ gates) {
  const int n = item * 4 + (TIDX >> 6), lane = TIDX & 63;
  const float4 lg = ((const float4*)(logits + (size_t)n * NEXP))[lane];
  const float4 rb = ((const float4*)router_bias)[lane];
  const float sc0 = sigmoidf(lg.x), sc1 = sigmoidf(lg.y), sc2 = sigmoidf(lg.z), sc3 = sigmoidf(lg.w);
  const float sel0 = sc0 + rb.x, sel1 = sc1 + rb.y, sel2 = sc2 + rb.z, sel3 = sc3 + rb.w;
  float t1 = fmaxf(sel0, sel1), t2 = fminf(sel0, sel1);
  { const float a = sel2; if (a > t1) { t2 = t1; t1 = a; } else if (a > t2) t2 = a; }
  { const float a = sel3; if (a > t1) { t2 = t1; t1 = a; } else if (a > t2) t2 = a; }
  { const float b1 = RT_DPPF(t1, 0xB1), b2 = RT_DPPF(t2, 0xB1); const float n1 = fmaxf(t1, b1), n2 = fmaxf(fminf(t1, b1), fmaxf(t2, b2)); t1 = n1; t2 = n2; }
  { const float b1 = RT_DPPF(t1, 0x4E), b2 = RT_DPPF(t2, 0x4E); const float n1 = fmaxf(t1, b1), n2 = fmaxf(fminf(t1, b1), fmaxf(t2, b2)); t1 = n1; t2 = n2; }
  { const float b1 = RT_DPPF(t1, 0x141), b2 = RT_DPPF(t2, 0x141); const float n1 = fmaxf(t1, b1), n2 = fmaxf(fminf(t1, b1), fmaxf(t2, b2)); t1 = n1; t2 = n2; }
  const float gs = t1 + t2;
  const int mygrp = lane >> 3;
  int rank = 0;
#pragma unroll
  for (int j = 0; j < 8; ++j) {
    const float o = __builtin_bit_cast(float, __builtin_amdgcn_readlane(__builtin_bit_cast(int, gs), j * 8));
    rank += (o > gs || (o == gs && j < mygrp)) ? 1 : 0;
  }
  const bool gsel = rank < 4;
  unsigned k0 = gsel ? rt_fkey(sel0) : 0u, k1 = gsel ? rt_fkey(sel1) : 0u, k2 = gsel ? rt_fkey(sel2) : 0u, k3 = gsel ? rt_fkey(sel3) : 0u;
  float gsum = 0.f; float myg = 0.f; int mye = 0;
#pragma unroll 1
  for (int r = 0; r < TOPK; ++r) {
    unsigned hi = k0, lo = 255u - (unsigned)(lane * 4);
    if (k1 > hi) { hi = k1; lo = 255u - (unsigned)(lane * 4 + 1); }
    if (k2 > hi) { hi = k2; lo = 255u - (unsigned)(lane * 4 + 2); }
    if (k3 > hi) { hi = k3; lo = 255u - (unsigned)(lane * 4 + 3); }
    RT_KSTEP(hi, lo, 0xB1, 0xf) RT_KSTEP(hi, lo, 0x4E, 0xf) RT_KSTEP(hi, lo, 0x141, 0xf) RT_KSTEP(hi, lo, 0x140, 0xf)
    RT_KSTEP(hi, lo, 0x142, 0xa) RT_KSTEP(hi, lo, 0x143, 0xc)
    const int be = 255 - __builtin_amdgcn_readlane((int)lo, 63);
    const int owner = be >> 2, slot = be & 3;
    const float tsel = (slot == 0) ? sc0 : (slot == 1) ? sc1 : (slot == 2) ? sc2 : sc3;
    const float bs = __builtin_bit_cast(float, __builtin_amdgcn_readlane(__builtin_bit_cast(int, tsel), owner));
    if (lane == owner) { if (slot == 0) k0 = 0u; else if (slot == 1) k1 = 0u; else if (slot == 2) k2 = 0u; else k3 = 0u; }
    gsum += bs;
    if (lane == r) { myg = bs; mye = be; }
  }
  if (lane < TOPK) {
    const int sh = item & (NSH - 1);
    const int slot = atomicAdd(&cnt[sh * NEXP + mye], 1);
    list[((size_t)sh * NEXP + mye) * CAPS + slot] = n * TOPK + lane;
    gates[(size_t)n * TOPK + lane] = myg / gsum * 2.5f;
  }
}
#undef RT_KSTEP

__device__ __forceinline__ void moe_build_prefix(const int* __restrict__ cnt, int* sscan) {
  const int tid = TIDX;
  const int e = ((tid & 31) << 3) | (tid >> 5);
  int c = 0;
#pragma unroll
  for (int s = 0; s < NSH; ++s) c += cnt[s * NEXP + e];
  __syncthreads();
  sscan[tid] = (c + 127) >> 7;
  __syncthreads();
  for (int o = 1; o < 256; o <<= 1) {
    const int v = (tid >= o) ? sscan[tid - o] : 0;
    __syncthreads();
    sscan[tid] += v;
    __syncthreads();
  }
}
__device__ __forceinline__ void moe_locate(const int* sscan, int x, int lt, int& e, int& rt) {
  const int base = x ? sscan[32 * x - 1] : 0;
  const int nrouted = sscan[32 * x + 31] - base;
  if (lt >= nrouted) { e = 256; rt = x * (NTOK / 128 / 8) + (lt - nrouted); return; }
  const int g = base + lt;
  int lo = 32 * x, hi = 32 * x + 31;
  while (lo < hi) { const int mid = (lo + hi) >> 1; if (sscan[mid] > g) hi = mid; else lo = mid + 1; }
  e = ((lo & 31) << 3) | (lo >> 5); rt = g - (lo ? sscan[lo - 1] : 0);
}

typedef int v8i __attribute__((ext_vector_type(8)));
typedef int i32x4 __attribute__((ext_vector_type(4)));
#define MX_ONE 0x7f7f7f7f
__device__ __forceinline__ long lo64(const u32x4& v) { return (long)(((unsigned long long)v[1] << 32) | (unsigned long long)v[0]); }
__device__ __forceinline__ long hi64(const u32x4& v) { return (long)(((unsigned long long)v[3] << 32) | (unsigned long long)v[2]); }
__device__ __forceinline__ void ph_moe(unsigned char* smem, int e, int rt, const unsigned char* __restrict__ x8, const int* __restrict__ cnt,
                                       const int* __restrict__ list, const float* __restrict__ gates, const unsigned char* __restrict__ wge, const unsigned char* __restrict__ wue,
                                       const unsigned char* __restrict__ wde, unsigned char* __restrict__ ybuf, unsigned char* __restrict__ dummy) {
  int* sasg = (int*)(smem + SM_MISC + 2048);
  float* sgate = (float*)(smem + SM_MISC + 2048 + 512);
  const int tid = TIDX, lane = tid & 63, w = tid >> 6, fr = lane & 15, fq = lane >> 4;
  __syncthreads();
  if (tid < 128) {
    const int r = rt * 128 + tid;
    int a = -1;
    if (e < 256) {
      int cum = 0;
#pragma unroll
      for (int s = 0; s < NSH; ++s) {
        const int c = cnt[s * NEXP + e];
        if (r >= cum && r < cum + c) a = list[((size_t)s * NEXP + e) * CAPS + (r - cum)];
        cum += c;
      }
    } else if (r < NTOK) a = NA + r;
    sasg[tid] = a;
    sgate[tid] = (a >= 0 && a < NA) ? gates[a] : 1.f;
  }
  __syncthreads();
  v8i hf[2][2];
  {
    LdRowBF16 al; al.init([&](int r) { const int a = sasg[r]; const int tok = (a < 0) ? 0 : (a < NA ? (a >> 3) : (a - NA)); return x8 + (size_t)tok * DM; }, 0);
    LdRowBF16 bl; bl.init([&](int j) {
      const int bn = j >> 4, ff = (bn >> 1) * 16 + (j & 15);
      return ((bn & 1) ? wue : wge) + (size_t)ff * DM; }, (size_t)64 * DM);
    al.issue(0, 0, smem); bl.issue(0, 0, smem + 16384);
    asm volatile("s_waitcnt vmcnt(0)" ::: "memory");
    __syncthreads();
#pragma unroll
    for (int m = 0; m < 2; ++m)
#pragma unroll
      for (int s = 0; s < 2; ++s) hf[m][s] = (v8i){0, 0, 0, 0, 0, 0, 0, 0};
#pragma unroll 1
    for (int ct = 0; ct < 4; ++ct) {
      f32x4 acc[2][8];
#pragma unroll
      for (int m = 0; m < 2; ++m)
#pragma unroll
        for (int n = 0; n < 8; ++n) acc[m][n] = (f32x4){0.f, 0.f, 0.f, 0.f};
#pragma unroll 1
      for (int kk = 0; kk < 8; ++kk) {
        const int j = ct * 8 + kk;
        unsigned char* cur = smem + (j & 1) * 32768; unsigned char* nxt = smem + ((j & 1) ^ 1) * 32768;
        if (j + 1 < 32) { al.issue((j + 1) >> 3, (j + 1) & 7, nxt); bl.issue((j + 1) >> 3, (j + 1) & 7, nxt + 16384); }
        {
          v8i a[2], bfrag[8];
#pragma unroll
          for (int m = 0; m < 2; ++m) {
            const int row = w * 32 + m * 16 + fr;
            const i32x4 lo = *(const i32x4*)(cur + row * 128 + ((fq ^ (row & 7)) << 4));
            const i32x4 hi = *(const i32x4*)(cur + row * 128 + (((4 + fq) ^ (row & 7)) << 4));
            a[m] = __builtin_shufflevector(lo, hi, 0, 1, 2, 3, 4, 5, 6, 7);
          }
#pragma unroll
          for (int n = 0; n < 8; ++n) {
            const int row = n * 16 + fr;
            const i32x4 lo = *(const i32x4*)(cur + 16384 + row * 128 + ((fq ^ (row & 7)) << 4));
            const i32x4 hi = *(const i32x4*)(cur + 16384 + row * 128 + (((4 + fq) ^ (row & 7)) << 4));
            bfrag[n] = __builtin_shufflevector(lo, hi, 0, 1, 2, 3, 4, 5, 6, 7);
          }
          __builtin_amdgcn_s_setprio(1);
#pragma unroll
          for (int n = 0; n < 8; ++n)
#pragma unroll
            for (int m = 0; m < 2; ++m)
              acc[m][n] = __builtin_amdgcn_mfma_scale_f32_16x16x128_f8f6f4(bfrag[n], a[m], acc[m][n], 0, 0, 0, MX_ONE, 0, MX_ONE);
          __builtin_amdgcn_s_setprio(0);
          __builtin_amdgcn_sched_group_barrier(0x100, 20, 0);
          __builtin_amdgcn_sched_group_barrier(0x008, 16, 0);
        }
        asm volatile("s_waitcnt vmcnt(0)" ::: "memory");
        __syncthreads();
      }
#pragma unroll
      for (int m = 0; m < 2; ++m) {
        int hp[4][2];
#pragma unroll
        for (int p = 0; p < 4; ++p) {
          float hv[4];
#pragma unroll
          for (int r = 0; r < 4; ++r) hv[r] = siluf(acc[m][2 * p][r] * (1.f / SC_WG)) * acc[m][2 * p + 1][r] * (SC_H / SC_WU);
          int pk = 0;
          pk = __builtin_amdgcn_cvt_pk_fp8_f32(hv[0], hv[1], pk, false);
          pk = __builtin_amdgcn_cvt_pk_fp8_f32(hv[2], hv[3], pk, true);
          hp[p][0] = pk;
        }
        if (ct == 0) { hf[m][0][0] = hp[0][0]; hf[m][0][1] = hp[1][0]; hf[m][0][2] = hp[2][0]; hf[m][0][3] = hp[3][0]; }
        else if (ct == 1) { hf[m][0][4] = hp[0][0]; hf[m][0][5] = hp[1][0]; hf[m][0][6] = hp[2][0]; hf[m][0][7] = hp[3][0]; }
        else if (ct == 2) { hf[m][1][0] = hp[0][0]; hf[m][1][1] = hp[1][0]; hf[m][1][2] = hp[2][0]; hf[m][1][3] = hp[3][0]; }
        else { hf[m][1][4] = hp[0][0]; hf[m][1][5] = hp[1][0]; hf[m][1][6] = hp[2][0]; hf[m][1][7] = hp[3][0]; }
      }
    }
  }
#define MOE_RAW_BARRIER() do { asm volatile("s_waitcnt lgkmcnt(0)" ::: "memory"); __builtin_amdgcn_s_barrier(); } while (0)
  {
    LdRowBF16 bl; bl.init([&](int j) { return wde + (size_t)j * EFF; }, (size_t)128 * EFF);
    bl.issue(0, 0, smem); bl.issue(0, 1, smem + 16384); bl.issue(1, 0, smem + 32768);
#pragma unroll 1
    for (int ct = 0; ct < 8; ++ct) {
      f32x4 acc[2][8];
#pragma unroll
      for (int m = 0; m < 2; ++m)
#pragma unroll
        for (int n = 0; n < 8; ++n) acc[m][n] = (f32x4){0.f, 0.f, 0.f, 0.f};
#pragma unroll
      for (int kk = 0; kk < 2; ++kk) {
        const int j = ct * 2 + kk;
        if (kk == 0) {
          if (ct == 0) asm volatile("s_waitcnt vmcnt(8)" ::: "memory");
          else if (ct == 1) asm volatile("s_waitcnt vmcnt(12)" ::: "memory");
          else if (ct < 7) asm volatile("s_waitcnt vmcnt(16)" ::: "memory");
          else asm volatile("s_waitcnt vmcnt(12)" ::: "memory");
        } else {
          if (ct == 0) asm volatile("s_waitcnt vmcnt(8)" ::: "memory");
          else if (ct < 7) asm volatile("s_waitcnt vmcnt(12)" ::: "memory");
          else asm volatile("s_waitcnt vmcnt(4)" ::: "memory");
        }
        MOE_RAW_BARRIER();
        if (j + 3 < 16) bl.issue((j + 3) >> 1, (j + 3) & 1, smem + ((j + 3) & 3) * 16384);
        const unsigned char* cur = smem + (j & 3) * 16384;
        {
          v8i wf[8];
#pragma unroll
          for (int n = 0; n < 8; ++n) {
            const int row = n * 16 + fr;
            const i32x4 lo = *(const i32x4*)(cur + row * 128 + ((fq ^ (row & 7)) << 4));
            const i32x4 hi = *(const i32x4*)(cur + row * 128 + (((4 + fq) ^ (row & 7)) << 4));
            wf[n] = __builtin_shufflevector(lo, hi, 0, 1, 2, 3, 4, 5, 6, 7);
          }
          __builtin_amdgcn_s_setprio(1);
#pragma unroll
          for (int n = 0; n < 8; ++n)
#pragma unroll
            for (int m = 0; m < 2; ++m) acc[m][n] = __builtin_amdgcn_mfma_scale_f32_16x16x128_f8f6f4(wf[n], hf[m][kk], acc[m][n], 0, 0, 0, MX_ONE, 0, MX_ONE);
          __builtin_amdgcn_s_setprio(0);
          __builtin_amdgcn_sched_group_barrier(0x100, 16, 0);
          __builtin_amdgcn_sched_group_barrier(0x008, 16, 0);
        }
      }
      const int n0 = ct * 128;
      {
        unsigned char* stg = smem + ((2 * ct + 1) & 3) * 16384 + w * 4096;
        MOE_RAW_BARRIER();
#pragma unroll
        for (int m = 0; m < 2; ++m) {
          const int row = m * 16 + fr;
          const float gt = sgate[w * 32 + row] * (SC_Y / (SC_H * SC_WD));
#pragma unroll
          for (int n = 0; n < 8; ++n) {
            int pk = 0;
            pk = __builtin_amdgcn_cvt_pk_fp8_f32(acc[m][n][0] * gt, acc[m][n][1] * gt, pk, false);
            pk = __builtin_amdgcn_cvt_pk_fp8_f32(acc[m][n][2] * gt, acc[m][n][3] * gt, pk, true);
            *(int*)(stg + row * 128 + ((n ^ (row & 7)) << 4) + 4 * fq) = pk;
          }
        }
#pragma unroll
        for (int i = 0; i < 4; ++i) {
          const int q = lane + 64 * i, row = q >> 3, ch = q & 7;
          const int a = sasg[w * 32 + row];
          unsigned char* yp = ((a >= 0) ? ybuf + (size_t)a * DM : dummy) + n0 + ch * 16;
          *(u32x4*)yp = *(const u32x4*)(stg + row * 128 + ((ch ^ (row & 7)) << 4));
        }
      }
    }
    MOE_RAW_BARRIER();
  }
#undef MOE_RAW_BARRIER
}

__device__ __forceinline__ void ph_final(int item, float* __restrict__ out, const bf16_t* __restrict__ xbf, const unsigned char* __restrict__ ybuf, const float* __restrict__ gam, const float* __restrict__ bet) {
  const int row = item * 4 + (TIDX >> 6), lane = TIDX & 63;
  f32x4* p = (f32x4*)(out + (size_t)row * DM + 16 * lane);
  const u32x4 xa = *(const u32x4*)(xbf + (size_t)row * DM + 16 * lane), xb = *(const u32x4*)(xbf + (size_t)row * DM + 16 * lane + 8);
  u32x4 yv[9];
#pragma unroll
  for (int k = 0; k < 8; ++k) yv[k] = *(const u32x4*)(ybuf + ((size_t)row * 8 + k) * DM + 16 * lane);
  yv[8] = *(const u32x4*)(ybuf + ((size_t)NA + row) * DM + 16 * lane);
  float ys[16];
#pragma unroll
  for (int c = 0; c < 16; ++c) ys[c] = 0.f;
#pragma unroll
  for (int k = 0; k < 9; ++k)
#pragma unroll
    for (int d = 0; d < 4; ++d) {
      const hwf32x2 lo = __builtin_amdgcn_cvt_pk_f32_fp8((int)yv[k][d], false), hi = __builtin_amdgcn_cvt_pk_f32_fp8((int)yv[k][d], true);
      ys[4 * d + 0] += lo[0]; ys[4 * d + 1] += lo[1]; ys[4 * d + 2] += hi[0]; ys[4 * d + 3] += hi[1];
    }
  f32x4 v[4];
  v[0] = (f32x4){bflo(xa[0]), bfhi(xa[0]), bflo(xa[1]), bfhi(xa[1])}; v[1] = (f32x4){bflo(xa[2]), bfhi(xa[2]), bflo(xa[3]), bfhi(xa[3])};
  v[2] = (f32x4){bflo(xb[0]), bfhi(xb[0]), bflo(xb[1]), bfhi(xb[1])}; v[3] = (f32x4){bflo(xb[2]), bfhi(xb[2]), bflo(xb[3]), bfhi(xb[3])};
  float s = 0.f;
#pragma unroll
  for (int i = 0; i < 4; ++i)
#pragma unroll
    for (int r = 0; r < 4; ++r) { v[i][r] = v[i][r] * ALPHA + ys[4 * i + r] * (1.f / SC_Y); s += v[i][r]; }
  const float mu = wave_sum(s) * (1.f / DM);
  float q = 0.f;
#pragma unroll
  for (int i = 0; i < 4; ++i)
#pragma unroll
    for (int r = 0; r < 4; ++r) { const float d = v[i][r] - mu; q += d * d; }
  const float rs = rsqrtf(wave_sum(q) * (1.f / DM) + LN_EPS);
#pragma unroll
  for (int i = 0; i < 4; ++i) {
    const f32x4 gg = *(const f32x4*)(gam + 16 * lane + 4 * i), bb = *(const f32x4*)(bet + 16 * lane + 4 * i);
    p[i] = (v[i] - mu) * rs * gg + bb;
  }
}

#define XB_TMO      128
#define XB_XCNT(j)  (256  + 64 * (j))
#define XB_XSUB(j)  (1280 + 64 * (j))
#define XB_XGEN(j)  (2304 + 64 * (j))
#define XB_TOP      3328
#define XB_TOPGEN   3392
#define XCD_BAR_WORDS 3456
#define XB_SPIN_CAP (1u << 22)
#define LAS __attribute__((address_space(3)))
__device__ __forceinline__ unsigned xb_ld(unsigned* p)              { return __hip_atomic_load(p, __ATOMIC_RELAXED, __HIP_MEMORY_SCOPE_AGENT); }
__device__ __forceinline__ unsigned xb_add(unsigned* p, unsigned v) { return __hip_atomic_fetch_add(p, v, __ATOMIC_RELAXED, __HIP_MEMORY_SCOPE_AGENT); }
__device__ __forceinline__ unsigned xb_xcc_id() { return (unsigned)__builtin_amdgcn_s_getreg((3 << 11) | 20) & 0xFu; }
#define XB_SPIN(cond, bar) do { unsigned _sp = 0; while (cond) { __builtin_amdgcn_s_sleep(1); \
    if ((++_sp & 255u) == 0u) { if (xb_ld(&(bar)[XB_TMO])) break; if (_sp > XB_SPIN_CAP) { atomicAdd(&(bar)[XB_TMO], 1u); break; } } } } while (0)
struct XcdBarrier { unsigned* bar; unsigned x; volatile LAS unsigned* st; };
__device__ __forceinline__ XcdBarrier xcd_barrier_post(unsigned* bar, volatile LAS unsigned* st) {
  XcdBarrier b; b.bar = bar; b.x = xb_xcc_id(); b.st = st;
  if (threadIdx.x == 0) (void)xb_add(&bar[XB_XCNT(b.x)], 1u);
  return b;
}
__device__ __forceinline__ void xcd_barrier_complete(unsigned* bar, unsigned x, unsigned& nloc, unsigned& nx) {
  const unsigned G = gridDim.x * gridDim.y * gridDim.z;
  unsigned sum, cnt, mine, sp = 0u;
  for (;;) {
    sum = 0u; cnt = 0u; mine = 0u;
#pragma unroll
    for (unsigned j = 0; j < 16; ++j) { const unsigned c = xb_ld(&bar[XB_XCNT(j)]); sum += c; cnt += (c > 0u) ? 1u : 0u; mine = (j == x) ? c : mine; }
    if (sum == G) break;
    __builtin_amdgcn_s_sleep(1);
    if ((++sp & 255u) == 0u) { if (xb_ld(&bar[XB_TMO])) break; if (sp > XB_SPIN_CAP) { atomicAdd(&bar[XB_TMO], 1u); break; } }
  }
  nloc = mine > 0u ? mine : 1u; nx = cnt > 0u ? cnt : 1u;
}
__device__ __forceinline__ void xcd_barrier(const XcdBarrier& b) {
  asm volatile("s_waitcnt vmcnt(0)" ::: "memory");
  __syncthreads();
  if (threadIdx.x == 0) {
    unsigned* bar = b.bar;
    __builtin_amdgcn_s_waitcnt(0);
    unsigned nloc = b.st[0], nx = b.st[1];
    if (nloc == 0u) { xcd_barrier_complete(bar, b.x, nloc, nx); b.st[0] = nloc; b.st[1] = nx; }
    const unsigned old = xb_add(&bar[XB_XSUB(b.x)], 1u);
    const unsigned gen = old / nloc;
    if (old + 1u == (gen + 1u) * nloc) {
      __builtin_amdgcn_fence(__ATOMIC_RELEASE, "agent");
      asm volatile("s_waitcnt vmcnt(0)" ::: "memory");
      const unsigned og = xb_add(&bar[XB_TOP], 1u);
      const unsigned tg = og / nx;
      if (og + 1u == (tg + 1u) * nx) xb_add(&bar[XB_TOPGEN], 1u);
      else XB_SPIN(xb_ld(&bar[XB_TOPGEN]) == tg, bar);
      __builtin_amdgcn_fence(__ATOMIC_ACQUIRE, "agent");
      xb_add(&bar[XB_XGEN(b.x)], 1u);
      asm volatile("s_waitcnt vmcnt(0)" ::: "memory");
    } else {
      XB_SPIN(xb_ld(&bar[XB_XGEN(b.x)]) == gen, bar);
      __builtin_amdgcn_fence(__ATOMIC_ACQUIRE, "agent");
      asm volatile("s_waitcnt vmcnt(0)" ::: "memory");
    }
  }
  __syncthreads();
}

__global__ void __launch_bounds__(256, 2) mega(Params P) {
  __shared__ __attribute__((aligned(16))) unsigned char smem[SMEM_BYTES];
  const int bid = blockIdx.x, nblk = gridDim.x;
#define xin (P.in[0])
#define w_in (P.in[1])
#define conv_w (P.in[2])
#define a_log (P.in[3])
#define dt_bias (P.in[4])
#define dn_norm_g (P.in[5])
#define sinks (P.in[6])
#define w_out (P.in[7])
#define ln1_g (P.in[8])
#define ln1_b (P.in[9])
#define router_w (P.in[10])
#define router_bias (P.in[11])
#define w_gate (P.in[12])
#define w_up (P.in[13])
#define w_down (P.in[14])
#define sw_gate (P.in[15])
#define sw_up (P.in[16])
#define sw_down (P.in[17])
#define ln2_g (P.in[18])
#define ln2_b (P.in[19])
#define outp (P.out)
#define x1bf ((bf16_t*)(P.ws + WS_X1BF))
#define logits ((float*)(P.ws + WS_LOGIT))
#define list ((int*)(P.ws + WS_LIST))
#define gates ((float*)(P.ws + WS_GATES))
#define cnt ((int*)(P.ws + WS_CTRL + CNT16_OFF))
#define barw ((unsigned*)(P.ws + WS_CTRL + 4096))
#define mixed ((bf16_t*)(P.ws + WS_MIXED))
#define proj ((bf16_t*)(P.ws + WS_PROJ))
#define ba ((float*)(P.ws + WS_BA))
#define QD ((bf16_t*)(P.ws + WS_QD))
#define W0N ((bf16_t*)(P.ws + WS_W0N))
#define KTT ((bf16_t*)(P.ws + WS_KTT))
#define RV ((bf16_t*)(P.ws + WS_RV))
#define TM ((bf16_t*)(P.ws + WS_TM))
#define ATT ((bf16_t*)(P.ws + WS_ATT))
#define GL ((float*)(P.ws + WS_GL))
#define obuf ((float*)(P.ws + WS_O))
#define VTb ((bf16_t*)(P.ws + WS_VT))
#define MIXO ((bf16_t*)(P.ws + WS_O))
#define XBF ((bf16_t*)(P.ws + WS_XBF))
#define WTIN ((bf16_t*)(P.ws + WS_WTIN))
#define WTOUT ((bf16_t*)(P.ws + WS_WTOUT))
#define WTR ((bf16_t*)(P.ws + WS_WTR))
#define ybuf ((unsigned char*)(P.ws + WS_YBUF))
  {
    volatile LAS unsigned* st0 = (volatile LAS unsigned*)(smem + SM_MISC + 4080);
    if (threadIdx.x == 0) { st0[0] = 0u; st0[1] = 0u; }
    __syncthreads();
  }
  const int xcd = bid & 7, xloc = bid >> 3, xnl = nblk >> 3;
  XcdBarrier xb = xcd_barrier_post(barw, (volatile LAS unsigned*)(smem + SM_MISC + 4080));
  for (int it = bid; it < NTOK / 8; it += nblk) { ph_cvt_x(2 * it, xin, XBF); ph_cvt_x(2 * it + 1, xin, XBF); }
  for (int it = bid; it < 16 * 46 + 16 * 16 + 16 * 4; it += nblk) {
    if (it < 16 * 46) ph_cvt_wt(smem, it % 16, it / 16, w_in, DM, INC, WTIN);
    else if (it < 16 * 46 + 256) { const int j = it - 16 * 46; ph_cvt_wt(smem, j % 16, j / 16, w_out, DM, DM, WTOUT); }
    else { const int j = it - 16 * 46 - 256; ph_cvt_wt(smem, j % 16, j / 16, router_w, DM, NEXP, WTR); }
  }
  xcd_barrier(xb);
  for (int l = xloc; l < 64; l += xnl) ph_proj(smem, xcd, l, XBF, WTIN, proj, ba, VTb);
  xcd_barrier(xb);
  for (int it = bid; it < 2048; it += nblk) ph_dnchunk(smem, it, proj, ba, conv_w, a_log, dt_bias, QD, W0N, KTT, RV, TM, ATT, GL);
  for (int it = bid; it < 512; it += nblk) ph_swa(smem, it, proj, VTb, sinks, mixed);
  xcd_barrier(xb);
  {
    const bool is512 = (nblk == 512);
    const bool scan_blk = is512 ? (bid < 256 && (bid & 7) < 2) : ((bid < 64) || (nblk <= 64));
    const bool swa_blk = is512 && bid >= 256 && (bid & 7) < 2;
    if (scan_blk) {
      if (is512) ph_dnscan(smem, (bid & 1) * 32 + (bid >> 3), QD, W0N, KTT, RV, TM, ATT, GL, obuf);
      else for (int it = bid; it < 64; it += nblk) ph_dnscan(smem, it, QD, W0N, KTT, RV, TM, ATT, GL, obuf);
    }
    if (swa_blk) { }
    else {
      const int tid = TIDX, lane = tid & 63, wv = tid >> 6;
      float* tile = (float*)(smem + wv * 16896);
      const int total = 257 * 192;
      const int T1 = is512 ? (total - 64 * 4 * 12) : ((nblk > 64) ? total : 0);
      int it, step, end;
      if (is512 && scan_blk) { const int sb = (bid & 1) * 32 + (bid >> 3); it = T1 + sb * 4 + wv; step = 64 * 4; end = total; }
      else if (is512) { const int cb = (bid >> 3) * 6 + (bid & 7) - 2; it = cb * 4 + wv; step = 384 * 4; end = T1; }
      else if (nblk > 64) { if (bid < 64) { it = 0; step = 1; end = 0; } else { it = (bid - 64) * 4 + wv; step = (nblk - 64) * 4; end = total; } }
      else { it = bid * 4 + wv; step = nblk * 4; end = total; }
      f32x4 vc[16], vn[16];
      CvtTile tc = cvt_decode(it < end ? it : 0, lane, w_gate, w_up, w_down, sw_gate, sw_up, sw_down, P.ws);
      if (it < end) cvt_load(tc, vc);
      while (it < end) {
        const int itn = it + step;
        CvtTile tn = cvt_decode(itn < end ? itn : 0, lane, w_gate, w_up, w_down, sw_gate, sw_up, sw_down, P.ws);
        if (itn < end) cvt_load(tn, vn);
        cvt_store(tile, lane, tc, vc);
#pragma unroll
        for (int i = 0; i < 16; ++i) vc[i] = vn[i];
        tc = tn; it = itn;
      }
    }
  }
  xcd_barrier(xb);
  for (int it = bid; it < NTOK / 4; it += nblk) ph_dn_post(it, obuf, proj, dn_norm_g, mixed);
  xcd_barrier(xb);
  for (int l = xloc; l < 64; l += xnl) ph_wout(smem, xcd, l, mixed, WTOUT, MIXO);
  xcd_barrier(xb);
  for (int it = bid; it < NTOK / 4; it += nblk) ph_ln1(it, xin, MIXO, ln1_g, ln1_b, x1bf, (unsigned char*)(P.ws + WS_X1F8));
  xcd_barrier(xb);
  for (int i = xloc; i < 32 * 2; i += xnl) ph_router(smem, (xcd * 32 + i / 2) * 2 + i % 2, x1bf, WTR, logits);
  xcd_barrier(xb);
  for (int it = bid; it < NTOK / 4; it += nblk) ph_route(it, logits, router_bias, cnt, list, gates);
  xcd_barrier(xb);
  int* sscan = (int*)(smem + SM_MISC);
  moe_build_prefix(cnt, sscan);
  const int ntile = sscan[32 * xcd + 31] - (xcd ? sscan[32 * xcd - 1] : 0) + NTOK / 128 / 8;
  for (int it = xloc; it < ntile; it += xnl) {
    int e, rt; moe_locate(sscan, xcd, it, e, rt);
    ph_moe(smem, e, rt, (const unsigned char*)(P.ws + WS_X1F8), cnt, list, gates,
           (const unsigned char*)P.ws + ((e < 256) ? WS_WTG8 + (size_t)e * EFF * DM : WS_WTSG8), (const unsigned char*)P.ws + ((e < 256) ? WS_WTU8 + (size_t)e * EFF * DM : WS_WTSU8),
           (const unsigned char*)P.ws + ((e < 256) ? WS_WTD8 + (size_t)e * DM * EFF : WS_WTSD8), ybuf, (unsigned char*)(P.ws + WS_DUMMY));
  }
  xcd_barrier(xb);
  for (int it = bid; it < NTOK / 4; it += nblk) ph_final(it, outp, x1bf, ybuf, ln2_g, ln2_b);
}

#undef xin
#undef w_in
#undef conv_w
#undef a_log
#undef dt_bias
#undef dn_norm_g
#undef sinks
#undef w_out
#undef ln1_g
#undef ln1_b
#undef router_w
#undef router_bias
#undef w_gate
#undef w_up
#undef w_down
#undef sw_gate
#undef sw_up
#undef sw_down
#undef ln2_g
#undef ln2_b
#undef outp
#undef x1bf
#undef logits
#undef list
#undef gates
#undef cnt
#undef mixed
#undef proj
#undef ba
#undef QD
#undef W0N
#undef KTT
#undef RV
#undef TM
#undef ATT
#undef GL
#undef obuf
#undef ybuf
#undef VTb
#undef MIXO
#undef XBF
#undef WTIN
#undef WTOUT
#undef WTR
#undef barw

extern "C" void kernel_launch(void* const* d_in, const int* in_sizes, int n_in, void* d_out, int out_size, void* d_ws, size_t ws_size, hipStream_t stream) {
  static int grid_blocks = 0;
  if (!grid_blocks) {
    int dev = 0, cus = 0, per_cu = 0;
    (void)hipGetDevice(&dev);
    (void)hipDeviceGetAttribute(&cus, hipDeviceAttributeMultiprocessorCount, dev);
    (void)hipOccupancyMaxActiveBlocksPerMultiprocessor(&per_cu, mega, 256, 0);
    if (per_cu > 2) per_cu = 2;
    if (per_cu < 1) per_cu = 1;
    grid_blocks = cus * per_cu;
  }
  Params p{};
  for (int i = 0; i < 20; ++i) p.in[i] = (const float*)d_in[i];
  p.out = (float*)d_out; p.ws = (char*)d_ws;
  (void)hipMemsetAsync((char*)d_ws + WS_CTRL, 0, CNT16_OFF + NSH * NEXP * 4, stream);
  void* args[] = {&p};
  hipError_t e = hipLaunchCooperativeKernel((void*)mega, dim3(grid_blocks), dim3(256), args, 0, stream);
  if (e != hipSuccess) fprintf(stderr, "cooperative launch failed: %s (grid %d)\n", hipGetErrorString(e), grid_blocks);
}
```

```cpp
#include <hip/hip_runtime.h>
#include <hip/hip_cooperative_groups.h>
#include <stdint.h>
#include <stdio.h>
namespace cg = cooperative_groups;

typedef __attribute__((ext_vector_type(8))) short bf16x8;
typedef __attribute__((ext_vector_type(4))) float f32x4;
typedef unsigned short bf16_t;
typedef __attribute__((ext_vector_type(4))) unsigned u32x4;
typedef __attribute__((ext_vector_type(2))) unsigned u32x2;

constexpr int NTOK = 32768, SEQ = 4096, DM = 1024;
constexpr int INC = 2824, PROJW = 2816;
constexpr int OFF_DQ = 0, OFF_DK = 512, OFF_DV = 1024, OFF_SQ = 1536, OFF_SK = 2048, OFF_SV = 2176, OFF_Z = 2304;
constexpr int NEXP = 256, TOPK = 8, EFF = 256;
constexpr int NA = NTOK * TOPK;
constexpr int NSH = 16, CAPS = NTOK / NSH;
constexpr int CNT16_OFF = 32768;
constexpr float ALPHA = 1.189207115002721f;
constexpr float LN_EPS = 1e-5f, RMS_EPS = 1e-6f, L2_EPS = 1e-6f;
constexpr float SC_WG = 32.f, SC_WU = 64.f, SC_WD = 32.f, SC_H = 8.f, SC_Y = 32.f;

constexpr size_t MiB = 1024ull * 1024ull;
constexpr size_t WS_WTD8 = 0;
constexpr size_t WS_WTG8 = 64 * MiB;
constexpr size_t WS_WTU8 = 128 * MiB;
constexpr size_t WS_WTSG8 = 192 * MiB;
constexpr size_t WS_WTSU8 = WS_WTSG8 + 256 * 1024;
constexpr size_t WS_WTSD8 = WS_WTSG8 + 512 * 1024;
constexpr size_t WS_X1F8 = 200 * MiB;
constexpr size_t WS_YBUF = 384 * MiB;
constexpr size_t WS_LOGIT = 384 * MiB;
constexpr size_t WS_X1BF = 896 * MiB;
constexpr size_t WS_LIST = 960 * MiB;
constexpr size_t WS_GATES = 992 * MiB;
constexpr size_t WS_CTRL = 993 * MiB;
constexpr size_t WS_WTIN = 994 * MiB;
constexpr size_t WS_WTOUT = 1000 * MiB;
constexpr size_t WS_WTR = 1002 * MiB;
constexpr size_t WS_DUMMY = 1005 * MiB;
constexpr size_t WS_PROJ = 384 * MiB;
constexpr size_t WS_BA = 560 * MiB;
constexpr size_t WS_QD = 561 * MiB;
constexpr size_t WS_W0N = 593 * MiB;
constexpr size_t WS_KTT = 625 * MiB;
constexpr size_t WS_RV = 657 * MiB;
constexpr size_t WS_TM = 689 * MiB;
constexpr size_t WS_ATT = 705 * MiB;
constexpr size_t WS_GL = 721 * MiB;
constexpr size_t WS_O = 722 * MiB;
constexpr size_t WS_VT = 786 * MiB;
constexpr size_t WS_MIXED = 794 * MiB;
constexpr size_t WS_XBF = 640 * MiB;

__device__ __forceinline__ int opaque_tid() { int t = threadIdx.x; asm volatile("" : "+v"(t)); return t; }
#define TIDX opaque_tid()
typedef __attribute__((ext_vector_type(2))) __bf16 hwbf16x2;
typedef __attribute__((ext_vector_type(2))) float hwf32x2;
__device__ __forceinline__ unsigned pack2(float lo, float hi) {
  hwf32x2 f = {lo, hi};
  return __builtin_bit_cast(unsigned, __builtin_convertvector(f, hwbf16x2));
}
__device__ __forceinline__ unsigned f2bf(float f) { return pack2(f, 0.f) & 0xffffu; }
__device__ __forceinline__ float bf2f(unsigned h) { return __uint_as_float(h << 16); }
__device__ __forceinline__ float bflo(unsigned w) { return __uint_as_float(w << 16); }
__device__ __forceinline__ float bfhi(unsigned w) { return __uint_as_float(w & 0xffff0000u); }
__device__ __forceinline__ float siluf(float x) { return x * __builtin_amdgcn_rcpf(1.f + __expf(-x)); }
__device__ __forceinline__ float sigmoidf(float x) { return __builtin_amdgcn_rcpf(1.f + __expf(-x)); }
#define DPP_ADD_(v, ctrl, rmask) v += __builtin_bit_cast(float, __builtin_amdgcn_update_dpp(0, __builtin_bit_cast(int, v), ctrl, rmask, 0xf, false))
__device__ __forceinline__ float wave_sum(float v) {
  DPP_ADD_(v, 0xB1, 0xf);
  DPP_ADD_(v, 0x4E, 0xf);
  DPP_ADD_(v, 0x141, 0xf);
  DPP_ADD_(v, 0x140, 0xf);
  DPP_ADD_(v, 0x142, 0xa);
  DPP_ADD_(v, 0x143, 0xc);
  return __builtin_bit_cast(float, __builtin_amdgcn_readlane(__builtin_bit_cast(int, v), 63));
}

template <int SEGDIV>
struct LdRowBF16T {
  const char* p[4]; size_t seghi, seglo; int tid16;
  template <class F> __device__ __forceinline__ void init(F rowptr, size_t hi, size_t lo = 0) {
    const int tid = TIDX; const int slot = tid & 7, row0 = tid >> 3; seghi = hi; seglo = lo; tid16 = tid * 16;
#pragma unroll
    for (int i = 0; i < 4; ++i) p[i] = (const char*)rowptr(row0 + i * 32) + ((slot ^ (row0 & 7)) << 4);
  }
  __device__ __forceinline__ void issue(int seg, int kk, unsigned char* lds) {
    const size_t off = (size_t)(seg / SEGDIV) * seghi + (size_t)(seg % SEGDIV) * seglo + (size_t)kk * 128;
#pragma unroll
    for (int i = 0; i < 4; ++i)
      __builtin_amdgcn_global_load_lds((const unsigned*)(p[i] + off), (__attribute__((address_space(3))) unsigned*)(lds + tid16 + i * 4096), 16, 0, 0);
  }
};
typedef LdRowBF16T<1> LdRowBF16;
__device__ __forceinline__ void gemm_kstep(const unsigned char* sA, const unsigned char* sB, f32x4 (&acc)[4][4], int wr, int wc, int fr, int fq) {
#pragma unroll
  for (int ks = 0; ks < 2; ++ks) {
    bf16x8 a[4], b[4];
#pragma unroll
    for (int m = 0; m < 4; ++m) {
      const int row = wr * 64 + m * 16 + fr;
      a[m] = *(const bf16x8*)(sA + row * 128 + (((ks * 4 + fq) ^ (row & 7)) << 4));
    }
#pragma unroll
    for (int n = 0; n < 4; ++n) {
      const int row = wc * 64 + n * 16 + fr;
      b[n] = *(const bf16x8*)(sB + row * 128 + (((ks * 4 + fq) ^ (row & 7)) << 4));
    }
    __builtin_amdgcn_s_setprio(1);
#pragma unroll
    for (int m = 0; m < 4; ++m)
#pragma unroll
      for (int n = 0; n < 4; ++n) acc[m][n] = __builtin_amdgcn_mfma_f32_16x16x32_bf16(b[n], a[m], acc[m][n], 0, 0, 0);
    __builtin_amdgcn_s_setprio(0);
  }
}
template <int KPER, class AL, class BL, class Epi>
__device__ __forceinline__ void gemm_stream(unsigned char* smem, AL& al, BL& bl, int nseg, Epi epi) {
  const int tid = TIDX, lane = tid & 63, wid = tid >> 6, wr = wid >> 1, wc = wid & 1, fr = lane & 15, fq = lane >> 4;
  const int total = nseg * KPER;
  f32x4 acc[4][4];
  al.issue(0, 0, smem); bl.issue(0, 0, smem + 16384);
  asm volatile("s_waitcnt vmcnt(0)" ::: "memory");
  __syncthreads();
  for (int j = 0; j < total; ++j) {
    unsigned char* cur = smem + (j & 1) * 32768; unsigned char* nxt = smem + ((j & 1) ^ 1) * 32768;
    if (j + 1 < total) { al.issue((j + 1) / KPER, (j + 1) % KPER, nxt); bl.issue((j + 1) / KPER, (j + 1) % KPER, nxt + 16384); }
    if (j % KPER == 0) {
#pragma unroll
      for (int m = 0; m < 4; ++m)
#pragma unroll
        for (int n = 0; n < 4; ++n) acc[m][n] = (f32x4){0.f, 0.f, 0.f, 0.f};
    }
    gemm_kstep(cur, cur + 16384, acc, wr, wc, fr, fq);
    asm volatile("s_waitcnt vmcnt(0)" ::: "memory");
    __syncthreads();
    if ((j + 1) % KPER == 0) epi((j + 1) / KPER - 1, acc, cur);
  }
}

template <class RowDst>
__device__ __forceinline__ void store_tile_bf16(unsigned char* fbuf, const f32x4 (&acc)[4][4], RowDst rowdst) {
  const int tid = TIDX, lane = tid & 63, wid = tid >> 6, wr = wid >> 1, wc = wid & 1, fr = lane & 15, fq = lane >> 4;
#pragma unroll
  for (int m = 0; m < 4; ++m) {
    const int row = wr * 64 + m * 16 + fr;
#pragma unroll
    for (int n = 0; n < 4; ++n) {
      const int col = wc * 64 + n * 16 + fq * 4;
      u32x2 w; w[0] = pack2(acc[m][n][0], acc[m][n][1]); w[1] = pack2(acc[m][n][2], acc[m][n][3]);
      *(u32x2*)(fbuf + row * 256 + (((col >> 3) ^ (row & 15)) << 4) + ((col >> 2) & 1) * 8) = w;
    }
  }
  __syncthreads();
#pragma unroll
  for (int i = 0; i < 8; ++i) {
    const int q = tid + 256 * i, row = q >> 4, ch = q & 15;
    *(u32x4*)(rowdst(row) + ch * 8) = *(const u32x4*)(fbuf + row * 256 + ((ch ^ (row & 15)) << 4));
  }
  __syncthreads();
}

template <class RowDst>
__device__ __forceinline__ void store_tile_bf16_T(unsigned char* fbuf, const f32x4 (&acc)[4][4], RowDst rowdst) {
  const int tid = TIDX, lane = tid & 63, wid = tid >> 6, wr = wid >> 1, wc = wid & 1, fr = lane & 15, fq = lane >> 4;
#pragma unroll
  for (int m = 0; m < 4; ++m) {
    const int t = wr * 64 + m * 16 + fr;
#pragma unroll
    for (int n = 0; n < 4; ++n)
#pragma unroll
      for (int r = 0; r < 4; ++r) {
        const int c = wc * 64 + n * 16 + fq * 4 + r;
        *(unsigned short*)(fbuf + c * 256 + ((((t >> 3) ^ (c & 15))) << 4) + (t & 7) * 2) = (unsigned short)f2bf(acc[m][n][r]);
      }
  }
  __syncthreads();
#pragma unroll
  for (int i = 0; i < 8; ++i) {
    const int q = tid + 256 * i, row = q >> 4, ch = q & 15;
    *(u32x4*)(rowdst(row) + ch * 8) = *(const u32x4*)(fbuf + row * 256 + ((ch ^ (row & 15)) << 4));
  }
  __syncthreads();
}

#define GEMM_IDS const int tid = TIDX, lane = tid & 63, wid = tid >> 6, wr = wid >> 1, wc = wid & 1, fr = lane & 15, fq = lane >> 4; (void)tid; (void)lane;

struct Params {
  const float* in[20];
  float* out;
  char* ws;
};

constexpr int SMEM_BYTES = 69632;
constexpr int SM_MISC = 65536;

__device__ __forceinline__ void ph_cvt_x(int item, const float* __restrict__ x, bf16_t* __restrict__ xbf) {
  const int tid = TIDX;
  const size_t base = (size_t)item * 4096 + (size_t)tid * 4;
#pragma unroll
  for (int i = 0; i < 4; ++i) {
    const f32x4 v = *(const f32x4*)(x + base + (size_t)i * 1024);
    u32x2 w; w[0] = pack2(v[0], v[1]); w[1] = pack2(v[2], v[3]);
    *(u32x2*)(xbf + base + (size_t)i * 1024) = w;
  }
}
__device__ __forceinline__ void ph_cvt_wt(unsigned char* smem, int kt, int nt, const float* __restrict__ W, int K, int N, bf16_t* __restrict__ WT, bool perm = false) {
  float* tile = (float*)smem;
  const int tid = TIDX;
  const int k0 = kt * 64, n0 = nt * 64;
  __syncthreads();
#pragma unroll
  for (int i = 0; i < 4; ++i) {
    const int k = (tid >> 4) + 16 * i, n = 4 * (tid & 15);
    f32x4 v = (f32x4){0.f, 0.f, 0.f, 0.f};
    if (n0 + n < N) v = *(const f32x4*)(W + (size_t)(k0 + k) * N + n0 + n);
    tile[k * 65 + n + 0] = v[0]; tile[k * 65 + n + 1] = v[1]; tile[k * 65 + n + 2] = v[2]; tile[k * 65 + n + 3] = v[3];
  }
  __syncthreads();
  const int n = tid >> 2, kq = tid & 3;
  u32x4 w0, w1;
#pragma unroll
  for (int j = 0; j < 4; ++j) {
    w0[j] = pack2(tile[(kq * 16 + 2 * j) * 65 + n], tile[(kq * 16 + 2 * j + 1) * 65 + n]);
    w1[j] = pack2(tile[(kq * 16 + 8 + 2 * j) * 65 + n], tile[(kq * 16 + 8 + 2 * j + 1) * 65 + n]);
  }
  if (!perm) {
    bf16_t* dst = WT + (size_t)(n0 + n) * K + k0 + kq * 16;
    *(u32x4*)dst = w0; *(u32x4*)(dst + 8) = w1;
  } else {
    const int blk = kq >> 1, hi = kq & 1;
    bf16_t* dst = WT + (size_t)(n0 + n) * K + k0 + blk * 32 + 4 * hi;
    u32x2 a; a[0] = w0[0]; a[1] = w0[1]; *(u32x2*)(dst + 0) = a;
    a[0] = w0[2]; a[1] = w0[3]; *(u32x2*)(dst + 8) = a;
    a[0] = w1[0]; a[1] = w1[1]; *(u32x2*)(dst + 16) = a;
    a[0] = w1[2]; a[1] = w1[3]; *(u32x2*)(dst + 24) = a;
  }
}

struct CvtTile { const float* src; unsigned char* dst; int ldn; int K; int perm; float scale; };
__device__ __forceinline__ CvtTile cvt_decode(int it, int lane, const float* __restrict__ w_gate, const float* __restrict__ w_up, const float* __restrict__ w_down,
                                              const float* __restrict__ sw_gate, const float* __restrict__ sw_up, const float* __restrict__ sw_down, char* ws) {
  const int e = it / 192, j = it % 192;
  const float* W; unsigned char* WT; int K, N, kt, nt; float sc;
  if (j < 64) { W = (e < 256) ? w_gate + (size_t)e * DM * EFF : sw_gate; WT = (unsigned char*)ws + ((e < 256) ? WS_WTG8 + (size_t)e * EFF * DM : WS_WTSG8); K = DM; N = EFF; nt = j & 7; kt = j >> 3; sc = SC_WG; }
  else if (j < 128) { W = (e < 256) ? w_up + (size_t)e * DM * EFF : sw_up; WT = (unsigned char*)ws + ((e < 256) ? WS_WTU8 + (size_t)e * EFF * DM : WS_WTSU8); K = DM; N = EFF; nt = (j - 64) & 7; kt = (j - 64) >> 3; sc = SC_WU; }
  else { W = (e < 256) ? w_down + (size_t)e * EFF * DM : sw_down; WT = (unsigned char*)ws + ((e < 256) ? WS_WTD8 + (size_t)e * DM * EFF : WS_WTSD8); K = EFF; N = DM; nt = (j - 128) & 31; kt = (j - 128) >> 5; sc = SC_WD; }
  CvtTile t;
  t.src = W + (size_t)(kt * 128 + (lane >> 3)) * N + nt * 32 + 4 * (lane & 7);
  t.dst = WT + (size_t)(nt * 32) * K + kt * 128;
  t.ldn = 8 * N; t.K = K; t.scale = sc;
  t.perm = (j >= 128) ? 1 : 0;
  return t;
}
__device__ __forceinline__ void cvt_load(const CvtTile& t, f32x4 (&v)[16]) {
#pragma unroll
  for (int i = 0; i < 16; ++i) v[i] = *(const f32x4*)(t.src + (size_t)i * t.ldn);
}
__device__ __forceinline__ void cvt_store(float* tile  , int lane, const CvtTile& t, const f32x4 (&v)[16]) {
#pragma unroll
  for (int i = 0; i < 16; ++i) {
    float* p = tile + ((lane >> 3) + 8 * i) * 33 + 4 * (lane & 7);
    p[0] = v[i][0]; p[1] = v[i][1]; p[2] = v[i][2]; p[3] = v[i][3];
  }
  const int c = lane & 7;
  int kk[16];
#pragma unroll
  for (int tt = 0; tt < 16; ++tt)
    kk[tt] = t.perm ? (64 * (c >> 2) + 16 * (tt >> 2) + 4 * (c & 3) + (tt & 3)) : (16 * c + tt);
  const float sc = t.scale;
#pragma unroll
  for (int i = 0; i < 4; ++i) {
    const int n = (lane >> 3) + 8 * i;
    u32x4 w;
#pragma unroll
    for (int d = 0; d < 4; ++d) {
      int pk = 0;
      pk = __builtin_amdgcn_cvt_pk_fp8_f32(tile[kk[4 * d + 0] * 33 + n] * sc, tile[kk[4 * d + 1] * 33 + n] * sc, pk, false);
      pk = __builtin_amdgcn_cvt_pk_fp8_f32(tile[kk[4 * d + 2] * 33 + n] * sc, tile[kk[4 * d + 3] * 33 + n] * sc, pk, true);
      w[d] = (unsigned)pk;
    }
    *(u32x4*)(t.dst + (size_t)n * t.K + 16 * c) = w;
  }
}

__device__ __forceinline__ void ph_proj(unsigned char* smem, int xcd, int l, const bf16_t* __restrict__ xbf, const bf16_t* __restrict__ wt, bf16_t* __restrict__ proj, float* __restrict__ ba, bf16_t* __restrict__ vt) {
  const int mi = l >> 3, ni = l & 7;
  LdRowBF16T<3> al; al.init([&](int r) { return xbf + (size_t)((xcd * 32 + mi) * 128 + r) * DM; }, (size_t)8 * 128 * DM * 2, 0);
  LdRowBF16T<3> bl; bl.init([&](int r) { return wt + (size_t)(ni * 128 + r) * DM; }, 0, (size_t)8 * 128 * DM * 2);
  gemm_stream<16>(smem, al, bl, 12, [&](int seg, f32x4 (&acc)[4][4], unsigned char* fbuf) {
    GEMM_IDS
    const int nt = (seg % 3) * 8 + ni;
    if (nt < 23) {
      const int m0 = (xcd * 32 + (seg / 3) * 8 + mi) * 128, n0 = nt * 128;
      if (n0 + 128 <= PROJW) store_tile_bf16(fbuf, acc, [&](int r) { return proj + (size_t)(m0 + r) * PROJW + n0; });
      else
#pragma unroll
      for (int m = 0; m < 4; ++m)
#pragma unroll
        for (int n = 0; n < 4; ++n) {
          const int row = m0 + wr * 64 + m * 16 + fr, col = n0 + wc * 64 + n * 16 + fq * 4;
          if (col < PROJW) {
            u32x2 w; w[0] = pack2(acc[m][n][0], acc[m][n][1]); w[1] = pack2(acc[m][n][2], acc[m][n][3]);
            *(u32x2*)(proj + (size_t)row * PROJW + col) = w;
          } else if (col < INC) {
            *(f32x4*)(ba + (size_t)row * 8 + (col - PROJW)) = acc[m][n];
          }
        }
      if (n0 == OFF_SV) {
        const int bb = m0 / SEQ, t0_ = m0 % SEQ;
        store_tile_bf16_T(fbuf, acc, [&](int c) { return vt + ((size_t)(bb * 128 + c)) * SEQ + t0_; });
      }
    }
  });
}

__device__ __forceinline__ bf16x8 pack8(f32x4 a, f32x4 b) {
  union { bf16x8 v; unsigned u[4]; } x;
  x.u[0] = pack2(a[0], a[1]); x.u[1] = pack2(a[2], a[3]); x.u[2] = pack2(b[0], b[1]); x.u[3] = pack2(b[2], b[3]);
  return x.v;
}
__device__ __forceinline__ void ph_dnchunk(unsigned char* smem, int item, const bf16_t* __restrict__ proj, const float* __restrict__ ba, const float* __restrict__ conv_w,
                                           const float* __restrict__ a_log, const float* __restrict__ dt_bias,
                                           bf16_t* __restrict__ QD, bf16_t* __restrict__ W0N, bf16_t* __restrict__ KTT, bf16_t* __restrict__ RV,
                                           bf16_t* __restrict__ TM, bf16_t* __restrict__ ATT, float* __restrict__ GL) {
  const int tid = TIDX, lane = tid & 63, w = tid >> 6, fr = lane & 15, fq = lane >> 4;
  const int n = item & 63, h = (item >> 6) & 3, b = item >> 8;
  const int t0 = n * 64; const size_t row0 = (size_t)b * SEQ + t0;
  unsigned char* qs = smem; unsigned char* ks = smem + 16384; float* AT = (float*)(smem + 32768);
  const float scale = 0.08838834764831845f;
  float bL, gcL;
  {
    const float* bap = ba + (row0 + lane) * 8;
    bL = sigmoidf(bap[h]);
    const float xx = bap[4 + h] + dt_bias[h];
    const float sp = fmaxf(xx, 0.f) + log1pf(__expf(-fabsf(xx)));
    float gg = -__expf(a_log[h]) * sp;
#pragma unroll
    for (int o = 1; o < 64; o <<= 1) { const float v = __shfl_up(gg, o); if (lane >= o) gg += v; }
    gcL = gg;
  }
  {
    const int d = 2 * lane;
    float cw[3][4][2];
#pragma unroll
    for (int mx = 0; mx < 3; ++mx)
#pragma unroll
      for (int j = 0; j < 4; ++j) {
        const float2 c2 = *(const float2*)(conv_w + j * 1536 + mx * 512 + h * 128 + d);
        cw[mx][j][0] = c2.x; cw[mx][j][1] = c2.y;
      }
    const bf16_t* pbase = proj + (row0 + 16 * w) * PROJW + h * 128 + d;
    unsigned raw[3][19];
#pragma unroll
    for (int j = 0; j < 19; ++j) {
      const bool ok = (t0 + 16 * w - 3 + j) >= 0;
#pragma unroll
      for (int mx = 0; mx < 3; ++mx) {
        unsigned u = 0;
        if (ok) u = *(const unsigned*)(pbase + (ptrdiff_t)(j - 3) * PROJW + mx * 512);
        raw[mx][j] = u;
      }
    }
#pragma unroll
    for (int i = 0; i < 16; ++i) {
      float s[3][2];
#pragma unroll
      for (int mx = 0; mx < 3; ++mx) {
        float y0 = 0.f, y1 = 0.f;
#pragma unroll
        for (int j = 0; j < 4; ++j) { y0 += cw[mx][j][0] * bflo(raw[mx][i + j]); y1 += cw[mx][j][1] * bfhi(raw[mx][i + j]); }
        s[mx][0] = siluf(y0); s[mx][1] = siluf(y1);
      }
      const int row = 16 * w + i;
      const float rq = rsqrtf(wave_sum(s[0][0] * s[0][0] + s[0][1] * s[0][1]) + L2_EPS);
      const float rk = rsqrtf(wave_sum(s[1][0] * s[1][0] + s[1][1] * s[1][1]) + L2_EPS);
      const int off = row * 256 + ((((lane >> 2) ^ (row & 15))) << 4) + (lane & 3) * 4;
      *(unsigned*)(qs + off) = pack2(s[0][0] * rq, s[0][1] * rq);
      *(unsigned*)(ks + off) = pack2(s[1][0] * rk, s[1][1] * rk);
      const float bi = __shfl(bL, row);
      *(unsigned*)(RV + ((size_t)item * 64 + row) * 128 + d) = pack2(bi * s[2][0], bi * s[2][1]);
    }
  }
  __syncthreads();
  {
    f32x4 aKK[4], aQK[4];
#pragma unroll
    for (int nt = 0; nt < 4; ++nt) { aKK[nt] = (f32x4){0.f, 0.f, 0.f, 0.f}; aQK[nt] = (f32x4){0.f, 0.f, 0.f, 0.f}; }
#pragma unroll
    for (int k4 = 0; k4 < 4; ++k4) {
      const int arow = 16 * w + fr;
      const bf16x8 aq = *(const bf16x8*)(qs + arow * 256 + ((((k4 * 4 + fq) ^ (arow & 15))) << 4));
      const bf16x8 ak = *(const bf16x8*)(ks + arow * 256 + ((((k4 * 4 + fq) ^ (arow & 15))) << 4));
#pragma unroll
      for (int nt = 0; nt < 4; ++nt) {
        const int brow = 16 * nt + fr;
        const bf16x8 bk = *(const bf16x8*)(ks + brow * 256 + ((((k4 * 4 + fq) ^ (brow & 15))) << 4));
        aKK[nt] = __builtin_amdgcn_mfma_f32_16x16x32_bf16(ak, bk, aKK[nt], 0, 0, 0);
        aQK[nt] = __builtin_amdgcn_mfma_f32_16x16x32_bf16(bk, aq, aQK[nt], 0, 0, 0);
      }
    }
    float gci[4], bi[4];
#pragma unroll
    for (int r = 0; r < 4; ++r) { gci[r] = __shfl(gcL, 16 * w + 4 * fq + r); bi[r] = __shfl(bL, 16 * w + 4 * fq + r); }
    const float gci2 = __shfl(gcL, 16 * w + fr);
#pragma unroll
    for (int nt = 0; nt < 4; ++nt) {
      const int j = 16 * nt + fr;
      const float gcj = __shfl(gcL, j);
      float av[4], at[4];
#pragma unroll
      for (int r = 0; r < 4; ++r) {
        const int i = 16 * w + 4 * fq + r;
        const float dec = (j <= i) ? __expf(gci[r] - gcj) : 0.f;
        av[r] = (j < i) ? bi[r] * aKK[nt][r] * dec : 0.f;
        const int i2 = 16 * w + fr, j2 = 16 * nt + 4 * fq + r;
        const float gcj2 = __shfl(gcL, j2);
        const float dec2 = (j2 <= i2) ? __expf(gci2 - gcj2) : 0.f;
        at[r] = aQK[nt][r] * scale * dec2;
      }
      *(float4*)(AT + j * 68 + 16 * w + 4 * fq) = make_float4(av[0], av[1], av[2], av[3]);
      u32x2 wv; wv[0] = pack2(at[0], at[1]); wv[1] = pack2(at[2], at[3]);
      *(u32x2*)(ATT + ((size_t)item * 64 + 16 * w + fr) * 64 + 32 * (nt >> 1) + 8 * fq + 4 * (nt & 1)) = wv;
    }
  }
  __syncthreads();
  if (w == 0) {
    float Tr[64];
    int ln = lane; asm volatile("" : "+v"(ln));
#pragma unroll
    for (int j = 0; j < 64; ++j) Tr[j] = 0.f;
    f32x4 cur[16], nxt[16];
#pragma unroll
    for (int j4 = 0; j4 < 16; ++j4) nxt[j4] = (f32x4){0.f, 0.f, 0.f, 0.f};
#pragma unroll
    for (int j4 = 15; j4 >= 16; --j4) cur[j4] = *(const f32x4*)(AT + 63 * 68 + j4 * 4);
#pragma unroll
    for (int c = 63; c >= 0; --c) {
      if (c > 0) {
#pragma unroll
        for (int j4 = 15; j4 >= c / 4; --j4) nxt[j4] = *(const f32x4*)(AT + (c - 1) * 68 + j4 * 4);
      }
      float a0 = 0.f, a1 = 0.f, a2 = 0.f, a3 = 0.f;
#pragma unroll
      for (int j4 = 15; j4 >= (c + 1) / 4; --j4) {
        asm volatile("v_fmac_f32 %0, %1, %2" : "+v"(a0) : "v"(Tr[4 * j4 + 0]), "v"(cur[j4][0]));
        asm volatile("v_fmac_f32 %0, %1, %2" : "+v"(a1) : "v"(Tr[4 * j4 + 1]), "v"(cur[j4][1]));
        asm volatile("v_fmac_f32 %0, %1, %2" : "+v"(a2) : "v"(Tr[4 * j4 + 2]), "v"(cur[j4][2]));
        asm volatile("v_fmac_f32 %0, %1, %2" : "+v"(a3) : "v"(Tr[4 * j4 + 3]), "v"(cur[j4][3]));
      }
      Tr[c] = ((ln == c) ? 1.f : 0.f) - ((a0 + a1) + (a2 + a3));
#pragma unroll
      for (int j4 = 0; j4 < 16; ++j4) cur[j4] = nxt[j4];
    }
    u32x4* tp = (u32x4*)(TM + ((size_t)item * 64 + lane) * 64);
#pragma unroll
    for (int oc = 0; oc < 8; ++oc) {
      const int k0 = 32 * (oc >> 2) + 4 * (oc & 3);
      u32x4 v;
      v[0] = pack2(Tr[k0 + 0], Tr[k0 + 1]); v[1] = pack2(Tr[k0 + 2], Tr[k0 + 3]);
      v[2] = pack2(Tr[k0 + 16], Tr[k0 + 17]); v[3] = pack2(Tr[k0 + 18], Tr[k0 + 19]);
      tp[oc] = v;
    }
  } else {
    const float gclast = __shfl(gcL, 63);
    if (tid == 64) GL[item] = __expf(gclast);
#pragma unroll 1
    for (int it = 0; it < 16; ++it) {
      const int idx = (tid - 64) + it * 192;
      const int mtx = idx >> 10, rem = idx & 1023;
      if (mtx < 2) {
        const int i = rem >> 4, oc = rem & 15;
        const float gi = __shfl(gcL, i), bi = __shfl(bL, i);
        const float f = (mtx == 0) ? scale * __expf(gi) : -bi * __expf(gi);
        const unsigned char* st = (mtx == 0) ? qs : ks;
        const int d0 = 32 * (oc >> 2) + 4 * (oc & 3);
        const uint2 lo = *(const uint2*)(st + i * 256 + ((((d0 >> 3) ^ (i & 15))) << 4) + (d0 & 7) * 2);
        const uint2 hi = *(const uint2*)(st + i * 256 + (((((d0 + 16) >> 3) ^ (i & 15))) << 4) + (d0 & 7) * 2);
        u32x4 v;
        v[0] = pack2(bflo(lo.x) * f, bfhi(lo.x) * f); v[1] = pack2(bflo(lo.y) * f, bfhi(lo.y) * f);
        v[2] = pack2(bflo(hi.x) * f, bfhi(hi.x) * f); v[3] = pack2(bflo(hi.y) * f, bfhi(hi.y) * f);
        bf16_t* dst = ((mtx == 0) ? QD : W0N) + ((size_t)item * 64 + i) * 128 + 8 * oc;
        *(u32x4*)dst = v;
      } else {
        const int d = rem & 127, oc = rem >> 7;
        const int j0 = 32 * (oc >> 2) + 4 * (oc & 3);
        float val[8];
#pragma unroll
        for (int e = 0; e < 8; ++e) {
          const int j = j0 + (e & 3) + ((e >> 2) << 4);
          const float f = __expf(gclast - __shfl(gcL, j));
          const unsigned short raw = *(const unsigned short*)(ks + j * 256 + ((((d >> 3) ^ (j & 15))) << 4) + (d & 7) * 2);
          val[e] = bf2f(raw) * f;
        }
        u32x4 v;
        v[0] = pack2(val[0], val[1]); v[1] = pack2(val[2], val[3]); v[2] = pack2(val[4], val[5]); v[3] = pack2(val[6], val[7]);
        *(u32x4*)(KTT + ((size_t)item * 128 + d) * 64 + 8 * oc) = v;
      }
    }
  }
  __syncthreads();
}

__device__ __forceinline__ void ph_dnscan(unsigned char* smem, int item, const bf16_t* __restrict__ QDp, const bf16_t* __restrict__ W0Np, const bf16_t* __restrict__ KTTp,
                                          const bf16_t* __restrict__ RVp, const bf16_t* __restrict__ TMp, const bf16_t* __restrict__ ATTp, const float* __restrict__ GLp,
                                          float* __restrict__ op) {
  const int tid = TIDX, lane = tid & 63, w = tid >> 6, fr = lane & 15, fq = lane >> 4;
  const int bh = item >> 1, half = item & 1, b = bh >> 2, h = bh & 3;
  const int vcol0 = (half * 4 + w) * 16;
  unsigned char* sW0 = smem; unsigned char* sQD = smem + 16384; unsigned char* sKT = smem + 32768; unsigned char* sT = smem + 49152; unsigned char* sAT = smem + 57344;
  f32x4 S[8];
#pragma unroll
  for (int t = 0; t < 8; ++t) S[t] = (f32x4){0.f, 0.f, 0.f, 0.f};
  u32x4 pfA[8], pfB[8]; unsigned short rvp[16];
#define DN_LOAD_A(nn_) do { \
    const size_t ci = (size_t)bh * 64 + (nn_); \
    _Pragma("unroll") for (int i = 0; i < 4; ++i) pfA[i] = *(const u32x4*)((const char*)W0Np + ci * 16384 + (size_t)(tid + 256 * i) * 16); \
    _Pragma("unroll") for (int i = 0; i < 4; ++i) pfA[4 + i] = *(const u32x4*)((const char*)QDp + ci * 16384 + (size_t)(tid + 256 * i) * 16); \
    _Pragma("unroll") for (int mt = 0; mt < 4; ++mt) \
      _Pragma("unroll") for (int r = 0; r < 4; ++r) rvp[mt * 4 + r] = RVp[(ci * 64 + 16 * mt + 4 * fq + r) * 128 + vcol0 + fr]; \
  } while (0)
#define DN_STORE_A() do { \
    _Pragma("unroll") for (int i = 0; i < 4; ++i) { const int q = tid + 256 * i, row = q >> 4, ch = q & 15; *(u32x4*)(sW0 + row * 256 + ((ch ^ (row & 15)) << 4)) = pfA[i]; } \
    _Pragma("unroll") for (int i = 0; i < 4; ++i) { const int q = tid + 256 * i, row = q >> 4, ch = q & 15; *(u32x4*)(sQD + row * 256 + ((ch ^ (row & 15)) << 4)) = pfA[4 + i]; } \
  } while (0)
#define DN_LOAD_B(nn_) do { \
    const size_t ci = (size_t)bh * 64 + (nn_); \
    _Pragma("unroll") for (int i = 0; i < 4; ++i) pfB[i] = *(const u32x4*)((const char*)KTTp + ci * 16384 + (size_t)(tid + 256 * i) * 16); \
    _Pragma("unroll") for (int i = 0; i < 2; ++i) pfB[4 + i] = *(const u32x4*)((const char*)TMp + ci * 8192 + (size_t)(tid + 256 * i) * 16); \
    _Pragma("unroll") for (int i = 0; i < 2; ++i) pfB[6 + i] = *(const u32x4*)((const char*)ATTp + ci * 8192 + (size_t)(tid + 256 * i) * 16); \
  } while (0)
#define DN_STORE_B() do { \
    _Pragma("unroll") for (int i = 0; i < 4; ++i) { const int q = tid + 256 * i, row = q >> 3, ch = q & 7; *(u32x4*)(sKT + row * 128 + ((ch ^ (row & 7)) << 4)) = pfB[i]; } \
    _Pragma("unroll") for (int i = 0; i < 2; ++i) { const int q = tid + 256 * i, row = q >> 3, ch = q & 7; *(u32x4*)(sT + row * 128 + ((ch ^ (row & 7)) << 4)) = pfB[4 + i]; } \
    _Pragma("unroll") for (int i = 0; i < 2; ++i) { const int q = tid + 256 * i, row = q >> 3, ch = q & 7; *(u32x4*)(sAT + row * 128 + ((ch ^ (row & 7)) << 4)) = pfB[6 + i]; } \
  } while (0)
#define DN_ZINIT() do { _Pragma("unroll") for (int mt = 0; mt < 4; ++mt) Z[mt] = (f32x4){bf2f(rvp[mt * 4 + 0]), bf2f(rvp[mt * 4 + 1]), bf2f(rvp[mt * 4 + 2]), bf2f(rvp[mt * 4 + 3])}; } while (0)
  __syncthreads();
  f32x4 Z[4];
  DN_LOAD_A(0);
  DN_LOAD_B(0);
  DN_STORE_A();
  DN_ZINIT();
  DN_LOAD_A(1);
  for (int nn = 0; nn < 64; ++nn) {
    const float gl = GLp[(size_t)bh * 64 + nn];
    __syncthreads();
    bf16x8 Sb[4];
#pragma unroll
    for (int k4 = 0; k4 < 4; ++k4) Sb[k4] = pack8(S[2 * k4], S[2 * k4 + 1]);
    f32x4 O[4];
#pragma unroll
    for (int mt = 0; mt < 4; ++mt) {
      O[mt] = (f32x4){0.f, 0.f, 0.f, 0.f};
      const int row = 16 * mt + fr;
#pragma unroll
      for (int k4 = 0; k4 < 4; ++k4) {
        const int off = row * 256 + ((((k4 * 4 + fq) ^ fr)) << 4);
        const bf16x8 aw = *(const bf16x8*)(sW0 + off);
        const bf16x8 aq = *(const bf16x8*)(sQD + off);
        Z[mt] = __builtin_amdgcn_mfma_f32_16x16x32_bf16(aw, Sb[k4], Z[mt], 0, 0, 0);
        O[mt] = __builtin_amdgcn_mfma_f32_16x16x32_bf16(Sb[k4], aq, O[mt], 0, 0, 0);
      }
    }
    bf16x8 Zb[2];
    Zb[0] = pack8(Z[0], Z[1]); Zb[1] = pack8(Z[2], Z[3]);
    DN_STORE_B();
    if (nn + 1 < 64) DN_LOAD_B(nn + 1);
    __syncthreads();
    f32x4 Vn[4];
#pragma unroll
    for (int mt = 0; mt < 4; ++mt) {
      Vn[mt] = (f32x4){0.f, 0.f, 0.f, 0.f};
      const int row = 16 * mt + fr;
#pragma unroll
      for (int s = 0; s < 2; ++s) {
        if (s <= (mt >> 1)) {
          const bf16x8 at = *(const bf16x8*)(sT + row * 128 + ((((s * 4 + fq) ^ (row & 7))) << 4));
          Vn[mt] = __builtin_amdgcn_mfma_f32_16x16x32_bf16(at, Zb[s], Vn[mt], 0, 0, 0);
        }
      }
    }
    bf16x8 Vb[2];
    Vb[0] = pack8(Vn[0], Vn[1]); Vb[1] = pack8(Vn[2], Vn[3]);
#pragma unroll
    for (int mt = 0; mt < 4; ++mt) {
      const int row = 16 * mt + fr;
#pragma unroll
      for (int s = 0; s < 2; ++s) {
        if (s <= (mt >> 1)) {
          const bf16x8 aa = *(const bf16x8*)(sAT + row * 128 + ((((s * 4 + fq) ^ (row & 7))) << 4));
          O[mt] = __builtin_amdgcn_mfma_f32_16x16x32_bf16(Vb[s], aa, O[mt], 0, 0, 0);
        }
      }
      *(f32x4*)(op + ((size_t)b * SEQ + nn * 64 + 16 * mt + fr) * 512 + h * 128 + vcol0 + 4 * fq) = O[mt];
    }
#pragma unroll
    for (int t = 0; t < 8; ++t) {
      S[t] = S[t] * gl;
      const int row = 16 * t + fr;
#pragma unroll
      for (int s = 0; s < 2; ++s) {
        const bf16x8 ak = *(const bf16x8*)(sKT + row * 128 + ((((s * 4 + fq) ^ (row & 7))) << 4));
        S[t] = __builtin_amdgcn_mfma_f32_16x16x32_bf16(ak, Vb[s], S[t], 0, 0, 0);
      }
    }
    if (nn + 1 < 64) {
      DN_STORE_A();
      DN_ZINIT();
      if (nn + 2 < 64) DN_LOAD_A(nn + 2);
    }
  }
  __syncthreads();
#undef DN_ZINIT
#undef DN_LOAD_A
#undef DN_STORE_A
#undef DN_LOAD_B
#undef DN_STORE_B
}

__device__ __forceinline__ void ph_dn_post(int item, const float* __restrict__ o, const bf16_t* __restrict__ proj, const float* __restrict__ dn_norm_g, bf16_t* __restrict__ mixed) {
  const int tid = TIDX, h = tid >> 6, lane = tid & 63;
  const float2 g2 = *(const float2*)(dn_norm_g + 2 * lane);
  float2 ov[4]; unsigned zv[4];
#pragma unroll
  for (int i = 0; i < 4; ++i) {
    const size_t n = (size_t)item * 4 + i;
    ov[i] = *(const float2*)(o + n * 512 + h * 128 + 2 * lane);
    zv[i] = *(const unsigned*)(proj + n * PROJW + OFF_Z + h * 128 + 2 * lane);
  }
#pragma unroll
  for (int i = 0; i < 4; ++i) {
    const size_t n = (size_t)item * 4 + i;
    const float ss = wave_sum(ov[i].x * ov[i].x + ov[i].y * ov[i].y);
    const float rn = rsqrtf(ss * (1.f / 128.f) + RMS_EPS);
    *(unsigned*)(mixed + n * DM + h * 128 + 2 * lane) = pack2(ov[i].x * rn * g2.x * siluf(bflo(zv[i])), ov[i].y * rn * g2.y * siluf(bfhi(zv[i])));
  }
}

__device__ __forceinline__ void ph_swa(unsigned char* smem, int item, const bf16_t* __restrict__ proj, const bf16_t* __restrict__ vt, const float* __restrict__ sinks, bf16_t* __restrict__ mixed) {
  const int tid = TIDX, lane = tid & 63, w = tid >> 6, fr = lane & 15, fq = lane >> 4;
  const int qb = item & 31, kvh = (item >> 5) & 1, b = item >> 6;
  const int t0 = qb * 128;
  const size_t rowb = (size_t)b * SEQ;
  unsigned char* sK = smem;
  unsigned char* sV = smem + 32768;
  __syncthreads();
#pragma unroll
  for (int i = 0; i < 8; ++i) {
    const int q = tid + 256 * i, row = q >> 3, ch = q & 7;
    const int pos = t0 - 128 + row;
    u32x4 v = (u32x4){0u, 0u, 0u, 0u};
    if (pos >= 0) v = *(const u32x4*)(proj + (rowb + pos) * PROJW + OFF_SK + kvh * 64 + ch * 8);
    *(u32x4*)(sK + row * 128 + ((ch ^ (row & 7)) << 4)) = v;
  }
#pragma unroll
  for (int i = 0; i < 8; ++i) {
    const int q = tid + 256 * i, row = q >> 5, ch = q & 31;
    const int pos = t0 - 128 + ch * 8;
    u32x4 v = (u32x4){0u, 0u, 0u, 0u};
    if (pos >= 0) v = *(const u32x4*)(vt + ((size_t)(b * 128 + kvh * 64 + row)) * SEQ + pos);
    *(u32x4*)(sV + row * 512 + ((ch ^ (row & 15)) << 4)) = v;
  }
  __syncthreads();
  const int head = kvh * 4 + w;
  const float slope = exp2f(-(float)(head + 1));
  const float sink = sinks[head];
  const bf16_t* qp0 = proj + (rowb + t0 + fr) * PROJW + OFF_SQ + head * 64 + fq * 8;
  bf16x8 qn0 = *(const bf16x8*)(qp0), qn1 = *(const bf16x8*)(qp0 + 32);
#pragma unroll 1
  for (int qt = 0; qt < 8; ++qt) {
    const bf16x8 qf0 = qn0, qf1 = qn1;
    if (qt < 7) { const bf16_t* qp = qp0 + (size_t)(qt + 1) * 16 * PROJW; qn0 = *(const bf16x8*)(qp); qn1 = *(const bf16x8*)(qp + 32); }
    const int kp0 = qt >> 1;
    f32x4 st[10];
#pragma unroll
    for (int kt = 0; kt < 10; ++kt) {
      const int krow = (2 * kp0 + kt) * 16 + fr;
      st[kt] = (f32x4){0.f, 0.f, 0.f, 0.f};
      const bf16x8 k0 = *(const bf16x8*)(sK + krow * 128 + (((0 + fq) ^ (krow & 7)) << 4));
      const bf16x8 k1 = *(const bf16x8*)(sK + krow * 128 + (((4 + fq) ^ (krow & 7)) << 4));
      st[kt] = __builtin_amdgcn_mfma_f32_16x16x32_bf16(k0, qf0, st[kt], 0, 0, 0);
      st[kt] = __builtin_amdgcn_mfma_f32_16x16x32_bf16(k1, qf1, st[kt], 0, 0, 0);
    }
    const int i = qt * 16 + fr;
    float mx = sink;
#pragma unroll
    for (int kt = 0; kt < 10; ++kt)
#pragma unroll
      for (int r = 0; r < 4; ++r) {
        const int jb = (2 * kp0 + kt) * 16 + 4 * fq + r;
        const int dist = 128 + i - jb;
        const bool ok = (dist >= 0) && (dist < 128) && (t0 - 128 + jb >= 0);
        const float s = ok ? (st[kt][r] * 0.125f - slope * (float)dist) : -INFINITY;
        st[kt][r] = s;
        mx = fmaxf(mx, s);
      }
    mx = fmaxf(mx, __shfl_xor(mx, 16));
    mx = fmaxf(mx, __shfl_xor(mx, 32));
    float sum = 0.f;
#pragma unroll
    for (int kt = 0; kt < 10; ++kt)
#pragma unroll
      for (int r = 0; r < 4; ++r) { const float p = __expf(st[kt][r] - mx); st[kt][r] = p; sum += p; }
    sum += __shfl_xor(sum, 16);
    sum += __shfl_xor(sum, 32);
    const float inv = 1.f / (sum + __expf(sink - mx));
    f32x4 O[4];
#pragma unroll
    for (int nt = 0; nt < 4; ++nt) O[nt] = (f32x4){0.f, 0.f, 0.f, 0.f};
#pragma unroll
    for (int s5 = 0; s5 < 5; ++s5) {
      const bf16x8 pa = pack8(st[2 * s5] * inv, st[2 * s5 + 1] * inv);
      const int key0 = (2 * kp0 + 2 * s5) * 16 + 4 * fq;
#pragma unroll
      for (int nt = 0; nt < 4; ++nt) {
        const int drow = nt * 16 + fr;
        const int c0 = key0 >> 3, c1 = (key0 + 16) >> 3;
        const u32x2 lo = *(const u32x2*)(sV + drow * 512 + ((c0 ^ (drow & 15)) << 4) + ((key0 >> 2) & 1) * 8);
        const u32x2 hi = *(const u32x2*)(sV + drow * 512 + ((c1 ^ (drow & 15)) << 4) + ((key0 >> 2) & 1) * 8);
        const u32x4 vb = (u32x4){lo[0], lo[1], hi[0], hi[1]};
        O[nt] = __builtin_amdgcn_mfma_f32_16x16x32_bf16(__builtin_bit_cast(bf16x8, vb), pa, O[nt], 0, 0, 0);
      }
    }
#pragma unroll
    for (int nt = 0; nt < 4; ++nt) {
      u32x2 wv; wv[0] = pack2(O[nt][0], O[nt][1]); wv[1] = pack2(O[nt][2], O[nt][3]);
      *(u32x2*)(mixed + (rowb + t0 + qt * 16 + fr) * DM + 512 + head * 64 + nt * 16 + 4 * fq) = wv;
    }
  }
}

__device__ __forceinline__ void ph_wout(unsigned char* smem, int xcd, int l, const bf16_t* __restrict__ mixed, const bf16_t* __restrict__ wt, bf16_t* __restrict__ mixo) {
  const int mi = l >> 3, ni = l & 7;
  LdRowBF16 al; al.init([&](int r) { return mixed + (size_t)((xcd * 32 + mi) * 128 + r) * DM; }, (size_t)8 * 128 * DM * 2);
  LdRowBF16 bl; bl.init([&](int r) { return wt + (size_t)(ni * 128 + r) * DM; }, 0);
  gemm_stream<16>(smem, al, bl, 4, [&](int seg, f32x4 (&acc)[4][4], unsigned char* fbuf) {
    const int m0 = (xcd * 32 + seg * 8 + mi) * 128, n0 = ni * 128;
    store_tile_bf16(fbuf, acc, [&](int r) { return mixo + (size_t)(m0 + r) * DM + n0; });
  });
}

__device__ __forceinline__ void ph_ln1(int item, const float* __restrict__ x, const bf16_t* __restrict__ mixo, const float* __restrict__ gam, const float* __restrict__ bet, bf16_t* __restrict__ xbf, unsigned char* __restrict__ x8) {
  const int row = item * 4 + (TIDX >> 6), lane = TIDX & 63;
  const float4* p = (const float4*)(x + (size_t)row * DM);
  const u32x2* pm = (const u32x2*)(mixo + (size_t)row * DM);
  float4 v[4]; float s = 0.f;
#pragma unroll
  for (int i = 0; i < 4; ++i) {
    const float4 xv = p[lane + i * 64]; const u32x2 mv = pm[lane + i * 64];
    v[i].x = ALPHA * xv.x + bflo(mv[0]); v[i].y = ALPHA * xv.y + bfhi(mv[0]); v[i].z = ALPHA * xv.z + bflo(mv[1]); v[i].w = ALPHA * xv.w + bfhi(mv[1]);
    s += v[i].x + v[i].y + v[i].z + v[i].w;
  }
  const float mu = wave_sum(s) * (1.f / DM);
  float q = 0.f;
#pragma unroll
  for (int i = 0; i < 4; ++i) { const float a = v[i].x - mu, b = v[i].y - mu, c = v[i].z - mu, d = v[i].w - mu; q += a * a + b * b + c * c + d * d; }
  const float rs = rsqrtf(wave_sum(q) * (1.f / DM) + LN_EPS);
#pragma unroll
  for (int i = 0; i < 4; ++i) {
    const float4 gg = ((const float4*)gam)[lane + i * 64], bb = ((const float4*)bet)[lane + i * 64];
    u32x2 w;
    w[0] = pack2((v[i].x - mu) * rs * gg.x + bb.x, (v[i].y - mu) * rs * gg.y + bb.y);
    w[1] = pack2((v[i].z - mu) * rs * gg.z + bb.z, (v[i].w - mu) * rs * gg.w + bb.w);
    ((u32x2*)(xbf + (size_t)row * DM))[lane + i * 64] = w;
    int pk = 0;
    pk = __builtin_amdgcn_cvt_pk_fp8_f32((v[i].x - mu) * rs * gg.x + bb.x, (v[i].y - mu) * rs * gg.y + bb.y, pk, false);
    pk = __builtin_amdgcn_cvt_pk_fp8_f32((v[i].z - mu) * rs * gg.z + bb.z, (v[i].w - mu) * rs * gg.w + bb.w, pk, true);
    ((int*)(x8 + (size_t)row * DM))[lane + i * 64] = pk;
  }
}

__device__ __forceinline__ void ph_router(unsigned char* smem, int tile, const bf16_t* __restrict__ xbf, const bf16_t* __restrict__ wt, float* __restrict__ logits) {
  GEMM_IDS
  const int n0 = (tile & 1) * 128, m0 = (tile >> 1) * 128;
  LdRowBF16 al; al.init([&](int r) { return xbf + (size_t)(m0 + r) * DM; }, 0);
  LdRowBF16 bl; bl.init([&](int r) { return wt + (size_t)(n0 + r) * DM; }, 0);
  gemm_stream<16>(smem, al, bl, 1, [&](int seg, f32x4 (&acc)[4][4], unsigned char* fbuf) {
    GEMM_IDS
#pragma unroll
    for (int m = 0; m < 4; ++m)
#pragma unroll
      for (int n = 0; n < 4; ++n)
        *(f32x4*)(logits + (size_t)(m0 + wr * 64 + m * 16 + fr) * NEXP + n0 + wc * 64 + n * 16 + fq * 4) = acc[m][n];
  });
}

__device__ __forceinline__ unsigned rt_fkey(float f) { const unsigned b = __float_as_uint(f); return (b & 0x80000000u) ? ~b : (b | 0x80000000u); }
#define RT_DPPF(x, ctrl) __builtin_bit_cast(float, __builtin_amdgcn_update_dpp(__builtin_bit_cast(int, x), __builtin_bit_cast(int, x), ctrl, 0xf, 0xf, false))
#define RT_DPPU(x, ctrl, rmask) (unsigned)__builtin_amdgcn_update_dpp((int)(x), (int)(x), ctrl, rmask, 0xf, false)
#define RT_KSTEP(hi, lo, ctrl, rmask) { const unsigned ph_ = RT_DPPU(hi, ctrl, rmask), pl_ = RT_DPPU(lo, ctrl, rmask); \
    const bool t_ = (ph_ > hi) || (ph_ == hi && pl_ > lo); hi = t_ ? ph_ : hi; lo = t_ ? pl_ : lo; }
__device__ __forceinline__ void ph_route(int item, const float* __restrict__ logits, const float* __restrict__ router_bias, int* __restrict__ cnt, int* __restrict__ list, float* __restrict__ gates) {
  const int n = item * 4 + (TIDX >> 6), lane = TIDX & 63;
  const float4 lg = ((const float4*)(logits + (size_t)n * NEXP))[lane];
  const float4 rb = ((const float4*)router_bias)[lane];
  const float sc0 = sigmoidf(lg.x), sc1 = sigmoidf(lg.y), sc2 = sigmoidf(lg.z), sc3 = sigmoidf(lg.w);
  const float sel0 = sc0 + rb.x, sel1 = sc1 + rb.y, sel2 = sc2 + rb.z, sel3 = sc3 + rb.w;
  float t1 = fmaxf(sel0, sel1), t2 = fminf(sel0, sel1);
  { const float a = sel2; if (a > t1) { t2 = t1; t1 = a; } else if (a > t2) t2 = a; }
  { const float a = sel3; if (a > t1) { t2 = t1; t1 = a; } else if (a > t2) t2 = a; }
  { const float b1 = RT_DPPF(t1, 0xB1), b2 = RT_DPPF(t2, 0xB1); const float n1 = fmaxf(t1, b1), n2 = fmaxf(fminf(t1, b1), fmaxf(t2, b2)); t1 = n1; t2 = n2; }
  { const float b1 = RT_DPPF(t1, 0x4E), b2 = RT_DPPF(t2, 0x4E); const float n1 = fmaxf(t1, b1), n2 = fmaxf(fminf(t1, b1), fmaxf(t2, b2)); t1 = n1; t2 = n2; }
  { const float b1 = RT_DPPF(t1, 0x141), b2 = RT_DPPF(t2, 0x141); const float n1 = fmaxf(t1, b1), n2 = fmaxf(fminf(t1, b1), fmaxf(t2, b2)); t1 = n1; t2 = n2; }
  const float gs = t1 + t2;
  const int mygrp = lane >> 3;
  int rank = 0;
#pragma unroll
  for (int j = 0; j < 8; ++j) {
    const float o = __builtin_bit_cast(float, __builtin_amdgcn_readlane(__builtin_bit_cast(int, gs), j * 8));
    rank += (o > gs || (o == gs && j < mygrp)) ? 1 : 0;
  }
  const bool gsel = rank < 4;
  unsigned k0 = gsel ? rt_fkey(sel0) : 0u, k1 = gsel ? rt_fkey(sel1) : 0u, k2 = gsel ? rt_fkey(sel2) : 0u, k3 = gsel ? rt_fkey(sel3) : 0u;
  float gsum = 0.f; float myg = 0.f; int mye = 0;
#pragma unroll 1
  for (int r = 0; r < TOPK; ++r) {
    unsigned hi = k0, lo = 255u - (unsigned)(lane * 4);
    if (k1 > hi) { hi = k1; lo = 255u - (unsigned)(lane * 4 + 1); }
    if (k2 > hi) { hi = k2; lo = 255u - (unsigned)(lane * 4 + 2); }
    if (k3 > hi) { hi = k3; lo = 255u - (unsigned)(lane * 4 + 3); }
    RT_KSTEP(hi, lo, 0xB1, 0xf) RT_KSTEP(hi, lo, 0x4E, 0xf) RT_KSTEP(hi, lo, 0x141, 0xf) RT_KSTEP(hi, lo, 0x140, 0xf)
    RT_KSTEP(hi, lo, 0x142, 0xa) RT_KSTEP(hi, lo, 0x143, 0xc)
    const int be = 255 - __builtin_amdgcn_readlane((int)lo, 63);
    const int owner = be >> 2, slot = be & 3;
    const float tsel = (slot == 0) ? sc0 : (slot == 1) ? sc1 : (slot == 2) ? sc2 : sc3;
    const float bs = __builtin_bit_cast(float, __builtin_amdgcn_readlane(__builtin_bit_cast(int, tsel), owner));
    if (lane == owner) { if (slot == 0) k0 = 0u; else if (slot == 1) k1 = 0u; else if (slot == 2) k2 = 0u; else k3 = 0u; }
    gsum += bs;
    if (lane == r) { myg = bs; mye = be; }
  }
  if (lane < TOPK) {
    const int sh = item & (NSH - 1);
    const int slot = atomicAdd(&cnt[sh * NEXP + mye], 1);
    list[((size_t)sh * NEXP + mye) * CAPS + slot] = n * TOPK + lane;
    gates[(size_t)n * TOPK + lane] = myg / gsum * 2.5f;
  }
}
#undef RT_KSTEP

__device__ __forceinline__ void moe_build_prefix(const int* __restrict__ cnt, int* sscan) {
  const int tid = TIDX;
  const int e = ((tid & 31) << 3) | (tid >> 5);
  int c = 0;
#pragma unroll
  for (int s = 0; s < NSH; ++s) c += cnt[s * NEXP + e];
  __syncthreads();
  sscan[tid] = (c + 127) >> 7;
  __syncthreads();
  for (int o = 1; o < 256; o <<= 1) {
    const int v = (tid >= o) ? sscan[tid - o] : 0;
    __syncthreads();
    sscan[tid] += v;
    __syncthreads();
  }
}
__device__ __forceinline__ void moe_locate(const int* sscan, int x, int lt, int& e, int& rt) {
  const int base = x ? sscan[32 * x - 1] : 0;
  const int nrouted = sscan[32 * x + 31] - base;
  if (lt >= nrouted) { e = 256; rt = x * (NTOK / 128 / 8) + (lt - nrouted); return; }
  const int g = base + lt;
  int lo = 32 * x, hi = 32 * x + 31;
  while (lo < hi) { const int mid = (lo + hi) >> 1; if (sscan[mid] > g) hi = mid; else lo = mid + 1; }
  e = ((lo & 31) << 3) | (lo >> 5); rt = g - (lo ? sscan[lo - 1] : 0);
}

typedef int v8i __attribute__((ext_vector_type(8)));
typedef int i32x4 __attribute__((ext_vector_type(4)));
#define MX_ONE 0x7f7f7f7f
__device__ __forceinline__ long lo64(const u32x4& v) { return (long)(((unsigned long long)v[1] << 32) | (unsigned long long)v[0]); }
__device__ __forceinline__ long hi64(const u32x4& v) { return (long)(((unsigned long long)v[3] << 32) | (unsigned long long)v[2]); }
__device__ __forceinline__ void ph_moe(unsigned char* smem, int e, int rt, const unsigned char* __restrict__ x8, const int* __restrict__ cnt,
                                       const int* __restrict__ list, const float* __restrict__ gates, const unsigned char* __restrict__ wge, const unsigned char* __restrict__ wue,
                                       const unsigned char* __restrict__ wde, unsigned char* __restrict__ ybuf, unsigned char* __restrict__ dummy) {
  int* sasg = (int*)(smem + SM_MISC + 2048);
  float* sgate = (float*)(smem + SM_MISC + 2048 + 512);
  const int tid = TIDX, lane = tid & 63, w = tid >> 6, fr = lane & 15, fq = lane >> 4;
  __syncthreads();
  if (tid < 128) {
    const int r = rt * 128 + tid;
    int a = -1;
    if (e < 256) {
      int cum = 0;
#pragma unroll
      for (int s = 0; s < NSH; ++s) {
        const int c = cnt[s * NEXP + e];
        if (r >= cum && r < cum + c) a = list[((size_t)s * NEXP + e) * CAPS + (r - cum)];
        cum += c;
      }
    } else if (r < NTOK) a = NA + r;
    sasg[tid] = a;
    sgate[tid] = (a >= 0 && a < NA) ? gates[a] : 1.f;
  }
  __syncthreads();
  v8i hf[2][2];
  {
    LdRowBF16 al; al.init([&](int r) { const int a = sasg[r]; const int tok = (a < 0) ? 0 : (a < NA ? (a >> 3) : (a - NA)); return x8 + (size_t)tok * DM; }, 0);
    LdRowBF16 bl; bl.init([&](int j) {
      const int bn = j >> 4, ff = (bn >> 1) * 16 + (j & 15);
      return ((bn & 1) ? wue : wge) + (size_t)ff * DM; }, (size_t)64 * DM);
    al.issue(0, 0, smem); bl.issue(0, 0, smem + 16384);
    asm volatile("s_waitcnt vmcnt(0)" ::: "memory");
    __syncthreads();
#pragma unroll
    for (int m = 0; m < 2; ++m)
#pragma unroll
      for (int s = 0; s < 2; ++s) hf[m][s] = (v8i){0, 0, 0, 0, 0, 0, 0, 0};
#pragma unroll 1
    for (int ct = 0; ct < 4; ++ct) {
      f32x4 acc[2][8];
#pragma unroll
      for (int m = 0; m < 2; ++m)
#pragma unroll
        for (int n = 0; n < 8; ++n) acc[m][n] = (f32x4){0.f, 0.f, 0.f, 0.f};
#pragma unroll 1
      for (int kk = 0; kk < 8; ++kk) {
        const int j = ct * 8 + kk;
        unsigned char* cur = smem + (j & 1) * 32768; unsigned char* nxt = smem + ((j & 1) ^ 1) * 32768;
        if (j + 1 < 32) { al.issue((j + 1) >> 3, (j + 1) & 7, nxt); bl.issue((j + 1) >> 3, (j + 1) & 7, nxt + 16384); }
        {
          v8i a[2], bfrag[8];
#pragma unroll
          for (int m = 0; m < 2; ++m) {
            const int row = w * 32 + m * 16 + fr;
            const i32x4 lo = *(const i32x4*)(cur + row * 128 + ((fq ^ (row & 7)) << 4));
            const i32x4 hi = *(const i32x4*)(cur + row * 128 + (((4 + fq) ^ (row & 7)) << 4));
            a[m] = __builtin_shufflevector(lo, hi, 0, 1, 2, 3, 4, 5, 6, 7);
          }
#pragma unroll
          for (int n = 0; n < 8; ++n) {
            const int row = n * 16 + fr;
            const i32x4 lo = *(const i32x4*)(cur + 16384 + row * 128 + ((fq ^ (row & 7)) << 4));
            const i32x4 hi = *(const i32x4*)(cur + 16384 + row * 128 + (((4 + fq) ^ (row & 7)) << 4));
            bfrag[n] = __builtin_shufflevector(lo, hi, 0, 1, 2, 3, 4, 5, 6, 7);
          }
          __builtin_amdgcn_s_setprio(1);
#pragma unroll
          for (int n = 0; n < 8; ++n)
#pragma unroll
            for (int m = 0; m < 2; ++m)
              acc[m][n] = __builtin_amdgcn_mfma_scale_f32_16x16x128_f8f6f4(bfrag[n], a[m], acc[m][n], 0, 0, 0, MX_ONE, 0, MX_ONE);
          __builtin_amdgcn_s_setprio(0);
          __builtin_amdgcn_sched_group_barrier(0x100, 20, 0);
          __builtin_amdgcn_sched_group_barrier(0x008, 16, 0);
        }
        asm volatile("s_waitcnt vmcnt(0)" ::: "memory");
        __syncthreads();
      }
#pragma unroll
      for (int m = 0; m < 2; ++m) {
        int hp[4][2];
#pragma unroll
        for (int p = 0; p < 4; ++p) {
          float hv[4];
#pragma unroll
          for (int r = 0; r < 4; ++r) hv[r] = siluf(acc[m][2 * p][r] * (1.f / SC_WG)) * acc[m][2 * p + 1][r] * (SC_H / SC_WU);
          int pk = 0;
          pk = __builtin_amdgcn_cvt_pk_fp8_f32(hv[0], hv[1], pk, false);
          pk = __builtin_amdgcn_cvt_pk_fp8_f32(hv[2], hv[3], pk, true);
          hp[p][0] = pk;
        }
        if (ct == 0) { hf[m][0][0] = hp[0][0]; hf[m][0][1] = hp[1][0]; hf[m][0][2] = hp[2][0]; hf[m][0][3] = hp[3][0]; }
        else if (ct == 1) { hf[m][0][4] = hp[0][0]; hf[m][0][5] = hp[1][0]; hf[m][0][6] = hp[2][0]; hf[m][0][7] = hp[3][0]; }
        else if (ct == 2) { hf[m][1][0] = hp[0][0]; hf[m][1][1] = hp[1][0]; hf[m][1][2] = hp[2][0]; hf[m][1][3] = hp[3][0]; }
        else { hf[m][1][4] = hp[0][0]; hf[m][1][5] = hp[1][0]; hf[m][1][6] = hp[2][0]; hf[m][1][7] = hp[3][0]; }
      }
    }
  }
#define MOE_RAW_BARRIER() do { asm volatile("s_waitcnt lgkmcnt(0)" ::: "memory"); __builtin_amdgcn_s_barrier(); } while (0)
  {
    LdRowBF16 bl; bl.init([&](int j) { return wde + (size_t)j * EFF; }, (size_t)128 * EFF);
    bl.issue(0, 0, smem); bl.issue(0, 1, smem + 16384);
#pragma unroll 1
    for (int ct = 0; ct < 8; ++ct) {
      f32x4 acc[2][8];
#pragma unroll
      for (int m = 0; m < 2; ++m)
#pragma unroll
        for (int n = 0; n < 8; ++n) acc[m][n] = (f32x4){0.f, 0.f, 0.f, 0.f};
#pragma unroll
      for (int kk = 0; kk < 2; ++kk) {
        const int j = ct * 2 + kk;
        if (j < 2 || j == 15) asm volatile("s_waitcnt vmcnt(4)" ::: "memory");
        else asm volatile("s_waitcnt vmcnt(8)" ::: "memory");
        MOE_RAW_BARRIER();
        if (j + 2 < 16) bl.issue((j + 2) >> 1, (j + 2) & 1, smem + ((j + 2) % 3) * 16384);
        const unsigned char* cur = smem + (j % 3) * 16384;
        {
          v8i wf[8];
#pragma unroll
          for (int n = 0; n < 8; ++n) {
            const int row = n * 16 + fr;
            const i32x4 lo = *(const i32x4*)(cur + row * 128 + ((fq ^ (row & 7)) << 4));
            const i32x4 hi = *(const i32x4*)(cur + row * 128 + (((4 + fq) ^ (row & 7)) << 4));
            wf[n] = __builtin_shufflevector(lo, hi, 0, 1, 2, 3, 4, 5, 6, 7);
          }
          __builtin_amdgcn_s_setprio(1);
#pragma unroll
          for (int n = 0; n < 8; ++n)
#pragma unroll
            for (int m = 0; m < 2; ++m) acc[m][n] = __builtin_amdgcn_mfma_scale_f32_16x16x128_f8f6f4(wf[n], hf[m][kk], acc[m][n], 0, 0, 0, MX_ONE, 0, MX_ONE);
          __builtin_amdgcn_s_setprio(0);
          __builtin_amdgcn_sched_group_barrier(0x100, 16, 0);
          __builtin_amdgcn_sched_group_barrier(0x008, 16, 0);
        }
      }
      const int n0 = ct * 128;
      {
        unsigned char* stg = smem + 3 * 16384 + w * 4096;
#pragma unroll
        for (int m = 0; m < 2; ++m) {
          const int row = m * 16 + fr;
          const float gt = sgate[w * 32 + row] * (SC_Y / (SC_H * SC_WD));
#pragma unroll
          for (int n = 0; n < 8; ++n) {
            int pk = 0;
            pk = __builtin_amdgcn_cvt_pk_fp8_f32(acc[m][n][0] * gt, acc[m][n][1] * gt, pk, false);
            pk = __builtin_amdgcn_cvt_pk_fp8_f32(acc[m][n][2] * gt, acc[m][n][3] * gt, pk, true);
            *(int*)(stg + row * 128 + ((n ^ (row & 7)) << 4) + 4 * fq) = pk;
          }
        }
#pragma unroll
        for (int i = 0; i < 4; ++i) {
          const int q = lane + 64 * i, row = q >> 3, ch = q & 7;
          const int a = sasg[w * 32 + row];
          unsigned char* yp = ((a >= 0) ? ybuf + (size_t)a * DM : dummy) + n0 + ch * 16;
          *(u32x4*)yp = *(const u32x4*)(stg + row * 128 + ((ch ^ (row & 7)) << 4));
        }
      }
    }
    MOE_RAW_BARRIER();
  }
#undef MOE_RAW_BARRIER
}

__device__ __forceinline__ void ph_final(int item, float* __restrict__ out, const bf16_t* __restrict__ xbf, const unsigned char* __restrict__ ybuf, const float* __restrict__ gam, const float* __restrict__ bet) {
  const int row = item * 4 + (TIDX >> 6), lane = TIDX & 63;
  f32x4* p = (f32x4*)(out + (size_t)row * DM + 16 * lane);
  const u32x4 xa = *(const u32x4*)(xbf + (size_t)row * DM + 16 * lane), xb = *(const u32x4*)(xbf + (size_t)row * DM + 16 * lane + 8);
  u32x4 yv[9];
#pragma unroll
  for (int k = 0; k < 8; ++k) yv[k] = *(const u32x4*)(ybuf + ((size_t)row * 8 + k) * DM + 16 * lane);
  yv[8] = *(const u32x4*)(ybuf + ((size_t)NA + row) * DM + 16 * lane);
  float ys[16];
#pragma unroll
  for (int c = 0; c < 16; ++c) ys[c] = 0.f;
#pragma unroll
  for (int k = 0; k < 9; ++k)
#pragma unroll
    for (int d = 0; d < 4; ++d) {
      const hwf32x2 lo = __builtin_amdgcn_cvt_pk_f32_fp8((int)yv[k][d], false), hi = __builtin_amdgcn_cvt_pk_f32_fp8((int)yv[k][d], true);
      ys[4 * d + 0] += lo[0]; ys[4 * d + 1] += lo[1]; ys[4 * d + 2] += hi[0]; ys[4 * d + 3] += hi[1];
    }
  f32x4 v[4];
  v[0] = (f32x4){bflo(xa[0]), bfhi(xa[0]), bflo(xa[1]), bfhi(xa[1])}; v[1] = (f32x4){bflo(xa[2]), bfhi(xa[2]), bflo(xa[3]), bfhi(xa[3])};
  v[2] = (f32x4){bflo(xb[0]), bfhi(xb[0]), bflo(xb[1]), bfhi(xb[1])}; v[3] = (f32x4){bflo(xb[2]), bfhi(xb[2]), bflo(xb[3]), bfhi(xb[3])};
  float s = 0.f;
#pragma unroll
  for (int i = 0; i < 4; ++i)
#pragma unroll
    for (int r = 0; r < 4; ++r) { v[i][r] = v[i][r] * ALPHA + ys[4 * i + r] * (1.f / SC_Y); s += v[i][r]; }
  const float mu = wave_sum(s) * (1.f / DM);
  float q = 0.f;
#pragma unroll
  for (int i = 0; i < 4; ++i)
#pragma unroll
    for (int r = 0; r < 4; ++r) { const float d = v[i][r] - mu; q += d * d; }
  const float rs = rsqrtf(wave_sum(q) * (1.f / DM) + LN_EPS);
#pragma unroll
  for (int i = 0; i < 4; ++i) {
    const f32x4 gg = *(const f32x4*)(gam + 16 * lane + 4 * i), bb = *(const f32x4*)(bet + 16 * lane + 4 * i);
    p[i] = (v[i] - mu) * rs * gg + bb;
  }
}

#define XB_TMO      128
#define XB_XCNT(j)  (256  + 64 * (j))
#define XB_XSUB(j)  (1280 + 64 * (j))
#define XB_XGEN(j)  (2304 + 64 * (j))
#define XB_TOP      3328
#define XB_TOPGEN   3392
#define XCD_BAR_WORDS 3456
#define XB_SPIN_CAP (1u << 22)
#define LAS __attribute__((address_space(3)))
__device__ __forceinline__ unsigned xb_ld(unsigned* p)              { return __hip_atomic_load(p, __ATOMIC_RELAXED, __HIP_MEMORY_SCOPE_AGENT); }
__device__ __forceinline__ unsigned xb_add(unsigned* p, unsigned v) { return __hip_atomic_fetch_add(p, v, __ATOMIC_RELAXED, __HIP_MEMORY_SCOPE_AGENT); }
__device__ __forceinline__ unsigned xb_xcc_id() { return (unsigned)__builtin_amdgcn_s_getreg((3 << 11) | 20) & 0xFu; }
#define XB_SPIN(cond, bar) do { unsigned _sp = 0; while (cond) { __builtin_amdgcn_s_sleep(1); \
    if ((++_sp & 255u) == 0u) { if (xb_ld(&(bar)[XB_TMO])) break; if (_sp > XB_SPIN_CAP) { atomicAdd(&(bar)[XB_TMO], 1u); break; } } } } while (0)
struct XcdBarrier { unsigned* bar; unsigned x; volatile LAS unsigned* st; };
__device__ __forceinline__ XcdBarrier xcd_barrier_post(unsigned* bar, volatile LAS unsigned* st) {
  XcdBarrier b; b.bar = bar; b.x = xb_xcc_id(); b.st = st;
  if (threadIdx.x == 0) (void)xb_add(&bar[XB_XCNT(b.x)], 1u);
  return b;
}
__device__ __forceinline__ void xcd_barrier_complete(unsigned* bar, unsigned x, unsigned& nloc, unsigned& nx) {
  const unsigned G = gridDim.x * gridDim.y * gridDim.z;
  unsigned sum, cnt, mine, sp = 0u;
  for (;;) {
    sum = 0u; cnt = 0u; mine = 0u;
#pragma unroll
    for (unsigned j = 0; j < 16; ++j) { const unsigned c = xb_ld(&bar[XB_XCNT(j)]); sum += c; cnt += (c > 0u) ? 1u : 0u; mine = (j == x) ? c : mine; }
    if (sum == G) break;
    __builtin_amdgcn_s_sleep(1);
    if ((++sp & 255u) == 0u) { if (xb_ld(&bar[XB_TMO])) break; if (sp > XB_SPIN_CAP) { atomicAdd(&bar[XB_TMO], 1u); break; } }
  }
  nloc = mine > 0u ? mine : 1u; nx = cnt > 0u ? cnt : 1u;
}
__device__ __forceinline__ void xcd_barrier(const XcdBarrier& b) {
  asm volatile("s_waitcnt vmcnt(0)" ::: "memory");
  __syncthreads();
  if (threadIdx.x == 0) {
    unsigned* bar = b.bar;
    __builtin_amdgcn_s_waitcnt(0);
    unsigned nloc = b.st[0], nx = b.st[1];
    if (nloc == 0u) { xcd_barrier_complete(bar, b.x, nloc, nx); b.st[0] = nloc; b.st[1] = nx; }
    const unsigned old = xb_add(&bar[XB_XSUB(b.x)], 1u);
    const unsigned gen = old / nloc;
    if (old + 1u == (gen + 1u) * nloc) {
      __builtin_amdgcn_fence(__ATOMIC_RELEASE, "agent");
      asm volatile("s_waitcnt vmcnt(0)" ::: "memory");
      const unsigned og = xb_add(&bar[XB_TOP], 1u);
      const unsigned tg = og / nx;
      if (og + 1u == (tg + 1u) * nx) xb_add(&bar[XB_TOPGEN], 1u);
      else XB_SPIN(xb_ld(&bar[XB_TOPGEN]) == tg, bar);
      __builtin_amdgcn_fence(__ATOMIC_ACQUIRE, "agent");
      xb_add(&bar[XB_XGEN(b.x)], 1u);
      asm volatile("s_waitcnt vmcnt(0)" ::: "memory");
    } else {
      XB_SPIN(xb_ld(&bar[XB_XGEN(b.x)]) == gen, bar);
      __builtin_amdgcn_fence(__ATOMIC_ACQUIRE, "agent");
      asm volatile("s_waitcnt vmcnt(0)" ::: "memory");
    }
  }
  __syncthreads();
}

__global__ void __launch_bounds__(256, 2) mega(Params P) {
  __shared__ __attribute__((aligned(16))) unsigned char smem[SMEM_BYTES];
  const int bid = blockIdx.x, nblk = gridDim.x;
#define xin (P.in[0])
#define w_in (P.in[1])
#define conv_w (P.in[2])
#define a_log (P.in[3])
#define dt_bias (P.in[4])
#define dn_norm_g (P.in[5])
#define sinks (P.in[6])
#define w_out (P.in[7])
#define ln1_g (P.in[8])
#define ln1_b (P.in[9])
#define router_w (P.in[10])
#define router_bias (P.in[11])
#define w_gate (P.in[12])
#define w_up (P.in[13])
#define w_down (P.in[14])
#define sw_gate (P.in[15])
#define sw_up (P.in[16])
#define sw_down (P.in[17])
#define ln2_g (P.in[18])
#define ln2_b (P.in[19])
#define outp (P.out)
#define x1bf ((bf16_t*)(P.ws + WS_X1BF))
#define logits ((float*)(P.ws + WS_LOGIT))
#define list ((int*)(P.ws + WS_LIST))
#define gates ((float*)(P.ws + WS_GATES))
#define cnt ((int*)(P.ws + WS_CTRL + CNT16_OFF))
#define barw ((unsigned*)(P.ws + WS_CTRL + 4096))
#define mixed ((bf16_t*)(P.ws + WS_MIXED))
#define proj ((bf16_t*)(P.ws + WS_PROJ))
#define ba ((float*)(P.ws + WS_BA))
#define QD ((bf16_t*)(P.ws + WS_QD))
#define W0N ((bf16_t*)(P.ws + WS_W0N))
#define KTT ((bf16_t*)(P.ws + WS_KTT))
#define RV ((bf16_t*)(P.ws + WS_RV))
#define TM ((bf16_t*)(P.ws + WS_TM))
#define ATT ((bf16_t*)(P.ws + WS_ATT))
#define GL ((float*)(P.ws + WS_GL))
#define obuf ((float*)(P.ws + WS_O))
#define VTb ((bf16_t*)(P.ws + WS_VT))
#define MIXO ((bf16_t*)(P.ws + WS_O))
#define XBF ((bf16_t*)(P.ws + WS_XBF))
#define WTIN ((bf16_t*)(P.ws + WS_WTIN))
#define WTOUT ((bf16_t*)(P.ws + WS_WTOUT))
#define WTR ((bf16_t*)(P.ws + WS_WTR))
#define ybuf ((unsigned char*)(P.ws + WS_YBUF))
  {
    volatile LAS unsigned* st0 = (volatile LAS unsigned*)(smem + SM_MISC + 4080);
    if (threadIdx.x == 0) { st0[0] = 0u; st0[1] = 0u; }
    __syncthreads();
  }
  const int xcd = bid & 7, xloc = bid >> 3, xnl = nblk >> 3;
  XcdBarrier xb = xcd_barrier_post(barw, (volatile LAS unsigned*)(smem + SM_MISC + 4080));
  for (int it = bid; it < NTOK / 8; it += nblk) { ph_cvt_x(2 * it, xin, XBF); ph_cvt_x(2 * it + 1, xin, XBF); }
  for (int it = bid; it < 16 * 46 + 16 * 16 + 16 * 4; it += nblk) {
    if (it < 16 * 46) ph_cvt_wt(smem, it % 16, it / 16, w_in, DM, INC, WTIN);
    else if (it < 16 * 46 + 256) { const int j = it - 16 * 46; ph_cvt_wt(smem, j % 16, j / 16, w_out, DM, DM, WTOUT); }
    else { const int j = it - 16 * 46 - 256; ph_cvt_wt(smem, j % 16, j / 16, router_w, DM, NEXP, WTR); }
  }
  xcd_barrier(xb);
  for (int l = xloc; l < 64; l += xnl) ph_proj(smem, xcd, l, XBF, WTIN, proj, ba, VTb);
  xcd_barrier(xb);
  for (int it = bid; it < 2048; it += nblk) ph_dnchunk(smem, it, proj, ba, conv_w, a_log, dt_bias, QD, W0N, KTT, RV, TM, ATT, GL);
  for (int it = bid; it < 512; it += nblk) ph_swa(smem, it, proj, VTb, sinks, mixed);
  xcd_barrier(xb);
  {
    const bool is512 = (nblk == 512);
    const bool scan_blk = is512 ? (bid < 256 && (bid & 7) < 2) : ((bid < 64) || (nblk <= 64));
    const bool swa_blk = is512 && bid >= 256 && (bid & 7) < 2;
    if (scan_blk) {
      if (is512) ph_dnscan(smem, (bid & 1) * 32 + (bid >> 3), QD, W0N, KTT, RV, TM, ATT, GL, obuf);
      else for (int it = bid; it < 64; it += nblk) ph_dnscan(smem, it, QD, W0N, KTT, RV, TM, ATT, GL, obuf);
    }
    if (swa_blk) { }
    else {
      const int tid = TIDX, lane = tid & 63, wv = tid >> 6;
      float* tile = (float*)(smem + wv * 16896);
      const int total = 257 * 192;
      const int T1 = is512 ? (total - 64 * 4 * 12) : ((nblk > 64) ? total : 0);
      int it, step, end;
      if (is512 && scan_blk) { const int sb = (bid & 1) * 32 + (bid >> 3); it = T1 + sb * 4 + wv; step = 64 * 4; end = total; }
      else if (is512) { const int cb = (bid >> 3) * 6 + (bid & 7) - 2; it = cb * 4 + wv; step = 384 * 4; end = T1; }
      else if (nblk > 64) { if (bid < 64) { it = 0; step = 1; end = 0; } else { it = (bid - 64) * 4 + wv; step = (nblk - 64) * 4; end = total; } }
      else { it = bid * 4 + wv; step = nblk * 4; end = total; }
      f32x4 vc[16], vn[16];
      CvtTile tc = cvt_decode(it < end ? it : 0, lane, w_gate, w_up, w_down, sw_gate, sw_up, sw_down, P.ws);
      if (it < end) cvt_load(tc, vc);
      while (it < end) {
        const int itn = it + step;
        CvtTile tn = cvt_decode(itn < end ? itn : 0, lane, w_gate, w_up, w_down, sw_gate, sw_up, sw_down, P.ws);
        if (itn < end) cvt_load(tn, vn);
        cvt_store(tile, lane, tc, vc);
#pragma unroll
        for (int i = 0; i < 16; ++i) vc[i] = vn[i];
        tc = tn; it = itn;
      }
    }
  }
  xcd_barrier(xb);
  for (int it = bid; it < NTOK / 4; it += nblk) ph_dn_post(it, obuf, proj, dn_norm_g, mixed);
  xcd_barrier(xb);
  for (int l = xloc; l < 64; l += xnl) ph_wout(smem, xcd, l, mixed, WTOUT, MIXO);
  xcd_barrier(xb);
  for (int it = bid; it < NTOK / 4; it += nblk) ph_ln1(it, xin, MIXO, ln1_g, ln1_b, x1bf, (unsigned char*)(P.ws + WS_X1F8));
  xcd_barrier(xb);
  for (int i = xloc; i < 32 * 2; i += xnl) ph_router(smem, (xcd * 32 + i / 2) * 2 + i % 2, x1bf, WTR, logits);
  xcd_barrier(xb);
  for (int it = bid; it < NTOK / 4; it += nblk) ph_route(it, logits, router_bias, cnt, list, gates);
  xcd_barrier(xb);
  int* sscan = (int*)(smem + SM_MISC);
  moe_build_prefix(cnt, sscan);
  const int ntile = sscan[32 * xcd + 31] - (xcd ? sscan[32 * xcd - 1] : 0) + NTOK / 128 / 8;
  for (int it = xloc; it < ntile; it += xnl) {
    int e, rt; moe_locate(sscan, xcd, it, e, rt);
    ph_moe(smem, e, rt, (const unsigned char*)(P.ws + WS_X1F8), cnt, list, gates,
           (const unsigned char*)P.ws + ((e < 256) ? WS_WTG8 + (size_t)e * EFF * DM : WS_WTSG8), (const unsigned char*)P.ws + ((e < 256) ? WS_WTU8 + (size_t)e * EFF * DM : WS_WTSU8),
           (const unsigned char*)P.ws + ((e < 256) ? WS_WTD8 + (size_t)e * DM * EFF : WS_WTSD8), ybuf, (unsigned char*)(P.ws + WS_DUMMY));
  }
  xcd_barrier(xb);
  for (int it = bid; it < NTOK / 4; it += nblk) ph_final(it, outp, x1bf, ybuf, ln2_g, ln2_b);
}

#undef xin
#undef w_in
#undef conv_w
#undef a_log
#undef dt_bias
#undef dn_norm_g
#undef sinks
#undef w_out
#undef ln1_g
#undef ln1_b
#undef router_w
#undef router_bias
#undef w_gate
#undef w_up
#undef w_down
#undef sw_gate
#undef sw_up
#undef sw_down
#undef ln2_g
#undef ln2_b
#undef outp
#undef x1bf
#undef logits
#undef list
#undef gates
#undef cnt
#undef mixed
#undef proj
#undef ba
#undef QD
#undef W0N
#undef KTT
#undef RV
#undef TM
#undef ATT
#undef GL
#undef obuf
#undef ybuf
#undef VTb
#undef MIXO
#undef XBF
#undef WTIN
#undef WTOUT
#undef WTR
#undef barw

extern "C" void kernel_launch(void* const* d_in, const int* in_sizes, int n_in, void* d_out, int out_size, void* d_ws, size_t ws_size, hipStream_t stream) {
  static int grid_blocks = 0;
  if (!grid_blocks) {
    int dev = 0, cus = 0, per_cu = 0;
    (void)hipGetDevice(&dev);
    (void)hipDeviceGetAttribute(&cus, hipDeviceAttributeMultiprocessorCount, dev);
    (void)hipOccupancyMaxActiveBlocksPerMultiprocessor(&per_cu, mega, 256, 0);
    if (per_cu > 2) per_cu = 2;
    if (per_cu < 1) per_cu = 1;
    grid_blocks = cus * per_cu;
  }
  Params p{};
  for (int i = 0; i < 20; ++i) p.in[i] = (const float*)d_in[i];
  p.out = (float*)d_out; p.ws = (char*)d_ws;
  (void)hipMemsetAsync((char*)d_ws + WS_CTRL, 0, CNT16_OFF + NSH * NEXP * 4, stream);
  void* args[] = {&p};
  hipError_t e = hipLaunchCooperativeKernel((void*)mega, dim3(grid_blocks), dim3(256), args, 0, stream);
  if (e != hipSuccess) fprintf(stderr, "cooperative launch failed: %s (grid %d)\n", hipGetErrorString(e), grid_blocks);
}
```

```cpp
#include <hip/hip_runtime.h>
#include <hip/hip_cooperative_groups.h>
#include <stdint.h>
#include <stdio.h>
namespace cg = cooperative_groups;

typedef __attribute__((ext_vector_type(8))) short bf16x8;
typedef __attribute__((ext_vector_type(4))) float f32x4;
typedef unsigned short bf16_t;
typedef __attribute__((ext_vector_type(4))) unsigned u32x4;
typedef __attribute__((ext_vector_type(2))) unsigned u32x2;

constexpr int NTOK = 32768, SEQ = 4096, DM = 1024;
constexpr int INC = 2824, PROJW = 2816;
constexpr int OFF_DQ = 0, OFF_DK = 512, OFF_DV = 1024, OFF_SQ = 1536, OFF_SK = 2048, OFF_SV = 2176, OFF_Z = 2304;
constexpr int NEXP = 256, TOPK = 8, EFF = 256;
constexpr int NA = NTOK * TOPK;
constexpr int NSH = 16, CAPS = NTOK / NSH;
constexpr int CNT16_OFF = 32768;
constexpr float ALPHA = 1.189207115002721f;
constexpr float LN_EPS = 1e-5f, RMS_EPS = 1e-6f, L2_EPS = 1e-6f;
constexpr float SC_WG = 32.f, SC_WU = 64.f, SC_WD = 32.f, SC_H = 8.f, SC_Y = 32.f;

constexpr size_t MiB = 1024ull * 1024ull;
constexpr size_t WS_WTD8 = 0;
constexpr size_t WS_WTG8 = 64 * MiB;
constexpr size_t WS_WTU8 = 128 * MiB;
constexpr size_t WS_WTSG8 = 192 * MiB;
constexpr size_t WS_WTSU8 = WS_WTSG8 + 256 * 1024;
constexpr size_t WS_WTSD8 = WS_WTSG8 + 512 * 1024;
constexpr size_t WS_X1F8 = 200 * MiB;
constexpr size_t WS_YBUF = 384 * MiB;
constexpr size_t WS_LOGIT = 384 * MiB;
constexpr size_t WS_X1BF = 896 * MiB;
constexpr size_t WS_LIST = 960 * MiB;
constexpr size_t WS_GATES = 992 * MiB;
constexpr size_t WS_CTRL = 993 * MiB;
constexpr size_t WS_WTIN = 994 * MiB;
constexpr size_t WS_WTOUT = 1000 * MiB;
constexpr size_t WS_WTR = 1002 * MiB;
constexpr size_t WS_DUMMY = 1005 * MiB;
constexpr size_t WS_PROJ = 384 * MiB;
constexpr size_t WS_BA = 560 * MiB;
constexpr size_t WS_QD = 561 * MiB;
constexpr size_t WS_W0N = 593 * MiB;
constexpr size_t WS_KTT = 625 * MiB;
constexpr size_t WS_RV = 657 * MiB;
constexpr size_t WS_TM = 689 * MiB;
constexpr size_t WS_ATT = 705 * MiB;
constexpr size_t WS_GL = 721 * MiB;
constexpr size_t WS_O = 722 * MiB;
constexpr size_t WS_VT = 786 * MiB;
constexpr size_t WS_MIXED = 794 * MiB;
constexpr size_t WS_XBF = 640 * MiB;

__device__ __forceinline__ int opaque_tid() { int t = threadIdx.x; asm volatile("" : "+v"(t)); return t; }
#define TIDX opaque_tid()
typedef __attribute__((ext_vector_type(2))) __bf16 hwbf16x2;
typedef __attribute__((ext_vector_type(2))) float hwf32x2;
__device__ __forceinline__ unsigned pack2(float lo, float hi) {
  hwf32x2 f = {lo, hi};
  return __builtin_bit_cast(unsigned, __builtin_convertvector(f, hwbf16x2));
}
__device__ __forceinline__ unsigned f2bf(float f) { return pack2(f, 0.f) & 0xffffu; }
__device__ __forceinline__ float bf2f(unsigned h) { return __uint_as_float(h << 16); }
__device__ __forceinline__ float bflo(unsigned w) { return __uint_as_float(w << 16); }
__device__ __forceinline__ float bfhi(unsigned w) { return __uint_as_float(w & 0xffff0000u); }
__device__ __forceinline__ float siluf(float x) { return x * __builtin_amdgcn_rcpf(1.f + __expf(-x)); }
__device__ __forceinline__ float sigmoidf(float x) { return __builtin_amdgcn_rcpf(1.f + __expf(-x)); }
#define DPP_ADD_(v, ctrl, rmask) v += __builtin_bit_cast(float, __builtin_amdgcn_update_dpp(0, __builtin_bit_cast(int, v), ctrl, rmask, 0xf, false))
__device__ __forceinline__ float wave_sum(float v) {
  DPP_ADD_(v, 0xB1, 0xf);
  DPP_ADD_(v, 0x4E, 0xf);
  DPP_ADD_(v, 0x141, 0xf);
  DPP_ADD_(v, 0x140, 0xf);
  DPP_ADD_(v, 0x142, 0xa);
  DPP_ADD_(v, 0x143, 0xc);
  return __builtin_bit_cast(float, __builtin_amdgcn_readlane(__builtin_bit_cast(int, v), 63));
}

template <int SEGDIV>
struct LdRowBF16T {
  const char* p[4]; size_t seghi, seglo; int tid16;
  template <class F> __device__ __forceinline__ void init(F rowptr, size_t hi, size_t lo = 0) {
    const int tid = TIDX; const int slot = tid & 7, row0 = tid >> 3; seghi = hi; seglo = lo; tid16 = tid * 16;
#pragma unroll
    for (int i = 0; i < 4; ++i) p[i] = (const char*)rowptr(row0 + i * 32) + ((slot ^ (row0 & 7)) << 4);
  }
  __device__ __forceinline__ void issue(int seg, int kk, unsigned char* lds) {
    const size_t off = (size_t)(seg / SEGDIV) * seghi + (size_t)(seg % SEGDIV) * seglo + (size_t)kk * 128;
#pragma unroll
    for (int i = 0; i < 4; ++i)
      __builtin_amdgcn_global_load_lds((const unsigned*)(p[i] + off), (__attribute__((address_space(3))) unsigned*)(lds + tid16 + i * 4096), 16, 0, 0);
  }
};
typedef LdRowBF16T<1> LdRowBF16;
__device__ __forceinline__ void gemm_kstep(const unsigned char* sA, const unsigned char* sB, f32x4 (&acc)[4][4], int wr, int wc, int fr, int fq) {
#pragma unroll
  for (int ks = 0; ks < 2; ++ks) {
    bf16x8 a[4], b[4];
#pragma unroll
    for (int m = 0; m < 4; ++m) {
      const int row = wr * 64 + m * 16 + fr;
      a[m] = *(const bf16x8*)(sA + row * 128 + (((ks * 4 + fq) ^ (row & 7)) << 4));
    }
#pragma unroll
    for (int n = 0; n < 4; ++n) {
      const int row = wc * 64 + n * 16 + fr;
      b[n] = *(const bf16x8*)(sB + row * 128 + (((ks * 4 + fq) ^ (row & 7)) << 4));
    }
    __builtin_amdgcn_s_setprio(1);
#pragma unroll
    for (int m = 0; m < 4; ++m)
#pragma unroll
      for (int n = 0; n < 4; ++n) acc[m][n] = __builtin_amdgcn_mfma_f32_16x16x32_bf16(b[n], a[m], acc[m][n], 0, 0, 0);
    __builtin_amdgcn_s_setprio(0);
  }
}
template <int KPER, class AL, class BL, class Epi>
__device__ __forceinline__ void gemm_stream(unsigned char* smem, AL& al, BL& bl, int nseg, Epi epi) {
  const int tid = TIDX, lane = tid & 63, wid = tid >> 6, wr = wid >> 1, wc = wid & 1, fr = lane & 15, fq = lane >> 4;
  const int total = nseg * KPER;
  f32x4 acc[4][4];
  al.issue(0, 0, smem); bl.issue(0, 0, smem + 16384);
  asm volatile("s_waitcnt vmcnt(0)" ::: "memory");
  __syncthreads();
  for (int j = 0; j < total; ++j) {
    unsigned char* cur = smem + (j & 1) * 32768; unsigned char* nxt = smem + ((j & 1) ^ 1) * 32768;
    if (j + 1 < total) { al.issue((j + 1) / KPER, (j + 1) % KPER, nxt); bl.issue((j + 1) / KPER, (j + 1) % KPER, nxt + 16384); }
    if (j % KPER == 0) {
#pragma unroll
      for (int m = 0; m < 4; ++m)
#pragma unroll
        for (int n = 0; n < 4; ++n) acc[m][n] = (f32x4){0.f, 0.f, 0.f, 0.f};
    }
    gemm_kstep(cur, cur + 16384, acc, wr, wc, fr, fq);
    asm volatile("s_waitcnt vmcnt(0)" ::: "memory");
    __syncthreads();
    if ((j + 1) % KPER == 0) epi((j + 1) / KPER - 1, acc, cur);
  }
}

template <class RowDst>
__device__ __forceinline__ void store_tile_bf16(unsigned char* fbuf, const f32x4 (&acc)[4][4], RowDst rowdst) {
  const int tid = TIDX, lane = tid & 63, wid = tid >> 6, wr = wid >> 1, wc = wid & 1, fr = lane & 15, fq = lane >> 4;
#pragma unroll
  for (int m = 0; m < 4; ++m) {
    const int row = wr * 64 + m * 16 + fr;
#pragma unroll
    for (int n = 0; n < 4; ++n) {
      const int col = wc * 64 + n * 16 + fq * 4;
      u32x2 w; w[0] = pack2(acc[m][n][0], acc[m][n][1]); w[1] = pack2(acc[m][n][2], acc[m][n][3]);
      *(u32x2*)(fbuf + row * 256 + (((col >> 3) ^ (row & 15)) << 4) + ((col >> 2) & 1) * 8) = w;
    }
  }
  __syncthreads();
#pragma unroll
  for (int i = 0; i < 8; ++i) {
    const int q = tid + 256 * i, row = q >> 4, ch = q & 15;
    *(u32x4*)(rowdst(row) + ch * 8) = *(const u32x4*)(fbuf + row * 256 + ((ch ^ (row & 15)) << 4));
  }
  __syncthreads();
}

template <class RowDst>
__device__ __forceinline__ void store_tile_bf16_T(unsigned char* fbuf, const f32x4 (&acc)[4][4], RowDst rowdst) {
  const int tid = TIDX, lane = tid & 63, wid = tid >> 6, wr = wid >> 1, wc = wid & 1, fr = lane & 15, fq = lane >> 4;
#pragma unroll
  for (int m = 0; m < 4; ++m) {
    const int t = wr * 64 + m * 16 + fr;
#pragma unroll
    for (int n = 0; n < 4; ++n)
#pragma unroll
      for (int r = 0; r < 4; ++r) {
        const int c = wc * 64 + n * 16 + fq * 4 + r;
        *(unsigned short*)(fbuf + c * 256 + ((((t >> 3) ^ (c & 15))) << 4) + (t & 7) * 2) = (unsigned short)f2bf(acc[m][n][r]);
      }
  }
  __syncthreads();
#pragma unroll
  for (int i = 0; i < 8; ++i) {
    const int q = tid + 256 * i, row = q >> 4, ch = q & 15;
    *(u32x4*)(rowdst(row) + ch * 8) = *(const u32x4*)(fbuf + row * 256 + ((ch ^ (row & 15)) << 4));
  }
  __syncthreads();
}

#define GEMM_IDS const int tid = TIDX, lane = tid & 63, wid = tid >> 6, wr = wid >> 1, wc = wid & 1, fr = lane & 15, fq = lane >> 4; (void)tid; (void)lane;

struct Params {
  const float* in[20];
  float* out;
  char* ws;
};

constexpr int SMEM_BYTES = 69632;
constexpr int SM_MISC = 65536;

__device__ __forceinline__ void ph_cvt_x(int item, const float* __restrict__ x, bf16_t* __restrict__ xbf) {
  const int tid = TIDX;
  const size_t base = (size_t)item * 4096 + (size_t)tid * 4;
#pragma unroll
  for (int i = 0; i < 4; ++i) {
    const f32x4 v = *(const f32x4*)(x + base + (size_t)i * 1024);
    u32x2 w; w[0] = pack2(v[0], v[1]); w[1] = pack2(v[2], v[3]);
    *(u32x2*)(xbf + base + (size_t)i * 1024) = w;
  }
}
__device__ __forceinline__ void ph_cvt_wt(unsigned char* smem, int kt, int nt, const float* __restrict__ W, int K, int N, bf16_t* __restrict__ WT, bool perm = false) {
  float* tile = (float*)smem;
  const int tid = TIDX;
  const int k0 = kt * 64, n0 = nt * 64;
  __syncthreads();
#pragma unroll
  for (int i = 0; i < 4; ++i) {
    const int k = (tid >> 4) + 16 * i, n = 4 * (tid & 15);
    f32x4 v = (f32x4){0.f, 0.f, 0.f, 0.f};
    if (n0 + n < N) v = *(const f32x4*)(W + (size_t)(k0 + k) * N + n0 + n);
    tile[k * 65 + n + 0] = v[0]; tile[k * 65 + n + 1] = v[1]; tile[k * 65 + n + 2] = v[2]; tile[k * 65 + n + 3] = v[3];
  }
  __syncthreads();
  const int n = tid >> 2, kq = tid & 3;
  u32x4 w0, w1;
#pragma unroll
  for (int j = 0; j < 4; ++j) {
    w0[j] = pack2(tile[(kq * 16 + 2 * j) * 65 + n], tile[(kq * 16 + 2 * j + 1) * 65 + n]);
    w1[j] = pack2(tile[(kq * 16 + 8 + 2 * j) * 65 + n], tile[(kq * 16 + 8 + 2 * j + 1) * 65 + n]);
  }
  if (!perm) {
    bf16_t* dst = WT + (size_t)(n0 + n) * K + k0 + kq * 16;
    *(u32x4*)dst = w0; *(u32x4*)(dst + 8) = w1;
  } else {
    const int blk = kq >> 1, hi = kq & 1;
    bf16_t* dst = WT + (size_t)(n0 + n) * K + k0 + blk * 32 + 4 * hi;
    u32x2 a; a[0] = w0[0]; a[1] = w0[1]; *(u32x2*)(dst + 0) = a;
    a[0] = w0[2]; a[1] = w0[3]; *(u32x2*)(dst + 8) = a;
    a[0] = w1[0]; a[1] = w1[1]; *(u32x2*)(dst + 16) = a;
    a[0] = w1[2]; a[1] = w1[3]; *(u32x2*)(dst + 24) = a;
  }
}

struct CvtTile { const float* src; unsigned char* dst; int ldn; int K; int perm; float scale; };
__device__ __forceinline__ CvtTile cvt_decode(int it, int lane, const float* __restrict__ w_gate, const float* __restrict__ w_up, const float* __restrict__ w_down,
                                              const float* __restrict__ sw_gate, const float* __restrict__ sw_up, const float* __restrict__ sw_down, char* ws) {
  const int e = it / 192, j = it % 192;
  const float* W; unsigned char* WT; int K, N, kt, nt; float sc;
  if (j < 64) { W = (e < 256) ? w_gate + (size_t)e * DM * EFF : sw_gate; WT = (unsigned char*)ws + ((e < 256) ? WS_WTG8 + (size_t)e * EFF * DM : WS_WTSG8); K = DM; N = EFF; nt = j & 7; kt = j >> 3; sc = SC_WG; }
  else if (j < 128) { W = (e < 256) ? w_up + (size_t)e * DM * EFF : sw_up; WT = (unsigned char*)ws + ((e < 256) ? WS_WTU8 + (size_t)e * EFF * DM : WS_WTSU8); K = DM; N = EFF; nt = (j - 64) & 7; kt = (j - 64) >> 3; sc = SC_WU; }
  else { W = (e < 256) ? w_down + (size_t)e * EFF * DM : sw_down; WT = (unsigned char*)ws + ((e < 256) ? WS_WTD8 + (size_t)e * DM * EFF : WS_WTSD8); K = EFF; N = DM; nt = (j - 128) & 31; kt = (j - 128) >> 5; sc = SC_WD; }
  CvtTile t;
  t.src = W + (size_t)(kt * 128 + (lane >> 3)) * N + nt * 32 + 4 * (lane & 7);
  t.dst = WT + (size_t)(nt * 32) * K + kt * 128;
  t.ldn = 8 * N; t.K = K; t.scale = sc;
  t.perm = (j >= 128) ? 1 : 0;
  return t;
}
__device__ __forceinline__ void cvt_load(const CvtTile& t, f32x4 (&v)[16]) {
#pragma unroll
  for (int i = 0; i < 16; ++i) v[i] = *(const f32x4*)(t.src + (size_t)i * t.ldn);
}
__device__ __forceinline__ void cvt_store(float* tile  , int lane, const CvtTile& t, const f32x4 (&v)[16]) {
#pragma unroll
  for (int i = 0; i < 16; ++i) {
    float* p = tile + ((lane >> 3) + 8 * i) * 33 + 4 * (lane & 7);
    p[0] = v[i][0]; p[1] = v[i][1]; p[2] = v[i][2]; p[3] = v[i][3];
  }
  const int c = lane & 7;
  int kk[16];
#pragma unroll
  for (int tt = 0; tt < 16; ++tt)
    kk[tt] = t.perm ? (64 * (c >> 2) + 16 * (tt >> 2) + 4 * (c & 3) + (tt & 3)) : (16 * c + tt);
  const float sc = t.scale;
#pragma unroll
  for (int i = 0; i < 4; ++i) {
    const int n = (lane >> 3) + 8 * i;
    u32x4 w;
#pragma unroll
    for (int d = 0; d < 4; ++d) {
      int pk = 0;
      pk = __builtin_amdgcn_cvt_pk_fp8_f32(tile[kk[4 * d + 0] * 33 + n] * sc, tile[kk[4 * d + 1] * 33 + n] * sc, pk, false);
      pk = __builtin_amdgcn_cvt_pk_fp8_f32(tile[kk[4 * d + 2] * 33 + n] * sc, tile[kk[4 * d + 3] * 33 + n] * sc, pk, true);
      w[d] = (unsigned)pk;
    }
    *(u32x4*)(t.dst + (size_t)n * t.K + 16 * c) = w;
  }
}

__device__ __forceinline__ void ph_proj(unsigned char* smem, int xcd, int l, const bf16_t* __restrict__ xbf, const bf16_t* __restrict__ wt, bf16_t* __restrict__ proj, float* __restrict__ ba, bf16_t* __restrict__ vt) {
  const int mi = l >> 3, ni = l & 7;
  LdRowBF16T<3> al; al.init([&](int r) { return xbf + (size_t)((xcd * 32 + mi) * 128 + r) * DM; }, (size_t)8 * 128 * DM * 2, 0);
  LdRowBF16T<3> bl; bl.init([&](int r) { return wt + (size_t)(ni * 128 + r) * DM; }, 0, (size_t)8 * 128 * DM * 2);
  gemm_stream<16>(smem, al, bl, 12, [&](int seg, f32x4 (&acc)[4][4], unsigned char* fbuf) {
    GEMM_IDS
    const int nt = (seg % 3) * 8 + ni;
    if (nt < 23) {
      const int m0 = (xcd * 32 + (seg / 3) * 8 + mi) * 128, n0 = nt * 128;
      if (n0 + 128 <= PROJW) store_tile_bf16(fbuf, acc, [&](int r) { return proj + (size_t)(m0 + r) * PROJW + n0; });
      else
#pragma unroll
      for (int m = 0; m < 4; ++m)
#pragma unroll
        for (int n = 0; n < 4; ++n) {
          const int row = m0 + wr * 64 + m * 16 + fr, col = n0 + wc * 64 + n * 16 + fq * 4;
          if (col < PROJW) {
            u32x2 w; w[0] = pack2(acc[m][n][0], acc[m][n][1]); w[1] = pack2(acc[m][n][2], acc[m][n][3]);
            *(u32x2*)(proj + (size_t)row * PROJW + col) = w;
          } else if (col < INC) {
            *(f32x4*)(ba + (size_t)row * 8 + (col - PROJW)) = acc[m][n];
          }
        }
      if (n0 == OFF_SV) {
        const int bb = m0 / SEQ, t0_ = m0 % SEQ;
        store_tile_bf16_T(fbuf, acc, [&](int c) { return vt + ((size_t)(bb * 128 + c)) * SEQ + t0_; });
      }
    }
  });
}

__device__ __forceinline__ bf16x8 pack8(f32x4 a, f32x4 b) {
  union { bf16x8 v; unsigned u[4]; } x;
  x.u[0] = pack2(a[0], a[1]); x.u[1] = pack2(a[2], a[3]); x.u[2] = pack2(b[0], b[1]); x.u[3] = pack2(b[2], b[3]);
  return x.v;
}
__device__ __forceinline__ void ph_dnchunk(unsigned char* smem, int item, const bf16_t* __restrict__ proj, const float* __restrict__ ba, const float* __restrict__ conv_w,
                                           const float* __restrict__ a_log, const float* __restrict__ dt_bias,
                                           bf16_t* __restrict__ QD, bf16_t* __restrict__ W0N, bf16_t* __restrict__ KTT, bf16_t* __restrict__ RV,
                                           bf16_t* __restrict__ TM, bf16_t* __restrict__ ATT, float* __restrict__ GL) {
  const int tid = TIDX, lane = tid & 63, w = tid >> 6, fr = lane & 15, fq = lane >> 4;
  const int n = item & 63, h = (item >> 6) & 3, b = item >> 8;
  const int t0 = n * 64; const size_t row0 = (size_t)b * SEQ + t0;
  unsigned char* qs = smem; unsigned char* ks = smem + 16384; float* AT = (float*)(smem + 32768);
  const float scale = 0.08838834764831845f;
  float bL, gcL;
  {
    const float* bap = ba + (row0 + lane) * 8;
    bL = sigmoidf(bap[h]);
    const float xx = bap[4 + h] + dt_bias[h];
    const float sp = fmaxf(xx, 0.f) + log1pf(__expf(-fabsf(xx)));
    float gg = -__expf(a_log[h]) * sp;
#pragma unroll
    for (int o = 1; o < 64; o <<= 1) { const float v = __shfl_up(gg, o); if (lane >= o) gg += v; }
    gcL = gg;
  }
  {
    const int d = 2 * lane;
    float cw[3][4][2];
#pragma unroll
    for (int mx = 0; mx < 3; ++mx)
#pragma unroll
      for (int j = 0; j < 4; ++j) {
        const float2 c2 = *(const float2*)(conv_w + j * 1536 + mx * 512 + h * 128 + d);
        cw[mx][j][0] = c2.x; cw[mx][j][1] = c2.y;
      }
    const bf16_t* pbase = proj + (row0 + 16 * w) * PROJW + h * 128 + d;
    unsigned raw[3][19];
#pragma unroll
    for (int j = 0; j < 19; ++j) {
      const bool ok = (t0 + 16 * w - 3 + j) >= 0;
#pragma unroll
      for (int mx = 0; mx < 3; ++mx) {
        unsigned u = 0;
        if (ok) u = *(const unsigned*)(pbase + (ptrdiff_t)(j - 3) * PROJW + mx * 512);
        raw[mx][j] = u;
      }
    }
#pragma unroll
    for (int i = 0; i < 16; ++i) {
      float s[3][2];
#pragma unroll
      for (int mx = 0; mx < 3; ++mx) {
        float y0 = 0.f, y1 = 0.f;
#pragma unroll
        for (int j = 0; j < 4; ++j) { y0 += cw[mx][j][0] * bflo(raw[mx][i + j]); y1 += cw[mx][j][1] * bfhi(raw[mx][i + j]); }
        s[mx][0] = siluf(y0); s[mx][1] = siluf(y1);
      }
      const int row = 16 * w + i;
      const float rq = rsqrtf(wave_sum(s[0][0] * s[0][0] + s[0][1] * s[0][1]) + L2_EPS);
      const float rk = rsqrtf(wave_sum(s[1][0] * s[1][0] + s[1][1] * s[1][1]) + L2_EPS);
      const int off = row * 256 + ((((lane >> 2) ^ (row & 15))) << 4) + (lane & 3) * 4;
      *(unsigned*)(qs + off) = pack2(s[0][0] * rq, s[0][1] * rq);
      *(unsigned*)(ks + off) = pack2(s[1][0] * rk, s[1][1] * rk);
      const float bi = __shfl(bL, row);
      *(unsigned*)(RV + ((size_t)item * 64 + row) * 128 + d) = pack2(bi * s[2][0], bi * s[2][1]);
    }
  }
  __syncthreads();
  {
    f32x4 aKK[4], aQK[4];
#pragma unroll
    for (int nt = 0; nt < 4; ++nt) { aKK[nt] = (f32x4){0.f, 0.f, 0.f, 0.f}; aQK[nt] = (f32x4){0.f, 0.f, 0.f, 0.f}; }
#pragma unroll
    for (int k4 = 0; k4 < 4; ++k4) {
      const int arow = 16 * w + fr;
      const bf16x8 aq = *(const bf16x8*)(qs + arow * 256 + ((((k4 * 4 + fq) ^ (arow & 15))) << 4));
      const bf16x8 ak = *(const bf16x8*)(ks + arow * 256 + ((((k4 * 4 + fq) ^ (arow & 15))) << 4));
#pragma unroll
      for (int nt = 0; nt < 4; ++nt) {
        const int brow = 16 * nt + fr;
        const bf16x8 bk = *(const bf16x8*)(ks + brow * 256 + ((((k4 * 4 + fq) ^ (brow & 15))) << 4));
        aKK[nt] = __builtin_amdgcn_mfma_f32_16x16x32_bf16(ak, bk, aKK[nt], 0, 0, 0);
        aQK[nt] = __builtin_amdgcn_mfma_f32_16x16x32_bf16(bk, aq, aQK[nt], 0, 0, 0);
      }
    }
    float gci[4], bi[4];
#pragma unroll
    for (int r = 0; r < 4; ++r) { gci[r] = __shfl(gcL, 16 * w + 4 * fq + r); bi[r] = __shfl(bL, 16 * w + 4 * fq + r); }
    const float gci2 = __shfl(gcL, 16 * w + fr);
#pragma unroll
    for (int nt = 0; nt < 4; ++nt) {
      const int j = 16 * nt + fr;
      const float gcj = __shfl(gcL, j);
      float av[4], at[4];
#pragma unroll
      for (int r = 0; r < 4; ++r) {
        const int i = 16 * w + 4 * fq + r;
        const float dec = (j <= i) ? __expf(gci[r] - gcj) : 0.f;
        av[r] = (j < i) ? bi[r] * aKK[nt][r] * dec : 0.f;
        const int i2 = 16 * w + fr, j2 = 16 * nt + 4 * fq + r;
        const float gcj2 = __shfl(gcL, j2);
        const float dec2 = (j2 <= i2) ? __expf(gci2 - gcj2) : 0.f;
        at[r] = aQK[nt][r] * scale * dec2;
      }
      *(float4*)(AT + j * 68 + 16 * w + 4 * fq) = make_float4(av[0], av[1], av[2], av[3]);
      u32x2 wv; wv[0] = pack2(at[0], at[1]); wv[1] = pack2(at[2], at[3]);
      *(u32x2*)(ATT + ((size_t)item * 64 + 16 * w + fr) * 64 + 32 * (nt >> 1) + 8 * fq + 4 * (nt & 1)) = wv;
    }
  }
  __syncthreads();
  if (w == 0) {
    float Tr[64];
    int ln = lane; asm volatile("" : "+v"(ln));
#pragma unroll
    for (int j = 0; j < 64; ++j) Tr[j] = 0.f;
    f32x4 cur[16], nxt[16];
#pragma unroll
    for (int j4 = 0; j4 < 16; ++j4) nxt[j4] = (f32x4){0.f, 0.f, 0.f, 0.f};
#pragma unroll
    for (int j4 = 15; j4 >= 16; --j4) cur[j4] = *(const f32x4*)(AT + 63 * 68 + j4 * 4);
#pragma unroll
    for (int c = 63; c >= 0; --c) {
      if (c > 0) {
#pragma unroll
        for (int j4 = 15; j4 >= c / 4; --j4) nxt[j4] = *(const f32x4*)(AT + (c - 1) * 68 + j4 * 4);
      }
      float a0 = 0.f, a1 = 0.f, a2 = 0.f, a3 = 0.f;
#pragma unroll
      for (int j4 = 15; j4 >= (c + 1) / 4; --j4) {
        asm volatile("v_fmac_f32 %0, %1, %2" : "+v"(a0) : "v"(Tr[4 * j4 + 0]), "v"(cur[j4][0]));
        asm volatile("v_fmac_f32 %0, %1, %2" : "+v"(a1) : "v"(Tr[4 * j4 + 1]), "v"(cur[j4][1]));
        asm volatile("v_fmac_f32 %0, %1, %2" : "+v"(a2) : "v"(Tr[4 * j4 + 2]), "v"(cur[j4][2]));
        asm volatile("v_fmac_f32 %0, %1, %2" : "+v"(a3) : "v"(Tr[4 * j4 + 3]), "v"(cur[j4][3]));
      }
      Tr[c] = ((ln == c) ? 1.f : 0.f) - ((a0 + a1) + (a2 + a3));
#pragma unroll
      for (int j4 = 0; j4 < 16; ++j4) cur[j4] = nxt[j4];
    }
    u32x4* tp = (u32x4*)(TM + ((size_t)item * 64 + lane) * 64);
#pragma unroll
    for (int oc = 0; oc < 8; ++oc) {
      const int k0 = 32 * (oc >> 2) + 4 * (oc & 3);
      u32x4 v;
      v[0] = pack2(Tr[k0 + 0], Tr[k0 + 1]); v[1] = pack2(Tr[k0 + 2], Tr[k0 + 3]);
      v[2] = pack2(Tr[k0 + 16], Tr[k0 + 17]); v[3] = pack2(Tr[k0 + 18], Tr[k0 + 19]);
      tp[oc] = v;
    }
  } else {
    const float gclast = __shfl(gcL, 63);
    if (tid == 64) GL[item] = __expf(gclast);
#pragma unroll 1
    for (int it = 0; it < 16; ++it) {
      const int idx = (tid - 64) + it * 192;
      const int mtx = idx >> 10, rem = idx & 1023;
      if (mtx < 2) {
        const int i = rem >> 4, oc = rem & 15;
        const float gi = __shfl(gcL, i), bi = __shfl(bL, i);
        const float f = (mtx == 0) ? scale * __expf(gi) : -bi * __expf(gi);
        const unsigned char* st = (mtx == 0) ? qs : ks;
        const int d0 = 32 * (oc >> 2) + 4 * (oc & 3);
        const uint2 lo = *(const uint2*)(st + i * 256 + ((((d0 >> 3) ^ (i & 15))) << 4) + (d0 & 7) * 2);
        const uint2 hi = *(const uint2*)(st + i * 256 + (((((d0 + 16) >> 3) ^ (i & 15))) << 4) + (d0 & 7) * 2);
        u32x4 v;
        v[0] = pack2(bflo(lo.x) * f, bfhi(lo.x) * f); v[1] = pack2(bflo(lo.y) * f, bfhi(lo.y) * f);
        v[2] = pack2(bflo(hi.x) * f, bfhi(hi.x) * f); v[3] = pack2(bflo(hi.y) * f, bfhi(hi.y) * f);
        bf16_t* dst = ((mtx == 0) ? QD : W0N) + ((size_t)item * 64 + i) * 128 + 8 * oc;
        *(u32x4*)dst = v;
      } else {
        const int d = rem & 127, oc = rem >> 7;
        const int j0 = 32 * (oc >> 2) + 4 * (oc & 3);
        float val[8];
#pragma unroll
        for (int e = 0; e < 8; ++e) {
          const int j = j0 + (e & 3) + ((e >> 2) << 4);
          const float f = __expf(gclast - __shfl(gcL, j));
          const unsigned short raw = *(const unsigned short*)(ks + j * 256 + ((((d >> 3) ^ (j & 15))) << 4) + (d & 7) * 2);
          val[e] = bf2f(raw) * f;
        }
        u32x4 v;
        v[0] = pack2(val[0], val[1]); v[1] = pack2(val[2], val[3]); v[2] = pack2(val[4], val[5]); v[3] = pack2(val[6], val[7]);
        *(u32x4*)(KTT + ((size_t)item * 128 + d) * 64 + 8 * oc) = v;
      }
    }
  }
  __syncthreads();
}

__device__ __forceinline__ void ph_dnscan(unsigned char* smem, int item, const bf16_t* __restrict__ QDp, const bf16_t* __restrict__ W0Np, const bf16_t* __restrict__ KTTp,
                                          const bf16_t* __restrict__ RVp, const bf16_t* __restrict__ TMp, const bf16_t* __restrict__ ATTp, const float* __restrict__ GLp,
                                          float* __restrict__ op) {
  const int tid = TIDX, lane = tid & 63, w = tid >> 6, fr = lane & 15, fq = lane >> 4;
  const int bh = item >> 1, half = item & 1, b = bh >> 2, h = bh & 3;
  const int vcol0 = (half * 4 + w) * 16;
  unsigned char* sW0 = smem; unsigned char* sQD = smem + 16384; unsigned char* sKT = smem + 32768; unsigned char* sT = smem + 49152; unsigned char* sAT = smem + 57344;
  f32x4 S[8];
#pragma unroll
  for (int t = 0; t < 8; ++t) S[t] = (f32x4){0.f, 0.f, 0.f, 0.f};
  u32x4 pfA[8], pfB[8]; unsigned short rvp[16];
#define DN_LOAD_A(nn_) do { \
    const size_t ci = (size_t)bh * 64 + (nn_); \
    _Pragma("unroll") for (int i = 0; i < 4; ++i) pfA[i] = *(const u32x4*)((const char*)W0Np + ci * 16384 + (size_t)(tid + 256 * i) * 16); \
    _Pragma("unroll") for (int i = 0; i < 4; ++i) pfA[4 + i] = *(const u32x4*)((const char*)QDp + ci * 16384 + (size_t)(tid + 256 * i) * 16); \
    _Pragma("unroll") for (int mt = 0; mt < 4; ++mt) \
      _Pragma("unroll") for (int r = 0; r < 4; ++r) rvp[mt * 4 + r] = RVp[(ci * 64 + 16 * mt + 4 * fq + r) * 128 + vcol0 + fr]; \
  } while (0)
#define DN_STORE_A() do { \
    _Pragma("unroll") for (int i = 0; i < 4; ++i) { const int q = tid + 256 * i, row = q >> 4, ch = q & 15; *(u32x4*)(sW0 + row * 256 + ((ch ^ (row & 15)) << 4)) = pfA[i]; } \
    _Pragma("unroll") for (int i = 0; i < 4; ++i) { const int q = tid + 256 * i, row = q >> 4, ch = q & 15; *(u32x4*)(sQD + row * 256 + ((ch ^ (row & 15)) << 4)) = pfA[4 + i]; } \
  } while (0)
#define DN_LOAD_B(nn_) do { \
    const size_t ci = (size_t)bh * 64 + (nn_); \
    _Pragma("unroll") for (int i = 0; i < 4; ++i) pfB[i] = *(const u32x4*)((const char*)KTTp + ci * 16384 + (size_t)(tid + 256 * i) * 16); \
    _Pragma("unroll") for (int i = 0; i < 2; ++i) pfB[4 + i] = *(const u32x4*)((const char*)TMp + ci * 8192 + (size_t)(tid + 256 * i) * 16); \
    _Pragma("unroll") for (int i = 0; i < 2; ++i) pfB[6 + i] = *(const u32x4*)((const char*)ATTp + ci * 8192 + (size_t)(tid + 256 * i) * 16); \
  } while (0)
#define DN_STORE_B() do { \
    _Pragma("unroll") for (int i = 0; i < 4; ++i) { const int q = tid + 256 * i, row = q >> 3, ch = q & 7; *(u32x4*)(sKT + row * 128 + ((ch ^ (row & 7)) << 4)) = pfB[i]; } \
    _Pragma("unroll") for (int i = 0; i < 2; ++i) { const int q = tid + 256 * i, row = q >> 3, ch = q & 7; *(u32x4*)(sT + row * 128 + ((ch ^ (row & 7)) << 4)) = pfB[4 + i]; } \
    _Pragma("unroll") for (int i = 0; i < 2; ++i) { const int q = tid + 256 * i, row = q >> 3, ch = q & 7; *(u32x4*)(sAT + row * 128 + ((ch ^ (row & 7)) << 4)) = pfB[6 + i]; } \
  } while (0)
#define DN_ZINIT() do { _Pragma("unroll") for (int mt = 0; mt < 4; ++mt) Z[mt] = (f32x4){bf2f(rvp[mt * 4 + 0]), bf2f(rvp[mt * 4 + 1]), bf2f(rvp[mt * 4 + 2]), bf2f(rvp[mt * 4 + 3])}; } while (0)
  __syncthreads();
  f32x4 Z[4];
  DN_LOAD_A(0);
  DN_LOAD_B(0);
  DN_STORE_A();
  DN_ZINIT();
  DN_LOAD_A(1);
  for (int nn = 0; nn < 64; ++nn) {
    const float gl = GLp[(size_t)bh * 64 + nn];
    __syncthreads();
    bf16x8 Sb[4];
#pragma unroll
    for (int k4 = 0; k4 < 4; ++k4) Sb[k4] = pack8(S[2 * k4], S[2 * k4 + 1]);
    f32x4 O[4];
#pragma unroll
    for (int mt = 0; mt < 4; ++mt) {
      O[mt] = (f32x4){0.f, 0.f, 0.f, 0.f};
      const int row = 16 * mt + fr;
#pragma unroll
      for (int k4 = 0; k4 < 4; ++k4) {
        const int off = row * 256 + ((((k4 * 4 + fq) ^ fr)) << 4);
        const bf16x8 aw = *(const bf16x8*)(sW0 + off);
        const bf16x8 aq = *(const bf16x8*)(sQD + off);
        Z[mt] = __builtin_amdgcn_mfma_f32_16x16x32_bf16(aw, Sb[k4], Z[mt], 0, 0, 0);
        O[mt] = __builtin_amdgcn_mfma_f32_16x16x32_bf16(Sb[k4], aq, O[mt], 0, 0, 0);
      }
    }
    bf16x8 Zb[2];
    Zb[0] = pack8(Z[0], Z[1]); Zb[1] = pack8(Z[2], Z[3]);
    DN_STORE_B();
    if (nn + 1 < 64) DN_LOAD_B(nn + 1);
    __syncthreads();
    f32x4 Vn[4];
#pragma unroll
    for (int mt = 0; mt < 4; ++mt) {
      Vn[mt] = (f32x4){0.f, 0.f, 0.f, 0.f};
      const int row = 16 * mt + fr;
#pragma unroll
      for (int s = 0; s < 2; ++s) {
        if (s <= (mt >> 1)) {
          const bf16x8 at = *(const bf16x8*)(sT + row * 128 + ((((s * 4 + fq) ^ (row & 7))) << 4));
          Vn[mt] = __builtin_amdgcn_mfma_f32_16x16x32_bf16(at, Zb[s], Vn[mt], 0, 0, 0);
        }
      }
    }
    bf16x8 Vb[2];
    Vb[0] = pack8(Vn[0], Vn[1]); Vb[1] = pack8(Vn[2], Vn[3]);
#pragma unroll
    for (int mt = 0; mt < 4; ++mt) {
      const int row = 16 * mt + fr;
#pragma unroll
      for (int s = 0; s < 2; ++s) {
        if (s <= (mt >> 1)) {
          const bf16x8 aa = *(const bf16x8*)(sAT + row * 128 + ((((s * 4 + fq) ^ (row & 7))) << 4));
          O[mt] = __builtin_amdgcn_mfma_f32_16x16x32_bf16(Vb[s], aa, O[mt], 0, 0, 0);
        }
      }
      *(f32x4*)(op + ((size_t)b * SEQ + nn * 64 + 16 * mt + fr) * 512 + h * 128 + vcol0 + 4 * fq) = O[mt];
    }
#pragma unroll
    for (int t = 0; t < 8; ++t) {
      S[t] = S[t] * gl;
      const int row = 16 * t + fr;
#pragma unroll
      for (int s = 0; s < 2; ++s) {
        const bf16x8 ak = *(const bf16x8*)(sKT + row * 128 + ((((s * 4 + fq) ^ (row & 7))) << 4));
        S[t] = __builtin_amdgcn_mfma_f32_16x16x32_bf16(ak, Vb[s], S[t], 0, 0, 0);
      }
    }
    if (nn + 1 < 64) {
      DN_STORE_A();
      DN_ZINIT();
      if (nn + 2 < 64) DN_LOAD_A(nn + 2);
    }
  }
  __syncthreads();
#undef DN_ZINIT
#undef DN_LOAD_A
#undef DN_STORE_A
#undef DN_LOAD_B
#undef DN_STORE_B
}

__device__ __forceinline__ void ph_dn_post(int item, const float* __restrict__ o, const bf16_t* __restrict__ proj, const float* __restrict__ dn_norm_g, bf16_t* __restrict__ mixed) {
  const int tid = TIDX, h = tid >> 6, lane = tid & 63;
  const float2 g2 = *(const float2*)(dn_norm_g + 2 * lane);
  float2 ov[4]; unsigned zv[4];
#pragma unroll
  for (int i = 0; i < 4; ++i) {
    const size_t n = (size_t)item * 4 + i;
    ov[i] = *(const float2*)(o + n * 512 + h * 128 + 2 * lane);
    zv[i] = *(const unsigned*)(proj + n * PROJW + OFF_Z + h * 128 + 2 * lane);
  }
#pragma unroll
  for (int i = 0; i < 4; ++i) {
    const size_t n = (size_t)item * 4 + i;
    const float ss = wave_sum(ov[i].x * ov[i].x + ov[i].y * ov[i].y);
    const float rn = rsqrtf(ss * (1.f / 128.f) + RMS_EPS);
    *(unsigned*)(mixed + n * DM + h * 128 + 2 * lane) = pack2(ov[i].x * rn * g2.x * siluf(bflo(zv[i])), ov[i].y * rn * g2.y * siluf(bfhi(zv[i])));
  }
}

__device__ __forceinline__ void ph_swa(unsigned char* smem, int item, const bf16_t* __restrict__ proj, const bf16_t* __restrict__ vt, const float* __restrict__ sinks, bf16_t* __restrict__ mixed) {
  const int tid = TIDX, lane = tid & 63, w = tid >> 6, fr = lane & 15, fq = lane >> 4;
  const int qb = item & 31, kvh = (item >> 5) & 1, b = item >> 6;
  const int t0 = qb * 128;
  const size_t rowb = (size_t)b * SEQ;
  unsigned char* sK = smem;
  unsigned char* sV = smem + 32768;
  __syncthreads();
#pragma unroll
  for (int i = 0; i < 8; ++i) {
    const int q = tid + 256 * i, row = q >> 3, ch = q & 7;
    const int pos = t0 - 128 + row;
    u32x4 v = (u32x4){0u, 0u, 0u, 0u};
    if (pos >= 0) v = *(const u32x4*)(proj + (rowb + pos) * PROJW + OFF_SK + kvh * 64 + ch * 8);
    *(u32x4*)(sK + row * 128 + ((ch ^ (row & 7)) << 4)) = v;
  }
#pragma unroll
  for (int i = 0; i < 8; ++i) {
    const int q = tid + 256 * i, row = q >> 5, ch = q & 31;
    const int pos = t0 - 128 + ch * 8;
    u32x4 v = (u32x4){0u, 0u, 0u, 0u};
    if (pos >= 0) v = *(const u32x4*)(vt + ((size_t)(b * 128 + kvh * 64 + row)) * SEQ + pos);
    *(u32x4*)(sV + row * 512 + ((ch ^ (row & 15)) << 4)) = v;
  }
  __syncthreads();
  const int head = kvh * 4 + w;
  const float slope = exp2f(-(float)(head + 1));
  const float sink = sinks[head];
  const bf16_t* qp0 = proj + (rowb + t0 + fr) * PROJW + OFF_SQ + head * 64 + fq * 8;
  bf16x8 qn0 = *(const bf16x8*)(qp0), qn1 = *(const bf16x8*)(qp0 + 32);
#pragma unroll 1
  for (int qt = 0; qt < 8; ++qt) {
    const bf16x8 qf0 = qn0, qf1 = qn1;
    if (qt < 7) { const bf16_t* qp = qp0 + (size_t)(qt + 1) * 16 * PROJW; qn0 = *(const bf16x8*)(qp); qn1 = *(const bf16x8*)(qp + 32); }
    const int kp0 = qt >> 1;
    f32x4 st[10];
#pragma unroll
    for (int kt = 0; kt < 10; ++kt) {
      const int krow = (2 * kp0 + kt) * 16 + fr;
      st[kt] = (f32x4){0.f, 0.f, 0.f, 0.f};
      const bf16x8 k0 = *(const bf16x8*)(sK + krow * 128 + (((0 + fq) ^ (krow & 7)) << 4));
      const bf16x8 k1 = *(const bf16x8*)(sK + krow * 128 + (((4 + fq) ^ (krow & 7)) << 4));
      st[kt] = __builtin_amdgcn_mfma_f32_16x16x32_bf16(k0, qf0, st[kt], 0, 0, 0);
      st[kt] = __builtin_amdgcn_mfma_f32_16x16x32_bf16(k1, qf1, st[kt], 0, 0, 0);
    }
    const int i = qt * 16 + fr;
    float mx = sink;
#pragma unroll
    for (int kt = 0; kt < 10; ++kt)
#pragma unroll
      for (int r = 0; r < 4; ++r) {
        const int jb = (2 * kp0 + kt) * 16 + 4 * fq + r;
        const int dist = 128 + i - jb;
        const bool ok = (dist >= 0) && (dist < 128) && (t0 - 128 + jb >= 0);
        const float s = ok ? (st[kt][r] * 0.125f - slope * (float)dist) : -INFINITY;
        st[kt][r] = s;
        mx = fmaxf(mx, s);
      }
    mx = fmaxf(mx, __shfl_xor(mx, 16));
    mx = fmaxf(mx, __shfl_xor(mx, 32));
    float sum = 0.f;
#pragma unroll
    for (int kt = 0; kt < 10; ++kt)
#pragma unroll
      for (int r = 0; r < 4; ++r) { const float p = __expf(st[kt][r] - mx); st[kt][r] = p; sum += p; }
    sum += __shfl_xor(sum, 16);
    sum += __shfl_xor(sum, 32);
    const float inv = 1.f / (sum + __expf(sink - mx));
    f32x4 O[4];
#pragma unroll
    for (int nt = 0; nt < 4; ++nt) O[nt] = (f32x4){0.f, 0.f, 0.f, 0.f};
#pragma unroll
    for (int s5 = 0; s5 < 5; ++s5) {
      const bf16x8 pa = pack8(st[2 * s5] * inv, st[2 * s5 + 1] * inv);
      const int key0 = (2 * kp0 + 2 * s5) * 16 + 4 * fq;
#pragma unroll
      for (int nt = 0; nt < 4; ++nt) {
        const int drow = nt * 16 + fr;
        const int c0 = key0 >> 3, c1 = (key0 + 16) >> 3;
        const u32x2 lo = *(const u32x2*)(sV + drow * 512 + ((c0 ^ (drow & 15)) << 4) + ((key0 >> 2) & 1) * 8);
        const u32x2 hi = *(const u32x2*)(sV + drow * 512 + ((c1 ^ (drow & 15)) << 4) + ((key0 >> 2) & 1) * 8);
        const u32x4 vb = (u32x4){lo[0], lo[1], hi[0], hi[1]};
        O[nt] = __builtin_amdgcn_mfma_f32_16x16x32_bf16(__builtin_bit_cast(bf16x8, vb), pa, O[nt], 0, 0, 0);
      }
    }
#pragma unroll
    for (int nt = 0; nt < 4; ++nt) {
      u32x2 wv; wv[0] = pack2(O[nt][0], O[nt][1]); wv[1] = pack2(O[nt][2], O[nt][3]);
      *(u32x2*)(mixed + (rowb + t0 + qt * 16 + fr) * DM + 512 + head * 64 + nt * 16 + 4 * fq) = wv;
    }
  }
}

__device__ __forceinline__ void ph_wout(unsigned char* smem, int xcd, int l, const bf16_t* __restrict__ mixed, const bf16_t* __restrict__ wt, bf16_t* __restrict__ mixo) {
  const int mi = l >> 3, ni = l & 7;
  LdRowBF16 al; al.init([&](int r) { return mixed + (size_t)((xcd * 32 + mi) * 128 + r) * DM; }, (size_t)8 * 128 * DM * 2);
  LdRowBF16 bl; bl.init([&](int r) { return wt + (size_t)(ni * 128 + r) * DM; }, 0);
  gemm_stream<16>(smem, al, bl, 4, [&](int seg, f32x4 (&acc)[4][4], unsigned char* fbuf) {
    const int m0 = (xcd * 32 + seg * 8 + mi) * 128, n0 = ni * 128;
    store_tile_bf16(fbuf, acc, [&](int r) { return mixo + (size_t)(m0 + r) * DM + n0; });
  });
}

__device__ __forceinline__ void ph_ln1(int item, const float* __restrict__ x, const bf16_t* __restrict__ mixo, const float* __restrict__ gam, const float* __restrict__ bet, bf16_t* __restrict__ xbf, unsigned char* __restrict__ x8) {
  const int row = item * 4 + (TIDX >> 6), lane = TIDX & 63;
  const float4* p = (const float4*)(x + (size_t)row * DM);
  const u32x2* pm = (const u32x2*)(mixo + (size_t)row * DM);
  float4 v[4]; float s = 0.f;
#pragma unroll
  for (int i = 0; i < 4; ++i) {
    const float4 xv = p[lane + i * 64]; const u32x2 mv = pm[lane + i * 64];
    v[i].x = ALPHA * xv.x + bflo(mv[0]); v[i].y = ALPHA * xv.y + bfhi(mv[0]); v[i].z = ALPHA * xv.z + bflo(mv[1]); v[i].w = ALPHA * xv.w + bfhi(mv[1]);
    s += v[i].x + v[i].y + v[i].z + v[i].w;
  }
  const float mu = wave_sum(s) * (1.f / DM);
  float q = 0.f;
#pragma unroll
  for (int i = 0; i < 4; ++i) { const float a = v[i].x - mu, b = v[i].y - mu, c = v[i].z - mu, d = v[i].w - mu; q += a * a + b * b + c * c + d * d; }
  const float rs = rsqrtf(wave_sum(q) * (1.f / DM) + LN_EPS);
#pragma unroll
  for (int i = 0; i < 4; ++i) {
    const float4 gg = ((const float4*)gam)[lane + i * 64], bb = ((const float4*)bet)[lane + i * 64];
    u32x2 w;
    w[0] = pack2((v[i].x - mu) * rs * gg.x + bb.x, (v[i].y - mu) * rs * gg.y + bb.y);
    w[1] = pack2((v[i].z - mu) * rs * gg.z + bb.z, (v[i].w - mu) * rs * gg.w + bb.w);
    ((u32x2*)(xbf + (size_t)row * DM))[lane + i * 64] = w;
    int pk = 0;
    pk = __builtin_amdgcn_cvt_pk_fp8_f32((v[i].x - mu) * rs * gg.x + bb.x, (v[i].y - mu) * rs * gg.y + bb.y, pk, false);
    pk = __builtin_amdgcn_cvt_pk_fp8_f32((v[i].z - mu) * rs * gg.z + bb.z, (v[i].w - mu) * rs * gg.w + bb.w, pk, true);
    ((int*)(x8 + (size_t)row * DM))[lane + i * 64] = pk;
  }
}

__device__ __forceinline__ void ph_router(unsigned char* smem, int tile, const bf16_t* __restrict__ xbf, const bf16_t* __restrict__ wt, float* __restrict__ logits) {
  GEMM_IDS
  const int n0 = (tile & 1) * 128, m0 = (tile >> 1) * 128;
  LdRowBF16 al; al.init([&](int r) { return xbf + (size_t)(m0 + r) * DM; }, 0);
  LdRowBF16 bl; bl.init([&](int r) { return wt + (size_t)(n0 + r) * DM; }, 0);
  gemm_stream<16>(smem, al, bl, 1, [&](int seg, f32x4 (&acc)[4][4], unsigned char* fbuf) {
    GEMM_IDS
#pragma unroll
    for (int m = 0; m < 4; ++m)
#pragma unroll
      for (int n = 0; n < 4; ++n)
        *(f32x4*)(logits + (size_t)(m0 + wr * 64 + m * 16 + fr) * NEXP + n0 + wc * 64 + n * 16 + fq * 4) = acc[m][n];
  });
}

__device__ __forceinline__ unsigned rt_fkey(float f) { const unsigned b = __float_as_uint(f); return (b & 0x80000000u) ? ~b : (b | 0x80000000u); }
#define RT_DPPF(x, ctrl) __builtin_bit_cast(float, __builtin_amdgcn_update_dpp(__builtin_bit_cast(int, x), __builtin_bit_cast(int, x), ctrl, 0xf, 0xf, false))
#define RT_DPPU(x, ctrl, rmask) (unsigned)__builtin_amdgcn_update_dpp((int)(x), (int)(x), ctrl, rmask, 0xf, false)
#define RT_KSTEP(hi, lo, ctrl, rmask) { const unsigned ph_ = RT_DPPU(hi, ctrl, rmask), pl_ = RT_DPPU(lo, ctrl, rmask); \
    const bool t_ = (ph_ > hi) || (ph_ == hi && pl_ > lo); hi = t_ ? ph_ : hi; lo = t_ ? pl_ : lo; }
__device__ __forceinline__ void ph_route(int item, const float* __restrict__ logits, const float* __restrict__ router_bias, int* __restrict__ cnt, int* __restrict__ list, float* __restrict__ gates) {
  const int n = item * 4 + (TIDX >> 6), lane = TIDX & 63;
  const float4 lg = ((const float4*)(logits + (size_t)n * NEXP))[lane];
  const float4 rb = ((const float4*)router_bias)[lane];
  const float sc0 = sigmoidf(lg.x), sc1 = sigmoidf(lg.y), sc2 = sigmoidf(lg.z), sc3 = sigmoidf(lg.w);
  const float sel0 = sc0 + rb.x, sel1 = sc1 + rb.y, sel2 = sc2 + rb.z, sel3 = sc3 + rb.w;
  float t1 = fmaxf(sel0, sel1), t2 = fminf(sel0, sel1);
  { const float a = sel2; if (a > t1) { t2 = t1; t1 = a; } else if (a > t2) t2 = a; }
  { const float a = sel3; if (a > t1) { t2 = t1; t1 = a; } else if (a > t2) t2 = a; }
  { const float b1 = RT_DPPF(t1, 0xB1), b2 = RT_DPPF(t2, 0xB1); const float n1 = fmaxf(t1, b1), n2 = fmaxf(fminf(t1, b1), fmaxf(t2, b2)); t1 = n1; t2 = n2; }
  { const float b1 = RT_DPPF(t1, 0x4E), b2 = RT_DPPF(t2, 0x4E); const float n1 = fmaxf(t1, b1), n2 = fmaxf(fminf(t1, b1), fmaxf(t2, b2)); t1 = n1; t2 = n2; }
  { const float b1 = RT_DPPF(t1, 0x141), b2 = RT_DPPF(t2, 0x141); const float n1 = fmaxf(t1, b1), n2 = fmaxf(fminf(t1, b1), fmaxf(t2, b2)); t1 = n1; t2 = n2; }
  const float gs = t1 + t2;
  const int mygrp = lane >> 3;
  int rank = 0;
#pragma unroll
  for (int j = 0; j < 8; ++j) {
    const float o = __builtin_bit_cast(float, __builtin_amdgcn_readlane(__builtin_bit_cast(int, gs), j * 8));
    rank += (o > gs || (o == gs && j < mygrp)) ? 1 : 0;
  }
  const bool gsel = rank < 4;
  unsigned k0 = gsel ? rt_fkey(sel0) : 0u, k1 = gsel ? rt_fkey(sel1) : 0u, k2 = gsel ? rt_fkey(sel2) : 0u, k3 = gsel ? rt_fkey(sel3) : 0u;
  float gsum = 0.f; float myg = 0.f; int mye = 0;
#pragma unroll 1
  for (int r = 0; r < TOPK; ++r) {
    unsigned hi = k0, lo = 255u - (unsigned)(lane * 4);
    if (k1 > hi) { hi = k1; lo = 255u - (unsigned)(lane * 4 + 1); }
    if (k2 > hi) { hi = k2; lo = 255u - (unsigned)(lane * 4 + 2); }
    if (k3 > hi) { hi = k3; lo = 255u - (unsigned)(lane * 4 + 3); }
    RT_KSTEP(hi, lo, 0xB1, 0xf) RT_KSTEP(hi, lo, 0x4E, 0xf) RT_KSTEP(hi, lo, 0x141, 0xf) RT_KSTEP(hi, lo, 0x140, 0xf)
    RT_KSTEP(hi, lo, 0x142, 0xa) RT_KSTEP(hi, lo, 0x143, 0xc)
    const int be = 255 - __builtin_amdgcn_readlane((int)lo, 63);
    const int owner = be >> 2, slot = be & 3;
    const float tsel = (slot == 0) ? sc0 : (slot == 1) ? sc1 : (slot == 2) ? sc2 : sc3;
    const float bs = __builtin_bit_cast(float, __builtin_amdgcn_readlane(__builtin_bit_cast(int, tsel), owner));
    if (lane == owner) { if (slot == 0) k0 = 0u; else if (slot == 1) k1 = 0u; else if (slot == 2) k2 = 0u; else k3 = 0u; }
    gsum += bs;
    if (lane == r) { myg = bs; mye = be; }
  }
  if (lane < TOPK) {
    const int sh = item & (NSH - 1);
    const int slot = atomicAdd(&cnt[sh * NEXP + mye], 1);
    list[((size_t)sh * NEXP + mye) * CAPS + slot] = n * TOPK + lane;
    gates[(size_t)n * TOPK + lane] = myg / gsum * 2.5f;
  }
}
#undef RT_KSTEP

__device__ __forceinline__ void moe_build_prefix(const int* __restrict__ cnt, int* sscan) {
  const int tid = TIDX;
  const int e = ((tid & 31) << 3) | (tid >> 5);
  int c = 0;
#pragma unroll
  for (int s = 0; s < NSH; ++s) c += cnt[s * NEXP + e];
  __syncthreads();
  sscan[tid] = (c + 127) >> 7;
  __syncthreads();
  for (int o = 1; o < 256; o <<= 1) {
    const int v = (tid >= o) ? sscan[tid - o] : 0;
    __syncthreads();
    sscan[tid] += v;
    __syncthreads();
  }
}
__device__ __forceinline__ void moe_locate(const int* sscan, int x, int lt, int& e, int& rt) {
  const int base = x ? sscan[32 * x - 1] : 0;
  const int nrouted = sscan[32 * x + 31] - base;
  if (lt >= nrouted) { e = 256; rt = x * (NTOK / 128 / 8) + (lt - nrouted); return; }
  const int g = base + lt;
  int lo = 32 * x, hi = 32 * x + 31;
  while (lo < hi) { const int mid = (lo + hi) >> 1; if (sscan[mid] > g) hi = mid; else lo = mid + 1; }
  e = ((lo & 31) << 3) | (lo >> 5); rt = g - (lo ? sscan[lo - 1] : 0);
}

typedef int v8i __attribute__((ext_vector_type(8)));
typedef int i32x4 __attribute__((ext_vector_type(4)));
#define MX_ONE 0x7f7f7f7f
__device__ __forceinline__ long lo64(const u32x4& v) { return (long)(((unsigned long long)v[1] << 32) | (unsigned long long)v[0]); }
__device__ __forceinline__ long hi64(const u32x4& v) { return (long)(((unsigned long long)v[3] << 32) | (unsigned long long)v[2]); }
__device__ __forceinline__ void ph_moe(unsigned char* smem, int e, int rt, const unsigned char* __restrict__ x8, const int* __restrict__ cnt,
                                       const int* __restrict__ list, const float* __restrict__ gates, const unsigned char* __restrict__ wge, const unsigned char* __restrict__ wue,
                                       const unsigned char* __restrict__ wde, unsigned char* __restrict__ ybuf, unsigned char* __restrict__ dummy) {
  int* sasg = (int*)(smem + SM_MISC + 2048);
  float* sgate = (float*)(smem + SM_MISC + 2048 + 512);
  const int tid = TIDX, lane = tid & 63, w = tid >> 6, fr = lane & 15, fq = lane >> 4;
  __syncthreads();
  if (tid < 128) {
    const int r = rt * 128 + tid;
    int a = -1;
    if (e < 256) {
      int cum = 0;
#pragma unroll
      for (int s = 0; s < NSH; ++s) {
        const int c = cnt[s * NEXP + e];
        if (r >= cum && r < cum + c) a = list[((size_t)s * NEXP + e) * CAPS + (r - cum)];
        cum += c;
      }
    } else if (r < NTOK) a = NA + r;
    sasg[tid] = a;
    sgate[tid] = (a >= 0 && a < NA) ? gates[a] : 1.f;
  }
  __syncthreads();
  v8i hf[2][2];
  {
    LdRowBF16 al; al.init([&](int r) { const int a = sasg[r]; const int tok = (a < 0) ? 0 : (a < NA ? (a >> 3) : (a - NA)); return x8 + (size_t)tok * DM; }, 0);
    LdRowBF16 bl; bl.init([&](int j) {
      const int bn = j >> 4, ff = (bn >> 1) * 16 + (j & 15);
      return ((bn & 1) ? wue : wge) + (size_t)ff * DM; }, (size_t)64 * DM);
    al.issue(0, 0, smem); bl.issue(0, 0, smem + 16384);
    asm volatile("s_waitcnt vmcnt(0)" ::: "memory");
    __syncthreads();
#pragma unroll
    for (int m = 0; m < 2; ++m)
#pragma unroll
      for (int s = 0; s < 2; ++s) hf[m][s] = (v8i){0, 0, 0, 0, 0, 0, 0, 0};
#pragma unroll 1
    for (int ct = 0; ct < 4; ++ct) {
      f32x4 acc[2][8];
#pragma unroll
      for (int m = 0; m < 2; ++m)
#pragma unroll
        for (int n = 0; n < 8; ++n) acc[m][n] = (f32x4){0.f, 0.f, 0.f, 0.f};
#pragma unroll 1
      for (int kk = 0; kk < 8; ++kk) {
        const int j = ct * 8 + kk;
        unsigned char* cur = smem + (j & 1) * 32768; unsigned char* nxt = smem + ((j & 1) ^ 1) * 32768;
        if (j + 1 < 32) { al.issue((j + 1) >> 3, (j + 1) & 7, nxt); bl.issue((j + 1) >> 3, (j + 1) & 7, nxt + 16384); }
        {
          v8i a[2], bfrag[8];
#pragma unroll
          for (int m = 0; m < 2; ++m) {
            const int row = w * 32 + m * 16 + fr;
            const i32x4 lo = *(const i32x4*)(cur + row * 128 + ((fq ^ (row & 7)) << 4));
            const i32x4 hi = *(const i32x4*)(cur + row * 128 + (((4 + fq) ^ (row & 7)) << 4));
            a[m] = __builtin_shufflevector(lo, hi, 0, 1, 2, 3, 4, 5, 6, 7);
          }
#pragma unroll
          for (int n = 0; n < 8; ++n) {
            const int row = n * 16 + fr;
            const i32x4 lo = *(const i32x4*)(cur + 16384 + row * 128 + ((fq ^ (row & 7)) << 4));
            const i32x4 hi = *(const i32x4*)(cur + 16384 + row * 128 + (((4 + fq) ^ (row & 7)) << 4));
            bfrag[n] = __builtin_shufflevector(lo, hi, 0, 1, 2, 3, 4, 5, 6, 7);
          }
          __builtin_amdgcn_s_setprio(1);
#pragma unroll
          for (int n = 0; n < 8; ++n)
#pragma unroll
            for (int m = 0; m < 2; ++m)
              acc[m][n] = __builtin_amdgcn_mfma_scale_f32_16x16x128_f8f6f4(bfrag[n], a[m], acc[m][n], 0, 0, 0, MX_ONE, 0, MX_ONE);
          __builtin_amdgcn_s_setprio(0);
          __builtin_amdgcn_sched_group_barrier(0x100, 20, 0);
          __builtin_amdgcn_sched_group_barrier(0x008, 16, 0);
        }
        asm volatile("s_waitcnt vmcnt(0)" ::: "memory");
        __syncthreads();
      }
#pragma unroll
      for (int m = 0; m < 2; ++m) {
        int hp[4][2];
#pragma unroll
        for (int p = 0; p < 4; ++p) {
          float hv[4];
#pragma unroll
          for (int r = 0; r < 4; ++r) hv[r] = siluf(acc[m][2 * p][r] * (1.f / SC_WG)) * acc[m][2 * p + 1][r] * (SC_H / SC_WU);
          int pk = 0;
          pk = __builtin_amdgcn_cvt_pk_fp8_f32(hv[0], hv[1], pk, false);
          pk = __builtin_amdgcn_cvt_pk_fp8_f32(hv[2], hv[3], pk, true);
          hp[p][0] = pk;
        }
        if (ct == 0) { hf[m][0][0] = hp[0][0]; hf[m][0][1] = hp[1][0]; hf[m][0][2] = hp[2][0]; hf[m][0][3] = hp[3][0]; }
        else if (ct == 1) { hf[m][0][4] = hp[0][0]; hf[m][0][5] = hp[1][0]; hf[m][0][6] = hp[2][0]; hf[m][0][7] = hp[3][0]; }
        else if (ct == 2) { hf[m][1][0] = hp[0][0]; hf[m][1][1] = hp[1][0]; hf[m][1][2] = hp[2][0]; hf[m][1][3] = hp[3][0]; }
        else { hf[m][1][4] = hp[0][0]; hf[m][1][5] = hp[1][0]; hf[m][1][6] = hp[2][0]; hf[m][1][7] = hp[3][0]; }
      }
    }
  }
#define MOE_RAW_BARRIER() do { asm volatile("s_waitcnt lgkmcnt(0)" ::: "memory"); __builtin_amdgcn_s_barrier(); } while (0)
  {
    LdRowBF16 bl; bl.init([&](int j) { return wde + (size_t)j * EFF; }, (size_t)128 * EFF);
    bl.issue(0, 0, smem); bl.issue(0, 1, smem + 16384);
#pragma unroll 1
    for (int ct = 0; ct < 8; ++ct) {
      f32x4 acc[2][8];
#pragma unroll
      for (int m = 0; m < 2; ++m)
#pragma unroll
        for (int n = 0; n < 8; ++n) acc[m][n] = (f32x4){0.f, 0.f, 0.f, 0.f};
#pragma unroll
      for (int kk = 0; kk < 2; ++kk) {
        const int j = ct * 2 + kk;
        if (j < 2 || j == 15) asm volatile("s_waitcnt vmcnt(4)" ::: "memory");
        else asm volatile("s_waitcnt vmcnt(8)" ::: "memory");
        MOE_RAW_BARRIER();
        if (j + 2 < 16) bl.issue((j + 2) >> 1, (j + 2) & 1, smem + ((j + 2) % 3) * 16384);
        const unsigned char* cur = smem + (j % 3) * 16384;
        {
          v8i wf[8];
#pragma unroll
          for (int n = 0; n < 8; ++n) {
            const int row = n * 16 + fr;
            const i32x4 lo = *(const i32x4*)(cur + row * 128 + ((fq ^ (row & 7)) << 4));
            const i32x4 hi = *(const i32x4*)(cur + row * 128 + (((4 + fq) ^ (row & 7)) << 4));
            wf[n] = __builtin_shufflevector(lo, hi, 0, 1, 2, 3, 4, 5, 6, 7);
          }
          __builtin_amdgcn_s_setprio(1);
#pragma unroll
          for (int n = 0; n < 8; ++n)
#pragma unroll
            for (int m = 0; m < 2; ++m) acc[m][n] = __builtin_amdgcn_mfma_scale_f32_16x16x128_f8f6f4(wf[n], hf[m][kk], acc[m][n], 0, 0, 0, MX_ONE, 0, MX_ONE);
          __builtin_amdgcn_s_setprio(0);
          __builtin_amdgcn_sched_group_barrier(0x100, 16, 0);
          __builtin_amdgcn_sched_group_barrier(0x008, 16, 0);
        }
      }
      const int n0 = ct * 128;
      {
        unsigned char* stg = smem + 3 * 16384 + w * 4096;
#pragma unroll
        for (int m = 0; m < 2; ++m) {
          const int row = m * 16 + fr;
          const float gt = sgate[w * 32 + row] * (SC_Y / (SC_H * SC_WD));
#pragma unroll
          for (int n = 0; n < 8; ++n) {
            int pk = 0;
            pk = __builtin_amdgcn_cvt_pk_fp8_f32(acc[m][n][0] * gt, acc[m][n][1] * gt, pk, false);
            pk = __builtin_amdgcn_cvt_pk_fp8_f32(acc[m][n][2] * gt, acc[m][n][3] * gt, pk, true);
            *(int*)(stg + row * 128 + ((n ^ (row & 7)) << 4) + 4 * fq) = pk;
          }
        }
#pragma unroll
        for (int i = 0; i < 4; ++i) {
          const int q = lane + 64 * i, row = q >> 3, ch = q & 7;
          const int a = sasg[w * 32 + row];
          unsigned char* yp = ((a >= 0) ? ybuf + (size_t)a * DM : dummy) + n0 + ch * 16;
          *(u32x4*)yp = *(const u32x4*)(stg + row * 128 + ((ch ^ (row & 7)) << 4));
        }
      }
    }
    MOE_RAW_BARRIER();
  }
#undef MOE_RAW_BARRIER
}

__device__ __forceinline__ void ph_final(int item, float* __restrict__ out, const bf16_t* __restrict__ xbf, const unsigned char* __restrict__ ybuf, const float* __restrict__ gam, const float* __restrict__ bet) {
  const int row = item * 4 + (TIDX >> 6), lane = TIDX & 63;
  f32x4* p = (f32x4*)(out + (size_t)row * DM + 16 * lane);
  const u32x4 xa = *(const u32x4*)(xbf + (size_t)row * DM + 16 * lane), xb = *(const u32x4*)(xbf + (size_t)row * DM + 16 * lane + 8);
  u32x4 yv[9];
#pragma unroll
  for (int k = 0; k < 8; ++k) yv[k] = *(const u32x4*)(ybuf + ((size_t)row * 8 + k) * DM + 16 * lane);
  yv[8] = *(const u32x4*)(ybuf + ((size_t)NA + row) * DM + 16 * lane);
  float ys[16];
#pragma unroll
  for (int c = 0; c < 16; ++c) ys[c] = 0.f;
#pragma unroll
  for (int k = 0; k < 9; ++k)
#pragma unroll
    for (int d = 0; d < 4; ++d) {
      const hwf32x2 lo = __builtin_amdgcn_cvt_pk_f32_fp8((int)yv[k][d], false), hi = __builtin_amdgcn_cvt_pk_f32_fp8((int)yv[k][d], true);
      ys[4 * d + 0] += lo[0]; ys[4 * d + 1] += lo[1]; ys[4 * d + 2] += hi[0]; ys[4 * d + 3] += hi[1];
    }
  f32x4 v[4];
  v[0] = (f32x4){bflo(xa[0]), bfhi(xa[0]), bflo(xa[1]), bfhi(xa[1])}; v[1] = (f32x4){bflo(xa[2]), bfhi(xa[2]), bflo(xa[3]), bfhi(xa[3])};
  v[2] = (f32x4){bflo(xb[0]), bfhi(xb[0]), bflo(xb[1]), bfhi(xb[1])}; v[3] = (f32x4){bflo(xb[2]), bfhi(xb[2]), bflo(xb[3]), bfhi(xb[3])};
  float s = 0.f;
#pragma unroll
  for (int i = 0; i < 4; ++i)
#pragma unroll
    for (int r = 0; r < 4; ++r) { v[i][r] = v[i][r] * ALPHA + ys[4 * i + r] * (1.f / SC_Y); s += v[i][r]; }
  const float mu = wave_sum(s) * (1.f / DM);
  float q = 0.f;
#pragma unroll
  for (int i = 0; i < 4; ++i)
#pragma unroll
    for (int r = 0; r < 4; ++r) { const float d = v[i][r] - mu; q += d * d; }
  const float rs = rsqrtf(wave_sum(q) * (1.f / DM) + LN_EPS);
#pragma unroll
  for (int i = 0; i < 4; ++i) {
    const f32x4 gg = *(const f32x4*)(gam + 16 * lane + 4 * i), bb = *(const f32x4*)(bet + 16 * lane + 4 * i);
    p[i] = (v[i] - mu) * rs * gg + bb;
  }
}

#define XB_TMO      128
#define XB_XCNT(j)  (256  + 64 * (j))
#define XB_XSUB(j)  (1280 + 64 * (j))
#define XB_XGEN(j)  (2304 + 64 * (j))
#define XB_TOP      3328
#define XB_TOPGEN   3392
#define XCD_BAR_WORDS 3456
#define XB_SPIN_CAP (1u << 22)
#define LAS __attribute__((address_space(3)))
__device__ __forceinline__ unsigned xb_ld(unsigned* p)              { return __hip_atomic_load(p, __ATOMIC_RELAXED, __HIP_MEMORY_SCOPE_AGENT); }
__device__ __forceinline__ unsigned xb_add(unsigned* p, unsigned v) { return __hip_atomic_fetch_add(p, v, __ATOMIC_RELAXED, __HIP_MEMORY_SCOPE_AGENT); }
__device__ __forceinline__ unsigned xb_xcc_id() { return (unsigned)__builtin_amdgcn_s_getreg((3 << 11) | 20) & 0xFu; }
#define XB_SPIN(cond, bar) do { unsigned _sp = 0; while (cond) { __builtin_amdgcn_s_sleep(1); \
    if ((++_sp & 255u) == 0u) { if (xb_ld(&(bar)[XB_TMO])) break; if (_sp > XB_SPIN_CAP) { atomicAdd(&(bar)[XB_TMO], 1u); break; } } } } while (0)
struct XcdBarrier { unsigned* bar; unsigned x; volatile LAS unsigned* st; };
__device__ __forceinline__ XcdBarrier xcd_barrier_post(unsigned* bar, volatile LAS unsigned* st) {
  XcdBarrier b; b.bar = bar; b.x = xb_xcc_id(); b.st = st;
  if (threadIdx.x == 0) (void)xb_add(&bar[XB_XCNT(b.x)], 1u);
  return b;
}
__device__ __forceinline__ void xcd_barrier_complete(unsigned* bar, unsigned x, unsigned& nloc, unsigned& nx) {
  const unsigned G = gridDim.x * gridDim.y * gridDim.z;
  unsigned sum, cnt, mine, sp = 0u;
  for (;;) {
    sum = 0u; cnt = 0u; mine = 0u;
#pragma unroll
    for (unsigned j = 0; j < 16; ++j) { const unsigned c = xb_ld(&bar[XB_XCNT(j)]); sum += c; cnt += (c > 0u) ? 1u : 0u; mine = (j == x) ? c : mine; }
    if (sum == G) break;
    __builtin_amdgcn_s_sleep(1);
    if ((++sp & 255u) == 0u) { if (xb_ld(&bar[XB_TMO])) break; if (sp > XB_SPIN_CAP) { atomicAdd(&bar[XB_TMO], 1u); break; } }
  }
  nloc = mine > 0u ? mine : 1u; nx = cnt > 0u ? cnt : 1u;
}
__device__ __forceinline__ void xcd_barrier(const XcdBarrier& b) {
  asm volatile("s_waitcnt vmcnt(0)" ::: "memory");
  __syncthreads();
  if (threadIdx.x == 0) {
    unsigned* bar = b.bar;
    __builtin_amdgcn_s_waitcnt(0);
    unsigned nloc = b.st[0], nx = b.st[1];
    if (nloc == 0u) { xcd_barrier_complete(bar, b.x, nloc, nx); b.st[0] = nloc; b.st[1] = nx; }
    const unsigned old = xb_add(&bar[XB_XSUB(b.x)], 1u);
    const unsigned gen = old / nloc;
    if (old + 1u == (gen + 1u) * nloc) {
      __builtin_amdgcn_fence(__ATOMIC_RELEASE, "agent");
      asm volatile("s_waitcnt vmcnt(0)" ::: "memory");
      const unsigned og = xb_add(&bar[XB_TOP], 1u);
      const unsigned tg = og / nx;
      if (og + 1u == (tg + 1u) * nx) xb_add(&bar[XB_TOPGEN], 1u);
      else XB_SPIN(xb_ld(&bar[XB_TOPGEN]) == tg, bar);
      __builtin_amdgcn_fence(__ATOMIC_ACQUIRE, "agent");
      xb_add(&bar[XB_XGEN(b.x)], 1u);
      asm volatile("s_waitcnt vmcnt(0)" ::: "memory");
    } else {
      XB_SPIN(xb_ld(&bar[XB_XGEN(b.x)]) == gen, bar);
      __builtin_amdgcn_fence(__ATOMIC_ACQUIRE, "agent");
      asm volatile("s_waitcnt vmcnt(0)" ::: "memory");
    }
  }
  __syncthreads();
}

__global__ void __launch_bounds__(256, 2) mega(Params P) {
  __shared__ __attribute__((aligned(16))) unsigned char smem[SMEM_BYTES];
  const int bid = blockIdx.x, nblk = gridDim.x;
#define xin (P.in[0])
#define w_in (P.in[1])
#define conv_w (P.in[2])
#define a_log (P.in[3])
#define dt_bias (P.in[4])
#define dn_norm_g (P.in[5])
#define sinks (P.in[6])
#define w_out (P.in[7])
#define ln1_g (P.in[8])
#define ln1_b (P.in[9])
#define router_w (P.in[10])
#define router_bias (P.in[11])
#define w_gate (P.in[12])
#define w_up (P.in[13])
#define w_down (P.in[14])
#define sw_gate (P.in[15])
#define sw_up (P.in[16])
#define sw_down (P.in[17])
#define ln2_g (P.in[18])
#define ln2_b (P.in[19])
#define outp (P.out)
#define x1bf ((bf16_t*)(P.ws + WS_X1BF))
#define logits ((float*)(P.ws + WS_LOGIT))
#define list ((int*)(P.ws + WS_LIST))
#define gates ((float*)(P.ws + WS_GATES))
#define cnt ((int*)(P.ws + WS_CTRL + CNT16_OFF))
#define barw ((unsigned*)(P.ws + WS_CTRL + 4096))
#define mixed ((bf16_t*)(P.ws + WS_MIXED))
#define proj ((bf16_t*)(P.ws + WS_PROJ))
#define ba ((float*)(P.ws + WS_BA))
#define QD ((bf16_t*)(P.ws + WS_QD))
#define W0N ((bf16_t*)(P.ws + WS_W0N))
#define KTT ((bf16_t*)(P.ws + WS_KTT))
#define RV ((bf16_t*)(P.ws + WS_RV))
#define TM ((bf16_t*)(P.ws + WS_TM))
#define ATT ((bf16_t*)(P.ws + WS_ATT))
#define GL ((float*)(P.ws + WS_GL))
#define obuf ((float*)(P.ws + WS_O))
#define VTb ((bf16_t*)(P.ws + WS_VT))
#define MIXO ((bf16_t*)(P.ws + WS_O))
#define XBF ((bf16_t*)(P.ws + WS_XBF))
#define WTIN ((bf16_t*)(P.ws + WS_WTIN))
#define WTOUT ((bf16_t*)(P.ws + WS_WTOUT))
#define WTR ((bf16_t*)(P.ws + WS_WTR))
#define ybuf ((unsigned char*)(P.ws + WS_YBUF))
  {
    volatile LAS unsigned* st0 = (volatile LAS unsigned*)(smem + SM_MISC + 4080);
    if (threadIdx.x == 0) { st0[0] = 0u; st0[1] = 0u; }
    __syncthreads();
  }
  const int xcd = bid & 7, xloc = bid >> 3, xnl = nblk >> 3;
  XcdBarrier xb = xcd_barrier_post(barw, (volatile LAS unsigned*)(smem + SM_MISC + 4080));
  for (int it = bid; it < NTOK / 8; it += nblk) { ph_cvt_x(2 * it, xin, XBF); ph_cvt_x(2 * it + 1, xin, XBF); }
  for (int it = bid; it < 16 * 46 + 16 * 16 + 16 * 4; it += nblk) {
    if (it < 16 * 46) ph_cvt_wt(smem, it % 16, it / 16, w_in, DM, INC, WTIN);
    else if (it < 16 * 46 + 256) { const int j = it - 16 * 46; ph_cvt_wt(smem, j % 16, j / 16, w_out, DM, DM, WTOUT); }
    else { const int j = it - 16 * 46 - 256; ph_cvt_wt(smem, j % 16, j / 16, router_w, DM, NEXP, WTR); }
  }
  xcd_barrier(xb);
  for (int l = xloc; l < 64; l += xnl) ph_proj(smem, xcd, l, XBF, WTIN, proj, ba, VTb);
  xcd_barrier(xb);
  const bool is512 = (nblk == 512);
  for (int it = bid; it < 2048; it += nblk) ph_dnchunk(smem, it, proj, ba, conv_w, a_log, dt_bias, QD, W0N, KTT, RV, TM, ATT, GL);
  if (!is512) for (int it = bid; it < 512; it += nblk) ph_swa(smem, it, proj, VTb, sinks, mixed);
  xcd_barrier(xb);
  {
    const bool scan_blk = is512 ? (bid < 256 && (bid & 7) < 2) : ((bid < 64) || (nblk <= 64));
    const bool mate_blk = is512 && bid >= 256 && (bid & 7) < 2;
    const int cb = (bid >> 3) * 6 + (bid & 7) - 2;
    if (scan_blk) {
      if (is512) ph_dnscan(smem, (bid & 1) * 32 + (bid >> 3), QD, W0N, KTT, RV, TM, ATT, GL, obuf);
      else for (int it = bid; it < 64; it += nblk) ph_dnscan(smem, it, QD, W0N, KTT, RV, TM, ATT, GL, obuf);
    } else if (is512 && !mate_blk) {
      ph_swa(smem, cb, proj, VTb, sinks, mixed);
      if (cb < 128) ph_swa(smem, cb + 384, proj, VTb, sinks, mixed);
      __syncthreads();
    }
    if (mate_blk) { }
    else {
      const int tid = TIDX, lane = tid & 63, wv = tid >> 6;
      float* tile = (float*)(smem + wv * 16896);
      const int total = 257 * 192;
      constexpr int NTA = 28;
      int it, step, end;
      if (is512 && scan_blk) { const int sb = (bid & 1) * 32 + (bid >> 3); it = 256 * 192 + sb * 4 + wv; step = 64 * 4; end = total; }
      else if (is512 && cb < 128) { it = cb * 4 + wv; step = 512; end = 512 * NTA; }
      else if (is512) { it = 512 * NTA + (cb - 128) * 4 + wv; step = 1024; end = 256 * 192; }
      else if (nblk > 64) { if (bid < 64) { it = 0; step = 1; end = 0; } else { it = (bid - 64) * 4 + wv; step = (nblk - 64) * 4; end = total; } }
      else { it = bid * 4 + wv; step = nblk * 4; end = total; }
      f32x4 vc[16], vn[16];
      CvtTile tc = cvt_decode(it < end ? it : 0, lane, w_gate, w_up, w_down, sw_gate, sw_up, sw_down, P.ws);
      if (it < end) cvt_load(tc, vc);
      while (it < end) {
        const int itn = it + step;
        CvtTile tn = cvt_decode(itn < end ? itn : 0, lane, w_gate, w_up, w_down, sw_gate, sw_up, sw_down, P.ws);
        if (itn < end) cvt_load(tn, vn);
        cvt_store(tile, lane, tc, vc);
#pragma unroll
        for (int i = 0; i < 16; ++i) vc[i] = vn[i];
        tc = tn; it = itn;
      }
    }
  }
  xcd_barrier(xb);
  for (int it = bid; it < NTOK / 4; it += nblk) ph_dn_post(it, obuf, proj, dn_norm_g, mixed);
  xcd_barrier(xb);
  for (int l = xloc; l < 64; l += xnl) ph_wout(smem, xcd, l, mixed, WTOUT, MIXO);
  xcd_barrier(xb);
  for (int it = bid; it < NTOK / 4; it += nblk) ph_ln1(it, xin, MIXO, ln1_g, ln1_b, x1bf, (unsigned char*)(P.ws + WS_X1F8));
  xcd_barrier(xb);
  for (int i = xloc; i < 32 * 2; i += xnl) ph_router(smem, (xcd * 32 + i / 2) * 2 + i % 2, x1bf, WTR, logits);
  xcd_barrier(xb);
  for (int it = bid; it < NTOK / 4; it += nblk) ph_route(it, logits, router_bias, cnt, list, gates);
  xcd_barrier(xb);
  int* sscan = (int*)(smem + SM_MISC);
  moe_build_prefix(cnt, sscan);
  const int ntile = sscan[32 * xcd + 31] - (xcd ? sscan[32 * xcd - 1] : 0) + NTOK / 128 / 8;
  for (int it = xloc; it < ntile; it += xnl) {
    int e, rt; moe_locate(sscan, xcd, it, e, rt);
    ph_moe(smem, e, rt, (const unsigned char*)(P.ws + WS_X1F8), cnt, list, gates,
           (const unsigned char*)P.ws + ((e < 256) ? WS_WTG8 + (size_t)e * EFF * DM : WS_WTSG8), (const unsigned char*)P.ws + ((e < 256) ? WS_WTU8 + (size_t)e * EFF * DM : WS_WTSU8),
           (const unsigned char*)P.ws + ((e < 256) ? WS_WTD8 + (size_t)e * DM * EFF : WS_WTSD8), ybuf, (unsigned char*)(P.ws + WS_DUMMY));
  }
  xcd_barrier(xb);
  for (int it = bid; it < NTOK / 4; it += nblk) ph_final(it, outp, x1bf, ybuf, ln2_g, ln2_b);
}

#undef xin
#undef w_in
#undef conv_w
#undef a_log
#undef dt_bias
#undef dn_norm_g
#undef sinks
#undef w_out
#undef ln1_g
#undef ln1_b
#undef router_w
#undef router_bias
#undef w_gate
#undef w_up
#undef w_down
#undef sw_gate
#undef sw_up
#undef sw_down
#undef ln2_g
#undef ln2_b
#undef outp
#undef x1bf
#undef logits
#undef list
#undef gates
#undef cnt
#undef mixed
#undef proj
#undef ba
#undef QD
#undef W0N
#undef KTT
#undef RV
#undef TM
#undef ATT
#undef GL
#undef obuf
#undef ybuf
#undef VTb
#undef MIXO
#undef XBF
#undef WTIN
#undef WTOUT
#undef WTR
#undef barw

extern "C" void kernel_launch(void* const* d_in, const int* in_sizes, int n_in, void* d_out, int out_size, void* d_ws, size_t ws_size, hipStream_t stream) {
  static int grid_blocks = 0;
  if (!grid_blocks) {
    int dev = 0, cus = 0, per_cu = 0;
    (void)hipGetDevice(&dev);
    (void)hipDeviceGetAttribute(&cus, hipDeviceAttributeMultiprocessorCount, dev);
    (void)hipOccupancyMaxActiveBlocksPerMultiprocessor(&per_cu, mega, 256, 0);
    if (per_cu > 2) per_cu = 2;
    if (per_cu < 1) per_cu = 1;
    grid_blocks = cus * per_cu;
  }
  Params p{};
  for (int i = 0; i < 20; ++i) p.in[i] = (const float*)d_in[i];
  p.out = (float*)d_out; p.ws = (char*)d_ws;
  (void)hipMemsetAsync((char*)d_ws + WS_CTRL, 0, CNT16_OFF + NSH * NEXP * 4, stream);
  void* args[] = {&p};
  hipError_t e = hipLaunchCooperativeKernel((void*)mega, dim3(grid_blocks), dim3(256), args, 0, stream);
  if (e != hipSuccess) fprintf(stderr, "cooperative launch failed: %s (grid %d)\n", hipGetErrorString(e), grid_blocks);
}
```
